# Optimizing an MI355X kernel written in HIP

```python
import math
import jax, jax.numpy as jnp
from jax import lax
import numpy as np

D_MODEL = 1024
BATCH = 2
SEQ = 8192
DEPTH = 2

N_MEM = 256
N_A_LAYERS = DEPTH // 2
N_B_LAYERS = DEPTH - N_A_LAYERS
HEAD_DIM = 64
FOX_HEADS = 12
MEM_HEADS = 4
MLA_HEADS = 12
Q_LORA = 384
KV_LORA = 256
QK_NOPE = 64
QK_ROPE = 32
V_DIM = 64
ROPE_THETA = 10000.0
N_EXPERTS = 32
TOP_K = 4
D_EXPERT = D_MODEL
SWIGLU_LIMIT = 7.0
SWIGLU_ALPHA = 1.702
MOE_BLOCK = 128
Q_BLOCK = 128
LN_EPS = 1e-5
RMS_EPS = 1e-6
NEG_INF = -1e30
DEEPNORM_ALPHA = (2 * DEPTH) ** 0.25
DEEPNORM_BETA = (8 * DEPTH) ** -0.25
FOX_WIDTH = FOX_HEADS * HEAD_DIM
MEM_WIDTH = MEM_HEADS * HEAD_DIM
MLA_V_WIDTH = MLA_HEADS * V_DIM
FOX_IN = 3 * FOX_WIDTH + FOX_HEADS + MEM_WIDTH
MLA_IN = Q_LORA + MEM_WIDTH
MIX_OUT_A = FOX_WIDTH + MEM_WIDTH
MIX_OUT_B = MLA_V_WIDTH + MEM_WIDTH

kernel_name = 'hybrid_fox_mla_yoco_moe_block'


def layer_norm(x, g, b):
    xf = x.astype(jnp.float32)
    mu = jnp.mean(xf, axis=-1, keepdims=True)
    var = jnp.mean(jnp.square(xf - mu), axis=-1, keepdims=True)
    y = (xf - mu) * lax.rsqrt(var + LN_EPS) * g.astype(jnp.float32) + b.astype(jnp.float32)
    return y.astype(x.dtype)


def rms_norm(x, g):
    xf = x.astype(jnp.float32)
    y = xf * lax.rsqrt(jnp.mean(jnp.square(xf), axis=-1, keepdims=True) + RMS_EPS) * g.astype(jnp.float32)
    return y.astype(x.dtype)


def rope(x, positions):
    r = x.shape[-1]
    half = r // 2
    inv_freq = ROPE_THETA ** (-jnp.arange(half, dtype=jnp.float32) * 2.0 / r)
    ang = positions.astype(jnp.float32)[..., None] * inv_freq
    cos = jnp.cos(ang)[:, :, None, :]
    sin = jnp.sin(ang)[:, :, None, :]
    xf = x.astype(jnp.float32)
    x1, x2 = xf[..., :half], xf[..., half:]
    return jnp.concatenate([x1 * cos - x2 * sin, x1 * sin + x2 * cos], axis=-1).astype(x.dtype)


def causal_block_attention(q, k, v, scale, cum=None):
    B, S, H, Dk = q.shape
    nb = S // Q_BLOCK
    qb = q.reshape(B, nb, Q_BLOCK, H, Dk).swapaxes(0, 1)
    key_pos = jnp.arange(S)
    blk_idx = jnp.arange(nb)
    if cum is not None:
        cum_k = cum.transpose(0, 2, 1)
        cum_q = cum.reshape(B, nb, Q_BLOCK, H).swapaxes(0, 1)

    def one_block(args):
        i, qi = args[0], args[1]
        s = jnp.einsum('bqhd,bkhd->bhqk', qi, k, preferred_element_type=jnp.float32) * scale
        if cum is not None:
            ci = args[2]
            s = s + ci.transpose(0, 2, 1)[..., None] - cum_k[:, :, None, :]
        q_pos = i * Q_BLOCK + jnp.arange(Q_BLOCK)
        s = jnp.where(key_pos[None, :] <= q_pos[:, None], s, NEG_INF)
        p = jax.nn.softmax(s, axis=-1)
        return jnp.einsum('bhqk,bkhd->bqhd', p.astype(v.dtype), v)

    xs = (blk_idx, qb) if cum is None else (blk_idx, qb, cum_q)
    out = lax.map(one_block, xs)
    return out.swapaxes(0, 1).reshape(B, S, H, v.shape[-1])


def memory_attention(q_flat, mem, w_mkv):
    B, S, _ = q_flat.shape
    M = mem.shape[1]
    q = q_flat.reshape(B, S, MEM_HEADS, HEAD_DIM)
    mkv = jnp.einsum('bmd,de->bme', mem, w_mkv)
    mk = mkv[..., :MEM_WIDTH].reshape(B, M, MEM_HEADS, HEAD_DIM)
    mv = mkv[..., MEM_WIDTH:].reshape(B, M, MEM_HEADS, HEAD_DIM)
    s = jnp.einsum('bshd,bmhd->bhsm', q, mk, preferred_element_type=jnp.float32) * (HEAD_DIM ** -0.5)
    p = jax.nn.softmax(s, axis=-1)
    o = jnp.einsum('bhsm,bmhd->bshd', p.astype(mv.dtype), mv)
    return o.reshape(B, S, MEM_WIDTH)


def fox_mixer(x, mem, w_in, b_f, w_out, w_mkv):
    B, S, _ = x.shape
    proj = jnp.einsum('bsd,de->bse', x, w_in)
    q = proj[..., :FOX_WIDTH].reshape(B, S, FOX_HEADS, HEAD_DIM)
    k = proj[..., FOX_WIDTH:2 * FOX_WIDTH].reshape(B, S, FOX_HEADS, HEAD_DIM)
    v = proj[..., 2 * FOX_WIDTH:3 * FOX_WIDTH].reshape(B, S, FOX_HEADS, HEAD_DIM)
    f_logit = proj[..., 3 * FOX_WIDTH:3 * FOX_WIDTH + FOX_HEADS]
    mq = proj[..., 3 * FOX_WIDTH + FOX_HEADS:]
    log_f = jax.nn.log_sigmoid(f_logit.astype(jnp.float32) + b_f.astype(jnp.float32))
    cum = jnp.cumsum(log_f, axis=1)
    fox = causal_block_attention(q, k, v, HEAD_DIM ** -0.5, cum)
    memo = memory_attention(mq, mem, w_mkv)
    merged = jnp.concatenate([fox.reshape(B, S, FOX_WIDTH), memo], axis=-1)
    return jnp.einsum('bse,ed->bsd', merged, w_out)


def shared_mla_kv(h, positions, w_dkv, g_kv, w_ukv):
    B, S, _ = h.shape
    lat = jnp.einsum('bsd,de->bse', h, w_dkv)
    c_kv = rms_norm(lat[..., :KV_LORA], g_kv)
    k_r = lat[..., KV_LORA:]
    kv = jnp.einsum('bsc,ce->bse', c_kv, w_ukv).reshape(B, S, MLA_HEADS, QK_NOPE + V_DIM)
    k_nope, v = kv[..., :QK_NOPE], kv[..., QK_NOPE:]
    k_rope = rope(k_r[:, :, None, :], positions)
    k = jnp.concatenate([k_nope, jnp.broadcast_to(k_rope, (B, S, MLA_HEADS, QK_ROPE))], axis=-1)
    return k, v


def mla_mixer(x, mem, positions, k, v, w_in, g_q, w_uq, w_out, w_mkv):
    B, S, _ = x.shape
    proj = jnp.einsum('bsd,de->bse', x, w_in)
    c_q = rms_norm(proj[..., :Q_LORA], g_q)
    mq = proj[..., Q_LORA:]
    q = jnp.einsum('bsc,ce->bse', c_q, w_uq).reshape(B, S, MLA_HEADS, QK_NOPE + QK_ROPE)
    q = jnp.concatenate([q[..., :QK_NOPE], rope(q[..., QK_NOPE:], positions)], axis=-1)
    att = causal_block_attention(q, k, v, (QK_NOPE + QK_ROPE) ** -0.5)
    memo = memory_attention(mq, mem, w_mkv)
    merged = jnp.concatenate([att.reshape(B, S, MLA_V_WIDTH), memo], axis=-1)
    return jnp.einsum('bse,ed->bsd', merged, w_out)


def moe_ffn(x, w_r, b_r, w_gu, b_gu, w_dn, b_dn):
    B, S, D = x.shape
    T = B * S
    xt = x.reshape(T, D)
    logits = jnp.dot(xt, w_r, preferred_element_type=jnp.float32) + b_r.astype(jnp.float32)
    top_logit, top_idx = lax.top_k(logits, TOP_K)
    gates = jax.nn.softmax(top_logit, axis=-1)
    M = T * TOP_K
    expert_flat = top_idx.reshape(M)
    token_flat = jnp.arange(M, dtype=jnp.int32) // TOP_K
    gate_flat = gates.reshape(M)
    order = jnp.argsort(expert_flat)
    e_sorted = expert_flat[order]
    tok_sorted = token_flat[order]
    gate_sorted = gate_flat[order]
    counts = jnp.bincount(expert_flat, length=N_EXPERTS)
    padded = ((counts + MOE_BLOCK - 1) // MOE_BLOCK) * MOE_BLOCK
    start = jnp.cumsum(counts) - counts
    pend = jnp.cumsum(padded)
    pstart = pend - padded
    dest = pstart[e_sorted] + (jnp.arange(M) - start[e_sorted])
    n_blocks = -(-M // MOE_BLOCK) + N_EXPERTS
    P = n_blocks * MOE_BLOCK
    slot_tok = jnp.full((P,), T, jnp.int32).at[dest].set(tok_sorted)
    x_pad = jnp.concatenate([xt, jnp.zeros((1, D), xt.dtype)], axis=0)
    xb = x_pad[slot_tok].reshape(n_blocks, MOE_BLOCK, D)
    block_expert = jnp.minimum(
        jnp.searchsorted(pend, jnp.arange(n_blocks) * MOE_BLOCK, side='right'), N_EXPERTS - 1)

    def expert_block(args):
        xi, e = args
        gu = jnp.dot(xi, w_gu[e]) + b_gu[e]
        g, u = gu[:, :D_EXPERT], gu[:, D_EXPERT:]
        g = jnp.minimum(g, SWIGLU_LIMIT)
        u = jnp.clip(u, -SWIGLU_LIMIT, SWIGLU_LIMIT)
        h = (u + 1.0) * (g * jax.nn.sigmoid(SWIGLU_ALPHA * g))
        return jnp.dot(h, w_dn[e]) + b_dn[e]

    yb = lax.map(expert_block, (xb, block_expert)).reshape(P, D)
    y_sorted = yb[dest].astype(jnp.float32) * gate_sorted[:, None]
    out = jax.ops.segment_sum(y_sorted, tok_sorted, num_segments=T)
    return out.astype(x.dtype).reshape(B, S, D)


def setup_inputs(seed: int = 0) -> dict:
    key = jax.random.key(seed)
    ks = jax.random.split(key, 24)

    def nrm(k, shape, scale):
        return jax.random.normal(k, shape, jnp.float32) * scale

    x = nrm(ks[0], (BATCH, SEQ, D_MODEL), 1.0)
    mem = nrm(ks[1], (BATCH, N_MEM, D_MODEL), 1.0)
    positions = jnp.broadcast_to(jnp.arange(SEQ, dtype=jnp.int32)[None, :], (BATCH, SEQ))
    a_w_in = nrm(ks[2], (N_A_LAYERS, D_MODEL, FOX_IN), D_MODEL ** -0.5)
    a_w_in = a_w_in.at[:, :, 2 * FOX_WIDTH:3 * FOX_WIDTH].multiply(DEEPNORM_BETA)
    a_b_f = nrm(ks[3], (N_A_LAYERS, FOX_HEADS), 0.1)
    a_w_out = nrm(ks[4], (N_A_LAYERS, MIX_OUT_A, D_MODEL), MIX_OUT_A ** -0.5 * DEEPNORM_BETA)
    b_w_in = nrm(ks[5], (N_B_LAYERS, D_MODEL, MLA_IN), D_MODEL ** -0.5)
    b_g_q = 1.0 + nrm(ks[6], (N_B_LAYERS, Q_LORA), 0.01)
    b_w_uq = nrm(ks[7], (N_B_LAYERS, Q_LORA, MLA_HEADS * (QK_NOPE + QK_ROPE)), Q_LORA ** -0.5)
    b_w_out = nrm(ks[8], (N_B_LAYERS, MIX_OUT_B, D_MODEL), MIX_OUT_B ** -0.5 * DEEPNORM_BETA)
    kv_w_dkv = nrm(ks[9], (D_MODEL, KV_LORA + QK_ROPE), D_MODEL ** -0.5)
    kv_g = 1.0 + nrm(ks[10], (KV_LORA,), 0.01)
    w_uk = nrm(ks[11], (KV_LORA, MLA_HEADS, QK_NOPE), KV_LORA ** -0.5)
    w_uv = nrm(ks[12], (KV_LORA, MLA_HEADS, V_DIM), KV_LORA ** -0.5 * DEEPNORM_BETA)
    kv_w_ukv = jnp.concatenate([w_uk, w_uv], axis=-1).reshape(KV_LORA, MLA_HEADS * (QK_NOPE + V_DIM))
    mem_w_kv = nrm(ks[13], (DEPTH, D_MODEL, 2 * MEM_WIDTH), D_MODEL ** -0.5)
    mem_w_kv = mem_w_kv.at[:, :, MEM_WIDTH:].multiply(DEEPNORM_BETA)
    ln_g = 1.0 + nrm(ks[14], (DEPTH, 2, D_MODEL), 0.01)
    ln_b = nrm(ks[15], (DEPTH, 2, D_MODEL), 0.01)
    moe_w_r = nrm(ks[16], (DEPTH, D_MODEL, N_EXPERTS), D_MODEL ** -0.5)
    moe_b_r = nrm(ks[17], (DEPTH, N_EXPERTS), 0.01)
    moe_w_gu = nrm(ks[18], (DEPTH, N_EXPERTS, D_MODEL, 2 * D_EXPERT), D_MODEL ** -0.5)
    moe_b_gu = nrm(ks[19], (DEPTH, N_EXPERTS, 2 * D_EXPERT), 0.01)
    moe_w_dn = nrm(ks[20], (DEPTH, N_EXPERTS, D_EXPERT, D_MODEL), D_EXPERT ** -0.5 * DEEPNORM_BETA)
    moe_b_dn = nrm(ks[21], (DEPTH, N_EXPERTS, D_MODEL), 0.01)
    return {'x': x, 'mem': mem, 'positions': positions,
            'a_w_in': a_w_in, 'a_b_f': a_b_f, 'a_w_out': a_w_out,
            'b_w_in': b_w_in, 'b_g_q': b_g_q, 'b_w_uq': b_w_uq, 'b_w_out': b_w_out,
            'kv_w_dkv': kv_w_dkv, 'kv_g': kv_g, 'kv_w_ukv': kv_w_ukv,
            'mem_w_kv': mem_w_kv, 'ln_g': ln_g, 'ln_b': ln_b,
            'moe_w_r': moe_w_r, 'moe_b_r': moe_b_r, 'moe_w_gu': moe_w_gu, 'moe_b_gu': moe_b_gu,
            'moe_w_dn': moe_w_dn, 'moe_b_dn': moe_b_dn}


def reference(x, mem, positions, a_w_in, a_b_f, a_w_out, b_w_in, b_g_q, b_w_uq, b_w_out,
              kv_w_dkv, kv_g, kv_w_ukv, mem_w_kv, ln_g, ln_b,
              moe_w_r, moe_b_r, moe_w_gu, moe_b_gu, moe_w_dn, moe_b_dn):
    shared_k = None
    shared_v = None
    for l in range(DEPTH):
        if l < N_A_LAYERS:
            mix = fox_mixer(x, mem, a_w_in[l], a_b_f[l], a_w_out[l], mem_w_kv[l])
        else:
            if shared_k is None:
                shared_k, shared_v = shared_mla_kv(x, positions, kv_w_dkv, kv_g, kv_w_ukv)
            b = l - N_A_LAYERS
            mix = mla_mixer(x, mem, positions, shared_k, shared_v,
                            b_w_in[b], b_g_q[b], b_w_uq[b], b_w_out[b], mem_w_kv[l])
        x = layer_norm(DEEPNORM_ALPHA * x + mix, ln_g[l, 0], ln_b[l, 0])
        ffn = moe_ffn(x, moe_w_r[l], moe_b_r[l], moe_w_gu[l], moe_b_gu[l], moe_w_dn[l], moe_b_dn[l])
        x = layer_norm(DEEPNORM_ALPHA * x + ffn, ln_g[l, 1], ln_b[l, 1])
    return x
```

```cpp
#include <hip/hip_runtime.h>
#include <hip/hip_cooperative_groups.h>
#include <cstdio>
#include <cstdint>
#include <cmath>
namespace cg = cooperative_groups;

#define DI __device__ __forceinline__
#define LAS __attribute__((address_space(3)))
typedef unsigned short bf16_t;
typedef short bf16x8 __attribute__((ext_vector_type(8)));
typedef float f32x4 __attribute__((ext_vector_type(4)));
typedef float f32x2 __attribute__((ext_vector_type(2)));
typedef float f32x16 __attribute__((ext_vector_type(16)));
typedef unsigned u32x4 __attribute__((ext_vector_type(4)));
typedef unsigned u32x2 __attribute__((ext_vector_type(2)));
typedef __bf16 bf16x2_t __attribute__((ext_vector_type(2)));

constexpr int NB = 2, SEQ = 8192, T = NB * SEQ, DM = 1024;
constexpr int NH = 12, NMEM = 256;
constexpr int FOX_IN = 2572;
constexpr int NE = 32;
constexpr float LOG2E = 1.4426950408889634f;
constexpr float ALPHA = 1.4142135623730951f;
constexpr float LN_EPS = 1e-5f, RMS_EPS = 1e-6f;
constexpr int NTHREADS = 512;
constexpr int LDS_BYTES = 131072 + 4096;
constexpr int LDS_CTL = 131072;
constexpr int SLOT_ROWS = 65536 + NE * 256;

constexpr size_t al256(size_t x) { return (x + 255) & ~(size_t)255; }
constexpr size_t WS_CTL = 0, CTL_BYTES = 65536;
constexpr size_t WS_W_AIN = al256(WS_CTL + CTL_BYTES);
constexpr size_t WS_W_AOUT = al256(WS_W_AIN + (size_t)2560 * 1024 * 2);
constexpr size_t WS_W_BIN = al256(WS_W_AOUT + (size_t)1024 * 1024 * 2);
constexpr size_t WS_W_UQ = al256(WS_W_BIN + (size_t)1024 * 1024 * 2);
constexpr size_t WS_W_UKV = al256(WS_W_UQ + (size_t)1280 * 384 * 2);
constexpr size_t WS_W_BOUT = al256(WS_W_UKV + (size_t)1536 * 256 * 2);
constexpr size_t WS_W_MKV = al256(WS_W_BOUT + (size_t)1024 * 1024 * 2);
constexpr size_t WS_W_GU = al256(WS_W_MKV + (size_t)2 * 512 * 1024 * 2);
constexpr size_t WS_W_DN = al256(WS_W_GU + (size_t)2 * 32 * 2048 * 1024 * 2);
constexpr size_t WS_XB = al256(WS_W_DN + (size_t)2 * 32 * 1024 * 1024 * 2);
constexpr size_t WS_MEMB = al256(WS_XB + (size_t)T * 1024 * 2);
constexpr size_t WS_LOGF = al256(WS_MEMB + (size_t)512 * 1024 * 2);
constexpr size_t WS_CUM = al256(WS_LOGF + (size_t)24 * 8192 * 4);
constexpr size_t WS_Q = al256(WS_CUM + (size_t)24 * 8192 * 4);
constexpr size_t WS_K = al256(WS_Q + (size_t)T * 1152 * 2);
constexpr size_t WS_VT = al256(WS_K + (size_t)T * 1152 * 2);
constexpr size_t WS_MQ = al256(WS_VT + (size_t)1536 * 8192 * 2);
constexpr size_t WS_MK = al256(WS_MQ + (size_t)T * 256 * 2);
constexpr size_t WS_MVT = al256(WS_MK + (size_t)2 * 512 * 256 * 2);
constexpr size_t WS_MERGED = al256(WS_MVT + (size_t)2 * 2 * 256 * 256 * 2);
constexpr size_t WS_Y = al256(WS_MERGED + (size_t)T * 1024 * 2);
constexpr size_t WS_X1 = al256(WS_Y + (size_t)T * 1024 * 4);
constexpr size_t WS_X1B = al256(WS_X1 + (size_t)T * 1024 * 4);
constexpr size_t WS_PE = al256(WS_X1B + (size_t)T * 1024 * 2);
constexpr size_t WS_PPOS = al256(WS_PE + (size_t)T * 4 * 4);
constexpr size_t WS_GATE = al256(WS_PPOS + (size_t)T * 4 * 4);
constexpr size_t WS_TOKOF = al256(WS_GATE + (size_t)T * 4 * 4);
constexpr size_t WS_H = al256(WS_TOKOF + (size_t)NE * T * 4);
constexpr size_t WS_YE = al256(WS_H + (size_t)SLOT_ROWS * 1024 * 2);
constexpr size_t WS_LAT = al256(WS_YE + (size_t)SLOT_ROWS * 1024 * 2);
constexpr size_t WS_CKV = al256(WS_LAT + (size_t)T * 1024 * 4);
constexpr size_t WS_CQ = al256(WS_CKV + (size_t)T * 256 * 2);
constexpr size_t WS_X2 = al256(WS_CQ + (size_t)T * 384 * 2);
constexpr size_t WS_KN2 = al256(WS_X2 + (size_t)T * 1024 * 4);
constexpr size_t WS_WRT = al256(WS_KN2 + (size_t)24 * 128 * 4);
constexpr size_t WS_END = al256(WS_WRT + (size_t)2 * 32 * 1024 * 4);
constexpr int CW_CNT = 8192;
constexpr int CW_WORK = 256;
constexpr int CW_BAR = 4096;

struct Params {
    const float* x; const float* mem; const int* pos;
    const float *a_w_in, *a_b_f, *a_w_out, *b_w_in, *b_g_q, *b_w_uq, *b_w_out, *kv_w_dkv, *kv_g, *kv_w_ukv, *mem_w_kv, *ln_g, *ln_b;
    const float *moe_w_r, *moe_b_r, *moe_w_gu, *moe_b_gu, *moe_w_dn, *moe_b_dn;
    float* out; unsigned char* ws; int ph_lo, ph_hi; int use_grid_sync, pad;
};

#define KP ((const __attribute__((address_space(4))) Params*)__builtin_amdgcn_kernarg_segment_ptr())
DI unsigned cvtpk(float lo, float hi) { f32x2 v = {lo, hi}; bf16x2_t b = __builtin_convertvector(v, bf16x2_t); return __builtin_bit_cast(unsigned, b); }
DI float bf2f(unsigned short b) { return __uint_as_float(((unsigned)b) << 16); }
DI float wave_sum(float v) {
#pragma unroll
    for (int o = 1; o < 64; o <<= 1) v += __shfl_xor(v, o);
    return v;
}
DI float wave_max(float v) {
#pragma unroll
    for (int o = 1; o < 64; o <<= 1) v = fmaxf(v, __shfl_xor(v, o));
    return v;
}

DI void sincos_cw(float x, float& sn, float& cs) {
    int j = (int)(x * 1.27323954473516f); j = (j + 1) & ~1;
    const float y = (float)j;
    const float r = ((x - y * 0.78515625f) - y * 2.4187564849853515625e-4f) - y * 3.77489497744594108e-8f;
    const float z = r * r;
    const float sp = ((-1.9515295891e-4f * z + 8.3321608736e-3f) * z - 1.6666654611e-1f) * z * r + r;
    const float cp = ((2.443315711809948e-5f * z - 1.388731625493765e-3f) * z + 4.166664568298827e-2f) * z * z - 0.5f * z + 1.0f;
    const int q = (j >> 1) & 3;
    const float s0 = (q & 1) ? cp : sp, c0 = (q & 1) ? sp : cp;
    sn = (q & 2) ? -s0 : s0;
    cs = ((q + 1) & 2) ? -c0 : c0;
}
DI float fadd_s(float a, float b) { float r; asm("v_add_f32_e32 %0, %1, %2" : "=v"(r) : "v"(a), "v"(b)); return r; }
DI int vlane() { int l; asm volatile("v_mbcnt_lo_u32_b32 %0, -1, 0\n\tv_mbcnt_hi_u32_b32 %0, -1, %0" : "=v"(l)); return l; }
#define LDS_WAIT() asm volatile("s_waitcnt lgkmcnt(0)" ::: "memory")
#define VM_WAIT() asm volatile("s_waitcnt vmcnt(0)" ::: "memory")

#ifndef GEMM_TOKPF
#define GEMM_TOKPF 2
#endif
namespace pg8 {
constexpr int BM = 256, BK = 64, HALF = 128, HTB = HALF * BK * 2, STAGE_BYTES = 8 * HTB, NXCD = 8, WGM = 8;
DI int lds_byte(int r, int c) { const int st = (r >> 4) * 2 + (c >> 5), rr = r & 15, cc = c & 31, ob = rr * 64 + cc * 2; return st * 1024 + (ob ^ (((ob >> 9) & 1) << 5)); }
DI void stage_rc(int b, int& R, int& C) { const int st = b / 1024, sb = b % 1024, swz = sb ^ (((sb >> 9) & 1) << 5); R = (st >> 1) * 16 + swz / 64; C = (st & 1) * 32 + (swz % 64) / 2; }
DI int perm32(int rho) { const int n = rho >> 4, i = rho & 15; return 8 * (i >> 2) + 4 * n + (i & 3); }
struct Unit { int pm, pn; };
struct Gemm { const bf16_t* A; const bf16_t* Bt; int K; };
struct StaticOrder {
    int nM, nN, nwg, G, c, K2;
    DI void init(int M, int N, int K, int G_, int c_) { nM = M / BM; nN = N / BM; nwg = nM * nN; G = G_; c = c_; K2 = K * 2; }
    DI bool next(int i, Unit& u) const {
        const long L = (long)i * G + c; if (L >= nwg) return false;
        int wgid = (int)L; { const int q = nwg / NXCD, r = nwg % NXCD, xcd = wgid % NXCD, off = wgid / NXCD; wgid = (xcd < r ? xcd * (q + 1) : r * (q + 1) + (xcd - r) * q) + off; }
        const int nig = WGM * nN, gid = wgid / nig, fm = gid * WGM, gsz = (nM - fm) < WGM ? (nM - fm) : WGM;
        u.pm = fm + ((wgid % nig) % gsz); u.pn = (wgid % nig) / gsz; return true;
    }
    DI unsigned a_off(const Unit& u, int r) const { return (unsigned)(u.pm * BM + r) * (unsigned)K2; }
    DI unsigned a_off_pf(const Unit& u, int r, int) const { return a_off(u, r); }
    DI void prefetch(const Unit&, int, int, int) const {}
    DI void a_ready(const Unit&) const {}
    DI void done(const Unit&) const {}
};

template <class Epi, class Sched, bool ALIGN_EPI>
DI void gemm_phase(LAS unsigned char* lds, const Gemm g, const Sched& S, const Epi& E, const int wid) {
    const int lane = vlane(), tid = wid * 64 + lane, wr = wid >> 2, wc = wid & 3, fr = lane & 15, fq = lane >> 4;
    const int K = g.K, nt = K / BK;
    int RA[2]; unsigned cA2[2], voffB[2];
#pragma unroll
    for (int i = 0; i < 2; ++i) { int R, C; stage_rc(tid * 16 + i * 8192, R, C); const int Rb = Epi::PERM ? ((R & ~31) + perm32(R & 31)) : R;
        RA[i] = R; cA2[i] = (unsigned)C * 2u; voffB[i] = (unsigned)(Rb * K + C) * 2u; }
    const size_t kstep = (size_t)(BK * 2);
    const size_t hstep = (size_t)HALF * K * 2;
    const size_t tstep = 2 * hstep;
    const unsigned ldsw = (unsigned)wid * 1024u;
    const int aoff = lds_byte(wr * 64 + fr, fq * 8), boff = lds_byte(wc * 32 + fr, fq * 8);
#define PG8_SA(b, h) (((b) * 2 + (h)) * HTB)
#define PG8_SB(b, h) ((4 + (b) * 2 + (h)) * HTB)
#define PG8_STAGE_B(bufoff, gbase) do { _Pragma("unroll") for (int _i = 0; _i < 2; ++_i) \
        __builtin_amdgcn_global_load_lds((const unsigned*)((const char*)(gbase) + voffB[_i]), (LAS unsigned*)(lds + (bufoff) + ldsw + _i * 8192), 16, 0, 0); } while (0)
#define PG8_STAGE_A(bufoff, kbytes, uo) do { _Pragma("unroll") for (int _i = 0; _i < 2; ++_i) \
        __builtin_amdgcn_global_load_lds((const unsigned*)((const char*)g.A + (kbytes) + (uo)[_i]), (LAS unsigned*)(lds + (bufoff) + ldsw + _i * 8192), 16, 0, 0); } while (0)
#define PG8_STAGE_A2(bufoff, kbytes, h) do { _Pragma("unroll") for (int _i = 0; _i < 2; ++_i) \
        __builtin_amdgcn_global_load_lds((const unsigned*)((const char*)g.A + (kbytes) + (last ? uN[h][_i] : uC[h][_i])), (LAS unsigned*)(lds + (bufoff) + ldsw + _i * 8192), 16, 0, 0); } while (0)
#define PG8_LDA(dst, b, h) do { _Pragma("unroll") for (int m = 0; m < 4; ++m) _Pragma("unroll") for (int k = 0; k < 2; ++k) dst[m][k] = *(const LAS bf16x8*)(lds + PG8_SA(b, h) + aoff + m * 2048 + k * 1024); } while (0)
#define PG8_LDB(dst, b, h) do { _Pragma("unroll") for (int n = 0; n < 2; ++n) _Pragma("unroll") for (int k = 0; k < 2; ++k) dst[n][k] = *(const LAS bf16x8*)(lds + PG8_SB(b, h) + boff + n * 2048 + k * 1024); } while (0)
#define PG8_MMA(ai, bj, At, Bt) do { __builtin_amdgcn_s_setprio(1); _Pragma("unroll") for (int m = 0; m < 4; ++m) _Pragma("unroll") for (int n = 0; n < 2; ++n) _Pragma("unroll") for (int k = 0; k < 2; ++k) \
        acc[ai][bj][m][n] = __builtin_amdgcn_mfma_f32_16x16x32_bf16(Bt[n][k], At[m][k], acc[ai][bj][m][n], 0, 0, 0); __builtin_amdgcn_s_setprio(0); } while (0)
#define PG8_WAIT_V(n) asm volatile("s_waitcnt vmcnt(" #n ")" ::: "memory")
#define PG8_WAIT_L(n) asm volatile("s_waitcnt lgkmcnt(" #n ")" ::: "memory")
#define PG8_BAR __builtin_amdgcn_s_barrier()
#define PG8_SCHED __builtin_amdgcn_sched_barrier(0)
    Unit cur, nxt; int ui = 0;
    if (!S.next(0, cur)) return;
    f32x4 acc[2][2][4][2];
#pragma unroll
    for (int a = 0; a < 2; ++a)
#pragma unroll
        for (int b = 0; b < 2; ++b)
#pragma unroll
            for (int m = 0; m < 4; ++m)
#pragma unroll
                for (int n = 0; n < 2; ++n) acc[a][b][m][n] = (f32x4){0.f, 0.f, 0.f, 0.f};
    bf16x8 At[4][2], B0[2][2], B1[2][2];
    unsigned uC[2][2], uN[2][2];
#pragma unroll
    for (int h = 0; h < 2; ++h)
#pragma unroll
        for (int i = 0; i < 2; ++i) uC[h][i] = S.a_off(cur, h * HALF + RA[i]) + cA2[i];
    const char* cB = (const char*)g.Bt + (size_t)cur.pn * tstep;
    S.a_ready(cur);
    PG8_STAGE_B(PG8_SB(0, 0), cB); PG8_STAGE_B(PG8_SB(0, 1), cB + hstep); PG8_STAGE_A(PG8_SA(0, 0), 0, uC[0]); PG8_STAGE_A(PG8_SA(0, 1), 0, uC[1]);
    if (wr == 1) PG8_BAR;
    PG8_WAIT_V(2); PG8_BAR;
    PG8_STAGE_B(PG8_SB(1, 0), cB + kstep); PG8_STAGE_A(PG8_SA(1, 0), kstep, uC[0]); PG8_STAGE_B(PG8_SB(1, 1), cB + hstep + kstep);
    PG8_WAIT_V(6); PG8_BAR;
    for (;;) {
        const bool has_next = S.next(ui + 1, nxt);
        const char* nB = has_next ? (const char*)g.Bt + (size_t)nxt.pn * tstep : cB;
#if GEMM_TOKPF == 1
        if (has_next) S.prefetch(nxt, (ui + 1) & 1, wid, lane);
#elif GEMM_TOKPF == 2
        {
            Unit nx2; const bool has2 = S.next(ui + 2, nx2);
#pragma unroll
            for (int h = 0; h < 2; ++h)
#pragma unroll
                for (int i = 0; i < 2; ++i) uN[h][i] = has_next ? ((ui == 0 ? S.a_off(nxt, h * HALF + RA[i]) : S.a_off_pf(nxt, h * HALF + RA[i], (ui + 1) & 1)) + cA2[i]) : uC[h][i];
            if (has2) S.prefetch(nx2, ui & 1, wid, lane);
        }
#else
#pragma unroll
        for (int h = 0; h < 2; ++h)
#pragma unroll
            for (int i = 0; i < 2; ++i) uN[h][i] = has_next ? (S.a_off(nxt, h * HALF + RA[i]) + cA2[i]) : uC[h][i];
#endif
#pragma nounroll
        for (int t = 0; t < nt; t += 2) {
            const bool last = (t == nt - 2);
            const size_t ka1 = (size_t)(t + 1) * kstep;
            const size_t ka2 = last ? (size_t)0 : (size_t)(t + 2) * kstep, ka3 = ka2 + kstep;
            const char* b2 = last ? nB : cB + (size_t)(t + 2) * kstep; const char* b3 = b2 + kstep;
#if GEMM_TOKPF == 1
            if (last) {
                if (has_next) S.a_ready(nxt);
#pragma unroll
                for (int h = 0; h < 2; ++h)
#pragma unroll
                    for (int i = 0; i < 2; ++i) uN[h][i] = has_next ? (S.a_off_pf(nxt, h * HALF + RA[i], (ui + 1) & 1) + cA2[i]) : uC[h][i];
            }
#endif
            PG8_LDB(B0, 0, 0); PG8_LDB(B1, 0, 1); PG8_SCHED; PG8_LDA(At, 0, 0); PG8_STAGE_A(PG8_SA(1, 1), ka1, uC[1]);
            PG8_WAIT_V(8); PG8_WAIT_L(0); PG8_BAR; PG8_MMA(0, 0, At, B0); PG8_MMA(0, 1, At, B1); PG8_BAR; PG8_SCHED;
            PG8_LDA(At, 0, 1); PG8_STAGE_B(PG8_SB(0, 0), b2); PG8_STAGE_B(PG8_SB(0, 1), b2 + hstep); PG8_STAGE_A2(PG8_SA(0, 0), ka2, 0);
            PG8_WAIT_V(8); PG8_WAIT_L(0); PG8_BAR; PG8_MMA(1, 0, At, B0); PG8_MMA(1, 1, At, B1); PG8_BAR; PG8_SCHED;
            PG8_LDB(B0, 1, 0); PG8_LDB(B1, 1, 1); PG8_SCHED; PG8_LDA(At, 1, 0); PG8_STAGE_A2(PG8_SA(0, 1), ka2, 1);
            PG8_WAIT_V(8); PG8_WAIT_L(0); PG8_BAR; PG8_MMA(0, 0, At, B0); PG8_MMA(0, 1, At, B1); PG8_BAR; PG8_SCHED;
            PG8_LDA(At, 1, 1); PG8_STAGE_B(PG8_SB(1, 0), b3); PG8_STAGE_B(PG8_SB(1, 1), b3 + hstep); PG8_STAGE_A2(PG8_SA(1, 0), ka3, 0);
            PG8_WAIT_V(8); PG8_WAIT_L(0); PG8_BAR; PG8_MMA(1, 0, At, B0); PG8_MMA(1, 1, At, B1); PG8_BAR; PG8_SCHED;
        }
        if constexpr (ALIGN_EPI) { if (wr == 0) PG8_BAR; }
        E(acc, cur, wr, wc, fr, fq); S.done(cur);
        if (!has_next) break;
#pragma unroll
        for (int a = 0; a < 2; ++a)
#pragma unroll
            for (int b = 0; b < 2; ++b)
#pragma unroll
                for (int m = 0; m < 4; ++m)
#pragma unroll
                    for (int n = 0; n < 2; ++n) acc[a][b][m][n] = (f32x4){0.f, 0.f, 0.f, 0.f};
        cur = nxt; cB = nB; ++ui;
#pragma unroll
        for (int h = 0; h < 2; ++h)
#pragma unroll
            for (int i = 0; i < 2; ++i) uC[h][i] = uN[h][i];
        if constexpr (ALIGN_EPI) { if (wr == 1) PG8_BAR; }
    }
    PG8_WAIT_V(0);
    if constexpr (!ALIGN_EPI) { if (wr == 0) PG8_BAR; }
    PG8_BAR;
#undef PG8_SA
#undef PG8_SB
#undef PG8_STAGE_A
#undef PG8_STAGE_A2
#undef PG8_STAGE_B
#undef PG8_LDA
#undef PG8_LDB
#undef PG8_MMA
#undef PG8_WAIT_V
#undef PG8_WAIT_L
#undef PG8_BAR
#undef PG8_SCHED
}
}

struct Dst { bf16_t* O; int ldo, row0, col0, nvalid; float scale; bool headmap; };
template <class Route> struct EpiBf16R {
    static constexpr bool PERM = true;
    Route R;
    DI void operator()(const f32x4 (&acc)[2][2][4][2], const pg8::Unit& u, int wr, int wc, int fr, int fq) const {
        const Dst d = R(u);
#pragma unroll
        for (int ai = 0; ai < 2; ++ai)
#pragma unroll
            for (int m = 0; m < 4; ++m) {
                bf16_t* rowp = d.O + (size_t)(d.row0 + ai * 128 + wr * 64 + m * 16 + fr) * d.ldo + d.col0;
#pragma unroll
                for (int bj = 0; bj < 2; ++bj) {
                    const int c = bj * 128 + wc * 32 + 8 * fq;
                    if (c < d.nvalid) {
                        const f32x4 v0 = acc[ai][bj][m][0] * d.scale, v1 = acc[ai][bj][m][1] * d.scale;
                        u32x4 w; w.x = cvtpk(v0[0], v0[1]); w.y = cvtpk(v0[2], v0[3]); w.z = cvtpk(v1[0], v1[1]); w.w = cvtpk(v1[2], v1[3]);
                        const int oc = d.headmap ? ((c >> 6) * 96 + (c & 63)) : c;
                        *(u32x4*)(rowp + oc) = w;
                    }
                }
            }
    }
};
struct EpiResF32 {
    static constexpr bool PERM = false;
    float* Y; const float* X;
    DI void operator()(const f32x4 (&acc)[2][2][4][2], const pg8::Unit& u, int wr, int wc, int fr, int fq) const {
#pragma unroll
        for (int ai = 0; ai < 2; ++ai)
#pragma unroll
            for (int m = 0; m < 4; ++m) {
                const size_t ro = (size_t)(u.pm * 256 + ai * 128 + wr * 64 + m * 16 + fr) * DM + u.pn * 256 + wc * 32 + 4 * fq;
#pragma unroll
                for (int bj = 0; bj < 2; ++bj)
#pragma unroll
                    for (int n = 0; n < 2; ++n) {
                        const f32x4 xv = *(const f32x4*)(X + ro + bj * 128 + n * 16);
                        *(f32x4*)(Y + ro + bj * 128 + n * 16) = xv * ALPHA + acc[ai][bj][m][n];
                    }
            }
    }
};
struct EpiLat {
    static constexpr bool PERM = false;
    float* O; int ncol;
    DI void operator()(const f32x4 (&acc)[2][2][4][2], const pg8::Unit& u, int wr, int wc, int fr, int fq) const {
#pragma unroll
        for (int ai = 0; ai < 2; ++ai)
#pragma unroll
            for (int m = 0; m < 4; ++m) {
                const int c0 = u.pn * 256 + wc * 32 + 4 * fq;
                float* rowp = O + (size_t)(u.pm * 256 + ai * 128 + wr * 64 + m * 16 + fr) * 1024;
#pragma unroll
                for (int bj = 0; bj < 2; ++bj)
#pragma unroll
                    for (int n = 0; n < 2; ++n) { const int c = c0 + bj * 128 + n * 16; if (c < ncol) *(f32x4*)(rowp + c) = acc[ai][bj][m][n]; }
            }
    }
};
struct EpiGU {
    static constexpr bool PERM = true;
    bf16_t* H; const float* bias;
    DI void operator()(const f32x4 (&acc)[2][2][4][2], const pg8::Unit& u, int wr, int wc, int fr, int fq) const {
        const int e = u.pn >> 3, ct = u.pn & 7;
        const int j = ct * 128 + wc * 32 + 8 * fq;
        const float* be = bias + (size_t)e * 2048;
        f32x4 bg[2], bu[2];
#pragma unroll
        for (int n = 0; n < 2; ++n) { bg[n] = *(const f32x4*)(be + j + 4 * n); bu[n] = *(const f32x4*)(be + 1024 + j + 4 * n); }
#pragma unroll
        for (int ai = 0; ai < 2; ++ai)
#pragma unroll
            for (int m = 0; m < 4; ++m) {
                float h[8];
#pragma unroll
                for (int n = 0; n < 2; ++n)
#pragma unroll
                    for (int i = 0; i < 4; ++i) {
                        const float gg = fminf(acc[ai][0][m][n][i] + bg[n][i], 7.0f);
                        const float uu = fminf(fmaxf(acc[ai][1][m][n][i] + bu[n][i], -7.0f), 7.0f);
                        const float sg = __builtin_amdgcn_rcpf(1.0f + __builtin_amdgcn_exp2f(-1.702f * LOG2E * gg));
                        h[4 * n + i] = (uu + 1.0f) * (gg * sg);
                    }
                u32x4 w; w.x = cvtpk(h[0], h[1]); w.y = cvtpk(h[2], h[3]); w.z = cvtpk(h[4], h[5]); w.w = cvtpk(h[6], h[7]);
                *(u32x4*)(H + (size_t)(u.pm * 256 + ai * 128 + wr * 64 + m * 16 + fr) * 1024 + j) = w;
            }
    }
};
struct EpiDN {
    static constexpr bool PERM = true;
    bf16_t* Y; const float* bias;
    DI void operator()(const f32x4 (&acc)[2][2][4][2], const pg8::Unit& u, int wr, int wc, int fr, int fq) const {
        const int e = u.pn >> 2, ct = u.pn & 3;
        const float* be = bias + (size_t)e * 1024;
#pragma unroll
        for (int bj = 0; bj < 2; ++bj) {
            const int c = ct * 256 + bj * 128 + wc * 32 + 8 * fq;
            const f32x4 b0 = *(const f32x4*)(be + c), b1 = *(const f32x4*)(be + c + 4);
#pragma unroll
            for (int ai = 0; ai < 2; ++ai)
#pragma unroll
                for (int m = 0; m < 4; ++m) {
                    const f32x4 v0 = acc[ai][bj][m][0] + b0, v1 = acc[ai][bj][m][1] + b1;
                    u32x4 w; w.x = cvtpk(v0[0], v0[1]); w.y = cvtpk(v0[2], v0[3]); w.z = cvtpk(v1[0], v1[1]); w.w = cvtpk(v1[2], v1[3]);
                    *(u32x4*)(Y + (size_t)(u.pm * 256 + ai * 128 + wr * 64 + m * 16 + fr) * 1024 + c) = w;
                }
        }
    }
};
struct Frame {
    LAS unsigned char* lds; unsigned* ctl; unsigned char* ws; int tid, lane, wid; int G, bid;
};
struct MoeOrder {
    const LAS int* tstart; int sh; bool gather; const int* tokof; const LAS int* tokbuf; const LAS int* ulist;
    static DI void build(Frame& F, const LAS int* tstart, int nNt, LAS int* ulist) {
        __syncthreads();
        const int nwg = tstart[32] * nNt;
        if (F.tid == 0) ulist[0] = 0;
        __syncthreads();
        if (F.tid < 24) {
            const long L = (long)F.tid * F.G + F.bid;
            if (L < nwg) {
                int wgid = (int)L; { const int q = nwg / 8, r = nwg % 8, xcd = wgid % 8, off = wgid / 8; wgid = (xcd < r ? xcd * (q + 1) : r * (q + 1) + (xcd - r) * q) + off; }
                int e = 0;
                for (int k = 1; k < 32; ++k) if (tstart[k] * nNt <= wgid) e = k;
                const int rem = wgid - tstart[e] * nNt, nte = tstart[e + 1] - tstart[e];
                const int ct = rem / nte, rt = rem % nte;
                ulist[4 + 4 * F.tid] = tstart[e] + rt; ulist[5 + 4 * F.tid] = e * nNt + ct; ulist[6 + 4 * F.tid] = e; ulist[7 + 4 * F.tid] = rt;
                __hip_atomic_fetch_add(ulist, 1, __ATOMIC_RELAXED, __HIP_MEMORY_SCOPE_WORKGROUP);
            }
        }
        __syncthreads();
    }
    DI bool next(int i, pg8::Unit& u) const {
        if (i >= ulist[0]) return false;
        u.pm = ulist[4 + 4 * i]; u.pn = ulist[5 + 4 * i]; return true;
    }
    DI unsigned a_off(const pg8::Unit& u, int r) const {
        if (!gather) return (unsigned)(u.pm * 256 + r) * 2048u;
        const int e = u.pn >> sh, idx = (u.pm - tstart[e]) * 256 + r;
        const int t = idx < tstart[80 + e] ? tokof[(size_t)e * T + idx] : 0;
        return (unsigned)t * 2048u;
    }
    DI void prefetch(const pg8::Unit& u, int slot, int wid, int lane) const {
        if (gather && wid == 0) {
            const int e = u.pn >> sh, rt = u.pm - tstart[e];
            __builtin_amdgcn_global_load_lds((const unsigned*)(tokof + (size_t)e * T + rt * 256 + vlane() * 4), (LAS unsigned*)((LAS unsigned char*)tokbuf + slot * 1024), 16, 0, 0);
        }
    }
    DI unsigned a_off_pf(const pg8::Unit& u, int r, int slot) const {
        if (!gather) return (unsigned)(u.pm * 256 + r) * 2048u;
        const int e = u.pn >> sh, idx = (u.pm - tstart[e]) * 256 + r;
        const int t = idx < tstart[80 + e] ? tokbuf[slot * 256 + r] : 0;
        return (unsigned)t * 2048u;
    }
    DI void a_ready(const pg8::Unit&) const {}
    DI void done(const pg8::Unit&) const {}
};

DI int crow(int r, int hi) { return (r & 3) + 8 * (r >> 2) + 4 * hi; }
template <int DK, bool FOX, bool ROPEQ>
DI void attn_unit(LAS unsigned char* lds, const bf16_t* Q, int ldq, const bf16_t* Kp, int ldk, const bf16_t* Vt, int ldv,
                  const float* cum, bf16_t* O, int ldo, int q0, int ntiles, bool causal, const int* pos, const int wid, const float* kn2 = nullptr) {
    constexpr int PK = DK * 2 + 16, KBYTES = 64 * PK, VBYTES = 64 * 136, BUF = KBYTES + VBYTES + 256, KCH = DK / 8, NS = DK / 16;
    const int lane = vlane(), tid = wid * 64 + lane, r32 = lane & 31, hi = lane >> 5;
    const int qw0 = q0 + wid * 32, qrow = qw0 + r32;
    bf16x8 qf[NS];
#pragma unroll
    for (int s = 0; s < NS; ++s) qf[s] = *(const bf16x8*)(Q + (size_t)qrow * ldq + 16 * s + 8 * hi);
    if constexpr (ROPEQ) {
        const float p = (float)pos[qrow];
#pragma unroll
        for (int j = 0; j < 8; ++j) {
            const int i = 8 * hi + j;
            const float inv = exp2f(-(float)i * (13.287712379549449f / 16.0f));
            float sn, cs; sincos_cw(p * inv, sn, cs);
            const float x1 = bf2f((unsigned short)qf[4][j]), x2 = bf2f((unsigned short)qf[5][j]);
            const float o1 = x1 * cs - x2 * sn, o2 = x1 * sn + x2 * cs;
            qf[4][j] = (short)(cvtpk(o1, 0.f) & 0xffffu); qf[5][j] = (short)(cvtpk(o2, 0.f) & 0xffffu);
        }
    }
    const float cq = FOX ? cum[qrow] : 0.f;
    int jstart = 0; float prune_c = 0.f;
    if constexpr (FOX) {
        LAS float* red = (LAS float*)(lds + 2 * BUF);
        float ss = 0.f;
#pragma unroll
        for (int s = 0; s < NS; ++s)
#pragma unroll
            for (int j = 0; j < 8; ++j) { const float v = bf2f((unsigned short)qf[s][j]); ss += v * v; }
        ss += __shfl_xor(ss, 32);
        ss = wave_max(ss);
        float kk = 0.f;
        for (int j = tid; j < ntiles; j += NTHREADS) kk = fmaxf(kk, kn2[j]);
        kk = wave_max(kk);
        __syncthreads();
        if (lane == 0) { red[wid] = ss; red[8 + wid] = kk; }
        __syncthreads();
        float qm = red[0], km = red[8];
#pragma unroll
        for (int w = 1; w < 8; ++w) { qm = fmaxf(qm, red[w]); km = fmaxf(km, red[8 + w]); }
        prune_c = 2.0f * sqrtf(qm * km) * 1.01f + 65.0f;
        const float cq0 = cum[q0];
        int cand = ntiles;
        for (int j = tid; j < ntiles; j += NTHREADS) if (cq0 - cum[64 * j + 63] + prune_c >= 0.f) cand = min(cand, j);
#pragma unroll
        for (int o = 1; o < 64; o <<= 1) cand = min(cand, __shfl_xor(cand, o));
        __syncthreads();
        if (lane == 0) ((LAS int*)red)[16 + wid] = cand;
        __syncthreads();
        jstart = ((LAS int*)red)[16];
#pragma unroll
        for (int w = 1; w < 8; ++w) jstart = min(jstart, ((LAS int*)red)[16 + w]);
        jstart = min(jstart, ntiles - 4);
        __syncthreads();
    }
    const float cqw0 = FOX ? __shfl(cq, 0) : 0.f;
    f32x16 o0, o1;
#pragma unroll
    for (int r = 0; r < 16; ++r) { o0[r] = 0.f; o1[r] = 0.f; }
    float mrun = -1e30f, lrun = 0.f;
    const int kr0 = tid / KCH, kc0 = tid % KCH;
    const int kr1 = (tid + 512) / KCH, kc1 = (tid + 512) % KCH;
    const bool k2 = (DK == 96) && (tid < 256);
    const int vd = tid >> 3, vc = tid & 7;
    u32x4 kreg0, kreg1 = (u32x4){0, 0, 0, 0}, vreg; float creg = 0.f;
#define ATT_GLOAD(j) do { \
        kreg0 = *(const u32x4*)(Kp + (size_t)(64 * (j) + kr0) * ldk + kc0 * 8); \
        if (k2) kreg1 = *(const u32x4*)(Kp + (size_t)(64 * (j) + kr1) * ldk + kc1 * 8); \
        vreg = *(const u32x4*)(Vt + (size_t)vd * ldv + 64 * (j) + vc * 8); \
        if (FOX && tid < 64) creg = cum[64 * (j) + tid]; } while (0)
#define ATT_LWRITE(buf) do { LAS unsigned char* bb_ = lds + (buf) * BUF; \
        *(LAS u32x4*)(bb_ + kr0 * PK + kc0 * 16) = kreg0; \
        if (k2) *(LAS u32x4*)(bb_ + kr1 * PK + kc1 * 16) = kreg1; \
        *(LAS u32x2*)(bb_ + KBYTES + vd * 136 + vc * 16) = (u32x2){vreg.x, vreg.y}; \
        *(LAS u32x2*)(bb_ + KBYTES + vd * 136 + vc * 16 + 8) = (u32x2){vreg.z, vreg.w}; \
        if (FOX && tid < 64) *(LAS float*)(bb_ + KBYTES + VBYTES + tid * 4) = creg; } while (0)
    ATT_GLOAD(jstart); ATT_LWRITE(0); __syncthreads();
    for (int j = jstart; j < ntiles; ++j) {
        const int cur = (j - jstart) & 1;
        if (j + 1 < ntiles) ATT_GLOAD(j + 1);
        const LAS unsigned char* kb = lds + cur * BUF; const LAS unsigned char* vb = kb + KBYTES; const LAS unsigned char* cb = vb + VBYTES;
        bool active = !causal || (64 * j <= qw0 + 31);
        if constexpr (FOX) { if (cqw0 - *(const LAS float*)(cb + 63 * 4) + prune_c < 0.f) active = false; }
        if (active) {
            f32x16 sp0, sp1;
#pragma unroll
            for (int r = 0; r < 16; ++r) { sp0[r] = 0.f; sp1[r] = 0.f; }
#pragma unroll
            for (int s = 0; s < NS; ++s) {
                const bf16x8 k0 = *(const LAS bf16x8*)(kb + r32 * PK + 32 * s + 16 * hi);
                const bf16x8 k1 = *(const LAS bf16x8*)(kb + (32 + r32) * PK + 32 * s + 16 * hi);
                sp0 = __builtin_amdgcn_mfma_f32_32x32x16_bf16(k0, qf[s], sp0, 0, 0, 0);
                sp1 = __builtin_amdgcn_mfma_f32_32x32x16_bf16(k1, qf[s], sp1, 0, 0, 0);
            }
            __builtin_amdgcn_sched_barrier(0);
            if constexpr (FOX) {
#pragma unroll
                for (int g = 0; g < 4; ++g) {
                    const f32x4 c0 = *(const LAS f32x4*)(cb + (8 * g + 4 * hi) * 4);
                    const f32x4 c1 = *(const LAS f32x4*)(cb + (32 + 8 * g + 4 * hi) * 4);
#pragma unroll
                    for (int i = 0; i < 4; ++i) { sp0[4 * g + i] += cq - c0[i]; sp1[4 * g + i] += cq - c1[i]; }
                }
            }
            if (causal && (64 * j + 63 > qw0)) {
#pragma unroll
                for (int r = 0; r < 16; ++r) {
                    const int key = 64 * j + crow(r, hi);
                    if (key > qrow) sp0[r] = -1e30f;
                    if (key + 32 > qrow) sp1[r] = -1e30f;
                }
            }
            float mx = fmaxf(sp0[0], sp1[0]);
#pragma unroll
            for (int r = 1; r < 16; ++r) mx = fmaxf(mx, fmaxf(sp0[r], sp1[r]));
            mx = fmaxf(mx, __shfl_xor(mx, 32));
            const float mnew = fmaxf(mrun, mx);
            const float alpha = __builtin_amdgcn_exp2f(mrun - mnew);
            mrun = mnew;
            float ls = 0.f;
#pragma unroll
            for (int r = 0; r < 16; ++r) { sp0[r] = __builtin_amdgcn_exp2f(sp0[r] - mnew); sp1[r] = __builtin_amdgcn_exp2f(sp1[r] - mnew); ls += sp0[r] + sp1[r]; }
            lrun = lrun * alpha + ls;
#pragma unroll
            for (int r = 0; r < 16; ++r) { o0[r] *= alpha; o1[r] *= alpha; }
            __builtin_amdgcn_sched_barrier(0);
#pragma unroll
            for (int ks = 0; ks < 4; ++ks) {
                const int p = ks >> 1, s2 = ks & 1;
                u32x4 pw;
                if (p == 0) { pw.x = cvtpk(sp0[8 * s2 + 0], sp0[8 * s2 + 1]); pw.y = cvtpk(sp0[8 * s2 + 2], sp0[8 * s2 + 3]); pw.z = cvtpk(sp0[8 * s2 + 4], sp0[8 * s2 + 5]); pw.w = cvtpk(sp0[8 * s2 + 6], sp0[8 * s2 + 7]); }
                else        { pw.x = cvtpk(sp1[8 * s2 + 0], sp1[8 * s2 + 1]); pw.y = cvtpk(sp1[8 * s2 + 2], sp1[8 * s2 + 3]); pw.z = cvtpk(sp1[8 * s2 + 4], sp1[8 * s2 + 5]); pw.w = cvtpk(sp1[8 * s2 + 6], sp1[8 * s2 + 7]); }
                const bf16x8 pf = __builtin_bit_cast(bf16x8, pw);
                const int kbase = (32 * p + 16 * s2 + 4 * hi) * 2;
                {
                    const u32x2 lo = *(const LAS u32x2*)(vb + r32 * 136 + kbase), h2 = *(const LAS u32x2*)(vb + r32 * 136 + kbase + 16);
                    const bf16x8 vf = __builtin_bit_cast(bf16x8, (u32x4){lo.x, lo.y, h2.x, h2.y});
                    o0 = __builtin_amdgcn_mfma_f32_32x32x16_bf16(vf, pf, o0, 0, 0, 0);
                }
                {
                    const u32x2 lo = *(const LAS u32x2*)(vb + (32 + r32) * 136 + kbase), h2 = *(const LAS u32x2*)(vb + (32 + r32) * 136 + kbase + 16);
                    const bf16x8 vf = __builtin_bit_cast(bf16x8, (u32x4){lo.x, lo.y, h2.x, h2.y});
                    o1 = __builtin_amdgcn_mfma_f32_32x32x16_bf16(vf, pf, o1, 0, 0, 0);
                }
            }
        }
        if (j + 1 < ntiles) ATT_LWRITE(cur ^ 1);
        __syncthreads();
    }
#undef ATT_GLOAD
#undef ATT_LWRITE
    const float ltot = lrun + __shfl_xor(lrun, 32);
    const float inv = 1.0f / ltot;
#pragma unroll
    for (int g = 0; g < 4; ++g) {
        const int d0 = 8 * g + 4 * hi;
        u32x2 w0, w1;
        w0.x = cvtpk(o0[4 * g] * inv, o0[4 * g + 1] * inv); w0.y = cvtpk(o0[4 * g + 2] * inv, o0[4 * g + 3] * inv);
        w1.x = cvtpk(o1[4 * g] * inv, o1[4 * g + 1] * inv); w1.y = cvtpk(o1[4 * g + 2] * inv, o1[4 * g + 3] * inv);
        *(u32x2*)(O + (size_t)qrow * ldo + d0) = w0;
        *(u32x2*)(O + (size_t)qrow * ldo + 32 + d0) = w1;
    }
}


template <int DK, bool ROPEQ>
DI void attn_unit_pipe(LAS unsigned char* lds, const bf16_t* Q, int ldq, const bf16_t* Kp, int ldk, const bf16_t* Vt, int ldv,
                       bf16_t* O, int ldo, int q0, int ntiles, const int* pos, const int wid) {
    constexpr int PK = DK * 2 + 16, KBYTES = 64 * PK, VBYTES = 64 * 136, KCH = DK / 8, NS = DK / 16, VOFF = 2 * KBYTES;
    constexpr float THR = 6.0f;
    const int lane = vlane(), tid = wid * 64 + lane, r32 = lane & 31, hi = lane >> 5;
    const int qw0 = q0 + wid * 32, qrow = qw0 + r32;
    bf16x8 qf[NS];
#pragma unroll
    for (int s = 0; s < NS; ++s) qf[s] = *(const bf16x8*)(Q + (size_t)qrow * ldq + 16 * s + 8 * hi);
    if constexpr (ROPEQ) {
        const float p = (float)pos[qrow];
#pragma unroll
        for (int j = 0; j < 8; ++j) {
            const int i = 8 * hi + j;
            const float inv = exp2f(-(float)i * (13.287712379549449f / 16.0f));
            float sn, cs; sincos_cw(p * inv, sn, cs);
            const float x1 = bf2f((unsigned short)qf[NS - 2][j]), x2 = bf2f((unsigned short)qf[NS - 1][j]);
            const float o1 = x1 * cs - x2 * sn, o2 = x1 * sn + x2 * cs;
            qf[NS - 2][j] = (short)(cvtpk(o1, 0.f) & 0xffffu); qf[NS - 1][j] = (short)(cvtpk(o2, 0.f) & 0xffffu);
        }
    }
    const int kr0 = tid / KCH, kc0 = tid % KCH;
    const int kr1 = (tid + 512) / KCH, kc1 = (tid + 512) % KCH;
    const bool k2 = (DK == 96) && (tid < 256);
    const int vd = tid >> 3, vc = tid & 7;
    const int kfo = r32 * PK + 16 * hi;
    const int vfo = VOFF + r32 * 136 + 8 * hi;
    u32x4 kA0, kA1 = (u32x4){0, 0, 0, 0}, vA, kB0, kB1 = (u32x4){0, 0, 0, 0}, vB;
#define SBAR() __builtin_amdgcn_sched_barrier(0)
#define AP_LOADK(j, R0, R1) do { R0 = *(const u32x4*)(Kp + (size_t)(64 * (j) + kr0) * ldk + kc0 * 8); \
        if (k2) R1 = *(const u32x4*)(Kp + (size_t)(64 * (j) + kr1) * ldk + kc1 * 8); } while (0)
#define AP_LOADV(j, RV) do { RV = *(const u32x4*)(Vt + (size_t)vd * ldv + 64 * (j) + vc * 8); } while (0)
#define AP_WRITEK(buf, R0, R1) do { LAS unsigned char* bb_ = lds + (buf) * KBYTES; *(LAS u32x4*)(bb_ + kr0 * PK + kc0 * 16) = R0; \
        if (k2) *(LAS u32x4*)(bb_ + kr1 * PK + kc1 * 16) = R1; } while (0)
#define AP_WRITEV(buf, RV) do { LAS unsigned char* bb_ = lds + VOFF + (buf) * VBYTES; \
        *(LAS u32x2*)(bb_ + vd * 136 + vc * 16) = (u32x2){RV.x, RV.y}; *(LAS u32x2*)(bb_ + vd * 136 + vc * 16 + 8) = (u32x2){RV.z, RV.w}; } while (0)
#define AP_KF(dst0, dst1, kbuf, s) do { dst0 = *(const LAS bf16x8*)(lds + (kbuf) * KBYTES + kfo + 32 * (s)); dst1 = *(const LAS bf16x8*)(lds + (kbuf) * KBYTES + kfo + 32 * PK + 32 * (s)); } while (0)
#define AP_VF(dst0, dst1, vbuf, ks) do { const LAS unsigned char* p_ = lds + (vbuf) * VBYTES + vfo + (32 * ((ks) >> 1) + 16 * ((ks) & 1)) * 2; \
        const u32x2 a_ = *(const LAS u32x2*)(p_), b_ = *(const LAS u32x2*)(p_ + 16), c_ = *(const LAS u32x2*)(p_ + 32 * 136), d_ = *(const LAS u32x2*)(p_ + 32 * 136 + 16); \
        dst0 = __builtin_bit_cast(bf16x8, (u32x4){a_.x, a_.y, b_.x, b_.y}); dst1 = __builtin_bit_cast(bf16x8, (u32x4){c_.x, c_.y, d_.x, d_.y}); } while (0)
#define AP_MFMA(a, b, c) __builtin_amdgcn_mfma_f32_32x32x16_bf16(a, b, c, 0, 0, 0)
#define AP_MASK(S0, S1, t) do { _Pragma("unroll") for (int r_ = 0; r_ < 16; ++r_) { const int key_ = 64 * (t) + crow(r_, hi); \
        if (key_ > qrow) S0[r_] = -1e30f; if (key_ + 32 > qrow) S1[r_] = -1e30f; } } while (0)
#define AP_ROWMAX(S0, S1, out) do { float a_ = fmaxf(fmaxf(S0[0], S1[0]), S0[1]), b_ = fmaxf(fmaxf(S1[1], S0[2]), S1[2]); \
        _Pragma("unroll") for (int r_ = 3; r_ < 15; r_ += 2) { a_ = fmaxf(fmaxf(a_, S0[r_]), S1[r_]); b_ = fmaxf(fmaxf(b_, S0[r_ + 1]), S1[r_ + 1]); } \
        a_ = fmaxf(fmaxf(a_, S0[15]), S1[15]); a_ = fmaxf(a_, b_); out = fmaxf(a_, __shfl_xor(a_, 32)); } while (0)
    f32x16 o0, o1, pa0, pa1, sb0, sb1;
#pragma unroll
    for (int r = 0; r < 16; ++r) { o0[r] = 0.f; o1[r] = 0.f; }
    float mref = 0.f, lrun = 0.f;
    bf16x8 pf[4];
    bf16x8 fa0, fa1, fb0, fb1;
    AP_LOADK(0, kA0, kA1); AP_LOADV(0, vA); AP_WRITEK(0, kA0, kA1); AP_WRITEV(0, vA);
    AP_LOADK(1, kA0, kA1); AP_WRITEK(1, kA0, kA1);
    AP_LOADK(2, kA0, kA1); AP_LOADV(1, vA);
    __syncthreads();
#pragma unroll
    for (int r = 0; r < 16; ++r) { pa0[r] = 0.f; pa1[r] = 0.f; }
#pragma unroll
    for (int s = 0; s < NS; ++s) { AP_KF(fa0, fa1, 0, s); pa0 = AP_MFMA(fa0, qf[s], pa0); pa1 = AP_MFMA(fa1, qf[s], pa1); }
    if (ntiles == 4) AP_MASK(pa0, pa1, 0);
    { float mx; AP_ROWMAX(pa0, pa1, mx); mref = mx;
#pragma unroll
      for (int r = 0; r < 16; ++r) { pa0[r] = __builtin_amdgcn_exp2f(pa0[r] - mx); pa1[r] = __builtin_amdgcn_exp2f(pa1[r] - mx); } }
    __syncthreads();
    f32x16 negm;
#pragma unroll
    for (int r = 0; r < 16; ++r) negm[r] = -mref;
    asm volatile("" : "+v"(negm));
#define AP_STEPA(s, X0, X1, Y0, Y1, VALU) do { if ((s) + 1 < NS) AP_KF(Y0, Y1, kb_, (s) + 1); else AP_VF(Y0, Y1, vb_, 0); \
        if ((s) == 0) { sb0 = AP_MFMA(X0, qf[s], negm); sb1 = AP_MFMA(X1, qf[s], negm); } else { sb0 = AP_MFMA(X0, qf[s], sb0); sb1 = AP_MFMA(X1, qf[s], sb1); } VALU; SBAR(); } while (0)
#define AP_PK(i, P, b) pw_[i] = (u32x4){cvtpk(P[b], P[b + 1]), cvtpk(P[b + 2], P[b + 3]), cvtpk(P[b + 4], P[b + 5]), cvtpk(P[b + 6], P[b + 7])}; \
        ls0_ = fadd_s(ls0_, fadd_s(fadd_s(P[b], P[b + 1]), fadd_s(P[b + 2], P[b + 3]))); ls1_ = fadd_s(ls1_, fadd_s(fadd_s(P[b + 4], P[b + 5]), fadd_s(P[b + 6], P[b + 7]))); asm volatile("" : "+v"(pw_[i]), "+v"(ls0_), "+v"(ls1_))
#define AP_EXP4(P, S, b) do { P[b] = __builtin_amdgcn_exp2f(S[b]); P[b + 1] = __builtin_amdgcn_exp2f(S[b + 1]); P[b + 2] = __builtin_amdgcn_exp2f(S[b + 2]); P[b + 3] = __builtin_amdgcn_exp2f(S[b + 3]); asm volatile("" : "+v"(P)); } while (0)
#define AP_STEPB(ks, X0, X1, Y0, Y1, E0, E1) do { if ((ks) + 1 < 4) AP_VF(Y0, Y1, vb_, (ks) + 1); \
        o0 = AP_MFMA(X0, pf[ks], o0); E0; SBAR(); o1 = AP_MFMA(X1, pf[ks], o1); E1; SBAR(); } while (0)
#define AP_ITER(t, MASKED, WK0, WK1, WV, LK0, LK1, LV) do {     \
        const int kb_ = (t) & 1, vb_ = ((t) - 1) & 1; \
        if ((t) + 2 < ntiles) AP_LOADK((t) + 2, LK0, LK1); \
        if ((t) + 1 < ntiles) AP_LOADV((t) + 1, LV); \
        u32x4 pw_[4]; float ls0_ = 0.f, ls1_ = 0.f; \
        AP_KF(fa0, fa1, kb_, 0); SBAR(); \
        AP_STEPA(0, fa0, fa1, fb0, fb1, AP_PK(0, pa0, 0)); \
        AP_STEPA(1, fb0, fb1, fa0, fa1, AP_PK(1, pa0, 8)); \
        AP_STEPA(2, fa0, fa1, fb0, fb1, AP_PK(2, pa1, 0)); \
        AP_STEPA(3, fb0, fb1, fa0, fa1, AP_PK(3, pa1, 8)); \
        if (NS == 6) { AP_STEPA(4, fa0, fa1, fb0, fb1, (void)0); AP_STEPA(5, fb0, fb1, fa0, fa1, (void)0); } \
        lrun += ls0_ + ls1_; \
        pf[0] = __builtin_bit_cast(bf16x8, pw_[0]); pf[1] = __builtin_bit_cast(bf16x8, pw_[1]); pf[2] = __builtin_bit_cast(bf16x8, pw_[2]); pf[3] = __builtin_bit_cast(bf16x8, pw_[3]); \
        if ((t) >= ntiles - 4) AP_MASK(sb0, sb1, t); \
        float mx_; AP_ROWMAX(sb0, sb1, mx_); \
        float resc_ = 1.0f; bool do_resc_ = false; \
        if (__any(mx_ > THR)) { const float dl_ = fmaxf(mx_, 0.f); mref += dl_; \
            _Pragma("unroll") for (int r_ = 0; r_ < 16; ++r_) { sb0[r_] -= dl_; sb1[r_] -= dl_; negm[r_] = -mref; } \
            asm volatile("" : "+v"(negm)); \
            resc_ = __builtin_amdgcn_exp2f(-dl_); lrun *= resc_; do_resc_ = true; } \
        SBAR(); \
        AP_STEPB(0, fa0, fa1, fb0, fb1, AP_EXP4(pa0, sb0, 0), AP_EXP4(pa0, sb0, 4)); \
        AP_STEPB(1, fb0, fb1, fa0, fa1, AP_EXP4(pa0, sb0, 8), AP_EXP4(pa0, sb0, 12)); \
        AP_STEPB(2, fa0, fa1, fb0, fb1, AP_EXP4(pa1, sb1, 0), AP_EXP4(pa1, sb1, 4)); \
        AP_STEPB(3, fb0, fb1, fa0, fa1, AP_EXP4(pa1, sb1, 8), AP_EXP4(pa1, sb1, 12)); \
        if (do_resc_) { asm volatile("" ::: "memory"); _Pragma("unroll") for (int r_ = 0; r_ < 16; ++r_) { o0[r_] *= resc_; o1[r_] *= resc_; } asm volatile("" : "+v"(o0), "+v"(o1)); } \
        if ((t) + 1 < ntiles) AP_WRITEK(((t) + 1) & 1, WK0, WK1); \
        AP_WRITEV((t) & 1, WV); \
        __syncthreads(); } while (0)
    static_assert(NS == 4 || NS == 6, "head dim 64 or 96");
    if (wid >= 4) __builtin_amdgcn_s_setprio(1);
    int t = 1;
    for (; t + 1 < ntiles; t += 2) { AP_ITER(t, 1, kA0, kA1, vA, kB0, kB1, vB); AP_ITER(t + 1, 1, kB0, kB1, vB, kA0, kA1, vA); }
    AP_ITER(t, 1, kA0, kA1, vA, kB0, kB1, vB);
    {
        u32x4 pw_[4]; float ls0_ = 0.f, ls1_ = 0.f;
        AP_PK(0, pa0, 0); AP_PK(1, pa0, 8); AP_PK(2, pa1, 0); AP_PK(3, pa1, 8);
        lrun += ls0_ + ls1_;
        pf[0] = __builtin_bit_cast(bf16x8, pw_[0]); pf[1] = __builtin_bit_cast(bf16x8, pw_[1]); pf[2] = __builtin_bit_cast(bf16x8, pw_[2]); pf[3] = __builtin_bit_cast(bf16x8, pw_[3]);
        const int vb_ = (ntiles - 1) & 1;
#pragma unroll
        for (int ks = 0; ks < 4; ++ks) { AP_VF(fa0, fa1, vb_, ks); o0 = AP_MFMA(fa0, pf[ks], o0); o1 = AP_MFMA(fa1, pf[ks], o1); }
    }
    const float ltot = lrun + __shfl_xor(lrun, 32);
    const float inv = 1.0f / ltot;
#pragma unroll
    for (int g = 0; g < 4; ++g) {
        const int d0 = 8 * g + 4 * hi;
        u32x2 w0, w1;
        w0.x = cvtpk(o0[4 * g] * inv, o0[4 * g + 1] * inv); w0.y = cvtpk(o0[4 * g + 2] * inv, o0[4 * g + 3] * inv);
        w1.x = cvtpk(o1[4 * g] * inv, o1[4 * g + 1] * inv); w1.y = cvtpk(o1[4 * g + 2] * inv, o1[4 * g + 3] * inv);
        *(u32x2*)(O + (size_t)qrow * ldo + d0) = w0;
        *(u32x2*)(O + (size_t)qrow * ldo + 32 + d0) = w1;
    }
    __syncthreads();
#undef SBAR
#undef AP_LOADK
#undef AP_LOADV
#undef AP_WRITEK
#undef AP_WRITEV
#undef AP_KF
#undef AP_VF
#undef AP_MFMA
#undef AP_MASK
#undef AP_ROWMAX
#undef AP_STEPA
#undef AP_PK
#undef AP_EXP4
#undef AP_STEPB
#undef AP_ITER
}

#define XB_TMO      128
#define XB_XCNT(j)  (256  + 64 * (j))
#define XB_XSUB(j)  (1280 + 64 * (j))
#define XB_XGEN(j)  (2304 + 64 * (j))
#define XB_TOP      3328
#define XB_TOPGEN   3392
#define XCD_BAR_WORDS 3456
#define XB_SPIN_CAP (1u << 18)
DI unsigned xb_ld(unsigned* p) { return __hip_atomic_load(p, __ATOMIC_RELAXED, __HIP_MEMORY_SCOPE_AGENT); }
DI unsigned xb_add(unsigned* p, unsigned v) { return __hip_atomic_fetch_add(p, v, __ATOMIC_RELAXED, __HIP_MEMORY_SCOPE_AGENT); }
DI unsigned xb_xcc_id() { return (unsigned)__builtin_amdgcn_s_getreg((3 << 11) | 20) & 0xFu; }
#define XB_SPIN(cond, bar) do { unsigned _sp = 0; while (cond) { __builtin_amdgcn_s_sleep(1); \
    if ((++_sp & 255u) == 0u) { if (xb_ld(&(bar)[XB_TMO])) break; if (_sp > XB_SPIN_CAP) { atomicAdd(&(bar)[XB_TMO], 1u); break; } } } } while (0)
struct XcdBarrier { unsigned* bar; unsigned x; volatile LAS unsigned* st; int wid; };
DI XcdBarrier xcd_barrier_post(unsigned* bar, volatile LAS unsigned* st, int wid) {
    XcdBarrier b; b.bar = bar; b.x = xb_xcc_id(); b.st = st; b.wid = wid;
    if (wid == 0 && vlane() == 0) (void)xb_add(&bar[XB_XCNT(b.x)], 1u);
    return b;
}
DI void xcd_barrier_complete(unsigned* bar, unsigned x, unsigned& nloc, unsigned& nx) {
    const unsigned G = gridDim.x * gridDim.y * gridDim.z;
    unsigned sum, cnt, mine, sp = 0u;
    for (;;) {
        sum = 0u; cnt = 0u; mine = 0u;
#pragma unroll
        for (unsigned j = 0; j < 16; ++j) { const unsigned c = xb_ld(&bar[XB_XCNT(j)]); sum += c; cnt += (c > 0u) ? 1u : 0u; mine = (j == x) ? c : mine; }
        if (sum == G) break;
        __builtin_amdgcn_s_sleep(1);
        if ((++sp & 255u) == 0u) { if (xb_ld(&bar[XB_TMO])) break; if (sp > XB_SPIN_CAP) { atomicAdd(&bar[XB_TMO], 1u); break; } }
    }
    nloc = mine > 0u ? mine : 1u; nx = cnt > 0u ? cnt : 1u;
}
DI void xcd_barrier(const XcdBarrier& b) {
    asm volatile("s_waitcnt vmcnt(0)" ::: "memory");
    __syncthreads();
    if (b.wid == 0 && vlane() == 0) {
        unsigned* bar = b.bar;
        __builtin_amdgcn_s_waitcnt(0);
        unsigned nloc = b.st[0], nx = b.st[1];
        if (nloc == 0u) { xcd_barrier_complete(bar, b.x, nloc, nx); b.st[0] = nloc; b.st[1] = nx; }
        const unsigned old = xb_add(&bar[XB_XSUB(b.x)], 1u);
        const unsigned gen = old / nloc;
        if (old + 1u == (gen + 1u) * nloc) {
            __builtin_amdgcn_fence(__ATOMIC_RELEASE, "agent");
            asm volatile("s_waitcnt vmcnt(0)" ::: "memory");
            const unsigned og = xb_add(&bar[XB_TOP], 1u);
            const unsigned tg = og / nx;
            if (og + 1u == (tg + 1u) * nx) xb_add(&bar[XB_TOPGEN], 1u);
            else XB_SPIN(xb_ld(&bar[XB_TOPGEN]) == tg, bar);
            __builtin_amdgcn_fence(__ATOMIC_ACQUIRE, "agent");
            xb_add(&bar[XB_XGEN(b.x)], 1u);
            asm volatile("s_waitcnt vmcnt(0)" ::: "memory");
        } else {
            XB_SPIN(xb_ld(&bar[XB_XGEN(b.x)]) == gen, bar);
            __builtin_amdgcn_fence(__ATOMIC_ACQUIRE, "agent");
            asm volatile("s_waitcnt vmcnt(0)" ::: "memory");
        }
    }
    __syncthreads();
}

DI int next_unit(Frame& F, int widx) {
    LAS int* s = (LAS int*)(F.lds + LDS_CTL);
    __syncthreads();
    if (F.tid == 0) *s = (int)atomicAdd(F.ctl + CW_WORK + 64 * widx, 1u);
    __syncthreads();
    return *s;
}

DI void transpose_item(const float* W, int ldw, int srccol, int K, bf16_t* WT, int drow, LAS unsigned* scr, int k0, int lane, int nvalid) {
    const int n4 = lane & 15, kq = lane >> 4;
#pragma unroll 8
    for (int i = 0; i < 16; ++i) {
        const int kk = 4 * i + kq;
        f32x4 v = (f32x4){0.f, 0.f, 0.f, 0.f};
        if (4 * n4 < nvalid) v = *(const f32x4*)(W + (size_t)(k0 + kk) * ldw + srccol + 4 * n4);
        scr[kk * 33 + 2 * n4] = cvtpk(v[0], v[1]); scr[kk * 33 + 2 * n4 + 1] = cvtpk(v[2], v[3]);
    }
    LDS_WAIT(); asm volatile("" ::: "memory");
    const int c = lane & 7;
    const LAS unsigned short* s16 = (const LAS unsigned short*)scr;
#pragma unroll
    for (int j = 0; j < 8; ++j) {
        const int n = (lane >> 3) + 8 * j;
        const LAS unsigned short* sp = s16 + (8 * c) * 66 + n;
        u32x4 o;
        o.x = (unsigned)sp[0 * 66] | ((unsigned)sp[1 * 66] << 16); o.y = (unsigned)sp[2 * 66] | ((unsigned)sp[3 * 66] << 16);
        o.z = (unsigned)sp[4 * 66] | ((unsigned)sp[5 * 66] << 16); o.w = (unsigned)sp[6 * 66] | ((unsigned)sp[7 * 66] << 16);
        if (n < nvalid) *(u32x4*)(WT + (size_t)(drow + n) * K + k0 + 8 * c) = o;
    }
    LDS_WAIT(); asm volatile("" ::: "memory");
}
constexpr int CONV_P1 = 5, CONV_A0 = 5, CONV_GU = 7, CONV_DN = 4, CONV_A1 = 12;
constexpr int MOE_I_GU = 16 * 32, MOE_I_DN = 16 * 16, MOE_ITEMS_PER_LAYER = 32 * (MOE_I_GU + MOE_I_DN);
DI void moe_convert_item(unsigned char* ws, LAS unsigned* scr, int r, int lane) {
    const int l = r / MOE_ITEMS_PER_LAYER; r -= l * MOE_ITEMS_PER_LAYER;
    if (r < 32 * MOE_I_GU) {
        const int e = l * 32 + r / MOE_I_GU, q = r % MOE_I_GU, kb = q / 32, nb = q % 32;
        const int jj = (nb & 15) * 64, drow = (jj >> 7) * 256 + (nb >> 4) * 128 + (jj & 127);
        transpose_item(KP->moe_w_gu + (size_t)e * 1024 * 2048, 2048, 64 * nb, 1024, (bf16_t*)(ws + WS_W_GU) + (size_t)e * 2048 * 1024, drow, scr, 64 * kb, lane, 64);
    } else {
        r -= 32 * MOE_I_GU;
        const int e = l * 32 + r / MOE_I_DN, q = r % MOE_I_DN, kb = q / 16, nb = q % 16;
        transpose_item(KP->moe_w_dn + (size_t)e * 1024 * 1024, 1024, 64 * nb, 1024, (bf16_t*)(ws + WS_W_DN) + (size_t)e * 1024 * 1024, 64 * nb, scr, 64 * kb, lane, 64);
    }
}
constexpr int CW_CONVQ = CW_WORK + 64 * 8;
DI bool conv_pull(Frame& F, int l, int nchunks) {
    constexpr int NCHUNK = MOE_ITEMS_PER_LAYER / 8;
    LAS int* s = (LAS int*)(F.lds + LDS_CTL + 8);
    __syncthreads();
    if (F.tid == 0) *s = (int)atomicAdd(F.ctl + CW_CONVQ + 64 * l, (unsigned)nchunks);
    __syncthreads();
    const int base = *s;
    LAS unsigned* scr = (LAS unsigned*)(F.lds + F.wid * 8448);
    for (int c = base; c < base + nchunks && c < NCHUNK; ++c) moe_convert_item(F.ws, scr, l * MOE_ITEMS_PER_LAYER + c * 8 + F.wid, F.lane);
    __syncthreads();
    return base + nchunks < NCHUNK;
}
struct TrMat { const float* W; int ldw, col0, K, N; bf16_t* WT; int drow0, mode; };

DI void phase_prologue(Frame& F, const Params& P) {
    F.lane = vlane(); F.tid = F.wid * 64 + F.lane;
    LAS unsigned* scr = (LAS unsigned*)(F.lds + F.wid * 8448);
    const int gw = F.bid * 8 + F.wid, NGW = F.G * 8;
    unsigned char* ws = F.ws;
    TrMat mats[11];
    mats[0] = TrMat{KP->a_w_in, FOX_IN, 0, 1024, 1536, (bf16_t*)(ws + WS_W_AIN), 0, 0};
    mats[1] = TrMat{KP->a_w_in, FOX_IN, 2316, 1024, 256, (bf16_t*)(ws + WS_W_AIN), 1536, 0};
    mats[2] = TrMat{KP->a_w_in, FOX_IN, 1536, 1024, 768, (bf16_t*)(ws + WS_W_AIN), 1792, 0};
    mats[3] = TrMat{KP->a_w_out, 1024, 0, 1024, 1024, (bf16_t*)(ws + WS_W_AOUT), 0, 0};
    mats[4] = TrMat{KP->kv_w_dkv, 288, 0, 1024, 288, (bf16_t*)(ws + WS_W_BIN), 0, 0};
    mats[5] = TrMat{KP->b_w_in, 640, 0, 1024, 640, (bf16_t*)(ws + WS_W_BIN), 288, 0};
    mats[6] = TrMat{KP->b_w_uq, 1152, 0, 384, 1152, (bf16_t*)(ws + WS_W_UQ), 0, 0};
    mats[7] = TrMat{KP->kv_w_ukv, 1536, 0, 256, 1536, (bf16_t*)(ws + WS_W_UKV), 0, 1};
    mats[8] = TrMat{KP->b_w_out, 1024, 0, 1024, 1024, (bf16_t*)(ws + WS_W_BOUT), 0, 0};
    mats[9] = TrMat{KP->mem_w_kv, 512, 0, 1024, 512, (bf16_t*)(ws + WS_W_MKV), 0, 0};
    mats[10] = TrMat{KP->mem_w_kv + (size_t)1024 * 512, 512, 0, 1024, 512, (bf16_t*)(ws + WS_W_MKV) + (size_t)512 * 1024, 0, 0};
    int nsmall = 0;
#pragma unroll
    for (int i = 0; i < 11; ++i) nsmall += (mats[i].K / 64) * ((mats[i].N + 63) / 64);
    const int ntot = nsmall;
    for (int it = gw; it < ntot; it += NGW) {
        int r = it;
        if (r < nsmall) {
#pragma unroll
            for (int i = 0; i < 11; ++i) {
                const int nblk = (mats[i].N + 63) / 64, ni = (mats[i].K / 64) * nblk;
                if (r >= 0 && r < ni) {
                    const int kb = r / nblk, nb = r % nblk;
                    const int drow = mats[i].mode == 1 ? ((nb & 1) * 768 + (nb >> 1) * 64) : (mats[i].drow0 + 64 * nb);
                    transpose_item(mats[i].W, mats[i].ldw, mats[i].col0 + 64 * nb, mats[i].K, mats[i].WT, drow, scr, 64 * kb, F.lane, mats[i].N - 64 * nb);
                }
                r -= ni;
            }
            continue;
        }
    }
    __syncthreads();
    LAS float* wf = (LAS float*)F.lds;
    for (int i = F.tid; i < 1024 * 12; i += NTHREADS) { const int k = i / 12, h = i % 12; wf[i] = KP->a_w_in[(size_t)k * FOX_IN + 2304 + h]; }
    __syncthreads();
    float* logf = (float*)(ws + WS_LOGF);
    bf16_t* xb = (bf16_t*)(ws + WS_XB);
    for (int row = gw; row < T; row += NGW) {
        const f32x4* xr = (const f32x4*)(KP->x + (size_t)row * DM) + F.lane;
        f32x4 v[4];
#pragma unroll
        for (int j = 0; j < 4; ++j) v[j] = xr[64 * j];
        u32x2* o8 = (u32x2*)(xb + (size_t)row * DM) + F.lane;
#pragma unroll
        for (int j = 0; j < 4; ++j) o8[64 * j] = (u32x2){cvtpk(v[j][0], v[j][1]), cvtpk(v[j][2], v[j][3])};
        float part[12];
#pragma unroll
        for (int h = 0; h < 12; ++h) part[h] = 0.f;
#pragma unroll
        for (int j = 0; j < 4; ++j)
#pragma unroll
            for (int i = 0; i < 4; ++i) {
                const int k = 4 * F.lane + 256 * j + i;
                const LAS f32x4* wp = (const LAS f32x4*)(wf + k * 12);
                const f32x4 w0 = wp[0], w1 = wp[1], w2 = wp[2];
                const float xv = v[j][i];
                part[0] += xv * w0[0]; part[1] += xv * w0[1]; part[2] += xv * w0[2]; part[3] += xv * w0[3];
                part[4] += xv * w1[0]; part[5] += xv * w1[1]; part[6] += xv * w1[2]; part[7] += xv * w1[3];
                part[8] += xv * w2[0]; part[9] += xv * w2[1]; part[10] += xv * w2[2]; part[11] += xv * w2[3];
            }
        float mine = 0.f;
#pragma unroll
        for (int h = 0; h < 12; ++h) { const float s = wave_sum(part[h]); if (F.lane == h) mine = s; }
        if (F.lane < 12) {
            const float z = mine + KP->a_b_f[F.lane];
            const float ls = fminf(z, 0.f) - log1pf(expf(-fabsf(z)));
            const int b = row / SEQ, s = row % SEQ;
            logf[(size_t)(b * NH + F.lane) * SEQ + s] = ls;
        }
    }
    {
        float* wrt = (float*)(ws + WS_WRT);
        for (int i = F.bid * NTHREADS + F.tid; i < 2 * 1024 * 32; i += F.G * NTHREADS) { const int l = i >> 15, k = (i >> 5) & 1023, e = i & 31; wrt[(size_t)(l * 32 + e) * 1024 + k] = KP->moe_w_r[i]; }
    }
    bf16_t* memb = (bf16_t*)(ws + WS_MEMB);
    for (int row = gw; row < NB * NMEM; row += NGW) {
        const f32x4* xr = (const f32x4*)(KP->mem + (size_t)row * DM) + F.lane;
        u32x2* o8 = (u32x2*)(memb + (size_t)row * DM) + F.lane;
#pragma unroll
        for (int j = 0; j < 4; ++j) { const f32x4 v = xr[64 * j]; o8[64 * j] = (u32x2){cvtpk(v[0], v[1]), cvtpk(v[2], v[3])}; }
    }
}

DI void scan_unit(Frame& F, int bh) {
    const float* src = (const float*)(F.ws + WS_LOGF) + (size_t)bh * SEQ;
    float* dst = (float*)(F.ws + WS_CUM) + (size_t)bh * SEQ;
    LAS float* wtot = (LAS float*)F.lds;
    float v[16];
#pragma unroll
    for (int j = 0; j < 4; ++j) { const f32x4 t = *(const f32x4*)(src + F.tid * 16 + 4 * j); v[4 * j] = t[0]; v[4 * j + 1] = t[1]; v[4 * j + 2] = t[2]; v[4 * j + 3] = t[3]; }
#pragma unroll
    for (int i = 1; i < 16; ++i) v[i] += v[i - 1];
    float tot = v[15];
    float inc = tot;
#pragma unroll
    for (int o = 1; o < 64; o <<= 1) { const float t = __shfl_up(inc, o); if (F.lane >= o) inc += t; }
    __syncthreads();
    if (F.lane == 63) wtot[F.wid] = inc;
    __syncthreads();
    float base = inc - tot;
    for (int w = 0; w < F.wid; ++w) base += wtot[w];
#pragma unroll
    for (int j = 0; j < 4; ++j) {
        f32x4 t; t[0] = (base + v[4 * j]) * LOG2E; t[1] = (base + v[4 * j + 1]) * LOG2E; t[2] = (base + v[4 * j + 2]) * LOG2E; t[3] = (base + v[4 * j + 3]) * LOG2E;
        *(f32x4*)(dst + F.tid * 16 + 4 * j) = t;
    }
    __syncthreads();
}

struct RouteQKM { unsigned char* ws; DI Dst operator()(const pg8::Unit& u) const {
    if (u.pn < 3) return Dst{(bf16_t*)(ws + WS_Q), 768, u.pm * 256, u.pn * 256, 256, 0.125f * LOG2E, false};
    if (u.pn < 6) return Dst{(bf16_t*)(ws + WS_K), 768, u.pm * 256, (u.pn - 3) * 256, 256, 1.0f, false};
    return Dst{(bf16_t*)(ws + WS_MQ), 256, u.pm * 256, 0, 256, 0.125f * LOG2E, false}; } };
struct RouteVT { unsigned char* ws; DI Dst operator()(const pg8::Unit& u) const {
    const int b = u.pn >> 5; return Dst{(bf16_t*)(ws + WS_VT) + (size_t)b * 768 * SEQ, SEQ, u.pm * 256, (u.pn & 31) * 256, 256, 1.0f, false}; } };
struct RoutePlain { bf16_t* O; int ldo; DI Dst operator()(const pg8::Unit& u) const { return Dst{O, ldo, u.pm * 256, u.pn * 256, 256, 1.0f, false}; } };
DI void phase_proj0(Frame& F, const Params& P) {
    F.lane = vlane(); F.tid = F.wid * 64 + F.lane;
    unsigned char* ws = F.ws;
    const bf16_t* xb = (const bf16_t*)(ws + WS_XB);
    const bf16_t* win = (const bf16_t*)(ws + WS_W_AIN);
    const bf16_t* memb = (const bf16_t*)(ws + WS_MEMB);
    {
        pg8::Gemm g{xb, win, 1024}; pg8::StaticOrder S; S.init(T, 1792, 1024, F.G, F.bid);
        EpiBf16R<RouteQKM> E{RouteQKM{ws}};
        pg8::gemm_phase<EpiBf16R<RouteQKM>, pg8::StaticOrder, true>(F.lds, g, S, E, F.wid);
    }
    {
        pg8::Gemm g{win + (size_t)1792 * 1024, xb, 1024}; pg8::StaticOrder S; S.init(768, T, 1024, F.G, (F.bid + 64) % F.G);
        EpiBf16R<RouteVT> E{RouteVT{ws}};
        pg8::gemm_phase<EpiBf16R<RouteVT>, pg8::StaticOrder, true>(F.lds, g, S, E, F.wid);
    }
    for (int l = 0; l < 2; ++l) {
        const bf16_t* wk = (const bf16_t*)(ws + WS_W_MKV) + (size_t)l * 512 * 1024;
        {
            pg8::Gemm g{memb, wk, 1024}; pg8::StaticOrder S; S.init(512, 256, 1024, F.G, (F.bid + F.G - (152 + 4 * l)) % F.G);
            EpiBf16R<RoutePlain> E{RoutePlain{(bf16_t*)(ws + WS_MK) + (size_t)l * 512 * 256, 256}};
            pg8::gemm_phase<EpiBf16R<RoutePlain>, pg8::StaticOrder, true>(F.lds, g, S, E, F.wid);
        }
        for (int b = 0; b < 2; ++b) {
            pg8::Gemm g{wk + (size_t)256 * 1024, memb + (size_t)b * 256 * 1024, 1024}; pg8::StaticOrder S; S.init(256, 256, 1024, F.G, (F.bid + F.G - (154 + 4 * l + b)) % F.G);
            EpiBf16R<RoutePlain> E{RoutePlain{(bf16_t*)(ws + WS_MVT) + (size_t)(l * 2 + b) * 256 * 256, 256}};
            pg8::gemm_phase<EpiBf16R<RoutePlain>, pg8::StaticOrder, true>(F.lds, g, S, E, F.wid);
        }
    }
    if (F.G == 256 && F.bid >= 128) conv_pull(F, 0, CONV_P1);
}


DI void phase_scan_knorm(Frame& F) {
    F.lane = vlane(); F.tid = F.wid * 64 + F.lane;
    unsigned char* ws = F.ws;
    if (F.bid < 24) scan_unit(F, F.bid);
    const bf16_t* K = (const bf16_t*)(ws + WS_K);
    float* kn2 = (float*)(ws + WS_KN2);
    const int gw = F.bid * 8 + F.wid, NGW = F.G * 8;
    for (int it = gw; it < 24 * 128; it += NGW) {
        const int bh = it >> 7, j = it & 127, b = bh / 12, h = bh % 12;
        const u32x4* kr = (const u32x4*)(K + (size_t)(b * SEQ + 64 * j + F.lane) * 768 + h * 64);
        float ss = 0.f;
#pragma unroll
        for (int c = 0; c < 8; ++c) {
            const u32x4 w = kr[c];
            const unsigned ww[4] = {w.x, w.y, w.z, w.w};
#pragma unroll
            for (int i = 0; i < 4; ++i) { const float a = __uint_as_float(ww[i] << 16), bb = __uint_as_float(ww[i] & 0xffff0000u); ss += a * a + bb * bb; }
        }
        ss = wave_max(ss);
        if (F.lane == 0) kn2[it] = ss;
    }
}

DI void mem_attn_unit(Frame& F, int l, int v) {
    unsigned char* ws = F.ws;
    const int qb = v >> 3, bm = v & 7, b = bm >> 2, mh = bm & 3;
    const bf16_t* Q = (const bf16_t*)(ws + WS_MQ) + (size_t)b * SEQ * 256 + mh * 64;
    const bf16_t* K = (const bf16_t*)(ws + WS_MK) + (size_t)l * 512 * 256 + (size_t)b * 256 * 256 + mh * 64;
    const bf16_t* Vt = (const bf16_t*)(ws + WS_MVT) + (size_t)(l * 2 + b) * 256 * 256 + (size_t)mh * 64 * 256;
    bf16_t* O = (bf16_t*)(ws + WS_MERGED) + (size_t)b * SEQ * 1024 + 768 + mh * 64;
    attn_unit<64, false, false>(F.lds, Q, 256, K, 256, Vt, 256, nullptr, O, 1024, qb * 256, 4, false, nullptr, F.wid);
}
DI void phase_attn0(Frame& F, const Params& P) {
    F.lane = vlane(); F.tid = F.wid * 64 + F.lane;
    unsigned char* ws = F.ws;
    constexpr int NU = 768 + 256 + 512;
    for (;;) {
        const int uu = next_unit(F, 0);
        if (uu >= NU) break;
        if (uu % 3 == 2) { conv_pull(F, 0, CONV_A0); continue; }
        const int u = 2 * (uu / 3) + uu % 3;
        if (u < 768) {
            const int qb = 31 - u / 24, bh = u % 24, b = bh / 12, h = bh % 12;
            const bf16_t* Q = (const bf16_t*)(ws + WS_Q) + (size_t)b * SEQ * 768 + h * 64;
            const bf16_t* K = (const bf16_t*)(ws + WS_K) + (size_t)b * SEQ * 768 + h * 64;
            const bf16_t* Vt = (const bf16_t*)(ws + WS_VT) + (size_t)(b * 768 + h * 64) * SEQ;
            const float* cum = (const float*)(ws + WS_CUM) + (size_t)bh * SEQ;
            bf16_t* O = (bf16_t*)(ws + WS_MERGED) + (size_t)b * SEQ * 1024 + h * 64;
            attn_unit<64, true, false>(F.lds, Q, 768, K, 768, Vt, SEQ, cum, O, 1024, qb * 256, 4 * (qb + 1), true, nullptr, F.wid, (const float*)(ws + WS_KN2) + bh * 128);
        } else mem_attn_unit(F, 0, u - 768);
    }
    while (conv_pull(F, 0, 16)) {}
}
DI void phase_attn1(Frame& F, const Params& P) {
    F.lane = vlane(); F.tid = F.wid * 64 + F.lane;
    unsigned char* ws = F.ws;
    constexpr int NCONV = 256, NU = 768 + 256 + NCONV;
    for (;;) {
        const int uu = next_unit(F, 1);
        if (uu >= NU) break;
        if (uu % 5 == 4) { conv_pull(F, 1, CONV_A1); continue; }
        const int u = 4 * (uu / 5) + uu % 5;
        if (u < 768) {
            const int qb = 31 - u / 24, bh = u % 24, b = bh / 12, h = bh % 12;
            const bf16_t* Q = (const bf16_t*)(ws + WS_Q) + (size_t)b * SEQ * 1152 + h * 96;
            const bf16_t* K = (const bf16_t*)(ws + WS_K) + (size_t)b * SEQ * 1152 + h * 96;
            const bf16_t* Vt = (const bf16_t*)(ws + WS_VT) + (size_t)(b * 768 + h * 64) * SEQ;
            bf16_t* O = (bf16_t*)(ws + WS_MERGED) + (size_t)b * SEQ * 1024 + h * 64;
            attn_unit_pipe<96, true>(F.lds, Q, 1152, K, 1152, Vt, SEQ, O, 1024, qb * 256, 4 * (qb + 1), KP->pos + (size_t)b * SEQ, F.wid);
        } else mem_attn_unit(F, 1, u - 768);
    }
    while (conv_pull(F, 1, 16)) {}
}

DI void phase_outproj(Frame& F, const float* X, const bf16_t* Wt) {
    F.lane = vlane(); F.tid = F.wid * 64 + F.lane;
    unsigned char* ws = F.ws;
    pg8::Gemm g{(const bf16_t*)(ws + WS_MERGED), Wt, 1024}; pg8::StaticOrder S; S.init(T, 1024, 1024, F.G, F.bid);
    EpiResF32 E{(float*)(ws + WS_Y), X};
    pg8::gemm_phase<EpiResF32, pg8::StaticOrder, false>(F.lds, g, S, E, F.wid);
}


DI void phase_ln_router(Frame& F, const Params& P, int l) {
    F.lane = vlane(); F.tid = F.wid * 64 + F.lane;
    unsigned char* ws = F.ws;
    LAS float* wt = (LAS float*)F.lds;
    const f32x4* wr4 = (const f32x4*)((const float*)(ws + WS_WRT) + (size_t)l * 32 * 1024);
    LAS int* pairs = (LAS int*)(F.lds + LDS_CTL + 1024);
    LAS int* lcnt = (LAS int*)(F.lds + LDS_CTL + 3072); LAS int* gbase = lcnt + 32;
    __syncthreads();
    for (int i = F.tid; i < 1024 * 32 / 4; i += NTHREADS) ((LAS f32x4*)wt)[i] = wr4[i];
    if (F.tid < 32) lcnt[F.tid] = 0;
    __syncthreads();
    const float* g = KP->ln_g + (size_t)(l * 2 + 0) * DM; const float* bt = KP->ln_b + (size_t)(l * 2 + 0) * DM;
    const float* br = KP->moe_b_r + l * 32;
    const float* Y = (const float*)(ws + WS_Y);
    bf16_t* X1B = (bf16_t*)(ws + WS_X1B);
    int* PE = (int*)(ws + WS_PE); int* PPOS = (int*)(ws + WS_PPOS); float* GATE = (float*)(ws + WS_GATE); int* TOKOF = (int*)(ws + WS_TOKOF);
    unsigned* cnt = F.ctl + CW_CNT + l * 32 * 64;
    const int gw = F.bid * 8 + F.wid, NGW = F.G * 8;
    int it = 0;
    f32x4 vnx[4];
    if (gw < T) {
#pragma unroll
        for (int j = 0; j < 4; ++j) vnx[j] = *((const f32x4*)(Y + (size_t)gw * DM) + F.lane + 64 * j);
    }
    for (int row = gw; row < T; row += NGW, ++it) {
        f32x4 v[4]; float s = 0.f;
#pragma unroll
        for (int j = 0; j < 4; ++j) { v[j] = vnx[j]; s += (v[j][0] + v[j][1]) + (v[j][2] + v[j][3]); }
        if (row + NGW < T) {
#pragma unroll
            for (int j = 0; j < 4; ++j) vnx[j] = *((const f32x4*)(Y + (size_t)(row + NGW) * DM) + F.lane + 64 * j);
        }
        const float mean = wave_sum(s) * (1.f / DM); float s2 = 0.f;
#pragma unroll
        for (int j = 0; j < 4; ++j) { v[j] = v[j] - mean; s2 += (v[j][0] * v[j][0] + v[j][1] * v[j][1]) + (v[j][2] * v[j][2] + v[j][3] * v[j][3]); }
        const float rstd = 1.0f / sqrtf(wave_sum(s2) * (1.f / DM) + LN_EPS);
#pragma unroll
        for (int j = 0; j < 4; ++j) {
            const f32x4 gg = *((const f32x4*)g + F.lane + 64 * j), bb = *((const f32x4*)bt + F.lane + 64 * j);
            v[j] = v[j] * rstd * gg + bb;
            *((u32x2*)(X1B + (size_t)row * DM) + F.lane + 64 * j) = (u32x2){cvtpk(v[j][0], v[j][1]), cvtpk(v[j][2], v[j][3])};
        }
        float part[16];
        f32x4 wc[4], wc2[4], wn[4], wn2[4];
#pragma unroll
        for (int j = 0; j < 4; ++j) { wc[j] = *((const LAS f32x4*)(wt) + F.lane + 64 * j); wc2[j] = *((const LAS f32x4*)(wt + 16 * 1024) + F.lane + 64 * j); }
#pragma unroll
        for (int i = 0; i < 16; ++i) {
            if (i + 1 < 16) {
#pragma unroll
                for (int j = 0; j < 4; ++j) { wn[j] = *((const LAS f32x4*)(wt + (i + 1) * 1024) + F.lane + 64 * j); wn2[j] = *((const LAS f32x4*)(wt + (i + 17) * 1024) + F.lane + 64 * j); }
            }
            asm volatile("" ::: "memory");
            float a = 0.f, b = 0.f;
#pragma unroll
            for (int j = 0; j < 4; ++j) {
                a += (v[j][0] * wc[j][0] + v[j][1] * wc[j][1]) + (v[j][2] * wc[j][2] + v[j][3] * wc[j][3]);
                b += (v[j][0] * wc2[j][0] + v[j][1] * wc2[j][1]) + (v[j][2] * wc2[j][2] + v[j][3] * wc2[j][3]);
            }
            const auto rr = __builtin_amdgcn_permlane32_swap(__float_as_uint(a), __float_as_uint(b), false, false);
            part[i] = __uint_as_float(rr[0]) + __uint_as_float(rr[1]);
#pragma unroll
            for (int j = 0; j < 4; ++j) { wc[j] = wn[j]; wc2[j] = wn2[j]; }
        }
#pragma unroll
        for (int i = 0; i < 8; ++i) {
            const auto rr = __builtin_amdgcn_permlane16_swap(__float_as_uint(part[i]), __float_as_uint(part[i + 8]), false, false);
            part[i] = __uint_as_float(rr[0]) + __uint_as_float(rr[1]);
        }
#pragma unroll
        for (int i = 0; i < 4; ++i) { const bool up = (F.lane & 8) != 0; const float keep = up ? part[i + 4] : part[i], send = up ? part[i] : part[i + 4]; part[i] = keep + __shfl_xor(send, 8); }
#pragma unroll
        for (int i = 0; i < 2; ++i) { const bool up = (F.lane & 4) != 0; const float keep = up ? part[i + 2] : part[i], send = up ? part[i] : part[i + 2]; part[i] = keep + __shfl_xor(send, 4); }
        { const bool up = (F.lane & 2) != 0; const float keep = up ? part[1] : part[0], send = up ? part[0] : part[1]; part[0] = keep + __shfl_xor(send, 2); }
        float logit = part[0] + __shfl_xor(part[0], 1);
        const int myexp = F.lane >> 1;
        logit += br[myexp];
        int rank = 0;
#pragma unroll
        for (int e = 0; e < 32; ++e) {
            const float ve = __uint_as_float((unsigned)__builtin_amdgcn_readlane((int)__float_as_uint(logit), 2 * e));
            rank += (ve > logit || (ve == logit && e < myexp)) ? 1 : 0;
        }
        float tv[4]; int te[4];
#pragma unroll
        for (int k = 0; k < 4; ++k) {
            const unsigned long long bal = __ballot(rank == k);
            const int ln = __ffsll((long long)bal) - 1;
            te[k] = ln >> 1; tv[k] = __uint_as_float((unsigned)__builtin_amdgcn_readlane((int)__float_as_uint(logit), ln));
        }
        const float e1 = __expf(tv[1] - tv[0]), e2 = __expf(tv[2] - tv[0]), e3 = __expf(tv[3] - tv[0]);
        const float rs = 1.0f / (1.0f + e1 + e2 + e3);
        if (F.lane < 4) {
            const int k = F.lane;
            const int e = k == 0 ? te[0] : k == 1 ? te[1] : k == 2 ? te[2] : te[3];
            const float gt = (k == 0 ? 1.0f : k == 1 ? e1 : k == 2 ? e2 : e3) * rs;
            const int rk = __hip_atomic_fetch_add(lcnt + e, 1, __ATOMIC_RELAXED, __HIP_MEMORY_SCOPE_WORKGROUP);
            PE[row * 4 + k] = e; GATE[row * 4 + k] = gt; pairs[(F.wid * 16 + (it & 15)) * 4 + k] = e | (rk << 8);
        }
    }
    __syncthreads();
    if (F.tid < 32) { const int c = lcnt[F.tid]; gbase[F.tid] = c ? (int)atomicAdd(cnt + F.tid * 64, (unsigned)c) : 0; }
    __syncthreads();
    it = 0;
    for (int row = gw; row < T; row += NGW, ++it) {
        if (F.lane < 4) {
            const int pr = pairs[(F.wid * 16 + (it & 15)) * 4 + F.lane], e = pr & 255, p = gbase[e] + (pr >> 8);
            PPOS[row * 4 + F.lane] = p; TOKOF[(size_t)e * T + p] = row;
        }
    }
}

DI void moe_tables(Frame& F, int l, LAS int* tstart, LAS int* soff) {
    __syncthreads();
    if (F.tid == 0) {
        int ts = 0;
        for (int e = 0; e < 32; ++e) {
            const int c = (int)__hip_atomic_load(F.ctl + CW_CNT + (l * 32 + e) * 64, __ATOMIC_RELAXED, __HIP_MEMORY_SCOPE_AGENT);
            tstart[e] = ts; soff[e] = ts * 256; tstart[80 + e] = c; ts += (c + 255) >> 8;
        }
        tstart[32] = ts; soff[32] = ts * 256;
    }
    __syncthreads();
}
DI void phase_moe_gu(Frame& F, const Params& P, int l) {
    F.lane = vlane(); F.tid = F.wid * 64 + F.lane;
    unsigned char* ws = F.ws;
    LAS int* tstart = (LAS int*)(F.lds + LDS_CTL + 64); LAS int* soff = tstart + 40;
    moe_tables(F, l, tstart, soff);
    pg8::Gemm g{(const bf16_t*)(ws + WS_X1B), (const bf16_t*)(ws + WS_W_GU) + (size_t)l * 32 * 2048 * 1024, 1024};
    LAS int* ulist = (LAS int*)(F.lds + LDS_CTL + 3328);
    MoeOrder::build(F, tstart, 8, ulist);
    MoeOrder S{tstart, 3, true, (const int*)(ws + WS_TOKOF), (const LAS int*)(F.lds + LDS_CTL + 1024), ulist};
    EpiGU E{(bf16_t*)(ws + WS_H), KP->moe_b_gu + (size_t)l * 32 * 2048};
    pg8::gemm_phase<EpiGU, MoeOrder, true>(F.lds, g, S, E, F.wid);
    if (l == 0) { const int rem = (tstart[32] * 8) % F.G; if (rem && F.bid >= rem) conv_pull(F, 1, CONV_GU); }
}
DI void phase_moe_dn(Frame& F, const Params& P, int l) {
    F.lane = vlane(); F.tid = F.wid * 64 + F.lane;
    unsigned char* ws = F.ws;
    LAS int* tstart = (LAS int*)(F.lds + LDS_CTL + 64); LAS int* soff = tstart + 40;
    moe_tables(F, l, tstart, soff);
    pg8::Gemm g{(const bf16_t*)(ws + WS_H), (const bf16_t*)(ws + WS_W_DN) + (size_t)l * 32 * 1024 * 1024, 1024};
    LAS int* ulist = (LAS int*)(F.lds + LDS_CTL + 3328);
    MoeOrder::build(F, tstart, 4, ulist);
    MoeOrder S{tstart, 2, false, nullptr, nullptr, ulist};
    EpiDN E{(bf16_t*)(ws + WS_YE), KP->moe_b_dn + (size_t)l * 32 * 1024};
    pg8::gemm_phase<EpiDN, MoeOrder, true>(F.lds, g, S, E, F.wid);
    if (l == 0) { const int rem = (tstart[32] * 4) % F.G; if (rem && F.bid >= rem) conv_pull(F, 1, CONV_DN); }
}


DI void phase_combine(Frame& F, const Params& P, int l, float* outf, bf16_t* outb) {
    F.lane = vlane(); F.tid = F.wid * 64 + F.lane;
    unsigned char* ws = F.ws;
    LAS int* tstart = (LAS int*)(F.lds + LDS_CTL + 64); LAS int* soff = tstart + 40;
    moe_tables(F, l, tstart, soff);
    const float* g = KP->ln_g + (size_t)(l * 2 + 1) * DM; const float* bt = KP->ln_b + (size_t)(l * 2 + 1) * DM;
    const float* X1 = (const float*)(ws + WS_Y); const bf16_t* YE = (const bf16_t*)(ws + WS_YE);
    const float* g1 = KP->ln_g + (size_t)(l * 2 + 0) * DM; const float* b1 = KP->ln_b + (size_t)(l * 2 + 0) * DM;
    const int* PE = (const int*)(ws + WS_PE); const int* PPOS = (const int*)(ws + WS_PPOS); const float* GATE = (const float*)(ws + WS_GATE);
    const int gw = F.bid * 8 + F.wid, NGW = F.G * 8;
    typedef int i32x4 __attribute__((ext_vector_type(4)));
    i32x4 ie, ip; f32x4 ig;
    f32x4 xn[4]; u32x2 yn[4][4]; f32x4 gn;
#define CB_LOADIDX(r) do { ie = *(const i32x4*)(PE + (size_t)(r) * 4); ip = *(const i32x4*)(PPOS + (size_t)(r) * 4); ig = *(const f32x4*)(GATE + (size_t)(r) * 4); } while (0)
#define CB_LOADDATA(r) do { gn = ig; \
        _Pragma("unroll") for (int j = 0; j < 4; ++j) xn[j] = *((const f32x4*)(X1 + (size_t)(r) * DM) + F.lane + 64 * j); \
        _Pragma("unroll") for (int k = 0; k < 4; ++k) { const int slot = soff[ie[k]] + ip[k]; const u32x2* yr = (const u32x2*)(YE + (size_t)slot * 1024) + F.lane; \
            _Pragma("unroll") for (int j = 0; j < 4; ++j) yn[k][j] = yr[64 * j]; } } while (0)
    if (gw < T) { CB_LOADIDX(gw); CB_LOADDATA(gw); if (gw + NGW < T) CB_LOADIDX(gw + NGW); }
    for (int row = gw; row < T; row += NGW) {
        f32x4 v[4]; u32x2 yc[4][4]; f32x4 gc = gn;
        {
            float s0 = 0.f;
#pragma unroll
            for (int j = 0; j < 4; ++j) { v[j] = xn[j]; s0 += (v[j][0] + v[j][1]) + (v[j][2] + v[j][3]); }
            const float mean0 = wave_sum(s0) * (1.f / DM); float q0 = 0.f;
#pragma unroll
            for (int j = 0; j < 4; ++j) { v[j] = v[j] - mean0; q0 += (v[j][0] * v[j][0] + v[j][1] * v[j][1]) + (v[j][2] * v[j][2] + v[j][3] * v[j][3]); }
            const float rstd0 = 1.0f / sqrtf(wave_sum(q0) * (1.f / DM) + LN_EPS);
#pragma unroll
            for (int j = 0; j < 4; ++j) {
                const f32x4 gg = *((const f32x4*)g1 + F.lane + 64 * j), bb = *((const f32x4*)b1 + F.lane + 64 * j);
                v[j] = (v[j] * rstd0 * gg + bb) * ALPHA;
            }
        }
#pragma unroll
        for (int k = 0; k < 4; ++k)
#pragma unroll
            for (int j = 0; j < 4; ++j) yc[k][j] = yn[k][j];
        if (row + NGW < T) { CB_LOADDATA(row + NGW); if (row + 2 * NGW < T) CB_LOADIDX(row + 2 * NGW); }
#pragma unroll
        for (int k = 0; k < 4; ++k) {
            const float gt = gc[k];
#pragma unroll
            for (int j = 0; j < 4; ++j) {
                const u32x2 w = yc[k][j];
                v[j][0] += gt * __uint_as_float(w.x << 16); v[j][1] += gt * __uint_as_float(w.x & 0xffff0000u);
                v[j][2] += gt * __uint_as_float(w.y << 16); v[j][3] += gt * __uint_as_float(w.y & 0xffff0000u);
            }
        }
        float s = 0.f;
#pragma unroll
        for (int j = 0; j < 4; ++j) s += (v[j][0] + v[j][1]) + (v[j][2] + v[j][3]);
        const float mean = wave_sum(s) * (1.f / DM); float s2 = 0.f;
#pragma unroll
        for (int j = 0; j < 4; ++j) { v[j] = v[j] - mean; s2 += (v[j][0] * v[j][0] + v[j][1] * v[j][1]) + (v[j][2] * v[j][2] + v[j][3] * v[j][3]); }
        const float rstd = 1.0f / sqrtf(wave_sum(s2) * (1.f / DM) + LN_EPS);
#pragma unroll
        for (int j = 0; j < 4; ++j) {
            const f32x4 gg = *((const f32x4*)g + F.lane + 64 * j), bb = *((const f32x4*)bt + F.lane + 64 * j);
            v[j] = v[j] * rstd * gg + bb;
            *((f32x4*)(outf + (size_t)row * DM) + F.lane + 64 * j) = v[j];
            if (outb) *((u32x2*)(outb + (size_t)row * DM) + F.lane + 64 * j) = (u32x2){cvtpk(v[j][0], v[j][1]), cvtpk(v[j][2], v[j][3])};
        }
    }
#undef CB_LOADIDX
#undef CB_LOADDATA
}

DI void phase_lat(Frame& F) {
    F.lane = vlane(); F.tid = F.wid * 64 + F.lane;
    unsigned char* ws = F.ws;
    pg8::Gemm g{(const bf16_t*)(ws + WS_XB), (const bf16_t*)(ws + WS_W_BIN), 1024}; pg8::StaticOrder S; S.init(T, 1024, 1024, F.G, F.bid);
    EpiLat E{(float*)(ws + WS_LAT), 928};
    pg8::gemm_phase<EpiLat, pg8::StaticOrder, false>(F.lds, g, S, E, F.wid);
}

DI void phase_latrows(Frame& F, const Params& P) {
    F.lane = vlane(); F.tid = F.wid * 64 + F.lane;
    unsigned char* ws = F.ws;
    const float* LAT = (const float*)(ws + WS_LAT);
    bf16_t* CKV = (bf16_t*)(ws + WS_CKV); bf16_t* CQ = (bf16_t*)(ws + WS_CQ); bf16_t* MQ = (bf16_t*)(ws + WS_MQ); bf16_t* Kb = (bf16_t*)(ws + WS_K);
    const int gw = F.bid * 8 + F.wid, NGW = F.G * 8;
    for (int row = gw; row < T; row += NGW) {
        const float* lr = LAT + (size_t)row * 1024;
        {
            const f32x4 v = *((const f32x4*)lr + F.lane);
            const float ss = wave_sum((v[0] * v[0] + v[1] * v[1]) + (v[2] * v[2] + v[3] * v[3]));
            const float rs = 1.0f / sqrtf(ss * (1.f / 256.f) + RMS_EPS);
            const f32x4 gg = *((const f32x4*)KP->kv_g + F.lane);
            const f32x4 o = v * rs * gg;
            *((u32x2*)(CKV + (size_t)row * 256) + F.lane) = (u32x2){cvtpk(o[0], o[1]), cvtpk(o[2], o[3])};
        }
        {
            const f32x4 v0 = *((const f32x4*)(lr + 288) + F.lane);
            f32x4 v1 = (f32x4){0.f, 0.f, 0.f, 0.f};
            if (F.lane < 32) v1 = *((const f32x4*)(lr + 288 + 256) + F.lane);
            const float ss = wave_sum((v0[0] * v0[0] + v0[1] * v0[1]) + (v0[2] * v0[2] + v0[3] * v0[3]) + (v1[0] * v1[0] + v1[1] * v1[1]) + (v1[2] * v1[2] + v1[3] * v1[3]));
            const float rs = 1.0f / sqrtf(ss * (1.f / 384.f) + RMS_EPS);
            const f32x4 g0 = *((const f32x4*)KP->b_g_q + F.lane);
            const f32x4 o0 = v0 * rs * g0;
            *((u32x2*)(CQ + (size_t)row * 384) + F.lane) = (u32x2){cvtpk(o0[0], o0[1]), cvtpk(o0[2], o0[3])};
            if (F.lane < 32) {
                const f32x4 g1 = *((const f32x4*)(KP->b_g_q + 256) + F.lane);
                const f32x4 o1 = v1 * rs * g1;
                *((u32x2*)(CQ + (size_t)row * 384 + 256) + F.lane) = (u32x2){cvtpk(o1[0], o1[1]), cvtpk(o1[2], o1[3])};
            }
        }
        {
            const f32x4 v = *((const f32x4*)(lr + 672) + F.lane) * (0.125f * LOG2E);
            *((u32x2*)(MQ + (size_t)row * 256) + F.lane) = (u32x2){cvtpk(v[0], v[1]), cvtpk(v[2], v[3])};
        }
        if (F.lane < 16) {
            const int i = F.lane;
            const float p = (float)KP->pos[row];
            const float inv = exp2f(-(float)i * (13.287712379549449f / 16.0f));
            float sn, cs; sincos_cw(p * inv, sn, cs);
            const float x1 = lr[256 + i], x2 = lr[256 + 16 + i];
            const unsigned short o1 = (unsigned short)(cvtpk(x1 * cs - x2 * sn, 0.f) & 0xffffu), o2 = (unsigned short)(cvtpk(x1 * sn + x2 * cs, 0.f) & 0xffffu);
#pragma unroll
            for (int h = 0; h < NH; ++h) { Kb[(size_t)row * 1152 + h * 96 + 64 + i] = o1; Kb[(size_t)row * 1152 + h * 96 + 80 + i] = o2; }
        }
    }
}
#ifndef UPSEL
#define UPSEL 7
#endif
struct RouteK1 { unsigned char* ws; DI Dst operator()(const pg8::Unit& u) const { return Dst{(bf16_t*)(ws + WS_K), 1152, u.pm * 256, u.pn * 384, 256, 1.0f, true}; } };
struct RouteQ1 { unsigned char* ws; DI Dst operator()(const pg8::Unit& u) const { const int nv = 1152 - u.pn * 256; return Dst{(bf16_t*)(ws + WS_Q), 1152, u.pm * 256, u.pn * 256, nv < 256 ? nv : 256, 0.10206207261596577f * LOG2E, false}; } };
DI void phase_up1(Frame& F) {
    F.lane = vlane(); F.tid = F.wid * 64 + F.lane;
    unsigned char* ws = F.ws;
    const bf16_t* ckv = (const bf16_t*)(ws + WS_CKV); const bf16_t* cq = (const bf16_t*)(ws + WS_CQ);
    const bf16_t* wukv = (const bf16_t*)(ws + WS_W_UKV); const bf16_t* wuq = (const bf16_t*)(ws + WS_W_UQ);
#if (UPSEL & 1)
    {
        pg8::Gemm g{cq, wuq, 384}; pg8::StaticOrder S; S.init(T, 1280, 384, F.G, F.bid);
        EpiBf16R<RouteQ1> E{RouteQ1{ws}};
        pg8::gemm_phase<EpiBf16R<RouteQ1>, pg8::StaticOrder, true>(F.lds, g, S, E, F.wid);
    }
#endif
#if (UPSEL & 2)
    {
        pg8::Gemm g{ckv, wukv, 256}; pg8::StaticOrder S; S.init(T, 768, 256, F.G, F.G - 1 - F.bid);
        EpiBf16R<RouteK1> E{RouteK1{ws}};
        pg8::gemm_phase<EpiBf16R<RouteK1>, pg8::StaticOrder, true>(F.lds, g, S, E, F.wid);
    }
#endif
#if (UPSEL & 4)
    {
        pg8::Gemm g{wukv + (size_t)768 * 256, ckv, 256}; pg8::StaticOrder S; S.init(768, T, 256, F.G, F.G - 1 - F.bid);
        EpiBf16R<RouteVT> E{RouteVT{ws}};
        pg8::gemm_phase<EpiBf16R<RouteVT>, pg8::StaticOrder, true>(F.lds, g, S, E, F.wid);
    }
#endif
}


__global__ void __launch_bounds__(NTHREADS) mega_fwd(Params P) {
    extern __shared__ __attribute__((aligned(16))) unsigned char lds_raw[];
    Frame F;
    F.lds = (LAS unsigned char*)lds_raw; F.ws = KP->ws; F.ctl = (unsigned*)(KP->ws + WS_CTL);
    F.wid = __builtin_amdgcn_readfirstlane((int)threadIdx.x >> 6); F.lane = vlane(); F.tid = F.wid * 64 + F.lane; F.G = gridDim.x; F.bid = blockIdx.x;
    const int lo = KP->ph_lo, hi = KP->ph_hi;
    { volatile LAS unsigned* st0 = (volatile LAS unsigned*)(F.lds + LDS_CTL + 512); if (F.tid < 2) st0[F.tid] = 0u; }
    __syncthreads();
    XcdBarrier bar = xcd_barrier_post(F.ctl + CW_BAR, (volatile LAS unsigned*)(F.lds + LDS_CTL + 512), F.wid);
#ifndef PHMASK
#define PHMASK 0x1ffff
#endif
#define IN(k) (((PHMASK >> (k)) & 1) && lo <= (k) && (k) < hi)
#define SEAM(k) do { if (IN(k) && IN((k) + 1)) { if (KP->use_grid_sync) { if ((k) == 0) cg::this_grid().sync(); else xcd_barrier(bar); } } } while (0)
    unsigned char* ws = KP->ws;
    if (IN(0)) { phase_prologue(F, P);
    }
    SEAM(0);
    if (IN(1)) { phase_proj0(F, P);
        if (KP->use_grid_sync) xcd_barrier(bar); phase_scan_knorm(F); }
    SEAM(1);
    if (IN(2)) { phase_attn0(F, P);
    }
    SEAM(2);
    if (IN(3)) { phase_outproj(F, KP->x, (const bf16_t*)(ws + WS_W_AOUT));
    }
    SEAM(3);
    if (IN(4)) phase_ln_router(F, P, 0);
    SEAM(4);
    if (IN(5)) phase_moe_gu(F, P, 0);
    SEAM(5);
    if (IN(6)) phase_moe_dn(F, P, 0);
    SEAM(6);
    if (IN(7)) phase_combine(F, P, 0, (float*)(ws + WS_X2), (bf16_t*)(ws + WS_XB));
    SEAM(7);
    if (IN(8)) phase_lat(F);
    SEAM(8);
    if (IN(9)) phase_latrows(F, P);
    SEAM(9);
    if (IN(10)) { phase_up1(F);
    }
    SEAM(10);
    if (IN(11)) { phase_attn1(F, P);
    }
    SEAM(11);
    if (IN(12)) phase_outproj(F, (const float*)(ws + WS_X2), (const bf16_t*)(ws + WS_W_BOUT));
    SEAM(12);
    if (IN(13)) phase_ln_router(F, P, 1);
    SEAM(13);
    if (IN(14)) { phase_moe_gu(F, P, 1);
    }
    SEAM(14);
    if (IN(15)) { phase_moe_dn(F, P, 1);
    }
    SEAM(15);
    if (IN(16)) { phase_combine(F, P, 1, KP->out, nullptr);
    }
#undef IN
#undef SEAM
}

constexpr int N_PHASES = 17;
#ifndef MK_N_LAUNCHES
#define MK_N_LAUNCHES 1
#endif

extern "C" void kernel_launch(void* const* d_in, const int* in_sizes, int n_in, void* d_out, int out_size, void* d_ws, size_t ws_size, hipStream_t stream) {
    static int grid = 0;
    if (grid == 0) {
        if (n_in != 22 || ws_size < WS_END) { fprintf(stderr, "kernel_launch: need 22 inputs and %zu bytes of workspace (got %d, %zu)\n", (size_t)WS_END, n_in, ws_size); grid = -1; return; }
        int dev = 0, cus = 0, per_cu = 0;
        hipGetDevice(&dev);
        hipDeviceGetAttribute(&cus, hipDeviceAttributeMultiprocessorCount, dev);
        if (hipFuncSetAttribute((const void*)mega_fwd, hipFuncAttributeMaxDynamicSharedMemorySize, LDS_BYTES) != hipSuccess) fprintf(stderr, "kernel_launch: hipFuncSetAttribute failed\n");
        if (hipOccupancyMaxActiveBlocksPerMultiprocessor(&per_cu, (const void*)mega_fwd, NTHREADS, LDS_BYTES) != hipSuccess || per_cu < 1) { fprintf(stderr, "kernel_launch: occupancy query failed (%d)\n", per_cu); per_cu = 1; }
        (void)hipGetLastError();
        grid = cus * (per_cu > 1 ? 1 : per_cu);
        if (grid <= 0) grid = 256;
    }
    if (grid < 0) return;
    hipMemsetAsync((char*)d_ws + WS_CTL, 0, CTL_BYTES, stream);
    Params p{};
    p.x = (const float*)d_in[0]; p.mem = (const float*)d_in[1]; p.pos = (const int*)d_in[2];
    p.a_w_in = (const float*)d_in[3]; p.a_b_f = (const float*)d_in[4]; p.a_w_out = (const float*)d_in[5];
    p.b_w_in = (const float*)d_in[6]; p.b_g_q = (const float*)d_in[7]; p.b_w_uq = (const float*)d_in[8]; p.b_w_out = (const float*)d_in[9];
    p.kv_w_dkv = (const float*)d_in[10]; p.kv_g = (const float*)d_in[11]; p.kv_w_ukv = (const float*)d_in[12]; p.mem_w_kv = (const float*)d_in[13];
    p.ln_g = (const float*)d_in[14]; p.ln_b = (const float*)d_in[15]; p.moe_w_r = (const float*)d_in[16]; p.moe_b_r = (const float*)d_in[17];
    p.moe_w_gu = (const float*)d_in[18]; p.moe_b_gu = (const float*)d_in[19]; p.moe_w_dn = (const float*)d_in[20]; p.moe_b_dn = (const float*)d_in[21];
    p.out = (float*)d_out; p.ws = (unsigned char*)d_ws;
    if (MK_N_LAUNCHES == 1) {
        p.ph_lo = 0; p.ph_hi = N_PHASES; p.use_grid_sync = 1;
        void* args[] = {&p};
        hipError_t e = hipLaunchCooperativeKernel((const void*)mega_fwd, dim3(grid), dim3(NTHREADS), args, LDS_BYTES, stream);
        if (e != hipSuccess) fprintf(stderr, "kernel_launch: cooperative launch failed: %s (grid %d)\n", hipGetErrorString(e), grid);
    } else {
        for (int ph = 0; ph < N_PHASES; ++ph) {
            p.ph_lo = ph; p.ph_hi = ph + 1; p.use_grid_sync = 0;
            hipLaunchKernelGGL(mega_fwd, dim3(grid), dim3(NTHREADS), LDS_BYTES, stream, p);
        }
    }
}
```

```cpp
#include <hip/hip_runtime.h>
#include <hip/hip_cooperative_groups.h>
#include <cstdio>
#include <cstdint>
#include <cmath>
namespace cg = cooperative_groups;

#define DI __device__ __forceinline__
#define LAS __attribute__((address_space(3)))
typedef unsigned short bf16_t;
typedef short bf16x8 __attribute__((ext_vector_type(8)));
typedef float f32x4 __attribute__((ext_vector_type(4)));
typedef float f32x2 __attribute__((ext_vector_type(2)));
typedef float f32x16 __attribute__((ext_vector_type(16)));
typedef unsigned u32x4 __attribute__((ext_vector_type(4)));
typedef unsigned u32x2 __attribute__((ext_vector_type(2)));
typedef __bf16 bf16x2_t __attribute__((ext_vector_type(2)));

constexpr int NB = 2, SEQ = 8192, T = NB * SEQ, DM = 1024;
constexpr int NH = 12, NMEM = 256;
constexpr int FOX_IN = 2572;
constexpr int NE = 32;
constexpr float LOG2E = 1.4426950408889634f;
constexpr float ALPHA = 1.4142135623730951f;
constexpr float LN_EPS = 1e-5f, RMS_EPS = 1e-6f;
constexpr int NTHREADS = 512;
constexpr int LDS_BYTES = 131072 + 4096;
constexpr int LDS_CTL = 131072;
constexpr int SLOT_ROWS = 65536 + NE * 256;

constexpr size_t al256(size_t x) { return (x + 255) & ~(size_t)255; }
constexpr size_t WS_CTL = 0, CTL_BYTES = 65536;
constexpr size_t WS_W_AIN = al256(WS_CTL + CTL_BYTES);
constexpr size_t WS_W_AOUT = al256(WS_W_AIN + (size_t)2560 * 1024 * 2);
constexpr size_t WS_W_BIN = al256(WS_W_AOUT + (size_t)1024 * 1024 * 2);
constexpr size_t WS_W_UQ = al256(WS_W_BIN + (size_t)1024 * 1024 * 2);
constexpr size_t WS_W_UKV = al256(WS_W_UQ + (size_t)1280 * 384 * 2);
constexpr size_t WS_W_BOUT = al256(WS_W_UKV + (size_t)1536 * 256 * 2);
constexpr size_t WS_W_MKV = al256(WS_W_BOUT + (size_t)1024 * 1024 * 2);
constexpr size_t WS_W_GU = al256(WS_W_MKV + (size_t)2 * 512 * 1024 * 2);
constexpr size_t WS_W_DN = al256(WS_W_GU + (size_t)2 * 32 * 2048 * 1024 * 2);
constexpr size_t WS_XB = al256(WS_W_DN + (size_t)2 * 32 * 1024 * 1024 * 2);
constexpr size_t WS_MEMB = al256(WS_XB + (size_t)T * 1024 * 2);
constexpr size_t WS_LOGF = al256(WS_MEMB + (size_t)512 * 1024 * 2);
constexpr size_t WS_CUM = al256(WS_LOGF + (size_t)24 * 8192 * 4);
constexpr size_t WS_Q = al256(WS_CUM + (size_t)24 * 8192 * 4);
constexpr size_t WS_K = al256(WS_Q + (size_t)T * 1152 * 2);
constexpr size_t WS_VT = al256(WS_K + (size_t)T * 1152 * 2);
constexpr size_t WS_MQ = al256(WS_VT + (size_t)1536 * 8192 * 2);
constexpr size_t WS_MK = al256(WS_MQ + (size_t)T * 256 * 2);
constexpr size_t WS_MVT = al256(WS_MK + (size_t)2 * 512 * 256 * 2);
constexpr size_t WS_MERGED = al256(WS_MVT + (size_t)2 * 2 * 256 * 256 * 2);
constexpr size_t WS_Y = al256(WS_MERGED + (size_t)T * 1024 * 2);
constexpr size_t WS_X1 = al256(WS_Y + (size_t)T * 1024 * 4);
constexpr size_t WS_X1B = al256(WS_X1 + (size_t)T * 1024 * 4);
constexpr size_t WS_PE = al256(WS_X1B + (size_t)T * 1024 * 2);
constexpr size_t WS_PPOS = al256(WS_PE + (size_t)T * 4 * 4);
constexpr size_t WS_GATE = al256(WS_PPOS + (size_t)T * 4 * 4);
constexpr size_t WS_TOKOF = al256(WS_GATE + (size_t)T * 4 * 4);
constexpr size_t WS_H = al256(WS_TOKOF + (size_t)NE * T * 4);
constexpr size_t WS_YE = al256(WS_H + (size_t)SLOT_ROWS * 1024 * 2);
constexpr size_t WS_LAT = al256(WS_YE + (size_t)SLOT_ROWS * 1024 * 2);
constexpr size_t WS_CKV = al256(WS_LAT + (size_t)T * 1024 * 4);
constexpr size_t WS_CQ = al256(WS_CKV + (size_t)T * 256 * 2);
constexpr size_t WS_X2 = al256(WS_CQ + (size_t)T * 384 * 2);
constexpr size_t WS_KN2 = al256(WS_X2 + (size_t)T * 1024 * 4);
constexpr size_t WS_WRT = al256(WS_KN2 + (size_t)24 * 128 * 4);
constexpr size_t WS_END = al256(WS_WRT + (size_t)2 * 32 * 1024 * 4);
constexpr int CW_CNT = 8192;
constexpr int CW_WORK = 256;
constexpr int CW_BAR = 4096;

struct Params {
    const float* x; const float* mem; const int* pos;
    const float *a_w_in, *a_b_f, *a_w_out, *b_w_in, *b_g_q, *b_w_uq, *b_w_out, *kv_w_dkv, *kv_g, *kv_w_ukv, *mem_w_kv, *ln_g, *ln_b;
    const float *moe_w_r, *moe_b_r, *moe_w_gu, *moe_b_gu, *moe_w_dn, *moe_b_dn;
    float* out; unsigned char* ws; int ph_lo, ph_hi; int use_grid_sync, pad;
};

#define KP ((const __attribute__((address_space(4))) Params*)__builtin_amdgcn_kernarg_segment_ptr())
DI unsigned cvtpk(float lo, float hi) { f32x2 v = {lo, hi}; bf16x2_t b = __builtin_convertvector(v, bf16x2_t); return __builtin_bit_cast(unsigned, b); }
DI float bf2f(unsigned short b) { return __uint_as_float(((unsigned)b) << 16); }
DI float wave_sum(float v) {
#pragma unroll
    for (int o = 1; o < 64; o <<= 1) v += __shfl_xor(v, o);
    return v;
}
DI float wave_max(float v) {
#pragma unroll
    for (int o = 1; o < 64; o <<= 1) v = fmaxf(v, __shfl_xor(v, o));
    return v;
}

DI void sincos_cw(float x, float& sn, float& cs) {
    int j = (int)(x * 1.27323954473516f); j = (j + 1) & ~1;
    const float y = (float)j;
    const float r = ((x - y * 0.78515625f) - y * 2.4187564849853515625e-4f) - y * 3.77489497744594108e-8f;
    const float z = r * r;
    const float sp = ((-1.9515295891e-4f * z + 8.3321608736e-3f) * z - 1.6666654611e-1f) * z * r + r;
    const float cp = ((2.443315711809948e-5f * z - 1.388731625493765e-3f) * z + 4.166664568298827e-2f) * z * z - 0.5f * z + 1.0f;
    const int q = (j >> 1) & 3;
    const float s0 = (q & 1) ? cp : sp, c0 = (q & 1) ? sp : cp;
    sn = (q & 2) ? -s0 : s0;
    cs = ((q + 1) & 2) ? -c0 : c0;
}
DI float fadd_s(float a, float b) { float r; asm("v_add_f32_e32 %0, %1, %2" : "=v"(r) : "v"(a), "v"(b)); return r; }
DI int vlane() { int l; asm volatile("v_mbcnt_lo_u32_b32 %0, -1, 0\n\tv_mbcnt_hi_u32_b32 %0, -1, %0" : "=v"(l)); return l; }
#define LDS_WAIT() asm volatile("s_waitcnt lgkmcnt(0)" ::: "memory")
#define VM_WAIT() asm volatile("s_waitcnt vmcnt(0)" ::: "memory")

#ifndef GEMM_TOKPF
#define GEMM_TOKPF 2
#endif
namespace pg8 {
constexpr int BM = 256, BK = 64, HALF = 128, HTB = HALF * BK * 2, STAGE_BYTES = 8 * HTB, NXCD = 8, WGM = 8;
DI int lds_byte(int r, int c) { const int st = (r >> 4) * 2 + (c >> 5), rr = r & 15, cc = c & 31, ob = rr * 64 + cc * 2; return st * 1024 + (ob ^ (((ob >> 9) & 1) << 5)); }
DI void stage_rc(int b, int& R, int& C) { const int st = b / 1024, sb = b % 1024, swz = sb ^ (((sb >> 9) & 1) << 5); R = (st >> 1) * 16 + swz / 64; C = (st & 1) * 32 + (swz % 64) / 2; }
DI int perm32(int rho) { const int n = rho >> 4, i = rho & 15; return 8 * (i >> 2) + 4 * n + (i & 3); }
struct Unit { int pm, pn; };
struct Gemm { const bf16_t* A; const bf16_t* Bt; int K; };
struct StaticOrder {
    int nM, nN, nwg, G, c, K2;
    DI void init(int M, int N, int K, int G_, int c_) { nM = M / BM; nN = N / BM; nwg = nM * nN; G = G_; c = c_; K2 = K * 2; }
    DI bool next(int i, Unit& u) const {
        const long L = (long)i * G + c; if (L >= nwg) return false;
        int wgid = (int)L; { const int q = nwg / NXCD, r = nwg % NXCD, xcd = wgid % NXCD, off = wgid / NXCD; wgid = (xcd < r ? xcd * (q + 1) : r * (q + 1) + (xcd - r) * q) + off; }
        const int nig = WGM * nN, gid = wgid / nig, fm = gid * WGM, gsz = (nM - fm) < WGM ? (nM - fm) : WGM;
        u.pm = fm + ((wgid % nig) % gsz); u.pn = (wgid % nig) / gsz; return true;
    }
    DI unsigned a_off(const Unit& u, int r) const { return (unsigned)(u.pm * BM + r) * (unsigned)K2; }
    DI unsigned a_off_pf(const Unit& u, int r, int) const { return a_off(u, r); }
    DI void prefetch(const Unit&, int, int, int) const {}
    DI void a_ready(const Unit&) const {}
    DI void done(const Unit&) const {}
};

template <class Epi, class Sched, bool ALIGN_EPI>
DI void gemm_phase(LAS unsigned char* lds, const Gemm g, const Sched& S, const Epi& E, const int wid) {
    const int lane = vlane(), tid = wid * 64 + lane, wr = wid >> 2, wc = wid & 3, fr = lane & 15, fq = lane >> 4;
    const int K = g.K, nt = K / BK;
    int RA[2]; unsigned cA2[2], voffB[2];
#pragma unroll
    for (int i = 0; i < 2; ++i) { int R, C; stage_rc(tid * 16 + i * 8192, R, C); const int Rb = Epi::PERM ? ((R & ~31) + perm32(R & 31)) : R;
        RA[i] = R; cA2[i] = (unsigned)C * 2u; voffB[i] = (unsigned)(Rb * K + C) * 2u; }
    const size_t kstep = (size_t)(BK * 2);
    const size_t hstep = (size_t)HALF * K * 2;
    const size_t tstep = 2 * hstep;
    const unsigned ldsw = (unsigned)wid * 1024u;
    const int aoff = lds_byte(wr * 64 + fr, fq * 8), boff = lds_byte(wc * 32 + fr, fq * 8);
#define PG8_SA(b, h) (((b) * 2 + (h)) * HTB)
#define PG8_SB(b, h) ((4 + (b) * 2 + (h)) * HTB)
#define PG8_STAGE_B(bufoff, gbase) do { _Pragma("unroll") for (int _i = 0; _i < 2; ++_i) \
        __builtin_amdgcn_global_load_lds((const unsigned*)((const char*)(gbase) + voffB[_i]), (LAS unsigned*)(lds + (bufoff) + ldsw + _i * 8192), 16, 0, 0); } while (0)
#define PG8_STAGE_A(bufoff, kbytes, uo) do { _Pragma("unroll") for (int _i = 0; _i < 2; ++_i) \
        __builtin_amdgcn_global_load_lds((const unsigned*)((const char*)g.A + (kbytes) + (uo)[_i]), (LAS unsigned*)(lds + (bufoff) + ldsw + _i * 8192), 16, 0, 0); } while (0)
#define PG8_STAGE_A2(bufoff, kbytes, h) do { _Pragma("unroll") for (int _i = 0; _i < 2; ++_i) \
        __builtin_amdgcn_global_load_lds((const unsigned*)((const char*)g.A + (kbytes) + (last ? uN[h][_i] : uC[h][_i])), (LAS unsigned*)(lds + (bufoff) + ldsw + _i * 8192), 16, 0, 0); } while (0)
#define PG8_LDA(dst, b, h) do { _Pragma("unroll") for (int m = 0; m < 4; ++m) _Pragma("unroll") for (int k = 0; k < 2; ++k) dst[m][k] = *(const LAS bf16x8*)(lds + PG8_SA(b, h) + aoff + m * 2048 + k * 1024); } while (0)
#define PG8_LDB(dst, b, h) do { _Pragma("unroll") for (int n = 0; n < 2; ++n) _Pragma("unroll") for (int k = 0; k < 2; ++k) dst[n][k] = *(const LAS bf16x8*)(lds + PG8_SB(b, h) + boff + n * 2048 + k * 1024); } while (0)
#define PG8_MMA(ai, bj, At, Bt) do { __builtin_amdgcn_s_setprio(1); _Pragma("unroll") for (int m = 0; m < 4; ++m) _Pragma("unroll") for (int n = 0; n < 2; ++n) _Pragma("unroll") for (int k = 0; k < 2; ++k) \
        acc[ai][bj][m][n] = __builtin_amdgcn_mfma_f32_16x16x32_bf16(Bt[n][k], At[m][k], acc[ai][bj][m][n], 0, 0, 0); __builtin_amdgcn_s_setprio(0); } while (0)
#define PG8_WAIT_V(n) asm volatile("s_waitcnt vmcnt(" #n ")" ::: "memory")
#define PG8_WAIT_L(n) asm volatile("s_waitcnt lgkmcnt(" #n ")" ::: "memory")
#define PG8_BAR __builtin_amdgcn_s_barrier()
#define PG8_SCHED __builtin_amdgcn_sched_barrier(0)
    Unit cur, nxt; int ui = 0;
    if (!S.next(0, cur)) return;
    f32x4 acc[2][2][4][2];
#pragma unroll
    for (int a = 0; a < 2; ++a)
#pragma unroll
        for (int b = 0; b < 2; ++b)
#pragma unroll
            for (int m = 0; m < 4; ++m)
#pragma unroll
                for (int n = 0; n < 2; ++n) acc[a][b][m][n] = (f32x4){0.f, 0.f, 0.f, 0.f};
    bf16x8 At[4][2], B0[2][2], B1[2][2];
    unsigned uC[2][2], uN[2][2];
#pragma unroll
    for (int h = 0; h < 2; ++h)
#pragma unroll
        for (int i = 0; i < 2; ++i) uC[h][i] = S.a_off(cur, h * HALF + RA[i]) + cA2[i];
    const char* cB = (const char*)g.Bt + (size_t)cur.pn * tstep;
    S.a_ready(cur);
    PG8_STAGE_B(PG8_SB(0, 0), cB); PG8_STAGE_B(PG8_SB(0, 1), cB + hstep); PG8_STAGE_A(PG8_SA(0, 0), 0, uC[0]); PG8_STAGE_A(PG8_SA(0, 1), 0, uC[1]);
    if (wr == 1) PG8_BAR;
    PG8_WAIT_V(2); PG8_BAR;
    PG8_STAGE_B(PG8_SB(1, 0), cB + kstep); PG8_STAGE_A(PG8_SA(1, 0), kstep, uC[0]); PG8_STAGE_B(PG8_SB(1, 1), cB + hstep + kstep);
    PG8_WAIT_V(6); PG8_BAR;
    for (;;) {
        const bool has_next = S.next(ui + 1, nxt);
        const char* nB = has_next ? (const char*)g.Bt + (size_t)nxt.pn * tstep : cB;
#if GEMM_TOKPF == 1
        if (has_next) S.prefetch(nxt, (ui + 1) & 1, wid, lane);
#elif GEMM_TOKPF == 2
        {
            Unit nx2; const bool has2 = S.next(ui + 2, nx2);
#pragma unroll
            for (int h = 0; h < 2; ++h)
#pragma unroll
                for (int i = 0; i < 2; ++i) uN[h][i] = has_next ? ((ui == 0 ? S.a_off(nxt, h * HALF + RA[i]) : S.a_off_pf(nxt, h * HALF + RA[i], (ui + 1) & 1)) + cA2[i]) : uC[h][i];
            if (has2) S.prefetch(nx2, ui & 1, wid, lane);
        }
#else
#pragma unroll
        for (int h = 0; h < 2; ++h)
#pragma unroll
            for (int i = 0; i < 2; ++i) uN[h][i] = has_next ? (S.a_off(nxt, h * HALF + RA[i]) + cA2[i]) : uC[h][i];
#endif
#pragma nounroll
        for (int t = 0; t < nt; t += 2) {
            const bool last = (t == nt - 2);
            const size_t ka1 = (size_t)(t + 1) * kstep;
            const size_t ka2 = last ? (size_t)0 : (size_t)(t + 2) * kstep, ka3 = ka2 + kstep;
            const char* b2 = last ? nB : cB + (size_t)(t + 2) * kstep; const char* b3 = b2 + kstep;
#if GEMM_TOKPF == 1
            if (last) {
                if (has_next) S.a_ready(nxt);
#pragma unroll
                for (int h = 0; h < 2; ++h)
#pragma unroll
                    for (int i = 0; i < 2; ++i) uN[h][i] = has_next ? (S.a_off_pf(nxt, h * HALF + RA[i], (ui + 1) & 1) + cA2[i]) : uC[h][i];
            }
#endif
            PG8_LDB(B0, 0, 0); PG8_LDB(B1, 0, 1); PG8_SCHED; PG8_LDA(At, 0, 0); PG8_STAGE_A(PG8_SA(1, 1), ka1, uC[1]);
            PG8_WAIT_V(8); PG8_WAIT_L(0); PG8_BAR; PG8_MMA(0, 0, At, B0); PG8_MMA(0, 1, At, B1); PG8_BAR; PG8_SCHED;
            PG8_LDA(At, 0, 1); PG8_STAGE_B(PG8_SB(0, 0), b2); PG8_STAGE_B(PG8_SB(0, 1), b2 + hstep); PG8_STAGE_A2(PG8_SA(0, 0), ka2, 0);
            PG8_WAIT_V(8); PG8_WAIT_L(0); PG8_BAR; PG8_MMA(1, 0, At, B0); PG8_MMA(1, 1, At, B1); PG8_BAR; PG8_SCHED;
            PG8_LDB(B0, 1, 0); PG8_LDB(B1, 1, 1); PG8_SCHED; PG8_LDA(At, 1, 0); PG8_STAGE_A2(PG8_SA(0, 1), ka2, 1);
            PG8_WAIT_V(8); PG8_WAIT_L(0); PG8_BAR; PG8_MMA(0, 0, At, B0); PG8_MMA(0, 1, At, B1); PG8_BAR; PG8_SCHED;
            PG8_LDA(At, 1, 1); PG8_STAGE_B(PG8_SB(1, 0), b3); PG8_STAGE_B(PG8_SB(1, 1), b3 + hstep); PG8_STAGE_A2(PG8_SA(1, 0), ka3, 0);
            PG8_WAIT_V(8); PG8_WAIT_L(0); PG8_BAR; PG8_MMA(1, 0, At, B0); PG8_MMA(1, 1, At, B1); PG8_BAR; PG8_SCHED;
        }
        if constexpr (ALIGN_EPI) { if (wr == 0) PG8_BAR; }
        E(acc, cur, wr, wc, fr, fq); S.done(cur);
        if (!has_next) break;
#pragma unroll
        for (int a = 0; a < 2; ++a)
#pragma unroll
            for (int b = 0; b < 2; ++b)
#pragma unroll
                for (int m = 0; m < 4; ++m)
#pragma unroll
                    for (int n = 0; n < 2; ++n) acc[a][b][m][n] = (f32x4){0.f, 0.f, 0.f, 0.f};
        cur = nxt; cB = nB; ++ui;
#pragma unroll
        for (int h = 0; h < 2; ++h)
#pragma unroll
            for (int i = 0; i < 2; ++i) uC[h][i] = uN[h][i];
        if constexpr (ALIGN_EPI) { if (wr == 1) PG8_BAR; }
    }
    PG8_WAIT_V(0);
    if constexpr (!ALIGN_EPI) { if (wr == 0) PG8_BAR; }
    PG8_BAR;
#undef PG8_SA
#undef PG8_SB
#undef PG8_STAGE_A
#undef PG8_STAGE_A2
#undef PG8_STAGE_B
#undef PG8_LDA
#undef PG8_LDB
#undef PG8_MMA
#undef PG8_WAIT_V
#undef PG8_WAIT_L
#undef PG8_BAR
#undef PG8_SCHED
}
}

struct Dst { bf16_t* O; int ldo, row0, col0, nvalid; float scale; bool headmap; };
template <class Route> struct EpiBf16R {
    static constexpr bool PERM = true;
    Route R;
    DI void operator()(const f32x4 (&acc)[2][2][4][2], const pg8::Unit& u, int wr, int wc, int fr, int fq) const {
        const Dst d = R(u);
#pragma unroll
        for (int ai = 0; ai < 2; ++ai)
#pragma unroll
            for (int m = 0; m < 4; ++m) {
                bf16_t* rowp = d.O + (size_t)(d.row0 + ai * 128 + wr * 64 + m * 16 + fr) * d.ldo + d.col0;
#pragma unroll
                for (int bj = 0; bj < 2; ++bj) {
                    const int c = bj * 128 + wc * 32 + 8 * fq;
                    if (c < d.nvalid) {
                        const f32x4 v0 = acc[ai][bj][m][0] * d.scale, v1 = acc[ai][bj][m][1] * d.scale;
                        u32x4 w; w.x = cvtpk(v0[0], v0[1]); w.y = cvtpk(v0[2], v0[3]); w.z = cvtpk(v1[0], v1[1]); w.w = cvtpk(v1[2], v1[3]);
                        const int oc = d.headmap ? ((c >> 6) * 96 + (c & 63)) : c;
                        *(u32x4*)(rowp + oc) = w;
                    }
                }
            }
    }
};
struct EpiResF32 {
    static constexpr bool PERM = false;
    float* Y; const float* X;
    DI void operator()(const f32x4 (&acc)[2][2][4][2], const pg8::Unit& u, int wr, int wc, int fr, int fq) const {
#pragma unroll
        for (int ai = 0; ai < 2; ++ai)
#pragma unroll
            for (int m = 0; m < 4; ++m) {
                const size_t ro = (size_t)(u.pm * 256 + ai * 128 + wr * 64 + m * 16 + fr) * DM + u.pn * 256 + wc * 32 + 4 * fq;
#pragma unroll
                for (int bj = 0; bj < 2; ++bj)
#pragma unroll
                    for (int n = 0; n < 2; ++n) {
                        const f32x4 xv = *(const f32x4*)(X + ro + bj * 128 + n * 16);
                        *(f32x4*)(Y + ro + bj * 128 + n * 16) = xv * ALPHA + acc[ai][bj][m][n];
                    }
            }
    }
};
struct EpiLat {
    static constexpr bool PERM = false;
    float* O; int ncol;
    DI void operator()(const f32x4 (&acc)[2][2][4][2], const pg8::Unit& u, int wr, int wc, int fr, int fq) const {
#pragma unroll
        for (int ai = 0; ai < 2; ++ai)
#pragma unroll
            for (int m = 0; m < 4; ++m) {
                const int c0 = u.pn * 256 + wc * 32 + 4 * fq;
                float* rowp = O + (size_t)(u.pm * 256 + ai * 128 + wr * 64 + m * 16 + fr) * 1024;
#pragma unroll
                for (int bj = 0; bj < 2; ++bj)
#pragma unroll
                    for (int n = 0; n < 2; ++n) { const int c = c0 + bj * 128 + n * 16; if (c < ncol) *(f32x4*)(rowp + c) = acc[ai][bj][m][n]; }
            }
    }
};
struct EpiGU {
    static constexpr bool PERM = true;
    bf16_t* H; const float* bias;
    DI void operator()(const f32x4 (&acc)[2][2][4][2], const pg8::Unit& u, int wr, int wc, int fr, int fq) const {
        const int e = u.pn >> 3, ct = u.pn & 7;
        const int j = ct * 128 + wc * 32 + 8 * fq;
        const float* be = bias + (size_t)e * 2048;
        f32x4 bg[2], bu[2];
#pragma unroll
        for (int n = 0; n < 2; ++n) { bg[n] = *(const f32x4*)(be + j + 4 * n); bu[n] = *(const f32x4*)(be + 1024 + j + 4 * n); }
#pragma unroll
        for (int ai = 0; ai < 2; ++ai)
#pragma unroll
            for (int m = 0; m < 4; ++m) {
                float h[8];
#pragma unroll
                for (int n = 0; n < 2; ++n)
#pragma unroll
                    for (int i = 0; i < 4; ++i) {
                        const float gg = fminf(acc[ai][0][m][n][i] + bg[n][i], 7.0f);
                        const float uu = fminf(fmaxf(acc[ai][1][m][n][i] + bu[n][i], -7.0f), 7.0f);
                        const float sg = __builtin_amdgcn_rcpf(1.0f + __builtin_amdgcn_exp2f(-1.702f * LOG2E * gg));
                        h[4 * n + i] = (uu + 1.0f) * (gg * sg);
                    }
                u32x4 w; w.x = cvtpk(h[0], h[1]); w.y = cvtpk(h[2], h[3]); w.z = cvtpk(h[4], h[5]); w.w = cvtpk(h[6], h[7]);
                *(u32x4*)(H + (size_t)(u.pm * 256 + ai * 128 + wr * 64 + m * 16 + fr) * 1024 + j) = w;
            }
    }
};
struct EpiDN {
    static constexpr bool PERM = true;
    bf16_t* Y; const float* bias;
    DI void operator()(const f32x4 (&acc)[2][2][4][2], const pg8::Unit& u, int wr, int wc, int fr, int fq) const {
        const int e = u.pn >> 2, ct = u.pn & 3;
        const float* be = bias + (size_t)e * 1024;
#pragma unroll
        for (int bj = 0; bj < 2; ++bj) {
            const int c = ct * 256 + bj * 128 + wc * 32 + 8 * fq;
            const f32x4 b0 = *(const f32x4*)(be + c), b1 = *(const f32x4*)(be + c + 4);
#pragma unroll
            for (int ai = 0; ai < 2; ++ai)
#pragma unroll
                for (int m = 0; m < 4; ++m) {
                    const f32x4 v0 = acc[ai][bj][m][0] + b0, v1 = acc[ai][bj][m][1] + b1;
                    u32x4 w; w.x = cvtpk(v0[0], v0[1]); w.y = cvtpk(v0[2], v0[3]); w.z = cvtpk(v1[0], v1[1]); w.w = cvtpk(v1[2], v1[3]);
                    *(u32x4*)(Y + (size_t)(u.pm * 256 + ai * 128 + wr * 64 + m * 16 + fr) * 1024 + c) = w;
                }
        }
    }
};
struct Frame {
    LAS unsigned char* lds; unsigned* ctl; unsigned char* ws; int tid, lane, wid; int G, bid;
};
struct MoeOrder {
    const LAS int* tstart; int sh; bool gather; const int* tokof; const LAS int* tokbuf; const LAS int* ulist;
    static DI void build(Frame& F, const LAS int* tstart, int nNt, LAS int* ulist) {
        __syncthreads();
        const int nwg = tstart[32] * nNt;
        if (F.tid == 0) ulist[0] = 0;
        __syncthreads();
        if (F.tid < 24) {
            const long L = (long)F.tid * F.G + F.bid;
            if (L < nwg) {
                int wgid = (int)L; { const int q = nwg / 8, r = nwg % 8, xcd = wgid % 8, off = wgid / 8; wgid = (xcd < r ? xcd * (q + 1) : r * (q + 1) + (xcd - r) * q) + off; }
                int e = 0;
                for (int k = 1; k < 32; ++k) if (tstart[k] * nNt <= wgid) e = k;
                const int rem = wgid - tstart[e] * nNt, nte = tstart[e + 1] - tstart[e];
                const int ct = rem / nte, rt = rem % nte;
                ulist[4 + 4 * F.tid] = tstart[e] + rt; ulist[5 + 4 * F.tid] = e * nNt + ct; ulist[6 + 4 * F.tid] = e; ulist[7 + 4 * F.tid] = rt;
                __hip_atomic_fetch_add(ulist, 1, __ATOMIC_RELAXED, __HIP_MEMORY_SCOPE_WORKGROUP);
            }
        }
        __syncthreads();
    }
    DI bool next(int i, pg8::Unit& u) const {
        if (i >= ulist[0]) return false;
        u.pm = ulist[4 + 4 * i]; u.pn = ulist[5 + 4 * i]; return true;
    }
    DI unsigned a_off(const pg8::Unit& u, int r) const {
        if (!gather) return (unsigned)(u.pm * 256 + r) * 2048u;
        const int e = u.pn >> sh, idx = (u.pm - tstart[e]) * 256 + r;
        const int t = idx < tstart[80 + e] ? tokof[(size_t)e * T + idx] : 0;
        return (unsigned)t * 2048u;
    }
    DI void prefetch(const pg8::Unit& u, int slot, int wid, int lane) const {
        if (gather && wid == 0) {
            const int e = u.pn >> sh, rt = u.pm - tstart[e];
            __builtin_amdgcn_global_load_lds((const unsigned*)(tokof + (size_t)e * T + rt * 256 + vlane() * 4), (LAS unsigned*)((LAS unsigned char*)tokbuf + slot * 1024), 16, 0, 0);
        }
    }
    DI unsigned a_off_pf(const pg8::Unit& u, int r, int slot) const {
        if (!gather) return (unsigned)(u.pm * 256 + r) * 2048u;
        const int e = u.pn >> sh, idx = (u.pm - tstart[e]) * 256 + r;
        const int t = idx < tstart[80 + e] ? tokbuf[slot * 256 + r] : 0;
        return (unsigned)t * 2048u;
    }
    DI void a_ready(const pg8::Unit&) const {}
    DI void done(const pg8::Unit&) const {}
};

DI int crow(int r, int hi) { return (r & 3) + 8 * (r >> 2) + 4 * hi; }
template <int DK, bool FOX, bool ROPEQ>
DI void attn_unit(LAS unsigned char* lds, const bf16_t* Q, int ldq, const bf16_t* Kp, int ldk, const bf16_t* Vt, int ldv,
                  const float* cum, bf16_t* O, int ldo, int q0, int ntiles, bool causal, const int* pos, const int wid, const float* kn2 = nullptr) {
    constexpr int PK = DK * 2 + 16, KBYTES = 64 * PK, VBYTES = 64 * 136, BUF = KBYTES + VBYTES + 256, KCH = DK / 8, NS = DK / 16;
    const int lane = vlane(), tid = wid * 64 + lane, r32 = lane & 31, hi = lane >> 5;
    const int qw0 = q0 + wid * 32, qrow = qw0 + r32;
    bf16x8 qf[NS];
#pragma unroll
    for (int s = 0; s < NS; ++s) qf[s] = *(const bf16x8*)(Q + (size_t)qrow * ldq + 16 * s + 8 * hi);
    if constexpr (ROPEQ) {
        const float p = (float)pos[qrow];
#pragma unroll
        for (int j = 0; j < 8; ++j) {
            const int i = 8 * hi + j;
            const float inv = exp2f(-(float)i * (13.287712379549449f / 16.0f));
            float sn, cs; sincos_cw(p * inv, sn, cs);
            const float x1 = bf2f((unsigned short)qf[4][j]), x2 = bf2f((unsigned short)qf[5][j]);
            const float o1 = x1 * cs - x2 * sn, o2 = x1 * sn + x2 * cs;
            qf[4][j] = (short)(cvtpk(o1, 0.f) & 0xffffu); qf[5][j] = (short)(cvtpk(o2, 0.f) & 0xffffu);
        }
    }
    const float cq = FOX ? cum[qrow] : 0.f;
    int jstart = 0; float prune_c = 0.f;
    if constexpr (FOX) {
        LAS float* red = (LAS float*)(lds + 2 * BUF);
        float ss = 0.f;
#pragma unroll
        for (int s = 0; s < NS; ++s)
#pragma unroll
            for (int j = 0; j < 8; ++j) { const float v = bf2f((unsigned short)qf[s][j]); ss += v * v; }
        ss += __shfl_xor(ss, 32);
        ss = wave_max(ss);
        float kk = 0.f;
        for (int j = tid; j < ntiles; j += NTHREADS) kk = fmaxf(kk, kn2[j]);
        kk = wave_max(kk);
        __syncthreads();
        if (lane == 0) { red[wid] = ss; red[8 + wid] = kk; }
        __syncthreads();
        float qm = red[0], km = red[8];
#pragma unroll
        for (int w = 1; w < 8; ++w) { qm = fmaxf(qm, red[w]); km = fmaxf(km, red[8 + w]); }
        prune_c = 2.0f * sqrtf(qm * km) * 1.01f + 65.0f;
        const float cq0 = cum[q0];
        int cand = ntiles;
        for (int j = tid; j < ntiles; j += NTHREADS) if (cq0 - cum[64 * j + 63] + prune_c >= 0.f) cand = min(cand, j);
#pragma unroll
        for (int o = 1; o < 64; o <<= 1) cand = min(cand, __shfl_xor(cand, o));
        __syncthreads();
        if (lane == 0) ((LAS int*)red)[16 + wid] = cand;
        __syncthreads();
        jstart = ((LAS int*)red)[16];
#pragma unroll
        for (int w = 1; w < 8; ++w) jstart = min(jstart, ((LAS int*)red)[16 + w]);
        jstart = min(jstart, ntiles - 4);
        __syncthreads();
    }
    const float cqw0 = FOX ? __shfl(cq, 0) : 0.f;
    f32x16 o0, o1;
#pragma unroll
    for (int r = 0; r < 16; ++r) { o0[r] = 0.f; o1[r] = 0.f; }
    float mrun = -1e30f, lrun = 0.f;
    const int kr0 = tid / KCH, kc0 = tid % KCH;
    const int kr1 = (tid + 512) / KCH, kc1 = (tid + 512) % KCH;
    const bool k2 = (DK == 96) && (tid < 256);
    const int vd = tid >> 3, vc = tid & 7;
    u32x4 kreg0, kreg1 = (u32x4){0, 0, 0, 0}, vreg; float creg = 0.f;
#define ATT_GLOAD(j) do { \
        kreg0 = *(const u32x4*)(Kp + (size_t)(64 * (j) + kr0) * ldk + kc0 * 8); \
        if (k2) kreg1 = *(const u32x4*)(Kp + (size_t)(64 * (j) + kr1) * ldk + kc1 * 8); \
        vreg = *(const u32x4*)(Vt + (size_t)vd * ldv + 64 * (j) + vc * 8); \
        if (FOX && tid < 64) creg = cum[64 * (j) + tid]; } while (0)
#define ATT_LWRITE(buf) do { LAS unsigned char* bb_ = lds + (buf) * BUF; \
        *(LAS u32x4*)(bb_ + kr0 * PK + kc0 * 16) = kreg0; \
        if (k2) *(LAS u32x4*)(bb_ + kr1 * PK + kc1 * 16) = kreg1; \
        *(LAS u32x2*)(bb_ + KBYTES + vd * 136 + vc * 16) = (u32x2){vreg.x, vreg.y}; \
        *(LAS u32x2*)(bb_ + KBYTES + vd * 136 + vc * 16 + 8) = (u32x2){vreg.z, vreg.w}; \
        if (FOX && tid < 64) *(LAS float*)(bb_ + KBYTES + VBYTES + tid * 4) = creg; } while (0)
    ATT_GLOAD(jstart); ATT_LWRITE(0); __syncthreads();
    for (int j = jstart; j < ntiles; ++j) {
        const int cur = (j - jstart) & 1;
        if (j + 1 < ntiles) ATT_GLOAD(j + 1);
        const LAS unsigned char* kb = lds + cur * BUF; const LAS unsigned char* vb = kb + KBYTES; const LAS unsigned char* cb = vb + VBYTES;
        bool active = !causal || (64 * j <= qw0 + 31);
        if constexpr (FOX) { if (cqw0 - *(const LAS float*)(cb + 63 * 4) + prune_c < 0.f) active = false; }
        if (active) {
            f32x16 sp0, sp1;
#pragma unroll
            for (int r = 0; r < 16; ++r) { sp0[r] = 0.f; sp1[r] = 0.f; }
#pragma unroll
            for (int s = 0; s < NS; ++s) {
                const bf16x8 k0 = *(const LAS bf16x8*)(kb + r32 * PK + 32 * s + 16 * hi);
                const bf16x8 k1 = *(const LAS bf16x8*)(kb + (32 + r32) * PK + 32 * s + 16 * hi);
                sp0 = __builtin_amdgcn_mfma_f32_32x32x16_bf16(k0, qf[s], sp0, 0, 0, 0);
                sp1 = __builtin_amdgcn_mfma_f32_32x32x16_bf16(k1, qf[s], sp1, 0, 0, 0);
            }
            __builtin_amdgcn_sched_barrier(0);
            if constexpr (FOX) {
#pragma unroll
                for (int g = 0; g < 4; ++g) {
                    const f32x4 c0 = *(const LAS f32x4*)(cb + (8 * g + 4 * hi) * 4);
                    const f32x4 c1 = *(const LAS f32x4*)(cb + (32 + 8 * g + 4 * hi) * 4);
#pragma unroll
                    for (int i = 0; i < 4; ++i) { sp0[4 * g + i] += cq - c0[i]; sp1[4 * g + i] += cq - c1[i]; }
                }
            }
            if (causal && (64 * j + 63 > qw0)) {
#pragma unroll
                for (int r = 0; r < 16; ++r) {
                    const int key = 64 * j + crow(r, hi);
                    if (key > qrow) sp0[r] = -1e30f;
                    if (key + 32 > qrow) sp1[r] = -1e30f;
                }
            }
            float mx = fmaxf(sp0[0], sp1[0]);
#pragma unroll
            for (int r = 1; r < 16; ++r) mx = fmaxf(mx, fmaxf(sp0[r], sp1[r]));
            mx = fmaxf(mx, __shfl_xor(mx, 32));
            const float mnew = fmaxf(mrun, mx);
            const float alpha = __builtin_amdgcn_exp2f(mrun - mnew);
            mrun = mnew;
            float ls = 0.f;
#pragma unroll
            for (int r = 0; r < 16; ++r) { sp0[r] = __builtin_amdgcn_exp2f(sp0[r] - mnew); sp1[r] = __builtin_amdgcn_exp2f(sp1[r] - mnew); ls += sp0[r] + sp1[r]; }
            lrun = lrun * alpha + ls;
#pragma unroll
            for (int r = 0; r < 16; ++r) { o0[r] *= alpha; o1[r] *= alpha; }
            __builtin_amdgcn_sched_barrier(0);
#pragma unroll
            for (int ks = 0; ks < 4; ++ks) {
                const int p = ks >> 1, s2 = ks & 1;
                u32x4 pw;
                if (p == 0) { pw.x = cvtpk(sp0[8 * s2 + 0], sp0[8 * s2 + 1]); pw.y = cvtpk(sp0[8 * s2 + 2], sp0[8 * s2 + 3]); pw.z = cvtpk(sp0[8 * s2 + 4], sp0[8 * s2 + 5]); pw.w = cvtpk(sp0[8 * s2 + 6], sp0[8 * s2 + 7]); }
                else        { pw.x = cvtpk(sp1[8 * s2 + 0], sp1[8 * s2 + 1]); pw.y = cvtpk(sp1[8 * s2 + 2], sp1[8 * s2 + 3]); pw.z = cvtpk(sp1[8 * s2 + 4], sp1[8 * s2 + 5]); pw.w = cvtpk(sp1[8 * s2 + 6], sp1[8 * s2 + 7]); }
                const bf16x8 pf = __builtin_bit_cast(bf16x8, pw);
                const int kbase = (32 * p + 16 * s2 + 4 * hi) * 2;
                {
                    const u32x2 lo = *(const LAS u32x2*)(vb + r32 * 136 + kbase), h2 = *(const LAS u32x2*)(vb + r32 * 136 + kbase + 16);
                    const bf16x8 vf = __builtin_bit_cast(bf16x8, (u32x4){lo.x, lo.y, h2.x, h2.y});
                    o0 = __builtin_amdgcn_mfma_f32_32x32x16_bf16(vf, pf, o0, 0, 0, 0);
                }
                {
                    const u32x2 lo = *(const LAS u32x2*)(vb + (32 + r32) * 136 + kbase), h2 = *(const LAS u32x2*)(vb + (32 + r32) * 136 + kbase + 16);
                    const bf16x8 vf = __builtin_bit_cast(bf16x8, (u32x4){lo.x, lo.y, h2.x, h2.y});
                    o1 = __builtin_amdgcn_mfma_f32_32x32x16_bf16(vf, pf, o1, 0, 0, 0);
                }
            }
        }
        if (j + 1 < ntiles) ATT_LWRITE(cur ^ 1);
        __syncthreads();
    }
#undef ATT_GLOAD
#undef ATT_LWRITE
    const float ltot = lrun + __shfl_xor(lrun, 32);
    const float inv = 1.0f / ltot;
#pragma unroll
    for (int g = 0; g < 4; ++g) {
        const int d0 = 8 * g + 4 * hi;
        u32x2 w0, w1;
        w0.x = cvtpk(o0[4 * g] * inv, o0[4 * g + 1] * inv); w0.y = cvtpk(o0[4 * g + 2] * inv, o0[4 * g + 3] * inv);
        w1.x = cvtpk(o1[4 * g] * inv, o1[4 * g + 1] * inv); w1.y = cvtpk(o1[4 * g + 2] * inv, o1[4 * g + 3] * inv);
        *(u32x2*)(O + (size_t)qrow * ldo + d0) = w0;
        *(u32x2*)(O + (size_t)qrow * ldo + 32 + d0) = w1;
    }
}


template <int DK, bool ROPEQ>
DI void attn_unit_pipe(LAS unsigned char* lds, const bf16_t* Q, int ldq, const bf16_t* Kp, int ldk, const bf16_t* Vt, int ldv,
                       bf16_t* O, int ldo, int q0, int ntiles, const int* pos, const int wid) {
    constexpr int PK = DK * 2 + 16, KBYTES = 64 * PK, VBYTES = 64 * 136, KCH = DK / 8, NS = DK / 16, VOFF = 2 * KBYTES;
    constexpr float THR = 6.0f;
    const int lane = vlane(), tid = wid * 64 + lane, r32 = lane & 31, hi = lane >> 5;
    const int qw0 = q0 + wid * 32, qrow = qw0 + r32;
    bf16x8 qf[NS];
#pragma unroll
    for (int s = 0; s < NS; ++s) qf[s] = *(const bf16x8*)(Q + (size_t)qrow * ldq + 16 * s + 8 * hi);
    if constexpr (ROPEQ) {
        const float p = (float)pos[qrow];
#pragma unroll
        for (int j = 0; j < 8; ++j) {
            const int i = 8 * hi + j;
            const float inv = exp2f(-(float)i * (13.287712379549449f / 16.0f));
            float sn, cs; sincos_cw(p * inv, sn, cs);
            const float x1 = bf2f((unsigned short)qf[NS - 2][j]), x2 = bf2f((unsigned short)qf[NS - 1][j]);
            const float o1 = x1 * cs - x2 * sn, o2 = x1 * sn + x2 * cs;
            qf[NS - 2][j] = (short)(cvtpk(o1, 0.f) & 0xffffu); qf[NS - 1][j] = (short)(cvtpk(o2, 0.f) & 0xffffu);
        }
    }
    const int kr0 = tid / KCH, kc0 = tid % KCH;
    const int kr1 = (tid + 512) / KCH, kc1 = (tid + 512) % KCH;
    const bool k2 = (DK == 96) && (tid < 256);
    const int vd = tid >> 3, vc = tid & 7;
    const int kfo = r32 * PK + 16 * hi;
    const int vfo = VOFF + r32 * 136 + 8 * hi;
    u32x4 kA0, kA1 = (u32x4){0, 0, 0, 0}, vA, kB0, kB1 = (u32x4){0, 0, 0, 0}, vB;
#define SBAR() __builtin_amdgcn_sched_barrier(0)
#define AP_LOADK(j, R0, R1) do { R0 = *(const u32x4*)(Kp + (size_t)(64 * (j) + kr0) * ldk + kc0 * 8); \
        if (k2) R1 = *(const u32x4*)(Kp + (size_t)(64 * (j) + kr1) * ldk + kc1 * 8); } while (0)
#define AP_LOADV(j, RV) do { RV = *(const u32x4*)(Vt + (size_t)vd * ldv + 64 * (j) + vc * 8); } while (0)
#define AP_WRITEK(buf, R0, R1) do { LAS unsigned char* bb_ = lds + (buf) * KBYTES; *(LAS u32x4*)(bb_ + kr0 * PK + kc0 * 16) = R0; \
        if (k2) *(LAS u32x4*)(bb_ + kr1 * PK + kc1 * 16) = R1; } while (0)
#define AP_WRITEV(buf, RV) do { LAS unsigned char* bb_ = lds + VOFF + (buf) * VBYTES; \
        *(LAS u32x2*)(bb_ + vd * 136 + vc * 16) = (u32x2){RV.x, RV.y}; *(LAS u32x2*)(bb_ + vd * 136 + vc * 16 + 8) = (u32x2){RV.z, RV.w}; } while (0)
#define AP_KF(dst0, dst1, kbuf, s) do { dst0 = *(const LAS bf16x8*)(lds + (kbuf) * KBYTES + kfo + 32 * (s)); dst1 = *(const LAS bf16x8*)(lds + (kbuf) * KBYTES + kfo + 32 * PK + 32 * (s)); } while (0)
#define AP_VF(dst0, dst1, vbuf, ks) do { const LAS unsigned char* p_ = lds + (vbuf) * VBYTES + vfo + (32 * ((ks) >> 1) + 16 * ((ks) & 1)) * 2; \
        const u32x2 a_ = *(const LAS u32x2*)(p_), b_ = *(const LAS u32x2*)(p_ + 16), c_ = *(const LAS u32x2*)(p_ + 32 * 136), d_ = *(const LAS u32x2*)(p_ + 32 * 136 + 16); \
        dst0 = __builtin_bit_cast(bf16x8, (u32x4){a_.x, a_.y, b_.x, b_.y}); dst1 = __builtin_bit_cast(bf16x8, (u32x4){c_.x, c_.y, d_.x, d_.y}); } while (0)
#define AP_MFMA(a, b, c) __builtin_amdgcn_mfma_f32_32x32x16_bf16(a, b, c, 0, 0, 0)
#define AP_MASK(S0, S1, t) do { _Pragma("unroll") for (int r_ = 0; r_ < 16; ++r_) { const int key_ = 64 * (t) + crow(r_, hi); \
        if (key_ > qrow) S0[r_] = -1e30f; if (key_ + 32 > qrow) S1[r_] = -1e30f; } } while (0)
#define AP_ROWMAX(S0, S1, out) do { float a_ = fmaxf(fmaxf(S0[0], S1[0]), S0[1]), b_ = fmaxf(fmaxf(S1[1], S0[2]), S1[2]); \
        _Pragma("unroll") for (int r_ = 3; r_ < 15; r_ += 2) { a_ = fmaxf(fmaxf(a_, S0[r_]), S1[r_]); b_ = fmaxf(fmaxf(b_, S0[r_ + 1]), S1[r_ + 1]); } \
        a_ = fmaxf(fmaxf(a_, S0[15]), S1[15]); a_ = fmaxf(a_, b_); out = fmaxf(a_, __shfl_xor(a_, 32)); } while (0)
    f32x16 o0, o1, pa0, pa1, sb0, sb1;
#pragma unroll
    for (int r = 0; r < 16; ++r) { o0[r] = 0.f; o1[r] = 0.f; }
    float mref = 0.f, lrun = 0.f;
    bf16x8 pf[4];
    bf16x8 fa0, fa1, fb0, fb1;
    AP_LOADK(0, kA0, kA1); AP_LOADV(0, vA); AP_WRITEK(0, kA0, kA1); AP_WRITEV(0, vA);
    AP_LOADK(1, kA0, kA1); AP_WRITEK(1, kA0, kA1);
    AP_LOADK(2, kA0, kA1); AP_LOADV(1, vA);
    __syncthreads();
#pragma unroll
    for (int r = 0; r < 16; ++r) { pa0[r] = 0.f; pa1[r] = 0.f; }
#pragma unroll
    for (int s = 0; s < NS; ++s) { AP_KF(fa0, fa1, 0, s); pa0 = AP_MFMA(fa0, qf[s], pa0); pa1 = AP_MFMA(fa1, qf[s], pa1); }
    if (ntiles == 4) AP_MASK(pa0, pa1, 0);
    { float mx; AP_ROWMAX(pa0, pa1, mx); mref = mx;
#pragma unroll
      for (int r = 0; r < 16; ++r) { pa0[r] = __builtin_amdgcn_exp2f(pa0[r] - mx); pa1[r] = __builtin_amdgcn_exp2f(pa1[r] - mx); } }
    __syncthreads();
    f32x16 negm;
#pragma unroll
    for (int r = 0; r < 16; ++r) negm[r] = -mref;
    asm volatile("" : "+v"(negm));
#define AP_STEPA(s, X0, X1, Y0, Y1, VALU) do { if ((s) + 1 < NS) AP_KF(Y0, Y1, kb_, (s) + 1); else AP_VF(Y0, Y1, vb_, 0); \
        if ((s) == 0) { sb0 = AP_MFMA(X0, qf[s], negm); sb1 = AP_MFMA(X1, qf[s], negm); } else { sb0 = AP_MFMA(X0, qf[s], sb0); sb1 = AP_MFMA(X1, qf[s], sb1); } VALU; SBAR(); } while (0)
#define AP_PK(i, P, b) pw_[i] = (u32x4){cvtpk(P[b], P[b + 1]), cvtpk(P[b + 2], P[b + 3]), cvtpk(P[b + 4], P[b + 5]), cvtpk(P[b + 6], P[b + 7])}; \
        ls0_ = fadd_s(ls0_, fadd_s(fadd_s(P[b], P[b + 1]), fadd_s(P[b + 2], P[b + 3]))); ls1_ = fadd_s(ls1_, fadd_s(fadd_s(P[b + 4], P[b + 5]), fadd_s(P[b + 6], P[b + 7]))); asm volatile("" : "+v"(pw_[i]), "+v"(ls0_), "+v"(ls1_))
#define AP_EXP4(P, S, b) do { P[b] = __builtin_amdgcn_exp2f(S[b]); P[b + 1] = __builtin_amdgcn_exp2f(S[b + 1]); P[b + 2] = __builtin_amdgcn_exp2f(S[b + 2]); P[b + 3] = __builtin_amdgcn_exp2f(S[b + 3]); asm volatile("" : "+v"(P)); } while (0)
#define AP_STEPB(ks, X0, X1, Y0, Y1, E0, E1) do { if ((ks) + 1 < 4) AP_VF(Y0, Y1, vb_, (ks) + 1); \
        o0 = AP_MFMA(X0, pf[ks], o0); E0; SBAR(); o1 = AP_MFMA(X1, pf[ks], o1); E1; SBAR(); } while (0)
#define AP_ITER(t, MASKED, WK0, WK1, WV, LK0, LK1, LV) do {     \
        const int kb_ = (t) & 1, vb_ = ((t) - 1) & 1; \
        if ((t) + 2 < ntiles) AP_LOADK((t) + 2, LK0, LK1); \
        if ((t) + 1 < ntiles) AP_LOADV((t) + 1, LV); \
        u32x4 pw_[4]; float ls0_ = 0.f, ls1_ = 0.f; \
        AP_KF(fa0, fa1, kb_, 0); SBAR(); \
        AP_STEPA(0, fa0, fa1, fb0, fb1, AP_PK(0, pa0, 0)); \
        AP_STEPA(1, fb0, fb1, fa0, fa1, AP_PK(1, pa0, 8)); \
        AP_STEPA(2, fa0, fa1, fb0, fb1, AP_PK(2, pa1, 0)); \
        AP_STEPA(3, fb0, fb1, fa0, fa1, AP_PK(3, pa1, 8)); \
        if (NS == 6) { AP_STEPA(4, fa0, fa1, fb0, fb1, (void)0); AP_STEPA(5, fb0, fb1, fa0, fa1, (void)0); } \
        lrun += ls0_ + ls1_; \
        pf[0] = __builtin_bit_cast(bf16x8, pw_[0]); pf[1] = __builtin_bit_cast(bf16x8, pw_[1]); pf[2] = __builtin_bit_cast(bf16x8, pw_[2]); pf[3] = __builtin_bit_cast(bf16x8, pw_[3]); \
        if ((t) >= ntiles - 4) AP_MASK(sb0, sb1, t); \
        float mx_; AP_ROWMAX(sb0, sb1, mx_); \
        float resc_ = 1.0f; bool do_resc_ = false; \
        if (__any(mx_ > THR)) { const float dl_ = fmaxf(mx_, 0.f); mref += dl_; \
            _Pragma("unroll") for (int r_ = 0; r_ < 16; ++r_) { sb0[r_] -= dl_; sb1[r_] -= dl_; negm[r_] = -mref; } \
            asm volatile("" : "+v"(negm)); \
            resc_ = __builtin_amdgcn_exp2f(-dl_); lrun *= resc_; do_resc_ = true; } \
        SBAR(); \
        AP_STEPB(0, fa0, fa1, fb0, fb1, AP_EXP4(pa0, sb0, 0), AP_EXP4(pa0, sb0, 4)); \
        AP_STEPB(1, fb0, fb1, fa0, fa1, AP_EXP4(pa0, sb0, 8), AP_EXP4(pa0, sb0, 12)); \
        AP_STEPB(2, fa0, fa1, fb0, fb1, AP_EXP4(pa1, sb1, 0), AP_EXP4(pa1, sb1, 4)); \
        AP_STEPB(3, fb0, fb1, fa0, fa1, AP_EXP4(pa1, sb1, 8), AP_EXP4(pa1, sb1, 12)); \
        if (do_resc_) { asm volatile("" ::: "memory"); _Pragma("unroll") for (int r_ = 0; r_ < 16; ++r_) { o0[r_] *= resc_; o1[r_] *= resc_; } asm volatile("" : "+v"(o0), "+v"(o1)); } \
        if ((t) + 1 < ntiles) AP_WRITEK(((t) + 1) & 1, WK0, WK1); \
        AP_WRITEV((t) & 1, WV); \
        __syncthreads(); } while (0)
    static_assert(NS == 4 || NS == 6, "head dim 64 or 96");
    if (wid >= 4) __builtin_amdgcn_s_setprio(1);
    int t = 1;
    for (; t + 1 < ntiles; t += 2) { AP_ITER(t, 1, kA0, kA1, vA, kB0, kB1, vB); AP_ITER(t + 1, 1, kB0, kB1, vB, kA0, kA1, vA); }
    AP_ITER(t, 1, kA0, kA1, vA, kB0, kB1, vB);
    {
        u32x4 pw_[4]; float ls0_ = 0.f, ls1_ = 0.f;
        AP_PK(0, pa0, 0); AP_PK(1, pa0, 8); AP_PK(2, pa1, 0); AP_PK(3, pa1, 8);
        lrun += ls0_ + ls1_;
        pf[0] = __builtin_bit_cast(bf16x8, pw_[0]); pf[1] = __builtin_bit_cast(bf16x8, pw_[1]); pf[2] = __builtin_bit_cast(bf16x8, pw_[2]); pf[3] = __builtin_bit_cast(bf16x8, pw_[3]);
        const int vb_ = (ntiles - 1) & 1;
#pragma unroll
        for (int ks = 0; ks < 4; ++ks) { AP_VF(fa0, fa1, vb_, ks); o0 = AP_MFMA(fa0, pf[ks], o0); o1 = AP_MFMA(fa1, pf[ks], o1); }
    }
    const float ltot = lrun + __shfl_xor(lrun, 32);
    const float inv = 1.0f / ltot;
#pragma unroll
    for (int g = 0; g < 4; ++g) {
        const int d0 = 8 * g + 4 * hi;
        u32x2 w0, w1;
        w0.x = cvtpk(o0[4 * g] * inv, o0[4 * g + 1] * inv); w0.y = cvtpk(o0[4 * g + 2] * inv, o0[4 * g + 3] * inv);
        w1.x = cvtpk(o1[4 * g] * inv, o1[4 * g + 1] * inv); w1.y = cvtpk(o1[4 * g + 2] * inv, o1[4 * g + 3] * inv);
        *(u32x2*)(O + (size_t)qrow * ldo + d0) = w0;
        *(u32x2*)(O + (size_t)qrow * ldo + 32 + d0) = w1;
    }
    __syncthreads();
#undef SBAR
#undef AP_LOADK
#undef AP_LOADV
#undef AP_WRITEK
#undef AP_WRITEV
#undef AP_KF
#undef AP_VF
#undef AP_MFMA
#undef AP_MASK
#undef AP_ROWMAX
#undef AP_STEPA
#undef AP_PK
#undef AP_EXP4
#undef AP_STEPB
#undef AP_ITER
}

#define XB_TMO      128
#define XB_XCNT(j)  (256  + 64 * (j))
#define XB_XSUB(j)  (1280 + 64 * (j))
#define XB_XGEN(j)  (2304 + 64 * (j))
#define XB_TOP      3328
#define XB_TOPGEN   3392
#define XCD_BAR_WORDS 3456
#define XB_SPIN_CAP (1u << 18)
DI unsigned xb_ld(unsigned* p) { return __hip_atomic_load(p, __ATOMIC_RELAXED, __HIP_MEMORY_SCOPE_AGENT); }
DI unsigned xb_add(unsigned* p, unsigned v) { return __hip_atomic_fetch_add(p, v, __ATOMIC_RELAXED, __HIP_MEMORY_SCOPE_AGENT); }
DI unsigned xb_xcc_id() { return (unsigned)__builtin_amdgcn_s_getreg((3 << 11) | 20) & 0xFu; }
#define XB_SPIN(cond, bar) do { unsigned _sp = 0; while (cond) { __builtin_amdgcn_s_sleep(1); \
    if ((++_sp & 255u) == 0u) { if (xb_ld(&(bar)[XB_TMO])) break; if (_sp > XB_SPIN_CAP) { atomicAdd(&(bar)[XB_TMO], 1u); break; } } } } while (0)
struct XcdBarrier { unsigned* bar; unsigned x; volatile LAS unsigned* st; int wid; };
DI XcdBarrier xcd_barrier_post(unsigned* bar, volatile LAS unsigned* st, int wid) {
    XcdBarrier b; b.bar = bar; b.x = xb_xcc_id(); b.st = st; b.wid = wid;
    if (wid == 0 && vlane() == 0) (void)xb_add(&bar[XB_XCNT(b.x)], 1u);
    return b;
}
DI void xcd_barrier_complete(unsigned* bar, unsigned x, unsigned& nloc, unsigned& nx) {
    const unsigned G = gridDim.x * gridDim.y * gridDim.z;
    unsigned sum, cnt, mine, sp = 0u;
    for (;;) {
        sum = 0u; cnt = 0u; mine = 0u;
#pragma unroll
        for (unsigned j = 0; j < 16; ++j) { const unsigned c = xb_ld(&bar[XB_XCNT(j)]); sum += c; cnt += (c > 0u) ? 1u : 0u; mine = (j == x) ? c : mine; }
        if (sum == G) break;
        __builtin_amdgcn_s_sleep(1);
        if ((++sp & 255u) == 0u) { if (xb_ld(&bar[XB_TMO])) break; if (sp > XB_SPIN_CAP) { atomicAdd(&bar[XB_TMO], 1u); break; } }
    }
    nloc = mine > 0u ? mine : 1u; nx = cnt > 0u ? cnt : 1u;
}
DI void xcd_barrier(const XcdBarrier& b) {
    asm volatile("s_waitcnt vmcnt(0)" ::: "memory");
    __syncthreads();
    if (b.wid == 0 && vlane() == 0) {
        unsigned* bar = b.bar;
        __builtin_amdgcn_s_waitcnt(0);
        unsigned nloc = b.st[0], nx = b.st[1];
        if (nloc == 0u) { xcd_barrier_complete(bar, b.x, nloc, nx); b.st[0] = nloc; b.st[1] = nx; }
        const unsigned old = xb_add(&bar[XB_XSUB(b.x)], 1u);
        const unsigned gen = old / nloc;
        if (old + 1u == (gen + 1u) * nloc) {
            __builtin_amdgcn_fence(__ATOMIC_RELEASE, "agent");
            asm volatile("s_waitcnt vmcnt(0)" ::: "memory");
            const unsigned og = xb_add(&bar[XB_TOP], 1u);
            const unsigned tg = og / nx;
            if (og + 1u == (tg + 1u) * nx) xb_add(&bar[XB_TOPGEN], 1u);
            else XB_SPIN(xb_ld(&bar[XB_TOPGEN]) == tg, bar);
            __builtin_amdgcn_fence(__ATOMIC_ACQUIRE, "agent");
            xb_add(&bar[XB_XGEN(b.x)], 1u);
            asm volatile("s_waitcnt vmcnt(0)" ::: "memory");
        } else {
            XB_SPIN(xb_ld(&bar[XB_XGEN(b.x)]) == gen, bar);
            __builtin_amdgcn_fence(__ATOMIC_ACQUIRE, "agent");
            asm volatile("s_waitcnt vmcnt(0)" ::: "memory");
        }
    }
    __syncthreads();
}

DI int next_unit(Frame& F, int widx) {
    LAS int* s = (LAS int*)(F.lds + LDS_CTL);
    __syncthreads();
    if (F.tid == 0) *s = (int)atomicAdd(F.ctl + CW_WORK + 64 * widx, 1u);
    __syncthreads();
    return *s;
}

DI void transpose_item(const float* W, int ldw, int srccol, int K, bf16_t* WT, int drow, LAS unsigned* scr, int k0, int lane, int nvalid) {
    const int n4 = lane & 15, kq = lane >> 4;
#pragma unroll 8
    for (int i = 0; i < 16; ++i) {
        const int kk = 4 * i + kq;
        f32x4 v = (f32x4){0.f, 0.f, 0.f, 0.f};
        if (4 * n4 < nvalid) v = *(const f32x4*)(W + (size_t)(k0 + kk) * ldw + srccol + 4 * n4);
        scr[kk * 33 + 2 * n4] = cvtpk(v[0], v[1]); scr[kk * 33 + 2 * n4 + 1] = cvtpk(v[2], v[3]);
    }
    LDS_WAIT(); asm volatile("" ::: "memory");
    const int c = lane & 7;
    const LAS unsigned short* s16 = (const LAS unsigned short*)scr;
#pragma unroll
    for (int j = 0; j < 8; ++j) {
        const int n = (lane >> 3) + 8 * j;
        const LAS unsigned short* sp = s16 + (8 * c) * 66 + n;
        u32x4 o;
        o.x = (unsigned)sp[0 * 66] | ((unsigned)sp[1 * 66] << 16); o.y = (unsigned)sp[2 * 66] | ((unsigned)sp[3 * 66] << 16);
        o.z = (unsigned)sp[4 * 66] | ((unsigned)sp[5 * 66] << 16); o.w = (unsigned)sp[6 * 66] | ((unsigned)sp[7 * 66] << 16);
        if (n < nvalid) *(u32x4*)(WT + (size_t)(drow + n) * K + k0 + 8 * c) = o;
    }
    LDS_WAIT(); asm volatile("" ::: "memory");
}
constexpr int CONV_P1 = 5, CONV_A0 = 5, CONV_GU = 7, CONV_DN = 4, CONV_A1 = 12;
constexpr int MOE_I_GU = 16 * 32, MOE_I_DN = 16 * 16, MOE_ITEMS_PER_LAYER = 32 * (MOE_I_GU + MOE_I_DN);
DI void moe_convert_item(unsigned char* ws, LAS unsigned* scr, int r, int lane) {
    const int l = r / MOE_ITEMS_PER_LAYER; r -= l * MOE_ITEMS_PER_LAYER;
    if (r < 32 * MOE_I_GU) {
        const int e = l * 32 + r / MOE_I_GU, q = r % MOE_I_GU, kb = q / 32, nb = q % 32;
        const int jj = (nb & 15) * 64, drow = (jj >> 7) * 256 + (nb >> 4) * 128 + (jj & 127);
        transpose_item(KP->moe_w_gu + (size_t)e * 1024 * 2048, 2048, 64 * nb, 1024, (bf16_t*)(ws + WS_W_GU) + (size_t)e * 2048 * 1024, drow, scr, 64 * kb, lane, 64);
    } else {
        r -= 32 * MOE_I_GU;
        const int e = l * 32 + r / MOE_I_DN, q = r % MOE_I_DN, kb = q / 16, nb = q % 16;
        transpose_item(KP->moe_w_dn + (size_t)e * 1024 * 1024, 1024, 64 * nb, 1024, (bf16_t*)(ws + WS_W_DN) + (size_t)e * 1024 * 1024, 64 * nb, scr, 64 * kb, lane, 64);
    }
}
constexpr int CW_CONVQ = CW_WORK + 64 * 8;
DI bool conv_pull(Frame& F, int l, int nchunks) {
    constexpr int NCHUNK = MOE_ITEMS_PER_LAYER / 8;
    LAS int* s = (LAS int*)(F.lds + LDS_CTL + 8);
    __syncthreads();
    if (F.tid == 0) *s = (int)atomicAdd(F.ctl + CW_CONVQ + 64 * l, (unsigned)nchunks);
    __syncthreads();
    const int base = *s;
    LAS unsigned* scr = (LAS unsigned*)(F.lds + F.wid * 8448);
    for (int c = base; c < base + nchunks && c < NCHUNK; ++c) moe_convert_item(F.ws, scr, l * MOE_ITEMS_PER_LAYER + c * 8 + F.wid, F.lane);
    __syncthreads();
    return base + nchunks < NCHUNK;
}
struct TrMat { const float* W; int ldw, col0, K, N; bf16_t* WT; int drow0, mode; };

DI void phase_prologue(Frame& F, const Params& P) {
    F.lane = vlane(); F.tid = F.wid * 64 + F.lane;
    LAS unsigned* scr = (LAS unsigned*)(F.lds + F.wid * 8448);
    const int gw = F.bid * 8 + F.wid, NGW = F.G * 8;
    unsigned char* ws = F.ws;
    TrMat mats[11];
    mats[0] = TrMat{KP->a_w_in, FOX_IN, 0, 1024, 1536, (bf16_t*)(ws + WS_W_AIN), 0, 0};
    mats[1] = TrMat{KP->a_w_in, FOX_IN, 2316, 1024, 256, (bf16_t*)(ws + WS_W_AIN), 1536, 0};
    mats[2] = TrMat{KP->a_w_in, FOX_IN, 1536, 1024, 768, (bf16_t*)(ws + WS_W_AIN), 1792, 0};
    mats[3] = TrMat{KP->a_w_out, 1024, 0, 1024, 1024, (bf16_t*)(ws + WS_W_AOUT), 0, 0};
    mats[4] = TrMat{KP->kv_w_dkv, 288, 0, 1024, 288, (bf16_t*)(ws + WS_W_BIN), 0, 0};
    mats[5] = TrMat{KP->b_w_in, 640, 0, 1024, 640, (bf16_t*)(ws + WS_W_BIN), 288, 0};
    mats[6] = TrMat{KP->b_w_uq, 1152, 0, 384, 1152, (bf16_t*)(ws + WS_W_UQ), 0, 0};
    mats[7] = TrMat{KP->kv_w_ukv, 1536, 0, 256, 1536, (bf16_t*)(ws + WS_W_UKV), 0, 1};
    mats[8] = TrMat{KP->b_w_out, 1024, 0, 1024, 1024, (bf16_t*)(ws + WS_W_BOUT), 0, 0};
    mats[9] = TrMat{KP->mem_w_kv, 512, 0, 1024, 512, (bf16_t*)(ws + WS_W_MKV), 0, 0};
    mats[10] = TrMat{KP->mem_w_kv + (size_t)1024 * 512, 512, 0, 1024, 512, (bf16_t*)(ws + WS_W_MKV) + (size_t)512 * 1024, 0, 0};
    int nsmall = 0;
#pragma unroll
    for (int i = 0; i < 11; ++i) nsmall += (mats[i].K / 64) * ((mats[i].N + 63) / 64);
    const int ntot = nsmall;
    for (int it = gw; it < ntot; it += NGW) {
        int r = it;
        if (r < nsmall) {
#pragma unroll
            for (int i = 0; i < 11; ++i) {
                const int nblk = (mats[i].N + 63) / 64, ni = (mats[i].K / 64) * nblk;
                if (r >= 0 && r < ni) {
                    const int kb = r / nblk, nb = r % nblk;
                    const int drow = mats[i].mode == 1 ? ((nb & 1) * 768 + (nb >> 1) * 64) : (mats[i].drow0 + 64 * nb);
                    transpose_item(mats[i].W, mats[i].ldw, mats[i].col0 + 64 * nb, mats[i].K, mats[i].WT, drow, scr, 64 * kb, F.lane, mats[i].N - 64 * nb);
                }
                r -= ni;
            }
            continue;
        }
    }
    __syncthreads();
    LAS float* wf = (LAS float*)F.lds;
    for (int i = F.tid; i < 1024 * 12; i += NTHREADS) { const int k = i / 12, h = i % 12; wf[i] = KP->a_w_in[(size_t)k * FOX_IN + 2304 + h]; }
    __syncthreads();
    float* logf = (float*)(ws + WS_LOGF);
    bf16_t* xb = (bf16_t*)(ws + WS_XB);
    for (int row = gw; row < T; row += NGW) {
        const f32x4* xr = (const f32x4*)(KP->x + (size_t)row * DM) + F.lane;
        f32x4 v[4];
#pragma unroll
        for (int j = 0; j < 4; ++j) v[j] = xr[64 * j];
        u32x2* o8 = (u32x2*)(xb + (size_t)row * DM) + F.lane;
#pragma unroll
        for (int j = 0; j < 4; ++j) o8[64 * j] = (u32x2){cvtpk(v[j][0], v[j][1]), cvtpk(v[j][2], v[j][3])};
        float part[12];
#pragma unroll
        for (int h = 0; h < 12; ++h) part[h] = 0.f;
#pragma unroll
        for (int j = 0; j < 4; ++j)
#pragma unroll
            for (int i = 0; i < 4; ++i) {
                const int k = 4 * F.lane + 256 * j + i;
                const LAS f32x4* wp = (const LAS f32x4*)(wf + k * 12);
                const f32x4 w0 = wp[0], w1 = wp[1], w2 = wp[2];
                const float xv = v[j][i];
                part[0] += xv * w0[0]; part[1] += xv * w0[1]; part[2] += xv * w0[2]; part[3] += xv * w0[3];
                part[4] += xv * w1[0]; part[5] += xv * w1[1]; part[6] += xv * w1[2]; part[7] += xv * w1[3];
                part[8] += xv * w2[0]; part[9] += xv * w2[1]; part[10] += xv * w2[2]; part[11] += xv * w2[3];
            }
        float mine = 0.f;
#pragma unroll
        for (int h = 0; h < 12; ++h) { const float s = wave_sum(part[h]); if (F.lane == h) mine = s; }
        if (F.lane < 12) {
            const float z = mine + KP->a_b_f[F.lane];
            const float ls = fminf(z, 0.f) - log1pf(expf(-fabsf(z)));
            const int b = row / SEQ, s = row % SEQ;
            logf[(size_t)(b * NH + F.lane) * SEQ + s] = ls;
        }
    }
    {
        float* wrt = (float*)(ws + WS_WRT);
        for (int i = F.bid * NTHREADS + F.tid; i < 2 * 1024 * 32; i += F.G * NTHREADS) { const int l = i >> 15, k = (i >> 5) & 1023, e = i & 31; wrt[(size_t)(l * 32 + e) * 1024 + k] = KP->moe_w_r[i]; }
    }
    bf16_t* memb = (bf16_t*)(ws + WS_MEMB);
    for (int row = gw; row < NB * NMEM; row += NGW) {
        const f32x4* xr = (const f32x4*)(KP->mem + (size_t)row * DM) + F.lane;
        u32x2* o8 = (u32x2*)(memb + (size_t)row * DM) + F.lane;
#pragma unroll
        for (int j = 0; j < 4; ++j) { const f32x4 v = xr[64 * j]; o8[64 * j] = (u32x2){cvtpk(v[0], v[1]), cvtpk(v[2], v[3])}; }
    }
}

DI void scan_unit(Frame& F, int bh) {
    const float* src = (const float*)(F.ws + WS_LOGF) + (size_t)bh * SEQ;
    float* dst = (float*)(F.ws + WS_CUM) + (size_t)bh * SEQ;
    LAS float* wtot = (LAS float*)F.lds;
    float v[16];
#pragma unroll
    for (int j = 0; j < 4; ++j) { const f32x4 t = *(const f32x4*)(src + F.tid * 16 + 4 * j); v[4 * j] = t[0]; v[4 * j + 1] = t[1]; v[4 * j + 2] = t[2]; v[4 * j + 3] = t[3]; }
#pragma unroll
    for (int i = 1; i < 16; ++i) v[i] += v[i - 1];
    float tot = v[15];
    float inc = tot;
#pragma unroll
    for (int o = 1; o < 64; o <<= 1) { const float t = __shfl_up(inc, o); if (F.lane >= o) inc += t; }
    __syncthreads();
    if (F.lane == 63) wtot[F.wid] = inc;
    __syncthreads();
    float base = inc - tot;
    for (int w = 0; w < F.wid; ++w) base += wtot[w];
#pragma unroll
    for (int j = 0; j < 4; ++j) {
        f32x4 t; t[0] = (base + v[4 * j]) * LOG2E; t[1] = (base + v[4 * j + 1]) * LOG2E; t[2] = (base + v[4 * j + 2]) * LOG2E; t[3] = (base + v[4 * j + 3]) * LOG2E;
        *(f32x4*)(dst + F.tid * 16 + 4 * j) = t;
    }
    __syncthreads();
}

struct RouteQKM { unsigned char* ws; DI Dst operator()(const pg8::Unit& u) const {
    if (u.pn < 3) return Dst{(bf16_t*)(ws + WS_Q), 768, u.pm * 256, u.pn * 256, 256, 0.125f * LOG2E, false};
    if (u.pn < 6) return Dst{(bf16_t*)(ws + WS_K), 768, u.pm * 256, (u.pn - 3) * 256, 256, 1.0f, false};
    return Dst{(bf16_t*)(ws + WS_MQ), 256, u.pm * 256, 0, 256, 0.125f * LOG2E, false}; } };
struct RouteVT { unsigned char* ws; DI Dst operator()(const pg8::Unit& u) const {
    const int b = u.pn >> 5; return Dst{(bf16_t*)(ws + WS_VT) + (size_t)b * 768 * SEQ, SEQ, u.pm * 256, (u.pn & 31) * 256, 256, 1.0f, false}; } };
struct RoutePlain { bf16_t* O; int ldo; DI Dst operator()(const pg8::Unit& u) const { return Dst{O, ldo, u.pm * 256, u.pn * 256, 256, 1.0f, false}; } };
DI void phase_proj0(Frame& F, const Params& P) {
    F.lane = vlane(); F.tid = F.wid * 64 + F.lane;
    unsigned char* ws = F.ws;
    const bf16_t* xb = (const bf16_t*)(ws + WS_XB);
    const bf16_t* win = (const bf16_t*)(ws + WS_W_AIN);
    const bf16_t* memb = (const bf16_t*)(ws + WS_MEMB);
    {
        pg8::Gemm g{xb, win, 1024}; pg8::StaticOrder S; S.init(T, 1792, 1024, F.G, F.bid);
        EpiBf16R<RouteQKM> E{RouteQKM{ws}};
        pg8::gemm_phase<EpiBf16R<RouteQKM>, pg8::StaticOrder, true>(F.lds, g, S, E, F.wid);
    }
    {
        pg8::Gemm g{win + (size_t)1792 * 1024, xb, 1024}; pg8::StaticOrder S; S.init(768, T, 1024, F.G, (F.bid + 64) % F.G);
        EpiBf16R<RouteVT> E{RouteVT{ws}};
        pg8::gemm_phase<EpiBf16R<RouteVT>, pg8::StaticOrder, true>(F.lds, g, S, E, F.wid);
    }
    for (int l = 0; l < 2; ++l) {
        const bf16_t* wk = (const bf16_t*)(ws + WS_W_MKV) + (size_t)l * 512 * 1024;
        {
            pg8::Gemm g{memb, wk, 1024}; pg8::StaticOrder S; S.init(512, 256, 1024, F.G, (F.bid + F.G - (152 + 4 * l)) % F.G);
            EpiBf16R<RoutePlain> E{RoutePlain{(bf16_t*)(ws + WS_MK) + (size_t)l * 512 * 256, 256}};
            pg8::gemm_phase<EpiBf16R<RoutePlain>, pg8::StaticOrder, true>(F.lds, g, S, E, F.wid);
        }
        for (int b = 0; b < 2; ++b) {
            pg8::Gemm g{wk + (size_t)256 * 1024, memb + (size_t)b * 256 * 1024, 1024}; pg8::StaticOrder S; S.init(256, 256, 1024, F.G, (F.bid + F.G - (154 + 4 * l + b)) % F.G);
            EpiBf16R<RoutePlain> E{RoutePlain{(bf16_t*)(ws + WS_MVT) + (size_t)(l * 2 + b) * 256 * 256, 256}};
            pg8::gemm_phase<EpiBf16R<RoutePlain>, pg8::StaticOrder, true>(F.lds, g, S, E, F.wid);
        }
    }
    if (F.G == 256 && F.bid >= 128) conv_pull(F, 0, CONV_P1);
}


DI void phase_scan_knorm(Frame& F) {
    F.lane = vlane(); F.tid = F.wid * 64 + F.lane;
    unsigned char* ws = F.ws;
    if (F.bid < 24) scan_unit(F, F.bid);
    const bf16_t* K = (const bf16_t*)(ws + WS_K);
    float* kn2 = (float*)(ws + WS_KN2);
    const int gw = F.bid * 8 + F.wid, NGW = F.G * 8;
    for (int it = gw; it < 24 * 128; it += NGW) {
        const int bh = it >> 7, j = it & 127, b = bh / 12, h = bh % 12;
        const u32x4* kr = (const u32x4*)(K + (size_t)(b * SEQ + 64 * j + F.lane) * 768 + h * 64);
        float ss = 0.f;
#pragma unroll
        for (int c = 0; c < 8; ++c) {
            const u32x4 w = kr[c];
            const unsigned ww[4] = {w.x, w.y, w.z, w.w};
#pragma unroll
            for (int i = 0; i < 4; ++i) { const float a = __uint_as_float(ww[i] << 16), bb = __uint_as_float(ww[i] & 0xffff0000u); ss += a * a + bb * bb; }
        }
        ss = wave_max(ss);
        if (F.lane == 0) kn2[it] = ss;
    }
}

DI void mem_attn_unit(Frame& F, int l, int v) {
    unsigned char* ws = F.ws;
    const int qb = v >> 3, bm = v & 7, b = bm >> 2, mh = bm & 3;
    const bf16_t* Q = (const bf16_t*)(ws + WS_MQ) + (size_t)b * SEQ * 256 + mh * 64;
    const bf16_t* K = (const bf16_t*)(ws + WS_MK) + (size_t)l * 512 * 256 + (size_t)b * 256 * 256 + mh * 64;
    const bf16_t* Vt = (const bf16_t*)(ws + WS_MVT) + (size_t)(l * 2 + b) * 256 * 256 + (size_t)mh * 64 * 256;
    bf16_t* O = (bf16_t*)(ws + WS_MERGED) + (size_t)b * SEQ * 1024 + 768 + mh * 64;
    attn_unit<64, false, false>(F.lds, Q, 256, K, 256, Vt, 256, nullptr, O, 1024, qb * 256, 4, false, nullptr, F.wid);
}
DI void phase_attn0(Frame& F, const Params& P) {
    F.lane = vlane(); F.tid = F.wid * 64 + F.lane;
    unsigned char* ws = F.ws;
    constexpr int NU = 768 + 256 + 512;
    for (;;) {
        const int uu = next_unit(F, 0);
        if (uu >= NU) break;
        if (uu % 3 == 2) { conv_pull(F, 0, CONV_A0); continue; }
        const int u = 2 * (uu / 3) + uu % 3;
        if (u < 768) {
            const int qb = 31 - u / 24, bh = u % 24, b = bh / 12, h = bh % 12;
            const bf16_t* Q = (const bf16_t*)(ws + WS_Q) + (size_t)b * SEQ * 768 + h * 64;
            const bf16_t* K = (const bf16_t*)(ws + WS_K) + (size_t)b * SEQ * 768 + h * 64;
            const bf16_t* Vt = (const bf16_t*)(ws + WS_VT) + (size_t)(b * 768 + h * 64) * SEQ;
            const float* cum = (const float*)(ws + WS_CUM) + (size_t)bh * SEQ;
            bf16_t* O = (bf16_t*)(ws + WS_MERGED) + (size_t)b * SEQ * 1024 + h * 64;
            attn_unit<64, true, false>(F.lds, Q, 768, K, 768, Vt, SEQ, cum, O, 1024, qb * 256, 4 * (qb + 1), true, nullptr, F.wid, (const float*)(ws + WS_KN2) + bh * 128);
        } else mem_attn_unit(F, 0, u - 768);
    }
    while (conv_pull(F, 0, 16)) {}
}
DI void phase_attn1(Frame& F, const Params& P) {
    F.lane = vlane(); F.tid = F.wid * 64 + F.lane;
    unsigned char* ws = F.ws;
    constexpr int NCONV = 256, NU = 768 + 256 + NCONV;
    for (;;) {
        const int uu = next_unit(F, 1);
        if (uu >= NU) break;
        if (uu % 5 == 4) { conv_pull(F, 1, CONV_A1); continue; }
        const int u = 4 * (uu / 5) + uu % 5;
        if (u < 768) {
            const int qb = 31 - u / 24, bh = u % 24, b = bh / 12, h = bh % 12;
            const bf16_t* Q = (const bf16_t*)(ws + WS_Q) + (size_t)b * SEQ * 1152 + h * 96;
            const bf16_t* K = (const bf16_t*)(ws + WS_K) + (size_t)b * SEQ * 1152 + h * 96;
            const bf16_t* Vt = (const bf16_t*)(ws + WS_VT) + (size_t)(b * 768 + h * 64) * SEQ;
            bf16_t* O = (bf16_t*)(ws + WS_MERGED) + (size_t)b * SEQ * 1024 + h * 64;
            attn_unit_pipe<96, true>(F.lds, Q, 1152, K, 1152, Vt, SEQ, O, 1024, qb * 256, 4 * (qb + 1), KP->pos + (size_t)b * SEQ, F.wid);
        } else mem_attn_unit(F, 1, u - 768);
    }
    while (conv_pull(F, 1, 16)) {}
}

DI void phase_outproj(Frame& F, const float* X, const bf16_t* Wt) {
    F.lane = vlane(); F.tid = F.wid * 64 + F.lane;
    unsigned char* ws = F.ws;
    pg8::Gemm g{(const bf16_t*)(ws + WS_MERGED), Wt, 1024}; pg8::StaticOrder S; S.init(T, 1024, 1024, F.G, F.bid);
    EpiResF32 E{(float*)(ws + WS_Y), X};
    pg8::gemm_phase<EpiResF32, pg8::StaticOrder, false>(F.lds, g, S, E, F.wid);
}


DI void phase_ln_router(Frame& F, const Params& P, int l) {
    F.lane = vlane(); F.tid = F.wid * 64 + F.lane;
    unsigned char* ws = F.ws;
    LAS float* wt = (LAS float*)F.lds;
    const f32x4* wr4 = (const f32x4*)((const float*)(ws + WS_WRT) + (size_t)l * 32 * 1024);
    LAS int* pairs = (LAS int*)(F.lds + LDS_CTL + 1024);
    LAS int* lcnt = (LAS int*)(F.lds + LDS_CTL + 3072); LAS int* gbase = lcnt + 32;
    __syncthreads();
    for (int i = F.tid; i < 1024 * 32 / 4; i += NTHREADS) ((LAS f32x4*)wt)[i] = wr4[i];
    if (F.tid < 32) lcnt[F.tid] = 0;
    __syncthreads();
    const float* g = KP->ln_g + (size_t)(l * 2 + 0) * DM; const float* bt = KP->ln_b + (size_t)(l * 2 + 0) * DM;
    const float* br = KP->moe_b_r + l * 32;
    const float* Y = (const float*)(ws + WS_Y);
    bf16_t* X1B = (bf16_t*)(ws + WS_X1B);
    int* PE = (int*)(ws + WS_PE); int* PPOS = (int*)(ws + WS_PPOS); float* GATE = (float*)(ws + WS_GATE); int* TOKOF = (int*)(ws + WS_TOKOF);
    unsigned* cnt = F.ctl + CW_CNT + l * 32 * 64;
    const int gw = F.bid * 8 + F.wid, NGW = F.G * 8;
    int it = 0;
    f32x4 vnx[4];
    if (gw < T) {
#pragma unroll
        for (int j = 0; j < 4; ++j) vnx[j] = *((const f32x4*)(Y + (size_t)gw * DM) + F.lane + 64 * j);
    }
    for (int row = gw; row < T; row += NGW, ++it) {
        f32x4 v[4]; float s = 0.f;
#pragma unroll
        for (int j = 0; j < 4; ++j) { v[j] = vnx[j]; s += (v[j][0] + v[j][1]) + (v[j][2] + v[j][3]); }
        if (row + NGW < T) {
#pragma unroll
            for (int j = 0; j < 4; ++j) vnx[j] = *((const f32x4*)(Y + (size_t)(row + NGW) * DM) + F.lane + 64 * j);
        }
        const float mean = wave_sum(s) * (1.f / DM); float s2 = 0.f;
#pragma unroll
        for (int j = 0; j < 4; ++j) { v[j] = v[j] - mean; s2 += (v[j][0] * v[j][0] + v[j][1] * v[j][1]) + (v[j][2] * v[j][2] + v[j][3] * v[j][3]); }
        const float rstd = 1.0f / sqrtf(wave_sum(s2) * (1.f / DM) + LN_EPS);
#pragma unroll
        for (int j = 0; j < 4; ++j) {
            const f32x4 gg = *((const f32x4*)g + F.lane + 64 * j), bb = *((const f32x4*)bt + F.lane + 64 * j);
            v[j] = v[j] * rstd * gg + bb;
            *((u32x2*)(X1B + (size_t)row * DM) + F.lane + 64 * j) = (u32x2){cvtpk(v[j][0], v[j][1]), cvtpk(v[j][2], v[j][3])};
        }
        float part[16];
        f32x4 wc[4], wc2[4], wn[4], wn2[4];
#pragma unroll
        for (int j = 0; j < 4; ++j) { wc[j] = *((const LAS f32x4*)(wt) + F.lane + 64 * j); wc2[j] = *((const LAS f32x4*)(wt + 16 * 1024) + F.lane + 64 * j); }
#pragma unroll
        for (int i = 0; i < 16; ++i) {
            if (i + 1 < 16) {
#pragma unroll
                for (int j = 0; j < 4; ++j) { wn[j] = *((const LAS f32x4*)(wt + (i + 1) * 1024) + F.lane + 64 * j); wn2[j] = *((const LAS f32x4*)(wt + (i + 17) * 1024) + F.lane + 64 * j); }
            }
            asm volatile("" ::: "memory");
            float a = 0.f, b = 0.f;
#pragma unroll
            for (int j = 0; j < 4; ++j) {
                a += (v[j][0] * wc[j][0] + v[j][1] * wc[j][1]) + (v[j][2] * wc[j][2] + v[j][3] * wc[j][3]);
                b += (v[j][0] * wc2[j][0] + v[j][1] * wc2[j][1]) + (v[j][2] * wc2[j][2] + v[j][3] * wc2[j][3]);
            }
            const auto rr = __builtin_amdgcn_permlane32_swap(__float_as_uint(a), __float_as_uint(b), false, false);
            part[i] = __uint_as_float(rr[0]) + __uint_as_float(rr[1]);
#pragma unroll
            for (int j = 0; j < 4; ++j) { wc[j] = wn[j]; wc2[j] = wn2[j]; }
        }
#pragma unroll
        for (int i = 0; i < 8; ++i) {
            const auto rr = __builtin_amdgcn_permlane16_swap(__float_as_uint(part[i]), __float_as_uint(part[i + 8]), false, false);
            part[i] = __uint_as_float(rr[0]) + __uint_as_float(rr[1]);
        }
#pragma unroll
        for (int i = 0; i < 4; ++i) { const bool up = (F.lane & 8) != 0; const float keep = up ? part[i + 4] : part[i], send = up ? part[i] : part[i + 4]; part[i] = keep + __shfl_xor(send, 8); }
#pragma unroll
        for (int i = 0; i < 2; ++i) { const bool up = (F.lane & 4) != 0; const float keep = up ? part[i + 2] : part[i], send = up ? part[i] : part[i + 2]; part[i] = keep + __shfl_xor(send, 4); }
        { const bool up = (F.lane & 2) != 0; const float keep = up ? part[1] : part[0], send = up ? part[0] : part[1]; part[0] = keep + __shfl_xor(send, 2); }
        float logit = part[0] + __shfl_xor(part[0], 1);
        const int myexp = F.lane >> 1;
        logit += br[myexp];
        int rank = 0;
#pragma unroll
        for (int e = 0; e < 32; ++e) {
            const float ve = __uint_as_float((unsigned)__builtin_amdgcn_readlane((int)__float_as_uint(logit), 2 * e));
            rank += (ve > logit || (ve == logit && e < myexp)) ? 1 : 0;
        }
        float tv[4]; int te[4];
#pragma unroll
        for (int k = 0; k < 4; ++k) {
            const unsigned long long bal = __ballot(rank == k);
            const int ln = __ffsll((long long)bal) - 1;
            te[k] = ln >> 1; tv[k] = __uint_as_float((unsigned)__builtin_amdgcn_readlane((int)__float_as_uint(logit), ln));
        }
        const float e1 = __expf(tv[1] - tv[0]), e2 = __expf(tv[2] - tv[0]), e3 = __expf(tv[3] - tv[0]);
        const float rs = 1.0f / (1.0f + e1 + e2 + e3);
        if (F.lane < 4) {
            const int k = F.lane;
            const int e = k == 0 ? te[0] : k == 1 ? te[1] : k == 2 ? te[2] : te[3];
            const float gt = (k == 0 ? 1.0f : k == 1 ? e1 : k == 2 ? e2 : e3) * rs;
            const int rk = __hip_atomic_fetch_add(lcnt + e, 1, __ATOMIC_RELAXED, __HIP_MEMORY_SCOPE_WORKGROUP);
            PE[row * 4 + k] = e; GATE[row * 4 + k] = gt; pairs[(F.wid * 16 + (it & 15)) * 4 + k] = e | (rk << 8);
        }
    }
    __syncthreads();
    if (F.tid < 32) { const int c = lcnt[F.tid]; gbase[F.tid] = c ? (int)atomicAdd(cnt + F.tid * 64, (unsigned)c) : 0; }
    __syncthreads();
    it = 0;
    for (int row = gw; row < T; row += NGW, ++it) {
        if (F.lane < 4) {
            const int pr = pairs[(F.wid * 16 + (it & 15)) * 4 + F.lane], e = pr & 255, p = gbase[e] + (pr >> 8);
            PPOS[row * 4 + F.lane] = p; TOKOF[(size_t)e * T + p] = row;
        }
    }
}

DI void moe_tables(Frame& F, int l, LAS int* tstart, LAS int* soff) {
    __syncthreads();
    if (F.tid == 0) {
        int ts = 0;
        for (int e = 0; e < 32; ++e) {
            const int c = (int)__hip_atomic_load(F.ctl + CW_CNT + (l * 32 + e) * 64, __ATOMIC_RELAXED, __HIP_MEMORY_SCOPE_AGENT);
            tstart[e] = ts; soff[e] = ts * 256; tstart[80 + e] = c; ts += (c + 255) >> 8;
        }
        tstart[32] = ts; soff[32] = ts * 256;
    }
    __syncthreads();
}
DI void phase_moe_gu(Frame& F, const Params& P, int l) {
    F.lane = vlane(); F.tid = F.wid * 64 + F.lane;
    unsigned char* ws = F.ws;
    LAS int* tstart = (LAS int*)(F.lds + LDS_CTL + 64); LAS int* soff = tstart + 40;
    moe_tables(F, l, tstart, soff);
    pg8::Gemm g{(const bf16_t*)(ws + WS_X1B), (const bf16_t*)(ws + WS_W_GU) + (size_t)l * 32 * 2048 * 1024, 1024};
    LAS int* ulist = (LAS int*)(F.lds + LDS_CTL + 3328);
    MoeOrder::build(F, tstart, 8, ulist);
    MoeOrder S{tstart, 3, true, (const int*)(ws + WS_TOKOF), (const LAS int*)(F.lds + LDS_CTL + 1024), ulist};
    EpiGU E{(bf16_t*)(ws + WS_H), KP->moe_b_gu + (size_t)l * 32 * 2048};
    pg8::gemm_phase<EpiGU, MoeOrder, true>(F.lds, g, S, E, F.wid);
    if (l == 0) { const int rem = (tstart[32] * 8) % F.G; if (rem && F.bid >= rem) conv_pull(F, 1, CONV_GU); }
}
DI void phase_moe_dn(Frame& F, const Params& P, int l) {
    F.lane = vlane(); F.tid = F.wid * 64 + F.lane;
    unsigned char* ws = F.ws;
    LAS int* tstart = (LAS int*)(F.lds + LDS_CTL + 64); LAS int* soff = tstart + 40;
    moe_tables(F, l, tstart, soff);
    pg8::Gemm g{(const bf16_t*)(ws + WS_H), (const bf16_t*)(ws + WS_W_DN) + (size_t)l * 32 * 1024 * 1024, 1024};
    LAS int* ulist = (LAS int*)(F.lds + LDS_CTL + 3328);
    MoeOrder::build(F, tstart, 4, ulist);
    MoeOrder S{tstart, 2, false, nullptr, nullptr, ulist};
    EpiDN E{(bf16_t*)(ws + WS_YE), KP->moe_b_dn + (size_t)l * 32 * 1024};
    pg8::gemm_phase<EpiDN, MoeOrder, true>(F.lds, g, S, E, F.wid);
    if (l == 0) { const int rem = (tstart[32] * 4) % F.G; if (rem && F.bid >= rem) conv_pull(F, 1, CONV_DN); }
}


DI void phase_combine(Frame& F, const Params& P, int l, float* outf, bf16_t* outb) {
    F.lane = vlane(); F.tid = F.wid * 64 + F.lane;
    unsigned char* ws = F.ws;
    LAS int* tstart = (LAS int*)(F.lds + LDS_CTL + 64); LAS int* soff = tstart + 40;
    moe_tables(F, l, tstart, soff);
    const float* g = KP->ln_g + (size_t)(l * 2 + 1) * DM; const float* bt = KP->ln_b + (size_t)(l * 2 + 1) * DM;
    const float* X1 = (const float*)(ws + WS_Y); const bf16_t* YE = (const bf16_t*)(ws + WS_YE);
    const float* g1 = KP->ln_g + (size_t)(l * 2 + 0) * DM; const float* b1 = KP->ln_b + (size_t)(l * 2 + 0) * DM;
    const int* PE = (const int*)(ws + WS_PE); const int* PPOS = (const int*)(ws + WS_PPOS); const float* GATE = (const float*)(ws + WS_GATE);
    const int gw = F.bid * 8 + F.wid, NGW = F.G * 8;
    typedef int i32x4 __attribute__((ext_vector_type(4)));
    i32x4 ie, ip; f32x4 ig;
    f32x4 xn[4]; u32x2 yn[4][4]; f32x4 gn;
#define CB_LOADIDX(r) do { ie = *(const i32x4*)(PE + (size_t)(r) * 4); ip = *(const i32x4*)(PPOS + (size_t)(r) * 4); ig = *(const f32x4*)(GATE + (size_t)(r) * 4); } while (0)
#define CB_LOADDATA(r) do { gn = ig; \
        _Pragma("unroll") for (int j = 0; j < 4; ++j) xn[j] = *((const f32x4*)(X1 + (size_t)(r) * DM) + F.lane + 64 * j); \
        _Pragma("unroll") for (int k = 0; k < 4; ++k) { const int slot = soff[ie[k]] + ip[k]; const u32x2* yr = (const u32x2*)(YE + (size_t)slot * 1024) + F.lane; \
            _Pragma("unroll") for (int j = 0; j < 4; ++j) yn[k][j] = yr[64 * j]; } } while (0)
    if (gw < T) { CB_LOADIDX(gw); CB_LOADDATA(gw); if (gw + NGW < T) CB_LOADIDX(gw + NGW); }
    for (int row = gw; row < T; row += NGW) {
        f32x4 v[4]; u32x2 yc[4][4]; f32x4 gc = gn;
        {
            float s0 = 0.f;
#pragma unroll
            for (int j = 0; j < 4; ++j) { v[j] = xn[j]; s0 += (v[j][0] + v[j][1]) + (v[j][2] + v[j][3]); }
            const float mean0 = wave_sum(s0) * (1.f / DM); float q0 = 0.f;
#pragma unroll
            for (int j = 0; j < 4; ++j) { v[j] = v[j] - mean0; q0 += (v[j][0] * v[j][0] + v[j][1] * v[j][1]) + (v[j][2] * v[j][2] + v[j][3] * v[j][3]); }
            const float rstd0 = 1.0f / sqrtf(wave_sum(q0) * (1.f / DM) + LN_EPS);
#pragma unroll
            for (int j = 0; j < 4; ++j) {
                const f32x4 gg = *((const f32x4*)g1 + F.lane + 64 * j), bb = *((const f32x4*)b1 + F.lane + 64 * j);
                v[j] = (v[j] * rstd0 * gg + bb) * ALPHA;
            }
        }
#pragma unroll
        for (int k = 0; k < 4; ++k)
#pragma unroll
            for (int j = 0; j < 4; ++j) yc[k][j] = yn[k][j];
        if (row + NGW < T) { CB_LOADDATA(row + NGW); if (row + 2 * NGW < T) CB_LOADIDX(row + 2 * NGW); }
#pragma unroll
        for (int k = 0; k < 4; ++k) {
            const float gt = gc[k];
#pragma unroll
            for (int j = 0; j < 4; ++j) {
                const u32x2 w = yc[k][j];
                v[j][0] += gt * __uint_as_float(w.x << 16); v[j][1] += gt * __uint_as_float(w.x & 0xffff0000u);
                v[j][2] += gt * __uint_as_float(w.y << 16); v[j][3] += gt * __uint_as_float(w.y & 0xffff0000u);
            }
        }
        float s = 0.f;
#pragma unroll
        for (int j = 0; j < 4; ++j) s += (v[j][0] + v[j][1]) + (v[j][2] + v[j][3]);
        const float mean = wave_sum(s) * (1.f / DM); float s2 = 0.f;
#pragma unroll
        for (int j = 0; j < 4; ++j) { v[j] = v[j] - mean; s2 += (v[j][0] * v[j][0] + v[j][1] * v[j][1]) + (v[j][2] * v[j][2] + v[j][3] * v[j][3]); }
        const float rstd = 1.0f / sqrtf(wave_sum(s2) * (1.f / DM) + LN_EPS);
#pragma unroll
        for (int j = 0; j < 4; ++j) {
            const f32x4 gg = *((const f32x4*)g + F.lane + 64 * j), bb = *((const f32x4*)bt + F.lane + 64 * j);
            v[j] = v[j] * rstd * gg + bb;
            *((f32x4*)(outf + (size_t)row * DM) + F.lane + 64 * j) = v[j];
            if (outb) *((u32x2*)(outb + (size_t)row * DM) + F.lane + 64 * j) = (u32x2){cvtpk(v[j][0], v[j][1]), cvtpk(v[j][2], v[j][3])};
        }
    }
#undef CB_LOADIDX
#undef CB_LOADDATA
}

DI void phase_lat(Frame& F) {
    F.lane = vlane(); F.tid = F.wid * 64 + F.lane;
    unsigned char* ws = F.ws;
    pg8::Gemm g{(const bf16_t*)(ws + WS_XB), (const bf16_t*)(ws + WS_W_BIN), 1024}; pg8::StaticOrder S; S.init(T, 1024, 1024, F.G, F.bid);
    EpiLat E{(float*)(ws + WS_LAT), 928};
    pg8::gemm_phase<EpiLat, pg8::StaticOrder, false>(F.lds, g, S, E, F.wid);
}

DI void phase_latrows(Frame& F, const Params& P) {
    F.lane = vlane(); F.tid = F.wid * 64 + F.lane;
    unsigned char* ws = F.ws;
    const float* LAT = (const float*)(ws + WS_LAT);
    bf16_t* CKV = (bf16_t*)(ws + WS_CKV); bf16_t* CQ = (bf16_t*)(ws + WS_CQ); bf16_t* MQ = (bf16_t*)(ws + WS_MQ); bf16_t* Kb = (bf16_t*)(ws + WS_K);
    const int gw = F.bid * 8 + F.wid, NGW = F.G * 8;
    for (int row = gw; row < T; row += NGW) {
        const float* lr = LAT + (size_t)row * 1024;
        {
            const f32x4 v = *((const f32x4*)lr + F.lane);
            const float ss = wave_sum((v[0] * v[0] + v[1] * v[1]) + (v[2] * v[2] + v[3] * v[3]));
            const float rs = 1.0f / sqrtf(ss * (1.f / 256.f) + RMS_EPS);
            const f32x4 gg = *((const f32x4*)KP->kv_g + F.lane);
            const f32x4 o = v * rs * gg;
            *((u32x2*)(CKV + (size_t)row * 256) + F.lane) = (u32x2){cvtpk(o[0], o[1]), cvtpk(o[2], o[3])};
        }
        {
            const f32x4 v0 = *((const f32x4*)(lr + 288) + F.lane);
            f32x4 v1 = (f32x4){0.f, 0.f, 0.f, 0.f};
            if (F.lane < 32) v1 = *((const f32x4*)(lr + 288 + 256) + F.lane);
            const float ss = wave_sum((v0[0] * v0[0] + v0[1] * v0[1]) + (v0[2] * v0[2] + v0[3] * v0[3]) + (v1[0] * v1[0] + v1[1] * v1[1]) + (v1[2] * v1[2] + v1[3] * v1[3]));
            const float rs = 1.0f / sqrtf(ss * (1.f / 384.f) + RMS_EPS);
            const f32x4 g0 = *((const f32x4*)KP->b_g_q + F.lane);
            const f32x4 o0 = v0 * rs * g0;
            *((u32x2*)(CQ + (size_t)row * 384) + F.lane) = (u32x2){cvtpk(o0[0], o0[1]), cvtpk(o0[2], o0[3])};
            if (F.lane < 32) {
                const f32x4 g1 = *((const f32x4*)(KP->b_g_q + 256) + F.lane);
                const f32x4 o1 = v1 * rs * g1;
                *((u32x2*)(CQ + (size_t)row * 384 + 256) + F.lane) = (u32x2){cvtpk(o1[0], o1[1]), cvtpk(o1[2], o1[3])};
            }
        }
        {
            const f32x4 v = *((const f32x4*)(lr + 672) + F.lane) * (0.125f * LOG2E);
            *((u32x2*)(MQ + (size_t)row * 256) + F.lane) = (u32x2){cvtpk(v[0], v[1]), cvtpk(v[2], v[3])};
        }
        if (F.lane < 16) {
            const int i = F.lane;
            const float p = (float)KP->pos[row];
            const float inv = exp2f(-(float)i * (13.287712379549449f / 16.0f));
            float sn, cs; sincos_cw(p * inv, sn, cs);
            const float x1 = lr[256 + i], x2 = lr[256 + 16 + i];
            const unsigned short o1 = (unsigned short)(cvtpk(x1 * cs - x2 * sn, 0.f) & 0xffffu), o2 = (unsigned short)(cvtpk(x1 * sn + x2 * cs, 0.f) & 0xffffu);
#pragma unroll
            for (int h = 0; h < NH; ++h) { Kb[(size_t)row * 1152 + h * 96 + 64 + i] = o1; Kb[(size_t)row * 1152 + h * 96 + 80 + i] = o2; }
        }
    }
}
#ifndef UPSEL
#define UPSEL 7
#endif
struct RouteK1 { unsigned char* ws; DI Dst operator()(const pg8::Unit& u) const { return Dst{(bf16_t*)(ws + WS_K), 1152, u.pm * 256, u.pn * 384, 256, 1.0f, true}; } };
struct RouteQ1 { unsigned char* ws; DI Dst operator()(const pg8::Unit& u) const { const int nv = 1152 - u.pn * 256; return Dst{(bf16_t*)(ws + WS_Q), 1152, u.pm * 256, u.pn * 256, nv < 256 ? nv : 256, 0.10206207261596577f * LOG2E, false}; } };
DI void phase_up1(Frame& F) {
    F.lane = vlane(); F.tid = F.wid * 64 + F.lane;
    unsigned char* ws = F.ws;
    const bf16_t* ckv = (const bf16_t*)(ws + WS_CKV); const bf16_t* cq = (const bf16_t*)(ws + WS_CQ);
    const bf16_t* wukv = (const bf16_t*)(ws + WS_W_UKV); const bf16_t* wuq = (const bf16_t*)(ws + WS_W_UQ);
#if (UPSEL & 1)
    {
        pg8::Gemm g{cq, wuq, 384}; pg8::StaticOrder S; S.init(T, 1280, 384, F.G, F.bid);
        EpiBf16R<RouteQ1> E{RouteQ1{ws}};
        pg8::gemm_phase<EpiBf16R<RouteQ1>, pg8::StaticOrder, true>(F.lds, g, S, E, F.wid);
    }
#endif
#if (UPSEL & 2)
    {
        pg8::Gemm g{ckv, wukv, 256}; pg8::StaticOrder S; S.init(T, 768, 256, F.G, F.G - 1 - F.bid);
        EpiBf16R<RouteK1> E{RouteK1{ws}};
        pg8::gemm_phase<EpiBf16R<RouteK1>, pg8::StaticOrder, true>(F.lds, g, S, E, F.wid);
    }
#endif
#if (UPSEL & 4)
    {
        pg8::Gemm g{wukv + (size_t)768 * 256, ckv, 256}; pg8::StaticOrder S; S.init(768, T, 256, F.G, F.G - 1 - F.bid);
        EpiBf16R<RouteVT> E{RouteVT{ws}};
        pg8::gemm_phase<EpiBf16R<RouteVT>, pg8::StaticOrder, true>(F.lds, g, S, E, F.wid);
    }
#endif
}


__global__ void __launch_bounds__(NTHREADS) mega_fwd(Params P) {
    extern __shared__ __attribute__((aligned(16))) unsigned char lds_raw[];
    Frame F;
    F.lds = (LAS unsigned char*)lds_raw; F.ws = KP->ws; F.ctl = (unsigned*)(KP->ws + WS_CTL);
    F.wid = __builtin_amdgcn_readfirstlane((int)threadIdx.x >> 6); F.lane = vlane(); F.tid = F.wid * 64 + F.lane; F.G = gridDim.x; F.bid = blockIdx.x;
    const int lo = KP->ph_lo, hi = KP->ph_hi;
    { volatile LAS unsigned* st0 = (volatile LAS unsigned*)(F.lds + LDS_CTL + 512); if (F.tid < 2) st0[F.tid] = 0u; }
    __syncthreads();
    XcdBarrier bar = xcd_barrier_post(F.ctl + CW_BAR, (volatile LAS unsigned*)(F.lds + LDS_CTL + 512), F.wid);
#ifndef PHMASK
#define PHMASK 0x1ffff
#endif
#define IN(k) (((PHMASK >> (k)) & 1) && lo <= (k) && (k) < hi)
#define SEAM(k) do { if (IN(k) && IN((k) + 1)) { if (KP->use_grid_sync) xcd_barrier(bar); } } while (0)
    unsigned char* ws = KP->ws;
    if (KP->use_grid_sync == 2) cg::this_grid().sync();
    if (IN(0)) { phase_prologue(F, P);
    }
    SEAM(0);
    if (IN(1)) { phase_proj0(F, P);
        if (KP->use_grid_sync) xcd_barrier(bar); phase_scan_knorm(F); }
    SEAM(1);
    if (IN(2)) { phase_attn0(F, P);
    }
    SEAM(2);
    if (IN(3)) { phase_outproj(F, KP->x, (const bf16_t*)(ws + WS_W_AOUT));
    }
    SEAM(3);
    if (IN(4)) phase_ln_router(F, P, 0);
    SEAM(4);
    if (IN(5)) phase_moe_gu(F, P, 0);
    SEAM(5);
    if (IN(6)) phase_moe_dn(F, P, 0);
    SEAM(6);
    if (IN(7)) phase_combine(F, P, 0, (float*)(ws + WS_X2), (bf16_t*)(ws + WS_XB));
    SEAM(7);
    if (IN(8)) phase_lat(F);
    SEAM(8);
    if (IN(9)) phase_latrows(F, P);
    SEAM(9);
    if (IN(10)) { phase_up1(F);
    }
    SEAM(10);
    if (IN(11)) { phase_attn1(F, P);
    }
    SEAM(11);
    if (IN(12)) phase_outproj(F, (const float*)(ws + WS_X2), (const bf16_t*)(ws + WS_W_BOUT));
    SEAM(12);
    if (IN(13)) phase_ln_router(F, P, 1);
    SEAM(13);
    if (IN(14)) { phase_moe_gu(F, P, 1);
    }
    SEAM(14);
    if (IN(15)) { phase_moe_dn(F, P, 1);
    }
    SEAM(15);
    if (IN(16)) { phase_combine(F, P, 1, KP->out, nullptr);
    }
#undef IN
#undef SEAM
}

constexpr int N_PHASES = 17;
#ifndef MK_N_LAUNCHES
#define MK_N_LAUNCHES 1
#endif

extern "C" void kernel_launch(void* const* d_in, const int* in_sizes, int n_in, void* d_out, int out_size, void* d_ws, size_t ws_size, hipStream_t stream) {
    static int grid = 0;
    if (grid == 0) {
        if (n_in != 22 || ws_size < WS_END) { fprintf(stderr, "kernel_launch: need 22 inputs and %zu bytes of workspace (got %d, %zu)\n", (size_t)WS_END, n_in, ws_size); grid = -1; return; }
        int dev = 0, cus = 0, per_cu = 0;
        hipGetDevice(&dev);
        hipDeviceGetAttribute(&cus, hipDeviceAttributeMultiprocessorCount, dev);
        if (hipFuncSetAttribute((const void*)mega_fwd, hipFuncAttributeMaxDynamicSharedMemorySize, LDS_BYTES) != hipSuccess) fprintf(stderr, "kernel_launch: hipFuncSetAttribute failed\n");
        if (hipOccupancyMaxActiveBlocksPerMultiprocessor(&per_cu, (const void*)mega_fwd, NTHREADS, LDS_BYTES) != hipSuccess || per_cu < 1) { fprintf(stderr, "kernel_launch: occupancy query failed (%d)\n", per_cu); per_cu = 1; }
        (void)hipGetLastError();
        grid = cus * (per_cu > 1 ? 1 : per_cu);
        if (grid <= 0) grid = 256;
    }
    if (grid < 0) return;
    hipMemsetAsync((char*)d_ws + WS_CTL, 0, CTL_BYTES, stream);
    Params p{};
    p.x = (const float*)d_in[0]; p.mem = (const float*)d_in[1]; p.pos = (const int*)d_in[2];
    p.a_w_in = (const float*)d_in[3]; p.a_b_f = (const float*)d_in[4]; p.a_w_out = (const float*)d_in[5];
    p.b_w_in = (const float*)d_in[6]; p.b_g_q = (const float*)d_in[7]; p.b_w_uq = (const float*)d_in[8]; p.b_w_out = (const float*)d_in[9];
    p.kv_w_dkv = (const float*)d_in[10]; p.kv_g = (const float*)d_in[11]; p.kv_w_ukv = (const float*)d_in[12]; p.mem_w_kv = (const float*)d_in[13];
    p.ln_g = (const float*)d_in[14]; p.ln_b = (const float*)d_in[15]; p.moe_w_r = (const float*)d_in[16]; p.moe_b_r = (const float*)d_in[17];
    p.moe_w_gu = (const float*)d_in[18]; p.moe_b_gu = (const float*)d_in[19]; p.moe_w_dn = (const float*)d_in[20]; p.moe_b_dn = (const float*)d_in[21];
    p.out = (float*)d_out; p.ws = (unsigned char*)d_ws;
    if (MK_N_LAUNCHES == 1) {
        p.ph_lo = 0; p.ph_hi = N_PHASES; p.use_grid_sync = 1;
        void* args[] = {&p};
        hipError_t e = hipLaunchCooperativeKernel((const void*)mega_fwd, dim3(grid), dim3(NTHREADS), args, LDS_BYTES, stream);
        if (e != hipSuccess) fprintf(stderr, "kernel_launch: cooperative launch failed: %s (grid %d)\n", hipGetErrorString(e), grid);
    } else {
        for (int ph = 0; ph < N_PHASES; ++ph) {
            p.ph_lo = ph; p.ph_hi = ph + 1; p.use_grid_sync = 0;
            hipLaunchKernelGGL(mega_fwd, dim3(grid), dim3(NTHREADS), LDS_BYTES, stream, p);
        }
    }
}
```

```cpp
#include <hip/hip_runtime.h>
#include <hip/hip_cooperative_groups.h>
#include <cstdio>
#include <cstdint>
#include <cmath>
namespace cg = cooperative_groups;

#define DI __device__ __forceinline__
#define LAS __attribute__((address_space(3)))
typedef unsigned short bf16_t;
typedef short bf16x8 __attribute__((ext_vector_type(8)));
typedef float f32x4 __attribute__((ext_vector_type(4)));
typedef float f32x2 __attribute__((ext_vector_type(2)));
typedef float f32x16 __attribute__((ext_vector_type(16)));
typedef unsigned u32x4 __attribute__((ext_vector_type(4)));
typedef unsigned u32x2 __attribute__((ext_vector_type(2)));
typedef __bf16 bf16x2_t __attribute__((ext_vector_type(2)));

constexpr int NB = 2, SEQ = 8192, T = NB * SEQ, DM = 1024;
constexpr int NH = 12, NMEM = 256;
constexpr int FOX_IN = 2572;
constexpr int NE = 32;
constexpr float LOG2E = 1.4426950408889634f;
constexpr float ALPHA = 1.4142135623730951f;
constexpr float LN_EPS = 1e-5f, RMS_EPS = 1e-6f;
constexpr int NTHREADS = 512;
constexpr int LDS_BYTES = 131072 + 4096;
constexpr int LDS_CTL = 131072;
constexpr int SLOT_ROWS = 65536 + NE * 256;

constexpr size_t al256(size_t x) { return (x + 255) & ~(size_t)255; }
constexpr size_t WS_CTL = 0, CTL_BYTES = 65536;
constexpr size_t WS_W_AIN = al256(WS_CTL + CTL_BYTES);
constexpr size_t WS_W_AOUT = al256(WS_W_AIN + (size_t)2560 * 1024 * 2);
constexpr size_t WS_W_BIN = al256(WS_W_AOUT + (size_t)1024 * 1024 * 2);
constexpr size_t WS_W_UQ = al256(WS_W_BIN + (size_t)1024 * 1024 * 2);
constexpr size_t WS_W_UKV = al256(WS_W_UQ + (size_t)1280 * 384 * 2);
constexpr size_t WS_W_BOUT = al256(WS_W_UKV + (size_t)1536 * 256 * 2);
constexpr size_t WS_W_MKV = al256(WS_W_BOUT + (size_t)1024 * 1024 * 2);
constexpr size_t WS_W_GU = al256(WS_W_MKV + (size_t)2 * 512 * 1024 * 2);
constexpr size_t WS_W_DN = al256(WS_W_GU + (size_t)2 * 32 * 2048 * 1024 * 2);
constexpr size_t WS_XB = al256(WS_W_DN + (size_t)2 * 32 * 1024 * 1024 * 2);
constexpr size_t WS_MEMB = al256(WS_XB + (size_t)T * 1024 * 2);
constexpr size_t WS_LOGF = al256(WS_MEMB + (size_t)512 * 1024 * 2);
constexpr size_t WS_CUM = al256(WS_LOGF + (size_t)24 * 8192 * 4);
constexpr size_t WS_Q = al256(WS_CUM + (size_t)24 * 8192 * 4);
constexpr size_t WS_K = al256(WS_Q + (size_t)T * 1152 * 2);
constexpr size_t WS_VT = al256(WS_K + (size_t)T * 1152 * 2);
constexpr size_t WS_MQ = al256(WS_VT + (size_t)1536 * 8192 * 2);
constexpr size_t WS_MK = al256(WS_MQ + (size_t)T * 256 * 2);
constexpr size_t WS_MVT = al256(WS_MK + (size_t)2 * 512 * 256 * 2);
constexpr size_t WS_MERGED = al256(WS_MVT + (size_t)2 * 2 * 256 * 256 * 2);
constexpr size_t WS_Y = al256(WS_MERGED + (size_t)T * 1024 * 2);
constexpr size_t WS_X1 = al256(WS_Y + (size_t)T * 1024 * 4);
constexpr size_t WS_X1B = al256(WS_X1 + (size_t)T * 1024 * 4);
constexpr size_t WS_PE = al256(WS_X1B + (size_t)T * 1024 * 2);
constexpr size_t WS_PPOS = al256(WS_PE + (size_t)T * 4 * 4);
constexpr size_t WS_GATE = al256(WS_PPOS + (size_t)T * 4 * 4);
constexpr size_t WS_TOKOF = al256(WS_GATE + (size_t)T * 4 * 4);
constexpr size_t WS_H = al256(WS_TOKOF + (size_t)NE * T * 4);
constexpr size_t WS_YE = al256(WS_H + (size_t)SLOT_ROWS * 1024 * 2);
constexpr size_t WS_LAT = al256(WS_YE + (size_t)SLOT_ROWS * 1024 * 2);
constexpr size_t WS_CKV = al256(WS_LAT + (size_t)T * 1024 * 4);
constexpr size_t WS_CQ = al256(WS_CKV + (size_t)T * 256 * 2);
constexpr size_t WS_X2 = al256(WS_CQ + (size_t)T * 384 * 2);
constexpr size_t WS_KN2 = al256(WS_X2 + (size_t)T * 1024 * 4);
constexpr size_t WS_WRT = al256(WS_KN2 + (size_t)24 * 128 * 4);
constexpr size_t WS_END = al256(WS_WRT + (size_t)2 * 32 * 1024 * 4);
constexpr int CW_CNT = 8192;
constexpr int CW_WORK = 256;
constexpr int CW_BAR = 4096;

struct Params {
    const float* x; const float* mem; const int* pos;
    const float *a_w_in, *a_b_f, *a_w_out, *b_w_in, *b_g_q, *b_w_uq, *b_w_out, *kv_w_dkv, *kv_g, *kv_w_ukv, *mem_w_kv, *ln_g, *ln_b;
    const float *moe_w_r, *moe_b_r, *moe_w_gu, *moe_b_gu, *moe_w_dn, *moe_b_dn;
    float* out; unsigned char* ws; int ph_lo, ph_hi; int use_grid_sync, pad;
};

#define KP ((const __attribute__((address_space(4))) Params*)__builtin_amdgcn_kernarg_segment_ptr())
DI unsigned cvtpk(float lo, float hi) { f32x2 v = {lo, hi}; bf16x2_t b = __builtin_convertvector(v, bf16x2_t); return __builtin_bit_cast(unsigned, b); }
DI float bf2f(unsigned short b) { return __uint_as_float(((unsigned)b) << 16); }
DI float wave_sum(float v) {
#pragma unroll
    for (int o = 1; o < 64; o <<= 1) v += __shfl_xor(v, o);
    return v;
}
DI float wave_max(float v) {
#pragma unroll
    for (int o = 1; o < 64; o <<= 1) v = fmaxf(v, __shfl_xor(v, o));
    return v;
}

DI void sincos_cw(float x, float& sn, float& cs) {
    int j = (int)(x * 1.27323954473516f); j = (j + 1) & ~1;
    const float y = (float)j;
    const float r = ((x - y * 0.78515625f) - y * 2.4187564849853515625e-4f) - y * 3.77489497744594108e-8f;
    const float z = r * r;
    const float sp = ((-1.9515295891e-4f * z + 8.3321608736e-3f) * z - 1.6666654611e-1f) * z * r + r;
    const float cp = ((2.443315711809948e-5f * z - 1.388731625493765e-3f) * z + 4.166664568298827e-2f) * z * z - 0.5f * z + 1.0f;
    const int q = (j >> 1) & 3;
    const float s0 = (q & 1) ? cp : sp, c0 = (q & 1) ? sp : cp;
    sn = (q & 2) ? -s0 : s0;
    cs = ((q + 1) & 2) ? -c0 : c0;
}
DI float fadd_s(float a, float b) { float r; asm("v_add_f32_e32 %0, %1, %2" : "=v"(r) : "v"(a), "v"(b)); return r; }
DI int vlane() { int l; asm volatile("v_mbcnt_lo_u32_b32 %0, -1, 0\n\tv_mbcnt_hi_u32_b32 %0, -1, %0" : "=v"(l)); return l; }
#define LDS_WAIT() asm volatile("s_waitcnt lgkmcnt(0)" ::: "memory")
#define VM_WAIT() asm volatile("s_waitcnt vmcnt(0)" ::: "memory")

#ifndef GEMM_TOKPF
#define GEMM_TOKPF 2
#endif
namespace pg8 {
constexpr int BM = 256, BK = 64, HALF = 128, HTB = HALF * BK * 2, STAGE_BYTES = 8 * HTB, NXCD = 8, WGM = 8;
DI int lds_byte(int r, int c) { const int st = (r >> 4) * 2 + (c >> 5), rr = r & 15, cc = c & 31, ob = rr * 64 + cc * 2; return st * 1024 + (ob ^ (((ob >> 9) & 1) << 5)); }
DI void stage_rc(int b, int& R, int& C) { const int st = b / 1024, sb = b % 1024, swz = sb ^ (((sb >> 9) & 1) << 5); R = (st >> 1) * 16 + swz / 64; C = (st & 1) * 32 + (swz % 64) / 2; }
DI int perm32(int rho) { const int n = rho >> 4, i = rho & 15; return 8 * (i >> 2) + 4 * n + (i & 3); }
struct Unit { int pm, pn; };
struct Gemm { const bf16_t* A; const bf16_t* Bt; int K; };
struct StaticOrder {
    int nM, nN, nwg, G, c, K2;
    DI void init(int M, int N, int K, int G_, int c_) { nM = M / BM; nN = N / BM; nwg = nM * nN; G = G_; c = c_; K2 = K * 2; }
    DI bool next(int i, Unit& u) const {
        const long L = (long)i * G + c; if (L >= nwg) return false;
        int wgid = (int)L; { const int q = nwg / NXCD, r = nwg % NXCD, xcd = wgid % NXCD, off = wgid / NXCD; wgid = (xcd < r ? xcd * (q + 1) : r * (q + 1) + (xcd - r) * q) + off; }
        const int nig = WGM * nN, gid = wgid / nig, fm = gid * WGM, gsz = (nM - fm) < WGM ? (nM - fm) : WGM;
        u.pm = fm + ((wgid % nig) % gsz); u.pn = (wgid % nig) / gsz; return true;
    }
    DI unsigned a_off(const Unit& u, int r) const { return (unsigned)(u.pm * BM + r) * (unsigned)K2; }
    DI unsigned a_off_pf(const Unit& u, int r, int) const { return a_off(u, r); }
    DI void prefetch(const Unit&, int, int, int) const {}
    DI void a_ready(const Unit&) const {}
    DI void done(const Unit&) const {}
};

template <class Epi, class Sched, bool ALIGN_EPI>
DI void gemm_phase(LAS unsigned char* lds, const Gemm g, const Sched& S, const Epi& E, const int wid) {
    const int lane = vlane(), tid = wid * 64 + lane, wr = wid >> 2, wc = wid & 3, fr = lane & 15, fq = lane >> 4;
    const int K = g.K, nt = K / BK;
    int RA[2]; unsigned cA2[2], voffB[2];
#pragma unroll
    for (int i = 0; i < 2; ++i) { int R, C; stage_rc(tid * 16 + i * 8192, R, C); const int Rb = Epi::PERM ? ((R & ~31) + perm32(R & 31)) : R;
        RA[i] = R; cA2[i] = (unsigned)C * 2u; voffB[i] = (unsigned)(Rb * K + C) * 2u; }
    const size_t kstep = (size_t)(BK * 2);
    const size_t hstep = (size_t)HALF * K * 2;
    const size_t tstep = 2 * hstep;
    const unsigned ldsw = (unsigned)wid * 1024u;
    const int aoff = lds_byte(wr * 64 + fr, fq * 8), boff = lds_byte(wc * 32 + fr, fq * 8);
#define PG8_SA(b, h) (((b) * 2 + (h)) * HTB)
#define PG8_SB(b, h) ((4 + (b) * 2 + (h)) * HTB)
#define PG8_STAGE_B(bufoff, gbase) do { _Pragma("unroll") for (int _i = 0; _i < 2; ++_i) \
        __builtin_amdgcn_global_load_lds((const unsigned*)((const char*)(gbase) + voffB[_i]), (LAS unsigned*)(lds + (bufoff) + ldsw + _i * 8192), 16, 0, 0); } while (0)
#define PG8_STAGE_A(bufoff, kbytes, uo) do { _Pragma("unroll") for (int _i = 0; _i < 2; ++_i) \
        __builtin_amdgcn_global_load_lds((const unsigned*)((const char*)g.A + (kbytes) + (uo)[_i]), (LAS unsigned*)(lds + (bufoff) + ldsw + _i * 8192), 16, 0, 0); } while (0)
#define PG8_STAGE_A2(bufoff, kbytes, h) do { _Pragma("unroll") for (int _i = 0; _i < 2; ++_i) \
        __builtin_amdgcn_global_load_lds((const unsigned*)((const char*)g.A + (kbytes) + (last ? uN[h][_i] : uC[h][_i])), (LAS unsigned*)(lds + (bufoff) + ldsw + _i * 8192), 16, 0, 0); } while (0)
#define PG8_LDA(dst, b, h) do { _Pragma("unroll") for (int m = 0; m < 4; ++m) _Pragma("unroll") for (int k = 0; k < 2; ++k) dst[m][k] = *(const LAS bf16x8*)(lds + PG8_SA(b, h) + aoff + m * 2048 + k * 1024); } while (0)
#define PG8_LDB(dst, b, h) do { _Pragma("unroll") for (int n = 0; n < 2; ++n) _Pragma("unroll") for (int k = 0; k < 2; ++k) dst[n][k] = *(const LAS bf16x8*)(lds + PG8_SB(b, h) + boff + n * 2048 + k * 1024); } while (0)
#define PG8_MMA(ai, bj, At, Bt) do { __builtin_amdgcn_s_setprio(1); _Pragma("unroll") for (int m = 0; m < 4; ++m) _Pragma("unroll") for (int n = 0; n < 2; ++n) _Pragma("unroll") for (int k = 0; k < 2; ++k) \
        acc[ai][bj][m][n] = __builtin_amdgcn_mfma_f32_16x16x32_bf16(Bt[n][k], At[m][k], acc[ai][bj][m][n], 0, 0, 0); __builtin_amdgcn_s_setprio(0); } while (0)
#define PG8_WAIT_V(n) asm volatile("s_waitcnt vmcnt(" #n ")" ::: "memory")
#define PG8_WAIT_L(n) asm volatile("s_waitcnt lgkmcnt(" #n ")" ::: "memory")
#define PG8_BAR __builtin_amdgcn_s_barrier()
#define PG8_SCHED __builtin_amdgcn_sched_barrier(0)
    Unit cur, nxt; int ui = 0;
    if (!S.next(0, cur)) return;
    f32x4 acc[2][2][4][2];
#pragma unroll
    for (int a = 0; a < 2; ++a)
#pragma unroll
        for (int b = 0; b < 2; ++b)
#pragma unroll
            for (int m = 0; m < 4; ++m)
#pragma unroll
                for (int n = 0; n < 2; ++n) acc[a][b][m][n] = (f32x4){0.f, 0.f, 0.f, 0.f};
    bf16x8 At[4][2], B0[2][2], B1[2][2];
    unsigned uC[2][2], uN[2][2];
#pragma unroll
    for (int h = 0; h < 2; ++h)
#pragma unroll
        for (int i = 0; i < 2; ++i) uC[h][i] = S.a_off(cur, h * HALF + RA[i]) + cA2[i];
    const char* cB = (const char*)g.Bt + (size_t)cur.pn * tstep;
    S.a_ready(cur);
    PG8_STAGE_B(PG8_SB(0, 0), cB); PG8_STAGE_B(PG8_SB(0, 1), cB + hstep); PG8_STAGE_A(PG8_SA(0, 0), 0, uC[0]); PG8_STAGE_A(PG8_SA(0, 1), 0, uC[1]);
    if (wr == 1) PG8_BAR;
    PG8_WAIT_V(2); PG8_BAR;
    PG8_STAGE_B(PG8_SB(1, 0), cB + kstep); PG8_STAGE_A(PG8_SA(1, 0), kstep, uC[0]); PG8_STAGE_B(PG8_SB(1, 1), cB + hstep + kstep);
    PG8_WAIT_V(6); PG8_BAR;
    for (;;) {
        const bool has_next = S.next(ui + 1, nxt);
        const char* nB = has_next ? (const char*)g.Bt + (size_t)nxt.pn * tstep : cB;
#if GEMM_TOKPF == 1
        if (has_next) S.prefetch(nxt, (ui + 1) & 1, wid, lane);
#elif GEMM_TOKPF == 2
        {
            Unit nx2; const bool has2 = S.next(ui + 2, nx2);
#pragma unroll
            for (int h = 0; h < 2; ++h)
#pragma unroll
                for (int i = 0; i < 2; ++i) uN[h][i] = has_next ? ((ui == 0 ? S.a_off(nxt, h * HALF + RA[i]) : S.a_off_pf(nxt, h * HALF + RA[i], (ui + 1) & 1)) + cA2[i]) : uC[h][i];
            if (has2) S.prefetch(nx2, ui & 1, wid, lane);
        }
#else
#pragma unroll
        for (int h = 0; h < 2; ++h)
#pragma unroll
            for (int i = 0; i < 2; ++i) uN[h][i] = has_next ? (S.a_off(nxt, h * HALF + RA[i]) + cA2[i]) : uC[h][i];
#endif
#pragma nounroll
        for (int t = 0; t < nt; t += 2) {
            const bool last = (t == nt - 2);
            const size_t ka1 = (size_t)(t + 1) * kstep;
            const size_t ka2 = last ? (size_t)0 : (size_t)(t + 2) * kstep, ka3 = ka2 + kstep;
            const char* b2 = last ? nB : cB + (size_t)(t + 2) * kstep; const char* b3 = b2 + kstep;
#if GEMM_TOKPF == 1
            if (last) {
                if (has_next) S.a_ready(nxt);
#pragma unroll
                for (int h = 0; h < 2; ++h)
#pragma unroll
                    for (int i = 0; i < 2; ++i) uN[h][i] = has_next ? (S.a_off_pf(nxt, h * HALF + RA[i], (ui + 1) & 1) + cA2[i]) : uC[h][i];
            }
#endif
            PG8_LDB(B0, 0, 0); PG8_LDB(B1, 0, 1); PG8_SCHED; PG8_LDA(At, 0, 0); PG8_STAGE_A(PG8_SA(1, 1), ka1, uC[1]);
            PG8_WAIT_V(8); PG8_WAIT_L(0); PG8_BAR; PG8_MMA(0, 0, At, B0); PG8_MMA(0, 1, At, B1); PG8_BAR; PG8_SCHED;
            PG8_LDA(At, 0, 1); PG8_STAGE_B(PG8_SB(0, 0), b2); PG8_STAGE_B(PG8_SB(0, 1), b2 + hstep); PG8_STAGE_A2(PG8_SA(0, 0), ka2, 0);
            PG8_WAIT_V(8); PG8_WAIT_L(0); PG8_BAR; PG8_MMA(1, 0, At, B0); PG8_MMA(1, 1, At, B1); PG8_BAR; PG8_SCHED;
            PG8_LDB(B0, 1, 0); PG8_LDB(B1, 1, 1); PG8_SCHED; PG8_LDA(At, 1, 0); PG8_STAGE_A2(PG8_SA(0, 1), ka2, 1);
            PG8_WAIT_V(8); PG8_WAIT_L(0); PG8_BAR; PG8_MMA(0, 0, At, B0); PG8_MMA(0, 1, At, B1); PG8_BAR; PG8_SCHED;
            PG8_LDA(At, 1, 1); PG8_STAGE_B(PG8_SB(1, 0), b3); PG8_STAGE_B(PG8_SB(1, 1), b3 + hstep); PG8_STAGE_A2(PG8_SA(1, 0), ka3, 0);
            PG8_WAIT_V(8); PG8_WAIT_L(0); PG8_BAR; PG8_MMA(1, 0, At, B0); PG8_MMA(1, 1, At, B1); PG8_BAR; PG8_SCHED;
        }
        if constexpr (ALIGN_EPI) { if (wr == 0) PG8_BAR; }
        E(acc, cur, wr, wc, fr, fq); S.done(cur);
        if (!has_next) break;
#pragma unroll
        for (int a = 0; a < 2; ++a)
#pragma unroll
            for (int b = 0; b < 2; ++b)
#pragma unroll
                for (int m = 0; m < 4; ++m)
#pragma unroll
                    for (int n = 0; n < 2; ++n) acc[a][b][m][n] = (f32x4){0.f, 0.f, 0.f, 0.f};
        cur = nxt; cB = nB; ++ui;
#pragma unroll
        for (int h = 0; h < 2; ++h)
#pragma unroll
            for (int i = 0; i < 2; ++i) uC[h][i] = uN[h][i];
        if constexpr (ALIGN_EPI) { if (wr == 1) PG8_BAR; }
    }
    PG8_WAIT_V(0);
    if constexpr (!ALIGN_EPI) { if (wr == 0) PG8_BAR; }
    PG8_BAR;
#undef PG8_SA
#undef PG8_SB
#undef PG8_STAGE_A
#undef PG8_STAGE_A2
#undef PG8_STAGE_B
#undef PG8_LDA
#undef PG8_LDB
#undef PG8_MMA
#undef PG8_WAIT_V
#undef PG8_WAIT_L
#undef PG8_BAR
#undef PG8_SCHED
}
}

struct Dst { bf16_t* O; int ldo, row0, col0, nvalid; float scale; bool headmap; };
template <class Route> struct EpiBf16R {
    static constexpr bool PERM = true;
    Route R;
    DI void operator()(const f32x4 (&acc)[2][2][4][2], const pg8::Unit& u, int wr, int wc, int fr, int fq) const {
        const Dst d = R(u);
#pragma unroll
        for (int ai = 0; ai < 2; ++ai)
#pragma unroll
            for (int m = 0; m < 4; ++m) {
                bf16_t* rowp = d.O + (size_t)(d.row0 + ai * 128 + wr * 64 + m * 16 + fr) * d.ldo + d.col0;
#pragma unroll
                for (int bj = 0; bj < 2; ++bj) {
                    const int c = bj * 128 + wc * 32 + 8 * fq;
                    if (c < d.nvalid) {
                        const f32x4 v0 = acc[ai][bj][m][0] * d.scale, v1 = acc[ai][bj][m][1] * d.scale;
                        u32x4 w; w.x = cvtpk(v0[0], v0[1]); w.y = cvtpk(v0[2], v0[3]); w.z = cvtpk(v1[0], v1[1]); w.w = cvtpk(v1[2], v1[3]);
                        const int oc = d.headmap ? ((c >> 6) * 96 + (c & 63)) : c;
                        *(u32x4*)(rowp + oc) = w;
                    }
                }
            }
    }
};
struct EpiResF32 {
    static constexpr bool PERM = false;
    float* Y; const float* X;
    DI void operator()(const f32x4 (&acc)[2][2][4][2], const pg8::Unit& u, int wr, int wc, int fr, int fq) const {
#pragma unroll
        for (int ai = 0; ai < 2; ++ai)
#pragma unroll
            for (int m = 0; m < 4; ++m) {
                const size_t ro = (size_t)(u.pm * 256 + ai * 128 + wr * 64 + m * 16 + fr) * DM + u.pn * 256 + wc * 32 + 4 * fq;
#pragma unroll
                for (int bj = 0; bj < 2; ++bj)
#pragma unroll
                    for (int n = 0; n < 2; ++n) {
                        const f32x4 xv = *(const f32x4*)(X + ro + bj * 128 + n * 16);
                        *(f32x4*)(Y + ro + bj * 128 + n * 16) = xv * ALPHA + acc[ai][bj][m][n];
                    }
            }
    }
};
struct EpiLat {
    static constexpr bool PERM = false;
    float* O; int ncol;
    DI void operator()(const f32x4 (&acc)[2][2][4][2], const pg8::Unit& u, int wr, int wc, int fr, int fq) const {
#pragma unroll
        for (int ai = 0; ai < 2; ++ai)
#pragma unroll
            for (int m = 0; m < 4; ++m) {
                const int c0 = u.pn * 256 + wc * 32 + 4 * fq;
                float* rowp = O + (size_t)(u.pm * 256 + ai * 128 + wr * 64 + m * 16 + fr) * 1024;
#pragma unroll
                for (int bj = 0; bj < 2; ++bj)
#pragma unroll
                    for (int n = 0; n < 2; ++n) { const int c = c0 + bj * 128 + n * 16; if (c < ncol) *(f32x4*)(rowp + c) = acc[ai][bj][m][n]; }
            }
    }
};
struct EpiGU {
    static constexpr bool PERM = true;
    bf16_t* H; const float* bias;
    DI void operator()(const f32x4 (&acc)[2][2][4][2], const pg8::Unit& u, int wr, int wc, int fr, int fq) const {
        const int e = u.pn >> 3, ct = u.pn & 7;
        const int j = ct * 128 + wc * 32 + 8 * fq;
        const float* be = bias + (size_t)e * 2048;
        f32x4 bg[2], bu[2];
#pragma unroll
        for (int n = 0; n < 2; ++n) { bg[n] = *(const f32x4*)(be + j + 4 * n); bu[n] = *(const f32x4*)(be + 1024 + j + 4 * n); }
#pragma unroll
        for (int ai = 0; ai < 2; ++ai)
#pragma unroll
            for (int m = 0; m < 4; ++m) {
                float h[8];
#pragma unroll
                for (int n = 0; n < 2; ++n)
#pragma unroll
                    for (int i = 0; i < 4; ++i) {
                        const float gg = fminf(acc[ai][0][m][n][i] + bg[n][i], 7.0f);
                        const float uu = fminf(fmaxf(acc[ai][1][m][n][i] + bu[n][i], -7.0f), 7.0f);
                        const float sg = __builtin_amdgcn_rcpf(1.0f + __builtin_amdgcn_exp2f(-1.702f * LOG2E * gg));
                        h[4 * n + i] = (uu + 1.0f) * (gg * sg);
                    }
                u32x4 w; w.x = cvtpk(h[0], h[1]); w.y = cvtpk(h[2], h[3]); w.z = cvtpk(h[4], h[5]); w.w = cvtpk(h[6], h[7]);
                *(u32x4*)(H + (size_t)(u.pm * 256 + ai * 128 + wr * 64 + m * 16 + fr) * 1024 + j) = w;
            }
    }
};
struct EpiDN {
    static constexpr bool PERM = true;
    bf16_t* Y; const float* bias;
    DI void operator()(const f32x4 (&acc)[2][2][4][2], const pg8::Unit& u, int wr, int wc, int fr, int fq) const {
        const int e = u.pn >> 2, ct = u.pn & 3;
        const float* be = bias + (size_t)e * 1024;
#pragma unroll
        for (int bj = 0; bj < 2; ++bj) {
            const int c = ct * 256 + bj * 128 + wc * 32 + 8 * fq;
            const f32x4 b0 = *(const f32x4*)(be + c), b1 = *(const f32x4*)(be + c + 4);
#pragma unroll
            for (int ai = 0; ai < 2; ++ai)
#pragma unroll
                for (int m = 0; m < 4; ++m) {
                    const f32x4 v0 = acc[ai][bj][m][0] + b0, v1 = acc[ai][bj][m][1] + b1;
                    u32x4 w; w.x = cvtpk(v0[0], v0[1]); w.y = cvtpk(v0[2], v0[3]); w.z = cvtpk(v1[0], v1[1]); w.w = cvtpk(v1[2], v1[3]);
                    *(u32x4*)(Y + (size_t)(u.pm * 256 + ai * 128 + wr * 64 + m * 16 + fr) * 1024 + c) = w;
                }
        }
    }
};
struct Frame {
    LAS unsigned char* lds; unsigned* ctl; unsigned char* ws; int tid, lane, wid; int G, bid;
};
struct MoeOrder {
    const LAS int* tstart; int sh; bool gather; const int* tokof; const LAS int* tokbuf; const LAS int* ulist;
    static DI void build(Frame& F, const LAS int* tstart, int nNt, LAS int* ulist, bool reverse = false) {
        __syncthreads();
        const int nwg = tstart[32] * nNt;
        if (F.tid == 0) ulist[0] = 0;
        __syncthreads();
        if (F.tid < 24) {
            const long L = (long)F.tid * F.G + F.bid;
            if (L < nwg) {
                int wgid = (int)L; { const int q = nwg / 8, r = nwg % 8, xcd = wgid % 8, off = wgid / 8; wgid = (xcd < r ? xcd * (q + 1) : r * (q + 1) + (xcd - r) * q) + off; }
                if (reverse) wgid = nwg - 1 - wgid;
                int e = 0;
                for (int k = 1; k < 32; ++k) if (tstart[k] * nNt <= wgid) e = k;
                const int rem = wgid - tstart[e] * nNt, nte = tstart[e + 1] - tstart[e];
                const int ct = rem / nte, rt = rem % nte;
                ulist[4 + 4 * F.tid] = tstart[e] + rt; ulist[5 + 4 * F.tid] = e * nNt + ct; ulist[6 + 4 * F.tid] = e; ulist[7 + 4 * F.tid] = rt;
                __hip_atomic_fetch_add(ulist, 1, __ATOMIC_RELAXED, __HIP_MEMORY_SCOPE_WORKGROUP);
            }
        }
        __syncthreads();
    }
    DI bool next(int i, pg8::Unit& u) const {
        if (i >= ulist[0]) return false;
        u.pm = ulist[4 + 4 * i]; u.pn = ulist[5 + 4 * i]; return true;
    }
    DI unsigned a_off(const pg8::Unit& u, int r) const {
        if (!gather) return (unsigned)(u.pm * 256 + r) * 2048u;
        const int e = u.pn >> sh, idx = (u.pm - tstart[e]) * 256 + r;
        const int t = idx < tstart[80 + e] ? tokof[(size_t)e * T + idx] : 0;
        return (unsigned)t * 2048u;
    }
    DI void prefetch(const pg8::Unit& u, int slot, int wid, int lane) const {
        if (gather && wid == 0) {
            const int e = u.pn >> sh, rt = u.pm - tstart[e];
            __builtin_amdgcn_global_load_lds((const unsigned*)(tokof + (size_t)e * T + rt * 256 + vlane() * 4), (LAS unsigned*)((LAS unsigned char*)tokbuf + slot * 1024), 16, 0, 0);
        }
    }
    DI unsigned a_off_pf(const pg8::Unit& u, int r, int slot) const {
        if (!gather) return (unsigned)(u.pm * 256 + r) * 2048u;
        const int e = u.pn >> sh, idx = (u.pm - tstart[e]) * 256 + r;
        const int t = idx < tstart[80 + e] ? tokbuf[slot * 256 + r] : 0;
        return (unsigned)t * 2048u;
    }
    DI void a_ready(const pg8::Unit&) const {}
    DI void done(const pg8::Unit&) const {}
};

DI int crow(int r, int hi) { return (r & 3) + 8 * (r >> 2) + 4 * hi; }
template <int DK, bool FOX, bool ROPEQ>
DI void attn_unit(LAS unsigned char* lds, const bf16_t* Q, int ldq, const bf16_t* Kp, int ldk, const bf16_t* Vt, int ldv,
                  const float* cum, bf16_t* O, int ldo, int q0, int ntiles, bool causal, const int* pos, const int wid, const float* kn2 = nullptr) {
    constexpr int PK = DK * 2 + 16, KBYTES = 64 * PK, VBYTES = 64 * 136, BUF = KBYTES + VBYTES + 256, KCH = DK / 8, NS = DK / 16;
    const int lane = vlane(), tid = wid * 64 + lane, r32 = lane & 31, hi = lane >> 5;
    const int qw0 = q0 + wid * 32, qrow = qw0 + r32;
    bf16x8 qf[NS];
#pragma unroll
    for (int s = 0; s < NS; ++s) qf[s] = *(const bf16x8*)(Q + (size_t)qrow * ldq + 16 * s + 8 * hi);
    if constexpr (ROPEQ) {
        const float p = (float)pos[qrow];
#pragma unroll
        for (int j = 0; j < 8; ++j) {
            const int i = 8 * hi + j;
            const float inv = exp2f(-(float)i * (13.287712379549449f / 16.0f));
            float sn, cs; sincos_cw(p * inv, sn, cs);
            const float x1 = bf2f((unsigned short)qf[4][j]), x2 = bf2f((unsigned short)qf[5][j]);
            const float o1 = x1 * cs - x2 * sn, o2 = x1 * sn + x2 * cs;
            qf[4][j] = (short)(cvtpk(o1, 0.f) & 0xffffu); qf[5][j] = (short)(cvtpk(o2, 0.f) & 0xffffu);
        }
    }
    const float cq = FOX ? cum[qrow] : 0.f;
    int jstart = 0; float prune_c = 0.f;
    if constexpr (FOX) {
        LAS float* red = (LAS float*)(lds + 2 * BUF);
        float ss = 0.f;
#pragma unroll
        for (int s = 0; s < NS; ++s)
#pragma unroll
            for (int j = 0; j < 8; ++j) { const float v = bf2f((unsigned short)qf[s][j]); ss += v * v; }
        ss += __shfl_xor(ss, 32);
        ss = wave_max(ss);
        float kk = 0.f;
        for (int j = tid; j < ntiles; j += NTHREADS) kk = fmaxf(kk, kn2[j]);
        kk = wave_max(kk);
        __syncthreads();
        if (lane == 0) { red[wid] = ss; red[8 + wid] = kk; }
        __syncthreads();
        float qm = red[0], km = red[8];
#pragma unroll
        for (int w = 1; w < 8; ++w) { qm = fmaxf(qm, red[w]); km = fmaxf(km, red[8 + w]); }
        prune_c = 2.0f * sqrtf(qm * km) * 1.01f + 65.0f;
        const float cq0 = cum[q0];
        int cand = ntiles;
        for (int j = tid; j < ntiles; j += NTHREADS) if (cq0 - cum[64 * j + 63] + prune_c >= 0.f) cand = min(cand, j);
#pragma unroll
        for (int o = 1; o < 64; o <<= 1) cand = min(cand, __shfl_xor(cand, o));
        __syncthreads();
        if (lane == 0) ((LAS int*)red)[16 + wid] = cand;
        __syncthreads();
        jstart = ((LAS int*)red)[16];
#pragma unroll
        for (int w = 1; w < 8; ++w) jstart = min(jstart, ((LAS int*)red)[16 + w]);
        jstart = min(jstart, ntiles - 4);
        __syncthreads();
    }
    const float cqw0 = FOX ? __shfl(cq, 0) : 0.f;
    f32x16 o0, o1;
#pragma unroll
    for (int r = 0; r < 16; ++r) { o0[r] = 0.f; o1[r] = 0.f; }
    float mrun = -1e30f, lrun = 0.f;
    const int kr0 = tid / KCH, kc0 = tid % KCH;
    const int kr1 = (tid + 512) / KCH, kc1 = (tid + 512) % KCH;
    const bool k2 = (DK == 96) && (tid < 256);
    const int vd = tid >> 3, vc = tid & 7;
    u32x4 kreg0, kreg1 = (u32x4){0, 0, 0, 0}, vreg; float creg = 0.f;
#define ATT_GLOAD(j) do { \
        kreg0 = *(const u32x4*)(Kp + (size_t)(64 * (j) + kr0) * ldk + kc0 * 8); \
        if (k2) kreg1 = *(const u32x4*)(Kp + (size_t)(64 * (j) + kr1) * ldk + kc1 * 8); \
        vreg = *(const u32x4*)(Vt + (size_t)vd * ldv + 64 * (j) + vc * 8); \
        if (FOX && tid < 64) creg = cum[64 * (j) + tid]; } while (0)
#define ATT_LWRITE(buf) do { LAS unsigned char* bb_ = lds + (buf) * BUF; \
        *(LAS u32x4*)(bb_ + kr0 * PK + kc0 * 16) = kreg0; \
        if (k2) *(LAS u32x4*)(bb_ + kr1 * PK + kc1 * 16) = kreg1; \
        *(LAS u32x2*)(bb_ + KBYTES + vd * 136 + vc * 16) = (u32x2){vreg.x, vreg.y}; \
        *(LAS u32x2*)(bb_ + KBYTES + vd * 136 + vc * 16 + 8) = (u32x2){vreg.z, vreg.w}; \
        if (FOX && tid < 64) *(LAS float*)(bb_ + KBYTES + VBYTES + tid * 4) = creg; } while (0)
    ATT_GLOAD(jstart); ATT_LWRITE(0); __syncthreads();
    for (int j = jstart; j < ntiles; ++j) {
        const int cur = (j - jstart) & 1;
        if (j + 1 < ntiles) ATT_GLOAD(j + 1);
        const LAS unsigned char* kb = lds + cur * BUF; const LAS unsigned char* vb = kb + KBYTES; const LAS unsigned char* cb = vb + VBYTES;
        bool active = !causal || (64 * j <= qw0 + 31);
        if constexpr (FOX) { if (cqw0 - *(const LAS float*)(cb + 63 * 4) + prune_c < 0.f) active = false; }
        if (active) {
            f32x16 sp0, sp1;
#pragma unroll
            for (int r = 0; r < 16; ++r) { sp0[r] = 0.f; sp1[r] = 0.f; }
#pragma unroll
            for (int s = 0; s < NS; ++s) {
                const bf16x8 k0 = *(const LAS bf16x8*)(kb + r32 * PK + 32 * s + 16 * hi);
                const bf16x8 k1 = *(const LAS bf16x8*)(kb + (32 + r32) * PK + 32 * s + 16 * hi);
                sp0 = __builtin_amdgcn_mfma_f32_32x32x16_bf16(k0, qf[s], sp0, 0, 0, 0);
                sp1 = __builtin_amdgcn_mfma_f32_32x32x16_bf16(k1, qf[s], sp1, 0, 0, 0);
            }
            __builtin_amdgcn_sched_barrier(0);
            if constexpr (FOX) {
#pragma unroll
                for (int g = 0; g < 4; ++g) {
                    const f32x4 c0 = *(const LAS f32x4*)(cb + (8 * g + 4 * hi) * 4);
                    const f32x4 c1 = *(const LAS f32x4*)(cb + (32 + 8 * g + 4 * hi) * 4);
#pragma unroll
                    for (int i = 0; i < 4; ++i) { sp0[4 * g + i] += cq - c0[i]; sp1[4 * g + i] += cq - c1[i]; }
                }
            }
            if (causal && (64 * j + 63 > qw0)) {
#pragma unroll
                for (int r = 0; r < 16; ++r) {
                    const int key = 64 * j + crow(r, hi);
                    if (key > qrow) sp0[r] = -1e30f;
                    if (key + 32 > qrow) sp1[r] = -1e30f;
                }
            }
            float mx = fmaxf(sp0[0], sp1[0]);
#pragma unroll
            for (int r = 1; r < 16; ++r) mx = fmaxf(mx, fmaxf(sp0[r], sp1[r]));
            mx = fmaxf(mx, __shfl_xor(mx, 32));
            const float mnew = fmaxf(mrun, mx);
            const float alpha = __builtin_amdgcn_exp2f(mrun - mnew);
            mrun = mnew;
            float ls = 0.f;
#pragma unroll
            for (int r = 0; r < 16; ++r) { sp0[r] = __builtin_amdgcn_exp2f(sp0[r] - mnew); sp1[r] = __builtin_amdgcn_exp2f(sp1[r] - mnew); ls += sp0[r] + sp1[r]; }
            lrun = lrun * alpha + ls;
#pragma unroll
            for (int r = 0; r < 16; ++r) { o0[r] *= alpha; o1[r] *= alpha; }
            __builtin_amdgcn_sched_barrier(0);
#pragma unroll
            for (int ks = 0; ks < 4; ++ks) {
                const int p = ks >> 1, s2 = ks & 1;
                u32x4 pw;
                if (p == 0) { pw.x = cvtpk(sp0[8 * s2 + 0], sp0[8 * s2 + 1]); pw.y = cvtpk(sp0[8 * s2 + 2], sp0[8 * s2 + 3]); pw.z = cvtpk(sp0[8 * s2 + 4], sp0[8 * s2 + 5]); pw.w = cvtpk(sp0[8 * s2 + 6], sp0[8 * s2 + 7]); }
                else        { pw.x = cvtpk(sp1[8 * s2 + 0], sp1[8 * s2 + 1]); pw.y = cvtpk(sp1[8 * s2 + 2], sp1[8 * s2 + 3]); pw.z = cvtpk(sp1[8 * s2 + 4], sp1[8 * s2 + 5]); pw.w = cvtpk(sp1[8 * s2 + 6], sp1[8 * s2 + 7]); }
                const bf16x8 pf = __builtin_bit_cast(bf16x8, pw);
                const int kbase = (32 * p + 16 * s2 + 4 * hi) * 2;
                {
                    const u32x2 lo = *(const LAS u32x2*)(vb + r32 * 136 + kbase), h2 = *(const LAS u32x2*)(vb + r32 * 136 + kbase + 16);
                    const bf16x8 vf = __builtin_bit_cast(bf16x8, (u32x4){lo.x, lo.y, h2.x, h2.y});
                    o0 = __builtin_amdgcn_mfma_f32_32x32x16_bf16(vf, pf, o0, 0, 0, 0);
                }
                {
                    const u32x2 lo = *(const LAS u32x2*)(vb + (32 + r32) * 136 + kbase), h2 = *(const LAS u32x2*)(vb + (32 + r32) * 136 + kbase + 16);
                    const bf16x8 vf = __builtin_bit_cast(bf16x8, (u32x4){lo.x, lo.y, h2.x, h2.y});
                    o1 = __builtin_amdgcn_mfma_f32_32x32x16_bf16(vf, pf, o1, 0, 0, 0);
                }
            }
        }
        if (j + 1 < ntiles) ATT_LWRITE(cur ^ 1);
        __syncthreads();
    }
#undef ATT_GLOAD
#undef ATT_LWRITE
    const float ltot = lrun + __shfl_xor(lrun, 32);
    const float inv = 1.0f / ltot;
#pragma unroll
    for (int g = 0; g < 4; ++g) {
        const int d0 = 8 * g + 4 * hi;
        u32x2 w0, w1;
        w0.x = cvtpk(o0[4 * g] * inv, o0[4 * g + 1] * inv); w0.y = cvtpk(o0[4 * g + 2] * inv, o0[4 * g + 3] * inv);
        w1.x = cvtpk(o1[4 * g] * inv, o1[4 * g + 1] * inv); w1.y = cvtpk(o1[4 * g + 2] * inv, o1[4 * g + 3] * inv);
        *(u32x2*)(O + (size_t)qrow * ldo + d0) = w0;
        *(u32x2*)(O + (size_t)qrow * ldo + 32 + d0) = w1;
    }
}


template <int DK, bool ROPEQ>
DI void attn_unit_pipe(LAS unsigned char* lds, const bf16_t* Q, int ldq, const bf16_t* Kp, int ldk, const bf16_t* Vt, int ldv,
                       bf16_t* O, int ldo, int q0, int ntiles, const int* pos, const int wid) {
    constexpr int PK = DK * 2 + 16, KBYTES = 64 * PK, VBYTES = 64 * 136, KCH = DK / 8, NS = DK / 16, VOFF = 2 * KBYTES;
    constexpr float THR = 6.0f;
    const int lane = vlane(), tid = wid * 64 + lane, r32 = lane & 31, hi = lane >> 5;
    const int qw0 = q0 + wid * 32, qrow = qw0 + r32;
    bf16x8 qf[NS];
#pragma unroll
    for (int s = 0; s < NS; ++s) qf[s] = *(const bf16x8*)(Q + (size_t)qrow * ldq + 16 * s + 8 * hi);
    if constexpr (ROPEQ) {
        const float p = (float)pos[qrow];
#pragma unroll
        for (int j = 0; j < 8; ++j) {
            const int i = 8 * hi + j;
            const float inv = exp2f(-(float)i * (13.287712379549449f / 16.0f));
            float sn, cs; sincos_cw(p * inv, sn, cs);
            const float x1 = bf2f((unsigned short)qf[NS - 2][j]), x2 = bf2f((unsigned short)qf[NS - 1][j]);
            const float o1 = x1 * cs - x2 * sn, o2 = x1 * sn + x2 * cs;
            qf[NS - 2][j] = (short)(cvtpk(o1, 0.f) & 0xffffu); qf[NS - 1][j] = (short)(cvtpk(o2, 0.f) & 0xffffu);
        }
    }
    const int kr0 = tid / KCH, kc0 = tid % KCH;
    const int kr1 = (tid + 512) / KCH, kc1 = (tid + 512) % KCH;
    const bool k2 = (DK == 96) && (tid < 256);
    const int vd = tid >> 3, vc = tid & 7;
    const int kfo = r32 * PK + 16 * hi;
    const int vfo = VOFF + r32 * 136 + 8 * hi;
    u32x4 kA0, kA1 = (u32x4){0, 0, 0, 0}, vA, kB0, kB1 = (u32x4){0, 0, 0, 0}, vB;
#define SBAR() __builtin_amdgcn_sched_barrier(0)
#define AP_LOADK(j, R0, R1) do { R0 = *(const u32x4*)(Kp + (size_t)(64 * (j) + kr0) * ldk + kc0 * 8); \
        if (k2) R1 = *(const u32x4*)(Kp + (size_t)(64 * (j) + kr1) * ldk + kc1 * 8); } while (0)
#define AP_LOADV(j, RV) do { RV = *(const u32x4*)(Vt + (size_t)vd * ldv + 64 * (j) + vc * 8); } while (0)
#define AP_WRITEK(buf, R0, R1) do { LAS unsigned char* bb_ = lds + (buf) * KBYTES; *(LAS u32x4*)(bb_ + kr0 * PK + kc0 * 16) = R0; \
        if (k2) *(LAS u32x4*)(bb_ + kr1 * PK + kc1 * 16) = R1; } while (0)
#define AP_WRITEV(buf, RV) do { LAS unsigned char* bb_ = lds + VOFF + (buf) * VBYTES; \
        *(LAS u32x2*)(bb_ + vd * 136 + vc * 16) = (u32x2){RV.x, RV.y}; *(LAS u32x2*)(bb_ + vd * 136 + vc * 16 + 8) = (u32x2){RV.z, RV.w}; } while (0)
#define AP_KF(dst0, dst1, kbuf, s) do { dst0 = *(const LAS bf16x8*)(lds + (kbuf) * KBYTES + kfo + 32 * (s)); dst1 = *(const LAS bf16x8*)(lds + (kbuf) * KBYTES + kfo + 32 * PK + 32 * (s)); } while (0)
#define AP_VF(dst0, dst1, vbuf, ks) do { const LAS unsigned char* p_ = lds + (vbuf) * VBYTES + vfo + (32 * ((ks) >> 1) + 16 * ((ks) & 1)) * 2; \
        const u32x2 a_ = *(const LAS u32x2*)(p_), b_ = *(const LAS u32x2*)(p_ + 16), c_ = *(const LAS u32x2*)(p_ + 32 * 136), d_ = *(const LAS u32x2*)(p_ + 32 * 136 + 16); \
        dst0 = __builtin_bit_cast(bf16x8, (u32x4){a_.x, a_.y, b_.x, b_.y}); dst1 = __builtin_bit_cast(bf16x8, (u32x4){c_.x, c_.y, d_.x, d_.y}); } while (0)
#define AP_MFMA(a, b, c) __builtin_amdgcn_mfma_f32_32x32x16_bf16(a, b, c, 0, 0, 0)
#define AP_MASK(S0, S1, t) do { _Pragma("unroll") for (int r_ = 0; r_ < 16; ++r_) { const int key_ = 64 * (t) + crow(r_, hi); \
        if (key_ > qrow) S0[r_] = -1e30f; if (key_ + 32 > qrow) S1[r_] = -1e30f; } } while (0)
#define AP_ROWMAX(S0, S1, out) do { float a_ = fmaxf(fmaxf(S0[0], S1[0]), S0[1]), b_ = fmaxf(fmaxf(S1[1], S0[2]), S1[2]); \
        _Pragma("unroll") for (int r_ = 3; r_ < 15; r_ += 2) { a_ = fmaxf(fmaxf(a_, S0[r_]), S1[r_]); b_ = fmaxf(fmaxf(b_, S0[r_ + 1]), S1[r_ + 1]); } \
        a_ = fmaxf(fmaxf(a_, S0[15]), S1[15]); a_ = fmaxf(a_, b_); out = fmaxf(a_, __shfl_xor(a_, 32)); } while (0)
    f32x16 o0, o1, pa0, pa1, sb0, sb1;
#pragma unroll
    for (int r = 0; r < 16; ++r) { o0[r] = 0.f; o1[r] = 0.f; }
    float mref = 0.f, lrun = 0.f;
    bf16x8 pf[4];
    bf16x8 fa0, fa1, fb0, fb1;
    AP_LOADK(0, kA0, kA1); AP_LOADV(0, vA); AP_WRITEK(0, kA0, kA1); AP_WRITEV(0, vA);
    AP_LOADK(1, kA0, kA1); AP_WRITEK(1, kA0, kA1);
    AP_LOADK(2, kA0, kA1); AP_LOADV(1, vA);
    __syncthreads();
#pragma unroll
    for (int r = 0; r < 16; ++r) { pa0[r] = 0.f; pa1[r] = 0.f; }
#pragma unroll
    for (int s = 0; s < NS; ++s) { AP_KF(fa0, fa1, 0, s); pa0 = AP_MFMA(fa0, qf[s], pa0); pa1 = AP_MFMA(fa1, qf[s], pa1); }
    if (ntiles == 4) AP_MASK(pa0, pa1, 0);
    { float mx; AP_ROWMAX(pa0, pa1, mx); mref = mx;
#pragma unroll
      for (int r = 0; r < 16; ++r) { pa0[r] = __builtin_amdgcn_exp2f(pa0[r] - mx); pa1[r] = __builtin_amdgcn_exp2f(pa1[r] - mx); } }
    __syncthreads();
    f32x16 negm;
#pragma unroll
    for (int r = 0; r < 16; ++r) negm[r] = -mref;
    asm volatile("" : "+v"(negm));
#define AP_STEPA(s, X0, X1, Y0, Y1, VALU) do { if ((s) + 1 < NS) AP_KF(Y0, Y1, kb_, (s) + 1); else AP_VF(Y0, Y1, vb_, 0); \
        if ((s) == 0) { sb0 = AP_MFMA(X0, qf[s], negm); sb1 = AP_MFMA(X1, qf[s], negm); } else { sb0 = AP_MFMA(X0, qf[s], sb0); sb1 = AP_MFMA(X1, qf[s], sb1); } VALU; SBAR(); } while (0)
#define AP_PK(i, P, b) pw_[i] = (u32x4){cvtpk(P[b], P[b + 1]), cvtpk(P[b + 2], P[b + 3]), cvtpk(P[b + 4], P[b + 5]), cvtpk(P[b + 6], P[b + 7])}; \
        ls0_ = fadd_s(ls0_, fadd_s(fadd_s(P[b], P[b + 1]), fadd_s(P[b + 2], P[b + 3]))); ls1_ = fadd_s(ls1_, fadd_s(fadd_s(P[b + 4], P[b + 5]), fadd_s(P[b + 6], P[b + 7]))); asm volatile("" : "+v"(pw_[i]), "+v"(ls0_), "+v"(ls1_))
#define AP_EXP4(P, S, b) do { P[b] = __builtin_amdgcn_exp2f(S[b]); P[b + 1] = __builtin_amdgcn_exp2f(S[b + 1]); P[b + 2] = __builtin_amdgcn_exp2f(S[b + 2]); P[b + 3] = __builtin_amdgcn_exp2f(S[b + 3]); asm volatile("" : "+v"(P)); } while (0)
#define AP_STEPB(ks, X0, X1, Y0, Y1, E0, E1) do { if ((ks) + 1 < 4) AP_VF(Y0, Y1, vb_, (ks) + 1); \
        o0 = AP_MFMA(X0, pf[ks], o0); E0; SBAR(); o1 = AP_MFMA(X1, pf[ks], o1); E1; SBAR(); } while (0)
#define AP_ITER(t, MASKED, WK0, WK1, WV, LK0, LK1, LV) do {     \
        const int kb_ = (t) & 1, vb_ = ((t) - 1) & 1; \
        if ((t) + 2 < ntiles) AP_LOADK((t) + 2, LK0, LK1); \
        if ((t) + 1 < ntiles) AP_LOADV((t) + 1, LV); \
        u32x4 pw_[4]; float ls0_ = 0.f, ls1_ = 0.f; \
        AP_KF(fa0, fa1, kb_, 0); SBAR(); \
        AP_STEPA(0, fa0, fa1, fb0, fb1, AP_PK(0, pa0, 0)); \
        AP_STEPA(1, fb0, fb1, fa0, fa1, AP_PK(1, pa0, 8)); \
        AP_STEPA(2, fa0, fa1, fb0, fb1, AP_PK(2, pa1, 0)); \
        AP_STEPA(3, fb0, fb1, fa0, fa1, AP_PK(3, pa1, 8)); \
        if (NS == 6) { AP_STEPA(4, fa0, fa1, fb0, fb1, (void)0); AP_STEPA(5, fb0, fb1, fa0, fa1, (void)0); } \
        lrun += ls0_ + ls1_; \
        pf[0] = __builtin_bit_cast(bf16x8, pw_[0]); pf[1] = __builtin_bit_cast(bf16x8, pw_[1]); pf[2] = __builtin_bit_cast(bf16x8, pw_[2]); pf[3] = __builtin_bit_cast(bf16x8, pw_[3]); \
        if ((t) >= ntiles - 4) AP_MASK(sb0, sb1, t); \
        float mx_; AP_ROWMAX(sb0, sb1, mx_); \
        float resc_ = 1.0f; bool do_resc_ = false; \
        if (__any(mx_ > THR)) { const float dl_ = fmaxf(mx_, 0.f); mref += dl_; \
            _Pragma("unroll") for (int r_ = 0; r_ < 16; ++r_) { sb0[r_] -= dl_; sb1[r_] -= dl_; negm[r_] = -mref; } \
            asm volatile("" : "+v"(negm)); \
            resc_ = __builtin_amdgcn_exp2f(-dl_); lrun *= resc_; do_resc_ = true; } \
        SBAR(); \
        AP_STEPB(0, fa0, fa1, fb0, fb1, AP_EXP4(pa0, sb0, 0), AP_EXP4(pa0, sb0, 4)); \
        AP_STEPB(1, fb0, fb1, fa0, fa1, AP_EXP4(pa0, sb0, 8), AP_EXP4(pa0, sb0, 12)); \
        AP_STEPB(2, fa0, fa1, fb0, fb1, AP_EXP4(pa1, sb1, 0), AP_EXP4(pa1, sb1, 4)); \
        AP_STEPB(3, fb0, fb1, fa0, fa1, AP_EXP4(pa1, sb1, 8), AP_EXP4(pa1, sb1, 12)); \
        if (do_resc_) { asm volatile("" ::: "memory"); _Pragma("unroll") for (int r_ = 0; r_ < 16; ++r_) { o0[r_] *= resc_; o1[r_] *= resc_; } asm volatile("" : "+v"(o0), "+v"(o1)); } \
        if ((t) + 1 < ntiles) AP_WRITEK(((t) + 1) & 1, WK0, WK1); \
        AP_WRITEV((t) & 1, WV); \
        __syncthreads(); } while (0)
    static_assert(NS == 4 || NS == 6, "head dim 64 or 96");
    if (wid >= 4) __builtin_amdgcn_s_setprio(1);
    int t = 1;
    for (; t + 1 < ntiles; t += 2) { AP_ITER(t, 1, kA0, kA1, vA, kB0, kB1, vB); AP_ITER(t + 1, 1, kB0, kB1, vB, kA0, kA1, vA); }
    AP_ITER(t, 1, kA0, kA1, vA, kB0, kB1, vB);
    {
        u32x4 pw_[4]; float ls0_ = 0.f, ls1_ = 0.f;
        AP_PK(0, pa0, 0); AP_PK(1, pa0, 8); AP_PK(2, pa1, 0); AP_PK(3, pa1, 8);
        lrun += ls0_ + ls1_;
        pf[0] = __builtin_bit_cast(bf16x8, pw_[0]); pf[1] = __builtin_bit_cast(bf16x8, pw_[1]); pf[2] = __builtin_bit_cast(bf16x8, pw_[2]); pf[3] = __builtin_bit_cast(bf16x8, pw_[3]);
        const int vb_ = (ntiles - 1) & 1;
#pragma unroll
        for (int ks = 0; ks < 4; ++ks) { AP_VF(fa0, fa1, vb_, ks); o0 = AP_MFMA(fa0, pf[ks], o0); o1 = AP_MFMA(fa1, pf[ks], o1); }
    }
    const float ltot = lrun + __shfl_xor(lrun, 32);
    const float inv = 1.0f / ltot;
#pragma unroll
    for (int g = 0; g < 4; ++g) {
        const int d0 = 8 * g + 4 * hi;
        u32x2 w0, w1;
        w0.x = cvtpk(o0[4 * g] * inv, o0[4 * g + 1] * inv); w0.y = cvtpk(o0[4 * g + 2] * inv, o0[4 * g + 3] * inv);
        w1.x = cvtpk(o1[4 * g] * inv, o1[4 * g + 1] * inv); w1.y = cvtpk(o1[4 * g + 2] * inv, o1[4 * g + 3] * inv);
        *(u32x2*)(O + (size_t)qrow * ldo + d0) = w0;
        *(u32x2*)(O + (size_t)qrow * ldo + 32 + d0) = w1;
    }
    __syncthreads();
#undef SBAR
#undef AP_LOADK
#undef AP_LOADV
#undef AP_WRITEK
#undef AP_WRITEV
#undef AP_KF
#undef AP_VF
#undef AP_MFMA
#undef AP_MASK
#undef AP_ROWMAX
#undef AP_STEPA
#undef AP_PK
#undef AP_EXP4
#undef AP_STEPB
#undef AP_ITER
}

#define XB_TMO      128
#define XB_XCNT(j)  (256  + 64 * (j))
#define XB_XSUB(j)  (1280 + 64 * (j))
#define XB_XGEN(j)  (2304 + 64 * (j))
#define XB_TOP      3328
#define XB_TOPGEN   3392
#define XCD_BAR_WORDS 3456
#define XB_SPIN_CAP (1u << 18)
DI unsigned xb_ld(unsigned* p) { return __hip_atomic_load(p, __ATOMIC_RELAXED, __HIP_MEMORY_SCOPE_AGENT); }
DI unsigned xb_add(unsigned* p, unsigned v) { return __hip_atomic_fetch_add(p, v, __ATOMIC_RELAXED, __HIP_MEMORY_SCOPE_AGENT); }
DI unsigned xb_xcc_id() { return (unsigned)__builtin_amdgcn_s_getreg((3 << 11) | 20) & 0xFu; }
#define XB_SPIN(cond, bar) do { unsigned _sp = 0; while (cond) { __builtin_amdgcn_s_sleep(1); \
    if ((++_sp & 255u) == 0u) { if (xb_ld(&(bar)[XB_TMO])) break; if (_sp > XB_SPIN_CAP) { atomicAdd(&(bar)[XB_TMO], 1u); break; } } } } while (0)
struct XcdBarrier { unsigned* bar; unsigned x; volatile LAS unsigned* st; int wid; };
DI XcdBarrier xcd_barrier_post(unsigned* bar, volatile LAS unsigned* st, int wid) {
    XcdBarrier b; b.bar = bar; b.x = xb_xcc_id(); b.st = st; b.wid = wid;
    if (wid == 0 && vlane() == 0) (void)xb_add(&bar[XB_XCNT(b.x)], 1u);
    return b;
}
DI void xcd_barrier_complete(unsigned* bar, unsigned x, unsigned& nloc, unsigned& nx) {
    const unsigned G = gridDim.x * gridDim.y * gridDim.z;
    unsigned sum, cnt, mine, sp = 0u;
    for (;;) {
        sum = 0u; cnt = 0u; mine = 0u;
#pragma unroll
        for (unsigned j = 0; j < 16; ++j) { const unsigned c = xb_ld(&bar[XB_XCNT(j)]); sum += c; cnt += (c > 0u) ? 1u : 0u; mine = (j == x) ? c : mine; }
        if (sum == G) break;
        __builtin_amdgcn_s_sleep(1);
        if ((++sp & 255u) == 0u) { if (xb_ld(&bar[XB_TMO])) break; if (sp > XB_SPIN_CAP) { atomicAdd(&bar[XB_TMO], 1u); break; } }
    }
    nloc = mine > 0u ? mine : 1u; nx = cnt > 0u ? cnt : 1u;
}
DI void xcd_barrier(const XcdBarrier& b) {
    asm volatile("s_waitcnt vmcnt(0)" ::: "memory");
    __syncthreads();
    if (b.wid == 0 && vlane() == 0) {
        unsigned* bar = b.bar;
        __builtin_amdgcn_s_waitcnt(0);
        unsigned nloc = b.st[0], nx = b.st[1];
        if (nloc == 0u) { xcd_barrier_complete(bar, b.x, nloc, nx); b.st[0] = nloc; b.st[1] = nx; }
        const unsigned old = xb_add(&bar[XB_XSUB(b.x)], 1u);
        const unsigned gen = old / nloc;
        if (old + 1u == (gen + 1u) * nloc) {
            __builtin_amdgcn_fence(__ATOMIC_RELEASE, "agent");
            asm volatile("s_waitcnt vmcnt(0)" ::: "memory");
            const unsigned og = xb_add(&bar[XB_TOP], 1u);
            const unsigned tg = og / nx;
            if (og + 1u == (tg + 1u) * nx) xb_add(&bar[XB_TOPGEN], 1u);
            else XB_SPIN(xb_ld(&bar[XB_TOPGEN]) == tg, bar);
            __builtin_amdgcn_fence(__ATOMIC_ACQUIRE, "agent");
            xb_add(&bar[XB_XGEN(b.x)], 1u);
            asm volatile("s_waitcnt vmcnt(0)" ::: "memory");
        } else {
            XB_SPIN(xb_ld(&bar[XB_XGEN(b.x)]) == gen, bar);
            __builtin_amdgcn_fence(__ATOMIC_ACQUIRE, "agent");
            asm volatile("s_waitcnt vmcnt(0)" ::: "memory");
        }
    }
    __syncthreads();
}

DI int next_unit(Frame& F, int widx) {
    LAS int* s = (LAS int*)(F.lds + LDS_CTL);
    __syncthreads();
    if (F.tid == 0) *s = (int)atomicAdd(F.ctl + CW_WORK + 64 * widx, 1u);
    __syncthreads();
    return *s;
}

DI void transpose_item(const float* W, int ldw, int srccol, int K, bf16_t* WT, int drow, LAS unsigned* scr, int k0, int lane, int nvalid) {
    const int n4 = lane & 15, kq = lane >> 4;
#pragma unroll 8
    for (int i = 0; i < 16; ++i) {
        const int kk = 4 * i + kq;
        f32x4 v = (f32x4){0.f, 0.f, 0.f, 0.f};
        if (4 * n4 < nvalid) v = *(const f32x4*)(W + (size_t)(k0 + kk) * ldw + srccol + 4 * n4);
        scr[kk * 33 + 2 * n4] = cvtpk(v[0], v[1]); scr[kk * 33 + 2 * n4 + 1] = cvtpk(v[2], v[3]);
    }
    LDS_WAIT(); asm volatile("" ::: "memory");
    const int c = lane & 7;
    const LAS unsigned short* s16 = (const LAS unsigned short*)scr;
#pragma unroll
    for (int j = 0; j < 8; ++j) {
        const int n = (lane >> 3) + 8 * j;
        const LAS unsigned short* sp = s16 + (8 * c) * 66 + n;
        u32x4 o;
        o.x = (unsigned)sp[0 * 66] | ((unsigned)sp[1 * 66] << 16); o.y = (unsigned)sp[2 * 66] | ((unsigned)sp[3 * 66] << 16);
        o.z = (unsigned)sp[4 * 66] | ((unsigned)sp[5 * 66] << 16); o.w = (unsigned)sp[6 * 66] | ((unsigned)sp[7 * 66] << 16);
        if (n < nvalid) *(u32x4*)(WT + (size_t)(drow + n) * K + k0 + 8 * c) = o;
    }
    LDS_WAIT(); asm volatile("" ::: "memory");
}
constexpr int CONV_P1 = 5, CONV_A0 = 5, CONV_GU = 7, CONV_DN = 4, CONV_A1 = 12;
constexpr int MOE_I_GU = 16 * 32, MOE_I_DN = 16 * 16, MOE_ITEMS_PER_LAYER = 32 * (MOE_I_GU + MOE_I_DN);
DI void moe_convert_item(unsigned char* ws, LAS unsigned* scr, int r, int lane) {
    const int l = r / MOE_ITEMS_PER_LAYER; r -= l * MOE_ITEMS_PER_LAYER;
    if (r < 32 * MOE_I_GU) {
        const int e = l * 32 + r / MOE_I_GU, q = r % MOE_I_GU, kb = q / 32, nb = q % 32;
        const int jj = (nb & 15) * 64, drow = (jj >> 7) * 256 + (nb >> 4) * 128 + (jj & 127);
        transpose_item(KP->moe_w_gu + (size_t)e * 1024 * 2048, 2048, 64 * nb, 1024, (bf16_t*)(ws + WS_W_GU) + (size_t)e * 2048 * 1024, drow, scr, 64 * kb, lane, 64);
    } else {
        r -= 32 * MOE_I_GU;
        const int e = l * 32 + r / MOE_I_DN, q = r % MOE_I_DN, kb = q / 16, nb = q % 16;
        transpose_item(KP->moe_w_dn + (size_t)e * 1024 * 1024, 1024, 64 * nb, 1024, (bf16_t*)(ws + WS_W_DN) + (size_t)e * 1024 * 1024, 64 * nb, scr, 64 * kb, lane, 64);
    }
}
constexpr int CW_CONVQ = CW_WORK + 64 * 8;
DI bool conv_pull(Frame& F, int l, int nchunks) {
    constexpr int NCHUNK = MOE_ITEMS_PER_LAYER / 8;
    LAS int* s = (LAS int*)(F.lds + LDS_CTL + 8);
    __syncthreads();
    if (F.tid == 0) *s = (int)atomicAdd(F.ctl + CW_CONVQ + 64 * l, (unsigned)nchunks);
    __syncthreads();
    const int base = *s;
    LAS unsigned* scr = (LAS unsigned*)(F.lds + F.wid * 8448);
    for (int c = base; c < base + nchunks && c < NCHUNK; ++c) moe_convert_item(F.ws, scr, l * MOE_ITEMS_PER_LAYER + c * 8 + F.wid, F.lane);
    __syncthreads();
    return base + nchunks < NCHUNK;
}
struct TrMat { const float* W; int ldw, col0, K, N; bf16_t* WT; int drow0, mode; };

DI void phase_prologue(Frame& F, const Params& P) {
    F.lane = vlane(); F.tid = F.wid * 64 + F.lane;
    LAS unsigned* scr = (LAS unsigned*)(F.lds + F.wid * 8448);
    const int gw = F.bid * 8 + F.wid, NGW = F.G * 8;
    unsigned char* ws = F.ws;
    TrMat mats[11];
    mats[0] = TrMat{KP->a_w_in, FOX_IN, 0, 1024, 1536, (bf16_t*)(ws + WS_W_AIN), 0, 0};
    mats[1] = TrMat{KP->a_w_in, FOX_IN, 2316, 1024, 256, (bf16_t*)(ws + WS_W_AIN), 1536, 0};
    mats[2] = TrMat{KP->a_w_in, FOX_IN, 1536, 1024, 768, (bf16_t*)(ws + WS_W_AIN), 1792, 0};
    mats[3] = TrMat{KP->a_w_out, 1024, 0, 1024, 1024, (bf16_t*)(ws + WS_W_AOUT), 0, 0};
    mats[4] = TrMat{KP->kv_w_dkv, 288, 0, 1024, 288, (bf16_t*)(ws + WS_W_BIN), 0, 0};
    mats[5] = TrMat{KP->b_w_in, 640, 0, 1024, 640, (bf16_t*)(ws + WS_W_BIN), 288, 0};
    mats[6] = TrMat{KP->b_w_uq, 1152, 0, 384, 1152, (bf16_t*)(ws + WS_W_UQ), 0, 0};
    mats[7] = TrMat{KP->kv_w_ukv, 1536, 0, 256, 1536, (bf16_t*)(ws + WS_W_UKV), 0, 1};
    mats[8] = TrMat{KP->b_w_out, 1024, 0, 1024, 1024, (bf16_t*)(ws + WS_W_BOUT), 0, 0};
    mats[9] = TrMat{KP->mem_w_kv, 512, 0, 1024, 512, (bf16_t*)(ws + WS_W_MKV), 0, 0};
    mats[10] = TrMat{KP->mem_w_kv + (size_t)1024 * 512, 512, 0, 1024, 512, (bf16_t*)(ws + WS_W_MKV) + (size_t)512 * 1024, 0, 0};
    int nsmall = 0;
#pragma unroll
    for (int i = 0; i < 11; ++i) nsmall += (mats[i].K / 64) * ((mats[i].N + 63) / 64);
    const int ntot = nsmall;
    for (int it = gw; it < ntot; it += NGW) {
        int r = it;
        if (r < nsmall) {
#pragma unroll
            for (int i = 0; i < 11; ++i) {
                const int nblk = (mats[i].N + 63) / 64, ni = (mats[i].K / 64) * nblk;
                if (r >= 0 && r < ni) {
                    const int kb = r / nblk, nb = r % nblk;
                    const int drow = mats[i].mode == 1 ? ((nb & 1) * 768 + (nb >> 1) * 64) : (mats[i].drow0 + 64 * nb);
                    transpose_item(mats[i].W, mats[i].ldw, mats[i].col0 + 64 * nb, mats[i].K, mats[i].WT, drow, scr, 64 * kb, F.lane, mats[i].N - 64 * nb);
                }
                r -= ni;
            }
            continue;
        }
    }
    __syncthreads();
    LAS float* wf = (LAS float*)F.lds;
    for (int i = F.tid; i < 1024 * 12; i += NTHREADS) { const int k = i / 12, h = i % 12; wf[i] = KP->a_w_in[(size_t)k * FOX_IN + 2304 + h]; }
    __syncthreads();
    float* logf = (float*)(ws + WS_LOGF);
    bf16_t* xb = (bf16_t*)(ws + WS_XB);
    for (int row = gw; row < T; row += NGW) {
        const f32x4* xr = (const f32x4*)(KP->x + (size_t)row * DM) + F.lane;
        f32x4 v[4];
#pragma unroll
        for (int j = 0; j < 4; ++j) v[j] = xr[64 * j];
        u32x2* o8 = (u32x2*)(xb + (size_t)row * DM) + F.lane;
#pragma unroll
        for (int j = 0; j < 4; ++j) o8[64 * j] = (u32x2){cvtpk(v[j][0], v[j][1]), cvtpk(v[j][2], v[j][3])};
        float part[12];
#pragma unroll
        for (int h = 0; h < 12; ++h) part[h] = 0.f;
#pragma unroll
        for (int j = 0; j < 4; ++j)
#pragma unroll
            for (int i = 0; i < 4; ++i) {
                const int k = 4 * F.lane + 256 * j + i;
                const LAS f32x4* wp = (const LAS f32x4*)(wf + k * 12);
                const f32x4 w0 = wp[0], w1 = wp[1], w2 = wp[2];
                const float xv = v[j][i];
                part[0] += xv * w0[0]; part[1] += xv * w0[1]; part[2] += xv * w0[2]; part[3] += xv * w0[3];
                part[4] += xv * w1[0]; part[5] += xv * w1[1]; part[6] += xv * w1[2]; part[7] += xv * w1[3];
                part[8] += xv * w2[0]; part[9] += xv * w2[1]; part[10] += xv * w2[2]; part[11] += xv * w2[3];
            }
        float mine = 0.f;
#pragma unroll
        for (int h = 0; h < 12; ++h) { const float s = wave_sum(part[h]); if (F.lane == h) mine = s; }
        if (F.lane < 12) {
            const float z = mine + KP->a_b_f[F.lane];
            const float ls = fminf(z, 0.f) - log1pf(expf(-fabsf(z)));
            const int b = row / SEQ, s = row % SEQ;
            logf[(size_t)(b * NH + F.lane) * SEQ + s] = ls;
        }
    }
    {
        float* wrt = (float*)(ws + WS_WRT);
        for (int i = F.bid * NTHREADS + F.tid; i < 2 * 1024 * 32; i += F.G * NTHREADS) { const int l = i >> 15, k = (i >> 5) & 1023, e = i & 31; wrt[(size_t)(l * 32 + e) * 1024 + k] = KP->moe_w_r[i]; }
    }
    bf16_t* memb = (bf16_t*)(ws + WS_MEMB);
    for (int row = gw; row < NB * NMEM; row += NGW) {
        const f32x4* xr = (const f32x4*)(KP->mem + (size_t)row * DM) + F.lane;
        u32x2* o8 = (u32x2*)(memb + (size_t)row * DM) + F.lane;
#pragma unroll
        for (int j = 0; j < 4; ++j) { const f32x4 v = xr[64 * j]; o8[64 * j] = (u32x2){cvtpk(v[0], v[1]), cvtpk(v[2], v[3])}; }
    }
}

DI void scan_unit(Frame& F, int bh) {
    const float* src = (const float*)(F.ws + WS_LOGF) + (size_t)bh * SEQ;
    float* dst = (float*)(F.ws + WS_CUM) + (size_t)bh * SEQ;
    LAS float* wtot = (LAS float*)F.lds;
    float v[16];
#pragma unroll
    for (int j = 0; j < 4; ++j) { const f32x4 t = *(const f32x4*)(src + F.tid * 16 + 4 * j); v[4 * j] = t[0]; v[4 * j + 1] = t[1]; v[4 * j + 2] = t[2]; v[4 * j + 3] = t[3]; }
#pragma unroll
    for (int i = 1; i < 16; ++i) v[i] += v[i - 1];
    float tot = v[15];
    float inc = tot;
#pragma unroll
    for (int o = 1; o < 64; o <<= 1) { const float t = __shfl_up(inc, o); if (F.lane >= o) inc += t; }
    __syncthreads();
    if (F.lane == 63) wtot[F.wid] = inc;
    __syncthreads();
    float base = inc - tot;
    for (int w = 0; w < F.wid; ++w) base += wtot[w];
#pragma unroll
    for (int j = 0; j < 4; ++j) {
        f32x4 t; t[0] = (base + v[4 * j]) * LOG2E; t[1] = (base + v[4 * j + 1]) * LOG2E; t[2] = (base + v[4 * j + 2]) * LOG2E; t[3] = (base + v[4 * j + 3]) * LOG2E;
        *(f32x4*)(dst + F.tid * 16 + 4 * j) = t;
    }
    __syncthreads();
}

struct RouteQKM { unsigned char* ws; DI Dst operator()(const pg8::Unit& u) const {
    if (u.pn < 3) return Dst{(bf16_t*)(ws + WS_Q), 768, u.pm * 256, u.pn * 256, 256, 0.125f * LOG2E, false};
    if (u.pn < 6) return Dst{(bf16_t*)(ws + WS_K), 768, u.pm * 256, (u.pn - 3) * 256, 256, 1.0f, false};
    return Dst{(bf16_t*)(ws + WS_MQ), 256, u.pm * 256, 0, 256, 0.125f * LOG2E, false}; } };
struct RouteVT { unsigned char* ws; DI Dst operator()(const pg8::Unit& u) const {
    const int b = u.pn >> 5; return Dst{(bf16_t*)(ws + WS_VT) + (size_t)b * 768 * SEQ, SEQ, u.pm * 256, (u.pn & 31) * 256, 256, 1.0f, false}; } };
struct RoutePlain { bf16_t* O; int ldo; DI Dst operator()(const pg8::Unit& u) const { return Dst{O, ldo, u.pm * 256, u.pn * 256, 256, 1.0f, false}; } };
DI void phase_proj0(Frame& F, const Params& P) {
    F.lane = vlane(); F.tid = F.wid * 64 + F.lane;
    unsigned char* ws = F.ws;
    const bf16_t* xb = (const bf16_t*)(ws + WS_XB);
    const bf16_t* win = (const bf16_t*)(ws + WS_W_AIN);
    const bf16_t* memb = (const bf16_t*)(ws + WS_MEMB);
    {
        pg8::Gemm g{xb, win, 1024}; pg8::StaticOrder S; S.init(T, 1792, 1024, F.G, F.bid);
        EpiBf16R<RouteQKM> E{RouteQKM{ws}};
        pg8::gemm_phase<EpiBf16R<RouteQKM>, pg8::StaticOrder, true>(F.lds, g, S, E, F.wid);
    }
    {
        pg8::Gemm g{win + (size_t)1792 * 1024, xb, 1024}; pg8::StaticOrder S; S.init(768, T, 1024, F.G, (F.bid + 64) % F.G);
        EpiBf16R<RouteVT> E{RouteVT{ws}};
        pg8::gemm_phase<EpiBf16R<RouteVT>, pg8::StaticOrder, true>(F.lds, g, S, E, F.wid);
    }
    for (int l = 0; l < 2; ++l) {
        const bf16_t* wk = (const bf16_t*)(ws + WS_W_MKV) + (size_t)l * 512 * 1024;
        {
            pg8::Gemm g{memb, wk, 1024}; pg8::StaticOrder S; S.init(512, 256, 1024, F.G, (F.bid + F.G - (152 + 4 * l)) % F.G);
            EpiBf16R<RoutePlain> E{RoutePlain{(bf16_t*)(ws + WS_MK) + (size_t)l * 512 * 256, 256}};
            pg8::gemm_phase<EpiBf16R<RoutePlain>, pg8::StaticOrder, true>(F.lds, g, S, E, F.wid);
        }
        for (int b = 0; b < 2; ++b) {
            pg8::Gemm g{wk + (size_t)256 * 1024, memb + (size_t)b * 256 * 1024, 1024}; pg8::StaticOrder S; S.init(256, 256, 1024, F.G, (F.bid + F.G - (154 + 4 * l + b)) % F.G);
            EpiBf16R<RoutePlain> E{RoutePlain{(bf16_t*)(ws + WS_MVT) + (size_t)(l * 2 + b) * 256 * 256, 256}};
            pg8::gemm_phase<EpiBf16R<RoutePlain>, pg8::StaticOrder, true>(F.lds, g, S, E, F.wid);
        }
    }
    if (F.G == 256 && F.bid >= 128) conv_pull(F, 0, CONV_P1);
}


DI void phase_scan_knorm(Frame& F) {
    F.lane = vlane(); F.tid = F.wid * 64 + F.lane;
    unsigned char* ws = F.ws;
    if (F.bid < 24) scan_unit(F, F.bid);
    const bf16_t* K = (const bf16_t*)(ws + WS_K);
    float* kn2 = (float*)(ws + WS_KN2);
    const int gw = F.bid * 8 + F.wid, NGW = F.G * 8;
    for (int it = gw; it < 24 * 128; it += NGW) {
        const int bh = it >> 7, j = it & 127, b = bh / 12, h = bh % 12;
        const u32x4* kr = (const u32x4*)(K + (size_t)(b * SEQ + 64 * j + F.lane) * 768 + h * 64);
        float ss = 0.f;
#pragma unroll
        for (int c = 0; c < 8; ++c) {
            const u32x4 w = kr[c];
            const unsigned ww[4] = {w.x, w.y, w.z, w.w};
#pragma unroll
            for (int i = 0; i < 4; ++i) { const float a = __uint_as_float(ww[i] << 16), bb = __uint_as_float(ww[i] & 0xffff0000u); ss += a * a + bb * bb; }
        }
        ss = wave_max(ss);
        if (F.lane == 0) kn2[it] = ss;
    }
}

DI void mem_attn_unit(Frame& F, int l, int v) {
    unsigned char* ws = F.ws;
    const int qb = v >> 3, bm = v & 7, b = bm >> 2, mh = bm & 3;
    const bf16_t* Q = (const bf16_t*)(ws + WS_MQ) + (size_t)b * SEQ * 256 + mh * 64;
    const bf16_t* K = (const bf16_t*)(ws + WS_MK) + (size_t)l * 512 * 256 + (size_t)b * 256 * 256 + mh * 64;
    const bf16_t* Vt = (const bf16_t*)(ws + WS_MVT) + (size_t)(l * 2 + b) * 256 * 256 + (size_t)mh * 64 * 256;
    bf16_t* O = (bf16_t*)(ws + WS_MERGED) + (size_t)b * SEQ * 1024 + 768 + mh * 64;
    attn_unit<64, false, false>(F.lds, Q, 256, K, 256, Vt, 256, nullptr, O, 1024, qb * 256, 4, false, nullptr, F.wid);
}
DI void phase_attn0(Frame& F, const Params& P) {
    F.lane = vlane(); F.tid = F.wid * 64 + F.lane;
    unsigned char* ws = F.ws;
    constexpr int NU = 768 + 256 + 512;
    for (;;) {
        const int uu = next_unit(F, 0);
        if (uu >= NU) break;
        if (uu % 3 == 2) { conv_pull(F, 0, CONV_A0); continue; }
        const int u = 2 * (uu / 3) + uu % 3;
        if (u < 768) {
            const int qb = 31 - u / 24, bh = u % 24, b = bh / 12, h = bh % 12;
            const bf16_t* Q = (const bf16_t*)(ws + WS_Q) + (size_t)b * SEQ * 768 + h * 64;
            const bf16_t* K = (const bf16_t*)(ws + WS_K) + (size_t)b * SEQ * 768 + h * 64;
            const bf16_t* Vt = (const bf16_t*)(ws + WS_VT) + (size_t)(b * 768 + h * 64) * SEQ;
            const float* cum = (const float*)(ws + WS_CUM) + (size_t)bh * SEQ;
            bf16_t* O = (bf16_t*)(ws + WS_MERGED) + (size_t)b * SEQ * 1024 + h * 64;
            attn_unit<64, true, false>(F.lds, Q, 768, K, 768, Vt, SEQ, cum, O, 1024, qb * 256, 4 * (qb + 1), true, nullptr, F.wid, (const float*)(ws + WS_KN2) + bh * 128);
        } else mem_attn_unit(F, 0, u - 768);
    }
    while (conv_pull(F, 0, 16)) {}
}
DI void phase_attn1(Frame& F, const Params& P) {
    F.lane = vlane(); F.tid = F.wid * 64 + F.lane;
    unsigned char* ws = F.ws;
    constexpr int NCONV = 256, NU = 768 + 256 + NCONV;
    for (;;) {
        const int uu = next_unit(F, 1);
        if (uu >= NU) break;
        if (uu % 5 == 4) { conv_pull(F, 1, CONV_A1); continue; }
        const int u = 4 * (uu / 5) + uu % 5;
        if (u < 768) {
            const int qb = 31 - u / 24, bh = u % 24, b = bh / 12, h = bh % 12;
            const bf16_t* Q = (const bf16_t*)(ws + WS_Q) + (size_t)b * SEQ * 1152 + h * 96;
            const bf16_t* K = (const bf16_t*)(ws + WS_K) + (size_t)b * SEQ * 1152 + h * 96;
            const bf16_t* Vt = (const bf16_t*)(ws + WS_VT) + (size_t)(b * 768 + h * 64) * SEQ;
            bf16_t* O = (bf16_t*)(ws + WS_MERGED) + (size_t)b * SEQ * 1024 + h * 64;
            attn_unit_pipe<96, true>(F.lds, Q, 1152, K, 1152, Vt, SEQ, O, 1024, qb * 256, 4 * (qb + 1), KP->pos + (size_t)b * SEQ, F.wid);
        } else mem_attn_unit(F, 1, u - 768);
    }
    while (conv_pull(F, 1, 16)) {}
}

DI void phase_outproj(Frame& F, const float* X, const bf16_t* Wt) {
    F.lane = vlane(); F.tid = F.wid * 64 + F.lane;
    unsigned char* ws = F.ws;
    pg8::Gemm g{(const bf16_t*)(ws + WS_MERGED), Wt, 1024}; pg8::StaticOrder S; S.init(T, 1024, 1024, F.G, F.bid);
    EpiResF32 E{(float*)(ws + WS_Y), X};
    pg8::gemm_phase<EpiResF32, pg8::StaticOrder, false>(F.lds, g, S, E, F.wid);
}


DI void phase_ln_router(Frame& F, const Params& P, int l) {
    F.lane = vlane(); F.tid = F.wid * 64 + F.lane;
    unsigned char* ws = F.ws;
    LAS float* wt = (LAS float*)F.lds;
    const f32x4* wr4 = (const f32x4*)((const float*)(ws + WS_WRT) + (size_t)l * 32 * 1024);
    LAS int* pairs = (LAS int*)(F.lds + LDS_CTL + 1024);
    LAS int* lcnt = (LAS int*)(F.lds + LDS_CTL + 3072); LAS int* gbase = lcnt + 32;
    __syncthreads();
    for (int i = F.tid; i < 1024 * 32 / 4; i += NTHREADS) ((LAS f32x4*)wt)[i] = wr4[i];
    if (F.tid < 32) lcnt[F.tid] = 0;
    __syncthreads();
    const float* g = KP->ln_g + (size_t)(l * 2 + 0) * DM; const float* bt = KP->ln_b + (size_t)(l * 2 + 0) * DM;
    const float* br = KP->moe_b_r + l * 32;
    const float* Y = (const float*)(ws + WS_Y);
    bf16_t* X1B = (bf16_t*)(ws + WS_X1B);
    int* PE = (int*)(ws + WS_PE); int* PPOS = (int*)(ws + WS_PPOS); float* GATE = (float*)(ws + WS_GATE); int* TOKOF = (int*)(ws + WS_TOKOF);
    unsigned* cnt = F.ctl + CW_CNT + l * 32 * 64;
    const int gw = F.bid * 8 + F.wid, NGW = F.G * 8;
    int it = 0;
    f32x4 vnx[4];
    if (gw < T) {
#pragma unroll
        for (int j = 0; j < 4; ++j) vnx[j] = *((const f32x4*)(Y + (size_t)gw * DM) + F.lane + 64 * j);
    }
    for (int row = gw; row < T; row += NGW, ++it) {
        f32x4 v[4]; float s = 0.f;
#pragma unroll
        for (int j = 0; j < 4; ++j) { v[j] = vnx[j]; s += (v[j][0] + v[j][1]) + (v[j][2] + v[j][3]); }
        if (row + NGW < T) {
#pragma unroll
            for (int j = 0; j < 4; ++j) vnx[j] = *((const f32x4*)(Y + (size_t)(row + NGW) * DM) + F.lane + 64 * j);
        }
        const float mean = wave_sum(s) * (1.f / DM); float s2 = 0.f;
#pragma unroll
        for (int j = 0; j < 4; ++j) { v[j] = v[j] - mean; s2 += (v[j][0] * v[j][0] + v[j][1] * v[j][1]) + (v[j][2] * v[j][2] + v[j][3] * v[j][3]); }
        const float rstd = 1.0f / sqrtf(wave_sum(s2) * (1.f / DM) + LN_EPS);
#pragma unroll
        for (int j = 0; j < 4; ++j) {
            const f32x4 gg = *((const f32x4*)g + F.lane + 64 * j), bb = *((const f32x4*)bt + F.lane + 64 * j);
            v[j] = v[j] * rstd * gg + bb;
            *((u32x2*)(X1B + (size_t)row * DM) + F.lane + 64 * j) = (u32x2){cvtpk(v[j][0], v[j][1]), cvtpk(v[j][2], v[j][3])};
        }
        float part[16];
        f32x4 wc[4], wc2[4], wn[4], wn2[4];
#pragma unroll
        for (int j = 0; j < 4; ++j) { wc[j] = *((const LAS f32x4*)(wt) + F.lane + 64 * j); wc2[j] = *((const LAS f32x4*)(wt + 16 * 1024) + F.lane + 64 * j); }
#pragma unroll
        for (int i = 0; i < 16; ++i) {
            if (i + 1 < 16) {
#pragma unroll
                for (int j = 0; j < 4; ++j) { wn[j] = *((const LAS f32x4*)(wt + (i + 1) * 1024) + F.lane + 64 * j); wn2[j] = *((const LAS f32x4*)(wt + (i + 17) * 1024) + F.lane + 64 * j); }
            }
            asm volatile("" ::: "memory");
            float a = 0.f, b = 0.f;
#pragma unroll
            for (int j = 0; j < 4; ++j) {
                a += (v[j][0] * wc[j][0] + v[j][1] * wc[j][1]) + (v[j][2] * wc[j][2] + v[j][3] * wc[j][3]);
                b += (v[j][0] * wc2[j][0] + v[j][1] * wc2[j][1]) + (v[j][2] * wc2[j][2] + v[j][3] * wc2[j][3]);
            }
            const auto rr = __builtin_amdgcn_permlane32_swap(__float_as_uint(a), __float_as_uint(b), false, false);
            part[i] = __uint_as_float(rr[0]) + __uint_as_float(rr[1]);
#pragma unroll
            for (int j = 0; j < 4; ++j) { wc[j] = wn[j]; wc2[j] = wn2[j]; }
        }
#pragma unroll
        for (int i = 0; i < 8; ++i) {
            const auto rr = __builtin_amdgcn_permlane16_swap(__float_as_uint(part[i]), __float_as_uint(part[i + 8]), false, false);
            part[i] = __uint_as_float(rr[0]) + __uint_as_float(rr[1]);
        }
#pragma unroll
        for (int i = 0; i < 4; ++i) { const bool up = (F.lane & 8) != 0; const float keep = up ? part[i + 4] : part[i], send = up ? part[i] : part[i + 4]; part[i] = keep + __shfl_xor(send, 8); }
#pragma unroll
        for (int i = 0; i < 2; ++i) { const bool up = (F.lane & 4) != 0; const float keep = up ? part[i + 2] : part[i], send = up ? part[i] : part[i + 2]; part[i] = keep + __shfl_xor(send, 4); }
        { const bool up = (F.lane & 2) != 0; const float keep = up ? part[1] : part[0], send = up ? part[0] : part[1]; part[0] = keep + __shfl_xor(send, 2); }
        float logit = part[0] + __shfl_xor(part[0], 1);
        const int myexp = F.lane >> 1;
        logit += br[myexp];
        int rank = 0;
#pragma unroll
        for (int e = 0; e < 32; ++e) {
            const float ve = __uint_as_float((unsigned)__builtin_amdgcn_readlane((int)__float_as_uint(logit), 2 * e));
            rank += (ve > logit || (ve == logit && e < myexp)) ? 1 : 0;
        }
        float tv[4]; int te[4];
#pragma unroll
        for (int k = 0; k < 4; ++k) {
            const unsigned long long bal = __ballot(rank == k);
            const int ln = __ffsll((long long)bal) - 1;
            te[k] = ln >> 1; tv[k] = __uint_as_float((unsigned)__builtin_amdgcn_readlane((int)__float_as_uint(logit), ln));
        }
        const float e1 = __expf(tv[1] - tv[0]), e2 = __expf(tv[2] - tv[0]), e3 = __expf(tv[3] - tv[0]);
        const float rs = 1.0f / (1.0f + e1 + e2 + e3);
        if (F.lane < 4) {
            const int k = F.lane;
            const int e = k == 0 ? te[0] : k == 1 ? te[1] : k == 2 ? te[2] : te[3];
            const float gt = (k == 0 ? 1.0f : k == 1 ? e1 : k == 2 ? e2 : e3) * rs;
            const int rk = __hip_atomic_fetch_add(lcnt + e, 1, __ATOMIC_RELAXED, __HIP_MEMORY_SCOPE_WORKGROUP);
            PE[row * 4 + k] = e; GATE[row * 4 + k] = gt; pairs[(F.wid * 16 + (it & 15)) * 4 + k] = e | (rk << 8);
        }
    }
    __syncthreads();
    if (F.tid < 32) { const int c = lcnt[F.tid]; gbase[F.tid] = c ? (int)atomicAdd(cnt + F.tid * 64, (unsigned)c) : 0; }
    __syncthreads();
    it = 0;
    for (int row = gw; row < T; row += NGW, ++it) {
        if (F.lane < 4) {
            const int pr = pairs[(F.wid * 16 + (it & 15)) * 4 + F.lane], e = pr & 255, p = gbase[e] + (pr >> 8);
            PPOS[row * 4 + F.lane] = p; TOKOF[(size_t)e * T + p] = row;
        }
    }
}

DI void moe_tables(Frame& F, int l, LAS int* tstart, LAS int* soff) {
    __syncthreads();
    if (F.tid == 0) {
        int ts = 0;
        for (int e = 0; e < 32; ++e) {
            const int c = (int)__hip_atomic_load(F.ctl + CW_CNT + (l * 32 + e) * 64, __ATOMIC_RELAXED, __HIP_MEMORY_SCOPE_AGENT);
            tstart[e] = ts; soff[e] = ts * 256; tstart[80 + e] = c; ts += (c + 255) >> 8;
        }
        tstart[32] = ts; soff[32] = ts * 256;
    }
    __syncthreads();
}
DI void phase_moe_gu(Frame& F, const Params& P, int l) {
    F.lane = vlane(); F.tid = F.wid * 64 + F.lane;
    unsigned char* ws = F.ws;
    LAS int* tstart = (LAS int*)(F.lds + LDS_CTL + 64); LAS int* soff = tstart + 40;
    moe_tables(F, l, tstart, soff);
    pg8::Gemm g{(const bf16_t*)(ws + WS_X1B), (const bf16_t*)(ws + WS_W_GU) + (size_t)l * 32 * 2048 * 1024, 1024};
    LAS int* ulist = (LAS int*)(F.lds + LDS_CTL + 3328);
    MoeOrder::build(F, tstart, 8, ulist);
    MoeOrder S{tstart, 3, true, (const int*)(ws + WS_TOKOF), (const LAS int*)(F.lds + LDS_CTL + 1024), ulist};
    EpiGU E{(bf16_t*)(ws + WS_H), KP->moe_b_gu + (size_t)l * 32 * 2048};
    pg8::gemm_phase<EpiGU, MoeOrder, true>(F.lds, g, S, E, F.wid);
    if (l == 0) { const int rem = (tstart[32] * 8) % F.G; if (rem && F.bid >= rem) conv_pull(F, 1, CONV_GU); }
}
DI void phase_moe_dn(Frame& F, const Params& P, int l) {
    F.lane = vlane(); F.tid = F.wid * 64 + F.lane;
    unsigned char* ws = F.ws;
    LAS int* tstart = (LAS int*)(F.lds + LDS_CTL + 64); LAS int* soff = tstart + 40;
    moe_tables(F, l, tstart, soff);
    pg8::Gemm g{(const bf16_t*)(ws + WS_H), (const bf16_t*)(ws + WS_W_DN) + (size_t)l * 32 * 1024 * 1024, 1024};
    LAS int* ulist = (LAS int*)(F.lds + LDS_CTL + 3328);
    MoeOrder::build(F, tstart, 4, ulist, true);
    MoeOrder S{tstart, 2, false, nullptr, nullptr, ulist};
    EpiDN E{(bf16_t*)(ws + WS_YE), KP->moe_b_dn + (size_t)l * 32 * 1024};
    pg8::gemm_phase<EpiDN, MoeOrder, true>(F.lds, g, S, E, F.wid);
    if (l == 0) { const int rem = (tstart[32] * 4) % F.G; if (rem && F.bid >= rem) conv_pull(F, 1, CONV_DN); }
}


DI void phase_combine(Frame& F, const Params& P, int l, float* outf, bf16_t* outb) {
    F.lane = vlane(); F.tid = F.wid * 64 + F.lane;
    unsigned char* ws = F.ws;
    LAS int* tstart = (LAS int*)(F.lds + LDS_CTL + 64); LAS int* soff = tstart + 40;
    moe_tables(F, l, tstart, soff);
    const float* g = KP->ln_g + (size_t)(l * 2 + 1) * DM; const float* bt = KP->ln_b + (size_t)(l * 2 + 1) * DM;
    const float* X1 = (const float*)(ws + WS_Y); const bf16_t* YE = (const bf16_t*)(ws + WS_YE);
    const float* g1 = KP->ln_g + (size_t)(l * 2 + 0) * DM; const float* b1 = KP->ln_b + (size_t)(l * 2 + 0) * DM;
    const int* PE = (const int*)(ws + WS_PE); const int* PPOS = (const int*)(ws + WS_PPOS); const float* GATE = (const float*)(ws + WS_GATE);
    const int gw = F.bid * 8 + F.wid, NGW = F.G * 8;
    typedef int i32x4 __attribute__((ext_vector_type(4)));
    i32x4 ie, ip; f32x4 ig;
    f32x4 xn[4]; u32x2 yn[4][4]; f32x4 gn;
#define CB_LOADIDX(r) do { ie = *(const i32x4*)(PE + (size_t)(r) * 4); ip = *(const i32x4*)(PPOS + (size_t)(r) * 4); ig = *(const f32x4*)(GATE + (size_t)(r) * 4); } while (0)
#define CB_LOADDATA(r) do { gn = ig; \
        _Pragma("unroll") for (int j = 0; j < 4; ++j) xn[j] = *((const f32x4*)(X1 + (size_t)(r) * DM) + F.lane + 64 * j); \
        _Pragma("unroll") for (int k = 0; k < 4; ++k) { const int slot = soff[ie[k]] + ip[k]; const u32x2* yr = (const u32x2*)(YE + (size_t)slot * 1024) + F.lane; \
            _Pragma("unroll") for (int j = 0; j < 4; ++j) yn[k][j] = yr[64 * j]; } } while (0)
    if (gw < T) { CB_LOADIDX(gw); CB_LOADDATA(gw); if (gw + NGW < T) CB_LOADIDX(gw + NGW); }
    for (int row = gw; row < T; row += NGW) {
        f32x4 v[4]; u32x2 yc[4][4]; f32x4 gc = gn;
        {
            float s0 = 0.f;
#pragma unroll
            for (int j = 0; j < 4; ++j) { v[j] = xn[j]; s0 += (v[j][0] + v[j][1]) + (v[j][2] + v[j][3]); }
            const float mean0 = wave_sum(s0) * (1.f / DM); float q0 = 0.f;
#pragma unroll
            for (int j = 0; j < 4; ++j) { v[j] = v[j] - mean0; q0 += (v[j][0] * v[j][0] + v[j][1] * v[j][1]) + (v[j][2] * v[j][2] + v[j][3] * v[j][3]); }
            const float rstd0 = 1.0f / sqrtf(wave_sum(q0) * (1.f / DM) + LN_EPS);
#pragma unroll
            for (int j = 0; j < 4; ++j) {
                const f32x4 gg = *((const f32x4*)g1 + F.lane + 64 * j), bb = *((const f32x4*)b1 + F.lane + 64 * j);
                v[j] = (v[j] * rstd0 * gg + bb) * ALPHA;
            }
        }
#pragma unroll
        for (int k = 0; k < 4; ++k)
#pragma unroll
            for (int j = 0; j < 4; ++j) yc[k][j] = yn[k][j];
        if (row + NGW < T) { CB_LOADDATA(row + NGW); if (row + 2 * NGW < T) CB_LOADIDX(row + 2 * NGW); }
#pragma unroll
        for (int k = 0; k < 4; ++k) {
            const float gt = gc[k];
#pragma unroll
            for (int j = 0; j < 4; ++j) {
                const u32x2 w = yc[k][j];
                v[j][0] += gt * __uint_as_float(w.x << 16); v[j][1] += gt * __uint_as_float(w.x & 0xffff0000u);
                v[j][2] += gt * __uint_as_float(w.y << 16); v[j][3] += gt * __uint_as_float(w.y & 0xffff0000u);
            }
        }
        float s = 0.f;
#pragma unroll
        for (int j = 0; j < 4; ++j) s += (v[j][0] + v[j][1]) + (v[j][2] + v[j][3]);
        const float mean = wave_sum(s) * (1.f / DM); float s2 = 0.f;
#pragma unroll
        for (int j = 0; j < 4; ++j) { v[j] = v[j] - mean; s2 += (v[j][0] * v[j][0] + v[j][1] * v[j][1]) + (v[j][2] * v[j][2] + v[j][3] * v[j][3]); }
        const float rstd = 1.0f / sqrtf(wave_sum(s2) * (1.f / DM) + LN_EPS);
#pragma unroll
        for (int j = 0; j < 4; ++j) {
            const f32x4 gg = *((const f32x4*)g + F.lane + 64 * j), bb = *((const f32x4*)bt + F.lane + 64 * j);
            v[j] = v[j] * rstd * gg + bb;
            *((f32x4*)(outf + (size_t)row * DM) + F.lane + 64 * j) = v[j];
            if (outb) *((u32x2*)(outb + (size_t)row * DM) + F.lane + 64 * j) = (u32x2){cvtpk(v[j][0], v[j][1]), cvtpk(v[j][2], v[j][3])};
        }
    }
#undef CB_LOADIDX
#undef CB_LOADDATA
}

DI void phase_lat(Frame& F) {
    F.lane = vlane(); F.tid = F.wid * 64 + F.lane;
    unsigned char* ws = F.ws;
    pg8::Gemm g{(const bf16_t*)(ws + WS_XB), (const bf16_t*)(ws + WS_W_BIN), 1024}; pg8::StaticOrder S; S.init(T, 1024, 1024, F.G, F.bid);
    EpiLat E{(float*)(ws + WS_LAT), 928};
    pg8::gemm_phase<EpiLat, pg8::StaticOrder, false>(F.lds, g, S, E, F.wid);
}

DI void phase_latrows(Frame& F, const Params& P) {
    F.lane = vlane(); F.tid = F.wid * 64 + F.lane;
    unsigned char* ws = F.ws;
    const float* LAT = (const float*)(ws + WS_LAT);
    bf16_t* CKV = (bf16_t*)(ws + WS_CKV); bf16_t* CQ = (bf16_t*)(ws + WS_CQ); bf16_t* MQ = (bf16_t*)(ws + WS_MQ); bf16_t* Kb = (bf16_t*)(ws + WS_K);
    const int gw = F.bid * 8 + F.wid, NGW = F.G * 8;
    for (int row = gw; row < T; row += NGW) {
        const float* lr = LAT + (size_t)row * 1024;
        {
            const f32x4 v = *((const f32x4*)lr + F.lane);
            const float ss = wave_sum((v[0] * v[0] + v[1] * v[1]) + (v[2] * v[2] + v[3] * v[3]));
            const float rs = 1.0f / sqrtf(ss * (1.f / 256.f) + RMS_EPS);
            const f32x4 gg = *((const f32x4*)KP->kv_g + F.lane);
            const f32x4 o = v * rs * gg;
            *((u32x2*)(CKV + (size_t)row * 256) + F.lane) = (u32x2){cvtpk(o[0], o[1]), cvtpk(o[2], o[3])};
        }
        {
            const f32x4 v0 = *((const f32x4*)(lr + 288) + F.lane);
            f32x4 v1 = (f32x4){0.f, 0.f, 0.f, 0.f};
            if (F.lane < 32) v1 = *((const f32x4*)(lr + 288 + 256) + F.lane);
            const float ss = wave_sum((v0[0] * v0[0] + v0[1] * v0[1]) + (v0[2] * v0[2] + v0[3] * v0[3]) + (v1[0] * v1[0] + v1[1] * v1[1]) + (v1[2] * v1[2] + v1[3] * v1[3]));
            const float rs = 1.0f / sqrtf(ss * (1.f / 384.f) + RMS_EPS);
            const f32x4 g0 = *((const f32x4*)KP->b_g_q + F.lane);
            const f32x4 o0 = v0 * rs * g0;
            *((u32x2*)(CQ + (size_t)row * 384) + F.lane) = (u32x2){cvtpk(o0[0], o0[1]), cvtpk(o0[2], o0[3])};
            if (F.lane < 32) {
                const f32x4 g1 = *((const f32x4*)(KP->b_g_q + 256) + F.lane);
                const f32x4 o1 = v1 * rs * g1;
                *((u32x2*)(CQ + (size_t)row * 384 + 256) + F.lane) = (u32x2){cvtpk(o1[0], o1[1]), cvtpk(o1[2], o1[3])};
            }
        }
        {
            const f32x4 v = *((const f32x4*)(lr + 672) + F.lane) * (0.125f * LOG2E);
            *((u32x2*)(MQ + (size_t)row * 256) + F.lane) = (u32x2){cvtpk(v[0], v[1]), cvtpk(v[2], v[3])};
        }
        if (F.lane < 16) {
            const int i = F.lane;
            const float p = (float)KP->pos[row];
            const float inv = exp2f(-(float)i * (13.287712379549449f / 16.0f));
            float sn, cs; sincos_cw(p * inv, sn, cs);
            const float x1 = lr[256 + i], x2 = lr[256 + 16 + i];
            const unsigned short o1 = (unsigned short)(cvtpk(x1 * cs - x2 * sn, 0.f) & 0xffffu), o2 = (unsigned short)(cvtpk(x1 * sn + x2 * cs, 0.f) & 0xffffu);
#pragma unroll
            for (int h = 0; h < NH; ++h) { Kb[(size_t)row * 1152 + h * 96 + 64 + i] = o1; Kb[(size_t)row * 1152 + h * 96 + 80 + i] = o2; }
        }
    }
}
#ifndef UPSEL
#define UPSEL 7
#endif
struct RouteK1 { unsigned char* ws; DI Dst operator()(const pg8::Unit& u) const { return Dst{(bf16_t*)(ws + WS_K), 1152, u.pm * 256, u.pn * 384, 256, 1.0f, true}; } };
struct RouteQ1 { unsigned char* ws; DI Dst operator()(const pg8::Unit& u) const { const int nv = 1152 - u.pn * 256; return Dst{(bf16_t*)(ws + WS_Q), 1152, u.pm * 256, u.pn * 256, nv < 256 ? nv : 256, 0.10206207261596577f * LOG2E, false}; } };
DI void phase_up1(Frame& F) {
    F.lane = vlane(); F.tid = F.wid * 64 + F.lane;
    unsigned char* ws = F.ws;
    const bf16_t* ckv = (const bf16_t*)(ws + WS_CKV); const bf16_t* cq = (const bf16_t*)(ws + WS_CQ);
    const bf16_t* wukv = (const bf16_t*)(ws + WS_W_UKV); const bf16_t* wuq = (const bf16_t*)(ws + WS_W_UQ);
#if (UPSEL & 1)
    {
        pg8::Gemm g{cq, wuq, 384}; pg8::StaticOrder S; S.init(T, 1280, 384, F.G, F.bid);
        EpiBf16R<RouteQ1> E{RouteQ1{ws}};
        pg8::gemm_phase<EpiBf16R<RouteQ1>, pg8::StaticOrder, true>(F.lds, g, S, E, F.wid);
    }
#endif
#if (UPSEL & 2)
    {
        pg8::Gemm g{ckv, wukv, 256}; pg8::StaticOrder S; S.init(T, 768, 256, F.G, F.G - 1 - F.bid);
        EpiBf16R<RouteK1> E{RouteK1{ws}};
        pg8::gemm_phase<EpiBf16R<RouteK1>, pg8::StaticOrder, true>(F.lds, g, S, E, F.wid);
    }
#endif
#if (UPSEL & 4)
    {
        pg8::Gemm g{wukv + (size_t)768 * 256, ckv, 256}; pg8::StaticOrder S; S.init(768, T, 256, F.G, F.G - 1 - F.bid);
        EpiBf16R<RouteVT> E{RouteVT{ws}};
        pg8::gemm_phase<EpiBf16R<RouteVT>, pg8::StaticOrder, true>(F.lds, g, S, E, F.wid);
    }
#endif
}


__global__ void __launch_bounds__(NTHREADS) mega_fwd(Params P) {
    extern __shared__ __attribute__((aligned(16))) unsigned char lds_raw[];
    Frame F;
    F.lds = (LAS unsigned char*)lds_raw; F.ws = KP->ws; F.ctl = (unsigned*)(KP->ws + WS_CTL);
    F.wid = __builtin_amdgcn_readfirstlane((int)threadIdx.x >> 6); F.lane = vlane(); F.tid = F.wid * 64 + F.lane; F.G = gridDim.x; F.bid = blockIdx.x;
    const int lo = KP->ph_lo, hi = KP->ph_hi;
    { volatile LAS unsigned* st0 = (volatile LAS unsigned*)(F.lds + LDS_CTL + 512); if (F.tid < 2) st0[F.tid] = 0u; }
    __syncthreads();
    XcdBarrier bar = xcd_barrier_post(F.ctl + CW_BAR, (volatile LAS unsigned*)(F.lds + LDS_CTL + 512), F.wid);
#ifndef PHMASK
#define PHMASK 0x1ffff
#endif
#define IN(k) (((PHMASK >> (k)) & 1) && lo <= (k) && (k) < hi)
#define SEAM(k) do { if (IN(k) && IN((k) + 1)) { if (KP->use_grid_sync) { if ((k) == 0) cg::this_grid().sync(); else xcd_barrier(bar); } } } while (0)
    unsigned char* ws = KP->ws;
    if (IN(0)) { phase_prologue(F, P);
    }
    SEAM(0);
    if (IN(1)) { phase_proj0(F, P);
        if (KP->use_grid_sync) xcd_barrier(bar); phase_scan_knorm(F); }
    SEAM(1);
    if (IN(2)) { phase_attn0(F, P);
    }
    SEAM(2);
    if (IN(3)) { phase_outproj(F, KP->x, (const bf16_t*)(ws + WS_W_AOUT));
    }
    SEAM(3);
    if (IN(4)) phase_ln_router(F, P, 0);
    SEAM(4);
    if (IN(5)) phase_moe_gu(F, P, 0);
    SEAM(5);
    if (IN(6)) phase_moe_dn(F, P, 0);
    SEAM(6);
    if (IN(7)) phase_combine(F, P, 0, (float*)(ws + WS_X2), (bf16_t*)(ws + WS_XB));
    SEAM(7);
    if (IN(8)) phase_lat(F);
    SEAM(8);
    if (IN(9)) phase_latrows(F, P);
    SEAM(9);
    if (IN(10)) { phase_up1(F);
    }
    SEAM(10);
    if (IN(11)) { phase_attn1(F, P);
    }
    SEAM(11);
    if (IN(12)) phase_outproj(F, (const float*)(ws + WS_X2), (const bf16_t*)(ws + WS_W_BOUT));
    SEAM(12);
    if (IN(13)) phase_ln_router(F, P, 1);
    SEAM(13);
    if (IN(14)) { phase_moe_gu(F, P, 1);
    }
    SEAM(14);
    if (IN(15)) { phase_moe_dn(F, P, 1);
    }
    SEAM(15);
    if (IN(16)) { phase_combine(F, P, 1, KP->out, nullptr);
    }
#undef IN
#undef SEAM
}

constexpr int N_PHASES = 17;
#ifndef MK_N_LAUNCHES
#define MK_N_LAUNCHES 1
#endif

extern "C" void kernel_launch(void* const* d_in, const int* in_sizes, int n_in, void* d_out, int out_size, void* d_ws, size_t ws_size, hipStream_t stream) {
    static int grid = 0;
    if (grid == 0) {
        if (n_in != 22 || ws_size < WS_END) { fprintf(stderr, "kernel_launch: need 22 inputs and %zu bytes of workspace (got %d, %zu)\n", (size_t)WS_END, n_in, ws_size); grid = -1; return; }
        int dev = 0, cus = 0, per_cu = 0;
        hipGetDevice(&dev);
        hipDeviceGetAttribute(&cus, hipDeviceAttributeMultiprocessorCount, dev);
        if (hipFuncSetAttribute((const void*)mega_fwd, hipFuncAttributeMaxDynamicSharedMemorySize, LDS_BYTES) != hipSuccess) fprintf(stderr, "kernel_launch: hipFuncSetAttribute failed\n");
        if (hipOccupancyMaxActiveBlocksPerMultiprocessor(&per_cu, (const void*)mega_fwd, NTHREADS, LDS_BYTES) != hipSuccess || per_cu < 1) { fprintf(stderr, "kernel_launch: occupancy query failed (%d)\n", per_cu); per_cu = 1; }
        (void)hipGetLastError();
        grid = cus * (per_cu > 1 ? 1 : per_cu);
        if (grid <= 0) grid = 256;
    }
    if (grid < 0) return;
    hipMemsetAsync((char*)d_ws + WS_CTL, 0, CTL_BYTES, stream);
    Params p{};
    p.x = (const float*)d_in[0]; p.mem = (const float*)d_in[1]; p.pos = (const int*)d_in[2];
    p.a_w_in = (const float*)d_in[3]; p.a_b_f = (const float*)d_in[4]; p.a_w_out = (const float*)d_in[5];
    p.b_w_in = (const float*)d_in[6]; p.b_g_q = (const float*)d_in[7]; p.b_w_uq = (const float*)d_in[8]; p.b_w_out = (const float*)d_in[9];
    p.kv_w_dkv = (const float*)d_in[10]; p.kv_g = (const float*)d_in[11]; p.kv_w_ukv = (const float*)d_in[12]; p.mem_w_kv = (const float*)d_in[13];
    p.ln_g = (const float*)d_in[14]; p.ln_b = (const float*)d_in[15]; p.moe_w_r = (const float*)d_in[16]; p.moe_b_r = (const float*)d_in[17];
    p.moe_w_gu = (const float*)d_in[18]; p.moe_b_gu = (const float*)d_in[19]; p.moe_w_dn = (const float*)d_in[20]; p.moe_b_dn = (const float*)d_in[21];
    p.out = (float*)d_out; p.ws = (unsigned char*)d_ws;
    if (MK_N_LAUNCHES == 1) {
        p.ph_lo = 0; p.ph_hi = N_PHASES; p.use_grid_sync = 1;
        void* args[] = {&p};
        hipError_t e = hipLaunchCooperativeKernel((const void*)mega_fwd, dim3(grid), dim3(NTHREADS), args, LDS_BYTES, stream);
        if (e != hipSuccess) fprintf(stderr, "kernel_launch: cooperative launch failed: %s (grid %d)\n", hipGetErrorString(e), grid);
    } else {
        for (int ph = 0; ph < N_PHASES; ++ph) {
            p.ph_lo = ph; p.ph_hi = ph + 1; p.use_grid_sync = 0;
            hipLaunchKernelGGL(mega_fwd, dim3(grid), dim3(NTHREADS), LDS_BYTES, stream, p);
        }
    }
}
```

```cpp
#include <hip/hip_runtime.h>
#include <hip/hip_cooperative_groups.h>
#include <cstdio>
#include <cstdint>
#include <cmath>
namespace cg = cooperative_groups;

#define DI __device__ __forceinline__
#define LAS __attribute__((address_space(3)))
typedef unsigned short bf16_t;
typedef short bf16x8 __attribute__((ext_vector_type(8)));
typedef float f32x4 __attribute__((ext_vector_type(4)));
typedef float f32x2 __attribute__((ext_vector_type(2)));
typedef float f32x16 __attribute__((ext_vector_type(16)));
typedef unsigned u32x4 __attribute__((ext_vector_type(4)));
typedef unsigned u32x2 __attribute__((ext_vector_type(2)));
typedef __bf16 bf16x2_t __attribute__((ext_vector_type(2)));

constexpr int NB = 2, SEQ = 8192, T = NB * SEQ, DM = 1024;
constexpr int NH = 12, NMEM = 256;
constexpr int FOX_IN = 2572;
constexpr int NE = 32;
constexpr float LOG2E = 1.4426950408889634f;
constexpr float ALPHA = 1.4142135623730951f;
constexpr float LN_EPS = 1e-5f, RMS_EPS = 1e-6f;
constexpr int NTHREADS = 512;
constexpr int LDS_BYTES = 131072 + 4096 + 8 * 1280 + 512;
constexpr int LDS_R1X = 131072 + 4096;
constexpr int LDS_CTL = 131072;
constexpr int SLOT_ROWS = 65536 + NE * 256;

constexpr size_t al256(size_t x) { return (x + 255) & ~(size_t)255; }
constexpr size_t WS_CTL = 0, CTL_BYTES = 65536;
constexpr size_t WS_W_AIN = al256(WS_CTL + CTL_BYTES);
constexpr size_t WS_W_AOUT = al256(WS_W_AIN + (size_t)2560 * 1024 * 2);
constexpr size_t WS_W_BIN = al256(WS_W_AOUT + (size_t)1024 * 1024 * 2);
constexpr size_t WS_W_UQ = al256(WS_W_BIN + (size_t)1024 * 1024 * 2);
constexpr size_t WS_W_UKV = al256(WS_W_UQ + (size_t)1280 * 384 * 2);
constexpr size_t WS_W_BOUT = al256(WS_W_UKV + (size_t)1536 * 256 * 2);
constexpr size_t WS_W_MKV = al256(WS_W_BOUT + (size_t)1024 * 1024 * 2);
constexpr size_t WS_W_GU = al256(WS_W_MKV + (size_t)2 * 512 * 1024 * 2);
constexpr size_t WS_W_DN = al256(WS_W_GU + (size_t)2 * 32 * 2048 * 1024 * 2);
constexpr size_t WS_XB = al256(WS_W_DN + (size_t)2 * 32 * 1024 * 1024 * 2);
constexpr size_t WS_MEMB = al256(WS_XB + (size_t)T * 1024 * 2);
constexpr size_t WS_LOGF = al256(WS_MEMB + (size_t)512 * 1024 * 2);
constexpr size_t WS_CUM = al256(WS_LOGF + (size_t)24 * 8192 * 4);
constexpr size_t WS_Q = al256(WS_CUM + (size_t)24 * 8192 * 4);
constexpr size_t WS_K = al256(WS_Q + (size_t)T * 1152 * 2);
constexpr size_t WS_VT = al256(WS_K + (size_t)T * 1152 * 2);
constexpr size_t WS_MQ = al256(WS_VT + (size_t)1536 * 8192 * 2);
constexpr size_t WS_MK = al256(WS_MQ + (size_t)T * 256 * 2);
constexpr size_t WS_MVT = al256(WS_MK + (size_t)2 * 512 * 256 * 2);
constexpr size_t WS_MERGED = al256(WS_MVT + (size_t)2 * 2 * 256 * 256 * 2);
constexpr size_t WS_Y = al256(WS_MERGED + (size_t)T * 1024 * 2);
constexpr size_t WS_X1 = al256(WS_Y + (size_t)T * 1024 * 4);
constexpr size_t WS_X1B = al256(WS_X1 + (size_t)T * 1024 * 4);
constexpr size_t WS_PE = al256(WS_X1B + (size_t)T * 1024 * 2);
constexpr size_t WS_PPOS = al256(WS_PE + (size_t)T * 4 * 4);
constexpr size_t WS_GATE = al256(WS_PPOS + (size_t)T * 4 * 4);
constexpr size_t WS_TOKOF = al256(WS_GATE + (size_t)T * 4 * 4);
constexpr size_t WS_H = al256(WS_TOKOF + (size_t)NE * T * 4);
constexpr size_t WS_YE = al256(WS_H + (size_t)SLOT_ROWS * 1024 * 2);
constexpr size_t WS_LAT = al256(WS_YE + (size_t)SLOT_ROWS * 1024 * 2);
constexpr size_t WS_CKV = al256(WS_LAT + (size_t)T * 1024 * 4);
constexpr size_t WS_CQ = al256(WS_CKV + (size_t)T * 256 * 2);
constexpr size_t WS_X2 = al256(WS_CQ + (size_t)T * 384 * 2);
constexpr size_t WS_KN2 = al256(WS_X2 + (size_t)T * 1024 * 4);
constexpr size_t WS_WRT = al256(WS_KN2 + (size_t)24 * 128 * 4);
constexpr size_t WS_WRH = al256(WS_WRT + (size_t)2 * 32 * 1024 * 4);
constexpr size_t WS_WRL = al256(WS_WRH + (size_t)2 * 32 * 1024 * 2);
constexpr size_t WS_END = al256(WS_WRL + (size_t)2 * 32 * 1024 * 2);
constexpr int CW_CNT = 8192;
constexpr int CW_WORK = 256;
constexpr int CW_BAR = 4096;

struct Params {
    const float* x; const float* mem; const int* pos;
    const float *a_w_in, *a_b_f, *a_w_out, *b_w_in, *b_g_q, *b_w_uq, *b_w_out, *kv_w_dkv, *kv_g, *kv_w_ukv, *mem_w_kv, *ln_g, *ln_b;
    const float *moe_w_r, *moe_b_r, *moe_w_gu, *moe_b_gu, *moe_w_dn, *moe_b_dn;
    float* out; unsigned char* ws; int ph_lo, ph_hi; int use_grid_sync, pad;
};

#define KP ((const __attribute__((address_space(4))) Params*)__builtin_amdgcn_kernarg_segment_ptr())
DI unsigned cvtpk(float lo, float hi) { f32x2 v = {lo, hi}; bf16x2_t b = __builtin_convertvector(v, bf16x2_t); return __builtin_bit_cast(unsigned, b); }
DI float bf2f(unsigned short b) { return __uint_as_float(((unsigned)b) << 16); }
DI float wave_sum(float v) {
#pragma unroll
    for (int o = 1; o < 64; o <<= 1) v += __shfl_xor(v, o);
    return v;
}
DI float wave_max(float v) {
#pragma unroll
    for (int o = 1; o < 64; o <<= 1) v = fmaxf(v, __shfl_xor(v, o));
    return v;
}

DI void sincos_cw(float x, float& sn, float& cs) {
    int j = (int)(x * 1.27323954473516f); j = (j + 1) & ~1;
    const float y = (float)j;
    const float r = ((x - y * 0.78515625f) - y * 2.4187564849853515625e-4f) - y * 3.77489497744594108e-8f;
    const float z = r * r;
    const float sp = ((-1.9515295891e-4f * z + 8.3321608736e-3f) * z - 1.6666654611e-1f) * z * r + r;
    const float cp = ((2.443315711809948e-5f * z - 1.388731625493765e-3f) * z + 4.166664568298827e-2f) * z * z - 0.5f * z + 1.0f;
    const int q = (j >> 1) & 3;
    const float s0 = (q & 1) ? cp : sp, c0 = (q & 1) ? sp : cp;
    sn = (q & 2) ? -s0 : s0;
    cs = ((q + 1) & 2) ? -c0 : c0;
}
DI float fadd_s(float a, float b) { float r; asm("v_add_f32_e32 %0, %1, %2" : "=v"(r) : "v"(a), "v"(b)); return r; }
DI int vlane() { int l; asm volatile("v_mbcnt_lo_u32_b32 %0, -1, 0\n\tv_mbcnt_hi_u32_b32 %0, -1, %0" : "=v"(l)); return l; }
#define LDS_WAIT() asm volatile("s_waitcnt lgkmcnt(0)" ::: "memory")
#define VM_WAIT() asm volatile("s_waitcnt vmcnt(0)" ::: "memory")

#ifndef GEMM_TOKPF
#define GEMM_TOKPF 2
#endif
namespace pg8 {
constexpr int BM = 256, BK = 64, HALF = 128, HTB = HALF * BK * 2, STAGE_BYTES = 8 * HTB, NXCD = 8, WGM = 8;
DI int lds_byte(int r, int c) { const int st = (r >> 4) * 2 + (c >> 5), rr = r & 15, cc = c & 31, ob = rr * 64 + cc * 2; return st * 1024 + (ob ^ (((ob >> 9) & 1) << 5)); }
DI void stage_rc(int b, int& R, int& C) { const int st = b / 1024, sb = b % 1024, swz = sb ^ (((sb >> 9) & 1) << 5); R = (st >> 1) * 16 + swz / 64; C = (st & 1) * 32 + (swz % 64) / 2; }
DI int perm32(int rho) { const int n = rho >> 4, i = rho & 15; return 8 * (i >> 2) + 4 * n + (i & 3); }
struct Unit { int pm, pn; };
struct Gemm { const bf16_t* A; const bf16_t* Bt; int K; };
struct StaticOrder {
    int nM, nN, nwg, G, c, K2;
    DI void init(int M, int N, int K, int G_, int c_) { nM = M / BM; nN = N / BM; nwg = nM * nN; G = G_; c = c_; K2 = K * 2; }
    DI bool next(int i, Unit& u) const {
        const long L = (long)i * G + c; if (L >= nwg) return false;
        int wgid = (int)L; { const int q = nwg / NXCD, r = nwg % NXCD, xcd = wgid % NXCD, off = wgid / NXCD; wgid = (xcd < r ? xcd * (q + 1) : r * (q + 1) + (xcd - r) * q) + off; }
        const int nig = WGM * nN, gid = wgid / nig, fm = gid * WGM, gsz = (nM - fm) < WGM ? (nM - fm) : WGM;
        u.pm = fm + ((wgid % nig) % gsz); u.pn = (wgid % nig) / gsz; return true;
    }
    DI unsigned a_off(const Unit& u, int r) const { return (unsigned)(u.pm * BM + r) * (unsigned)K2; }
    DI unsigned a_off_pf(const Unit& u, int r, int) const { return a_off(u, r); }
    DI void prefetch(const Unit&, int, int, int) const {}
    DI void a_ready(const Unit&) const {}
    DI void done(const Unit&) const {}
};

template <class Epi, class Sched, bool ALIGN_EPI>
DI void gemm_phase(LAS unsigned char* lds, const Gemm g, const Sched& S, const Epi& E, const int wid) {
    const int lane = vlane(), tid = wid * 64 + lane, wr = wid >> 2, wc = wid & 3, fr = lane & 15, fq = lane >> 4;
    const int K = g.K, nt = K / BK;
    int RA[2]; unsigned cA2[2], voffB[2];
#pragma unroll
    for (int i = 0; i < 2; ++i) { int R, C; stage_rc(tid * 16 + i * 8192, R, C); const int Rb = Epi::PERM ? ((R & ~31) + perm32(R & 31)) : R;
        RA[i] = R; cA2[i] = (unsigned)C * 2u; voffB[i] = (unsigned)(Rb * K + C) * 2u; }
    const size_t kstep = (size_t)(BK * 2);
    const size_t hstep = (size_t)HALF * K * 2;
    const size_t tstep = 2 * hstep;
    const unsigned ldsw = (unsigned)wid * 1024u;
    const int aoff = lds_byte(wr * 64 + fr, fq * 8), boff = lds_byte(wc * 32 + fr, fq * 8);
#define PG8_SA(b, h) (((b) * 2 + (h)) * HTB)
#define PG8_SB(b, h) ((4 + (b) * 2 + (h)) * HTB)
#define PG8_STAGE_B(bufoff, gbase) do { _Pragma("unroll") for (int _i = 0; _i < 2; ++_i) \
        __builtin_amdgcn_global_load_lds((const unsigned*)((const char*)(gbase) + voffB[_i]), (LAS unsigned*)(lds + (bufoff) + ldsw + _i * 8192), 16, 0, 0); } while (0)
#define PG8_STAGE_A(bufoff, kbytes, uo) do { _Pragma("unroll") for (int _i = 0; _i < 2; ++_i) \
        __builtin_amdgcn_global_load_lds((const unsigned*)((const char*)g.A + (kbytes) + (uo)[_i]), (LAS unsigned*)(lds + (bufoff) + ldsw + _i * 8192), 16, 0, 0); } while (0)
#define PG8_STAGE_A2(bufoff, kbytes, h) do { _Pragma("unroll") for (int _i = 0; _i < 2; ++_i) \
        __builtin_amdgcn_global_load_lds((const unsigned*)((const char*)g.A + (kbytes) + (last ? uN[h][_i] : uC[h][_i])), (LAS unsigned*)(lds + (bufoff) + ldsw + _i * 8192), 16, 0, 0); } while (0)
#define PG8_LDA(dst, b, h) do { _Pragma("unroll") for (int m = 0; m < 4; ++m) _Pragma("unroll") for (int k = 0; k < 2; ++k) dst[m][k] = *(const LAS bf16x8*)(lds + PG8_SA(b, h) + aoff + m * 2048 + k * 1024); } while (0)
#define PG8_LDB(dst, b, h) do { _Pragma("unroll") for (int n = 0; n < 2; ++n) _Pragma("unroll") for (int k = 0; k < 2; ++k) dst[n][k] = *(const LAS bf16x8*)(lds + PG8_SB(b, h) + boff + n * 2048 + k * 1024); } while (0)
#define PG8_MMA(ai, bj, At, Bt) do { __builtin_amdgcn_s_setprio(1); _Pragma("unroll") for (int m = 0; m < 4; ++m) _Pragma("unroll") for (int n = 0; n < 2; ++n) _Pragma("unroll") for (int k = 0; k < 2; ++k) \
        acc[ai][bj][m][n] = __builtin_amdgcn_mfma_f32_16x16x32_bf16(Bt[n][k], At[m][k], acc[ai][bj][m][n], 0, 0, 0); __builtin_amdgcn_s_setprio(0); } while (0)
#define PG8_WAIT_V(n) asm volatile("s_waitcnt vmcnt(" #n ")" ::: "memory")
#define PG8_WAIT_L(n) asm volatile("s_waitcnt lgkmcnt(" #n ")" ::: "memory")
#define PG8_BAR __builtin_amdgcn_s_barrier()
#define PG8_SCHED __builtin_amdgcn_sched_barrier(0)
    Unit cur, nxt; int ui = 0;
    if (!S.next(0, cur)) return;
    f32x4 acc[2][2][4][2];
#pragma unroll
    for (int a = 0; a < 2; ++a)
#pragma unroll
        for (int b = 0; b < 2; ++b)
#pragma unroll
            for (int m = 0; m < 4; ++m)
#pragma unroll
                for (int n = 0; n < 2; ++n) acc[a][b][m][n] = (f32x4){0.f, 0.f, 0.f, 0.f};
    bf16x8 At[4][2], B0[2][2], B1[2][2];
    unsigned uC[2][2], uN[2][2];
#pragma unroll
    for (int h = 0; h < 2; ++h)
#pragma unroll
        for (int i = 0; i < 2; ++i) uC[h][i] = S.a_off(cur, h * HALF + RA[i]) + cA2[i];
    const char* cB = (const char*)g.Bt + (size_t)cur.pn * tstep;
    S.a_ready(cur);
    PG8_STAGE_B(PG8_SB(0, 0), cB); PG8_STAGE_B(PG8_SB(0, 1), cB + hstep); PG8_STAGE_A(PG8_SA(0, 0), 0, uC[0]); PG8_STAGE_A(PG8_SA(0, 1), 0, uC[1]);
    if (wr == 1) PG8_BAR;
    PG8_WAIT_V(2); PG8_BAR;
    PG8_STAGE_B(PG8_SB(1, 0), cB + kstep); PG8_STAGE_A(PG8_SA(1, 0), kstep, uC[0]); PG8_STAGE_B(PG8_SB(1, 1), cB + hstep + kstep);
    PG8_WAIT_V(6); PG8_BAR;
    for (;;) {
        const bool has_next = S.next(ui + 1, nxt);
        const char* nB = has_next ? (const char*)g.Bt + (size_t)nxt.pn * tstep : cB;
#if GEMM_TOKPF == 1
        if (has_next) S.prefetch(nxt, (ui + 1) & 1, wid, lane);
#elif GEMM_TOKPF == 2
        {
            Unit nx2; const bool has2 = S.next(ui + 2, nx2);
#pragma unroll
            for (int h = 0; h < 2; ++h)
#pragma unroll
                for (int i = 0; i < 2; ++i) uN[h][i] = has_next ? ((ui == 0 ? S.a_off(nxt, h * HALF + RA[i]) : S.a_off_pf(nxt, h * HALF + RA[i], (ui + 1) & 1)) + cA2[i]) : uC[h][i];
            if (has2) S.prefetch(nx2, ui & 1, wid, lane);
        }
#else
#pragma unroll
        for (int h = 0; h < 2; ++h)
#pragma unroll
            for (int i = 0; i < 2; ++i) uN[h][i] = has_next ? (S.a_off(nxt, h * HALF + RA[i]) + cA2[i]) : uC[h][i];
#endif
#pragma nounroll
        for (int t = 0; t < nt; t += 2) {
            const bool last = (t == nt - 2);
            const size_t ka1 = (size_t)(t + 1) * kstep;
            const size_t ka2 = last ? (size_t)0 : (size_t)(t + 2) * kstep, ka3 = ka2 + kstep;
            const char* b2 = last ? nB : cB + (size_t)(t + 2) * kstep; const char* b3 = b2 + kstep;
#if GEMM_TOKPF == 1
            if (last) {
                if (has_next) S.a_ready(nxt);
#pragma unroll
                for (int h = 0; h < 2; ++h)
#pragma unroll
                    for (int i = 0; i < 2; ++i) uN[h][i] = has_next ? (S.a_off_pf(nxt, h * HALF + RA[i], (ui + 1) & 1) + cA2[i]) : uC[h][i];
            }
#endif
            PG8_LDB(B0, 0, 0); PG8_LDB(B1, 0, 1); PG8_SCHED; PG8_LDA(At, 0, 0); PG8_STAGE_A(PG8_SA(1, 1), ka1, uC[1]);
            PG8_WAIT_V(8); PG8_WAIT_L(0); PG8_BAR; PG8_MMA(0, 0, At, B0); PG8_MMA(0, 1, At, B1); PG8_BAR; PG8_SCHED;
            PG8_LDA(At, 0, 1); PG8_STAGE_B(PG8_SB(0, 0), b2); PG8_STAGE_B(PG8_SB(0, 1), b2 + hstep); PG8_STAGE_A2(PG8_SA(0, 0), ka2, 0);
            PG8_WAIT_V(8); PG8_WAIT_L(0); PG8_BAR; PG8_MMA(1, 0, At, B0); PG8_MMA(1, 1, At, B1); PG8_BAR; PG8_SCHED;
            PG8_LDB(B0, 1, 0); PG8_LDB(B1, 1, 1); PG8_SCHED; PG8_LDA(At, 1, 0); PG8_STAGE_A2(PG8_SA(0, 1), ka2, 1);
            PG8_WAIT_V(8); PG8_WAIT_L(0); PG8_BAR; PG8_MMA(0, 0, At, B0); PG8_MMA(0, 1, At, B1); PG8_BAR; PG8_SCHED;
            PG8_LDA(At, 1, 1); PG8_STAGE_B(PG8_SB(1, 0), b3); PG8_STAGE_B(PG8_SB(1, 1), b3 + hstep); PG8_STAGE_A2(PG8_SA(1, 0), ka3, 0);
            PG8_WAIT_V(8); PG8_WAIT_L(0); PG8_BAR; PG8_MMA(1, 0, At, B0); PG8_MMA(1, 1, At, B1); PG8_BAR; PG8_SCHED;
        }
        if constexpr (ALIGN_EPI) { if (wr == 0) PG8_BAR; }
        E(acc, cur, wr, wc, fr, fq); S.done(cur);
        if (!has_next) break;
#pragma unroll
        for (int a = 0; a < 2; ++a)
#pragma unroll
            for (int b = 0; b < 2; ++b)
#pragma unroll
                for (int m = 0; m < 4; ++m)
#pragma unroll
                    for (int n = 0; n < 2; ++n) acc[a][b][m][n] = (f32x4){0.f, 0.f, 0.f, 0.f};
        cur = nxt; cB = nB; ++ui;
#pragma unroll
        for (int h = 0; h < 2; ++h)
#pragma unroll
            for (int i = 0; i < 2; ++i) uC[h][i] = uN[h][i];
        if constexpr (ALIGN_EPI) { if (wr == 1) PG8_BAR; }
    }
    PG8_WAIT_V(0);
    if constexpr (!ALIGN_EPI) { if (wr == 0) PG8_BAR; }
    PG8_BAR;
#undef PG8_SA
#undef PG8_SB
#undef PG8_STAGE_A
#undef PG8_STAGE_A2
#undef PG8_STAGE_B
#undef PG8_LDA
#undef PG8_LDB
#undef PG8_MMA
#undef PG8_WAIT_V
#undef PG8_WAIT_L
#undef PG8_BAR
#undef PG8_SCHED
}
}

struct Dst { bf16_t* O; int ldo, row0, col0, nvalid; float scale; bool headmap; };
template <class Route> struct EpiBf16R {
    static constexpr bool PERM = true;
    Route R;
    DI void operator()(const f32x4 (&acc)[2][2][4][2], const pg8::Unit& u, int wr, int wc, int fr, int fq) const {
        const Dst d = R(u);
#pragma unroll
        for (int ai = 0; ai < 2; ++ai)
#pragma unroll
            for (int m = 0; m < 4; ++m) {
                bf16_t* rowp = d.O + (size_t)(d.row0 + ai * 128 + wr * 64 + m * 16 + fr) * d.ldo + d.col0;
#pragma unroll
                for (int bj = 0; bj < 2; ++bj) {
                    const int c = bj * 128 + wc * 32 + 8 * fq;
                    if (c < d.nvalid) {
                        const f32x4 v0 = acc[ai][bj][m][0] * d.scale, v1 = acc[ai][bj][m][1] * d.scale;
                        u32x4 w; w.x = cvtpk(v0[0], v0[1]); w.y = cvtpk(v0[2], v0[3]); w.z = cvtpk(v1[0], v1[1]); w.w = cvtpk(v1[2], v1[3]);
                        const int oc = d.headmap ? ((c >> 6) * 96 + (c & 63)) : c;
                        *(u32x4*)(rowp + oc) = w;
                    }
                }
            }
    }
};
struct EpiResF32 {
    static constexpr bool PERM = false;
    float* Y; const float* X;
    DI void operator()(const f32x4 (&acc)[2][2][4][2], const pg8::Unit& u, int wr, int wc, int fr, int fq) const {
#pragma unroll
        for (int ai = 0; ai < 2; ++ai)
#pragma unroll
            for (int m = 0; m < 4; ++m) {
                const size_t ro = (size_t)(u.pm * 256 + ai * 128 + wr * 64 + m * 16 + fr) * DM + u.pn * 256 + wc * 32 + 4 * fq;
#pragma unroll
                for (int bj = 0; bj < 2; ++bj)
#pragma unroll
                    for (int n = 0; n < 2; ++n) {
                        const f32x4 xv = *(const f32x4*)(X + ro + bj * 128 + n * 16);
                        *(f32x4*)(Y + ro + bj * 128 + n * 16) = xv * ALPHA + acc[ai][bj][m][n];
                    }
            }
    }
};
struct EpiLat {
    static constexpr bool PERM = false;
    float* O; int ncol;
    DI void operator()(const f32x4 (&acc)[2][2][4][2], const pg8::Unit& u, int wr, int wc, int fr, int fq) const {
#pragma unroll
        for (int ai = 0; ai < 2; ++ai)
#pragma unroll
            for (int m = 0; m < 4; ++m) {
                const int c0 = u.pn * 256 + wc * 32 + 4 * fq;
                float* rowp = O + (size_t)(u.pm * 256 + ai * 128 + wr * 64 + m * 16 + fr) * 1024;
#pragma unroll
                for (int bj = 0; bj < 2; ++bj)
#pragma unroll
                    for (int n = 0; n < 2; ++n) { const int c = c0 + bj * 128 + n * 16; if (c < ncol) *(f32x4*)(rowp + c) = acc[ai][bj][m][n]; }
            }
    }
};
struct EpiGU {
    static constexpr bool PERM = true;
    bf16_t* H; const float* bias;
    DI void operator()(const f32x4 (&acc)[2][2][4][2], const pg8::Unit& u, int wr, int wc, int fr, int fq) const {
        const int e = u.pn >> 3, ct = u.pn & 7;
        const int j = ct * 128 + wc * 32 + 8 * fq;
        const float* be = bias + (size_t)e * 2048;
        f32x4 bg[2], bu[2];
#pragma unroll
        for (int n = 0; n < 2; ++n) { bg[n] = *(const f32x4*)(be + j + 4 * n); bu[n] = *(const f32x4*)(be + 1024 + j + 4 * n); }
#pragma unroll
        for (int ai = 0; ai < 2; ++ai)
#pragma unroll
            for (int m = 0; m < 4; ++m) {
                float h[8];
#pragma unroll
                for (int n = 0; n < 2; ++n)
#pragma unroll
                    for (int i = 0; i < 4; ++i) {
                        const float gg = fminf(acc[ai][0][m][n][i] + bg[n][i], 7.0f);
                        const float uu = fminf(fmaxf(acc[ai][1][m][n][i] + bu[n][i], -7.0f), 7.0f);
                        const float sg = __builtin_amdgcn_rcpf(1.0f + __builtin_amdgcn_exp2f(-1.702f * LOG2E * gg));
                        h[4 * n + i] = (uu + 1.0f) * (gg * sg);
                    }
                u32x4 w; w.x = cvtpk(h[0], h[1]); w.y = cvtpk(h[2], h[3]); w.z = cvtpk(h[4], h[5]); w.w = cvtpk(h[6], h[7]);
                *(u32x4*)(H + (size_t)(u.pm * 256 + ai * 128 + wr * 64 + m * 16 + fr) * 1024 + j) = w;
            }
    }
};
struct EpiDN {
    static constexpr bool PERM = true;
    bf16_t* Y; const float* bias;
    DI void operator()(const f32x4 (&acc)[2][2][4][2], const pg8::Unit& u, int wr, int wc, int fr, int fq) const {
        const int e = u.pn >> 2, ct = u.pn & 3;
        const float* be = bias + (size_t)e * 1024;
#pragma unroll
        for (int bj = 0; bj < 2; ++bj) {
            const int c = ct * 256 + bj * 128 + wc * 32 + 8 * fq;
            const f32x4 b0 = *(const f32x4*)(be + c), b1 = *(const f32x4*)(be + c + 4);
#pragma unroll
            for (int ai = 0; ai < 2; ++ai)
#pragma unroll
                for (int m = 0; m < 4; ++m) {
                    const f32x4 v0 = acc[ai][bj][m][0] + b0, v1 = acc[ai][bj][m][1] + b1;
                    u32x4 w; w.x = cvtpk(v0[0], v0[1]); w.y = cvtpk(v0[2], v0[3]); w.z = cvtpk(v1[0], v1[1]); w.w = cvtpk(v1[2], v1[3]);
                    *(u32x4*)(Y + (size_t)(u.pm * 256 + ai * 128 + wr * 64 + m * 16 + fr) * 1024 + c) = w;
                }
        }
    }
};
struct Frame {
    LAS unsigned char* lds; unsigned* ctl; unsigned char* ws; int tid, lane, wid; int G, bid;
};
struct MoeOrder {
    const LAS int* tstart; int sh; bool gather; const int* tokof; const LAS int* tokbuf; const LAS int* ulist;
    static DI void build(Frame& F, const LAS int* tstart, int nNt, LAS int* ulist) {
        __syncthreads();
        const int nwg = tstart[32] * nNt;
        if (F.tid == 0) ulist[0] = 0;
        __syncthreads();
        if (F.tid < 24) {
            const long L = (long)F.tid * F.G + F.bid;
            if (L < nwg) {
                int wgid = (int)L; { const int q = nwg / 8, r = nwg % 8, xcd = wgid % 8, off = wgid / 8; wgid = (xcd < r ? xcd * (q + 1) : r * (q + 1) + (xcd - r) * q) + off; }
                int e = 0;
                for (int k = 1; k < 32; ++k) if (tstart[k] * nNt <= wgid) e = k;
                const int rem = wgid - tstart[e] * nNt, nte = tstart[e + 1] - tstart[e];
                const int ct = rem / nte, rt = rem % nte;
                ulist[4 + 4 * F.tid] = tstart[e] + rt; ulist[5 + 4 * F.tid] = e * nNt + ct; ulist[6 + 4 * F.tid] = e; ulist[7 + 4 * F.tid] = rt;
                __hip_atomic_fetch_add(ulist, 1, __ATOMIC_RELAXED, __HIP_MEMORY_SCOPE_WORKGROUP);
            }
        }
        __syncthreads();
    }
    DI bool next(int i, pg8::Unit& u) const {
        if (i >= ulist[0]) return false;
        u.pm = ulist[4 + 4 * i]; u.pn = ulist[5 + 4 * i]; return true;
    }
    DI unsigned a_off(const pg8::Unit& u, int r) const {
        if (!gather) return (unsigned)(u.pm * 256 + r) * 2048u;
        const int e = u.pn >> sh, idx = (u.pm - tstart[e]) * 256 + r;
        const int t = idx < tstart[80 + e] ? tokof[(size_t)e * T + idx] : 0;
        return (unsigned)t * 2048u;
    }
    DI void prefetch(const pg8::Unit& u, int slot, int wid, int lane) const {
        if (gather && wid == 0) {
            const int e = u.pn >> sh, rt = u.pm - tstart[e];
            __builtin_amdgcn_global_load_lds((const unsigned*)(tokof + (size_t)e * T + rt * 256 + vlane() * 4), (LAS unsigned*)((LAS unsigned char*)tokbuf + slot * 1024), 16, 0, 0);
        }
    }
    DI unsigned a_off_pf(const pg8::Unit& u, int r, int slot) const {
        if (!gather) return (unsigned)(u.pm * 256 + r) * 2048u;
        const int e = u.pn >> sh, idx = (u.pm - tstart[e]) * 256 + r;
        const int t = idx < tstart[80 + e] ? tokbuf[slot * 256 + r] : 0;
        return (unsigned)t * 2048u;
    }
    DI void a_ready(const pg8::Unit&) const {}
    DI void done(const pg8::Unit&) const {}
};

DI int crow(int r, int hi) { return (r & 3) + 8 * (r >> 2) + 4 * hi; }
template <int DK, bool FOX, bool ROPEQ>
DI void attn_unit(LAS unsigned char* lds, const bf16_t* Q, int ldq, const bf16_t* Kp, int ldk, const bf16_t* Vt, int ldv,
                  const float* cum, bf16_t* O, int ldo, int q0, int ntiles, bool causal, const int* pos, const int wid, const float* kn2 = nullptr) {
    constexpr int PK = DK * 2 + 16, KBYTES = 64 * PK, VBYTES = 64 * 136, BUF = KBYTES + VBYTES + 256, KCH = DK / 8, NS = DK / 16;
    const int lane = vlane(), tid = wid * 64 + lane, r32 = lane & 31, hi = lane >> 5;
    const int qw0 = q0 + wid * 32, qrow = qw0 + r32;
    bf16x8 qf[NS];
#pragma unroll
    for (int s = 0; s < NS; ++s) qf[s] = *(const bf16x8*)(Q + (size_t)qrow * ldq + 16 * s + 8 * hi);
    if constexpr (ROPEQ) {
        const float p = (float)pos[qrow];
#pragma unroll
        for (int j = 0; j < 8; ++j) {
            const int i = 8 * hi + j;
            const float inv = exp2f(-(float)i * (13.287712379549449f / 16.0f));
            float sn, cs; sincos_cw(p * inv, sn, cs);
            const float x1 = bf2f((unsigned short)qf[4][j]), x2 = bf2f((unsigned short)qf[5][j]);
            const float o1 = x1 * cs - x2 * sn, o2 = x1 * sn + x2 * cs;
            qf[4][j] = (short)(cvtpk(o1, 0.f) & 0xffffu); qf[5][j] = (short)(cvtpk(o2, 0.f) & 0xffffu);
        }
    }
    const float cq = FOX ? cum[qrow] : 0.f;
    int jstart = 0; float prune_c = 0.f;
    if constexpr (FOX) {
        LAS float* red = (LAS float*)(lds + 2 * BUF);
        float ss = 0.f;
#pragma unroll
        for (int s = 0; s < NS; ++s)
#pragma unroll
            for (int j = 0; j < 8; ++j) { const float v = bf2f((unsigned short)qf[s][j]); ss += v * v; }
        ss += __shfl_xor(ss, 32);
        ss = wave_max(ss);
        float kk = 0.f;
        for (int j = tid; j < ntiles; j += NTHREADS) kk = fmaxf(kk, kn2[j]);
        kk = wave_max(kk);
        __syncthreads();
        if (lane == 0) { red[wid] = ss; red[8 + wid] = kk; }
        __syncthreads();
        float qm = red[0], km = red[8];
#pragma unroll
        for (int w = 1; w < 8; ++w) { qm = fmaxf(qm, red[w]); km = fmaxf(km, red[8 + w]); }
        prune_c = 2.0f * sqrtf(qm * km) * 1.01f + 65.0f;
        const float cq0 = cum[q0];
        int cand = ntiles;
        for (int j = tid; j < ntiles; j += NTHREADS) if (cq0 - cum[64 * j + 63] + prune_c >= 0.f) cand = min(cand, j);
#pragma unroll
        for (int o = 1; o < 64; o <<= 1) cand = min(cand, __shfl_xor(cand, o));
        __syncthreads();
        if (lane == 0) ((LAS int*)red)[16 + wid] = cand;
        __syncthreads();
        jstart = ((LAS int*)red)[16];
#pragma unroll
        for (int w = 1; w < 8; ++w) jstart = min(jstart, ((LAS int*)red)[16 + w]);
        jstart = min(jstart, ntiles - 4);
        __syncthreads();
    }
    const float cqw0 = FOX ? __shfl(cq, 0) : 0.f;
    f32x16 o0, o1;
#pragma unroll
    for (int r = 0; r < 16; ++r) { o0[r] = 0.f; o1[r] = 0.f; }
    float mrun = -1e30f, lrun = 0.f;
    const int kr0 = tid / KCH, kc0 = tid % KCH;
    const int kr1 = (tid + 512) / KCH, kc1 = (tid + 512) % KCH;
    const bool k2 = (DK == 96) && (tid < 256);
    const int vd = tid >> 3, vc = tid & 7;
    u32x4 kreg0, kreg1 = (u32x4){0, 0, 0, 0}, vreg; float creg = 0.f;
#define ATT_GLOAD(j) do { \
        kreg0 = *(const u32x4*)(Kp + (size_t)(64 * (j) + kr0) * ldk + kc0 * 8); \
        if (k2) kreg1 = *(const u32x4*)(Kp + (size_t)(64 * (j) + kr1) * ldk + kc1 * 8); \
        vreg = *(const u32x4*)(Vt + (size_t)vd * ldv + 64 * (j) + vc * 8); \
        if (FOX && tid < 64) creg = cum[64 * (j) + tid]; } while (0)
#define ATT_LWRITE(buf) do { LAS unsigned char* bb_ = lds + (buf) * BUF; \
        *(LAS u32x4*)(bb_ + kr0 * PK + kc0 * 16) = kreg0; \
        if (k2) *(LAS u32x4*)(bb_ + kr1 * PK + kc1 * 16) = kreg1; \
        *(LAS u32x2*)(bb_ + KBYTES + vd * 136 + vc * 16) = (u32x2){vreg.x, vreg.y}; \
        *(LAS u32x2*)(bb_ + KBYTES + vd * 136 + vc * 16 + 8) = (u32x2){vreg.z, vreg.w}; \
        if (FOX && tid < 64) *(LAS float*)(bb_ + KBYTES + VBYTES + tid * 4) = creg; } while (0)
    ATT_GLOAD(jstart); ATT_LWRITE(0); __syncthreads();
    for (int j = jstart; j < ntiles; ++j) {
        const int cur = (j - jstart) & 1;
        if (j + 1 < ntiles) ATT_GLOAD(j + 1);
        const LAS unsigned char* kb = lds + cur * BUF; const LAS unsigned char* vb = kb + KBYTES; const LAS unsigned char* cb = vb + VBYTES;
        bool active = !causal || (64 * j <= qw0 + 31);
        if constexpr (FOX) { if (cqw0 - *(const LAS float*)(cb + 63 * 4) + prune_c < 0.f) active = false; }
        if (active) {
            f32x16 sp0, sp1;
#pragma unroll
            for (int r = 0; r < 16; ++r) { sp0[r] = 0.f; sp1[r] = 0.f; }
#pragma unroll
            for (int s = 0; s < NS; ++s) {
                const bf16x8 k0 = *(const LAS bf16x8*)(kb + r32 * PK + 32 * s + 16 * hi);
                const bf16x8 k1 = *(const LAS bf16x8*)(kb + (32 + r32) * PK + 32 * s + 16 * hi);
                sp0 = __builtin_amdgcn_mfma_f32_32x32x16_bf16(k0, qf[s], sp0, 0, 0, 0);
                sp1 = __builtin_amdgcn_mfma_f32_32x32x16_bf16(k1, qf[s], sp1, 0, 0, 0);
            }
            __builtin_amdgcn_sched_barrier(0);
            if constexpr (FOX) {
#pragma unroll
                for (int g = 0; g < 4; ++g) {
                    const f32x4 c0 = *(const LAS f32x4*)(cb + (8 * g + 4 * hi) * 4);
                    const f32x4 c1 = *(const LAS f32x4*)(cb + (32 + 8 * g + 4 * hi) * 4);
#pragma unroll
                    for (int i = 0; i < 4; ++i) { sp0[4 * g + i] += cq - c0[i]; sp1[4 * g + i] += cq - c1[i]; }
                }
            }
            if (causal && (64 * j + 63 > qw0)) {
#pragma unroll
                for (int r = 0; r < 16; ++r) {
                    const int key = 64 * j + crow(r, hi);
                    if (key > qrow) sp0[r] = -1e30f;
                    if (key + 32 > qrow) sp1[r] = -1e30f;
                }
            }
            float mx = fmaxf(sp0[0], sp1[0]);
#pragma unroll
            for (int r = 1; r < 16; ++r) mx = fmaxf(mx, fmaxf(sp0[r], sp1[r]));
            mx = fmaxf(mx, __shfl_xor(mx, 32));
            const float mnew = fmaxf(mrun, mx);
            const float alpha = __builtin_amdgcn_exp2f(mrun - mnew);
            mrun = mnew;
            float ls = 0.f;
#pragma unroll
            for (int r = 0; r < 16; ++r) { sp0[r] = __builtin_amdgcn_exp2f(sp0[r] - mnew); sp1[r] = __builtin_amdgcn_exp2f(sp1[r] - mnew); ls += sp0[r] + sp1[r]; }
            lrun = lrun * alpha + ls;
#pragma unroll
            for (int r = 0; r < 16; ++r) { o0[r] *= alpha; o1[r] *= alpha; }
            __builtin_amdgcn_sched_barrier(0);
#pragma unroll
            for (int ks = 0; ks < 4; ++ks) {
                const int p = ks >> 1, s2 = ks & 1;
                u32x4 pw;
                if (p == 0) { pw.x = cvtpk(sp0[8 * s2 + 0], sp0[8 * s2 + 1]); pw.y = cvtpk(sp0[8 * s2 + 2], sp0[8 * s2 + 3]); pw.z = cvtpk(sp0[8 * s2 + 4], sp0[8 * s2 + 5]); pw.w = cvtpk(sp0[8 * s2 + 6], sp0[8 * s2 + 7]); }
                else        { pw.x = cvtpk(sp1[8 * s2 + 0], sp1[8 * s2 + 1]); pw.y = cvtpk(sp1[8 * s2 + 2], sp1[8 * s2 + 3]); pw.z = cvtpk(sp1[8 * s2 + 4], sp1[8 * s2 + 5]); pw.w = cvtpk(sp1[8 * s2 + 6], sp1[8 * s2 + 7]); }
                const bf16x8 pf = __builtin_bit_cast(bf16x8, pw);
                const int kbase = (32 * p + 16 * s2 + 4 * hi) * 2;
                {
                    const u32x2 lo = *(const LAS u32x2*)(vb + r32 * 136 + kbase), h2 = *(const LAS u32x2*)(vb + r32 * 136 + kbase + 16);
                    const bf16x8 vf = __builtin_bit_cast(bf16x8, (u32x4){lo.x, lo.y, h2.x, h2.y});
                    o0 = __builtin_amdgcn_mfma_f32_32x32x16_bf16(vf, pf, o0, 0, 0, 0);
                }
                {
                    const u32x2 lo = *(const LAS u32x2*)(vb + (32 + r32) * 136 + kbase), h2 = *(const LAS u32x2*)(vb + (32 + r32) * 136 + kbase + 16);
                    const bf16x8 vf = __builtin_bit_cast(bf16x8, (u32x4){lo.x, lo.y, h2.x, h2.y});
                    o1 = __builtin_amdgcn_mfma_f32_32x32x16_bf16(vf, pf, o1, 0, 0, 0);
                }
            }
        }
        if (j + 1 < ntiles) ATT_LWRITE(cur ^ 1);
        __syncthreads();
    }
#undef ATT_GLOAD
#undef ATT_LWRITE
    const float ltot = lrun + __shfl_xor(lrun, 32);
    const float inv = 1.0f / ltot;
#pragma unroll
    for (int g = 0; g < 4; ++g) {
        const int d0 = 8 * g + 4 * hi;
        u32x2 w0, w1;
        w0.x = cvtpk(o0[4 * g] * inv, o0[4 * g + 1] * inv); w0.y = cvtpk(o0[4 * g + 2] * inv, o0[4 * g + 3] * inv);
        w1.x = cvtpk(o1[4 * g] * inv, o1[4 * g + 1] * inv); w1.y = cvtpk(o1[4 * g + 2] * inv, o1[4 * g + 3] * inv);
        *(u32x2*)(O + (size_t)qrow * ldo + d0) = w0;
        *(u32x2*)(O + (size_t)qrow * ldo + 32 + d0) = w1;
    }
}


template <int DK, bool ROPEQ>
DI void attn_unit_pipe(LAS unsigned char* lds, const bf16_t* Q, int ldq, const bf16_t* Kp, int ldk, const bf16_t* Vt, int ldv,
                       bf16_t* O, int ldo, int q0, int ntiles, const int* pos, const int wid) {
    constexpr int PK = DK * 2 + 16, KBYTES = 64 * PK, VBYTES = 64 * 136, KCH = DK / 8, NS = DK / 16, VOFF = 2 * KBYTES;
    constexpr float THR = 6.0f;
    const int lane = vlane(), tid = wid * 64 + lane, r32 = lane & 31, hi = lane >> 5;
    const int qw0 = q0 + wid * 32, qrow = qw0 + r32;
    bf16x8 qf[NS];
#pragma unroll
    for (int s = 0; s < NS; ++s) qf[s] = *(const bf16x8*)(Q + (size_t)qrow * ldq + 16 * s + 8 * hi);
    if constexpr (ROPEQ) {
        const float p = (float)pos[qrow];
#pragma unroll
        for (int j = 0; j < 8; ++j) {
            const int i = 8 * hi + j;
            const float inv = exp2f(-(float)i * (13.287712379549449f / 16.0f));
            float sn, cs; sincos_cw(p * inv, sn, cs);
            const float x1 = bf2f((unsigned short)qf[NS - 2][j]), x2 = bf2f((unsigned short)qf[NS - 1][j]);
            const float o1 = x1 * cs - x2 * sn, o2 = x1 * sn + x2 * cs;
            qf[NS - 2][j] = (short)(cvtpk(o1, 0.f) & 0xffffu); qf[NS - 1][j] = (short)(cvtpk(o2, 0.f) & 0xffffu);
        }
    }
    const int kr0 = tid / KCH, kc0 = tid % KCH;
    const int kr1 = (tid + 512) / KCH, kc1 = (tid + 512) % KCH;
    const bool k2 = (DK == 96) && (tid < 256);
    const int vd = tid >> 3, vc = tid & 7;
    const int kfo = r32 * PK + 16 * hi;
    const int vfo = VOFF + r32 * 136 + 8 * hi;
    u32x4 kA0, kA1 = (u32x4){0, 0, 0, 0}, vA, kB0, kB1 = (u32x4){0, 0, 0, 0}, vB;
#define SBAR() __builtin_amdgcn_sched_barrier(0)
#define AP_LOADK(j, R0, R1) do { R0 = *(const u32x4*)(Kp + (size_t)(64 * (j) + kr0) * ldk + kc0 * 8); \
        if (k2) R1 = *(const u32x4*)(Kp + (size_t)(64 * (j) + kr1) * ldk + kc1 * 8); } while (0)
#define AP_LOADV(j, RV) do { RV = *(const u32x4*)(Vt + (size_t)vd * ldv + 64 * (j) + vc * 8); } while (0)
#define AP_WRITEK(buf, R0, R1) do { LAS unsigned char* bb_ = lds + (buf) * KBYTES; *(LAS u32x4*)(bb_ + kr0 * PK + kc0 * 16) = R0; \
        if (k2) *(LAS u32x4*)(bb_ + kr1 * PK + kc1 * 16) = R1; } while (0)
#define AP_WRITEV(buf, RV) do { LAS unsigned char* bb_ = lds + VOFF + (buf) * VBYTES; \
        *(LAS u32x2*)(bb_ + vd * 136 + vc * 16) = (u32x2){RV.x, RV.y}; *(LAS u32x2*)(bb_ + vd * 136 + vc * 16 + 8) = (u32x2){RV.z, RV.w}; } while (0)
#define AP_KF(dst0, dst1, kbuf, s) do { dst0 = *(const LAS bf16x8*)(lds + (kbuf) * KBYTES + kfo + 32 * (s)); dst1 = *(const LAS bf16x8*)(lds + (kbuf) * KBYTES + kfo + 32 * PK + 32 * (s)); } while (0)
#define AP_VF(dst0, dst1, vbuf, ks) do { const LAS unsigned char* p_ = lds + (vbuf) * VBYTES + vfo + (32 * ((ks) >> 1) + 16 * ((ks) & 1)) * 2; \
        const u32x2 a_ = *(const LAS u32x2*)(p_), b_ = *(const LAS u32x2*)(p_ + 16), c_ = *(const LAS u32x2*)(p_ + 32 * 136), d_ = *(const LAS u32x2*)(p_ + 32 * 136 + 16); \
        dst0 = __builtin_bit_cast(bf16x8, (u32x4){a_.x, a_.y, b_.x, b_.y}); dst1 = __builtin_bit_cast(bf16x8, (u32x4){c_.x, c_.y, d_.x, d_.y}); } while (0)
#define AP_MFMA(a, b, c) __builtin_amdgcn_mfma_f32_32x32x16_bf16(a, b, c, 0, 0, 0)
#define AP_MASK(S0, S1, t) do { _Pragma("unroll") for (int r_ = 0; r_ < 16; ++r_) { const int key_ = 64 * (t) + crow(r_, hi); \
        if (key_ > qrow) S0[r_] = -1e30f; if (key_ + 32 > qrow) S1[r_] = -1e30f; } } while (0)
#define AP_ROWMAX(S0, S1, out) do { float a_ = fmaxf(fmaxf(S0[0], S1[0]), S0[1]), b_ = fmaxf(fmaxf(S1[1], S0[2]), S1[2]); \
        _Pragma("unroll") for (int r_ = 3; r_ < 15; r_ += 2) { a_ = fmaxf(fmaxf(a_, S0[r_]), S1[r_]); b_ = fmaxf(fmaxf(b_, S0[r_ + 1]), S1[r_ + 1]); } \
        a_ = fmaxf(fmaxf(a_, S0[15]), S1[15]); a_ = fmaxf(a_, b_); out = fmaxf(a_, __shfl_xor(a_, 32)); } while (0)
    f32x16 o0, o1, pa0, pa1, sb0, sb1;
#pragma unroll
    for (int r = 0; r < 16; ++r) { o0[r] = 0.f; o1[r] = 0.f; }
    float mref = 0.f, lrun = 0.f;
    bf16x8 pf[4];
    bf16x8 fa0, fa1, fb0, fb1;
    AP_LOADK(0, kA0, kA1); AP_LOADV(0, vA); AP_WRITEK(0, kA0, kA1); AP_WRITEV(0, vA);
    AP_LOADK(1, kA0, kA1); AP_WRITEK(1, kA0, kA1);
    AP_LOADK(2, kA0, kA1); AP_LOADV(1, vA);
    __syncthreads();
#pragma unroll
    for (int r = 0; r < 16; ++r) { pa0[r] = 0.f; pa1[r] = 0.f; }
#pragma unroll
    for (int s = 0; s < NS; ++s) { AP_KF(fa0, fa1, 0, s); pa0 = AP_MFMA(fa0, qf[s], pa0); pa1 = AP_MFMA(fa1, qf[s], pa1); }
    if (ntiles == 4) AP_MASK(pa0, pa1, 0);
    { float mx; AP_ROWMAX(pa0, pa1, mx); mref = mx;
#pragma unroll
      for (int r = 0; r < 16; ++r) { pa0[r] = __builtin_amdgcn_exp2f(pa0[r] - mx); pa1[r] = __builtin_amdgcn_exp2f(pa1[r] - mx); } }
    __syncthreads();
    f32x16 negm;
#pragma unroll
    for (int r = 0; r < 16; ++r) negm[r] = -mref;
    asm volatile("" : "+v"(negm));
#define AP_STEPA(s, X0, X1, Y0, Y1, VALU) do { if ((s) + 1 < NS) AP_KF(Y0, Y1, kb_, (s) + 1); else AP_VF(Y0, Y1, vb_, 0); \
        if ((s) == 0) { sb0 = AP_MFMA(X0, qf[s], negm); sb1 = AP_MFMA(X1, qf[s], negm); } else { sb0 = AP_MFMA(X0, qf[s], sb0); sb1 = AP_MFMA(X1, qf[s], sb1); } VALU; SBAR(); } while (0)
#define AP_PK(i, P, b) pw_[i] = (u32x4){cvtpk(P[b], P[b + 1]), cvtpk(P[b + 2], P[b + 3]), cvtpk(P[b + 4], P[b + 5]), cvtpk(P[b + 6], P[b + 7])}; \
        ls0_ = fadd_s(ls0_, fadd_s(fadd_s(P[b], P[b + 1]), fadd_s(P[b + 2], P[b + 3]))); ls1_ = fadd_s(ls1_, fadd_s(fadd_s(P[b + 4], P[b + 5]), fadd_s(P[b + 6], P[b + 7]))); asm volatile("" : "+v"(pw_[i]), "+v"(ls0_), "+v"(ls1_))
#define AP_EXP4(P, S, b) do { P[b] = __builtin_amdgcn_exp2f(S[b]); P[b + 1] = __builtin_amdgcn_exp2f(S[b + 1]); P[b + 2] = __builtin_amdgcn_exp2f(S[b + 2]); P[b + 3] = __builtin_amdgcn_exp2f(S[b + 3]); asm volatile("" : "+v"(P)); } while (0)
#define AP_STEPB(ks, X0, X1, Y0, Y1, E0, E1) do { if ((ks) + 1 < 4) AP_VF(Y0, Y1, vb_, (ks) + 1); \
        o0 = AP_MFMA(X0, pf[ks], o0); E0; SBAR(); o1 = AP_MFMA(X1, pf[ks], o1); E1; SBAR(); } while (0)
#define AP_ITER(t, MASKED, WK0, WK1, WV, LK0, LK1, LV) do {     \
        const int kb_ = (t) & 1, vb_ = ((t) - 1) & 1; \
        if ((t) + 2 < ntiles) AP_LOADK((t) + 2, LK0, LK1); \
        if ((t) + 1 < ntiles) AP_LOADV((t) + 1, LV); \
        u32x4 pw_[4]; float ls0_ = 0.f, ls1_ = 0.f; \
        AP_KF(fa0, fa1, kb_, 0); SBAR(); \
        AP_STEPA(0, fa0, fa1, fb0, fb1, AP_PK(0, pa0, 0)); \
        AP_STEPA(1, fb0, fb1, fa0, fa1, AP_PK(1, pa0, 8)); \
        AP_STEPA(2, fa0, fa1, fb0, fb1, AP_PK(2, pa1, 0)); \
        AP_STEPA(3, fb0, fb1, fa0, fa1, AP_PK(3, pa1, 8)); \
        if (NS == 6) { AP_STEPA(4, fa0, fa1, fb0, fb1, (void)0); AP_STEPA(5, fb0, fb1, fa0, fa1, (void)0); } \
        lrun += ls0_ + ls1_; \
        pf[0] = __builtin_bit_cast(bf16x8, pw_[0]); pf[1] = __builtin_bit_cast(bf16x8, pw_[1]); pf[2] = __builtin_bit_cast(bf16x8, pw_[2]); pf[3] = __builtin_bit_cast(bf16x8, pw_[3]); \
        if ((t) >= ntiles - 4) AP_MASK(sb0, sb1, t); \
        float mx_; AP_ROWMAX(sb0, sb1, mx_); \
        float resc_ = 1.0f; bool do_resc_ = false; \
        if (__any(mx_ > THR)) { const float dl_ = fmaxf(mx_, 0.f); mref += dl_; \
            _Pragma("unroll") for (int r_ = 0; r_ < 16; ++r_) { sb0[r_] -= dl_; sb1[r_] -= dl_; negm[r_] = -mref; } \
            asm volatile("" : "+v"(negm)); \
            resc_ = __builtin_amdgcn_exp2f(-dl_); lrun *= resc_; do_resc_ = true; } \
        SBAR(); \
        AP_STEPB(0, fa0, fa1, fb0, fb1, AP_EXP4(pa0, sb0, 0), AP_EXP4(pa0, sb0, 4)); \
        AP_STEPB(1, fb0, fb1, fa0, fa1, AP_EXP4(pa0, sb0, 8), AP_EXP4(pa0, sb0, 12)); \
        AP_STEPB(2, fa0, fa1, fb0, fb1, AP_EXP4(pa1, sb1, 0), AP_EXP4(pa1, sb1, 4)); \
        AP_STEPB(3, fb0, fb1, fa0, fa1, AP_EXP4(pa1, sb1, 8), AP_EXP4(pa1, sb1, 12)); \
        if (do_resc_) { asm volatile("" ::: "memory"); _Pragma("unroll") for (int r_ = 0; r_ < 16; ++r_) { o0[r_] *= resc_; o1[r_] *= resc_; } asm volatile("" : "+v"(o0), "+v"(o1)); } \
        if ((t) + 1 < ntiles) AP_WRITEK(((t) + 1) & 1, WK0, WK1); \
        AP_WRITEV((t) & 1, WV); \
        __syncthreads(); } while (0)
    static_assert(NS == 4 || NS == 6, "head dim 64 or 96");
    if (wid >= 4) __builtin_amdgcn_s_setprio(1);
    int t = 1;
    for (; t + 1 < ntiles; t += 2) { AP_ITER(t, 1, kA0, kA1, vA, kB0, kB1, vB); AP_ITER(t + 1, 1, kB0, kB1, vB, kA0, kA1, vA); }
    AP_ITER(t, 1, kA0, kA1, vA, kB0, kB1, vB);
    {
        u32x4 pw_[4]; float ls0_ = 0.f, ls1_ = 0.f;
        AP_PK(0, pa0, 0); AP_PK(1, pa0, 8); AP_PK(2, pa1, 0); AP_PK(3, pa1, 8);
        lrun += ls0_ + ls1_;
        pf[0] = __builtin_bit_cast(bf16x8, pw_[0]); pf[1] = __builtin_bit_cast(bf16x8, pw_[1]); pf[2] = __builtin_bit_cast(bf16x8, pw_[2]); pf[3] = __builtin_bit_cast(bf16x8, pw_[3]);
        const int vb_ = (ntiles - 1) & 1;
#pragma unroll
        for (int ks = 0; ks < 4; ++ks) { AP_VF(fa0, fa1, vb_, ks); o0 = AP_MFMA(fa0, pf[ks], o0); o1 = AP_MFMA(fa1, pf[ks], o1); }
    }
    const float ltot = lrun + __shfl_xor(lrun, 32);
    const float inv = 1.0f / ltot;
#pragma unroll
    for (int g = 0; g < 4; ++g) {
        const int d0 = 8 * g + 4 * hi;
        u32x2 w0, w1;
        w0.x = cvtpk(o0[4 * g] * inv, o0[4 * g + 1] * inv); w0.y = cvtpk(o0[4 * g + 2] * inv, o0[4 * g + 3] * inv);
        w1.x = cvtpk(o1[4 * g] * inv, o1[4 * g + 1] * inv); w1.y = cvtpk(o1[4 * g + 2] * inv, o1[4 * g + 3] * inv);
        *(u32x2*)(O + (size_t)qrow * ldo + d0) = w0;
        *(u32x2*)(O + (size_t)qrow * ldo + 32 + d0) = w1;
    }
    __syncthreads();
#undef SBAR
#undef AP_LOADK
#undef AP_LOADV
#undef AP_WRITEK
#undef AP_WRITEV
#undef AP_KF
#undef AP_VF
#undef AP_MFMA
#undef AP_MASK
#undef AP_ROWMAX
#undef AP_STEPA
#undef AP_PK
#undef AP_EXP4
#undef AP_STEPB
#undef AP_ITER
}

#define XB_TMO      128
#define XB_XCNT(j)  (256  + 64 * (j))
#define XB_XSUB(j)  (1280 + 64 * (j))
#define XB_XGEN(j)  (2304 + 64 * (j))
#define XB_TOP      3328
#define XB_TOPGEN   3392
#define XCD_BAR_WORDS 3456
#define XB_SPIN_CAP (1u << 18)
DI unsigned xb_ld(unsigned* p) { return __hip_atomic_load(p, __ATOMIC_RELAXED, __HIP_MEMORY_SCOPE_AGENT); }
DI unsigned xb_add(unsigned* p, unsigned v) { return __hip_atomic_fetch_add(p, v, __ATOMIC_RELAXED, __HIP_MEMORY_SCOPE_AGENT); }
DI unsigned xb_xcc_id() { return (unsigned)__builtin_amdgcn_s_getreg((3 << 11) | 20) & 0xFu; }
#define XB_SPIN(cond, bar) do { unsigned _sp = 0; while (cond) { __builtin_amdgcn_s_sleep(1); \
    if ((++_sp & 255u) == 0u) { if (xb_ld(&(bar)[XB_TMO])) break; if (_sp > XB_SPIN_CAP) { atomicAdd(&(bar)[XB_TMO], 1u); break; } } } } while (0)
struct XcdBarrier { unsigned* bar; unsigned x; volatile LAS unsigned* st; int wid; };
DI XcdBarrier xcd_barrier_post(unsigned* bar, volatile LAS unsigned* st, int wid) {
    XcdBarrier b; b.bar = bar; b.x = xb_xcc_id(); b.st = st; b.wid = wid;
    if (wid == 0 && vlane() == 0) (void)xb_add(&bar[XB_XCNT(b.x)], 1u);
    return b;
}
DI void xcd_barrier_complete(unsigned* bar, unsigned x, unsigned& nloc, unsigned& nx) {
    const unsigned G = gridDim.x * gridDim.y * gridDim.z;
    unsigned sum, cnt, mine, sp = 0u;
    for (;;) {
        sum = 0u; cnt = 0u; mine = 0u;
#pragma unroll
        for (unsigned j = 0; j < 16; ++j) { const unsigned c = xb_ld(&bar[XB_XCNT(j)]); sum += c; cnt += (c > 0u) ? 1u : 0u; mine = (j == x) ? c : mine; }
        if (sum == G) break;
        __builtin_amdgcn_s_sleep(1);
        if ((++sp & 255u) == 0u) { if (xb_ld(&bar[XB_TMO])) break; if (sp > XB_SPIN_CAP) { atomicAdd(&bar[XB_TMO], 1u); break; } }
    }
    nloc = mine > 0u ? mine : 1u; nx = cnt > 0u ? cnt : 1u;
}
DI void xcd_barrier(const XcdBarrier& b) {
    asm volatile("s_waitcnt vmcnt(0)" ::: "memory");
    __syncthreads();
    if (b.wid == 0 && vlane() == 0) {
        unsigned* bar = b.bar;
        __builtin_amdgcn_s_waitcnt(0);
        unsigned nloc = b.st[0], nx = b.st[1];
        if (nloc == 0u) { xcd_barrier_complete(bar, b.x, nloc, nx); b.st[0] = nloc; b.st[1] = nx; }
        const unsigned old = xb_add(&bar[XB_XSUB(b.x)], 1u);
        const unsigned gen = old / nloc;
        if (old + 1u == (gen + 1u) * nloc) {
            __builtin_amdgcn_fence(__ATOMIC_RELEASE, "agent");
            asm volatile("s_waitcnt vmcnt(0)" ::: "memory");
            const unsigned og = xb_add(&bar[XB_TOP], 1u);
            const unsigned tg = og / nx;
            if (og + 1u == (tg + 1u) * nx) xb_add(&bar[XB_TOPGEN], 1u);
            else XB_SPIN(xb_ld(&bar[XB_TOPGEN]) == tg, bar);
            __builtin_amdgcn_fence(__ATOMIC_ACQUIRE, "agent");
            xb_add(&bar[XB_XGEN(b.x)], 1u);
            asm volatile("s_waitcnt vmcnt(0)" ::: "memory");
        } else {
            XB_SPIN(xb_ld(&bar[XB_XGEN(b.x)]) == gen, bar);
            __builtin_amdgcn_fence(__ATOMIC_ACQUIRE, "agent");
            asm volatile("s_waitcnt vmcnt(0)" ::: "memory");
        }
    }
    __syncthreads();
}

DI int next_unit(Frame& F, int widx) {
    LAS int* s = (LAS int*)(F.lds + LDS_CTL);
    __syncthreads();
    if (F.tid == 0) *s = (int)atomicAdd(F.ctl + CW_WORK + 64 * widx, 1u);
    __syncthreads();
    return *s;
}

DI void transpose_item(const float* W, int ldw, int srccol, int K, bf16_t* WT, int drow, LAS unsigned* scr, int k0, int lane, int nvalid) {
    const int n4 = lane & 15, kq = lane >> 4;
#pragma unroll 8
    for (int i = 0; i < 16; ++i) {
        const int kk = 4 * i + kq;
        f32x4 v = (f32x4){0.f, 0.f, 0.f, 0.f};
        if (4 * n4 < nvalid) v = *(const f32x4*)(W + (size_t)(k0 + kk) * ldw + srccol + 4 * n4);
        scr[kk * 33 + 2 * n4] = cvtpk(v[0], v[1]); scr[kk * 33 + 2 * n4 + 1] = cvtpk(v[2], v[3]);
    }
    LDS_WAIT(); asm volatile("" ::: "memory");
    const int c = lane & 7;
    const LAS unsigned short* s16 = (const LAS unsigned short*)scr;
#pragma unroll
    for (int j = 0; j < 8; ++j) {
        const int n = (lane >> 3) + 8 * j;
        const LAS unsigned short* sp = s16 + (8 * c) * 66 + n;
        u32x4 o;
        o.x = (unsigned)sp[0 * 66] | ((unsigned)sp[1 * 66] << 16); o.y = (unsigned)sp[2 * 66] | ((unsigned)sp[3 * 66] << 16);
        o.z = (unsigned)sp[4 * 66] | ((unsigned)sp[5 * 66] << 16); o.w = (unsigned)sp[6 * 66] | ((unsigned)sp[7 * 66] << 16);
        if (n < nvalid) *(u32x4*)(WT + (size_t)(drow + n) * K + k0 + 8 * c) = o;
    }
    LDS_WAIT(); asm volatile("" ::: "memory");
}
constexpr int CONV_P1 = 5, CONV_A0 = 5, CONV_GU = 7, CONV_DN = 4, CONV_A1 = 12;
constexpr int MOE_I_GU = 16 * 32, MOE_I_DN = 16 * 16, MOE_ITEMS_PER_LAYER = 32 * (MOE_I_GU + MOE_I_DN);
DI void moe_convert_item(unsigned char* ws, LAS unsigned* scr, int r, int lane) {
    const int l = r / MOE_ITEMS_PER_LAYER; r -= l * MOE_ITEMS_PER_LAYER;
    if (r < 32 * MOE_I_GU) {
        const int e = l * 32 + r / MOE_I_GU, q = r % MOE_I_GU, kb = q / 32, nb = q % 32;
        const int jj = (nb & 15) * 64, drow = (jj >> 7) * 256 + (nb >> 4) * 128 + (jj & 127);
        transpose_item(KP->moe_w_gu + (size_t)e * 1024 * 2048, 2048, 64 * nb, 1024, (bf16_t*)(ws + WS_W_GU) + (size_t)e * 2048 * 1024, drow, scr, 64 * kb, lane, 64);
    } else {
        r -= 32 * MOE_I_GU;
        const int e = l * 32 + r / MOE_I_DN, q = r % MOE_I_DN, kb = q / 16, nb = q % 16;
        transpose_item(KP->moe_w_dn + (size_t)e * 1024 * 1024, 1024, 64 * nb, 1024, (bf16_t*)(ws + WS_W_DN) + (size_t)e * 1024 * 1024, 64 * nb, scr, 64 * kb, lane, 64);
    }
}
constexpr int CW_CONVQ = CW_WORK + 64 * 8;
DI bool conv_pull(Frame& F, int l, int nchunks) {
    constexpr int NCHUNK = MOE_ITEMS_PER_LAYER / 8;
    LAS int* s = (LAS int*)(F.lds + LDS_CTL + 8);
    __syncthreads();
    if (F.tid == 0) *s = (int)atomicAdd(F.ctl + CW_CONVQ + 64 * l, (unsigned)nchunks);
    __syncthreads();
    const int base = *s;
    LAS unsigned* scr = (LAS unsigned*)(F.lds + F.wid * 8448);
    for (int c = base; c < base + nchunks && c < NCHUNK; ++c) moe_convert_item(F.ws, scr, l * MOE_ITEMS_PER_LAYER + c * 8 + F.wid, F.lane);
    __syncthreads();
    return base + nchunks < NCHUNK;
}
struct TrMat { const float* W; int ldw, col0, K, N; bf16_t* WT; int drow0, mode; };

DI void phase_prologue(Frame& F, const Params& P) {
    F.lane = vlane(); F.tid = F.wid * 64 + F.lane;
    LAS unsigned* scr = (LAS unsigned*)(F.lds + F.wid * 8448);
    const int gw = F.bid * 8 + F.wid, NGW = F.G * 8;
    unsigned char* ws = F.ws;
    TrMat mats[11];
    mats[0] = TrMat{KP->a_w_in, FOX_IN, 0, 1024, 1536, (bf16_t*)(ws + WS_W_AIN), 0, 0};
    mats[1] = TrMat{KP->a_w_in, FOX_IN, 2316, 1024, 256, (bf16_t*)(ws + WS_W_AIN), 1536, 0};
    mats[2] = TrMat{KP->a_w_in, FOX_IN, 1536, 1024, 768, (bf16_t*)(ws + WS_W_AIN), 1792, 0};
    mats[3] = TrMat{KP->a_w_out, 1024, 0, 1024, 1024, (bf16_t*)(ws + WS_W_AOUT), 0, 0};
    mats[4] = TrMat{KP->kv_w_dkv, 288, 0, 1024, 288, (bf16_t*)(ws + WS_W_BIN), 0, 0};
    mats[5] = TrMat{KP->b_w_in, 640, 0, 1024, 640, (bf16_t*)(ws + WS_W_BIN), 288, 0};
    mats[6] = TrMat{KP->b_w_uq, 1152, 0, 384, 1152, (bf16_t*)(ws + WS_W_UQ), 0, 0};
    mats[7] = TrMat{KP->kv_w_ukv, 1536, 0, 256, 1536, (bf16_t*)(ws + WS_W_UKV), 0, 1};
    mats[8] = TrMat{KP->b_w_out, 1024, 0, 1024, 1024, (bf16_t*)(ws + WS_W_BOUT), 0, 0};
    mats[9] = TrMat{KP->mem_w_kv, 512, 0, 1024, 512, (bf16_t*)(ws + WS_W_MKV), 0, 0};
    mats[10] = TrMat{KP->mem_w_kv + (size_t)1024 * 512, 512, 0, 1024, 512, (bf16_t*)(ws + WS_W_MKV) + (size_t)512 * 1024, 0, 0};
    int nsmall = 0;
#pragma unroll
    for (int i = 0; i < 11; ++i) nsmall += (mats[i].K / 64) * ((mats[i].N + 63) / 64);
    const int ntot = nsmall;
    for (int it = gw; it < ntot; it += NGW) {
        int r = it;
        if (r < nsmall) {
#pragma unroll
            for (int i = 0; i < 11; ++i) {
                const int nblk = (mats[i].N + 63) / 64, ni = (mats[i].K / 64) * nblk;
                if (r >= 0 && r < ni) {
                    const int kb = r / nblk, nb = r % nblk;
                    const int drow = mats[i].mode == 1 ? ((nb & 1) * 768 + (nb >> 1) * 64) : (mats[i].drow0 + 64 * nb);
                    transpose_item(mats[i].W, mats[i].ldw, mats[i].col0 + 64 * nb, mats[i].K, mats[i].WT, drow, scr, 64 * kb, F.lane, mats[i].N - 64 * nb);
                }
                r -= ni;
            }
            continue;
        }
    }
    __syncthreads();
    LAS float* wf = (LAS float*)F.lds;
    for (int i = F.tid; i < 1024 * 12; i += NTHREADS) { const int k = i / 12, h = i % 12; wf[i] = KP->a_w_in[(size_t)k * FOX_IN + 2304 + h]; }
    __syncthreads();
    float* logf = (float*)(ws + WS_LOGF);
    bf16_t* xb = (bf16_t*)(ws + WS_XB);
    for (int row = gw; row < T; row += NGW) {
        const f32x4* xr = (const f32x4*)(KP->x + (size_t)row * DM) + F.lane;
        f32x4 v[4];
#pragma unroll
        for (int j = 0; j < 4; ++j) v[j] = xr[64 * j];
        u32x2* o8 = (u32x2*)(xb + (size_t)row * DM) + F.lane;
#pragma unroll
        for (int j = 0; j < 4; ++j) o8[64 * j] = (u32x2){cvtpk(v[j][0], v[j][1]), cvtpk(v[j][2], v[j][3])};
        float part[12];
#pragma unroll
        for (int h = 0; h < 12; ++h) part[h] = 0.f;
#pragma unroll
        for (int j = 0; j < 4; ++j)
#pragma unroll
            for (int i = 0; i < 4; ++i) {
                const int k = 4 * F.lane + 256 * j + i;
                const LAS f32x4* wp = (const LAS f32x4*)(wf + k * 12);
                const f32x4 w0 = wp[0], w1 = wp[1], w2 = wp[2];
                const float xv = v[j][i];
                part[0] += xv * w0[0]; part[1] += xv * w0[1]; part[2] += xv * w0[2]; part[3] += xv * w0[3];
                part[4] += xv * w1[0]; part[5] += xv * w1[1]; part[6] += xv * w1[2]; part[7] += xv * w1[3];
                part[8] += xv * w2[0]; part[9] += xv * w2[1]; part[10] += xv * w2[2]; part[11] += xv * w2[3];
            }
        float mine = 0.f;
#pragma unroll
        for (int h = 0; h < 12; ++h) { const float s = wave_sum(part[h]); if (F.lane == h) mine = s; }
        if (F.lane < 12) {
            const float z = mine + KP->a_b_f[F.lane];
            const float ls = fminf(z, 0.f) - log1pf(expf(-fabsf(z)));
            const int b = row / SEQ, s = row % SEQ;
            logf[(size_t)(b * NH + F.lane) * SEQ + s] = ls;
        }
    }
    {
        float* wrt = (float*)(ws + WS_WRT);
        bf16_t* wrh = (bf16_t*)(ws + WS_WRH); bf16_t* wrl = (bf16_t*)(ws + WS_WRL);
        for (int i = F.bid * NTHREADS + F.tid; i < 2 * 1024 * 32; i += F.G * NTHREADS) { const int l = i >> 15, k = (i >> 5) & 1023, e = i & 31; const float w = KP->moe_w_r[i];
            const unsigned hb = cvtpk(w, 0.f) & 0xffffu; const float hf = __uint_as_float(hb << 16);
            wrt[(size_t)(l * 32 + e) * 1024 + k] = w; wrh[(size_t)(l * 32 + e) * 1024 + k] = (bf16_t)hb; wrl[(size_t)(l * 32 + e) * 1024 + k] = (bf16_t)(cvtpk(w - hf, 0.f) & 0xffffu); }
    }
    bf16_t* memb = (bf16_t*)(ws + WS_MEMB);
    for (int row = gw; row < NB * NMEM; row += NGW) {
        const f32x4* xr = (const f32x4*)(KP->mem + (size_t)row * DM) + F.lane;
        u32x2* o8 = (u32x2*)(memb + (size_t)row * DM) + F.lane;
#pragma unroll
        for (int j = 0; j < 4; ++j) { const f32x4 v = xr[64 * j]; o8[64 * j] = (u32x2){cvtpk(v[0], v[1]), cvtpk(v[2], v[3])}; }
    }
}

DI void scan_unit(Frame& F, int bh) {
    const float* src = (const float*)(F.ws + WS_LOGF) + (size_t)bh * SEQ;
    float* dst = (float*)(F.ws + WS_CUM) + (size_t)bh * SEQ;
    LAS float* wtot = (LAS float*)F.lds;
    float v[16];
#pragma unroll
    for (int j = 0; j < 4; ++j) { const f32x4 t = *(const f32x4*)(src + F.tid * 16 + 4 * j); v[4 * j] = t[0]; v[4 * j + 1] = t[1]; v[4 * j + 2] = t[2]; v[4 * j + 3] = t[3]; }
#pragma unroll
    for (int i = 1; i < 16; ++i) v[i] += v[i - 1];
    float tot = v[15];
    float inc = tot;
#pragma unroll
    for (int o = 1; o < 64; o <<= 1) { const float t = __shfl_up(inc, o); if (F.lane >= o) inc += t; }
    __syncthreads();
    if (F.lane == 63) wtot[F.wid] = inc;
    __syncthreads();
    float base = inc - tot;
    for (int w = 0; w < F.wid; ++w) base += wtot[w];
#pragma unroll
    for (int j = 0; j < 4; ++j) {
        f32x4 t; t[0] = (base + v[4 * j]) * LOG2E; t[1] = (base + v[4 * j + 1]) * LOG2E; t[2] = (base + v[4 * j + 2]) * LOG2E; t[3] = (base + v[4 * j + 3]) * LOG2E;
        *(f32x4*)(dst + F.tid * 16 + 4 * j) = t;
    }
    __syncthreads();
}

struct RouteQKM { unsigned char* ws; DI Dst operator()(const pg8::Unit& u) const {
    if (u.pn < 3) return Dst{(bf16_t*)(ws + WS_Q), 768, u.pm * 256, u.pn * 256, 256, 0.125f * LOG2E, false};
    if (u.pn < 6) return Dst{(bf16_t*)(ws + WS_K), 768, u.pm * 256, (u.pn - 3) * 256, 256, 1.0f, false};
    return Dst{(bf16_t*)(ws + WS_MQ), 256, u.pm * 256, 0, 256, 0.125f * LOG2E, false}; } };
struct RouteVT { unsigned char* ws; DI Dst operator()(const pg8::Unit& u) const {
    const int b = u.pn >> 5; return Dst{(bf16_t*)(ws + WS_VT) + (size_t)b * 768 * SEQ, SEQ, u.pm * 256, (u.pn & 31) * 256, 256, 1.0f, false}; } };
struct RoutePlain { bf16_t* O; int ldo; DI Dst operator()(const pg8::Unit& u) const { return Dst{O, ldo, u.pm * 256, u.pn * 256, 256, 1.0f, false}; } };
DI void phase_proj0(Frame& F, const Params& P) {
    F.lane = vlane(); F.tid = F.wid * 64 + F.lane;
    unsigned char* ws = F.ws;
    const bf16_t* xb = (const bf16_t*)(ws + WS_XB);
    const bf16_t* win = (const bf16_t*)(ws + WS_W_AIN);
    const bf16_t* memb = (const bf16_t*)(ws + WS_MEMB);
    {
        pg8::Gemm g{xb, win, 1024}; pg8::StaticOrder S; S.init(T, 1792, 1024, F.G, F.bid);
        EpiBf16R<RouteQKM> E{RouteQKM{ws}};
        pg8::gemm_phase<EpiBf16R<RouteQKM>, pg8::StaticOrder, true>(F.lds, g, S, E, F.wid);
    }
    {
        pg8::Gemm g{win + (size_t)1792 * 1024, xb, 1024}; pg8::StaticOrder S; S.init(768, T, 1024, F.G, (F.bid + 64) % F.G);
        EpiBf16R<RouteVT> E{RouteVT{ws}};
        pg8::gemm_phase<EpiBf16R<RouteVT>, pg8::StaticOrder, true>(F.lds, g, S, E, F.wid);
    }
    for (int l = 0; l < 2; ++l) {
        const bf16_t* wk = (const bf16_t*)(ws + WS_W_MKV) + (size_t)l * 512 * 1024;
        {
            pg8::Gemm g{memb, wk, 1024}; pg8::StaticOrder S; S.init(512, 256, 1024, F.G, (F.bid + F.G - (152 + 4 * l)) % F.G);
            EpiBf16R<RoutePlain> E{RoutePlain{(bf16_t*)(ws + WS_MK) + (size_t)l * 512 * 256, 256}};
            pg8::gemm_phase<EpiBf16R<RoutePlain>, pg8::StaticOrder, true>(F.lds, g, S, E, F.wid);
        }
        for (int b = 0; b < 2; ++b) {
            pg8::Gemm g{wk + (size_t)256 * 1024, memb + (size_t)b * 256 * 1024, 1024}; pg8::StaticOrder S; S.init(256, 256, 1024, F.G, (F.bid + F.G - (154 + 4 * l + b)) % F.G);
            EpiBf16R<RoutePlain> E{RoutePlain{(bf16_t*)(ws + WS_MVT) + (size_t)(l * 2 + b) * 256 * 256, 256}};
            pg8::gemm_phase<EpiBf16R<RoutePlain>, pg8::StaticOrder, true>(F.lds, g, S, E, F.wid);
        }
    }
    if (F.G == 256 && F.bid >= 128) conv_pull(F, 0, CONV_P1);
}


DI void phase_scan_knorm(Frame& F) {
    F.lane = vlane(); F.tid = F.wid * 64 + F.lane;
    unsigned char* ws = F.ws;
    if (F.bid < 24) scan_unit(F, F.bid);
    const bf16_t* K = (const bf16_t*)(ws + WS_K);
    float* kn2 = (float*)(ws + WS_KN2);
    const int gw = F.bid * 8 + F.wid, NGW = F.G * 8;
    for (int it = gw; it < 24 * 128; it += NGW) {
        const int bh = it >> 7, j = it & 127, b = bh / 12, h = bh % 12;
        const u32x4* kr = (const u32x4*)(K + (size_t)(b * SEQ + 64 * j + F.lane) * 768 + h * 64);
        float ss = 0.f;
#pragma unroll
        for (int c = 0; c < 8; ++c) {
            const u32x4 w = kr[c];
            const unsigned ww[4] = {w.x, w.y, w.z, w.w};
#pragma unroll
            for (int i = 0; i < 4; ++i) { const float a = __uint_as_float(ww[i] << 16), bb = __uint_as_float(ww[i] & 0xffff0000u); ss += a * a + bb * bb; }
        }
        ss = wave_max(ss);
        if (F.lane == 0) kn2[it] = ss;
    }
}

DI void mem_attn_unit(Frame& F, int l, int v) {
    unsigned char* ws = F.ws;
    const int qb = v >> 3, bm = v & 7, b = bm >> 2, mh = bm & 3;
    const bf16_t* Q = (const bf16_t*)(ws + WS_MQ) + (size_t)b * SEQ * 256 + mh * 64;
    const bf16_t* K = (const bf16_t*)(ws + WS_MK) + (size_t)l * 512 * 256 + (size_t)b * 256 * 256 + mh * 64;
    const bf16_t* Vt = (const bf16_t*)(ws + WS_MVT) + (size_t)(l * 2 + b) * 256 * 256 + (size_t)mh * 64 * 256;
    bf16_t* O = (bf16_t*)(ws + WS_MERGED) + (size_t)b * SEQ * 1024 + 768 + mh * 64;
    attn_unit<64, false, false>(F.lds, Q, 256, K, 256, Vt, 256, nullptr, O, 1024, qb * 256, 4, false, nullptr, F.wid);
}
DI void phase_attn0(Frame& F, const Params& P) {
    F.lane = vlane(); F.tid = F.wid * 64 + F.lane;
    unsigned char* ws = F.ws;
    constexpr int NU = 768 + 256 + 512;
    for (;;) {
        const int uu = next_unit(F, 0);
        if (uu >= NU) break;
        if (uu % 3 == 2) { conv_pull(F, 0, CONV_A0); continue; }
        const int u = 2 * (uu / 3) + uu % 3;
        if (u < 768) {
            const int qb = 31 - u / 24, bh = u % 24, b = bh / 12, h = bh % 12;
            const bf16_t* Q = (const bf16_t*)(ws + WS_Q) + (size_t)b * SEQ * 768 + h * 64;
            const bf16_t* K = (const bf16_t*)(ws + WS_K) + (size_t)b * SEQ * 768 + h * 64;
            const bf16_t* Vt = (const bf16_t*)(ws + WS_VT) + (size_t)(b * 768 + h * 64) * SEQ;
            const float* cum = (const float*)(ws + WS_CUM) + (size_t)bh * SEQ;
            bf16_t* O = (bf16_t*)(ws + WS_MERGED) + (size_t)b * SEQ * 1024 + h * 64;
            attn_unit<64, true, false>(F.lds, Q, 768, K, 768, Vt, SEQ, cum, O, 1024, qb * 256, 4 * (qb + 1), true, nullptr, F.wid, (const float*)(ws + WS_KN2) + bh * 128);
        } else mem_attn_unit(F, 0, u - 768);
    }
    while (conv_pull(F, 0, 16)) {}
}
DI void phase_attn1(Frame& F, const Params& P) {
    F.lane = vlane(); F.tid = F.wid * 64 + F.lane;
    unsigned char* ws = F.ws;
    constexpr int NCONV = 256, NU = 768 + 256 + NCONV;
    for (;;) {
        const int uu = next_unit(F, 1);
        if (uu >= NU) break;
        if (uu % 5 == 4) { conv_pull(F, 1, CONV_A1); continue; }
        const int u = 4 * (uu / 5) + uu % 5;
        if (u < 768) {
            const int qb = 31 - u / 24, bh = u % 24, b = bh / 12, h = bh % 12;
            const bf16_t* Q = (const bf16_t*)(ws + WS_Q) + (size_t)b * SEQ * 1152 + h * 96;
            const bf16_t* K = (const bf16_t*)(ws + WS_K) + (size_t)b * SEQ * 1152 + h * 96;
            const bf16_t* Vt = (const bf16_t*)(ws + WS_VT) + (size_t)(b * 768 + h * 64) * SEQ;
            bf16_t* O = (bf16_t*)(ws + WS_MERGED) + (size_t)b * SEQ * 1024 + h * 64;
            attn_unit_pipe<96, true>(F.lds, Q, 1152, K, 1152, Vt, SEQ, O, 1024, qb * 256, 4 * (qb + 1), KP->pos + (size_t)b * SEQ, F.wid);
        } else mem_attn_unit(F, 1, u - 768);
    }
    while (conv_pull(F, 1, 16)) {}
}

DI void phase_outproj(Frame& F, const float* X, const bf16_t* Wt) {
    F.lane = vlane(); F.tid = F.wid * 64 + F.lane;
    unsigned char* ws = F.ws;
    pg8::Gemm g{(const bf16_t*)(ws + WS_MERGED), Wt, 1024}; pg8::StaticOrder S; S.init(T, 1024, 1024, F.G, F.bid);
    EpiResF32 E{(float*)(ws + WS_Y), X};
    pg8::gemm_phase<EpiResF32, pg8::StaticOrder, false>(F.lds, g, S, E, F.wid);
}


DI void phase_ln_router(Frame& F, const Params& P, int l) {
    F.lane = vlane(); F.tid = F.wid * 64 + F.lane;
    unsigned char* ws = F.ws;
    LAS unsigned char* wH = F.lds;
    LAS unsigned char* wL = F.lds + 65536;
    LAS int* pairs = (LAS int*)(F.lds + LDS_CTL + 1024);
    LAS int* lcnt = (LAS int*)(F.lds + LDS_CTL + 3072); LAS int* gbase = lcnt + 32;
    LAS float* lg = (LAS float*)(F.lds + LDS_R1X + F.wid * 1280);
    LAS int* rec = (LAS int*)(F.lds + LDS_R1X + F.wid * 1280 + 1024);
    LAS float* stt = (LAS float*)(F.lds + LDS_R1X + 8 * 1280 + F.wid * 64);
    __syncthreads();
    {
        const u32x4* srcH = (const u32x4*)((const bf16_t*)(ws + WS_WRH) + (size_t)l * 32 * 1024);
        const u32x4* srcL = (const u32x4*)((const bf16_t*)(ws + WS_WRL) + (size_t)l * 32 * 1024);
        for (int i = F.tid; i < 32 * 128; i += NTHREADS) { const int e = i >> 7, c = i & 127; const int off = e * 2048 + ((c ^ (e & 7)) << 4);
            *(LAS u32x4*)(wH + off) = srcH[i]; *(LAS u32x4*)(wL + off) = srcL[i]; }
    }
    if (F.tid < 32) lcnt[F.tid] = 0;
    __syncthreads();
    const float* g = KP->ln_g + (size_t)(l * 2 + 0) * DM; const float* bt = KP->ln_b + (size_t)(l * 2 + 0) * DM;
    const float* br = KP->moe_b_r + l * 32;
    const float* Y = (const float*)(ws + WS_Y);
    bf16_t* X1B = (bf16_t*)(ws + WS_X1B);
    int* PE = (int*)(ws + WS_PE); int* PPOS = (int*)(ws + WS_PPOS); float* GATE = (float*)(ws + WS_GATE); int* TOKOF = (int*)(ws + WS_TOKOF);
    unsigned* cnt = F.ctl + CW_CNT + l * 32 * 64;
    const int gw = F.bid * 8 + F.wid, NGW = F.G * 8;
    int it = 0;
    f32x4 vnx[4];
    if (gw < T) {
#pragma unroll
        for (int j = 0; j < 4; ++j) vnx[j] = *((const f32x4*)(Y + (size_t)gw * DM) + F.lane + 64 * j);
    }
    for (int row = gw; row < T; row += NGW, ++it) {
        f32x4 v[4]; float s = 0.f;
#pragma unroll
        for (int j = 0; j < 4; ++j) { v[j] = vnx[j]; s += (v[j][0] + v[j][1]) + (v[j][2] + v[j][3]); }
        if (row + NGW < T) {
#pragma unroll
            for (int j = 0; j < 4; ++j) vnx[j] = *((const f32x4*)(Y + (size_t)(row + NGW) * DM) + F.lane + 64 * j);
        }
        const float mean = wave_sum(s) * (1.f / DM); float s2 = 0.f;
#pragma unroll
        for (int j = 0; j < 4; ++j) { v[j] = v[j] - mean; s2 += (v[j][0] * v[j][0] + v[j][1] * v[j][1]) + (v[j][2] * v[j][2] + v[j][3] * v[j][3]); }
        const float rstd = 1.0f / sqrtf(wave_sum(s2) * (1.f / DM) + LN_EPS);
#pragma unroll
        for (int j = 0; j < 4; ++j) {
            const f32x4 gg = *((const f32x4*)g + F.lane + 64 * j), bb = *((const f32x4*)bt + F.lane + 64 * j);
            v[j] = v[j] * rstd * gg + bb;
            *((u32x2*)(X1B + (size_t)row * DM) + F.lane + 64 * j) = (u32x2){cvtpk(v[j][0], v[j][1]), cvtpk(v[j][2], v[j][3])};
        }
        if (F.lane == 0) { stt[2 * (it & 7)] = mean; stt[2 * (it & 7) + 1] = rstd; }
    }
    asm volatile("s_waitcnt lgkmcnt(0)" ::: "memory");
    {
        const int r16 = F.lane & 15, kg = F.lane >> 4;
        const int arow = gw + NGW * (r16 & 7);
        const float mean = stt[2 * (r16 & 7)], rstd = stt[2 * (r16 & 7) + 1];
        const float* yr = Y + (size_t)(arow < T ? arow : gw) * DM + 8 * kg;
        const float* gp = g + 8 * kg; const float* bp = bt + 8 * kg;
        f32x4 acc0 = (f32x4){0.f, 0.f, 0.f, 0.f}, acc1 = (f32x4){0.f, 0.f, 0.f, 0.f};
        const int e0 = r16, e1 = 16 + r16;
        const int b0off = e0 * 2048, b1off = e1 * 2048, sw = r16 & 7;
#pragma unroll 4
        for (int s2 = 0; s2 < 32; ++s2) {
            const f32x4 y0 = *(const f32x4*)(yr + 32 * s2), y1 = *(const f32x4*)(yr + 32 * s2 + 4);
            const f32x4 g0 = *(const f32x4*)(gp + 32 * s2), g1 = *(const f32x4*)(gp + 32 * s2 + 4);
            const f32x4 c0 = *(const f32x4*)(bp + 32 * s2), c1 = *(const f32x4*)(bp + 32 * s2 + 4);
            const f32x4 x0 = (y0 - mean) * rstd * g0 + c0, x1 = (y1 - mean) * rstd * g1 + c1;
            u32x4 ah, al;
            ah.x = cvtpk(x0[0], x0[1]); ah.y = cvtpk(x0[2], x0[3]); ah.z = cvtpk(x1[0], x1[1]); ah.w = cvtpk(x1[2], x1[3]);
            al.x = cvtpk(x0[0] - __uint_as_float(ah.x << 16), x0[1] - __uint_as_float(ah.x & 0xffff0000u)); al.y = cvtpk(x0[2] - __uint_as_float(ah.y << 16), x0[3] - __uint_as_float(ah.y & 0xffff0000u));
            al.z = cvtpk(x1[0] - __uint_as_float(ah.z << 16), x1[1] - __uint_as_float(ah.z & 0xffff0000u)); al.w = cvtpk(x1[2] - __uint_as_float(ah.w << 16), x1[3] - __uint_as_float(ah.w & 0xffff0000u));
            const bf16x8 Ah = __builtin_bit_cast(bf16x8, ah), Al = __builtin_bit_cast(bf16x8, al);
            const int co = (((4 * s2 + kg) ^ sw) << 4);
            const bf16x8 Bh0 = *(const LAS bf16x8*)(wH + b0off + co), Bl0 = *(const LAS bf16x8*)(wL + b0off + co);
            const bf16x8 Bh1 = *(const LAS bf16x8*)(wH + b1off + co), Bl1 = *(const LAS bf16x8*)(wL + b1off + co);
            acc0 = __builtin_amdgcn_mfma_f32_16x16x32_bf16(Ah, Bh0, acc0, 0, 0, 0); acc0 = __builtin_amdgcn_mfma_f32_16x16x32_bf16(Al, Bh0, acc0, 0, 0, 0); acc0 = __builtin_amdgcn_mfma_f32_16x16x32_bf16(Ah, Bl0, acc0, 0, 0, 0);
            acc1 = __builtin_amdgcn_mfma_f32_16x16x32_bf16(Ah, Bh1, acc1, 0, 0, 0); acc1 = __builtin_amdgcn_mfma_f32_16x16x32_bf16(Al, Bh1, acc1, 0, 0, 0); acc1 = __builtin_amdgcn_mfma_f32_16x16x32_bf16(Ah, Bl1, acc1, 0, 0, 0);
        }
        if (kg < 2) {
            const float bb0 = br[e0], bb1 = br[e1];
#pragma unroll
            for (int r = 0; r < 4; ++r) { lg[(4 * kg + r) * 32 + e0] = acc0[r] + bb0; lg[(4 * kg + r) * 32 + e1] = acc1[r] + bb1; }
        }
        asm volatile("s_waitcnt lgkmcnt(0)" ::: "memory");
        const int rr = F.lane >> 3, sub = F.lane & 7;
        f32x4 vv[8];
#pragma unroll
        for (int q = 0; q < 8; ++q) vv[q] = *(const LAS f32x4*)(lg + rr * 32 + 4 * q);
        const f32x4 mine = *(const LAS f32x4*)(lg + rr * 32 + 4 * sub);
        int rk[4] = {0, 0, 0, 0};
#pragma unroll
        for (int q = 0; q < 8; ++q)
#pragma unroll
            for (int i = 0; i < 4; ++i) {
                const float ve = vv[q][i]; const int ee = 4 * q + i;
#pragma unroll
                for (int c = 0; c < 4; ++c) rk[c] += (ve > mine[c] || (ve == mine[c] && ee < 4 * sub + c)) ? 1 : 0;
            }
#pragma unroll
        for (int c = 0; c < 4; ++c) if (rk[c] < 4) { rec[(rr * 4 + rk[c]) * 2] = 4 * sub + c; rec[(rr * 4 + rk[c]) * 2 + 1] = (int)__float_as_uint(mine[c]); }
        asm volatile("s_waitcnt lgkmcnt(0)" ::: "memory");
        const int te0 = rec[(rr * 4 + 0) * 2], te1 = rec[(rr * 4 + 1) * 2], te2 = rec[(rr * 4 + 2) * 2], te3 = rec[(rr * 4 + 3) * 2];
        const float tv0 = __uint_as_float((unsigned)rec[(rr * 4 + 0) * 2 + 1]), tv1 = __uint_as_float((unsigned)rec[(rr * 4 + 1) * 2 + 1]);
        const float tv2 = __uint_as_float((unsigned)rec[(rr * 4 + 2) * 2 + 1]), tv3 = __uint_as_float((unsigned)rec[(rr * 4 + 3) * 2 + 1]);
        const float e1_ = __expf(tv1 - tv0), e2_ = __expf(tv2 - tv0), e3_ = __expf(tv3 - tv0);
        const float rs = 1.0f / (1.0f + e1_ + e2_ + e3_);
        const int row = gw + NGW * rr;
        if (sub < 4 && row < T) {
            const int k = sub;
            const int e = k == 0 ? te0 : k == 1 ? te1 : k == 2 ? te2 : te3;
            const float gt = (k == 0 ? 1.0f : k == 1 ? e1_ : k == 2 ? e2_ : e3_) * rs;
            const int rnk = __hip_atomic_fetch_add(lcnt + e, 1, __ATOMIC_RELAXED, __HIP_MEMORY_SCOPE_WORKGROUP);
            PE[row * 4 + k] = e; GATE[row * 4 + k] = gt; pairs[(F.wid * 16 + rr) * 4 + k] = e | (rnk << 8);
        }
    }
    __syncthreads();
    if (F.tid < 32) { const int c = lcnt[F.tid]; gbase[F.tid] = c ? (int)atomicAdd(cnt + F.tid * 64, (unsigned)c) : 0; }
    __syncthreads();
    it = 0;
    for (int row = gw; row < T; row += NGW, ++it) {
        if (F.lane < 4) {
            const int pr = pairs[(F.wid * 16 + (it & 15)) * 4 + F.lane], e = pr & 255, p = gbase[e] + (pr >> 8);
            PPOS[row * 4 + F.lane] = p; TOKOF[(size_t)e * T + p] = row;
        }
    }
}

DI void moe_tables(Frame& F, int l, LAS int* tstart, LAS int* soff) {
    __syncthreads();
    if (F.tid == 0) {
        int ts = 0;
        for (int e = 0; e < 32; ++e) {
            const int c = (int)__hip_atomic_load(F.ctl + CW_CNT + (l * 32 + e) * 64, __ATOMIC_RELAXED, __HIP_MEMORY_SCOPE_AGENT);
            tstart[e] = ts; soff[e] = ts * 256; tstart[80 + e] = c; ts += (c + 255) >> 8;
        }
        tstart[32] = ts; soff[32] = ts * 256;
    }
    __syncthreads();
}
DI void phase_moe_gu(Frame& F, const Params& P, int l) {
    F.lane = vlane(); F.tid = F.wid * 64 + F.lane;
    unsigned char* ws = F.ws;
    LAS int* tstart = (LAS int*)(F.lds + LDS_CTL + 64); LAS int* soff = tstart + 40;
    moe_tables(F, l, tstart, soff);
    pg8::Gemm g{(const bf16_t*)(ws + WS_X1B), (const bf16_t*)(ws + WS_W_GU) + (size_t)l * 32 * 2048 * 1024, 1024};
    LAS int* ulist = (LAS int*)(F.lds + LDS_CTL + 3328);
    MoeOrder::build(F, tstart, 8, ulist);
    MoeOrder S{tstart, 3, true, (const int*)(ws + WS_TOKOF), (const LAS int*)(F.lds + LDS_CTL + 1024), ulist};
    EpiGU E{(bf16_t*)(ws + WS_H), KP->moe_b_gu + (size_t)l * 32 * 2048};
    pg8::gemm_phase<EpiGU, MoeOrder, true>(F.lds, g, S, E, F.wid);
    if (l == 0) { const int rem = (tstart[32] * 8) % F.G; if (rem && F.bid >= rem) conv_pull(F, 1, CONV_GU); }
}
DI void phase_moe_dn(Frame& F, const Params& P, int l) {
    F.lane = vlane(); F.tid = F.wid * 64 + F.lane;
    unsigned char* ws = F.ws;
    LAS int* tstart = (LAS int*)(F.lds + LDS_CTL + 64); LAS int* soff = tstart + 40;
    moe_tables(F, l, tstart, soff);
    pg8::Gemm g{(const bf16_t*)(ws + WS_H), (const bf16_t*)(ws + WS_W_DN) + (size_t)l * 32 * 1024 * 1024, 1024};
    LAS int* ulist = (LAS int*)(F.lds + LDS_CTL + 3328);
    MoeOrder::build(F, tstart, 4, ulist);
    MoeOrder S{tstart, 2, false, nullptr, nullptr, ulist};
    EpiDN E{(bf16_t*)(ws + WS_YE), KP->moe_b_dn + (size_t)l * 32 * 1024};
    pg8::gemm_phase<EpiDN, MoeOrder, true>(F.lds, g, S, E, F.wid);
    if (l == 0) { const int rem = (tstart[32] * 4) % F.G; if (rem && F.bid >= rem) conv_pull(F, 1, CONV_DN); }
}


DI void phase_combine(Frame& F, const Params& P, int l, float* outf, bf16_t* outb) {
    F.lane = vlane(); F.tid = F.wid * 64 + F.lane;
    unsigned char* ws = F.ws;
    LAS int* tstart = (LAS int*)(F.lds + LDS_CTL + 64); LAS int* soff = tstart + 40;
    moe_tables(F, l, tstart, soff);
    const float* g = KP->ln_g + (size_t)(l * 2 + 1) * DM; const float* bt = KP->ln_b + (size_t)(l * 2 + 1) * DM;
    const float* X1 = (const float*)(ws + WS_Y); const bf16_t* YE = (const bf16_t*)(ws + WS_YE);
    const float* g1 = KP->ln_g + (size_t)(l * 2 + 0) * DM; const float* b1 = KP->ln_b + (size_t)(l * 2 + 0) * DM;
    const int* PE = (const int*)(ws + WS_PE); const int* PPOS = (const int*)(ws + WS_PPOS); const float* GATE = (const float*)(ws + WS_GATE);
    const int gw = F.bid * 8 + F.wid, NGW = F.G * 8;
    typedef int i32x4 __attribute__((ext_vector_type(4)));
    i32x4 ie, ip; f32x4 ig;
    f32x4 xn[4]; u32x2 yn[4][4]; f32x4 gn;
#define CB_LOADIDX(r) do { ie = *(const i32x4*)(PE + (size_t)(r) * 4); ip = *(const i32x4*)(PPOS + (size_t)(r) * 4); ig = *(const f32x4*)(GATE + (size_t)(r) * 4); } while (0)
#define CB_LOADDATA(r) do { gn = ig; \
        _Pragma("unroll") for (int j = 0; j < 4; ++j) xn[j] = *((const f32x4*)(X1 + (size_t)(r) * DM) + F.lane + 64 * j); \
        _Pragma("unroll") for (int k = 0; k < 4; ++k) { const int slot = soff[ie[k]] + ip[k]; const u32x2* yr = (const u32x2*)(YE + (size_t)slot * 1024) + F.lane; \
            _Pragma("unroll") for (int j = 0; j < 4; ++j) yn[k][j] = yr[64 * j]; } } while (0)
    if (gw < T) { CB_LOADIDX(gw); CB_LOADDATA(gw); if (gw + NGW < T) CB_LOADIDX(gw + NGW); }
    for (int row = gw; row < T; row += NGW) {
        f32x4 v[4]; u32x2 yc[4][4]; f32x4 gc = gn;
        {
            float s0 = 0.f;
#pragma unroll
            for (int j = 0; j < 4; ++j) { v[j] = xn[j]; s0 += (v[j][0] + v[j][1]) + (v[j][2] + v[j][3]); }
            const float mean0 = wave_sum(s0) * (1.f / DM); float q0 = 0.f;
#pragma unroll
            for (int j = 0; j < 4; ++j) { v[j] = v[j] - mean0; q0 += (v[j][0] * v[j][0] + v[j][1] * v[j][1]) + (v[j][2] * v[j][2] + v[j][3] * v[j][3]); }
            const float rstd0 = 1.0f / sqrtf(wave_sum(q0) * (1.f / DM) + LN_EPS);
#pragma unroll
            for (int j = 0; j < 4; ++j) {
                const f32x4 gg = *((const f32x4*)g1 + F.lane + 64 * j), bb = *((const f32x4*)b1 + F.lane + 64 * j);
                v[j] = (v[j] * rstd0 * gg + bb) * ALPHA;
            }
        }
#pragma unroll
        for (int k = 0; k < 4; ++k)
#pragma unroll
            for (int j = 0; j < 4; ++j) yc[k][j] = yn[k][j];
        if (row + NGW < T) { CB_LOADDATA(row + NGW); if (row + 2 * NGW < T) CB_LOADIDX(row + 2 * NGW); }
#pragma unroll
        for (int k = 0; k < 4; ++k) {
            const float gt = gc[k];
#pragma unroll
            for (int j = 0; j < 4; ++j) {
                const u32x2 w = yc[k][j];
                v[j][0] += gt * __uint_as_float(w.x << 16); v[j][1] += gt * __uint_as_float(w.x & 0xffff0000u);
                v[j][2] += gt * __uint_as_float(w.y << 16); v[j][3] += gt * __uint_as_float(w.y & 0xffff0000u);
            }
        }
        float s = 0.f;
#pragma unroll
        for (int j = 0; j < 4; ++j) s += (v[j][0] + v[j][1]) + (v[j][2] + v[j][3]);
        const float mean = wave_sum(s) * (1.f / DM); float s2 = 0.f;
#pragma unroll
        for (int j = 0; j < 4; ++j) { v[j] = v[j] - mean; s2 += (v[j][0] * v[j][0] + v[j][1] * v[j][1]) + (v[j][2] * v[j][2] + v[j][3] * v[j][3]); }
        const float rstd = 1.0f / sqrtf(wave_sum(s2) * (1.f / DM) + LN_EPS);
#pragma unroll
        for (int j = 0; j < 4; ++j) {
            const f32x4 gg = *((const f32x4*)g + F.lane + 64 * j), bb = *((const f32x4*)bt + F.lane + 64 * j);
            v[j] = v[j] * rstd * gg + bb;
            *((f32x4*)(outf + (size_t)row * DM) + F.lane + 64 * j) = v[j];
            if (outb) *((u32x2*)(outb + (size_t)row * DM) + F.lane + 64 * j) = (u32x2){cvtpk(v[j][0], v[j][1]), cvtpk(v[j][2], v[j][3])};
        }
    }
#undef CB_LOADIDX
#undef CB_LOADDATA
}

DI void phase_lat(Frame& F) {
    F.lane = vlane(); F.tid = F.wid * 64 + F.lane;
    unsigned char* ws = F.ws;
    pg8::Gemm g{(const bf16_t*)(ws + WS_XB), (const bf16_t*)(ws + WS_W_BIN), 1024}; pg8::StaticOrder S; S.init(T, 1024, 1024, F.G, F.bid);
    EpiLat E{(float*)(ws + WS_LAT), 928};
    pg8::gemm_phase<EpiLat, pg8::StaticOrder, false>(F.lds, g, S, E, F.wid);
}

DI void phase_latrows(Frame& F, const Params& P) {
    F.lane = vlane(); F.tid = F.wid * 64 + F.lane;
    unsigned char* ws = F.ws;
    const float* LAT = (const float*)(ws + WS_LAT);
    bf16_t* CKV = (bf16_t*)(ws + WS_CKV); bf16_t* CQ = (bf16_t*)(ws + WS_CQ); bf16_t* MQ = (bf16_t*)(ws + WS_MQ); bf16_t* Kb = (bf16_t*)(ws + WS_K);
    const int gw = F.bid * 8 + F.wid, NGW = F.G * 8;
    for (int row = gw; row < T; row += NGW) {
        const float* lr = LAT + (size_t)row * 1024;
        {
            const f32x4 v = *((const f32x4*)lr + F.lane);
            const float ss = wave_sum((v[0] * v[0] + v[1] * v[1]) + (v[2] * v[2] + v[3] * v[3]));
            const float rs = 1.0f / sqrtf(ss * (1.f / 256.f) + RMS_EPS);
            const f32x4 gg = *((const f32x4*)KP->kv_g + F.lane);
            const f32x4 o = v * rs * gg;
            *((u32x2*)(CKV + (size_t)row * 256) + F.lane) = (u32x2){cvtpk(o[0], o[1]), cvtpk(o[2], o[3])};
        }
        {
            const f32x4 v0 = *((const f32x4*)(lr + 288) + F.lane);
            f32x4 v1 = (f32x4){0.f, 0.f, 0.f, 0.f};
            if (F.lane < 32) v1 = *((const f32x4*)(lr + 288 + 256) + F.lane);
            const float ss = wave_sum((v0[0] * v0[0] + v0[1] * v0[1]) + (v0[2] * v0[2] + v0[3] * v0[3]) + (v1[0] * v1[0] + v1[1] * v1[1]) + (v1[2] * v1[2] + v1[3] * v1[3]));
            const float rs = 1.0f / sqrtf(ss * (1.f / 384.f) + RMS_EPS);
            const f32x4 g0 = *((const f32x4*)KP->b_g_q + F.lane);
            const f32x4 o0 = v0 * rs * g0;
            *((u32x2*)(CQ + (size_t)row * 384) + F.lane) = (u32x2){cvtpk(o0[0], o0[1]), cvtpk(o0[2], o0[3])};
            if (F.lane < 32) {
                const f32x4 g1 = *((const f32x4*)(KP->b_g_q + 256) + F.lane);
                const f32x4 o1 = v1 * rs * g1;
                *((u32x2*)(CQ + (size_t)row * 384 + 256) + F.lane) = (u32x2){cvtpk(o1[0], o1[1]), cvtpk(o1[2], o1[3])};
            }
        }
        {
            const f32x4 v = *((const f32x4*)(lr + 672) + F.lane) * (0.125f * LOG2E);
            *((u32x2*)(MQ + (size_t)row * 256) + F.lane) = (u32x2){cvtpk(v[0], v[1]), cvtpk(v[2], v[3])};
        }
        if (F.lane < 16) {
            const int i = F.lane;
            const float p = (float)KP->pos[row];
            const float inv = exp2f(-(float)i * (13.287712379549449f / 16.0f));
            float sn, cs; sincos_cw(p * inv, sn, cs);
            const float x1 = lr[256 + i], x2 = lr[256 + 16 + i];
            const unsigned short o1 = (unsigned short)(cvtpk(x1 * cs - x2 * sn, 0.f) & 0xffffu), o2 = (unsigned short)(cvtpk(x1 * sn + x2 * cs, 0.f) & 0xffffu);
#pragma unroll
            for (int h = 0; h < NH; ++h) { Kb[(size_t)row * 1152 + h * 96 + 64 + i] = o1; Kb[(size_t)row * 1152 + h * 96 + 80 + i] = o2; }
        }
    }
}
#ifndef UPSEL
#define UPSEL 7
#endif
struct RouteK1 { unsigned char* ws; DI Dst operator()(const pg8::Unit& u) const { return Dst{(bf16_t*)(ws + WS_K), 1152, u.pm * 256, u.pn * 384, 256, 1.0f, true}; } };
struct RouteQ1 { unsigned char* ws; DI Dst operator()(const pg8::Unit& u) const { const int nv = 1152 - u.pn * 256; return Dst{(bf16_t*)(ws + WS_Q), 1152, u.pm * 256, u.pn * 256, nv < 256 ? nv : 256, 0.10206207261596577f * LOG2E, false}; } };
DI void phase_up1(Frame& F) {
    F.lane = vlane(); F.tid = F.wid * 64 + F.lane;
    unsigned char* ws = F.ws;
    const bf16_t* ckv = (const bf16_t*)(ws + WS_CKV); const bf16_t* cq = (const bf16_t*)(ws + WS_CQ);
    const bf16_t* wukv = (const bf16_t*)(ws + WS_W_UKV); const bf16_t* wuq = (const bf16_t*)(ws + WS_W_UQ);
#if (UPSEL & 1)
    {
        pg8::Gemm g{cq, wuq, 384}; pg8::StaticOrder S; S.init(T, 1280, 384, F.G, F.bid);
        EpiBf16R<RouteQ1> E{RouteQ1{ws}};
        pg8::gemm_phase<EpiBf16R<RouteQ1>, pg8::StaticOrder, true>(F.lds, g, S, E, F.wid);
    }
#endif
#if (UPSEL & 2)
    {
        pg8::Gemm g{ckv, wukv, 256}; pg8::StaticOrder S; S.init(T, 768, 256, F.G, F.G - 1 - F.bid);
        EpiBf16R<RouteK1> E{RouteK1{ws}};
        pg8::gemm_phase<EpiBf16R<RouteK1>, pg8::StaticOrder, true>(F.lds, g, S, E, F.wid);
    }
#endif
#if (UPSEL & 4)
    {
        pg8::Gemm g{wukv + (size_t)768 * 256, ckv, 256}; pg8::StaticOrder S; S.init(768, T, 256, F.G, F.G - 1 - F.bid);
        EpiBf16R<RouteVT> E{RouteVT{ws}};
        pg8::gemm_phase<EpiBf16R<RouteVT>, pg8::StaticOrder, true>(F.lds, g, S, E, F.wid);
    }
#endif
}


__global__ void __launch_bounds__(NTHREADS) mega_fwd(Params P) {
    extern __shared__ __attribute__((aligned(16))) unsigned char lds_raw[];
    Frame F;
    F.lds = (LAS unsigned char*)lds_raw; F.ws = KP->ws; F.ctl = (unsigned*)(KP->ws + WS_CTL);
    F.wid = __builtin_amdgcn_readfirstlane((int)threadIdx.x >> 6); F.lane = vlane(); F.tid = F.wid * 64 + F.lane; F.G = gridDim.x; F.bid = blockIdx.x;
    const int lo = KP->ph_lo, hi = KP->ph_hi;
    { volatile LAS unsigned* st0 = (volatile LAS unsigned*)(F.lds + LDS_CTL + 512); if (F.tid < 2) st0[F.tid] = 0u; }
    __syncthreads();
    XcdBarrier bar = xcd_barrier_post(F.ctl + CW_BAR, (volatile LAS unsigned*)(F.lds + LDS_CTL + 512), F.wid);
#ifndef PHMASK
#define PHMASK 0x1ffff
#endif
#define IN(k) (((PHMASK >> (k)) & 1) && lo <= (k) && (k) < hi)
#define SEAM(k) do { if (IN(k) && IN((k) + 1)) { if (KP->use_grid_sync) { if ((k) == 0) cg::this_grid().sync(); else xcd_barrier(bar); } } } while (0)
    unsigned char* ws = KP->ws;
    if (IN(0)) { phase_prologue(F, P);
    }
    SEAM(0);
    if (IN(1)) { phase_proj0(F, P);
        if (KP->use_grid_sync) xcd_barrier(bar); phase_scan_knorm(F); }
    SEAM(1);
    if (IN(2)) { phase_attn0(F, P);
    }
    SEAM(2);
    if (IN(3)) { phase_outproj(F, KP->x, (const bf16_t*)(ws + WS_W_AOUT));
    }
    SEAM(3);
    if (IN(4)) phase_ln_router(F, P, 0);
    SEAM(4);
    if (IN(5)) phase_moe_gu(F, P, 0);
    SEAM(5);
    if (IN(6)) phase_moe_dn(F, P, 0);
    SEAM(6);
    if (IN(7)) phase_combine(F, P, 0, (float*)(ws + WS_X2), (bf16_t*)(ws + WS_XB));
    SEAM(7);
    if (IN(8)) phase_lat(F);
    SEAM(8);
    if (IN(9)) phase_latrows(F, P);
    SEAM(9);
    if (IN(10)) { phase_up1(F);
    }
    SEAM(10);
    if (IN(11)) { phase_attn1(F, P);
    }
    SEAM(11);
    if (IN(12)) phase_outproj(F, (const float*)(ws + WS_X2), (const bf16_t*)(ws + WS_W_BOUT));
    SEAM(12);
    if (IN(13)) phase_ln_router(F, P, 1);
    SEAM(13);
    if (IN(14)) { phase_moe_gu(F, P, 1);
    }
    SEAM(14);
    if (IN(15)) { phase_moe_dn(F, P, 1);
    }
    SEAM(15);
    if (IN(16)) { phase_combine(F, P, 1, KP->out, nullptr);
    }
#undef IN
#undef SEAM
}

constexpr int N_PHASES = 17;
#ifndef MK_N_LAUNCHES
#define MK_N_LAUNCHES 1
#endif

extern "C" void kernel_launch(void* const* d_in, const int* in_sizes, int n_in, void* d_out, int out_size, void* d_ws, size_t ws_size, hipStream_t stream) {
    static int grid = 0;
    if (grid == 0) {
        if (n_in != 22 || ws_size < WS_END) { fprintf(stderr, "kernel_launch: need 22 inputs and %zu bytes of workspace (got %d, %zu)\n", (size_t)WS_END, n_in, ws_size); grid = -1; return; }
        int dev = 0, cus = 0, per_cu = 0;
        hipGetDevice(&dev);
        hipDeviceGetAttribute(&cus, hipDeviceAttributeMultiprocessorCount, dev);
        if (hipFuncSetAttribute((const void*)mega_fwd, hipFuncAttributeMaxDynamicSharedMemorySize, LDS_BYTES) != hipSuccess) fprintf(stderr, "kernel_launch: hipFuncSetAttribute failed\n");
        if (hipOccupancyMaxActiveBlocksPerMultiprocessor(&per_cu, (const void*)mega_fwd, NTHREADS, LDS_BYTES) != hipSuccess || per_cu < 1) { fprintf(stderr, "kernel_launch: occupancy query failed (%d)\n", per_cu); per_cu = 1; }
        (void)hipGetLastError();
        grid = cus * (per_cu > 1 ? 1 : per_cu);
        if (grid <= 0) grid = 256;
        if (grid != 256) fprintf(stderr, "kernel_launch: built for a 256-CU device (one workgroup per CU); got %d\n", grid);
    }
    if (grid < 0) return;
    hipMemsetAsync((char*)d_ws + WS_CTL, 0, CTL_BYTES, stream);
    Params p{};
    p.x = (const float*)d_in[0]; p.mem = (const float*)d_in[1]; p.pos = (const int*)d_in[2];
    p.a_w_in = (const float*)d_in[3]; p.a_b_f = (const float*)d_in[4]; p.a_w_out = (const float*)d_in[5];
    p.b_w_in = (const float*)d_in[6]; p.b_g_q = (const float*)d_in[7]; p.b_w_uq = (const float*)d_in[8]; p.b_w_out = (const float*)d_in[9];
    p.kv_w_dkv = (const float*)d_in[10]; p.kv_g = (const float*)d_in[11]; p.kv_w_ukv = (const float*)d_in[12]; p.mem_w_kv = (const float*)d_in[13];
    p.ln_g = (const float*)d_in[14]; p.ln_b = (const float*)d_in[15]; p.moe_w_r = (const float*)d_in[16]; p.moe_b_r = (const float*)d_in[17];
    p.moe_w_gu = (const float*)d_in[18]; p.moe_b_gu = (const float*)d_in[19]; p.moe_w_dn = (const float*)d_in[20]; p.moe_b_dn = (const float*)d_in[21];
    p.out = (float*)d_out; p.ws = (unsigned char*)d_ws;
    if (MK_N_LAUNCHES == 1) {
        p.ph_lo = 0; p.ph_hi = N_PHASES; p.use_grid_sync = 1;
        void* args[] = {&p};
        hipError_t e = hipLaunchCooperativeKernel((const void*)mega_fwd, dim3(grid), dim3(NTHREADS), args, LDS_BYTES, stream);
        if (e != hipSuccess) fprintf(stderr, "kernel_launch: cooperative launch failed: %s (grid %d)\n", hipGetErrorString(e), grid);
    } else {
        for (int ph = 0; ph < N_PHASES; ++ph) {
            p.ph_lo = ph; p.ph_hi = ph + 1; p.use_grid_sync = 0;
            hipLaunchKernelGGL(mega_fwd, dim3(grid), dim3(NTHREADS), LDS_BYTES, stream, p);
        }
    }
}
```

```cpp
#include <hip/hip_runtime.h>
#include <hip/hip_cooperative_groups.h>
#include <cstdio>
#include <cstdint>
#include <cmath>
namespace cg = cooperative_groups;

#define DI __device__ __forceinline__
#define LAS __attribute__((address_space(3)))
typedef unsigned short bf16_t;
typedef short bf16x8 __attribute__((ext_vector_type(8)));
typedef float f32x4 __attribute__((ext_vector_type(4)));
typedef float f32x2 __attribute__((ext_vector_type(2)));
typedef float f32x16 __attribute__((ext_vector_type(16)));
typedef unsigned u32x4 __attribute__((ext_vector_type(4)));
typedef unsigned u32x2 __attribute__((ext_vector_type(2)));
typedef int i32x4 __attribute__((ext_vector_type(4)));
typedef int i32x8 __attribute__((ext_vector_type(8)));
typedef __bf16 bf16x2_t __attribute__((ext_vector_type(2)));

constexpr int NB = 2, SEQ = 8192, T = NB * SEQ, DM = 1024;
constexpr int NH = 12, NMEM = 256;
constexpr int FOX_IN = 2572;
constexpr int NE = 32;
constexpr float LOG2E = 1.4426950408889634f;
constexpr float ALPHA = 1.4142135623730951f;
constexpr float LN_EPS = 1e-5f, RMS_EPS = 1e-6f;
constexpr int NTHREADS = 512;
constexpr int LDS_BYTES = 131072 + 4096 + 8 * 1280 + 512;
constexpr int LDS_R1X = 131072 + 4096;
constexpr int LDS_CTL = 131072;
constexpr int SLOT_ROWS = 65536 + NE * 256;

constexpr size_t al256(size_t x) { return (x + 255) & ~(size_t)255; }
constexpr size_t WS_CTL = 0, CTL_BYTES = 65536;
constexpr size_t WS_W_AIN = al256(WS_CTL + CTL_BYTES);
constexpr size_t WS_W_AOUT = al256(WS_W_AIN + (size_t)2560 * 1024 * 2);
constexpr size_t WS_W_BIN = al256(WS_W_AOUT + (size_t)1024 * 1024 * 2);
constexpr size_t WS_W_UQ = al256(WS_W_BIN + (size_t)1024 * 1024 * 2);
constexpr size_t WS_W_UKV = al256(WS_W_UQ + (size_t)1280 * 384 * 2);
constexpr size_t WS_W_BOUT = al256(WS_W_UKV + (size_t)1536 * 256 * 2);
constexpr size_t WS_W_MKV = al256(WS_W_BOUT + (size_t)1024 * 1024 * 2);
constexpr size_t WS_W_GU = al256(WS_W_MKV + (size_t)2 * 512 * 1024 * 2);
constexpr size_t WS_W_DN = al256(WS_W_GU + (size_t)2 * 32 * 2048 * 1024 * 2);
constexpr size_t WS_XB = al256(WS_W_DN + (size_t)2 * 32 * 1024 * 1024 * 2);
constexpr size_t WS_MEMB = al256(WS_XB + (size_t)T * 1024 * 2);
constexpr size_t WS_LOGF = al256(WS_MEMB + (size_t)512 * 1024 * 2);
constexpr size_t WS_CUM = al256(WS_LOGF + (size_t)24 * 8192 * 4);
constexpr size_t WS_Q = al256(WS_CUM + (size_t)24 * 8192 * 4);
constexpr size_t WS_K = al256(WS_Q + (size_t)T * 1152 * 2);
constexpr size_t WS_VT = al256(WS_K + (size_t)T * 1152 * 2);
constexpr size_t WS_MQ = al256(WS_VT + (size_t)1536 * 8192 * 2);
constexpr size_t WS_MK = al256(WS_MQ + (size_t)T * 256 * 2);
constexpr size_t WS_MVT = al256(WS_MK + (size_t)2 * 512 * 256 * 2);
constexpr size_t WS_MERGED = al256(WS_MVT + (size_t)2 * 2 * 256 * 256 * 2);
constexpr size_t WS_Y = al256(WS_MERGED + (size_t)T * 1024 * 2);
constexpr size_t WS_X1 = al256(WS_Y + (size_t)T * 1024 * 4);
constexpr size_t WS_X1B = al256(WS_X1 + (size_t)T * 1024 * 4);
constexpr size_t WS_PE = al256(WS_X1B + (size_t)T * 1024 * 2);
constexpr size_t WS_PPOS = al256(WS_PE + (size_t)T * 4 * 4);
constexpr size_t WS_GATE = al256(WS_PPOS + (size_t)T * 4 * 4);
constexpr size_t WS_TOKOF = al256(WS_GATE + (size_t)T * 4 * 4);
constexpr size_t WS_H = al256(WS_TOKOF + (size_t)NE * T * 4);
constexpr size_t WS_YE = al256(WS_H + (size_t)SLOT_ROWS * 1024 * 2);
constexpr size_t WS_LAT = al256(WS_YE + (size_t)SLOT_ROWS * 1024 * 2);
constexpr size_t WS_CKV = al256(WS_LAT + (size_t)T * 1024 * 4);
constexpr size_t WS_CQ = al256(WS_CKV + (size_t)T * 256 * 2);
constexpr size_t WS_X2 = al256(WS_CQ + (size_t)T * 384 * 2);
constexpr size_t WS_KN2 = al256(WS_X2 + (size_t)T * 1024 * 4);
constexpr size_t WS_WRT = al256(WS_KN2 + (size_t)24 * 128 * 4);
constexpr size_t WS_WRH = al256(WS_WRT + (size_t)2 * 32 * 1024 * 4);
constexpr size_t WS_WRL = al256(WS_WRH + (size_t)2 * 32 * 1024 * 2);
constexpr size_t WS_SGU = al256(WS_WRL + (size_t)2 * 32 * 1024 * 2);
constexpr size_t WS_SAS = al256(WS_SGU + (size_t)2 * 32 * 2048 * 4);
constexpr size_t WS_END = al256(WS_SAS + (size_t)NE * T * 4);
constexpr int CW_CNT = 8192;
constexpr int CW_WORK = 256;
constexpr int CW_BAR = 4096;

struct Params {
    const float* x; const float* mem; const int* pos;
    const float *a_w_in, *a_b_f, *a_w_out, *b_w_in, *b_g_q, *b_w_uq, *b_w_out, *kv_w_dkv, *kv_g, *kv_w_ukv, *mem_w_kv, *ln_g, *ln_b;
    const float *moe_w_r, *moe_b_r, *moe_w_gu, *moe_b_gu, *moe_w_dn, *moe_b_dn;
    float* out; unsigned char* ws; int ph_lo, ph_hi; int use_grid_sync, pad;
};

#define KP ((const __attribute__((address_space(4))) Params*)__builtin_amdgcn_kernarg_segment_ptr())
DI unsigned cvtpk(float lo, float hi) { f32x2 v = {lo, hi}; bf16x2_t b = __builtin_convertvector(v, bf16x2_t); return __builtin_bit_cast(unsigned, b); }
DI float bf2f(unsigned short b) { return __uint_as_float(((unsigned)b) << 16); }
DI float wave_sum(float v) {
#pragma unroll
    for (int o = 1; o < 64; o <<= 1) v += __shfl_xor(v, o);
    return v;
}
DI float wave_max(float v) {
#pragma unroll
    for (int o = 1; o < 64; o <<= 1) v = fmaxf(v, __shfl_xor(v, o));
    return v;
}

DI void sincos_cw(float x, float& sn, float& cs) {
    int j = (int)(x * 1.27323954473516f); j = (j + 1) & ~1;
    const float y = (float)j;
    const float r = ((x - y * 0.78515625f) - y * 2.4187564849853515625e-4f) - y * 3.77489497744594108e-8f;
    const float z = r * r;
    const float sp = ((-1.9515295891e-4f * z + 8.3321608736e-3f) * z - 1.6666654611e-1f) * z * r + r;
    const float cp = ((2.443315711809948e-5f * z - 1.388731625493765e-3f) * z + 4.166664568298827e-2f) * z * z - 0.5f * z + 1.0f;
    const int q = (j >> 1) & 3;
    const float s0 = (q & 1) ? cp : sp, c0 = (q & 1) ? sp : cp;
    sn = (q & 2) ? -s0 : s0;
    cs = ((q + 1) & 2) ? -c0 : c0;
}
DI float fadd_s(float a, float b) { float r; asm("v_add_f32_e32 %0, %1, %2" : "=v"(r) : "v"(a), "v"(b)); return r; }
DI int vlane() { int l; asm volatile("v_mbcnt_lo_u32_b32 %0, -1, 0\n\tv_mbcnt_hi_u32_b32 %0, -1, %0" : "=v"(l)); return l; }
#define LDS_WAIT() asm volatile("s_waitcnt lgkmcnt(0)" ::: "memory")
#define VM_WAIT() asm volatile("s_waitcnt vmcnt(0)" ::: "memory")

#ifndef GEMM_TOKPF
#define GEMM_TOKPF 2
#endif
namespace pg8 {
constexpr int BM = 256, BK = 64, HALF = 128, HTB = HALF * BK * 2, STAGE_BYTES = 8 * HTB, NXCD = 8, WGM = 8;
DI int lds_byte(int r, int c) { const int st = (r >> 4) * 2 + (c >> 5), rr = r & 15, cc = c & 31, ob = rr * 64 + cc * 2; return st * 1024 + (ob ^ (((ob >> 9) & 1) << 5)); }
DI void stage_rc(int b, int& R, int& C) { const int st = b / 1024, sb = b % 1024, swz = sb ^ (((sb >> 9) & 1) << 5); R = (st >> 1) * 16 + swz / 64; C = (st & 1) * 32 + (swz % 64) / 2; }
DI int perm32(int rho) { const int n = rho >> 4, i = rho & 15; return 8 * (i >> 2) + 4 * n + (i & 3); }
struct Unit { int pm, pn; };
struct Gemm { const bf16_t* A; const bf16_t* Bt; int K; };
struct StaticOrder {
    int nM, nN, nwg, G, c, K2;
    DI void init(int M, int N, int K, int G_, int c_) { nM = M / BM; nN = N / BM; nwg = nM * nN; G = G_; c = c_; K2 = K * 2; }
    DI bool next(int i, Unit& u) const {
        const long L = (long)i * G + c; if (L >= nwg) return false;
        int wgid = (int)L; { const int q = nwg / NXCD, r = nwg % NXCD, xcd = wgid % NXCD, off = wgid / NXCD; wgid = (xcd < r ? xcd * (q + 1) : r * (q + 1) + (xcd - r) * q) + off; }
        const int nig = WGM * nN, gid = wgid / nig, fm = gid * WGM, gsz = (nM - fm) < WGM ? (nM - fm) : WGM;
        u.pm = fm + ((wgid % nig) % gsz); u.pn = (wgid % nig) / gsz; return true;
    }
    DI unsigned a_off(const Unit& u, int r) const { return (unsigned)(u.pm * BM + r) * (unsigned)K2; }
    DI unsigned a_off_pf(const Unit& u, int r, int) const { return a_off(u, r); }
    DI void prefetch(const Unit&, int, int, int) const {}
    DI void a_ready(const Unit&) const {}
    DI void done(const Unit&) const {}
};

template <class Epi, class Sched, bool ALIGN_EPI, int MODE = 0>
DI void gemm_phase(LAS unsigned char* lds, const Gemm g, const Sched& S, const Epi& E, const int wid) {
    const int lane = vlane(), tid = wid * 64 + lane, wr = wid >> 2, wc = wid & 3, fr = lane & 15, fq = lane >> 4;
    const int K = g.K, nt = K / BK;
    int RA[2]; unsigned cA2[2], voffB[2];
#pragma unroll
    for (int i = 0; i < 2; ++i) { int R, C; stage_rc(tid * 16 + i * 8192, R, C); const int Rb = Epi::PERM ? ((R & ~31) + perm32(R & 31)) : R;
        RA[i] = R; cA2[i] = (unsigned)C * 2u; voffB[i] = (unsigned)(Rb * K + C) * 2u; }
    const size_t kstep = (size_t)(BK * 2);
    const size_t hstep = (size_t)HALF * K * 2;
    const size_t tstep = 2 * hstep;
    const unsigned ldsw = (unsigned)wid * 1024u;
    const int aoff = lds_byte(wr * 64 + fr, fq * 8), boff = lds_byte(wc * 32 + fr, fq * 8);
#define PG8_SA(b, h) (((b) * 2 + (h)) * HTB)
#define PG8_SB(b, h) ((4 + (b) * 2 + (h)) * HTB)
#define PG8_STAGE_B(bufoff, gbase) do { _Pragma("unroll") for (int _i = 0; _i < 2; ++_i) \
        __builtin_amdgcn_global_load_lds((const unsigned*)((const char*)(gbase) + voffB[_i]), (LAS unsigned*)(lds + (bufoff) + ldsw + _i * 8192), 16, 0, 0); } while (0)
#define PG8_STAGE_A(bufoff, kbytes, uo) do { _Pragma("unroll") for (int _i = 0; _i < 2; ++_i) \
        __builtin_amdgcn_global_load_lds((const unsigned*)((const char*)g.A + (kbytes) + (uo)[_i]), (LAS unsigned*)(lds + (bufoff) + ldsw + _i * 8192), 16, 0, 0); } while (0)
#define PG8_STAGE_A2(bufoff, kbytes, h) do { _Pragma("unroll") for (int _i = 0; _i < 2; ++_i) \
        __builtin_amdgcn_global_load_lds((const unsigned*)((const char*)g.A + (kbytes) + (last ? uN[h][_i] : uC[h][_i])), (LAS unsigned*)(lds + (bufoff) + ldsw + _i * 8192), 16, 0, 0); } while (0)
#define PG8_LDA(dst, b, h) do { _Pragma("unroll") for (int m = 0; m < 4; ++m) _Pragma("unroll") for (int k = 0; k < 2; ++k) dst[m][k] = *(const LAS bf16x8*)(lds + PG8_SA(b, h) + aoff + m * 2048 + k * 1024); } while (0)
#define PG8_LDB(dst, b, h) do { _Pragma("unroll") for (int n = 0; n < 2; ++n) _Pragma("unroll") for (int k = 0; k < 2; ++k) dst[n][k] = *(const LAS bf16x8*)(lds + PG8_SB(b, h) + boff + n * 2048 + k * 1024); } while (0)
#define PG8_MMA(ai, bj, At, Bt) do { __builtin_amdgcn_s_setprio(1); _Pragma("unroll") for (int m = 0; m < 4; ++m) _Pragma("unroll") for (int n = 0; n < 2; ++n) _Pragma("unroll") for (int k = 0; k < 2; ++k) \
        { if constexpr (MODE == 1) acc[ai][bj][m][n] = __builtin_bit_cast(f32x4, __builtin_amdgcn_mfma_i32_16x16x64_i8(__builtin_bit_cast(i32x4, Bt[n][k]), __builtin_bit_cast(i32x4, At[m][k]), __builtin_bit_cast(i32x4, acc[ai][bj][m][n]), 0, 0, 0)); \
          else acc[ai][bj][m][n] = __builtin_amdgcn_mfma_f32_16x16x32_bf16(Bt[n][k], At[m][k], acc[ai][bj][m][n], 0, 0, 0); } __builtin_amdgcn_s_setprio(0); } while (0)
#define PG8_WAIT_V(n) asm volatile("s_waitcnt vmcnt(" #n ")" ::: "memory")
#define PG8_WAIT_L(n) asm volatile("s_waitcnt lgkmcnt(" #n ")" ::: "memory")
#define PG8_BAR __builtin_amdgcn_s_barrier()
#define PG8_SCHED __builtin_amdgcn_sched_barrier(0)
    Unit cur, nxt; int ui = 0;
    if (!S.next(0, cur)) return;
    f32x4 acc[2][2][4][2];
#pragma unroll
    for (int a = 0; a < 2; ++a)
#pragma unroll
        for (int b = 0; b < 2; ++b)
#pragma unroll
            for (int m = 0; m < 4; ++m)
#pragma unroll
                for (int n = 0; n < 2; ++n) acc[a][b][m][n] = (f32x4){0.f, 0.f, 0.f, 0.f};
    bf16x8 At[4][2], B0[2][2], B1[2][2];
    unsigned uC[2][2], uN[2][2];
#pragma unroll
    for (int h = 0; h < 2; ++h)
#pragma unroll
        for (int i = 0; i < 2; ++i) uC[h][i] = S.a_off(cur, h * HALF + RA[i]) + cA2[i];
    const char* cB = (const char*)g.Bt + (size_t)cur.pn * tstep;
    S.a_ready(cur);
    PG8_STAGE_B(PG8_SB(0, 0), cB); PG8_STAGE_B(PG8_SB(0, 1), cB + hstep); PG8_STAGE_A(PG8_SA(0, 0), 0, uC[0]); PG8_STAGE_A(PG8_SA(0, 1), 0, uC[1]);
    if (wr == 1) PG8_BAR;
    PG8_WAIT_V(2); PG8_BAR;
    PG8_STAGE_B(PG8_SB(1, 0), cB + kstep); PG8_STAGE_A(PG8_SA(1, 0), kstep, uC[0]); PG8_STAGE_B(PG8_SB(1, 1), cB + hstep + kstep);
    PG8_WAIT_V(6); PG8_BAR;
    for (;;) {
        const bool has_next = S.next(ui + 1, nxt);
        const char* nB = has_next ? (const char*)g.Bt + (size_t)nxt.pn * tstep : cB;
#if GEMM_TOKPF == 1
        if (has_next) S.prefetch(nxt, (ui + 1) & 1, wid, lane);
#elif GEMM_TOKPF == 2
        {
            Unit nx2; const bool has2 = S.next(ui + 2, nx2);
#pragma unroll
            for (int h = 0; h < 2; ++h)
#pragma unroll
                for (int i = 0; i < 2; ++i) uN[h][i] = has_next ? ((ui == 0 ? S.a_off(nxt, h * HALF + RA[i]) : S.a_off_pf(nxt, h * HALF + RA[i], (ui + 1) & 1)) + cA2[i]) : uC[h][i];
            if (has2) S.prefetch(nx2, ui & 1, wid, lane);
        }
#else
#pragma unroll
        for (int h = 0; h < 2; ++h)
#pragma unroll
            for (int i = 0; i < 2; ++i) uN[h][i] = has_next ? (S.a_off(nxt, h * HALF + RA[i]) + cA2[i]) : uC[h][i];
#endif
#pragma nounroll
        for (int t = 0; t < nt; t += 2) {
            const bool last = (t == nt - 2);
            const size_t ka1 = (size_t)(t + 1) * kstep;
            const size_t ka2 = last ? (size_t)0 : (size_t)(t + 2) * kstep, ka3 = ka2 + kstep;
            const char* b2 = last ? nB : cB + (size_t)(t + 2) * kstep; const char* b3 = b2 + kstep;
#if GEMM_TOKPF == 1
            if (last) {
                if (has_next) S.a_ready(nxt);
#pragma unroll
                for (int h = 0; h < 2; ++h)
#pragma unroll
                    for (int i = 0; i < 2; ++i) uN[h][i] = has_next ? (S.a_off_pf(nxt, h * HALF + RA[i], (ui + 1) & 1) + cA2[i]) : uC[h][i];
            }
#endif
            PG8_LDB(B0, 0, 0); PG8_LDB(B1, 0, 1); PG8_SCHED; PG8_LDA(At, 0, 0); PG8_STAGE_A(PG8_SA(1, 1), ka1, uC[1]);
            PG8_WAIT_V(8); PG8_WAIT_L(0); PG8_BAR; PG8_MMA(0, 0, At, B0); PG8_MMA(0, 1, At, B1); PG8_BAR; PG8_SCHED;
            PG8_LDA(At, 0, 1); PG8_STAGE_B(PG8_SB(0, 0), b2); PG8_STAGE_B(PG8_SB(0, 1), b2 + hstep); PG8_STAGE_A2(PG8_SA(0, 0), ka2, 0);
            PG8_WAIT_V(8); PG8_WAIT_L(0); PG8_BAR; PG8_MMA(1, 0, At, B0); PG8_MMA(1, 1, At, B1); PG8_BAR; PG8_SCHED;
            PG8_LDB(B0, 1, 0); PG8_LDB(B1, 1, 1); PG8_SCHED; PG8_LDA(At, 1, 0); PG8_STAGE_A2(PG8_SA(0, 1), ka2, 1);
            PG8_WAIT_V(8); PG8_WAIT_L(0); PG8_BAR; PG8_MMA(0, 0, At, B0); PG8_MMA(0, 1, At, B1); PG8_BAR; PG8_SCHED;
            PG8_LDA(At, 1, 1); PG8_STAGE_B(PG8_SB(1, 0), b3); PG8_STAGE_B(PG8_SB(1, 1), b3 + hstep); PG8_STAGE_A2(PG8_SA(1, 0), ka3, 0);
            PG8_WAIT_V(8); PG8_WAIT_L(0); PG8_BAR; PG8_MMA(1, 0, At, B0); PG8_MMA(1, 1, At, B1); PG8_BAR; PG8_SCHED;
        }
        if constexpr (ALIGN_EPI) { if (wr == 0) PG8_BAR; }
        E(acc, cur, wr, wc, fr, fq); S.done(cur);
        if (!has_next) break;
#pragma unroll
        for (int a = 0; a < 2; ++a)
#pragma unroll
            for (int b = 0; b < 2; ++b)
#pragma unroll
                for (int m = 0; m < 4; ++m)
#pragma unroll
                    for (int n = 0; n < 2; ++n) acc[a][b][m][n] = (f32x4){0.f, 0.f, 0.f, 0.f};
        cur = nxt; cB = nB; ++ui;
#pragma unroll
        for (int h = 0; h < 2; ++h)
#pragma unroll
            for (int i = 0; i < 2; ++i) uC[h][i] = uN[h][i];
        if constexpr (ALIGN_EPI) { if (wr == 1) PG8_BAR; }
    }
    PG8_WAIT_V(0);
    if constexpr (!ALIGN_EPI) { if (wr == 0) PG8_BAR; }
    PG8_BAR;
#undef PG8_SA
#undef PG8_SB
#undef PG8_STAGE_A
#undef PG8_STAGE_A2
#undef PG8_STAGE_B
#undef PG8_LDA
#undef PG8_LDB
#undef PG8_MMA
#undef PG8_WAIT_V
#undef PG8_WAIT_L
#undef PG8_BAR
#undef PG8_SCHED
}
}

struct Dst { bf16_t* O; int ldo, row0, col0, nvalid; float scale; bool headmap; };
template <class Route> struct EpiBf16R {
    static constexpr bool PERM = true;
    Route R;
    DI void operator()(const f32x4 (&acc)[2][2][4][2], const pg8::Unit& u, int wr, int wc, int fr, int fq) const {
        const Dst d = R(u);
#pragma unroll
        for (int ai = 0; ai < 2; ++ai)
#pragma unroll
            for (int m = 0; m < 4; ++m) {
                bf16_t* rowp = d.O + (size_t)(d.row0 + ai * 128 + wr * 64 + m * 16 + fr) * d.ldo + d.col0;
#pragma unroll
                for (int bj = 0; bj < 2; ++bj) {
                    const int c = bj * 128 + wc * 32 + 8 * fq;
                    if (c < d.nvalid) {
                        const f32x4 v0 = acc[ai][bj][m][0] * d.scale, v1 = acc[ai][bj][m][1] * d.scale;
                        u32x4 w; w.x = cvtpk(v0[0], v0[1]); w.y = cvtpk(v0[2], v0[3]); w.z = cvtpk(v1[0], v1[1]); w.w = cvtpk(v1[2], v1[3]);
                        const int oc = d.headmap ? ((c >> 6) * 96 + (c & 63)) : c;
                        *(u32x4*)(rowp + oc) = w;
                    }
                }
            }
    }
};
struct EpiResF32 {
    static constexpr bool PERM = false;
    float* Y; const float* X;
    DI void operator()(const f32x4 (&acc)[2][2][4][2], const pg8::Unit& u, int wr, int wc, int fr, int fq) const {
#pragma unroll
        for (int ai = 0; ai < 2; ++ai)
#pragma unroll
            for (int m = 0; m < 4; ++m) {
                const size_t ro = (size_t)(u.pm * 256 + ai * 128 + wr * 64 + m * 16 + fr) * DM + u.pn * 256 + wc * 32 + 4 * fq;
#pragma unroll
                for (int bj = 0; bj < 2; ++bj)
#pragma unroll
                    for (int n = 0; n < 2; ++n) {
                        const f32x4 xv = *(const f32x4*)(X + ro + bj * 128 + n * 16);
                        *(f32x4*)(Y + ro + bj * 128 + n * 16) = xv * ALPHA + acc[ai][bj][m][n];
                    }
            }
    }
};
struct EpiLat {
    static constexpr bool PERM = false;
    float* O; int ncol;
    DI void operator()(const f32x4 (&acc)[2][2][4][2], const pg8::Unit& u, int wr, int wc, int fr, int fq) const {
#pragma unroll
        for (int ai = 0; ai < 2; ++ai)
#pragma unroll
            for (int m = 0; m < 4; ++m) {
                const int c0 = u.pn * 256 + wc * 32 + 4 * fq;
                float* rowp = O + (size_t)(u.pm * 256 + ai * 128 + wr * 64 + m * 16 + fr) * 1024;
#pragma unroll
                for (int bj = 0; bj < 2; ++bj)
#pragma unroll
                    for (int n = 0; n < 2; ++n) { const int c = c0 + bj * 128 + n * 16; if (c < ncol) *(f32x4*)(rowp + c) = acc[ai][bj][m][n]; }
            }
    }
};
struct EpiGU {
    static constexpr bool PERM = true;
    bf16_t* H; const float* bias; const float* sw; const float* sas; const LAS int* tstart;
    DI void operator()(const f32x4 (&acc)[2][2][4][2], const pg8::Unit& u, int wr, int wc, int fr, int fq) const {
        const int e = u.pn >> 3, ct = u.pn & 7;
        const int j = ct * 128 + wc * 32 + 8 * fq;
        const float* be = bias + (size_t)e * 2048;
        const float* se = sw + (size_t)e * 2048 + ct * 256 + wc * 32 + 8 * fq;
        const float* sa = sas + (size_t)e * T + (u.pm - tstart[e]) * 256 + wr * 64 + fr;
        f32x4 bg[2], bu[2], sg_[2], su_[2];
#pragma unroll
        for (int n = 0; n < 2; ++n) { bg[n] = *(const f32x4*)(be + j + 4 * n); bu[n] = *(const f32x4*)(be + 1024 + j + 4 * n); sg_[n] = *(const f32x4*)(se + 4 * n); su_[n] = *(const f32x4*)(se + 128 + 4 * n); }
#pragma unroll
        for (int ai = 0; ai < 2; ++ai)
#pragma unroll
            for (int m = 0; m < 4; ++m) {
                float h[8];
                const float st = sa[ai * 128 + m * 16];
#pragma unroll
                for (int n = 0; n < 2; ++n)
#pragma unroll
                    for (int i = 0; i < 4; ++i) {
                        const float gg = fminf((float)__float_as_int(acc[ai][0][m][n][i]) * (st * sg_[n][i]) + bg[n][i], 7.0f);
                        const float uu = fminf(fmaxf((float)__float_as_int(acc[ai][1][m][n][i]) * (st * su_[n][i]) + bu[n][i], -7.0f), 7.0f);
                        const float sg = __builtin_amdgcn_rcpf(1.0f + __builtin_amdgcn_exp2f(-1.702f * LOG2E * gg));
                        h[4 * n + i] = (uu + 1.0f) * (gg * sg);
                    }
                u32x4 w; w.x = cvtpk(h[0], h[1]); w.y = cvtpk(h[2], h[3]); w.z = cvtpk(h[4], h[5]); w.w = cvtpk(h[6], h[7]);
                *(u32x4*)(H + (size_t)(u.pm * 256 + ai * 128 + wr * 64 + m * 16 + fr) * 1024 + j) = w;
            }
    }
};
struct EpiDN {
    static constexpr bool PERM = true;
    bf16_t* Y; const float* bias;
    DI void operator()(const f32x4 (&acc)[2][2][4][2], const pg8::Unit& u, int wr, int wc, int fr, int fq) const {
        const int e = u.pn >> 2, ct = u.pn & 3;
        const float* be = bias + (size_t)e * 1024;
#pragma unroll
        for (int bj = 0; bj < 2; ++bj) {
            const int c = ct * 256 + bj * 128 + wc * 32 + 8 * fq;
            const f32x4 b0 = *(const f32x4*)(be + c), b1 = *(const f32x4*)(be + c + 4);
#pragma unroll
            for (int ai = 0; ai < 2; ++ai)
#pragma unroll
                for (int m = 0; m < 4; ++m) {
                    const f32x4 v0 = acc[ai][bj][m][0] + b0, v1 = acc[ai][bj][m][1] + b1;
                    u32x4 w; w.x = cvtpk(v0[0], v0[1]); w.y = cvtpk(v0[2], v0[3]); w.z = cvtpk(v1[0], v1[1]); w.w = cvtpk(v1[2], v1[3]);
                    *(u32x4*)(Y + (size_t)(u.pm * 256 + ai * 128 + wr * 64 + m * 16 + fr) * 1024 + c) = w;
                }
        }
    }
};
struct Frame {
    LAS unsigned char* lds; unsigned* ctl; unsigned char* ws; int tid, lane, wid; int G, bid;
};
struct MoeOrder {
    const LAS int* tstart; int sh; bool gather; const int* tokof; const LAS int* tokbuf; const LAS int* ulist; unsigned pitch;
    static DI void build(Frame& F, const LAS int* tstart, int nNt, LAS int* ulist) {
        __syncthreads();
        const int nwg = tstart[32] * nNt;
        if (F.tid == 0) ulist[0] = 0;
        __syncthreads();
        if (F.tid < 24) {
            const long L = (long)F.tid * F.G + F.bid;
            if (L < nwg) {
                int wgid = (int)L; { const int q = nwg / 8, r = nwg % 8, xcd = wgid % 8, off = wgid / 8; wgid = (xcd < r ? xcd * (q + 1) : r * (q + 1) + (xcd - r) * q) + off; }
                int e = 0;
                for (int k = 1; k < 32; ++k) if (tstart[k] * nNt <= wgid) e = k;
                const int rem = wgid - tstart[e] * nNt, nte = tstart[e + 1] - tstart[e];
                const int ct = rem / nte, rt = rem % nte;
                ulist[4 + 4 * F.tid] = tstart[e] + rt; ulist[5 + 4 * F.tid] = e * nNt + ct; ulist[6 + 4 * F.tid] = e; ulist[7 + 4 * F.tid] = rt;
                __hip_atomic_fetch_add(ulist, 1, __ATOMIC_RELAXED, __HIP_MEMORY_SCOPE_WORKGROUP);
            }
        }
        __syncthreads();
    }
    DI bool next(int i, pg8::Unit& u) const {
        if (i >= ulist[0]) return false;
        u.pm = ulist[4 + 4 * i]; u.pn = ulist[5 + 4 * i]; return true;
    }
    DI unsigned a_off(const pg8::Unit& u, int r) const {
        if (!gather) return (unsigned)(u.pm * 256 + r) * pitch;
        const int e = u.pn >> sh, idx = (u.pm - tstart[e]) * 256 + r;
        const int t = idx < tstart[80 + e] ? tokof[(size_t)e * T + idx] : 0;
        return (unsigned)t * pitch;
    }
    DI void prefetch(const pg8::Unit& u, int slot, int wid, int lane) const {
        if (gather && wid == 0) {
            const int e = u.pn >> sh, rt = u.pm - tstart[e];
            __builtin_amdgcn_global_load_lds((const unsigned*)(tokof + (size_t)e * T + rt * 256 + vlane() * 4), (LAS unsigned*)((LAS unsigned char*)tokbuf + slot * 1024), 16, 0, 0);
        }
    }
    DI unsigned a_off_pf(const pg8::Unit& u, int r, int slot) const {
        if (!gather) return (unsigned)(u.pm * 256 + r) * pitch;
        const int e = u.pn >> sh, idx = (u.pm - tstart[e]) * 256 + r;
        const int t = idx < tstart[80 + e] ? tokbuf[slot * 256 + r] : 0;
        return (unsigned)t * pitch;
    }
    DI void a_ready(const pg8::Unit&) const {}
    DI void done(const pg8::Unit&) const {}
};

DI int crow(int r, int hi) { return (r & 3) + 8 * (r >> 2) + 4 * hi; }
template <int DK, bool FOX, bool ROPEQ>
DI void attn_unit(LAS unsigned char* lds, const bf16_t* Q, int ldq, const bf16_t* Kp, int ldk, const bf16_t* Vt, int ldv,
                  const float* cum, bf16_t* O, int ldo, int q0, int ntiles, bool causal, const int* pos, const int wid, const float* kn2 = nullptr) {
    constexpr int PK = DK * 2 + 16, KBYTES = 64 * PK, VBYTES = 64 * 136, BUF = KBYTES + VBYTES + 256, KCH = DK / 8, NS = DK / 16;
    const int lane = vlane(), tid = wid * 64 + lane, r32 = lane & 31, hi = lane >> 5;
    const int qw0 = q0 + wid * 32, qrow = qw0 + r32;
    bf16x8 qf[NS];
#pragma unroll
    for (int s = 0; s < NS; ++s) qf[s] = *(const bf16x8*)(Q + (size_t)qrow * ldq + 16 * s + 8 * hi);
    if constexpr (ROPEQ) {
        const float p = (float)pos[qrow];
#pragma unroll
        for (int j = 0; j < 8; ++j) {
            const int i = 8 * hi + j;
            const float inv = exp2f(-(float)i * (13.287712379549449f / 16.0f));
            float sn, cs; sincos_cw(p * inv, sn, cs);
            const float x1 = bf2f((unsigned short)qf[4][j]), x2 = bf2f((unsigned short)qf[5][j]);
            const float o1 = x1 * cs - x2 * sn, o2 = x1 * sn + x2 * cs;
            qf[4][j] = (short)(cvtpk(o1, 0.f) & 0xffffu); qf[5][j] = (short)(cvtpk(o2, 0.f) & 0xffffu);
        }
    }
    const float cq = FOX ? cum[qrow] : 0.f;
    int jstart = 0; float prune_c = 0.f;
    if constexpr (FOX) {
        LAS float* red = (LAS float*)(lds + 2 * BUF);
        float ss = 0.f;
#pragma unroll
        for (int s = 0; s < NS; ++s)
#pragma unroll
            for (int j = 0; j < 8; ++j) { const float v = bf2f((unsigned short)qf[s][j]); ss += v * v; }
        ss += __shfl_xor(ss, 32);
        ss = wave_max(ss);
        float kk = 0.f;
        for (int j = tid; j < ntiles; j += NTHREADS) kk = fmaxf(kk, kn2[j]);
        kk = wave_max(kk);
        __syncthreads();
        if (lane == 0) { red[wid] = ss; red[8 + wid] = kk; }
        __syncthreads();
        float qm = red[0], km = red[8];
#pragma unroll
        for (int w = 1; w < 8; ++w) { qm = fmaxf(qm, red[w]); km = fmaxf(km, red[8 + w]); }
        prune_c = 2.0f * sqrtf(qm * km) * 1.01f + 65.0f;
        const float cq0 = cum[q0];
        int cand = ntiles;
        for (int j = tid; j < ntiles; j += NTHREADS) if (cq0 - cum[64 * j + 63] + prune_c >= 0.f) cand = min(cand, j);
#pragma unroll
        for (int o = 1; o < 64; o <<= 1) cand = min(cand, __shfl_xor(cand, o));
        __syncthreads();
        if (lane == 0) ((LAS int*)red)[16 + wid] = cand;
        __syncthreads();
        jstart = ((LAS int*)red)[16];
#pragma unroll
        for (int w = 1; w < 8; ++w) jstart = min(jstart, ((LAS int*)red)[16 + w]);
        jstart = min(jstart, ntiles - 4);
        __syncthreads();
    }
    const float cqw0 = FOX ? __shfl(cq, 0) : 0.f;
    f32x16 o0, o1;
#pragma unroll
    for (int r = 0; r < 16; ++r) { o0[r] = 0.f; o1[r] = 0.f; }
    float mrun = -1e30f, lrun = 0.f;
    const int kr0 = tid / KCH, kc0 = tid % KCH;
    const int kr1 = (tid + 512) / KCH, kc1 = (tid + 512) % KCH;
    const bool k2 = (DK == 96) && (tid < 256);
    const int vd = tid >> 3, vc = tid & 7;
    u32x4 kreg0, kreg1 = (u32x4){0, 0, 0, 0}, vreg; float creg = 0.f;
#define ATT_GLOAD(j) do { \
        kreg0 = *(const u32x4*)(Kp + (size_t)(64 * (j) + kr0) * ldk + kc0 * 8); \
        if (k2) kreg1 = *(const u32x4*)(Kp + (size_t)(64 * (j) + kr1) * ldk + kc1 * 8); \
        vreg = *(const u32x4*)(Vt + (size_t)vd * ldv + 64 * (j) + vc * 8); \
        if (FOX && tid < 64) creg = cum[64 * (j) + tid]; } while (0)
#define ATT_LWRITE(buf) do { LAS unsigned char* bb_ = lds + (buf) * BUF; \
        *(LAS u32x4*)(bb_ + kr0 * PK + kc0 * 16) = kreg0; \
        if (k2) *(LAS u32x4*)(bb_ + kr1 * PK + kc1 * 16) = kreg1; \
        *(LAS u32x2*)(bb_ + KBYTES + vd * 136 + vc * 16) = (u32x2){vreg.x, vreg.y}; \
        *(LAS u32x2*)(bb_ + KBYTES + vd * 136 + vc * 16 + 8) = (u32x2){vreg.z, vreg.w}; \
        if (FOX && tid < 64) *(LAS float*)(bb_ + KBYTES + VBYTES + tid * 4) = creg; } while (0)
    ATT_GLOAD(jstart); ATT_LWRITE(0); __syncthreads();
    for (int j = jstart; j < ntiles; ++j) {
        const int cur = (j - jstart) & 1;
        if (j + 1 < ntiles) ATT_GLOAD(j + 1);
        const LAS unsigned char* kb = lds + cur * BUF; const LAS unsigned char* vb = kb + KBYTES; const LAS unsigned char* cb = vb + VBYTES;
        bool active = !causal || (64 * j <= qw0 + 31);
        if constexpr (FOX) { if (cqw0 - *(const LAS float*)(cb + 63 * 4) + prune_c < 0.f) active = false; }
        if (active) {
            f32x16 sp0, sp1;
#pragma unroll
            for (int r = 0; r < 16; ++r) { sp0[r] = 0.f; sp1[r] = 0.f; }
#pragma unroll
            for (int s = 0; s < NS; ++s) {
                const bf16x8 k0 = *(const LAS bf16x8*)(kb + r32 * PK + 32 * s + 16 * hi);
                const bf16x8 k1 = *(const LAS bf16x8*)(kb + (32 + r32) * PK + 32 * s + 16 * hi);
                sp0 = __builtin_amdgcn_mfma_f32_32x32x16_bf16(k0, qf[s], sp0, 0, 0, 0);
                sp1 = __builtin_amdgcn_mfma_f32_32x32x16_bf16(k1, qf[s], sp1, 0, 0, 0);
            }
            __builtin_amdgcn_sched_barrier(0);
            if constexpr (FOX) {
#pragma unroll
                for (int g = 0; g < 4; ++g) {
                    const f32x4 c0 = *(const LAS f32x4*)(cb + (8 * g + 4 * hi) * 4);
                    const f32x4 c1 = *(const LAS f32x4*)(cb + (32 + 8 * g + 4 * hi) * 4);
#pragma unroll
                    for (int i = 0; i < 4; ++i) { sp0[4 * g + i] += cq - c0[i]; sp1[4 * g + i] += cq - c1[i]; }
                }
            }
            if (causal && (64 * j + 63 > qw0)) {
#pragma unroll
                for (int r = 0; r < 16; ++r) {
                    const int key = 64 * j + crow(r, hi);
                    if (key > qrow) sp0[r] = -1e30f;
                    if (key + 32 > qrow) sp1[r] = -1e30f;
                }
            }
            float mx = fmaxf(sp0[0], sp1[0]);
#pragma unroll
            for (int r = 1; r < 16; ++r) mx = fmaxf(mx, fmaxf(sp0[r], sp1[r]));
            mx = fmaxf(mx, __shfl_xor(mx, 32));
            const float mnew = fmaxf(mrun, mx);
            const float alpha = __builtin_amdgcn_exp2f(mrun - mnew);
            mrun = mnew;
            float ls = 0.f;
#pragma unroll
            for (int r = 0; r < 16; ++r) { sp0[r] = __builtin_amdgcn_exp2f(sp0[r] - mnew); sp1[r] = __builtin_amdgcn_exp2f(sp1[r] - mnew); ls += sp0[r] + sp1[r]; }
            lrun = lrun * alpha + ls;
#pragma unroll
            for (int r = 0; r < 16; ++r) { o0[r] *= alpha; o1[r] *= alpha; }
            __builtin_amdgcn_sched_barrier(0);
#pragma unroll
            for (int ks = 0; ks < 4; ++ks) {
                const int p = ks >> 1, s2 = ks & 1;
                u32x4 pw;
                if (p == 0) { pw.x = cvtpk(sp0[8 * s2 + 0], sp0[8 * s2 + 1]); pw.y = cvtpk(sp0[8 * s2 + 2], sp0[8 * s2 + 3]); pw.z = cvtpk(sp0[8 * s2 + 4], sp0[8 * s2 + 5]); pw.w = cvtpk(sp0[8 * s2 + 6], sp0[8 * s2 + 7]); }
                else        { pw.x = cvtpk(sp1[8 * s2 + 0], sp1[8 * s2 + 1]); pw.y = cvtpk(sp1[8 * s2 + 2], sp1[8 * s2 + 3]); pw.z = cvtpk(sp1[8 * s2 + 4], sp1[8 * s2 + 5]); pw.w = cvtpk(sp1[8 * s2 + 6], sp1[8 * s2 + 7]); }
                const bf16x8 pf = __builtin_bit_cast(bf16x8, pw);
                const int kbase = (32 * p + 16 * s2 + 4 * hi) * 2;
                {
                    const u32x2 lo = *(const LAS u32x2*)(vb + r32 * 136 + kbase), h2 = *(const LAS u32x2*)(vb + r32 * 136 + kbase + 16);
                    const bf16x8 vf = __builtin_bit_cast(bf16x8, (u32x4){lo.x, lo.y, h2.x, h2.y});
                    o0 = __builtin_amdgcn_mfma_f32_32x32x16_bf16(vf, pf, o0, 0, 0, 0);
                }
                {
                    const u32x2 lo = *(const LAS u32x2*)(vb + (32 + r32) * 136 + kbase), h2 = *(const LAS u32x2*)(vb + (32 + r32) * 136 + kbase + 16);
                    const bf16x8 vf = __builtin_bit_cast(bf16x8, (u32x4){lo.x, lo.y, h2.x, h2.y});
                    o1 = __builtin_amdgcn_mfma_f32_32x32x16_bf16(vf, pf, o1, 0, 0, 0);
                }
            }
        }
        if (j + 1 < ntiles) ATT_LWRITE(cur ^ 1);
        __syncthreads();
    }
#undef ATT_GLOAD
#undef ATT_LWRITE
    const float ltot = lrun + __shfl_xor(lrun, 32);
    const float inv = 1.0f / ltot;
#pragma unroll
    for (int g = 0; g < 4; ++g) {
        const int d0 = 8 * g + 4 * hi;
        u32x2 w0, w1;
        w0.x = cvtpk(o0[4 * g] * inv, o0[4 * g + 1] * inv); w0.y = cvtpk(o0[4 * g + 2] * inv, o0[4 * g + 3] * inv);
        w1.x = cvtpk(o1[4 * g] * inv, o1[4 * g + 1] * inv); w1.y = cvtpk(o1[4 * g + 2] * inv, o1[4 * g + 3] * inv);
        *(u32x2*)(O + (size_t)qrow * ldo + d0) = w0;
        *(u32x2*)(O + (size_t)qrow * ldo + 32 + d0) = w1;
    }
}


template <int DK, bool ROPEQ>
DI void attn_unit_pipe(LAS unsigned char* lds, const bf16_t* Q, int ldq, const bf16_t* Kp, int ldk, const bf16_t* Vt, int ldv,
                       bf16_t* O, int ldo, int q0, int ntiles, const int* pos, const int wid) {
    constexpr int PK = DK * 2 + 16, KBYTES = 64 * PK, VBYTES = 64 * 136, KCH = DK / 8, NS = DK / 16, VOFF = 2 * KBYTES;
    constexpr float THR = 6.0f;
    const int lane = vlane(), tid = wid * 64 + lane, r32 = lane & 31, hi = lane >> 5;
    const int qw0 = q0 + wid * 32, qrow = qw0 + r32;
    bf16x8 qf[NS];
#pragma unroll
    for (int s = 0; s < NS; ++s) qf[s] = *(const bf16x8*)(Q + (size_t)qrow * ldq + 16 * s + 8 * hi);
    if constexpr (ROPEQ) {
        const float p = (float)pos[qrow];
#pragma unroll
        for (int j = 0; j < 8; ++j) {
            const int i = 8 * hi + j;
            const float inv = exp2f(-(float)i * (13.287712379549449f / 16.0f));
            float sn, cs; sincos_cw(p * inv, sn, cs);
            const float x1 = bf2f((unsigned short)qf[NS - 2][j]), x2 = bf2f((unsigned short)qf[NS - 1][j]);
            const float o1 = x1 * cs - x2 * sn, o2 = x1 * sn + x2 * cs;
            qf[NS - 2][j] = (short)(cvtpk(o1, 0.f) & 0xffffu); qf[NS - 1][j] = (short)(cvtpk(o2, 0.f) & 0xffffu);
        }
    }
    const int kr0 = tid / KCH, kc0 = tid % KCH;
    const int kr1 = (tid + 512) / KCH, kc1 = (tid + 512) % KCH;
    const bool k2 = (DK == 96) && (tid < 256);
    const int vd = tid >> 3, vc = tid & 7;
    const int kfo = r32 * PK + 16 * hi;
    const int vfo = VOFF + r32 * 136 + 8 * hi;
    u32x4 kA0, kA1 = (u32x4){0, 0, 0, 0}, vA, kB0, kB1 = (u32x4){0, 0, 0, 0}, vB;
#define SBAR() __builtin_amdgcn_sched_barrier(0)
#define AP_LOADK(j, R0, R1) do { R0 = *(const u32x4*)(Kp + (size_t)(64 * (j) + kr0) * ldk + kc0 * 8); \
        if (k2) R1 = *(const u32x4*)(Kp + (size_t)(64 * (j) + kr1) * ldk + kc1 * 8); } while (0)
#define AP_LOADV(j, RV) do { RV = *(const u32x4*)(Vt + (size_t)vd * ldv + 64 * (j) + vc * 8); } while (0)
#define AP_WRITEK(buf, R0, R1) do { LAS unsigned char* bb_ = lds + (buf) * KBYTES; *(LAS u32x4*)(bb_ + kr0 * PK + kc0 * 16) = R0; \
        if (k2) *(LAS u32x4*)(bb_ + kr1 * PK + kc1 * 16) = R1; } while (0)
#define AP_WRITEV(buf, RV) do { LAS unsigned char* bb_ = lds + VOFF + (buf) * VBYTES; \
        *(LAS u32x2*)(bb_ + vd * 136 + vc * 16) = (u32x2){RV.x, RV.y}; *(LAS u32x2*)(bb_ + vd * 136 + vc * 16 + 8) = (u32x2){RV.z, RV.w}; } while (0)
#define AP_KF(dst0, dst1, kbuf, s) do { dst0 = *(const LAS bf16x8*)(lds + (kbuf) * KBYTES + kfo + 32 * (s)); dst1 = *(const LAS bf16x8*)(lds + (kbuf) * KBYTES + kfo + 32 * PK + 32 * (s)); } while (0)
#define AP_VF(dst0, dst1, vbuf, ks) do { const LAS unsigned char* p_ = lds + (vbuf) * VBYTES + vfo + (32 * ((ks) >> 1) + 16 * ((ks) & 1)) * 2; \
        const u32x2 a_ = *(const LAS u32x2*)(p_), b_ = *(const LAS u32x2*)(p_ + 16), c_ = *(const LAS u32x2*)(p_ + 32 * 136), d_ = *(const LAS u32x2*)(p_ + 32 * 136 + 16); \
        dst0 = __builtin_bit_cast(bf16x8, (u32x4){a_.x, a_.y, b_.x, b_.y}); dst1 = __builtin_bit_cast(bf16x8, (u32x4){c_.x, c_.y, d_.x, d_.y}); } while (0)
#define AP_MFMA(a, b, c) __builtin_amdgcn_mfma_f32_32x32x16_bf16(a, b, c, 0, 0, 0)
#define AP_MASK(S0, S1, t) do { _Pragma("unroll") for (int r_ = 0; r_ < 16; ++r_) { const int key_ = 64 * (t) + crow(r_, hi); \
        if (key_ > qrow) S0[r_] = -1e30f; if (key_ + 32 > qrow) S1[r_] = -1e30f; } } while (0)
#define AP_ROWMAX(S0, S1, out) do { float a_ = fmaxf(fmaxf(S0[0], S1[0]), S0[1]), b_ = fmaxf(fmaxf(S1[1], S0[2]), S1[2]); \
        _Pragma("unroll") for (int r_ = 3; r_ < 15; r_ += 2) { a_ = fmaxf(fmaxf(a_, S0[r_]), S1[r_]); b_ = fmaxf(fmaxf(b_, S0[r_ + 1]), S1[r_ + 1]); } \
        a_ = fmaxf(fmaxf(a_, S0[15]), S1[15]); a_ = fmaxf(a_, b_); out = fmaxf(a_, __shfl_xor(a_, 32)); } while (0)
    f32x16 o0, o1, pa0, pa1, sb0, sb1;
#pragma unroll
    for (int r = 0; r < 16; ++r) { o0[r] = 0.f; o1[r] = 0.f; }
    float mref = 0.f, lrun = 0.f;
    bf16x8 pf[4];
    bf16x8 fa0, fa1, fb0, fb1;
    AP_LOADK(0, kA0, kA1); AP_LOADV(0, vA); AP_WRITEK(0, kA0, kA1); AP_WRITEV(0, vA);
    AP_LOADK(1, kA0, kA1); AP_WRITEK(1, kA0, kA1);
    AP_LOADK(2, kA0, kA1); AP_LOADV(1, vA);
    __syncthreads();
#pragma unroll
    for (int r = 0; r < 16; ++r) { pa0[r] = 0.f; pa1[r] = 0.f; }
#pragma unroll
    for (int s = 0; s < NS; ++s) { AP_KF(fa0, fa1, 0, s); pa0 = AP_MFMA(fa0, qf[s], pa0); pa1 = AP_MFMA(fa1, qf[s], pa1); }
    if (ntiles == 4) AP_MASK(pa0, pa1, 0);
    { float mx; AP_ROWMAX(pa0, pa1, mx); mref = mx;
#pragma unroll
      for (int r = 0; r < 16; ++r) { pa0[r] = __builtin_amdgcn_exp2f(pa0[r] - mx); pa1[r] = __builtin_amdgcn_exp2f(pa1[r] - mx); } }
    __syncthreads();
    f32x16 negm;
#pragma unroll
    for (int r = 0; r < 16; ++r) negm[r] = -mref;
    asm volatile("" : "+v"(negm));
#define AP_STEPA(s, X0, X1, Y0, Y1, VALU) do { if ((s) + 1 < NS) AP_KF(Y0, Y1, kb_, (s) + 1); else AP_VF(Y0, Y1, vb_, 0); \
        if ((s) == 0) { sb0 = AP_MFMA(X0, qf[s], negm); sb1 = AP_MFMA(X1, qf[s], negm); } else { sb0 = AP_MFMA(X0, qf[s], sb0); sb1 = AP_MFMA(X1, qf[s], sb1); } VALU; SBAR(); } while (0)
#define AP_PK(i, P, b) pw_[i] = (u32x4){cvtpk(P[b], P[b + 1]), cvtpk(P[b + 2], P[b + 3]), cvtpk(P[b + 4], P[b + 5]), cvtpk(P[b + 6], P[b + 7])}; \
        ls0_ = fadd_s(ls0_, fadd_s(fadd_s(P[b], P[b + 1]), fadd_s(P[b + 2], P[b + 3]))); ls1_ = fadd_s(ls1_, fadd_s(fadd_s(P[b + 4], P[b + 5]), fadd_s(P[b + 6], P[b + 7]))); asm volatile("" : "+v"(pw_[i]), "+v"(ls0_), "+v"(ls1_))
#define AP_EXP4(P, S, b) do { P[b] = __builtin_amdgcn_exp2f(S[b]); P[b + 1] = __builtin_amdgcn_exp2f(S[b + 1]); P[b + 2] = __builtin_amdgcn_exp2f(S[b + 2]); P[b + 3] = __builtin_amdgcn_exp2f(S[b + 3]); asm volatile("" : "+v"(P)); } while (0)
#define AP_STEPB(ks, X0, X1, Y0, Y1, E0, E1) do { if ((ks) + 1 < 4) AP_VF(Y0, Y1, vb_, (ks) + 1); \
        o0 = AP_MFMA(X0, pf[ks], o0); E0; SBAR(); o1 = AP_MFMA(X1, pf[ks], o1); E1; SBAR(); } while (0)
#define AP_ITER(t, MASKED, WK0, WK1, WV, LK0, LK1, LV) do {     \
        const int kb_ = (t) & 1, vb_ = ((t) - 1) & 1; \
        if ((t) + 2 < ntiles) AP_LOADK((t) + 2, LK0, LK1); \
        if ((t) + 1 < ntiles) AP_LOADV((t) + 1, LV); \
        u32x4 pw_[4]; float ls0_ = 0.f, ls1_ = 0.f; \
        AP_KF(fa0, fa1, kb_, 0); SBAR(); \
        AP_STEPA(0, fa0, fa1, fb0, fb1, AP_PK(0, pa0, 0)); \
        AP_STEPA(1, fb0, fb1, fa0, fa1, AP_PK(1, pa0, 8)); \
        AP_STEPA(2, fa0, fa1, fb0, fb1, AP_PK(2, pa1, 0)); \
        AP_STEPA(3, fb0, fb1, fa0, fa1, AP_PK(3, pa1, 8)); \
        if (NS == 6) { AP_STEPA(4, fa0, fa1, fb0, fb1, (void)0); AP_STEPA(5, fb0, fb1, fa0, fa1, (void)0); } \
        lrun += ls0_ + ls1_; \
        pf[0] = __builtin_bit_cast(bf16x8, pw_[0]); pf[1] = __builtin_bit_cast(bf16x8, pw_[1]); pf[2] = __builtin_bit_cast(bf16x8, pw_[2]); pf[3] = __builtin_bit_cast(bf16x8, pw_[3]); \
        if ((t) >= ntiles - 4) AP_MASK(sb0, sb1, t); \
        float mx_; AP_ROWMAX(sb0, sb1, mx_); \
        float resc_ = 1.0f; bool do_resc_ = false; \
        if (__any(mx_ > THR)) { const float dl_ = fmaxf(mx_, 0.f); mref += dl_; \
            _Pragma("unroll") for (int r_ = 0; r_ < 16; ++r_) { sb0[r_] -= dl_; sb1[r_] -= dl_; negm[r_] = -mref; } \
            asm volatile("" : "+v"(negm)); \
            resc_ = __builtin_amdgcn_exp2f(-dl_); lrun *= resc_; do_resc_ = true; } \
        SBAR(); \
        AP_STEPB(0, fa0, fa1, fb0, fb1, AP_EXP4(pa0, sb0, 0), AP_EXP4(pa0, sb0, 4)); \
        AP_STEPB(1, fb0, fb1, fa0, fa1, AP_EXP4(pa0, sb0, 8), AP_EXP4(pa0, sb0, 12)); \
        AP_STEPB(2, fa0, fa1, fb0, fb1, AP_EXP4(pa1, sb1, 0), AP_EXP4(pa1, sb1, 4)); \
        AP_STEPB(3, fb0, fb1, fa0, fa1, AP_EXP4(pa1, sb1, 8), AP_EXP4(pa1, sb1, 12)); \
        if (do_resc_) { asm volatile("" ::: "memory"); _Pragma("unroll") for (int r_ = 0; r_ < 16; ++r_) { o0[r_] *= resc_; o1[r_] *= resc_; } asm volatile("" : "+v"(o0), "+v"(o1)); } \
        if ((t) + 1 < ntiles) AP_WRITEK(((t) + 1) & 1, WK0, WK1); \
        AP_WRITEV((t) & 1, WV); \
        __syncthreads(); } while (0)
    static_assert(NS == 4 || NS == 6, "head dim 64 or 96");
    if (wid >= 4) __builtin_amdgcn_s_setprio(1);
    int t = 1;
    for (; t + 1 < ntiles; t += 2) { AP_ITER(t, 1, kA0, kA1, vA, kB0, kB1, vB); AP_ITER(t + 1, 1, kB0, kB1, vB, kA0, kA1, vA); }
    AP_ITER(t, 1, kA0, kA1, vA, kB0, kB1, vB);
    {
        u32x4 pw_[4]; float ls0_ = 0.f, ls1_ = 0.f;
        AP_PK(0, pa0, 0); AP_PK(1, pa0, 8); AP_PK(2, pa1, 0); AP_PK(3, pa1, 8);
        lrun += ls0_ + ls1_;
        pf[0] = __builtin_bit_cast(bf16x8, pw_[0]); pf[1] = __builtin_bit_cast(bf16x8, pw_[1]); pf[2] = __builtin_bit_cast(bf16x8, pw_[2]); pf[3] = __builtin_bit_cast(bf16x8, pw_[3]);
        const int vb_ = (ntiles - 1) & 1;
#pragma unroll
        for (int ks = 0; ks < 4; ++ks) { AP_VF(fa0, fa1, vb_, ks); o0 = AP_MFMA(fa0, pf[ks], o0); o1 = AP_MFMA(fa1, pf[ks], o1); }
    }
    const float ltot = lrun + __shfl_xor(lrun, 32);
    const float inv = 1.0f / ltot;
#pragma unroll
    for (int g = 0; g < 4; ++g) {
        const int d0 = 8 * g + 4 * hi;
        u32x2 w0, w1;
        w0.x = cvtpk(o0[4 * g] * inv, o0[4 * g + 1] * inv); w0.y = cvtpk(o0[4 * g + 2] * inv, o0[4 * g + 3] * inv);
        w1.x = cvtpk(o1[4 * g] * inv, o1[4 * g + 1] * inv); w1.y = cvtpk(o1[4 * g + 2] * inv, o1[4 * g + 3] * inv);
        *(u32x2*)(O + (size_t)qrow * ldo + d0) = w0;
        *(u32x2*)(O + (size_t)qrow * ldo + 32 + d0) = w1;
    }
    __syncthreads();
#undef SBAR
#undef AP_LOADK
#undef AP_LOADV
#undef AP_WRITEK
#undef AP_WRITEV
#undef AP_KF
#undef AP_VF
#undef AP_MFMA
#undef AP_MASK
#undef AP_ROWMAX
#undef AP_STEPA
#undef AP_PK
#undef AP_EXP4
#undef AP_STEPB
#undef AP_ITER
}

#define XB_TMO      128
#define XB_XCNT(j)  (256  + 64 * (j))
#define XB_XSUB(j)  (1280 + 64 * (j))
#define XB_XGEN(j)  (2304 + 64 * (j))
#define XB_TOP      3328
#define XB_TOPGEN   3392
#define XCD_BAR_WORDS 3456
#define XB_SPIN_CAP (1u << 18)
DI unsigned xb_ld(unsigned* p) { return __hip_atomic_load(p, __ATOMIC_RELAXED, __HIP_MEMORY_SCOPE_AGENT); }
DI unsigned xb_add(unsigned* p, unsigned v) { return __hip_atomic_fetch_add(p, v, __ATOMIC_RELAXED, __HIP_MEMORY_SCOPE_AGENT); }
DI unsigned xb_xcc_id() { return (unsigned)__builtin_amdgcn_s_getreg((3 << 11) | 20) & 0xFu; }
#define XB_SPIN(cond, bar) do { unsigned _sp = 0; while (cond) { __builtin_amdgcn_s_sleep(1); \
    if ((++_sp & 255u) == 0u) { if (xb_ld(&(bar)[XB_TMO])) break; if (_sp > XB_SPIN_CAP) { atomicAdd(&(bar)[XB_TMO], 1u); break; } } } } while (0)
struct XcdBarrier { unsigned* bar; unsigned x; volatile LAS unsigned* st; int wid; };
DI XcdBarrier xcd_barrier_post(unsigned* bar, volatile LAS unsigned* st, int wid) {
    XcdBarrier b; b.bar = bar; b.x = xb_xcc_id(); b.st = st; b.wid = wid;
    if (wid == 0 && vlane() == 0) (void)xb_add(&bar[XB_XCNT(b.x)], 1u);
    return b;
}
DI void xcd_barrier_complete(unsigned* bar, unsigned x, unsigned& nloc, unsigned& nx) {
    const unsigned G = gridDim.x * gridDim.y * gridDim.z;
    unsigned sum, cnt, mine, sp = 0u;
    for (;;) {
        sum = 0u; cnt = 0u; mine = 0u;
#pragma unroll
        for (unsigned j = 0; j < 16; ++j) { const unsigned c = xb_ld(&bar[XB_XCNT(j)]); sum += c; cnt += (c > 0u) ? 1u : 0u; mine = (j == x) ? c : mine; }
        if (sum == G) break;
        __builtin_amdgcn_s_sleep(1);
        if ((++sp & 255u) == 0u) { if (xb_ld(&bar[XB_TMO])) break; if (sp > XB_SPIN_CAP) { atomicAdd(&bar[XB_TMO], 1u); break; } }
    }
    nloc = mine > 0u ? mine : 1u; nx = cnt > 0u ? cnt : 1u;
}
DI void xcd_barrier(const XcdBarrier& b) {
    asm volatile("s_waitcnt vmcnt(0)" ::: "memory");
    __syncthreads();
    if (b.wid == 0 && vlane() == 0) {
        unsigned* bar = b.bar;
        __builtin_amdgcn_s_waitcnt(0);
        unsigned nloc = b.st[0], nx = b.st[1];
        if (nloc == 0u) { xcd_barrier_complete(bar, b.x, nloc, nx); b.st[0] = nloc; b.st[1] = nx; }
        const unsigned old = xb_add(&bar[XB_XSUB(b.x)], 1u);
        const unsigned gen = old / nloc;
        if (old + 1u == (gen + 1u) * nloc) {
            __builtin_amdgcn_fence(__ATOMIC_RELEASE, "agent");
            asm volatile("s_waitcnt vmcnt(0)" ::: "memory");
            const unsigned og = xb_add(&bar[XB_TOP], 1u);
            const unsigned tg = og / nx;
            if (og + 1u == (tg + 1u) * nx) xb_add(&bar[XB_TOPGEN], 1u);
            else XB_SPIN(xb_ld(&bar[XB_TOPGEN]) == tg, bar);
            __builtin_amdgcn_fence(__ATOMIC_ACQUIRE, "agent");
            xb_add(&bar[XB_XGEN(b.x)], 1u);
            asm volatile("s_waitcnt vmcnt(0)" ::: "memory");
        } else {
            XB_SPIN(xb_ld(&bar[XB_XGEN(b.x)]) == gen, bar);
            __builtin_amdgcn_fence(__ATOMIC_ACQUIRE, "agent");
            asm volatile("s_waitcnt vmcnt(0)" ::: "memory");
        }
    }
    __syncthreads();
}

DI int next_unit(Frame& F, int widx) {
    LAS int* s = (LAS int*)(F.lds + LDS_CTL);
    __syncthreads();
    if (F.tid == 0) *s = (int)atomicAdd(F.ctl + CW_WORK + 64 * widx, 1u);
    __syncthreads();
    return *s;
}

DI void transpose_item(const float* W, int ldw, int srccol, int K, bf16_t* WT, int drow, LAS unsigned* scr, int k0, int lane, int nvalid) {
    const int n4 = lane & 15, kq = lane >> 4;
#pragma unroll 8
    for (int i = 0; i < 16; ++i) {
        const int kk = 4 * i + kq;
        f32x4 v = (f32x4){0.f, 0.f, 0.f, 0.f};
        if (4 * n4 < nvalid) v = *(const f32x4*)(W + (size_t)(k0 + kk) * ldw + srccol + 4 * n4);
        scr[kk * 33 + 2 * n4] = cvtpk(v[0], v[1]); scr[kk * 33 + 2 * n4 + 1] = cvtpk(v[2], v[3]);
    }
    LDS_WAIT(); asm volatile("" ::: "memory");
    const int c = lane & 7;
    const LAS unsigned short* s16 = (const LAS unsigned short*)scr;
#pragma unroll
    for (int j = 0; j < 8; ++j) {
        const int n = (lane >> 3) + 8 * j;
        const LAS unsigned short* sp = s16 + (8 * c) * 66 + n;
        u32x4 o;
        o.x = (unsigned)sp[0 * 66] | ((unsigned)sp[1 * 66] << 16); o.y = (unsigned)sp[2 * 66] | ((unsigned)sp[3 * 66] << 16);
        o.z = (unsigned)sp[4 * 66] | ((unsigned)sp[5 * 66] << 16); o.w = (unsigned)sp[6 * 66] | ((unsigned)sp[7 * 66] << 16);
        if (n < nvalid) *(u32x4*)(WT + (size_t)(drow + n) * K + k0 + 8 * c) = o;
    }
    LDS_WAIT(); asm volatile("" ::: "memory");
}
DI unsigned q8x4(float a, float b, float c, float d, float inv) {
    const float M = 12582912.0f;
    const unsigned ua = __float_as_uint(fmaf(a, inv, M)), ub = __float_as_uint(fmaf(b, inv, M)), uc = __float_as_uint(fmaf(c, inv, M)), ud = __float_as_uint(fmaf(d, inv, M));
    return __builtin_amdgcn_perm(ub, ua, 0x0c0c0400u) | __builtin_amdgcn_perm(ud, uc, 0x04000c0cu);
}
template <int QM>
DI void strip_item(const float* W, int ldw, int n0, unsigned char* dst, float* sc, LAS float* red, int tid) {
    const int c4 = tid & 15, kr = tid >> 4;
    const float* src = W + (size_t)(kr * 32) * ldw + n0 + 4 * c4;
    f32x4 v[32];
#pragma unroll
    for (int p = 0; p < 32; ++p) v[p] = *(const f32x4*)(src + (size_t)p * ldw);
    if constexpr (QM == 0) {
        f32x4 m = (f32x4){0.f, 0.f, 0.f, 0.f};
#pragma unroll
        for (int p = 0; p < 32; ++p)
#pragma unroll
            for (int j = 0; j < 4; ++j) m[j] = fmaxf(m[j], fabsf(v[p][j]));
#pragma unroll
        for (int j = 0; j < 4; ++j) { m[j] = fmaxf(m[j], __shfl_xor(m[j], 16)); m[j] = fmaxf(m[j], __shfl_xor(m[j], 32)); }
        __syncthreads();
        if ((tid & 63) < 16) *(LAS f32x4*)(red + (tid >> 6) * 64 + 4 * c4) = m;
        __syncthreads();
#pragma unroll
        for (int w = 0; w < 8; ++w) { const f32x4 o = *(const LAS f32x4*)(red + w * 64 + 4 * c4);
#pragma unroll
            for (int j = 0; j < 4; ++j) m[j] = fmaxf(m[j], o[j]); }
        if (kr == 0) *(f32x4*)(sc + 4 * c4) = m * (1.0f / 127.0f);
#pragma unroll
        for (int j = 0; j < 4; ++j) {
            const float inv = m[j] > 0.f ? 127.0f / m[j] : 0.f;
            u32x4 w0, w1;
            w0.x = q8x4(v[0][j], v[1][j], v[2][j], v[3][j], inv); w0.y = q8x4(v[4][j], v[5][j], v[6][j], v[7][j], inv);
            w0.z = q8x4(v[8][j], v[9][j], v[10][j], v[11][j], inv); w0.w = q8x4(v[12][j], v[13][j], v[14][j], v[15][j], inv);
            w1.x = q8x4(v[16][j], v[17][j], v[18][j], v[19][j], inv); w1.y = q8x4(v[20][j], v[21][j], v[22][j], v[23][j], inv);
            w1.z = q8x4(v[24][j], v[25][j], v[26][j], v[27][j], inv); w1.w = q8x4(v[28][j], v[29][j], v[30][j], v[31][j], inv);
            u32x4* o = (u32x4*)(dst + (size_t)(4 * c4 + j) * 1024 + kr * 32);
            o[0] = w0; o[1] = w1;
        }
    } else {
#pragma unroll
        for (int j = 0; j < 4; ++j) {
            u32x4* o = (u32x4*)(dst + (size_t)(4 * c4 + j) * 2048 + kr * 64);
#pragma unroll
            for (int q = 0; q < 4; ++q) { u32x4 w; w.x = cvtpk(v[8 * q][j], v[8 * q + 1][j]); w.y = cvtpk(v[8 * q + 2][j], v[8 * q + 3][j]); w.z = cvtpk(v[8 * q + 4][j], v[8 * q + 5][j]); w.w = cvtpk(v[8 * q + 6][j], v[8 * q + 7][j]); o[q] = w; }
        }
    }
}
constexpr int CONV_P1 = 2, CONV_A0 = 3, CONV_GU = 3, CONV_DN = 2, CONV_A1 = 6;
constexpr int MOE_S_GU = 32, MOE_S_DN = 16, MOE_STRIPS_PER_LAYER = 32 * (MOE_S_GU + MOE_S_DN);
DI void moe_convert_strip(unsigned char* ws, LAS float* red, int l, int r, int tid) {
    if (r < 32 * MOE_S_GU) {
        const int e = l * 32 + r / MOE_S_GU, nb = r % MOE_S_GU;
        const int jj = (nb & 15) * 64, drow = (jj >> 7) * 256 + (nb >> 4) * 128 + (jj & 127);
        strip_item<0>(KP->moe_w_gu + (size_t)e * 1024 * 2048, 2048, 64 * nb, ws + WS_W_GU + ((size_t)e * 2048 + drow) * 1024, (float*)(ws + WS_SGU) + (size_t)e * 2048 + drow, red, tid);
    } else {
        r -= 32 * MOE_S_GU;
        const int e = l * 32 + r / MOE_S_DN, nb = r % MOE_S_DN;
        strip_item<1>(KP->moe_w_dn + (size_t)e * 1024 * 1024, 1024, 64 * nb, ws + WS_W_DN + ((size_t)e * 1024 + 64 * nb) * 2048, nullptr, red, tid);
    }
}
constexpr int CW_CONVQ = CW_WORK + 64 * 8;
DI bool conv_pull(Frame& F, int l, int n) {
    LAS int* s = (LAS int*)(F.lds + LDS_CTL + 8);
    __syncthreads();
    if (F.tid == 0) *s = (int)atomicAdd(F.ctl + CW_CONVQ + 64 * l, (unsigned)n);
    __syncthreads();
    const int base = *s;
    for (int c = base; c < base + n && c < MOE_STRIPS_PER_LAYER; ++c) moe_convert_strip(F.ws, (LAS float*)F.lds, l, c, F.tid);
    __syncthreads();
    return base + n < MOE_STRIPS_PER_LAYER;
}
struct TrMat { const float* W; int ldw, col0, K, N; bf16_t* WT; int drow0, mode; };

DI void phase_prologue(Frame& F, const Params& P) {
    F.lane = vlane(); F.tid = F.wid * 64 + F.lane;
    LAS unsigned* scr = (LAS unsigned*)(F.lds + F.wid * 8448);
    const int gw = F.bid * 8 + F.wid, NGW = F.G * 8;
    unsigned char* ws = F.ws;
    TrMat mats[11];
    mats[0] = TrMat{KP->a_w_in, FOX_IN, 0, 1024, 1536, (bf16_t*)(ws + WS_W_AIN), 0, 0};
    mats[1] = TrMat{KP->a_w_in, FOX_IN, 2316, 1024, 256, (bf16_t*)(ws + WS_W_AIN), 1536, 0};
    mats[2] = TrMat{KP->a_w_in, FOX_IN, 1536, 1024, 768, (bf16_t*)(ws + WS_W_AIN), 1792, 0};
    mats[3] = TrMat{KP->a_w_out, 1024, 0, 1024, 1024, (bf16_t*)(ws + WS_W_AOUT), 0, 0};
    mats[4] = TrMat{KP->kv_w_dkv, 288, 0, 1024, 288, (bf16_t*)(ws + WS_W_BIN), 0, 0};
    mats[5] = TrMat{KP->b_w_in, 640, 0, 1024, 640, (bf16_t*)(ws + WS_W_BIN), 288, 0};
    mats[6] = TrMat{KP->b_w_uq, 1152, 0, 384, 1152, (bf16_t*)(ws + WS_W_UQ), 0, 0};
    mats[7] = TrMat{KP->kv_w_ukv, 1536, 0, 256, 1536, (bf16_t*)(ws + WS_W_UKV), 0, 1};
    mats[8] = TrMat{KP->b_w_out, 1024, 0, 1024, 1024, (bf16_t*)(ws + WS_W_BOUT), 0, 0};
    mats[9] = TrMat{KP->mem_w_kv, 512, 0, 1024, 512, (bf16_t*)(ws + WS_W_MKV), 0, 0};
    mats[10] = TrMat{KP->mem_w_kv + (size_t)1024 * 512, 512, 0, 1024, 512, (bf16_t*)(ws + WS_W_MKV) + (size_t)512 * 1024, 0, 0};
    int nsmall = 0;
#pragma unroll
    for (int i = 0; i < 11; ++i) nsmall += (mats[i].K / 64) * ((mats[i].N + 63) / 64);
    const int ntot = nsmall;
    for (int it = gw; it < ntot; it += NGW) {
        int r = it;
        if (r < nsmall) {
#pragma unroll
            for (int i = 0; i < 11; ++i) {
                const int nblk = (mats[i].N + 63) / 64, ni = (mats[i].K / 64) * nblk;
                if (r >= 0 && r < ni) {
                    const int kb = r / nblk, nb = r % nblk;
                    const int drow = mats[i].mode == 1 ? ((nb & 1) * 768 + (nb >> 1) * 64) : (mats[i].drow0 + 64 * nb);
                    transpose_item(mats[i].W, mats[i].ldw, mats[i].col0 + 64 * nb, mats[i].K, mats[i].WT, drow, scr, 64 * kb, F.lane, mats[i].N - 64 * nb);
                }
                r -= ni;
            }
            continue;
        }
    }
    __syncthreads();
    LAS float* wf = (LAS float*)F.lds;
    for (int i = F.tid; i < 1024 * 12; i += NTHREADS) { const int k = i / 12, h = i % 12; wf[i] = KP->a_w_in[(size_t)k * FOX_IN + 2304 + h]; }
    __syncthreads();
    float* logf = (float*)(ws + WS_LOGF);
    bf16_t* xb = (bf16_t*)(ws + WS_XB);
    for (int row = gw; row < T; row += NGW) {
        const f32x4* xr = (const f32x4*)(KP->x + (size_t)row * DM) + F.lane;
        f32x4 v[4];
#pragma unroll
        for (int j = 0; j < 4; ++j) v[j] = xr[64 * j];
        u32x2* o8 = (u32x2*)(xb + (size_t)row * DM) + F.lane;
#pragma unroll
        for (int j = 0; j < 4; ++j) o8[64 * j] = (u32x2){cvtpk(v[j][0], v[j][1]), cvtpk(v[j][2], v[j][3])};
        float part[12];
#pragma unroll
        for (int h = 0; h < 12; ++h) part[h] = 0.f;
#pragma unroll
        for (int j = 0; j < 4; ++j)
#pragma unroll
            for (int i = 0; i < 4; ++i) {
                const int k = 4 * F.lane + 256 * j + i;
                const LAS f32x4* wp = (const LAS f32x4*)(wf + k * 12);
                const f32x4 w0 = wp[0], w1 = wp[1], w2 = wp[2];
                const float xv = v[j][i];
                part[0] += xv * w0[0]; part[1] += xv * w0[1]; part[2] += xv * w0[2]; part[3] += xv * w0[3];
                part[4] += xv * w1[0]; part[5] += xv * w1[1]; part[6] += xv * w1[2]; part[7] += xv * w1[3];
                part[8] += xv * w2[0]; part[9] += xv * w2[1]; part[10] += xv * w2[2]; part[11] += xv * w2[3];
            }
        float mine = 0.f;
#pragma unroll
        for (int h = 0; h < 12; ++h) { const float s = wave_sum(part[h]); if (F.lane == h) mine = s; }
        if (F.lane < 12) {
            const float z = mine + KP->a_b_f[F.lane];
            const float ls = fminf(z, 0.f) - log1pf(expf(-fabsf(z)));
            const int b = row / SEQ, s = row % SEQ;
            logf[(size_t)(b * NH + F.lane) * SEQ + s] = ls;
        }
    }
    {
        float* wrt = (float*)(ws + WS_WRT);
        bf16_t* wrh = (bf16_t*)(ws + WS_WRH); bf16_t* wrl = (bf16_t*)(ws + WS_WRL);
        for (int i = F.bid * NTHREADS + F.tid; i < 2 * 1024 * 32; i += F.G * NTHREADS) { const int l = i >> 15, k = (i >> 5) & 1023, e = i & 31; const float w = KP->moe_w_r[i];
            const unsigned hb = cvtpk(w, 0.f) & 0xffffu; const float hf = __uint_as_float(hb << 16);
            wrt[(size_t)(l * 32 + e) * 1024 + k] = w; wrh[(size_t)(l * 32 + e) * 1024 + k] = (bf16_t)hb; wrl[(size_t)(l * 32 + e) * 1024 + k] = (bf16_t)(cvtpk(w - hf, 0.f) & 0xffffu); }
    }
    bf16_t* memb = (bf16_t*)(ws + WS_MEMB);
    for (int row = gw; row < NB * NMEM; row += NGW) {
        const f32x4* xr = (const f32x4*)(KP->mem + (size_t)row * DM) + F.lane;
        u32x2* o8 = (u32x2*)(memb + (size_t)row * DM) + F.lane;
#pragma unroll
        for (int j = 0; j < 4; ++j) { const f32x4 v = xr[64 * j]; o8[64 * j] = (u32x2){cvtpk(v[0], v[1]), cvtpk(v[2], v[3])}; }
    }
}

DI void scan_unit(Frame& F, int bh) {
    const float* src = (const float*)(F.ws + WS_LOGF) + (size_t)bh * SEQ;
    float* dst = (float*)(F.ws + WS_CUM) + (size_t)bh * SEQ;
    LAS float* wtot = (LAS float*)F.lds;
    float v[16];
#pragma unroll
    for (int j = 0; j < 4; ++j) { const f32x4 t = *(const f32x4*)(src + F.tid * 16 + 4 * j); v[4 * j] = t[0]; v[4 * j + 1] = t[1]; v[4 * j + 2] = t[2]; v[4 * j + 3] = t[3]; }
#pragma unroll
    for (int i = 1; i < 16; ++i) v[i] += v[i - 1];
    float tot = v[15];
    float inc = tot;
#pragma unroll
    for (int o = 1; o < 64; o <<= 1) { const float t = __shfl_up(inc, o); if (F.lane >= o) inc += t; }
    __syncthreads();
    if (F.lane == 63) wtot[F.wid] = inc;
    __syncthreads();
    float base = inc - tot;
    for (int w = 0; w < F.wid; ++w) base += wtot[w];
#pragma unroll
    for (int j = 0; j < 4; ++j) {
        f32x4 t; t[0] = (base + v[4 * j]) * LOG2E; t[1] = (base + v[4 * j + 1]) * LOG2E; t[2] = (base + v[4 * j + 2]) * LOG2E; t[3] = (base + v[4 * j + 3]) * LOG2E;
        *(f32x4*)(dst + F.tid * 16 + 4 * j) = t;
    }
    __syncthreads();
}

struct RouteQKM { unsigned char* ws; DI Dst operator()(const pg8::Unit& u) const {
    if (u.pn < 3) return Dst{(bf16_t*)(ws + WS_Q), 768, u.pm * 256, u.pn * 256, 256, 0.125f * LOG2E, false};
    if (u.pn < 6) return Dst{(bf16_t*)(ws + WS_K), 768, u.pm * 256, (u.pn - 3) * 256, 256, 1.0f, false};
    return Dst{(bf16_t*)(ws + WS_MQ), 256, u.pm * 256, 0, 256, 0.125f * LOG2E, false}; } };
struct RouteVT { unsigned char* ws; DI Dst operator()(const pg8::Unit& u) const {
    const int b = u.pn >> 5; return Dst{(bf16_t*)(ws + WS_VT) + (size_t)b * 768 * SEQ, SEQ, u.pm * 256, (u.pn & 31) * 256, 256, 1.0f, false}; } };
struct RoutePlain { bf16_t* O; int ldo; DI Dst operator()(const pg8::Unit& u) const { return Dst{O, ldo, u.pm * 256, u.pn * 256, 256, 1.0f, false}; } };
DI void phase_proj0(Frame& F, const Params& P) {
    F.lane = vlane(); F.tid = F.wid * 64 + F.lane;
    unsigned char* ws = F.ws;
    const bf16_t* xb = (const bf16_t*)(ws + WS_XB);
    const bf16_t* win = (const bf16_t*)(ws + WS_W_AIN);
    const bf16_t* memb = (const bf16_t*)(ws + WS_MEMB);
    {
        pg8::Gemm g{xb, win, 1024}; pg8::StaticOrder S; S.init(T, 1792, 1024, F.G, F.bid);
        EpiBf16R<RouteQKM> E{RouteQKM{ws}};
        pg8::gemm_phase<EpiBf16R<RouteQKM>, pg8::StaticOrder, true>(F.lds, g, S, E, F.wid);
    }
    {
        pg8::Gemm g{win + (size_t)1792 * 1024, xb, 1024}; pg8::StaticOrder S; S.init(768, T, 1024, F.G, (F.bid + 64) % F.G);
        EpiBf16R<RouteVT> E{RouteVT{ws}};
        pg8::gemm_phase<EpiBf16R<RouteVT>, pg8::StaticOrder, true>(F.lds, g, S, E, F.wid);
    }
    for (int l = 0; l < 2; ++l) {
        const bf16_t* wk = (const bf16_t*)(ws + WS_W_MKV) + (size_t)l * 512 * 1024;
        {
            pg8::Gemm g{memb, wk, 1024}; pg8::StaticOrder S; S.init(512, 256, 1024, F.G, (F.bid + F.G - (152 + 4 * l)) % F.G);
            EpiBf16R<RoutePlain> E{RoutePlain{(bf16_t*)(ws + WS_MK) + (size_t)l * 512 * 256, 256}};
            pg8::gemm_phase<EpiBf16R<RoutePlain>, pg8::StaticOrder, true>(F.lds, g, S, E, F.wid);
        }
        for (int b = 0; b < 2; ++b) {
            pg8::Gemm g{wk + (size_t)256 * 1024, memb + (size_t)b * 256 * 1024, 1024}; pg8::StaticOrder S; S.init(256, 256, 1024, F.G, (F.bid + F.G - (154 + 4 * l + b)) % F.G);
            EpiBf16R<RoutePlain> E{RoutePlain{(bf16_t*)(ws + WS_MVT) + (size_t)(l * 2 + b) * 256 * 256, 256}};
            pg8::gemm_phase<EpiBf16R<RoutePlain>, pg8::StaticOrder, true>(F.lds, g, S, E, F.wid);
        }
    }
    if (F.G == 256 && F.bid >= 128) conv_pull(F, 0, CONV_P1);
}


DI void phase_scan_knorm(Frame& F) {
    F.lane = vlane(); F.tid = F.wid * 64 + F.lane;
    unsigned char* ws = F.ws;
    if (F.bid < 24) scan_unit(F, F.bid);
    const bf16_t* K = (const bf16_t*)(ws + WS_K);
    float* kn2 = (float*)(ws + WS_KN2);
    const int gw = F.bid * 8 + F.wid, NGW = F.G * 8;
    for (int it = gw; it < 24 * 128; it += NGW) {
        const int bh = it >> 7, j = it & 127, b = bh / 12, h = bh % 12;
        const u32x4* kr = (const u32x4*)(K + (size_t)(b * SEQ + 64 * j + F.lane) * 768 + h * 64);
        float ss = 0.f;
#pragma unroll
        for (int c = 0; c < 8; ++c) {
            const u32x4 w = kr[c];
            const unsigned ww[4] = {w.x, w.y, w.z, w.w};
#pragma unroll
            for (int i = 0; i < 4; ++i) { const float a = __uint_as_float(ww[i] << 16), bb = __uint_as_float(ww[i] & 0xffff0000u); ss += a * a + bb * bb; }
        }
        ss = wave_max(ss);
        if (F.lane == 0) kn2[it] = ss;
    }
}

DI void mem_attn_unit(Frame& F, int l, int v) {
    unsigned char* ws = F.ws;
    const int qb = v >> 3, bm = v & 7, b = bm >> 2, mh = bm & 3;
    const bf16_t* Q = (const bf16_t*)(ws + WS_MQ) + (size_t)b * SEQ * 256 + mh * 64;
    const bf16_t* K = (const bf16_t*)(ws + WS_MK) + (size_t)l * 512 * 256 + (size_t)b * 256 * 256 + mh * 64;
    const bf16_t* Vt = (const bf16_t*)(ws + WS_MVT) + (size_t)(l * 2 + b) * 256 * 256 + (size_t)mh * 64 * 256;
    bf16_t* O = (bf16_t*)(ws + WS_MERGED) + (size_t)b * SEQ * 1024 + 768 + mh * 64;
    attn_unit<64, false, false>(F.lds, Q, 256, K, 256, Vt, 256, nullptr, O, 1024, qb * 256, 4, false, nullptr, F.wid);
}
DI void phase_attn0(Frame& F, const Params& P) {
    F.lane = vlane(); F.tid = F.wid * 64 + F.lane;
    unsigned char* ws = F.ws;
    constexpr int NU = 768 + 256 + 512;
    for (;;) {
        const int uu = next_unit(F, 0);
        if (uu >= NU) break;
        if (uu % 3 == 2) { conv_pull(F, 0, CONV_A0); continue; }
        const int u = 2 * (uu / 3) + uu % 3;
        if (u < 768) {
            const int qb = 31 - u / 24, bh = u % 24, b = bh / 12, h = bh % 12;
            const bf16_t* Q = (const bf16_t*)(ws + WS_Q) + (size_t)b * SEQ * 768 + h * 64;
            const bf16_t* K = (const bf16_t*)(ws + WS_K) + (size_t)b * SEQ * 768 + h * 64;
            const bf16_t* Vt = (const bf16_t*)(ws + WS_VT) + (size_t)(b * 768 + h * 64) * SEQ;
            const float* cum = (const float*)(ws + WS_CUM) + (size_t)bh * SEQ;
            bf16_t* O = (bf16_t*)(ws + WS_MERGED) + (size_t)b * SEQ * 1024 + h * 64;
            attn_unit<64, true, false>(F.lds, Q, 768, K, 768, Vt, SEQ, cum, O, 1024, qb * 256, 4 * (qb + 1), true, nullptr, F.wid, (const float*)(ws + WS_KN2) + bh * 128);
        } else mem_attn_unit(F, 0, u - 768);
    }
    while (conv_pull(F, 0, 16)) {}
}
DI void phase_attn1(Frame& F, const Params& P) {
    F.lane = vlane(); F.tid = F.wid * 64 + F.lane;
    unsigned char* ws = F.ws;
    constexpr int NCONV = 256, NU = 768 + 256 + NCONV;
    for (;;) {
        const int uu = next_unit(F, 1);
        if (uu >= NU) break;
        if (uu % 5 == 4) { conv_pull(F, 1, CONV_A1); continue; }
        const int u = 4 * (uu / 5) + uu % 5;
        if (u < 768) {
            const int qb = 31 - u / 24, bh = u % 24, b = bh / 12, h = bh % 12;
            const bf16_t* Q = (const bf16_t*)(ws + WS_Q) + (size_t)b * SEQ * 1152 + h * 96;
            const bf16_t* K = (const bf16_t*)(ws + WS_K) + (size_t)b * SEQ * 1152 + h * 96;
            const bf16_t* Vt = (const bf16_t*)(ws + WS_VT) + (size_t)(b * 768 + h * 64) * SEQ;
            bf16_t* O = (bf16_t*)(ws + WS_MERGED) + (size_t)b * SEQ * 1024 + h * 64;
            attn_unit_pipe<96, true>(F.lds, Q, 1152, K, 1152, Vt, SEQ, O, 1024, qb * 256, 4 * (qb + 1), KP->pos + (size_t)b * SEQ, F.wid);
        } else mem_attn_unit(F, 1, u - 768);
    }
    while (conv_pull(F, 1, 16)) {}
}

DI void phase_outproj(Frame& F, const float* X, const bf16_t* Wt) {
    F.lane = vlane(); F.tid = F.wid * 64 + F.lane;
    unsigned char* ws = F.ws;
    pg8::Gemm g{(const bf16_t*)(ws + WS_MERGED), Wt, 1024}; pg8::StaticOrder S; S.init(T, 1024, 1024, F.G, F.bid);
    EpiResF32 E{(float*)(ws + WS_Y), X};
    pg8::gemm_phase<EpiResF32, pg8::StaticOrder, false>(F.lds, g, S, E, F.wid);
}


DI void phase_ln_router(Frame& F, const Params& P, int l) {
    F.lane = vlane(); F.tid = F.wid * 64 + F.lane;
    unsigned char* ws = F.ws;
    LAS unsigned char* wH = F.lds;
    LAS unsigned char* wL = F.lds + 65536;
    LAS int* pairs = (LAS int*)(F.lds + LDS_CTL + 1024);
    LAS int* lcnt = (LAS int*)(F.lds + LDS_CTL + 3072); LAS int* gbase = lcnt + 32;
    LAS float* lg = (LAS float*)(F.lds + LDS_R1X + F.wid * 1280);
    LAS int* rec = (LAS int*)(F.lds + LDS_R1X + F.wid * 1280 + 1024);
    LAS float* stt = (LAS float*)(F.lds + LDS_R1X + 8 * 1280 + F.wid * 64);
    __syncthreads();
    {
        const u32x4* srcH = (const u32x4*)((const bf16_t*)(ws + WS_WRH) + (size_t)l * 32 * 1024);
        const u32x4* srcL = (const u32x4*)((const bf16_t*)(ws + WS_WRL) + (size_t)l * 32 * 1024);
        for (int i = F.tid; i < 32 * 128; i += NTHREADS) { const int e = i >> 7, c = i & 127; const int off = e * 2048 + ((c ^ (e & 7)) << 4);
            *(LAS u32x4*)(wH + off) = srcH[i]; *(LAS u32x4*)(wL + off) = srcL[i]; }
    }
    if (F.tid < 32) lcnt[F.tid] = 0;
    __syncthreads();
    const float* g = KP->ln_g + (size_t)(l * 2 + 0) * DM; const float* bt = KP->ln_b + (size_t)(l * 2 + 0) * DM;
    const float* br = KP->moe_b_r + l * 32;
    const float* Y = (const float*)(ws + WS_Y);
    unsigned char* X1Q = ws + WS_X1B;
    float* SAS = (float*)(ws + WS_SAS);
    int* PE = (int*)(ws + WS_PE); int* PPOS = (int*)(ws + WS_PPOS); float* GATE = (float*)(ws + WS_GATE); int* TOKOF = (int*)(ws + WS_TOKOF);
    unsigned* cnt = F.ctl + CW_CNT + l * 32 * 64;
    const int gw = F.bid * 8 + F.wid, NGW = F.G * 8;
    int it = 0;
    f32x4 vnx[4];
    if (gw < T) {
#pragma unroll
        for (int j = 0; j < 4; ++j) vnx[j] = *((const f32x4*)(Y + (size_t)gw * DM) + F.lane + 64 * j);
    }
    for (int row = gw; row < T; row += NGW, ++it) {
        f32x4 v[4]; float s = 0.f;
#pragma unroll
        for (int j = 0; j < 4; ++j) { v[j] = vnx[j]; s += (v[j][0] + v[j][1]) + (v[j][2] + v[j][3]); }
        if (row + NGW < T) {
#pragma unroll
            for (int j = 0; j < 4; ++j) vnx[j] = *((const f32x4*)(Y + (size_t)(row + NGW) * DM) + F.lane + 64 * j);
        }
        const float mean = wave_sum(s) * (1.f / DM); float s2 = 0.f;
#pragma unroll
        for (int j = 0; j < 4; ++j) { v[j] = v[j] - mean; s2 += (v[j][0] * v[j][0] + v[j][1] * v[j][1]) + (v[j][2] * v[j][2] + v[j][3] * v[j][3]); }
        const float rstd = 1.0f / sqrtf(wave_sum(s2) * (1.f / DM) + LN_EPS);
        float am = 0.f;
#pragma unroll
        for (int j = 0; j < 4; ++j) {
            const f32x4 gg = *((const f32x4*)g + F.lane + 64 * j), bb = *((const f32x4*)bt + F.lane + 64 * j);
            v[j] = v[j] * rstd * gg + bb;
            am = fmaxf(fmaxf(am, fmaxf(fabsf(v[j][0]), fabsf(v[j][1]))), fmaxf(fabsf(v[j][2]), fabsf(v[j][3])));
        }
        am = wave_max(am);
        const float qinv = am > 0.f ? 127.0f / am : 0.f;
#pragma unroll
        for (int j = 0; j < 4; ++j) *((unsigned*)(X1Q + (size_t)row * DM) + F.lane + 64 * j) = q8x4(v[j][0], v[j][1], v[j][2], v[j][3], qinv);
        if (F.lane == 0) { stt[2 * (it & 7)] = mean; stt[2 * (it & 7) + 1] = rstd; pairs[(F.wid * 16 + 8 + (it & 7)) * 4] = (int)__float_as_uint(am * (1.0f / 127.0f)); }
    }
    asm volatile("s_waitcnt lgkmcnt(0)" ::: "memory");
    {
        const int r16 = F.lane & 15, kg = F.lane >> 4;
        const int arow = gw + NGW * (r16 & 7);
        const float mean = stt[2 * (r16 & 7)], rstd = stt[2 * (r16 & 7) + 1];
        const float* yr = Y + (size_t)(arow < T ? arow : gw) * DM + 8 * kg;
        const float* gp = g + 8 * kg; const float* bp = bt + 8 * kg;
        f32x4 acc0 = (f32x4){0.f, 0.f, 0.f, 0.f}, acc1 = (f32x4){0.f, 0.f, 0.f, 0.f};
        const int e0 = r16, e1 = 16 + r16;
        const int b0off = e0 * 2048, b1off = e1 * 2048, sw = r16 & 7;
#pragma unroll 4
        for (int s2 = 0; s2 < 32; ++s2) {
            const f32x4 y0 = *(const f32x4*)(yr + 32 * s2), y1 = *(const f32x4*)(yr + 32 * s2 + 4);
            const f32x4 g0 = *(const f32x4*)(gp + 32 * s2), g1 = *(const f32x4*)(gp + 32 * s2 + 4);
            const f32x4 c0 = *(const f32x4*)(bp + 32 * s2), c1 = *(const f32x4*)(bp + 32 * s2 + 4);
            const f32x4 x0 = (y0 - mean) * rstd * g0 + c0, x1 = (y1 - mean) * rstd * g1 + c1;
            u32x4 ah, al;
            ah.x = cvtpk(x0[0], x0[1]); ah.y = cvtpk(x0[2], x0[3]); ah.z = cvtpk(x1[0], x1[1]); ah.w = cvtpk(x1[2], x1[3]);
            al.x = cvtpk(x0[0] - __uint_as_float(ah.x << 16), x0[1] - __uint_as_float(ah.x & 0xffff0000u)); al.y = cvtpk(x0[2] - __uint_as_float(ah.y << 16), x0[3] - __uint_as_float(ah.y & 0xffff0000u));
            al.z = cvtpk(x1[0] - __uint_as_float(ah.z << 16), x1[1] - __uint_as_float(ah.z & 0xffff0000u)); al.w = cvtpk(x1[2] - __uint_as_float(ah.w << 16), x1[3] - __uint_as_float(ah.w & 0xffff0000u));
            const bf16x8 Ah = __builtin_bit_cast(bf16x8, ah), Al = __builtin_bit_cast(bf16x8, al);
            const int co = (((4 * s2 + kg) ^ sw) << 4);
            const bf16x8 Bh0 = *(const LAS bf16x8*)(wH + b0off + co), Bl0 = *(const LAS bf16x8*)(wL + b0off + co);
            const bf16x8 Bh1 = *(const LAS bf16x8*)(wH + b1off + co), Bl1 = *(const LAS bf16x8*)(wL + b1off + co);
            acc0 = __builtin_amdgcn_mfma_f32_16x16x32_bf16(Ah, Bh0, acc0, 0, 0, 0); acc0 = __builtin_amdgcn_mfma_f32_16x16x32_bf16(Al, Bh0, acc0, 0, 0, 0); acc0 = __builtin_amdgcn_mfma_f32_16x16x32_bf16(Ah, Bl0, acc0, 0, 0, 0);
            acc1 = __builtin_amdgcn_mfma_f32_16x16x32_bf16(Ah, Bh1, acc1, 0, 0, 0); acc1 = __builtin_amdgcn_mfma_f32_16x16x32_bf16(Al, Bh1, acc1, 0, 0, 0); acc1 = __builtin_amdgcn_mfma_f32_16x16x32_bf16(Ah, Bl1, acc1, 0, 0, 0);
        }
        if (kg < 2) {
            const float bb0 = br[e0], bb1 = br[e1];
#pragma unroll
            for (int r = 0; r < 4; ++r) { lg[(4 * kg + r) * 32 + e0] = acc0[r] + bb0; lg[(4 * kg + r) * 32 + e1] = acc1[r] + bb1; }
        }
        asm volatile("s_waitcnt lgkmcnt(0)" ::: "memory");
        const int rr = F.lane >> 3, sub = F.lane & 7;
        f32x4 vv[8];
#pragma unroll
        for (int q = 0; q < 8; ++q) vv[q] = *(const LAS f32x4*)(lg + rr * 32 + 4 * q);
        const f32x4 mine = *(const LAS f32x4*)(lg + rr * 32 + 4 * sub);
        int rk[4] = {0, 0, 0, 0};
#pragma unroll
        for (int q = 0; q < 8; ++q)
#pragma unroll
            for (int i = 0; i < 4; ++i) {
                const float ve = vv[q][i]; const int ee = 4 * q + i;
#pragma unroll
                for (int c = 0; c < 4; ++c) rk[c] += (ve > mine[c] || (ve == mine[c] && ee < 4 * sub + c)) ? 1 : 0;
            }
#pragma unroll
        for (int c = 0; c < 4; ++c) if (rk[c] < 4) { rec[(rr * 4 + rk[c]) * 2] = 4 * sub + c; rec[(rr * 4 + rk[c]) * 2 + 1] = (int)__float_as_uint(mine[c]); }
        asm volatile("s_waitcnt lgkmcnt(0)" ::: "memory");
        const int te0 = rec[(rr * 4 + 0) * 2], te1 = rec[(rr * 4 + 1) * 2], te2 = rec[(rr * 4 + 2) * 2], te3 = rec[(rr * 4 + 3) * 2];
        const float tv0 = __uint_as_float((unsigned)rec[(rr * 4 + 0) * 2 + 1]), tv1 = __uint_as_float((unsigned)rec[(rr * 4 + 1) * 2 + 1]);
        const float tv2 = __uint_as_float((unsigned)rec[(rr * 4 + 2) * 2 + 1]), tv3 = __uint_as_float((unsigned)rec[(rr * 4 + 3) * 2 + 1]);
        const float e1_ = __expf(tv1 - tv0), e2_ = __expf(tv2 - tv0), e3_ = __expf(tv3 - tv0);
        const float rs = 1.0f / (1.0f + e1_ + e2_ + e3_);
        const int row = gw + NGW * rr;
        if (sub < 4 && row < T) {
            const int k = sub;
            const int e = k == 0 ? te0 : k == 1 ? te1 : k == 2 ? te2 : te3;
            const float gt = (k == 0 ? 1.0f : k == 1 ? e1_ : k == 2 ? e2_ : e3_) * rs;
            const int rnk = __hip_atomic_fetch_add(lcnt + e, 1, __ATOMIC_RELAXED, __HIP_MEMORY_SCOPE_WORKGROUP);
            PE[row * 4 + k] = e; GATE[row * 4 + k] = gt; pairs[(F.wid * 16 + rr) * 4 + k] = e | (rnk << 8);
        }
    }
    __syncthreads();
    if (F.tid < 32) { const int c = lcnt[F.tid]; gbase[F.tid] = c ? (int)atomicAdd(cnt + F.tid * 64, (unsigned)c) : 0; }
    __syncthreads();
    it = 0;
    for (int row = gw; row < T; row += NGW, ++it) {
        if (F.lane < 4) {
            const int pr = pairs[(F.wid * 16 + (it & 15)) * 4 + F.lane], e = pr & 255, p = gbase[e] + (pr >> 8);
            PPOS[row * 4 + F.lane] = p; TOKOF[(size_t)e * T + p] = row; SAS[(size_t)e * T + p] = __uint_as_float((unsigned)pairs[(F.wid * 16 + 8 + (it & 7)) * 4]);
        }
    }
}

DI void moe_tables(Frame& F, int l, LAS int* tstart, LAS int* soff) {
    __syncthreads();
    if (F.tid == 0) {
        int ts = 0;
        for (int e = 0; e < 32; ++e) {
            const int c = (int)__hip_atomic_load(F.ctl + CW_CNT + (l * 32 + e) * 64, __ATOMIC_RELAXED, __HIP_MEMORY_SCOPE_AGENT);
            tstart[e] = ts; soff[e] = ts * 256; tstart[80 + e] = c; ts += (c + 255) >> 8;
        }
        tstart[32] = ts; soff[32] = ts * 256;
    }
    __syncthreads();
}
DI void phase_moe_gu(Frame& F, const Params& P, int l) {
    F.lane = vlane(); F.tid = F.wid * 64 + F.lane;
    unsigned char* ws = F.ws;
    LAS int* tstart = (LAS int*)(F.lds + LDS_CTL + 64); LAS int* soff = tstart + 40;
    moe_tables(F, l, tstart, soff);
    pg8::Gemm g{(const bf16_t*)(ws + WS_X1B), (const bf16_t*)(ws + WS_W_GU + (size_t)l * 32 * 2048 * 1024), 512};
    LAS int* ulist = (LAS int*)(F.lds + LDS_CTL + 3328);
    MoeOrder::build(F, tstart, 8, ulist);
    MoeOrder S{tstart, 3, true, (const int*)(ws + WS_TOKOF), (const LAS int*)(F.lds + LDS_CTL + 1024), ulist, 1024u};
    EpiGU E{(bf16_t*)(ws + WS_H), KP->moe_b_gu + (size_t)l * 32 * 2048, (const float*)(ws + WS_SGU) + (size_t)l * 32 * 2048, (const float*)(ws + WS_SAS), tstart};
    pg8::gemm_phase<EpiGU, MoeOrder, true, 1>(F.lds, g, S, E, F.wid);
    if (l == 0) { const int rem = (tstart[32] * 8) % F.G; if (rem && F.bid >= rem) conv_pull(F, 1, CONV_GU); }
}
DI void phase_moe_dn(Frame& F, const Params& P, int l) {
    F.lane = vlane(); F.tid = F.wid * 64 + F.lane;
    unsigned char* ws = F.ws;
    LAS int* tstart = (LAS int*)(F.lds + LDS_CTL + 64); LAS int* soff = tstart + 40;
    moe_tables(F, l, tstart, soff);
    pg8::Gemm g{(const bf16_t*)(ws + WS_H), (const bf16_t*)(ws + WS_W_DN) + (size_t)l * 32 * 1024 * 1024, 1024};
    LAS int* ulist = (LAS int*)(F.lds + LDS_CTL + 3328);
    MoeOrder::build(F, tstart, 4, ulist);
    MoeOrder S{tstart, 2, false, nullptr, nullptr, ulist, 2048u};
    EpiDN E{(bf16_t*)(ws + WS_YE), KP->moe_b_dn + (size_t)l * 32 * 1024};
    pg8::gemm_phase<EpiDN, MoeOrder, true>(F.lds, g, S, E, F.wid);
    if (l == 0) { const int rem = (tstart[32] * 4) % F.G; if (rem && F.bid >= rem) conv_pull(F, 1, CONV_DN); }
}


DI void phase_combine(Frame& F, const Params& P, int l, float* outf, bf16_t* outb) {
    F.lane = vlane(); F.tid = F.wid * 64 + F.lane;
    unsigned char* ws = F.ws;
    LAS int* tstart = (LAS int*)(F.lds + LDS_CTL + 64); LAS int* soff = tstart + 40;
    moe_tables(F, l, tstart, soff);
    const float* g = KP->ln_g + (size_t)(l * 2 + 1) * DM; const float* bt = KP->ln_b + (size_t)(l * 2 + 1) * DM;
    const float* X1 = (const float*)(ws + WS_Y); const bf16_t* YE = (const bf16_t*)(ws + WS_YE);
    const float* g1 = KP->ln_g + (size_t)(l * 2 + 0) * DM; const float* b1 = KP->ln_b + (size_t)(l * 2 + 0) * DM;
    const int* PE = (const int*)(ws + WS_PE); const int* PPOS = (const int*)(ws + WS_PPOS); const float* GATE = (const float*)(ws + WS_GATE);
    const int gw = F.bid * 8 + F.wid, NGW = F.G * 8;
    i32x4 ie, ip; f32x4 ig;
    f32x4 xn[4]; u32x2 yn[4][4]; f32x4 gn;
#define CB_LOADIDX(r) do { ie = *(const i32x4*)(PE + (size_t)(r) * 4); ip = *(const i32x4*)(PPOS + (size_t)(r) * 4); ig = *(const f32x4*)(GATE + (size_t)(r) * 4); } while (0)
#define CB_LOADDATA(r) do { gn = ig; \
        _Pragma("unroll") for (int j = 0; j < 4; ++j) xn[j] = *((const f32x4*)(X1 + (size_t)(r) * DM) + F.lane + 64 * j); \
        _Pragma("unroll") for (int k = 0; k < 4; ++k) { const int slot = soff[ie[k]] + ip[k]; const u32x2* yr = (const u32x2*)(YE + (size_t)slot * 1024) + F.lane; \
            _Pragma("unroll") for (int j = 0; j < 4; ++j) yn[k][j] = yr[64 * j]; } } while (0)
    if (gw < T) { CB_LOADIDX(gw); CB_LOADDATA(gw); if (gw + NGW < T) CB_LOADIDX(gw + NGW); }
    for (int row = gw; row < T; row += NGW) {
        f32x4 v[4]; u32x2 yc[4][4]; f32x4 gc = gn;
        {
            float s0 = 0.f;
#pragma unroll
            for (int j = 0; j < 4; ++j) { v[j] = xn[j]; s0 += (v[j][0] + v[j][1]) + (v[j][2] + v[j][3]); }
            const float mean0 = wave_sum(s0) * (1.f / DM); float q0 = 0.f;
#pragma unroll
            for (int j = 0; j < 4; ++j) { v[j] = v[j] - mean0; q0 += (v[j][0] * v[j][0] + v[j][1] * v[j][1]) + (v[j][2] * v[j][2] + v[j][3] * v[j][3]); }
            const float rstd0 = 1.0f / sqrtf(wave_sum(q0) * (1.f / DM) + LN_EPS);
#pragma unroll
            for (int j = 0; j < 4; ++j) {
                const f32x4 gg = *((const f32x4*)g1 + F.lane + 64 * j), bb = *((const f32x4*)b1 + F.lane + 64 * j);
                v[j] = (v[j] * rstd0 * gg + bb) * ALPHA;
            }
        }
#pragma unroll
        for (int k = 0; k < 4; ++k)
#pragma unroll
            for (int j = 0; j < 4; ++j) yc[k][j] = yn[k][j];
        if (row + NGW < T) { CB_LOADDATA(row + NGW); if (row + 2 * NGW < T) CB_LOADIDX(row + 2 * NGW); }
#pragma unroll
        for (int k = 0; k < 4; ++k) {
            const float gt = gc[k];
#pragma unroll
            for (int j = 0; j < 4; ++j) {
                const u32x2 w = yc[k][j];
                v[j][0] += gt * __uint_as_float(w.x << 16); v[j][1] += gt * __uint_as_float(w.x & 0xffff0000u);
                v[j][2] += gt * __uint_as_float(w.y << 16); v[j][3] += gt * __uint_as_float(w.y & 0xffff0000u);
            }
        }
        float s = 0.f;
#pragma unroll
        for (int j = 0; j < 4; ++j) s += (v[j][0] + v[j][1]) + (v[j][2] + v[j][3]);
        const float mean = wave_sum(s) * (1.f / DM); float s2 = 0.f;
#pragma unroll
        for (int j = 0; j < 4; ++j) { v[j] = v[j] - mean; s2 += (v[j][0] * v[j][0] + v[j][1] * v[j][1]) + (v[j][2] * v[j][2] + v[j][3] * v[j][3]); }
        const float rstd = 1.0f / sqrtf(wave_sum(s2) * (1.f / DM) + LN_EPS);
#pragma unroll
        for (int j = 0; j < 4; ++j) {
            const f32x4 gg = *((const f32x4*)g + F.lane + 64 * j), bb = *((const f32x4*)bt + F.lane + 64 * j);
            v[j] = v[j] * rstd * gg + bb;
            *((f32x4*)(outf + (size_t)row * DM) + F.lane + 64 * j) = v[j];
            if (outb) *((u32x2*)(outb + (size_t)row * DM) + F.lane + 64 * j) = (u32x2){cvtpk(v[j][0], v[j][1]), cvtpk(v[j][2], v[j][3])};
        }
    }
#undef CB_LOADIDX
#undef CB_LOADDATA
}

DI void phase_lat(Frame& F) {
    F.lane = vlane(); F.tid = F.wid * 64 + F.lane;
    unsigned char* ws = F.ws;
    pg8::Gemm g{(const bf16_t*)(ws + WS_XB), (const bf16_t*)(ws + WS_W_BIN), 1024}; pg8::StaticOrder S; S.init(T, 1024, 1024, F.G, F.bid);
    EpiLat E{(float*)(ws + WS_LAT), 928};
    pg8::gemm_phase<EpiLat, pg8::StaticOrder, false>(F.lds, g, S, E, F.wid);
}

DI void phase_latrows(Frame& F, const Params& P) {
    F.lane = vlane(); F.tid = F.wid * 64 + F.lane;
    unsigned char* ws = F.ws;
    const float* LAT = (const float*)(ws + WS_LAT);
    bf16_t* CKV = (bf16_t*)(ws + WS_CKV); bf16_t* CQ = (bf16_t*)(ws + WS_CQ); bf16_t* MQ = (bf16_t*)(ws + WS_MQ); bf16_t* Kb = (bf16_t*)(ws + WS_K);
    const int gw = F.bid * 8 + F.wid, NGW = F.G * 8;
    for (int row = gw; row < T; row += NGW) {
        const float* lr = LAT + (size_t)row * 1024;
        {
            const f32x4 v = *((const f32x4*)lr + F.lane);
            const float ss = wave_sum((v[0] * v[0] + v[1] * v[1]) + (v[2] * v[2] + v[3] * v[3]));
            const float rs = 1.0f / sqrtf(ss * (1.f / 256.f) + RMS_EPS);
            const f32x4 gg = *((const f32x4*)KP->kv_g + F.lane);
            const f32x4 o = v * rs * gg;
            *((u32x2*)(CKV + (size_t)row * 256) + F.lane) = (u32x2){cvtpk(o[0], o[1]), cvtpk(o[2], o[3])};
        }
        {
            const f32x4 v0 = *((const f32x4*)(lr + 288) + F.lane);
            f32x4 v1 = (f32x4){0.f, 0.f, 0.f, 0.f};
            if (F.lane < 32) v1 = *((const f32x4*)(lr + 288 + 256) + F.lane);
            const float ss = wave_sum((v0[0] * v0[0] + v0[1] * v0[1]) + (v0[2] * v0[2] + v0[3] * v0[3]) + (v1[0] * v1[0] + v1[1] * v1[1]) + (v1[2] * v1[2] + v1[3] * v1[3]));
            const float rs = 1.0f / sqrtf(ss * (1.f / 384.f) + RMS_EPS);
            const f32x4 g0 = *((const f32x4*)KP->b_g_q + F.lane);
            const f32x4 o0 = v0 * rs * g0;
            *((u32x2*)(CQ + (size_t)row * 384) + F.lane) = (u32x2){cvtpk(o0[0], o0[1]), cvtpk(o0[2], o0[3])};
            if (F.lane < 32) {
                const f32x4 g1 = *((const f32x4*)(KP->b_g_q + 256) + F.lane);
                const f32x4 o1 = v1 * rs * g1;
                *((u32x2*)(CQ + (size_t)row * 384 + 256) + F.lane) = (u32x2){cvtpk(o1[0], o1[1]), cvtpk(o1[2], o1[3])};
            }
        }
        {
            const f32x4 v = *((const f32x4*)(lr + 672) + F.lane) * (0.125f * LOG2E);
            *((u32x2*)(MQ + (size_t)row * 256) + F.lane) = (u32x2){cvtpk(v[0], v[1]), cvtpk(v[2], v[3])};
        }
        if (F.lane < 16) {
            const int i = F.lane;
            const float p = (float)KP->pos[row];
            const float inv = exp2f(-(float)i * (13.287712379549449f / 16.0f));
            float sn, cs; sincos_cw(p * inv, sn, cs);
            const float x1 = lr[256 + i], x2 = lr[256 + 16 + i];
            const unsigned short o1 = (unsigned short)(cvtpk(x1 * cs - x2 * sn, 0.f) & 0xffffu), o2 = (unsigned short)(cvtpk(x1 * sn + x2 * cs, 0.f) & 0xffffu);
#pragma unroll
            for (int h = 0; h < NH; ++h) { Kb[(size_t)row * 1152 + h * 96 + 64 + i] = o1; Kb[(size_t)row * 1152 + h * 96 + 80 + i] = o2; }
        }
    }
}
#ifndef UPSEL
#define UPSEL 7
#endif
struct RouteK1 { unsigned char* ws; DI Dst operator()(const pg8::Unit& u) const { return Dst{(bf16_t*)(ws + WS_K), 1152, u.pm * 256, u.pn * 384, 256, 1.0f, true}; } };
struct RouteQ1 { unsigned char* ws; DI Dst operator()(const pg8::Unit& u) const { const int nv = 1152 - u.pn * 256; return Dst{(bf16_t*)(ws + WS_Q), 1152, u.pm * 256, u.pn * 256, nv < 256 ? nv : 256, 0.10206207261596577f * LOG2E, false}; } };
DI void phase_up1(Frame& F) {
    F.lane = vlane(); F.tid = F.wid * 64 + F.lane;
    unsigned char* ws = F.ws;
    const bf16_t* ckv = (const bf16_t*)(ws + WS_CKV); const bf16_t* cq = (const bf16_t*)(ws + WS_CQ);
    const bf16_t* wukv = (const bf16_t*)(ws + WS_W_UKV); const bf16_t* wuq = (const bf16_t*)(ws + WS_W_UQ);
#if (UPSEL & 1)
    {
        pg8::Gemm g{cq, wuq, 384}; pg8::StaticOrder S; S.init(T, 1280, 384, F.G, F.bid);
        EpiBf16R<RouteQ1> E{RouteQ1{ws}};
        pg8::gemm_phase<EpiBf16R<RouteQ1>, pg8::StaticOrder, true>(F.lds, g, S, E, F.wid);
    }
#endif
#if (UPSEL & 2)
    {
        pg8::Gemm g{ckv, wukv, 256}; pg8::StaticOrder S; S.init(T, 768, 256, F.G, F.G - 1 - F.bid);
        EpiBf16R<RouteK1> E{RouteK1{ws}};
        pg8::gemm_phase<EpiBf16R<RouteK1>, pg8::StaticOrder, true>(F.lds, g, S, E, F.wid);
    }
#endif
#if (UPSEL & 4)
    {
        pg8::Gemm g{wukv + (size_t)768 * 256, ckv, 256}; pg8::StaticOrder S; S.init(768, T, 256, F.G, F.G - 1 - F.bid);
        EpiBf16R<RouteVT> E{RouteVT{ws}};
        pg8::gemm_phase<EpiBf16R<RouteVT>, pg8::StaticOrder, true>(F.lds, g, S, E, F.wid);
    }
#endif
}


__global__ void __launch_bounds__(NTHREADS) mega_fwd(Params P) {
    extern __shared__ __attribute__((aligned(16))) unsigned char lds_raw[];
    Frame F;
    F.lds = (LAS unsigned char*)lds_raw; F.ws = KP->ws; F.ctl = (unsigned*)(KP->ws + WS_CTL);
    F.wid = __builtin_amdgcn_readfirstlane((int)threadIdx.x >> 6); F.lane = vlane(); F.tid = F.wid * 64 + F.lane; F.G = gridDim.x; F.bid = blockIdx.x;
    const int lo = KP->ph_lo, hi = KP->ph_hi;
    { volatile LAS unsigned* st0 = (volatile LAS unsigned*)(F.lds + LDS_CTL + 512); if (F.tid < 2) st0[F.tid] = 0u; }
    __syncthreads();
    XcdBarrier bar = xcd_barrier_post(F.ctl + CW_BAR, (volatile LAS unsigned*)(F.lds + LDS_CTL + 512), F.wid);
#ifndef PHMASK
#define PHMASK 0x1ffff
#endif
#define IN(k) (((PHMASK >> (k)) & 1) && lo <= (k) && (k) < hi)
#define SEAM(k) do { if (IN(k) && IN((k) + 1)) { if (KP->use_grid_sync) { if ((k) == 0) cg::this_grid().sync(); else xcd_barrier(bar); } } } while (0)
    unsigned char* ws = KP->ws;
    if (IN(0)) { phase_prologue(F, P);
    }
    SEAM(0);
    if (IN(1)) { phase_proj0(F, P);
        if (KP->use_grid_sync) xcd_barrier(bar); phase_scan_knorm(F); }
    SEAM(1);
    if (IN(2)) { phase_attn0(F, P);
    }
    SEAM(2);
    if (IN(3)) { phase_outproj(F, KP->x, (const bf16_t*)(ws + WS_W_AOUT));
    }
    SEAM(3);
    if (IN(4)) phase_ln_router(F, P, 0);
    SEAM(4);
    if (IN(5)) phase_moe_gu(F, P, 0);
    SEAM(5);
    if (IN(6)) phase_moe_dn(F, P, 0);
    SEAM(6);
    if (IN(7)) phase_combine(F, P, 0, (float*)(ws + WS_X2), (bf16_t*)(ws + WS_XB));
    SEAM(7);
    if (IN(8)) phase_lat(F);
    SEAM(8);
    if (IN(9)) phase_latrows(F, P);
    SEAM(9);
    if (IN(10)) { phase_up1(F);
    }
    SEAM(10);
    if (IN(11)) { phase_attn1(F, P);
    }
    SEAM(11);
    if (IN(12)) phase_outproj(F, (const float*)(ws + WS_X2), (const bf16_t*)(ws + WS_W_BOUT));
    SEAM(12);
    if (IN(13)) phase_ln_router(F, P, 1);
    SEAM(13);
    if (IN(14)) { phase_moe_gu(F, P, 1);
    }
    SEAM(14);
    if (IN(15)) { phase_moe_dn(F, P, 1);
    }
    SEAM(15);
    if (IN(16)) { phase_combine(F, P, 1, KP->out, nullptr);
    }
#undef IN
#undef SEAM
}

constexpr int N_PHASES = 17;
#ifndef MK_N_LAUNCHES
#define MK_N_LAUNCHES 1
#endif

extern "C" void kernel_launch(void* const* d_in, const int* in_sizes, int n_in, void* d_out, int out_size, void* d_ws, size_t ws_size, hipStream_t stream) {
    static int grid = 0;
    if (grid == 0) {
        if (n_in != 22 || ws_size < WS_END) { fprintf(stderr, "kernel_launch: need 22 inputs and %zu bytes of workspace (got %d, %zu)\n", (size_t)WS_END, n_in, ws_size); grid = -1; return; }
        int dev = 0, cus = 0, per_cu = 0;
        hipGetDevice(&dev);
        hipDeviceGetAttribute(&cus, hipDeviceAttributeMultiprocessorCount, dev);
        if (hipFuncSetAttribute((const void*)mega_fwd, hipFuncAttributeMaxDynamicSharedMemorySize, LDS_BYTES) != hipSuccess) fprintf(stderr, "kernel_launch: hipFuncSetAttribute failed\n");
        if (hipOccupancyMaxActiveBlocksPerMultiprocessor(&per_cu, (const void*)mega_fwd, NTHREADS, LDS_BYTES) != hipSuccess || per_cu < 1) { fprintf(stderr, "kernel_launch: occupancy query failed (%d)\n", per_cu); per_cu = 1; }
        (void)hipGetLastError();
        grid = cus * (per_cu > 1 ? 1 : per_cu);
        if (grid <= 0) grid = 256;
        if (grid != 256) fprintf(stderr, "kernel_launch: built for a 256-CU device (one workgroup per CU); got %d\n", grid);
    }
    if (grid < 0) return;
    hipMemsetAsync((char*)d_ws + WS_CTL, 0, CTL_BYTES, stream);
    Params p{};
    p.x = (const float*)d_in[0]; p.mem = (const float*)d_in[1]; p.pos = (const int*)d_in[2];
    p.a_w_in = (const float*)d_in[3]; p.a_b_f = (const float*)d_in[4]; p.a_w_out = (const float*)d_in[5];
    p.b_w_in = (const float*)d_in[6]; p.b_g_q = (const float*)d_in[7]; p.b_w_uq = (const float*)d_in[8]; p.b_w_out = (const float*)d_in[9];
    p.kv_w_dkv = (const float*)d_in[10]; p.kv_g = (const float*)d_in[11]; p.kv_w_ukv = (const float*)d_in[12]; p.mem_w_kv = (const float*)d_in[13];
    p.ln_g = (const float*)d_in[14]; p.ln_b = (const float*)d_in[15]; p.moe_w_r = (const float*)d_in[16]; p.moe_b_r = (const float*)d_in[17];
    p.moe_w_gu = (const float*)d_in[18]; p.moe_b_gu = (const float*)d_in[19]; p.moe_w_dn = (const float*)d_in[20]; p.moe_b_dn = (const float*)d_in[21];
    p.out = (float*)d_out; p.ws = (unsigned char*)d_ws;
    if (MK_N_LAUNCHES == 1) {
        p.ph_lo = 0; p.ph_hi = N_PHASES; p.use_grid_sync = 1;
        void* args[] = {&p};
        hipError_t e = hipLaunchCooperativeKernel((const void*)mega_fwd, dim3(grid), dim3(NTHREADS), args, LDS_BYTES, stream);
        if (e != hipSuccess) fprintf(stderr, "kernel_launch: cooperative launch failed: %s (grid %d)\n", hipGetErrorString(e), grid);
    } else {
        for (int ph = 0; ph < N_PHASES; ++ph) {
            p.ph_lo = ph; p.ph_hi = ph + 1; p.use_grid_sync = 0;
            hipLaunchKernelGGL(mega_fwd, dim3(grid), dim3(NTHREADS), LDS_BYTES, stream, p);
        }
    }
}
```

```cpp
#include <hip/hip_runtime.h>
#include <hip/hip_cooperative_groups.h>
#include <cstdio>
#include <cstdint>
#include <cmath>
namespace cg = cooperative_groups;

#define DI __device__ __forceinline__
#define LAS __attribute__((address_space(3)))
typedef unsigned short bf16_t;
typedef short bf16x8 __attribute__((ext_vector_type(8)));
typedef float f32x4 __attribute__((ext_vector_type(4)));
typedef float f32x2 __attribute__((ext_vector_type(2)));
typedef float f32x16 __attribute__((ext_vector_type(16)));
typedef unsigned u32x4 __attribute__((ext_vector_type(4)));
typedef unsigned u32x2 __attribute__((ext_vector_type(2)));
typedef int i32x4 __attribute__((ext_vector_type(4)));
typedef int i32x8 __attribute__((ext_vector_type(8)));
typedef long i64x4 __attribute__((ext_vector_type(4)));
typedef __bf16 bf16x2_t __attribute__((ext_vector_type(2)));

constexpr int NB = 2, SEQ = 8192, T = NB * SEQ, DM = 1024;
constexpr int NH = 12, NMEM = 256;
constexpr int FOX_IN = 2572;
constexpr int NE = 32;
constexpr float LOG2E = 1.4426950408889634f;
constexpr float ALPHA = 1.4142135623730951f;
constexpr float LN_EPS = 1e-5f, RMS_EPS = 1e-6f;
constexpr int NTHREADS = 512;
constexpr int LDS_BYTES = 131072 + 4096 + 8 * 1280 + 512;
constexpr int LDS_R1X = 131072 + 4096;
constexpr int LDS_CTL = 131072;
constexpr int SLOT_ROWS = 65536 + NE * 256;

constexpr size_t al256(size_t x) { return (x + 255) & ~(size_t)255; }
constexpr size_t WS_CTL = 0, CTL_BYTES = 65536;
constexpr size_t WS_W_AIN = al256(WS_CTL + CTL_BYTES);
constexpr size_t WS_W_AOUT = al256(WS_W_AIN + (size_t)2560 * 1024 * 2);
constexpr size_t WS_W_BIN = al256(WS_W_AOUT + (size_t)1024 * 1024 * 2);
constexpr size_t WS_W_UQ = al256(WS_W_BIN + (size_t)1024 * 1024 * 2);
constexpr size_t WS_W_UKV = al256(WS_W_UQ + (size_t)1280 * 384 * 2);
constexpr size_t WS_W_BOUT = al256(WS_W_UKV + (size_t)1536 * 256 * 2);
constexpr size_t WS_W_MKV = al256(WS_W_BOUT + (size_t)1024 * 1024 * 2);
constexpr size_t WS_W_GU = al256(WS_W_MKV + (size_t)2 * 512 * 1024 * 2);
constexpr size_t WS_W_DN = al256(WS_W_GU + (size_t)2 * 32 * 2048 * 1024 * 2);
constexpr size_t WS_XB = al256(WS_W_DN + (size_t)2 * 32 * 1024 * 1024 * 2);
constexpr size_t WS_MEMB = al256(WS_XB + (size_t)T * 1024 * 2);
constexpr size_t WS_LOGF = al256(WS_MEMB + (size_t)512 * 1024 * 2);
constexpr size_t WS_CUM = al256(WS_LOGF + (size_t)24 * 8192 * 4);
constexpr size_t WS_Q = al256(WS_CUM + (size_t)24 * 8192 * 4);
constexpr size_t WS_K = al256(WS_Q + (size_t)T * 1152 * 2);
constexpr size_t WS_VT = al256(WS_K + (size_t)T * 1152 * 2);
constexpr size_t WS_MQ = al256(WS_VT + (size_t)1536 * 8192 * 2);
constexpr size_t WS_MK = al256(WS_MQ + (size_t)T * 256 * 2);
constexpr size_t WS_MVT = al256(WS_MK + (size_t)2 * 512 * 256 * 2);
constexpr size_t WS_MERGED = al256(WS_MVT + (size_t)2 * 2 * 256 * 256 * 2);
constexpr size_t WS_Y = al256(WS_MERGED + (size_t)T * 1024 * 2);
constexpr size_t WS_X1 = al256(WS_Y + (size_t)T * 1024 * 4);
constexpr size_t WS_X1B = al256(WS_X1 + (size_t)T * 1024 * 4);
constexpr size_t WS_PE = al256(WS_X1B + (size_t)T * 1024 * 2);
constexpr size_t WS_PPOS = al256(WS_PE + (size_t)T * 4 * 4);
constexpr size_t WS_GATE = al256(WS_PPOS + (size_t)T * 4 * 4);
constexpr size_t WS_TOKOF = al256(WS_GATE + (size_t)T * 4 * 4);
constexpr size_t WS_H = al256(WS_TOKOF + (size_t)NE * T * 4);
constexpr size_t WS_YE = al256(WS_H + (size_t)SLOT_ROWS * 1024 * 2);
constexpr size_t WS_LAT = al256(WS_YE + (size_t)SLOT_ROWS * 1024 * 2);
constexpr size_t WS_CKV = al256(WS_LAT + (size_t)T * 1024 * 4);
constexpr size_t WS_CQ = al256(WS_CKV + (size_t)T * 256 * 2);
constexpr size_t WS_X2 = al256(WS_CQ + (size_t)T * 384 * 2);
constexpr size_t WS_KN2 = al256(WS_X2 + (size_t)T * 1024 * 4);
constexpr size_t WS_WRT = al256(WS_KN2 + (size_t)24 * 128 * 4);
constexpr size_t WS_WRH = al256(WS_WRT + (size_t)2 * 32 * 1024 * 4);
constexpr size_t WS_WRL = al256(WS_WRH + (size_t)2 * 32 * 1024 * 2);
constexpr size_t WS_SGU = al256(WS_WRL + (size_t)2 * 32 * 1024 * 2);
constexpr size_t WS_SDN = al256(WS_SGU + (size_t)2 * 32 * 2048 * 4);
constexpr size_t WS_SAS = al256(WS_SDN + (size_t)2 * 32 * 1024 * 4);
constexpr size_t WS_END = al256(WS_SAS + (size_t)NE * T * 4);
constexpr int CW_CNT = 8192;
constexpr int CW_WORK = 256;
constexpr int CW_BAR = 4096;

struct Params {
    const float* x; const float* mem; const int* pos;
    const float *a_w_in, *a_b_f, *a_w_out, *b_w_in, *b_g_q, *b_w_uq, *b_w_out, *kv_w_dkv, *kv_g, *kv_w_ukv, *mem_w_kv, *ln_g, *ln_b;
    const float *moe_w_r, *moe_b_r, *moe_w_gu, *moe_b_gu, *moe_w_dn, *moe_b_dn;
    float* out; unsigned char* ws; int ph_lo, ph_hi; int use_grid_sync, pad;
};

#define KP ((const __attribute__((address_space(4))) Params*)__builtin_amdgcn_kernarg_segment_ptr())
DI unsigned cvtpk(float lo, float hi) { f32x2 v = {lo, hi}; bf16x2_t b = __builtin_convertvector(v, bf16x2_t); return __builtin_bit_cast(unsigned, b); }
DI float bf2f(unsigned short b) { return __uint_as_float(((unsigned)b) << 16); }
DI float wave_sum(float v) {
#pragma unroll
    for (int o = 1; o < 64; o <<= 1) v += __shfl_xor(v, o);
    return v;
}
DI float wave_max(float v) {
#pragma unroll
    for (int o = 1; o < 64; o <<= 1) v = fmaxf(v, __shfl_xor(v, o));
    return v;
}

DI void sincos_cw(float x, float& sn, float& cs) {
    int j = (int)(x * 1.27323954473516f); j = (j + 1) & ~1;
    const float y = (float)j;
    const float r = ((x - y * 0.78515625f) - y * 2.4187564849853515625e-4f) - y * 3.77489497744594108e-8f;
    const float z = r * r;
    const float sp = ((-1.9515295891e-4f * z + 8.3321608736e-3f) * z - 1.6666654611e-1f) * z * r + r;
    const float cp = ((2.443315711809948e-5f * z - 1.388731625493765e-3f) * z + 4.166664568298827e-2f) * z * z - 0.5f * z + 1.0f;
    const int q = (j >> 1) & 3;
    const float s0 = (q & 1) ? cp : sp, c0 = (q & 1) ? sp : cp;
    sn = (q & 2) ? -s0 : s0;
    cs = ((q + 1) & 2) ? -c0 : c0;
}
DI float fadd_s(float a, float b) { float r; asm("v_add_f32_e32 %0, %1, %2" : "=v"(r) : "v"(a), "v"(b)); return r; }
DI int vlane() { int l; asm volatile("v_mbcnt_lo_u32_b32 %0, -1, 0\n\tv_mbcnt_hi_u32_b32 %0, -1, %0" : "=v"(l)); return l; }
#define LDS_WAIT() asm volatile("s_waitcnt lgkmcnt(0)" ::: "memory")
#define VM_WAIT() asm volatile("s_waitcnt vmcnt(0)" ::: "memory")

#ifndef GEMM_TOKPF
#define GEMM_TOKPF 2
#endif
namespace pg8 {
constexpr int BM = 256, BK = 64, HALF = 128, HTB = HALF * BK * 2, STAGE_BYTES = 8 * HTB, NXCD = 8, WGM = 8;
DI int lds_byte(int r, int c) { const int st = (r >> 4) * 2 + (c >> 5), rr = r & 15, cc = c & 31, ob = rr * 64 + cc * 2; return st * 1024 + (ob ^ (((ob >> 9) & 1) << 5)); }
DI void stage_rc(int b, int& R, int& C) { const int st = b / 1024, sb = b % 1024, swz = sb ^ (((sb >> 9) & 1) << 5); R = (st >> 1) * 16 + swz / 64; C = (st & 1) * 32 + (swz % 64) / 2; }
DI int perm32(int rho) { const int n = rho >> 4, i = rho & 15; return 8 * (i >> 2) + 4 * n + (i & 3); }
struct Unit { int pm, pn; };
struct Gemm { const bf16_t* A; const bf16_t* Bt; int K; };
struct StaticOrder {
    int nM, nN, nwg, G, c, K2;
    DI void init(int M, int N, int K, int G_, int c_) { nM = M / BM; nN = N / BM; nwg = nM * nN; G = G_; c = c_; K2 = K * 2; }
    DI bool next(int i, Unit& u) const {
        const long L = (long)i * G + c; if (L >= nwg) return false;
        int wgid = (int)L; { const int q = nwg / NXCD, r = nwg % NXCD, xcd = wgid % NXCD, off = wgid / NXCD; wgid = (xcd < r ? xcd * (q + 1) : r * (q + 1) + (xcd - r) * q) + off; }
        const int nig = WGM * nN, gid = wgid / nig, fm = gid * WGM, gsz = (nM - fm) < WGM ? (nM - fm) : WGM;
        u.pm = fm + ((wgid % nig) % gsz); u.pn = (wgid % nig) / gsz; return true;
    }
    DI unsigned a_off(const Unit& u, int r) const { return (unsigned)(u.pm * BM + r) * (unsigned)K2; }
    DI unsigned a_off_pf(const Unit& u, int r, int) const { return a_off(u, r); }
    DI void prefetch(const Unit&, int, int, int) const {}
    DI void a_ready(const Unit&) const {}
    DI void done(const Unit&) const {}
};

template <class Epi, class Sched, bool ALIGN_EPI, int MODE = 0>
DI void gemm_phase(LAS unsigned char* lds, const Gemm g, const Sched& S, const Epi& E, const int wid) {
    const int lane = vlane(), tid = wid * 64 + lane, wr = wid >> 2, wc = wid & 3, fr = lane & 15, fq = lane >> 4;
    const int K = g.K, nt = K / BK;
    int RA[2]; unsigned cA2[2], voffB[2];
#pragma unroll
    for (int i = 0; i < 2; ++i) { int R, C; stage_rc(tid * 16 + i * 8192, R, C); const int Rb = Epi::PERM ? ((R & ~31) + perm32(R & 31)) : R;
        RA[i] = R; cA2[i] = (unsigned)C * 2u; voffB[i] = (unsigned)(Rb * K + C) * 2u; }
    const size_t kstep = (size_t)(BK * 2);
    const size_t hstep = (size_t)HALF * K * 2;
    const size_t tstep = 2 * hstep;
    const unsigned ldsw = (unsigned)wid * 1024u;
    const int aoff = lds_byte(wr * 64 + fr, fq * 8), boff = lds_byte(wc * 32 + fr, fq * 8);
#define PG8_SA(b, h) (((b) * 2 + (h)) * HTB)
#define PG8_SB(b, h) ((4 + (b) * 2 + (h)) * HTB)
#define PG8_STAGE_B(bufoff, gbase) do { _Pragma("unroll") for (int _i = 0; _i < 2; ++_i) \
        __builtin_amdgcn_global_load_lds((const unsigned*)((const char*)(gbase) + voffB[_i]), (LAS unsigned*)(lds + (bufoff) + ldsw + _i * 8192), 16, 0, 0); } while (0)
#define PG8_STAGE_A(bufoff, kbytes, uo) do { _Pragma("unroll") for (int _i = 0; _i < 2; ++_i) \
        __builtin_amdgcn_global_load_lds((const unsigned*)((const char*)g.A + (kbytes) + (uo)[_i]), (LAS unsigned*)(lds + (bufoff) + ldsw + _i * 8192), 16, 0, 0); } while (0)
#define PG8_STAGE_A2(bufoff, kbytes, h) do { _Pragma("unroll") for (int _i = 0; _i < 2; ++_i) \
        __builtin_amdgcn_global_load_lds((const unsigned*)((const char*)g.A + (kbytes) + (last ? uN[h][_i] : uC[h][_i])), (LAS unsigned*)(lds + (bufoff) + ldsw + _i * 8192), 16, 0, 0); } while (0)
#define PG8_LDA(dst, b, h) do { _Pragma("unroll") for (int m = 0; m < 4; ++m) { dst[m].lo = *(const LAS i32x4*)(lds + PG8_SA(b, h) + aoff + m * 2048); dst[m].hi = *(const LAS i32x4*)(lds + PG8_SA(b, h) + aoff + m * 2048 + 1024); } } while (0)
#define PG8_LDB(dst, b, h) do { _Pragma("unroll") for (int n = 0; n < 2; ++n) { dst[n].lo = *(const LAS i32x4*)(lds + PG8_SB(b, h) + boff + n * 2048); dst[n].hi = *(const LAS i32x4*)(lds + PG8_SB(b, h) + boff + n * 2048 + 1024); } } while (0)
#define PG8_MMA(ai, bj, At, Bt) do { __builtin_amdgcn_s_setprio(1); _Pragma("unroll") for (int m = 0; m < 4; ++m) _Pragma("unroll") for (int n = 0; n < 2; ++n) { \
        if constexpr (MODE == 2) acc[ai][bj][m][n] = __builtin_amdgcn_mfma_scale_f32_16x16x128_f8f6f4(Bt[n], At[m], acc[ai][bj][m][n], 0, 0, 0, 0, 0, 0); \
        else if constexpr (MODE == 3) { const i64x4 b4_ = __builtin_bit_cast(i64x4, Bt[n]), a4_ = __builtin_bit_cast(i64x4, At[m]); _Pragma("unroll") for (int q = 0; q < 4; ++q) acc[ai][bj][m][n] = __builtin_amdgcn_mfma_f32_16x16x32_fp8_fp8(b4_[q], a4_[q], acc[ai][bj][m][n], 0, 0, 0); } \
        else if constexpr (MODE == 1) { acc[ai][bj][m][n] = __builtin_bit_cast(f32x4, __builtin_amdgcn_mfma_i32_16x16x64_i8(Bt[n].lo, At[m].lo, __builtin_bit_cast(i32x4, acc[ai][bj][m][n]), 0, 0, 0)); \
                                        acc[ai][bj][m][n] = __builtin_bit_cast(f32x4, __builtin_amdgcn_mfma_i32_16x16x64_i8(Bt[n].hi, At[m].hi, __builtin_bit_cast(i32x4, acc[ai][bj][m][n]), 0, 0, 0)); } \
        else { const i32x4 bl_ = Bt[n].lo, bh_ = Bt[n].hi, al_ = At[m].lo, ah_ = At[m].hi;     \
               acc[ai][bj][m][n] = __builtin_amdgcn_mfma_f32_16x16x32_bf16(__builtin_bit_cast(bf16x8, bl_), __builtin_bit_cast(bf16x8, al_), acc[ai][bj][m][n], 0, 0, 0); \
               acc[ai][bj][m][n] = __builtin_amdgcn_mfma_f32_16x16x32_bf16(__builtin_bit_cast(bf16x8, bh_), __builtin_bit_cast(bf16x8, ah_), acc[ai][bj][m][n], 0, 0, 0); } } __builtin_amdgcn_s_setprio(0); } while (0)
#define PG8_WAIT_V(n) asm volatile("s_waitcnt vmcnt(" #n ")" ::: "memory")
#define PG8_WAIT_L(n) asm volatile("s_waitcnt lgkmcnt(" #n ")" ::: "memory")
#define PG8_BAR __builtin_amdgcn_s_barrier()
#define PG8_SCHED __builtin_amdgcn_sched_barrier(0)
    Unit cur, nxt; int ui = 0;
    if (!S.next(0, cur)) return;
    f32x4 acc[2][2][4][2];
#pragma unroll
    for (int a = 0; a < 2; ++a)
#pragma unroll
        for (int b = 0; b < 2; ++b)
#pragma unroll
            for (int m = 0; m < 4; ++m)
#pragma unroll
                for (int n = 0; n < 2; ++n) acc[a][b][m][n] = (f32x4){0.f, 0.f, 0.f, 0.f};
    i32x8 At[4], B0[2], B1[2];
    unsigned uC[2][2], uN[2][2];
#pragma unroll
    for (int h = 0; h < 2; ++h)
#pragma unroll
        for (int i = 0; i < 2; ++i) uC[h][i] = S.a_off(cur, h * HALF + RA[i]) + cA2[i];
    const char* cB = (const char*)g.Bt + (size_t)cur.pn * tstep;
    S.a_ready(cur);
    PG8_STAGE_B(PG8_SB(0, 0), cB); PG8_STAGE_B(PG8_SB(0, 1), cB + hstep); PG8_STAGE_A(PG8_SA(0, 0), 0, uC[0]); PG8_STAGE_A(PG8_SA(0, 1), 0, uC[1]);
    if (wr == 1) PG8_BAR;
    PG8_WAIT_V(2); PG8_BAR;
    PG8_STAGE_B(PG8_SB(1, 0), cB + kstep); PG8_STAGE_A(PG8_SA(1, 0), kstep, uC[0]); PG8_STAGE_B(PG8_SB(1, 1), cB + hstep + kstep);
    PG8_WAIT_V(6); PG8_BAR;
    for (;;) {
        const bool has_next = S.next(ui + 1, nxt);
        const char* nB = has_next ? (const char*)g.Bt + (size_t)nxt.pn * tstep : cB;
#if GEMM_TOKPF == 1
        if (has_next) S.prefetch(nxt, (ui + 1) & 1, wid, lane);
#elif GEMM_TOKPF == 2
        {
            Unit nx2; const bool has2 = S.next(ui + 2, nx2);
            int RAn[2]; unsigned cAn[2];
            { const int tid2 = wid * 64 + vlane();
#pragma unroll
              for (int i = 0; i < 2; ++i) { int R, C; stage_rc(tid2 * 16 + i * 8192, R, C); RAn[i] = R; cAn[i] = (unsigned)C * 2u; } }
#pragma unroll
            for (int h = 0; h < 2; ++h)
#pragma unroll
                for (int i = 0; i < 2; ++i) uN[h][i] = has_next ? ((ui == 0 ? S.a_off(nxt, h * HALF + RAn[i]) : S.a_off_pf(nxt, h * HALF + RAn[i], (ui + 1) & 1)) + cAn[i]) : uC[h][i];
            if (has2) S.prefetch(nx2, ui & 1, wid, lane);
        }
#else
#pragma unroll
        for (int h = 0; h < 2; ++h)
#pragma unroll
            for (int i = 0; i < 2; ++i) uN[h][i] = has_next ? (S.a_off(nxt, h * HALF + RA[i]) + cA2[i]) : uC[h][i];
#endif
#pragma nounroll
        for (int t = 0; t < nt; t += 2) {
            const bool last = (t == nt - 2);
            const size_t ka1 = (size_t)(t + 1) * kstep;
            const size_t ka2 = last ? (size_t)0 : (size_t)(t + 2) * kstep, ka3 = ka2 + kstep;
            const char* b2 = last ? nB : cB + (size_t)(t + 2) * kstep; const char* b3 = b2 + kstep;
#if GEMM_TOKPF == 1
            if (last) {
                if (has_next) S.a_ready(nxt);
#pragma unroll
                for (int h = 0; h < 2; ++h)
#pragma unroll
                    for (int i = 0; i < 2; ++i) uN[h][i] = has_next ? (S.a_off_pf(nxt, h * HALF + RA[i], (ui + 1) & 1) + cA2[i]) : uC[h][i];
            }
#endif
            PG8_LDB(B0, 0, 0); PG8_LDB(B1, 0, 1); PG8_SCHED; PG8_LDA(At, 0, 0); PG8_STAGE_A(PG8_SA(1, 1), ka1, uC[1]);
            PG8_WAIT_V(8); PG8_WAIT_L(0); PG8_BAR; PG8_MMA(0, 0, At, B0); PG8_MMA(0, 1, At, B1); PG8_BAR; PG8_SCHED;
            PG8_LDA(At, 0, 1); PG8_STAGE_B(PG8_SB(0, 0), b2); PG8_STAGE_B(PG8_SB(0, 1), b2 + hstep); PG8_STAGE_A2(PG8_SA(0, 0), ka2, 0);
            PG8_WAIT_V(8); PG8_WAIT_L(0); PG8_BAR; PG8_MMA(1, 0, At, B0); PG8_MMA(1, 1, At, B1); PG8_BAR; PG8_SCHED;
            PG8_LDB(B0, 1, 0); PG8_LDB(B1, 1, 1); PG8_SCHED; PG8_LDA(At, 1, 0); PG8_STAGE_A2(PG8_SA(0, 1), ka2, 1);
            PG8_WAIT_V(8); PG8_WAIT_L(0); PG8_BAR; PG8_MMA(0, 0, At, B0); PG8_MMA(0, 1, At, B1); PG8_BAR; PG8_SCHED;
            PG8_LDA(At, 1, 1); PG8_STAGE_B(PG8_SB(1, 0), b3); PG8_STAGE_B(PG8_SB(1, 1), b3 + hstep); PG8_STAGE_A2(PG8_SA(1, 0), ka3, 0);
            PG8_WAIT_V(8); PG8_WAIT_L(0); PG8_BAR; PG8_MMA(1, 0, At, B0); PG8_MMA(1, 1, At, B1); PG8_BAR; PG8_SCHED;
        }
        if constexpr (ALIGN_EPI) { if (wr == 0) PG8_BAR; }
        E(acc, cur, wr, wc, fr, fq); S.done(cur);
        if (!has_next) break;
#pragma unroll
        for (int a = 0; a < 2; ++a)
#pragma unroll
            for (int b = 0; b < 2; ++b)
#pragma unroll
                for (int m = 0; m < 4; ++m)
#pragma unroll
                    for (int n = 0; n < 2; ++n) acc[a][b][m][n] = (f32x4){0.f, 0.f, 0.f, 0.f};
        cur = nxt; cB = nB; ++ui;
#pragma unroll
        for (int h = 0; h < 2; ++h)
#pragma unroll
            for (int i = 0; i < 2; ++i) uC[h][i] = uN[h][i];
        if constexpr (ALIGN_EPI) { if (wr == 1) PG8_BAR; }
    }
    PG8_WAIT_V(0);
    if constexpr (!ALIGN_EPI) { if (wr == 0) PG8_BAR; }
    PG8_BAR;
#undef PG8_SA
#undef PG8_SB
#undef PG8_STAGE_A
#undef PG8_STAGE_A2
#undef PG8_STAGE_B
#undef PG8_LDA
#undef PG8_LDB
#undef PG8_MMA
#undef PG8_WAIT_V
#undef PG8_WAIT_L
#undef PG8_BAR
#undef PG8_SCHED
}
}

struct Dst { bf16_t* O; int ldo, row0, col0, nvalid; float scale; bool headmap; };
template <class Route> struct EpiBf16R {
    static constexpr bool PERM = true;
    Route R;
    DI void operator()(const f32x4 (&acc)[2][2][4][2], const pg8::Unit& u, int wr, int wc, int fr, int fq) const {
        const Dst d = R(u);
#pragma unroll
        for (int ai = 0; ai < 2; ++ai)
#pragma unroll
            for (int m = 0; m < 4; ++m) {
                bf16_t* rowp = d.O + (size_t)(d.row0 + ai * 128 + wr * 64 + m * 16 + fr) * d.ldo + d.col0;
#pragma unroll
                for (int bj = 0; bj < 2; ++bj) {
                    const int c = bj * 128 + wc * 32 + 8 * fq;
                    if (c < d.nvalid) {
                        const f32x4 v0 = acc[ai][bj][m][0] * d.scale, v1 = acc[ai][bj][m][1] * d.scale;
                        u32x4 w; w.x = cvtpk(v0[0], v0[1]); w.y = cvtpk(v0[2], v0[3]); w.z = cvtpk(v1[0], v1[1]); w.w = cvtpk(v1[2], v1[3]);
                        const int oc = d.headmap ? ((c >> 6) * 96 + (c & 63)) : c;
                        *(u32x4*)(rowp + oc) = w;
                    }
                }
            }
    }
};
struct EpiResF32 {
    static constexpr bool PERM = false;
    float* Y; const float* X;
    DI void operator()(const f32x4 (&acc)[2][2][4][2], const pg8::Unit& u, int wr, int wc, int fr, int fq) const {
#pragma unroll
        for (int ai = 0; ai < 2; ++ai)
#pragma unroll
            for (int m = 0; m < 4; ++m) {
                const size_t ro = (size_t)(u.pm * 256 + ai * 128 + wr * 64 + m * 16 + fr) * DM + u.pn * 256 + wc * 32 + 4 * fq;
#pragma unroll
                for (int bj = 0; bj < 2; ++bj)
#pragma unroll
                    for (int n = 0; n < 2; ++n) {
                        const f32x4 xv = *(const f32x4*)(X + ro + bj * 128 + n * 16);
                        *(f32x4*)(Y + ro + bj * 128 + n * 16) = xv * ALPHA + acc[ai][bj][m][n];
                    }
            }
    }
};
struct EpiLat {
    static constexpr bool PERM = false;
    float* O; int ncol;
    DI void operator()(const f32x4 (&acc)[2][2][4][2], const pg8::Unit& u, int wr, int wc, int fr, int fq) const {
#pragma unroll
        for (int ai = 0; ai < 2; ++ai)
#pragma unroll
            for (int m = 0; m < 4; ++m) {
                const int c0 = u.pn * 256 + wc * 32 + 4 * fq;
                float* rowp = O + (size_t)(u.pm * 256 + ai * 128 + wr * 64 + m * 16 + fr) * 1024;
#pragma unroll
                for (int bj = 0; bj < 2; ++bj)
#pragma unroll
                    for (int n = 0; n < 2; ++n) { const int c = c0 + bj * 128 + n * 16; if (c < ncol) *(f32x4*)(rowp + c) = acc[ai][bj][m][n]; }
            }
    }
};
struct EpiGU {
    static constexpr bool PERM = true;
    unsigned char* H; const float* bias; const float* sw; const float* sas; const LAS int* tstart;
    DI void operator()(const f32x4 (&acc)[2][2][4][2], const pg8::Unit& u, int wr, int wc, int fr, int fq) const {
        const int e = u.pn >> 3, ct = u.pn & 7;
        const int j = ct * 128 + wc * 32 + 8 * fq;
        const float* be = bias + (size_t)e * 2048;
        const float* se = sw + (size_t)e * 2048 + ct * 256 + wc * 32 + 8 * fq;
        const float* sa = sas + (size_t)e * T + (u.pm - tstart[e]) * 256 + wr * 64 + fr;
        f32x4 bg[2], bu[2], sg_[2], su_[2];
#pragma unroll
        for (int n = 0; n < 2; ++n) { bg[n] = *(const f32x4*)(be + j + 4 * n); bu[n] = *(const f32x4*)(be + 1024 + j + 4 * n); sg_[n] = *(const f32x4*)(se + 4 * n); su_[n] = *(const f32x4*)(se + 128 + 4 * n); }
#pragma unroll
        for (int ai = 0; ai < 2; ++ai)
#pragma unroll
            for (int m = 0; m < 4; ++m) {
                float h[8];
                const float st = sa[ai * 128 + m * 16];
#pragma unroll
                for (int n = 0; n < 2; ++n)
#pragma unroll
                    for (int i = 0; i < 4; ++i) {
                        const float gg = fminf((float)__float_as_int(acc[ai][0][m][n][i]) * (st * sg_[n][i]) + bg[n][i], 7.0f);
                        const float uu = fminf(fmaxf((float)__float_as_int(acc[ai][1][m][n][i]) * (st * su_[n][i]) + bu[n][i], -7.0f), 7.0f);
                        const float sg = __builtin_amdgcn_rcpf(1.0f + __builtin_amdgcn_exp2f(-1.702f * LOG2E * gg));
                        h[4 * n + i] = (uu + 1.0f) * (gg * sg);
                    }
                u32x2 w;
                w.x = (unsigned)__builtin_amdgcn_cvt_pk_fp8_f32(h[2], h[3], __builtin_amdgcn_cvt_pk_fp8_f32(h[0], h[1], 0, false), true);
                w.y = (unsigned)__builtin_amdgcn_cvt_pk_fp8_f32(h[6], h[7], __builtin_amdgcn_cvt_pk_fp8_f32(h[4], h[5], 0, false), true);
                *(u32x2*)(H + (size_t)(u.pm * 256 + ai * 128 + wr * 64 + m * 16 + fr) * 1024 + j) = w;
            }
    }
};
struct EpiDN {
    static constexpr bool PERM = true;
    bf16_t* Y; const float* bias; const float* sw;
    DI void operator()(const f32x4 (&acc)[2][2][4][2], const pg8::Unit& u, int wr, int wc, int fr, int fq) const {
        const int e = u.pn >> 2, ct = u.pn & 3;
        const float* be = bias + (size_t)e * 1024; const float* se = sw + (size_t)e * 1024;
#pragma unroll
        for (int bj = 0; bj < 2; ++bj) {
            const int c = ct * 256 + bj * 128 + wc * 32 + 8 * fq;
            const f32x4 b0 = *(const f32x4*)(be + c), b1 = *(const f32x4*)(be + c + 4), s0 = *(const f32x4*)(se + c), s1 = *(const f32x4*)(se + c + 4);
#pragma unroll
            for (int ai = 0; ai < 2; ++ai)
#pragma unroll
                for (int m = 0; m < 4; ++m) {
                    const f32x4 v0 = acc[ai][bj][m][0] * s0 + b0, v1 = acc[ai][bj][m][1] * s1 + b1;
                    u32x4 w; w.x = cvtpk(v0[0], v0[1]); w.y = cvtpk(v0[2], v0[3]); w.z = cvtpk(v1[0], v1[1]); w.w = cvtpk(v1[2], v1[3]);
                    *(u32x4*)(Y + (size_t)(u.pm * 256 + ai * 128 + wr * 64 + m * 16 + fr) * 1024 + c) = w;
                }
        }
    }
};
struct Frame {
    LAS unsigned char* lds; unsigned* ctl; unsigned char* ws; int tid, lane, wid; int G, bid;
};
struct MoeOrder {
    const LAS int* tstart; int sh; bool gather; const int* tokof; const LAS int* tokbuf; const LAS int* ulist; unsigned pitch;
    static DI void build(Frame& F, const LAS int* tstart, int nNt, LAS int* ulist) {
        __syncthreads();
        const int nwg = tstart[32] * nNt;
        if (F.tid == 0) ulist[0] = 0;
        __syncthreads();
        if (F.tid < 24) {
            const long L = (long)F.tid * F.G + F.bid;
            if (L < nwg) {
                int wgid = (int)L; { const int q = nwg / 8, r = nwg % 8, xcd = wgid % 8, off = wgid / 8; wgid = (xcd < r ? xcd * (q + 1) : r * (q + 1) + (xcd - r) * q) + off; }
                int e = 0;
                for (int k = 1; k < 32; ++k) if (tstart[k] * nNt <= wgid) e = k;
                const int rem = wgid - tstart[e] * nNt, nte = tstart[e + 1] - tstart[e];
                const int ct = rem / nte, rt = rem % nte;
                ulist[4 + 4 * F.tid] = tstart[e] + rt; ulist[5 + 4 * F.tid] = e * nNt + ct; ulist[6 + 4 * F.tid] = e; ulist[7 + 4 * F.tid] = rt;
                __hip_atomic_fetch_add(ulist, 1, __ATOMIC_RELAXED, __HIP_MEMORY_SCOPE_WORKGROUP);
            }
        }
        __syncthreads();
    }
    DI bool next(int i, pg8::Unit& u) const {
        if (i >= ulist[0]) return false;
        u.pm = ulist[4 + 4 * i]; u.pn = ulist[5 + 4 * i]; return true;
    }
    DI unsigned a_off(const pg8::Unit& u, int r) const {
        if (!gather) return (unsigned)(u.pm * 256 + r) * pitch;
        const int e = u.pn >> sh, idx = (u.pm - tstart[e]) * 256 + r;
        const int t = idx < tstart[80 + e] ? tokof[(size_t)e * T + idx] : 0;
        return (unsigned)t * pitch;
    }
    DI void prefetch(const pg8::Unit& u, int slot, int wid, int lane) const {
        if (gather && wid == 0) {
            const int e = u.pn >> sh, rt = u.pm - tstart[e];
            __builtin_amdgcn_global_load_lds((const unsigned*)(tokof + (size_t)e * T + rt * 256 + vlane() * 4), (LAS unsigned*)((LAS unsigned char*)tokbuf + slot * 1024), 16, 0, 0);
        }
    }
    DI unsigned a_off_pf(const pg8::Unit& u, int r, int slot) const {
        if (!gather) return (unsigned)(u.pm * 256 + r) * pitch;
        const int e = u.pn >> sh, idx = (u.pm - tstart[e]) * 256 + r;
        const int t = idx < tstart[80 + e] ? tokbuf[slot * 256 + r] : 0;
        return (unsigned)t * pitch;
    }
    DI void a_ready(const pg8::Unit&) const {}
    DI void done(const pg8::Unit&) const {}
};

DI int crow(int r, int hi) { return (r & 3) + 8 * (r >> 2) + 4 * hi; }
template <int DK, bool FOX, bool ROPEQ>
DI void attn_unit(LAS unsigned char* lds, const bf16_t* Q, int ldq, const bf16_t* Kp, int ldk, const bf16_t* Vt, int ldv,
                  const float* cum, bf16_t* O, int ldo, int q0, int ntiles, bool causal, const int* pos, const int wid, const float* kn2 = nullptr) {
    constexpr int PK = DK * 2 + 16, KBYTES = 64 * PK, VBYTES = 64 * 136, BUF = KBYTES + VBYTES + 256, KCH = DK / 8, NS = DK / 16;
    const int lane = vlane(), tid = wid * 64 + lane, r32 = lane & 31, hi = lane >> 5;
    const int qw0 = q0 + wid * 32, qrow = qw0 + r32;
    bf16x8 qf[NS];
#pragma unroll
    for (int s = 0; s < NS; ++s) qf[s] = *(const bf16x8*)(Q + (size_t)qrow * ldq + 16 * s + 8 * hi);
    if constexpr (ROPEQ) {
        const float p = (float)pos[qrow];
#pragma unroll
        for (int j = 0; j < 8; ++j) {
            const int i = 8 * hi + j;
            const float inv = exp2f(-(float)i * (13.287712379549449f / 16.0f));
            float sn, cs; sincos_cw(p * inv, sn, cs);
            const float x1 = bf2f((unsigned short)qf[4][j]), x2 = bf2f((unsigned short)qf[5][j]);
            const float o1 = x1 * cs - x2 * sn, o2 = x1 * sn + x2 * cs;
            qf[4][j] = (short)(cvtpk(o1, 0.f) & 0xffffu); qf[5][j] = (short)(cvtpk(o2, 0.f) & 0xffffu);
        }
    }
    const float cq = FOX ? cum[qrow] : 0.f;
    int jstart = 0; float prune_c = 0.f;
    if constexpr (FOX) {
        LAS float* red = (LAS float*)(lds + 2 * BUF);
        float ss = 0.f;
#pragma unroll
        for (int s = 0; s < NS; ++s)
#pragma unroll
            for (int j = 0; j < 8; ++j) { const float v = bf2f((unsigned short)qf[s][j]); ss += v * v; }
        ss += __shfl_xor(ss, 32);
        ss = wave_max(ss);
        float kk = 0.f;
        for (int j = tid; j < ntiles; j += NTHREADS) kk = fmaxf(kk, kn2[j]);
        kk = wave_max(kk);
        __syncthreads();
        if (lane == 0) { red[wid] = ss; red[8 + wid] = kk; }
        __syncthreads();
        float qm = red[0], km = red[8];
#pragma unroll
        for (int w = 1; w < 8; ++w) { qm = fmaxf(qm, red[w]); km = fmaxf(km, red[8 + w]); }
        prune_c = 2.0f * sqrtf(qm * km) * 1.01f + 65.0f;
        const float cq0 = cum[q0];
        int cand = ntiles;
        for (int j = tid; j < ntiles; j += NTHREADS) if (cq0 - cum[64 * j + 63] + prune_c >= 0.f) cand = min(cand, j);
#pragma unroll
        for (int o = 1; o < 64; o <<= 1) cand = min(cand, __shfl_xor(cand, o));
        __syncthreads();
        if (lane == 0) ((LAS int*)red)[16 + wid] = cand;
        __syncthreads();
        jstart = ((LAS int*)red)[16];
#pragma unroll
        for (int w = 1; w < 8; ++w) jstart = min(jstart, ((LAS int*)red)[16 + w]);
        jstart = min(jstart, ntiles - 4);
        __syncthreads();
    }
    const float cqw0 = FOX ? __shfl(cq, 0) : 0.f;
    f32x16 o0, o1;
#pragma unroll
    for (int r = 0; r < 16; ++r) { o0[r] = 0.f; o1[r] = 0.f; }
    float mrun = -1e30f, lrun = 0.f;
    const int kr0 = tid / KCH, kc0 = tid % KCH;
    const int kr1 = (tid + 512) / KCH, kc1 = (tid + 512) % KCH;
    const bool k2 = (DK == 96) && (tid < 256);
    const int vd = tid >> 3, vc = tid & 7;
    u32x4 kreg0, kreg1 = (u32x4){0, 0, 0, 0}, vreg; float creg = 0.f;
#define ATT_GLOAD(j) do { \
        kreg0 = *(const u32x4*)(Kp + (size_t)(64 * (j) + kr0) * ldk + kc0 * 8); \
        if (k2) kreg1 = *(const u32x4*)(Kp + (size_t)(64 * (j) + kr1) * ldk + kc1 * 8); \
        vreg = *(const u32x4*)(Vt + (size_t)vd * ldv + 64 * (j) + vc * 8); \
        if (FOX && tid < 64) creg = cum[64 * (j) + tid]; } while (0)
#define ATT_LWRITE(buf) do { LAS unsigned char* bb_ = lds + (buf) * BUF; \
        *(LAS u32x4*)(bb_ + kr0 * PK + kc0 * 16) = kreg0; \
        if (k2) *(LAS u32x4*)(bb_ + kr1 * PK + kc1 * 16) = kreg1; \
        *(LAS u32x2*)(bb_ + KBYTES + vd * 136 + vc * 16) = (u32x2){vreg.x, vreg.y}; \
        *(LAS u32x2*)(bb_ + KBYTES + vd * 136 + vc * 16 + 8) = (u32x2){vreg.z, vreg.w}; \
        if (FOX && tid < 64) *(LAS float*)(bb_ + KBYTES + VBYTES + tid * 4) = creg; } while (0)
    ATT_GLOAD(jstart); ATT_LWRITE(0); __syncthreads();
    for (int j = jstart; j < ntiles; ++j) {
        const int cur = (j - jstart) & 1;
        if (j + 1 < ntiles) ATT_GLOAD(j + 1);
        const LAS unsigned char* kb = lds + cur * BUF; const LAS unsigned char* vb = kb + KBYTES; const LAS unsigned char* cb = vb + VBYTES;
        bool active = !causal || (64 * j <= qw0 + 31);
        if constexpr (FOX) { if (cqw0 - *(const LAS float*)(cb + 63 * 4) + prune_c < 0.f) active = false; }
        if (active) {
            f32x16 sp0, sp1;
#pragma unroll
            for (int r = 0; r < 16; ++r) { sp0[r] = 0.f; sp1[r] = 0.f; }
#pragma unroll
            for (int s = 0; s < NS; ++s) {
                const bf16x8 k0 = *(const LAS bf16x8*)(kb + r32 * PK + 32 * s + 16 * hi);
                const bf16x8 k1 = *(const LAS bf16x8*)(kb + (32 + r32) * PK + 32 * s + 16 * hi);
                sp0 = __builtin_amdgcn_mfma_f32_32x32x16_bf16(k0, qf[s], sp0, 0, 0, 0);
                sp1 = __builtin_amdgcn_mfma_f32_32x32x16_bf16(k1, qf[s], sp1, 0, 0, 0);
            }
            __builtin_amdgcn_sched_barrier(0);
            if constexpr (FOX) {
#pragma unroll
                for (int g = 0; g < 4; ++g) {
                    const f32x4 c0 = *(const LAS f32x4*)(cb + (8 * g + 4 * hi) * 4);
                    const f32x4 c1 = *(const LAS f32x4*)(cb + (32 + 8 * g + 4 * hi) * 4);
#pragma unroll
                    for (int i = 0; i < 4; ++i) { sp0[4 * g + i] += cq - c0[i]; sp1[4 * g + i] += cq - c1[i]; }
                }
            }
            if (causal && (64 * j + 63 > qw0)) {
#pragma unroll
                for (int r = 0; r < 16; ++r) {
                    const int key = 64 * j + crow(r, hi);
                    if (key > qrow) sp0[r] = -1e30f;
                    if (key + 32 > qrow) sp1[r] = -1e30f;
                }
            }
            float mx = fmaxf(sp0[0], sp1[0]);
#pragma unroll
            for (int r = 1; r < 16; ++r) mx = fmaxf(mx, fmaxf(sp0[r], sp1[r]));
            mx = fmaxf(mx, __shfl_xor(mx, 32));
            const float mnew = fmaxf(mrun, mx);
            const float alpha = __builtin_amdgcn_exp2f(mrun - mnew);
            mrun = mnew;
            float ls = 0.f;
#pragma unroll
            for (int r = 0; r < 16; ++r) { sp0[r] = __builtin_amdgcn_exp2f(sp0[r] - mnew); sp1[r] = __builtin_amdgcn_exp2f(sp1[r] - mnew); ls += sp0[r] + sp1[r]; }
            lrun = lrun * alpha + ls;
#pragma unroll
            for (int r = 0; r < 16; ++r) { o0[r] *= alpha; o1[r] *= alpha; }
            __builtin_amdgcn_sched_barrier(0);
#pragma unroll
            for (int ks = 0; ks < 4; ++ks) {
                const int p = ks >> 1, s2 = ks & 1;
                u32x4 pw;
                if (p == 0) { pw.x = cvtpk(sp0[8 * s2 + 0], sp0[8 * s2 + 1]); pw.y = cvtpk(sp0[8 * s2 + 2], sp0[8 * s2 + 3]); pw.z = cvtpk(sp0[8 * s2 + 4], sp0[8 * s2 + 5]); pw.w = cvtpk(sp0[8 * s2 + 6], sp0[8 * s2 + 7]); }
                else        { pw.x = cvtpk(sp1[8 * s2 + 0], sp1[8 * s2 + 1]); pw.y = cvtpk(sp1[8 * s2 + 2], sp1[8 * s2 + 3]); pw.z = cvtpk(sp1[8 * s2 + 4], sp1[8 * s2 + 5]); pw.w = cvtpk(sp1[8 * s2 + 6], sp1[8 * s2 + 7]); }
                const bf16x8 pf = __builtin_bit_cast(bf16x8, pw);
                const int kbase = (32 * p + 16 * s2 + 4 * hi) * 2;
                {
                    const u32x2 lo = *(const LAS u32x2*)(vb + r32 * 136 + kbase), h2 = *(const LAS u32x2*)(vb + r32 * 136 + kbase + 16);
                    const bf16x8 vf = __builtin_bit_cast(bf16x8, (u32x4){lo.x, lo.y, h2.x, h2.y});
                    o0 = __builtin_amdgcn_mfma_f32_32x32x16_bf16(vf, pf, o0, 0, 0, 0);
                }
                {
                    const u32x2 lo = *(const LAS u32x2*)(vb + (32 + r32) * 136 + kbase), h2 = *(const LAS u32x2*)(vb + (32 + r32) * 136 + kbase + 16);
                    const bf16x8 vf = __builtin_bit_cast(bf16x8, (u32x4){lo.x, lo.y, h2.x, h2.y});
                    o1 = __builtin_amdgcn_mfma_f32_32x32x16_bf16(vf, pf, o1, 0, 0, 0);
                }
            }
        }
        if (j + 1 < ntiles) ATT_LWRITE(cur ^ 1);
        __syncthreads();
    }
#undef ATT_GLOAD
#undef ATT_LWRITE
    const float ltot = lrun + __shfl_xor(lrun, 32);
    const float inv = 1.0f / ltot;
#pragma unroll
    for (int g = 0; g < 4; ++g) {
        const int d0 = 8 * g + 4 * hi;
        u32x2 w0, w1;
        w0.x = cvtpk(o0[4 * g] * inv, o0[4 * g + 1] * inv); w0.y = cvtpk(o0[4 * g + 2] * inv, o0[4 * g + 3] * inv);
        w1.x = cvtpk(o1[4 * g] * inv, o1[4 * g + 1] * inv); w1.y = cvtpk(o1[4 * g + 2] * inv, o1[4 * g + 3] * inv);
        *(u32x2*)(O + (size_t)qrow * ldo + d0) = w0;
        *(u32x2*)(O + (size_t)qrow * ldo + 32 + d0) = w1;
    }
}


template <int DK, bool ROPEQ>
DI void attn_unit_pipe(LAS unsigned char* lds, const bf16_t* Q, int ldq, const bf16_t* Kp, int ldk, const bf16_t* Vt, int ldv,
                       bf16_t* O, int ldo, int q0, int ntiles, const int* pos, const int wid) {
    constexpr int PK = DK * 2 + 16, KBYTES = 64 * PK, VBYTES = 64 * 136, KCH = DK / 8, NS = DK / 16, VOFF = 2 * KBYTES;
    constexpr float THR = 6.0f;
    const int lane = vlane(), tid = wid * 64 + lane, r32 = lane & 31, hi = lane >> 5;
    const int qw0 = q0 + wid * 32, qrow = qw0 + r32;
    bf16x8 qf[NS];
#pragma unroll
    for (int s = 0; s < NS; ++s) qf[s] = *(const bf16x8*)(Q + (size_t)qrow * ldq + 16 * s + 8 * hi);
    if constexpr (ROPEQ) {
        const float p = (float)pos[qrow];
#pragma unroll
        for (int j = 0; j < 8; ++j) {
            const int i = 8 * hi + j;
            const float inv = exp2f(-(float)i * (13.287712379549449f / 16.0f));
            float sn, cs; sincos_cw(p * inv, sn, cs);
            const float x1 = bf2f((unsigned short)qf[NS - 2][j]), x2 = bf2f((unsigned short)qf[NS - 1][j]);
            const float o1 = x1 * cs - x2 * sn, o2 = x1 * sn + x2 * cs;
            qf[NS - 2][j] = (short)(cvtpk(o1, 0.f) & 0xffffu); qf[NS - 1][j] = (short)(cvtpk(o2, 0.f) & 0xffffu);
        }
    }
    const int kr0 = tid / KCH, kc0 = tid % KCH;
    const int kr1 = (tid + 512) / KCH, kc1 = (tid + 512) % KCH;
    const bool k2 = (DK == 96) && (tid < 256);
    const int vd = tid >> 3, vc = tid & 7;
    const int kfo = r32 * PK + 16 * hi;
    const int vfo = VOFF + r32 * 136 + 8 * hi;
    u32x4 kA0, kA1 = (u32x4){0, 0, 0, 0}, vA, kB0, kB1 = (u32x4){0, 0, 0, 0}, vB;
#define SBAR() __builtin_amdgcn_sched_barrier(0)
#define AP_LOADK(j, R0, R1) do { R0 = *(const u32x4*)(Kp + (size_t)(64 * (j) + kr0) * ldk + kc0 * 8); \
        if (k2) R1 = *(const u32x4*)(Kp + (size_t)(64 * (j) + kr1) * ldk + kc1 * 8); } while (0)
#define AP_LOADV(j, RV) do { RV = *(const u32x4*)(Vt + (size_t)vd * ldv + 64 * (j) + vc * 8); } while (0)
#define AP_WRITEK(buf, R0, R1) do { LAS unsigned char* bb_ = lds + (buf) * KBYTES; *(LAS u32x4*)(bb_ + kr0 * PK + kc0 * 16) = R0; \
        if (k2) *(LAS u32x4*)(bb_ + kr1 * PK + kc1 * 16) = R1; } while (0)
#define AP_WRITEV(buf, RV) do { LAS unsigned char* bb_ = lds + VOFF + (buf) * VBYTES; \
        *(LAS u32x2*)(bb_ + vd * 136 + vc * 16) = (u32x2){RV.x, RV.y}; *(LAS u32x2*)(bb_ + vd * 136 + vc * 16 + 8) = (u32x2){RV.z, RV.w}; } while (0)
#define AP_KF(dst0, dst1, kbuf, s) do { dst0 = *(const LAS bf16x8*)(lds + (kbuf) * KBYTES + kfo + 32 * (s)); dst1 = *(const LAS bf16x8*)(lds + (kbuf) * KBYTES + kfo + 32 * PK + 32 * (s)); } while (0)
#define AP_VF(dst0, dst1, vbuf, ks) do { const LAS unsigned char* p_ = lds + (vbuf) * VBYTES + vfo + (32 * ((ks) >> 1) + 16 * ((ks) & 1)) * 2; \
        const u32x2 a_ = *(const LAS u32x2*)(p_), b_ = *(const LAS u32x2*)(p_ + 16), c_ = *(const LAS u32x2*)(p_ + 32 * 136), d_ = *(const LAS u32x2*)(p_ + 32 * 136 + 16); \
        dst0 = __builtin_bit_cast(bf16x8, (u32x4){a_.x, a_.y, b_.x, b_.y}); dst1 = __builtin_bit_cast(bf16x8, (u32x4){c_.x, c_.y, d_.x, d_.y}); } while (0)
#define AP_MFMA(a, b, c) __builtin_amdgcn_mfma_f32_32x32x16_bf16(a, b, c, 0, 0, 0)
#define AP_MASK(S0, S1, t) do { _Pragma("unroll") for (int r_ = 0; r_ < 16; ++r_) { const int key_ = 64 * (t) + crow(r_, hi); \
        if (key_ > qrow) S0[r_] = -1e30f; if (key_ + 32 > qrow) S1[r_] = -1e30f; } } while (0)
#define AP_ROWMAX(S0, S1, out) do { float a_ = fmaxf(fmaxf(S0[0], S1[0]), S0[1]), b_ = fmaxf(fmaxf(S1[1], S0[2]), S1[2]); \
        _Pragma("unroll") for (int r_ = 3; r_ < 15; r_ += 2) { a_ = fmaxf(fmaxf(a_, S0[r_]), S1[r_]); b_ = fmaxf(fmaxf(b_, S0[r_ + 1]), S1[r_ + 1]); } \
        a_ = fmaxf(fmaxf(a_, S0[15]), S1[15]); a_ = fmaxf(a_, b_); out = fmaxf(a_, __shfl_xor(a_, 32)); } while (0)
    f32x16 o0, o1, pa0, pa1, sb0, sb1;
#pragma unroll
    for (int r = 0; r < 16; ++r) { o0[r] = 0.f; o1[r] = 0.f; }
    float mref = 0.f, lrun = 0.f;
    bf16x8 pf[4];
    bf16x8 fa0, fa1, fb0, fb1;
    AP_LOADK(0, kA0, kA1); AP_LOADV(0, vA); AP_WRITEK(0, kA0, kA1); AP_WRITEV(0, vA);
    AP_LOADK(1, kA0, kA1); AP_WRITEK(1, kA0, kA1);
    AP_LOADK(2, kA0, kA1); AP_LOADV(1, vA);
    __syncthreads();
#pragma unroll
    for (int r = 0; r < 16; ++r) { pa0[r] = 0.f; pa1[r] = 0.f; }
#pragma unroll
    for (int s = 0; s < NS; ++s) { AP_KF(fa0, fa1, 0, s); pa0 = AP_MFMA(fa0, qf[s], pa0); pa1 = AP_MFMA(fa1, qf[s], pa1); }
    if (ntiles == 4) AP_MASK(pa0, pa1, 0);
    { float mx; AP_ROWMAX(pa0, pa1, mx); mref = mx;
#pragma unroll
      for (int r = 0; r < 16; ++r) { pa0[r] = __builtin_amdgcn_exp2f(pa0[r] - mx); pa1[r] = __builtin_amdgcn_exp2f(pa1[r] - mx); } }
    __syncthreads();
    f32x16 negm;
#pragma unroll
    for (int r = 0; r < 16; ++r) negm[r] = -mref;
    asm volatile("" : "+v"(negm));
#define AP_STEPA(s, X0, X1, Y0, Y1, VALU) do { if ((s) + 1 < NS) AP_KF(Y0, Y1, kb_, (s) + 1); else AP_VF(Y0, Y1, vb_, 0); \
        if ((s) == 0) { sb0 = AP_MFMA(X0, qf[s], negm); sb1 = AP_MFMA(X1, qf[s], negm); } else { sb0 = AP_MFMA(X0, qf[s], sb0); sb1 = AP_MFMA(X1, qf[s], sb1); } VALU; SBAR(); } while (0)
#define AP_PK(i, P, b) pw_[i] = (u32x4){cvtpk(P[b], P[b + 1]), cvtpk(P[b + 2], P[b + 3]), cvtpk(P[b + 4], P[b + 5]), cvtpk(P[b + 6], P[b + 7])}; \
        ls0_ = fadd_s(ls0_, fadd_s(fadd_s(P[b], P[b + 1]), fadd_s(P[b + 2], P[b + 3]))); ls1_ = fadd_s(ls1_, fadd_s(fadd_s(P[b + 4], P[b + 5]), fadd_s(P[b + 6], P[b + 7]))); asm volatile("" : "+v"(pw_[i]), "+v"(ls0_), "+v"(ls1_))
#define AP_EXP4(P, S, b) do { P[b] = __builtin_amdgcn_exp2f(S[b]); P[b + 1] = __builtin_amdgcn_exp2f(S[b + 1]); P[b + 2] = __builtin_amdgcn_exp2f(S[b + 2]); P[b + 3] = __builtin_amdgcn_exp2f(S[b + 3]); asm volatile("" : "+v"(P)); } while (0)
#define AP_STEPB(ks, X0, X1, Y0, Y1, E0, E1) do { if ((ks) + 1 < 4) AP_VF(Y0, Y1, vb_, (ks) + 1); \
        o0 = AP_MFMA(X0, pf[ks], o0); E0; SBAR(); o1 = AP_MFMA(X1, pf[ks], o1); E1; SBAR(); } while (0)
#define AP_ITER(t, MASKED, WK0, WK1, WV, LK0, LK1, LV) do {     \
        const int kb_ = (t) & 1, vb_ = ((t) - 1) & 1; \
        if ((t) + 2 < ntiles) AP_LOADK((t) + 2, LK0, LK1); \
        if ((t) + 1 < ntiles) AP_LOADV((t) + 1, LV); \
        u32x4 pw_[4]; float ls0_ = 0.f, ls1_ = 0.f; \
        AP_KF(fa0, fa1, kb_, 0); SBAR(); \
        AP_STEPA(0, fa0, fa1, fb0, fb1, AP_PK(0, pa0, 0)); \
        AP_STEPA(1, fb0, fb1, fa0, fa1, AP_PK(1, pa0, 8)); \
        AP_STEPA(2, fa0, fa1, fb0, fb1, AP_PK(2, pa1, 0)); \
        AP_STEPA(3, fb0, fb1, fa0, fa1, AP_PK(3, pa1, 8)); \
        if (NS == 6) { AP_STEPA(4, fa0, fa1, fb0, fb1, (void)0); AP_STEPA(5, fb0, fb1, fa0, fa1, (void)0); } \
        lrun += ls0_ + ls1_; \
        pf[0] = __builtin_bit_cast(bf16x8, pw_[0]); pf[1] = __builtin_bit_cast(bf16x8, pw_[1]); pf[2] = __builtin_bit_cast(bf16x8, pw_[2]); pf[3] = __builtin_bit_cast(bf16x8, pw_[3]); \
        if ((t) >= ntiles - 4) AP_MASK(sb0, sb1, t); \
        float mx_; AP_ROWMAX(sb0, sb1, mx_); \
        float resc_ = 1.0f; bool do_resc_ = false; \
        if (__any(mx_ > THR)) { const float dl_ = fmaxf(mx_, 0.f); mref += dl_; \
            _Pragma("unroll") for (int r_ = 0; r_ < 16; ++r_) { sb0[r_] -= dl_; sb1[r_] -= dl_; negm[r_] = -mref; } \
            asm volatile("" : "+v"(negm)); \
            resc_ = __builtin_amdgcn_exp2f(-dl_); lrun *= resc_; do_resc_ = true; } \
        SBAR(); \
        AP_STEPB(0, fa0, fa1, fb0, fb1, AP_EXP4(pa0, sb0, 0), AP_EXP4(pa0, sb0, 4)); \
        AP_STEPB(1, fb0, fb1, fa0, fa1, AP_EXP4(pa0, sb0, 8), AP_EXP4(pa0, sb0, 12)); \
        AP_STEPB(2, fa0, fa1, fb0, fb1, AP_EXP4(pa1, sb1, 0), AP_EXP4(pa1, sb1, 4)); \
        AP_STEPB(3, fb0, fb1, fa0, fa1, AP_EXP4(pa1, sb1, 8), AP_EXP4(pa1, sb1, 12)); \
        if (do_resc_) { asm volatile("" ::: "memory"); _Pragma("unroll") for (int r_ = 0; r_ < 16; ++r_) { o0[r_] *= resc_; o1[r_] *= resc_; } asm volatile("" : "+v"(o0), "+v"(o1)); } \
        if ((t) + 1 < ntiles) AP_WRITEK(((t) + 1) & 1, WK0, WK1); \
        AP_WRITEV((t) & 1, WV); \
        __syncthreads(); } while (0)
    static_assert(NS == 4 || NS == 6, "head dim 64 or 96");
    if (wid >= 4) __builtin_amdgcn_s_setprio(1);
    int t = 1;
    for (; t + 1 < ntiles; t += 2) { AP_ITER(t, 1, kA0, kA1, vA, kB0, kB1, vB); AP_ITER(t + 1, 1, kB0, kB1, vB, kA0, kA1, vA); }
    AP_ITER(t, 1, kA0, kA1, vA, kB0, kB1, vB);
    {
        u32x4 pw_[4]; float ls0_ = 0.f, ls1_ = 0.f;
        AP_PK(0, pa0, 0); AP_PK(1, pa0, 8); AP_PK(2, pa1, 0); AP_PK(3, pa1, 8);
        lrun += ls0_ + ls1_;
        pf[0] = __builtin_bit_cast(bf16x8, pw_[0]); pf[1] = __builtin_bit_cast(bf16x8, pw_[1]); pf[2] = __builtin_bit_cast(bf16x8, pw_[2]); pf[3] = __builtin_bit_cast(bf16x8, pw_[3]);
        const int vb_ = (ntiles - 1) & 1;
#pragma unroll
        for (int ks = 0; ks < 4; ++ks) { AP_VF(fa0, fa1, vb_, ks); o0 = AP_MFMA(fa0, pf[ks], o0); o1 = AP_MFMA(fa1, pf[ks], o1); }
    }
    const float ltot = lrun + __shfl_xor(lrun, 32);
    const float inv = 1.0f / ltot;
#pragma unroll
    for (int g = 0; g < 4; ++g) {
        const int d0 = 8 * g + 4 * hi;
        u32x2 w0, w1;
        w0.x = cvtpk(o0[4 * g] * inv, o0[4 * g + 1] * inv); w0.y = cvtpk(o0[4 * g + 2] * inv, o0[4 * g + 3] * inv);
        w1.x = cvtpk(o1[4 * g] * inv, o1[4 * g + 1] * inv); w1.y = cvtpk(o1[4 * g + 2] * inv, o1[4 * g + 3] * inv);
        *(u32x2*)(O + (size_t)qrow * ldo + d0) = w0;
        *(u32x2*)(O + (size_t)qrow * ldo + 32 + d0) = w1;
    }
    __syncthreads();
#undef SBAR
#undef AP_LOADK
#undef AP_LOADV
#undef AP_WRITEK
#undef AP_WRITEV
#undef AP_KF
#undef AP_VF
#undef AP_MFMA
#undef AP_MASK
#undef AP_ROWMAX
#undef AP_STEPA
#undef AP_PK
#undef AP_EXP4
#undef AP_STEPB
#undef AP_ITER
}

#define XB_TMO      128
#define XB_XCNT(j)  (256  + 64 * (j))
#define XB_XSUB(j)  (1280 + 64 * (j))
#define XB_XGEN(j)  (2304 + 64 * (j))
#define XB_TOP      3328
#define XB_TOPGEN   3392
#define XCD_BAR_WORDS 3456
#define XB_SPIN_CAP (1u << 18)
DI unsigned xb_ld(unsigned* p) { return __hip_atomic_load(p, __ATOMIC_RELAXED, __HIP_MEMORY_SCOPE_AGENT); }
DI unsigned xb_add(unsigned* p, unsigned v) { return __hip_atomic_fetch_add(p, v, __ATOMIC_RELAXED, __HIP_MEMORY_SCOPE_AGENT); }
DI unsigned xb_xcc_id() { return (unsigned)__builtin_amdgcn_s_getreg((3 << 11) | 20) & 0xFu; }
#define XB_SPIN(cond, bar) do { unsigned _sp = 0; while (cond) { __builtin_amdgcn_s_sleep(1); \
    if ((++_sp & 255u) == 0u) { if (xb_ld(&(bar)[XB_TMO])) break; if (_sp > XB_SPIN_CAP) { atomicAdd(&(bar)[XB_TMO], 1u); break; } } } } while (0)
struct XcdBarrier { unsigned* bar; unsigned x; volatile LAS unsigned* st; int wid; };
DI XcdBarrier xcd_barrier_post(unsigned* bar, volatile LAS unsigned* st, int wid) {
    XcdBarrier b; b.bar = bar; b.x = xb_xcc_id(); b.st = st; b.wid = wid;
    if (wid == 0 && vlane() == 0) (void)xb_add(&bar[XB_XCNT(b.x)], 1u);
    return b;
}
DI void xcd_barrier_complete(unsigned* bar, unsigned x, unsigned& nloc, unsigned& nx) {
    const unsigned G = gridDim.x * gridDim.y * gridDim.z;
    unsigned sum, cnt, mine, sp = 0u;
    for (;;) {
        sum = 0u; cnt = 0u; mine = 0u;
#pragma unroll
        for (unsigned j = 0; j < 16; ++j) { const unsigned c = xb_ld(&bar[XB_XCNT(j)]); sum += c; cnt += (c > 0u) ? 1u : 0u; mine = (j == x) ? c : mine; }
        if (sum == G) break;
        __builtin_amdgcn_s_sleep(1);
        if ((++sp & 255u) == 0u) { if (xb_ld(&bar[XB_TMO])) break; if (sp > XB_SPIN_CAP) { atomicAdd(&bar[XB_TMO], 1u); break; } }
    }
    nloc = mine > 0u ? mine : 1u; nx = cnt > 0u ? cnt : 1u;
}
DI void xcd_barrier(const XcdBarrier& b) {
    asm volatile("s_waitcnt vmcnt(0)" ::: "memory");
    __syncthreads();
    if (b.wid == 0 && vlane() == 0) {
        unsigned* bar = b.bar;
        __builtin_amdgcn_s_waitcnt(0);
        unsigned nloc = b.st[0], nx = b.st[1];
        if (nloc == 0u) { xcd_barrier_complete(bar, b.x, nloc, nx); b.st[0] = nloc; b.st[1] = nx; }
        const unsigned old = xb_add(&bar[XB_XSUB(b.x)], 1u);
        const unsigned gen = old / nloc;
        if (old + 1u == (gen + 1u) * nloc) {
            __builtin_amdgcn_fence(__ATOMIC_RELEASE, "agent");
            asm volatile("s_waitcnt vmcnt(0)" ::: "memory");
            const unsigned og = xb_add(&bar[XB_TOP], 1u);
            const unsigned tg = og / nx;
            if (og + 1u == (tg + 1u) * nx) xb_add(&bar[XB_TOPGEN], 1u);
            else XB_SPIN(xb_ld(&bar[XB_TOPGEN]) == tg, bar);
            __builtin_amdgcn_fence(__ATOMIC_ACQUIRE, "agent");
            xb_add(&bar[XB_XGEN(b.x)], 1u);
            asm volatile("s_waitcnt vmcnt(0)" ::: "memory");
        } else {
            XB_SPIN(xb_ld(&bar[XB_XGEN(b.x)]) == gen, bar);
            __builtin_amdgcn_fence(__ATOMIC_ACQUIRE, "agent");
            asm volatile("s_waitcnt vmcnt(0)" ::: "memory");
        }
    }
    __syncthreads();
}

DI int next_unit(Frame& F, int widx) {
    LAS int* s = (LAS int*)(F.lds + LDS_CTL);
    __syncthreads();
    if (F.tid == 0) *s = (int)atomicAdd(F.ctl + CW_WORK + 64 * widx, 1u);
    __syncthreads();
    return *s;
}

DI void transpose_item(const float* W, int ldw, int srccol, int K, bf16_t* WT, int drow, LAS unsigned* scr, int k0, int lane, int nvalid) {
    const int n4 = lane & 15, kq = lane >> 4;
#pragma unroll 8
    for (int i = 0; i < 16; ++i) {
        const int kk = 4 * i + kq;
        f32x4 v = (f32x4){0.f, 0.f, 0.f, 0.f};
        if (4 * n4 < nvalid) v = *(const f32x4*)(W + (size_t)(k0 + kk) * ldw + srccol + 4 * n4);
        scr[kk * 33 + 2 * n4] = cvtpk(v[0], v[1]); scr[kk * 33 + 2 * n4 + 1] = cvtpk(v[2], v[3]);
    }
    LDS_WAIT(); asm volatile("" ::: "memory");
    const int c = lane & 7;
    const LAS unsigned short* s16 = (const LAS unsigned short*)scr;
#pragma unroll
    for (int j = 0; j < 8; ++j) {
        const int n = (lane >> 3) + 8 * j;
        const LAS unsigned short* sp = s16 + (8 * c) * 66 + n;
        u32x4 o;
        o.x = (unsigned)sp[0 * 66] | ((unsigned)sp[1 * 66] << 16); o.y = (unsigned)sp[2 * 66] | ((unsigned)sp[3 * 66] << 16);
        o.z = (unsigned)sp[4 * 66] | ((unsigned)sp[5 * 66] << 16); o.w = (unsigned)sp[6 * 66] | ((unsigned)sp[7 * 66] << 16);
        if (n < nvalid) *(u32x4*)(WT + (size_t)(drow + n) * K + k0 + 8 * c) = o;
    }
    LDS_WAIT(); asm volatile("" ::: "memory");
}
DI unsigned q8x4(float a, float b, float c, float d, float inv) {
    const float M = 12582912.0f;
    const unsigned ua = __float_as_uint(fmaf(a, inv, M)), ub = __float_as_uint(fmaf(b, inv, M)), uc = __float_as_uint(fmaf(c, inv, M)), ud = __float_as_uint(fmaf(d, inv, M));
    return __builtin_amdgcn_perm(ub, ua, 0x0c0c0400u) | __builtin_amdgcn_perm(ud, uc, 0x04000c0cu);
}
template <int QM>
DI void strip_item(const float* W, int ldw, int n0, unsigned char* dst, float* sc, LAS float* red, int tid) {
    const int c4 = tid & 15, kr = tid >> 4;
    const float* src = W + (size_t)(kr * 32) * ldw + n0 + 4 * c4;
    f32x4 v[32];
#pragma unroll
    for (int p = 0; p < 32; ++p) v[p] = *(const f32x4*)(src + (size_t)p * ldw);
    f32x4 m = (f32x4){0.f, 0.f, 0.f, 0.f};
#pragma unroll
    for (int p = 0; p < 32; ++p)
#pragma unroll
        for (int j = 0; j < 4; ++j) m[j] = fmaxf(m[j], fabsf(v[p][j]));
#pragma unroll
    for (int j = 0; j < 4; ++j) { m[j] = fmaxf(m[j], __shfl_xor(m[j], 16)); m[j] = fmaxf(m[j], __shfl_xor(m[j], 32)); }
    __syncthreads();
    if ((tid & 63) < 16) *(LAS f32x4*)(red + (tid >> 6) * 64 + 4 * c4) = m;
    __syncthreads();
#pragma unroll
    for (int w = 0; w < 8; ++w) { const f32x4 o = *(const LAS f32x4*)(red + w * 64 + 4 * c4);
#pragma unroll
        for (int j = 0; j < 4; ++j) m[j] = fmaxf(m[j], o[j]); }
    constexpr float QMAX = QM == 0 ? 127.0f : 448.0f;
    if (kr == 0) *(f32x4*)(sc + 4 * c4) = m * (1.0f / QMAX);
#pragma unroll
    for (int j = 0; j < 4; ++j) {
        const float inv = m[j] > 0.f ? QMAX / m[j] : 0.f;
        unsigned w[8];
#pragma unroll
        for (int q = 0; q < 8; ++q) {
            if constexpr (QM == 0) w[q] = q8x4(v[4 * q][j], v[4 * q + 1][j], v[4 * q + 2][j], v[4 * q + 3][j], inv);
            else w[q] = (unsigned)__builtin_amdgcn_cvt_pk_fp8_f32(v[4 * q + 2][j] * inv, v[4 * q + 3][j] * inv, __builtin_amdgcn_cvt_pk_fp8_f32(v[4 * q][j] * inv, v[4 * q + 1][j] * inv, 0, false), true);
        }
        u32x4* o = (u32x4*)(dst + (size_t)(4 * c4 + j) * 1024 + kr * 32);
        o[0] = (u32x4){w[0], w[1], w[2], w[3]}; o[1] = (u32x4){w[4], w[5], w[6], w[7]};
    }
}
constexpr int CONV_P1 = 2, CONV_A0 = 3, CONV_GU = 3, CONV_DN = 2, CONV_A1 = 6;
constexpr int MOE_S_GU = 32, MOE_S_DN = 16, MOE_STRIPS_PER_LAYER = 32 * (MOE_S_GU + MOE_S_DN);
DI void moe_convert_strip(unsigned char* ws, LAS float* red, int l, int r, int tid) {
    if (r < 32 * MOE_S_GU) {
        const int e = l * 32 + r / MOE_S_GU, nb = r % MOE_S_GU;
        const int jj = (nb & 15) * 64, drow = (jj >> 7) * 256 + (nb >> 4) * 128 + (jj & 127);
        strip_item<0>(KP->moe_w_gu + (size_t)e * 1024 * 2048, 2048, 64 * nb, ws + WS_W_GU + ((size_t)e * 2048 + drow) * 1024, (float*)(ws + WS_SGU) + (size_t)e * 2048 + drow, red, tid);
    } else {
        r -= 32 * MOE_S_GU;
        const int e = l * 32 + r / MOE_S_DN, nb = r % MOE_S_DN;
        strip_item<2>(KP->moe_w_dn + (size_t)e * 1024 * 1024, 1024, 64 * nb, ws + WS_W_DN + ((size_t)e * 1024 + 64 * nb) * 1024, (float*)(ws + WS_SDN) + (size_t)e * 1024 + 64 * nb, red, tid);
    }
}
constexpr int CW_CONVQ = CW_WORK + 64 * 8;
DI bool conv_pull(Frame& F, int l, int n) {
    LAS int* s = (LAS int*)(F.lds + LDS_CTL + 8);
    __syncthreads();
    if (F.tid == 0) *s = (int)atomicAdd(F.ctl + CW_CONVQ + 64 * l, (unsigned)n);
    __syncthreads();
    const int base = *s;
    for (int c = base; c < base + n && c < MOE_STRIPS_PER_LAYER; ++c) moe_convert_strip(F.ws, (LAS float*)F.lds, l, c, F.tid);
    __syncthreads();
    return base + n < MOE_STRIPS_PER_LAYER;
}
struct TrMat { const float* W; int ldw, col0, K, N; bf16_t* WT; int drow0, mode; };

DI void phase_prologue(Frame& F, const Params& P) {
    F.lane = vlane(); F.tid = F.wid * 64 + F.lane;
    LAS unsigned* scr = (LAS unsigned*)(F.lds + F.wid * 8448);
    const int gw = F.bid * 8 + F.wid, NGW = F.G * 8;
    unsigned char* ws = F.ws;
    TrMat mats[11];
    mats[0] = TrMat{KP->a_w_in, FOX_IN, 0, 1024, 1536, (bf16_t*)(ws + WS_W_AIN), 0, 0};
    mats[1] = TrMat{KP->a_w_in, FOX_IN, 2316, 1024, 256, (bf16_t*)(ws + WS_W_AIN), 1536, 0};
    mats[2] = TrMat{KP->a_w_in, FOX_IN, 1536, 1024, 768, (bf16_t*)(ws + WS_W_AIN), 1792, 0};
    mats[3] = TrMat{KP->a_w_out, 1024, 0, 1024, 1024, (bf16_t*)(ws + WS_W_AOUT), 0, 0};
    mats[4] = TrMat{KP->kv_w_dkv, 288, 0, 1024, 288, (bf16_t*)(ws + WS_W_BIN), 0, 0};
    mats[5] = TrMat{KP->b_w_in, 640, 0, 1024, 640, (bf16_t*)(ws + WS_W_BIN), 288, 0};
    mats[6] = TrMat{KP->b_w_uq, 1152, 0, 384, 1152, (bf16_t*)(ws + WS_W_UQ), 0, 0};
    mats[7] = TrMat{KP->kv_w_ukv, 1536, 0, 256, 1536, (bf16_t*)(ws + WS_W_UKV), 0, 1};
    mats[8] = TrMat{KP->b_w_out, 1024, 0, 1024, 1024, (bf16_t*)(ws + WS_W_BOUT), 0, 0};
    mats[9] = TrMat{KP->mem_w_kv, 512, 0, 1024, 512, (bf16_t*)(ws + WS_W_MKV), 0, 0};
    mats[10] = TrMat{KP->mem_w_kv + (size_t)1024 * 512, 512, 0, 1024, 512, (bf16_t*)(ws + WS_W_MKV) + (size_t)512 * 1024, 0, 0};
    int nsmall = 0;
#pragma unroll
    for (int i = 0; i < 11; ++i) nsmall += (mats[i].K / 64) * ((mats[i].N + 63) / 64);
    const int ntot = nsmall;
    for (int it = gw; it < ntot; it += NGW) {
        int r = it;
        if (r < nsmall) {
#pragma unroll
            for (int i = 0; i < 11; ++i) {
                const int nblk = (mats[i].N + 63) / 64, ni = (mats[i].K / 64) * nblk;
                if (r >= 0 && r < ni) {
                    const int kb = r / nblk, nb = r % nblk;
                    const int drow = mats[i].mode == 1 ? ((nb & 1) * 768 + (nb >> 1) * 64) : (mats[i].drow0 + 64 * nb);
                    transpose_item(mats[i].W, mats[i].ldw, mats[i].col0 + 64 * nb, mats[i].K, mats[i].WT, drow, scr, 64 * kb, F.lane, mats[i].N - 64 * nb);
                }
                r -= ni;
            }
            continue;
        }
    }
    __syncthreads();
    LAS float* wf = (LAS float*)F.lds;
    for (int i = F.tid; i < 1024 * 12; i += NTHREADS) { const int k = i / 12, h = i % 12; wf[i] = KP->a_w_in[(size_t)k * FOX_IN + 2304 + h]; }
    __syncthreads();
    float* logf = (float*)(ws + WS_LOGF);
    bf16_t* xb = (bf16_t*)(ws + WS_XB);
    for (int row = gw; row < T; row += NGW) {
        const f32x4* xr = (const f32x4*)(KP->x + (size_t)row * DM) + F.lane;
        f32x4 v[4];
#pragma unroll
        for (int j = 0; j < 4; ++j) v[j] = xr[64 * j];
        u32x2* o8 = (u32x2*)(xb + (size_t)row * DM) + F.lane;
#pragma unroll
        for (int j = 0; j < 4; ++j) o8[64 * j] = (u32x2){cvtpk(v[j][0], v[j][1]), cvtpk(v[j][2], v[j][3])};
        float part[12];
#pragma unroll
        for (int h = 0; h < 12; ++h) part[h] = 0.f;
#pragma unroll
        for (int j = 0; j < 4; ++j)
#pragma unroll
            for (int i = 0; i < 4; ++i) {
                const int k = 4 * F.lane + 256 * j + i;
                const LAS f32x4* wp = (const LAS f32x4*)(wf + k * 12);
                const f32x4 w0 = wp[0], w1 = wp[1], w2 = wp[2];
                const float xv = v[j][i];
                part[0] += xv * w0[0]; part[1] += xv * w0[1]; part[2] += xv * w0[2]; part[3] += xv * w0[3];
                part[4] += xv * w1[0]; part[5] += xv * w1[1]; part[6] += xv * w1[2]; part[7] += xv * w1[3];
                part[8] += xv * w2[0]; part[9] += xv * w2[1]; part[10] += xv * w2[2]; part[11] += xv * w2[3];
            }
        float mine = 0.f;
#pragma unroll
        for (int h = 0; h < 12; ++h) { const float s = wave_sum(part[h]); if (F.lane == h) mine = s; }
        if (F.lane < 12) {
            const float z = mine + KP->a_b_f[F.lane];
            const float ls = fminf(z, 0.f) - log1pf(expf(-fabsf(z)));
            const int b = row / SEQ, s = row % SEQ;
            logf[(size_t)(b * NH + F.lane) * SEQ + s] = ls;
        }
    }
    {
        float* wrt = (float*)(ws + WS_WRT);
        bf16_t* wrh = (bf16_t*)(ws + WS_WRH); bf16_t* wrl = (bf16_t*)(ws + WS_WRL);
        for (int i = F.bid * NTHREADS + F.tid; i < 2 * 1024 * 32; i += F.G * NTHREADS) { const int l = i >> 15, k = (i >> 5) & 1023, e = i & 31; const float w = KP->moe_w_r[i];
            const unsigned hb = cvtpk(w, 0.f) & 0xffffu; const float hf = __uint_as_float(hb << 16);
            wrt[(size_t)(l * 32 + e) * 1024 + k] = w; wrh[(size_t)(l * 32 + e) * 1024 + k] = (bf16_t)hb; wrl[(size_t)(l * 32 + e) * 1024 + k] = (bf16_t)(cvtpk(w - hf, 0.f) & 0xffffu); }
    }
    bf16_t* memb = (bf16_t*)(ws + WS_MEMB);
    for (int row = gw; row < NB * NMEM; row += NGW) {
        const f32x4* xr = (const f32x4*)(KP->mem + (size_t)row * DM) + F.lane;
        u32x2* o8 = (u32x2*)(memb + (size_t)row * DM) + F.lane;
#pragma unroll
        for (int j = 0; j < 4; ++j) { const f32x4 v = xr[64 * j]; o8[64 * j] = (u32x2){cvtpk(v[0], v[1]), cvtpk(v[2], v[3])}; }
    }
}

DI void scan_unit(Frame& F, int bh) {
    const float* src = (const float*)(F.ws + WS_LOGF) + (size_t)bh * SEQ;
    float* dst = (float*)(F.ws + WS_CUM) + (size_t)bh * SEQ;
    LAS float* wtot = (LAS float*)F.lds;
    float v[16];
#pragma unroll
    for (int j = 0; j < 4; ++j) { const f32x4 t = *(const f32x4*)(src + F.tid * 16 + 4 * j); v[4 * j] = t[0]; v[4 * j + 1] = t[1]; v[4 * j + 2] = t[2]; v[4 * j + 3] = t[3]; }
#pragma unroll
    for (int i = 1; i < 16; ++i) v[i] += v[i - 1];
    float tot = v[15];
    float inc = tot;
#pragma unroll
    for (int o = 1; o < 64; o <<= 1) { const float t = __shfl_up(inc, o); if (F.lane >= o) inc += t; }
    __syncthreads();
    if (F.lane == 63) wtot[F.wid] = inc;
    __syncthreads();
    float base = inc - tot;
    for (int w = 0; w < F.wid; ++w) base += wtot[w];
#pragma unroll
    for (int j = 0; j < 4; ++j) {
        f32x4 t; t[0] = (base + v[4 * j]) * LOG2E; t[1] = (base + v[4 * j + 1]) * LOG2E; t[2] = (base + v[4 * j + 2]) * LOG2E; t[3] = (base + v[4 * j + 3]) * LOG2E;
        *(f32x4*)(dst + F.tid * 16 + 4 * j) = t;
    }
    __syncthreads();
}

struct RouteQKM { unsigned char* ws; DI Dst operator()(const pg8::Unit& u) const {
    if (u.pn < 3) return Dst{(bf16_t*)(ws + WS_Q), 768, u.pm * 256, u.pn * 256, 256, 0.125f * LOG2E, false};
    if (u.pn < 6) return Dst{(bf16_t*)(ws + WS_K), 768, u.pm * 256, (u.pn - 3) * 256, 256, 1.0f, false};
    return Dst{(bf16_t*)(ws + WS_MQ), 256, u.pm * 256, 0, 256, 0.125f * LOG2E, false}; } };
struct RouteVT { unsigned char* ws; DI Dst operator()(const pg8::Unit& u) const {
    const int b = u.pn >> 5; return Dst{(bf16_t*)(ws + WS_VT) + (size_t)b * 768 * SEQ, SEQ, u.pm * 256, (u.pn & 31) * 256, 256, 1.0f, false}; } };
struct RoutePlain { bf16_t* O; int ldo; DI Dst operator()(const pg8::Unit& u) const { return Dst{O, ldo, u.pm * 256, u.pn * 256, 256, 1.0f, false}; } };
DI void phase_proj0(Frame& F, const Params& P) {
    F.lane = vlane(); F.tid = F.wid * 64 + F.lane;
    unsigned char* ws = F.ws;
    const bf16_t* xb = (const bf16_t*)(ws + WS_XB);
    const bf16_t* win = (const bf16_t*)(ws + WS_W_AIN);
    const bf16_t* memb = (const bf16_t*)(ws + WS_MEMB);
    {
        pg8::Gemm g{xb, win, 1024}; pg8::StaticOrder S; S.init(T, 1792, 1024, F.G, F.bid);
        EpiBf16R<RouteQKM> E{RouteQKM{ws}};
        pg8::gemm_phase<EpiBf16R<RouteQKM>, pg8::StaticOrder, true>(F.lds, g, S, E, F.wid);
    }
    {
        pg8::Gemm g{win + (size_t)1792 * 1024, xb, 1024}; pg8::StaticOrder S; S.init(768, T, 1024, F.G, (F.bid + 64) % F.G);
        EpiBf16R<RouteVT> E{RouteVT{ws}};
        pg8::gemm_phase<EpiBf16R<RouteVT>, pg8::StaticOrder, true>(F.lds, g, S, E, F.wid);
    }
    for (int l = 0; l < 2; ++l) {
        const bf16_t* wk = (const bf16_t*)(ws + WS_W_MKV) + (size_t)l * 512 * 1024;
        {
            pg8::Gemm g{memb, wk, 1024}; pg8::StaticOrder S; S.init(512, 256, 1024, F.G, (F.bid + F.G - (152 + 4 * l)) % F.G);
            EpiBf16R<RoutePlain> E{RoutePlain{(bf16_t*)(ws + WS_MK) + (size_t)l * 512 * 256, 256}};
            pg8::gemm_phase<EpiBf16R<RoutePlain>, pg8::StaticOrder, true>(F.lds, g, S, E, F.wid);
        }
        for (int b = 0; b < 2; ++b) {
            pg8::Gemm g{wk + (size_t)256 * 1024, memb + (size_t)b * 256 * 1024, 1024}; pg8::StaticOrder S; S.init(256, 256, 1024, F.G, (F.bid + F.G - (154 + 4 * l + b)) % F.G);
            EpiBf16R<RoutePlain> E{RoutePlain{(bf16_t*)(ws + WS_MVT) + (size_t)(l * 2 + b) * 256 * 256, 256}};
            pg8::gemm_phase<EpiBf16R<RoutePlain>, pg8::StaticOrder, true>(F.lds, g, S, E, F.wid);
        }
    }
    if (F.G == 256 && F.bid >= 128) conv_pull(F, 0, CONV_P1);
}


DI void phase_scan_knorm(Frame& F) {
    F.lane = vlane(); F.tid = F.wid * 64 + F.lane;
    unsigned char* ws = F.ws;
    if (F.bid < 24) scan_unit(F, F.bid);
    const bf16_t* K = (const bf16_t*)(ws + WS_K);
    float* kn2 = (float*)(ws + WS_KN2);
    const int gw = F.bid * 8 + F.wid, NGW = F.G * 8;
    for (int it = gw; it < 24 * 128; it += NGW) {
        const int bh = it >> 7, j = it & 127, b = bh / 12, h = bh % 12;
        const u32x4* kr = (const u32x4*)(K + (size_t)(b * SEQ + 64 * j + F.lane) * 768 + h * 64);
        float ss = 0.f;
#pragma unroll
        for (int c = 0; c < 8; ++c) {
            const u32x4 w = kr[c];
            const unsigned ww[4] = {w.x, w.y, w.z, w.w};
#pragma unroll
            for (int i = 0; i < 4; ++i) { const float a = __uint_as_float(ww[i] << 16), bb = __uint_as_float(ww[i] & 0xffff0000u); ss += a * a + bb * bb; }
        }
        ss = wave_max(ss);
        if (F.lane == 0) kn2[it] = ss;
    }
}

DI void mem_attn_unit(Frame& F, int l, int v) {
    unsigned char* ws = F.ws;
    const int qb = v >> 3, bm = v & 7, b = bm >> 2, mh = bm & 3;
    const bf16_t* Q = (const bf16_t*)(ws + WS_MQ) + (size_t)b * SEQ * 256 + mh * 64;
    const bf16_t* K = (const bf16_t*)(ws + WS_MK) + (size_t)l * 512 * 256 + (size_t)b * 256 * 256 + mh * 64;
    const bf16_t* Vt = (const bf16_t*)(ws + WS_MVT) + (size_t)(l * 2 + b) * 256 * 256 + (size_t)mh * 64 * 256;
    bf16_t* O = (bf16_t*)(ws + WS_MERGED) + (size_t)b * SEQ * 1024 + 768 + mh * 64;
    attn_unit<64, false, false>(F.lds, Q, 256, K, 256, Vt, 256, nullptr, O, 1024, qb * 256, 4, false, nullptr, F.wid);
}
DI void phase_attn0(Frame& F, const Params& P) {
    F.lane = vlane(); F.tid = F.wid * 64 + F.lane;
    unsigned char* ws = F.ws;
    constexpr int NU = 768 + 256 + 512;
    for (;;) {
        const int uu = next_unit(F, 0);
        if (uu >= NU) break;
        if (uu % 3 == 2) { conv_pull(F, 0, CONV_A0); continue; }
        const int u = 2 * (uu / 3) + uu % 3;
        if (u < 768) {
            const int qb = 31 - u / 24, bh = u % 24, b = bh / 12, h = bh % 12;
            const bf16_t* Q = (const bf16_t*)(ws + WS_Q) + (size_t)b * SEQ * 768 + h * 64;
            const bf16_t* K = (const bf16_t*)(ws + WS_K) + (size_t)b * SEQ * 768 + h * 64;
            const bf16_t* Vt = (const bf16_t*)(ws + WS_VT) + (size_t)(b * 768 + h * 64) * SEQ;
            const float* cum = (const float*)(ws + WS_CUM) + (size_t)bh * SEQ;
            bf16_t* O = (bf16_t*)(ws + WS_MERGED) + (size_t)b * SEQ * 1024 + h * 64;
            attn_unit<64, true, false>(F.lds, Q, 768, K, 768, Vt, SEQ, cum, O, 1024, qb * 256, 4 * (qb + 1), true, nullptr, F.wid, (const float*)(ws + WS_KN2) + bh * 128);
        } else mem_attn_unit(F, 0, u - 768);
    }
    while (conv_pull(F, 0, 16)) {}
}
DI void phase_attn1(Frame& F, const Params& P) {
    F.lane = vlane(); F.tid = F.wid * 64 + F.lane;
    unsigned char* ws = F.ws;
    constexpr int NCONV = 256, NU = 768 + 256 + NCONV;
    for (;;) {
        const int uu = next_unit(F, 1);
        if (uu >= NU) break;
        if (uu % 5 == 4) { conv_pull(F, 1, CONV_A1); continue; }
        const int u = 4 * (uu / 5) + uu % 5;
        if (u < 768) {
            const int qb = 31 - u / 24, bh = u % 24, b = bh / 12, h = bh % 12;
            const bf16_t* Q = (const bf16_t*)(ws + WS_Q) + (size_t)b * SEQ * 1152 + h * 96;
            const bf16_t* K = (const bf16_t*)(ws + WS_K) + (size_t)b * SEQ * 1152 + h * 96;
            const bf16_t* Vt = (const bf16_t*)(ws + WS_VT) + (size_t)(b * 768 + h * 64) * SEQ;
            bf16_t* O = (bf16_t*)(ws + WS_MERGED) + (size_t)b * SEQ * 1024 + h * 64;
            attn_unit_pipe<96, true>(F.lds, Q, 1152, K, 1152, Vt, SEQ, O, 1024, qb * 256, 4 * (qb + 1), KP->pos + (size_t)b * SEQ, F.wid);
        } else mem_attn_unit(F, 1, u - 768);
    }
    while (conv_pull(F, 1, 16)) {}
}

DI void phase_outproj(Frame& F, const float* X, const bf16_t* Wt) {
    F.lane = vlane(); F.tid = F.wid * 64 + F.lane;
    unsigned char* ws = F.ws;
    pg8::Gemm g{(const bf16_t*)(ws + WS_MERGED), Wt, 1024}; pg8::StaticOrder S; S.init(T, 1024, 1024, F.G, F.bid);
    EpiResF32 E{(float*)(ws + WS_Y), X};
    pg8::gemm_phase<EpiResF32, pg8::StaticOrder, false>(F.lds, g, S, E, F.wid);
}


DI void phase_ln_router(Frame& F, const Params& P, int l) {
    F.lane = vlane(); F.tid = F.wid * 64 + F.lane;
    unsigned char* ws = F.ws;
    LAS unsigned char* wH = F.lds;
    LAS unsigned char* wL = F.lds + 65536;
    LAS int* pairs = (LAS int*)(F.lds + LDS_CTL + 1024);
    LAS int* lcnt = (LAS int*)(F.lds + LDS_CTL + 3072); LAS int* gbase = lcnt + 32;
    LAS float* lg = (LAS float*)(F.lds + LDS_R1X + F.wid * 1280);
    LAS int* rec = (LAS int*)(F.lds + LDS_R1X + F.wid * 1280 + 1024);
    LAS float* stt = (LAS float*)(F.lds + LDS_R1X + 8 * 1280 + F.wid * 64);
    __syncthreads();
    {
        const u32x4* srcH = (const u32x4*)((const bf16_t*)(ws + WS_WRH) + (size_t)l * 32 * 1024);
        const u32x4* srcL = (const u32x4*)((const bf16_t*)(ws + WS_WRL) + (size_t)l * 32 * 1024);
        for (int i = F.tid; i < 32 * 128; i += NTHREADS) { const int e = i >> 7, c = i & 127; const int off = e * 2048 + ((c ^ (e & 7)) << 4);
            *(LAS u32x4*)(wH + off) = srcH[i]; *(LAS u32x4*)(wL + off) = srcL[i]; }
    }
    if (F.tid < 32) lcnt[F.tid] = 0;
    __syncthreads();
    const float* g = KP->ln_g + (size_t)(l * 2 + 0) * DM; const float* bt = KP->ln_b + (size_t)(l * 2 + 0) * DM;
    const float* br = KP->moe_b_r + l * 32;
    const float* Y = (const float*)(ws + WS_Y);
    unsigned char* X1Q = ws + WS_X1B;
    float* SAS = (float*)(ws + WS_SAS);
    int* PE = (int*)(ws + WS_PE); int* PPOS = (int*)(ws + WS_PPOS); float* GATE = (float*)(ws + WS_GATE); int* TOKOF = (int*)(ws + WS_TOKOF);
    unsigned* cnt = F.ctl + CW_CNT + l * 32 * 64;
    const int gw = F.bid * 8 + F.wid, NGW = F.G * 8;
    int it = 0;
    f32x4 vnx[4];
    if (gw < T) {
#pragma unroll
        for (int j = 0; j < 4; ++j) vnx[j] = *((const f32x4*)(Y + (size_t)gw * DM) + F.lane + 64 * j);
    }
    for (int row = gw; row < T; row += NGW, ++it) {
        f32x4 v[4]; float s = 0.f;
#pragma unroll
        for (int j = 0; j < 4; ++j) { v[j] = vnx[j]; s += (v[j][0] + v[j][1]) + (v[j][2] + v[j][3]); }
        if (row + NGW < T) {
#pragma unroll
            for (int j = 0; j < 4; ++j) vnx[j] = *((const f32x4*)(Y + (size_t)(row + NGW) * DM) + F.lane + 64 * j);
        }
        const float mean = wave_sum(s) * (1.f / DM); float s2 = 0.f;
#pragma unroll
        for (int j = 0; j < 4; ++j) { v[j] = v[j] - mean; s2 += (v[j][0] * v[j][0] + v[j][1] * v[j][1]) + (v[j][2] * v[j][2] + v[j][3] * v[j][3]); }
        const float rstd = 1.0f / sqrtf(wave_sum(s2) * (1.f / DM) + LN_EPS);
        float am = 0.f;
#pragma unroll
        for (int j = 0; j < 4; ++j) {
            const f32x4 gg = *((const f32x4*)g + F.lane + 64 * j), bb = *((const f32x4*)bt + F.lane + 64 * j);
            v[j] = v[j] * rstd * gg + bb;
            am = fmaxf(fmaxf(am, fmaxf(fabsf(v[j][0]), fabsf(v[j][1]))), fmaxf(fabsf(v[j][2]), fabsf(v[j][3])));
        }
        am = wave_max(am);
        const float qinv = am > 0.f ? 127.0f / am : 0.f;
#pragma unroll
        for (int j = 0; j < 4; ++j) *((unsigned*)(X1Q + (size_t)row * DM) + F.lane + 64 * j) = q8x4(v[j][0], v[j][1], v[j][2], v[j][3], qinv);
        if (F.lane == 0) { stt[2 * (it & 7)] = mean; stt[2 * (it & 7) + 1] = rstd; pairs[(F.wid * 16 + 8 + (it & 7)) * 4] = (int)__float_as_uint(am * (1.0f / 127.0f)); }
    }
    asm volatile("s_waitcnt lgkmcnt(0)" ::: "memory");
    {
        const int r16 = F.lane & 15, kg = F.lane >> 4;
        const int arow = gw + NGW * (r16 & 7);
        const float mean = stt[2 * (r16 & 7)], rstd = stt[2 * (r16 & 7) + 1];
        const float* yr = Y + (size_t)(arow < T ? arow : gw) * DM + 8 * kg;
        const float* gp = g + 8 * kg; const float* bp = bt + 8 * kg;
        f32x4 acc0 = (f32x4){0.f, 0.f, 0.f, 0.f}, acc1 = (f32x4){0.f, 0.f, 0.f, 0.f};
        const int e0 = r16, e1 = 16 + r16;
        const int b0off = e0 * 2048, b1off = e1 * 2048, sw = r16 & 7;
#pragma unroll 4
        for (int s2 = 0; s2 < 32; ++s2) {
            const f32x4 y0 = *(const f32x4*)(yr + 32 * s2), y1 = *(const f32x4*)(yr + 32 * s2 + 4);
            const f32x4 g0 = *(const f32x4*)(gp + 32 * s2), g1 = *(const f32x4*)(gp + 32 * s2 + 4);
            const f32x4 c0 = *(const f32x4*)(bp + 32 * s2), c1 = *(const f32x4*)(bp + 32 * s2 + 4);
            const f32x4 x0 = (y0 - mean) * rstd * g0 + c0, x1 = (y1 - mean) * rstd * g1 + c1;
            u32x4 ah, al;
            ah.x = cvtpk(x0[0], x0[1]); ah.y = cvtpk(x0[2], x0[3]); ah.z = cvtpk(x1[0], x1[1]); ah.w = cvtpk(x1[2], x1[3]);
            al.x = cvtpk(x0[0] - __uint_as_float(ah.x << 16), x0[1] - __uint_as_float(ah.x & 0xffff0000u)); al.y = cvtpk(x0[2] - __uint_as_float(ah.y << 16), x0[3] - __uint_as_float(ah.y & 0xffff0000u));
            al.z = cvtpk(x1[0] - __uint_as_float(ah.z << 16), x1[1] - __uint_as_float(ah.z & 0xffff0000u)); al.w = cvtpk(x1[2] - __uint_as_float(ah.w << 16), x1[3] - __uint_as_float(ah.w & 0xffff0000u));
            const bf16x8 Ah = __builtin_bit_cast(bf16x8, ah), Al = __builtin_bit_cast(bf16x8, al);
            const int co = (((4 * s2 + kg) ^ sw) << 4);
            const bf16x8 Bh0 = *(const LAS bf16x8*)(wH + b0off + co), Bl0 = *(const LAS bf16x8*)(wL + b0off + co);
            const bf16x8 Bh1 = *(const LAS bf16x8*)(wH + b1off + co), Bl1 = *(const LAS bf16x8*)(wL + b1off + co);
            acc0 = __builtin_amdgcn_mfma_f32_16x16x32_bf16(Ah, Bh0, acc0, 0, 0, 0); acc0 = __builtin_amdgcn_mfma_f32_16x16x32_bf16(Al, Bh0, acc0, 0, 0, 0); acc0 = __builtin_amdgcn_mfma_f32_16x16x32_bf16(Ah, Bl0, acc0, 0, 0, 0);
            acc1 = __builtin_amdgcn_mfma_f32_16x16x32_bf16(Ah, Bh1, acc1, 0, 0, 0); acc1 = __builtin_amdgcn_mfma_f32_16x16x32_bf16(Al, Bh1, acc1, 0, 0, 0); acc1 = __builtin_amdgcn_mfma_f32_16x16x32_bf16(Ah, Bl1, acc1, 0, 0, 0);
        }
        if (kg < 2) {
            const float bb0 = br[e0], bb1 = br[e1];
#pragma unroll
            for (int r = 0; r < 4; ++r) { lg[(4 * kg + r) * 32 + e0] = acc0[r] + bb0; lg[(4 * kg + r) * 32 + e1] = acc1[r] + bb1; }
        }
        asm volatile("s_waitcnt lgkmcnt(0)" ::: "memory");
        const int rr = F.lane >> 3, sub = F.lane & 7;
        f32x4 vv[8];
#pragma unroll
        for (int q = 0; q < 8; ++q) vv[q] = *(const LAS f32x4*)(lg + rr * 32 + 4 * q);
        const f32x4 mine = *(const LAS f32x4*)(lg + rr * 32 + 4 * sub);
        int rk[4] = {0, 0, 0, 0};
#pragma unroll
        for (int q = 0; q < 8; ++q)
#pragma unroll
            for (int i = 0; i < 4; ++i) {
                const float ve = vv[q][i]; const int ee = 4 * q + i;
#pragma unroll
                for (int c = 0; c < 4; ++c) rk[c] += (ve > mine[c] || (ve == mine[c] && ee < 4 * sub + c)) ? 1 : 0;
            }
#pragma unroll
        for (int c = 0; c < 4; ++c) if (rk[c] < 4) { rec[(rr * 4 + rk[c]) * 2] = 4 * sub + c; rec[(rr * 4 + rk[c]) * 2 + 1] = (int)__float_as_uint(mine[c]); }
        asm volatile("s_waitcnt lgkmcnt(0)" ::: "memory");
        const int te0 = rec[(rr * 4 + 0) * 2], te1 = rec[(rr * 4 + 1) * 2], te2 = rec[(rr * 4 + 2) * 2], te3 = rec[(rr * 4 + 3) * 2];
        const float tv0 = __uint_as_float((unsigned)rec[(rr * 4 + 0) * 2 + 1]), tv1 = __uint_as_float((unsigned)rec[(rr * 4 + 1) * 2 + 1]);
        const float tv2 = __uint_as_float((unsigned)rec[(rr * 4 + 2) * 2 + 1]), tv3 = __uint_as_float((unsigned)rec[(rr * 4 + 3) * 2 + 1]);
        const float e1_ = __expf(tv1 - tv0), e2_ = __expf(tv2 - tv0), e3_ = __expf(tv3 - tv0);
        const float rs = 1.0f / (1.0f + e1_ + e2_ + e3_);
        const int row = gw + NGW * rr;
        if (sub < 4 && row < T) {
            const int k = sub;
            const int e = k == 0 ? te0 : k == 1 ? te1 : k == 2 ? te2 : te3;
            const float gt = (k == 0 ? 1.0f : k == 1 ? e1_ : k == 2 ? e2_ : e3_) * rs;
            const int rnk = __hip_atomic_fetch_add(lcnt + e, 1, __ATOMIC_RELAXED, __HIP_MEMORY_SCOPE_WORKGROUP);
            PE[row * 4 + k] = e; GATE[row * 4 + k] = gt; pairs[(F.wid * 16 + rr) * 4 + k] = e | (rnk << 8);
        }
    }
    __syncthreads();
    if (F.tid < 32) { const int c = lcnt[F.tid]; gbase[F.tid] = c ? (int)atomicAdd(cnt + F.tid * 64, (unsigned)c) : 0; }
    __syncthreads();
    it = 0;
    for (int row = gw; row < T; row += NGW, ++it) {
        if (F.lane < 4) {
            const int pr = pairs[(F.wid * 16 + (it & 15)) * 4 + F.lane], e = pr & 255, p = gbase[e] + (pr >> 8);
            PPOS[row * 4 + F.lane] = p; TOKOF[(size_t)e * T + p] = row; SAS[(size_t)e * T + p] = __uint_as_float((unsigned)pairs[(F.wid * 16 + 8 + (it & 7)) * 4]);
        }
    }
}

DI void moe_tables(Frame& F, int l, LAS int* tstart, LAS int* soff) {
    __syncthreads();
    if (F.tid == 0) {
        int ts = 0;
        for (int e = 0; e < 32; ++e) {
            const int c = (int)__hip_atomic_load(F.ctl + CW_CNT + (l * 32 + e) * 64, __ATOMIC_RELAXED, __HIP_MEMORY_SCOPE_AGENT);
            tstart[e] = ts; soff[e] = ts * 256; tstart[80 + e] = c; ts += (c + 255) >> 8;
        }
        tstart[32] = ts; soff[32] = ts * 256;
    }
    __syncthreads();
}
DI void phase_moe_gu(Frame& F, const Params& P, int l) {
    F.lane = vlane(); F.tid = F.wid * 64 + F.lane;
    unsigned char* ws = F.ws;
    LAS int* tstart = (LAS int*)(F.lds + LDS_CTL + 64); LAS int* soff = tstart + 40;
    moe_tables(F, l, tstart, soff);
    pg8::Gemm g{(const bf16_t*)(ws + WS_X1B), (const bf16_t*)(ws + WS_W_GU + (size_t)l * 32 * 2048 * 1024), 512};
    LAS int* ulist = (LAS int*)(F.lds + LDS_CTL + 3328);
    MoeOrder::build(F, tstart, 8, ulist);
    MoeOrder S{tstart, 3, true, (const int*)(ws + WS_TOKOF), (const LAS int*)(F.lds + LDS_CTL + 1024), ulist, 1024u};
    EpiGU E{ws + WS_H, KP->moe_b_gu + (size_t)l * 32 * 2048, (const float*)(ws + WS_SGU) + (size_t)l * 32 * 2048, (const float*)(ws + WS_SAS), tstart};
    pg8::gemm_phase<EpiGU, MoeOrder, true, 1>(F.lds, g, S, E, F.wid);
    if (l == 0) { const int rem = (tstart[32] * 8) % F.G; if (rem && F.bid >= rem) conv_pull(F, 1, CONV_GU); }
}
DI void phase_moe_dn(Frame& F, const Params& P, int l) {
    F.lane = vlane(); F.tid = F.wid * 64 + F.lane;
    unsigned char* ws = F.ws;
    LAS int* tstart = (LAS int*)(F.lds + LDS_CTL + 64); LAS int* soff = tstart + 40;
    moe_tables(F, l, tstart, soff);
    pg8::Gemm g{(const bf16_t*)(ws + WS_H), (const bf16_t*)(ws + WS_W_DN + (size_t)l * 32 * 1024 * 1024), 512};
    LAS int* ulist = (LAS int*)(F.lds + LDS_CTL + 3328);
    MoeOrder::build(F, tstart, 4, ulist);
    MoeOrder S{tstart, 2, false, nullptr, nullptr, ulist, 1024u};
    EpiDN E{(bf16_t*)(ws + WS_YE), KP->moe_b_dn + (size_t)l * 32 * 1024, (const float*)(ws + WS_SDN) + (size_t)l * 32 * 1024};
    pg8::gemm_phase<EpiDN, MoeOrder, true, 3>(F.lds, g, S, E, F.wid);
    if (l == 0) { const int rem = (tstart[32] * 4) % F.G; if (rem && F.bid >= rem) conv_pull(F, 1, CONV_DN); }
}


DI void phase_combine(Frame& F, const Params& P, int l, float* outf, bf16_t* outb) {
    F.lane = vlane(); F.tid = F.wid * 64 + F.lane;
    unsigned char* ws = F.ws;
    LAS int* tstart = (LAS int*)(F.lds + LDS_CTL + 64); LAS int* soff = tstart + 40;
    moe_tables(F, l, tstart, soff);
    const float* g = KP->ln_g + (size_t)(l * 2 + 1) * DM; const float* bt = KP->ln_b + (size_t)(l * 2 + 1) * DM;
    const float* X1 = (const float*)(ws + WS_Y); const bf16_t* YE = (const bf16_t*)(ws + WS_YE);
    const float* g1 = KP->ln_g + (size_t)(l * 2 + 0) * DM; const float* b1 = KP->ln_b + (size_t)(l * 2 + 0) * DM;
    const int* PE = (const int*)(ws + WS_PE); const int* PPOS = (const int*)(ws + WS_PPOS); const float* GATE = (const float*)(ws + WS_GATE);
    const int gw = F.bid * 8 + F.wid, NGW = F.G * 8;
    i32x4 ie, ip; f32x4 ig;
    f32x4 xn[4]; u32x2 yn[4][4]; f32x4 gn;
#define CB_LOADIDX(r) do { ie = *(const i32x4*)(PE + (size_t)(r) * 4); ip = *(const i32x4*)(PPOS + (size_t)(r) * 4); ig = *(const f32x4*)(GATE + (size_t)(r) * 4); } while (0)
#define CB_LOADDATA(r) do { gn = ig; \
        _Pragma("unroll") for (int j = 0; j < 4; ++j) xn[j] = *((const f32x4*)(X1 + (size_t)(r) * DM) + F.lane + 64 * j); \
        _Pragma("unroll") for (int k = 0; k < 4; ++k) { const int slot = soff[ie[k]] + ip[k]; const u32x2* yr = (const u32x2*)(YE + (size_t)slot * 1024) + F.lane; \
            _Pragma("unroll") for (int j = 0; j < 4; ++j) yn[k][j] = yr[64 * j]; } } while (0)
    if (gw < T) { CB_LOADIDX(gw); CB_LOADDATA(gw); if (gw + NGW < T) CB_LOADIDX(gw + NGW); }
    for (int row = gw; row < T; row += NGW) {
        f32x4 v[4]; u32x2 yc[4][4]; f32x4 gc = gn;
        {
            float s0 = 0.f;
#pragma unroll
            for (int j = 0; j < 4; ++j) { v[j] = xn[j]; s0 += (v[j][0] + v[j][1]) + (v[j][2] + v[j][3]); }
            const float mean0 = wave_sum(s0) * (1.f / DM); float q0 = 0.f;
#pragma unroll
            for (int j = 0; j < 4; ++j) { v[j] = v[j] - mean0; q0 += (v[j][0] * v[j][0] + v[j][1] * v[j][1]) + (v[j][2] * v[j][2] + v[j][3] * v[j][3]); }
            const float rstd0 = 1.0f / sqrtf(wave_sum(q0) * (1.f / DM) + LN_EPS);
#pragma unroll
            for (int j = 0; j < 4; ++j) {
                const f32x4 gg = *((const f32x4*)g1 + F.lane + 64 * j), bb = *((const f32x4*)b1 + F.lane + 64 * j);
                v[j] = (v[j] * rstd0 * gg + bb) * ALPHA;
            }
        }
#pragma unroll
        for (int k = 0; k < 4; ++k)
#pragma unroll
            for (int j = 0; j < 4; ++j) yc[k][j] = yn[k][j];
        if (row + NGW < T) { CB_LOADDATA(row + NGW); if (row + 2 * NGW < T) CB_LOADIDX(row + 2 * NGW); }
#pragma unroll
        for (int k = 0; k < 4; ++k) {
            const float gt = gc[k];
#pragma unroll
            for (int j = 0; j < 4; ++j) {
                const u32x2 w = yc[k][j];
                v[j][0] += gt * __uint_as_float(w.x << 16); v[j][1] += gt * __uint_as_float(w.x & 0xffff0000u);
                v[j][2] += gt * __uint_as_float(w.y << 16); v[j][3] += gt * __uint_as_float(w.y & 0xffff0000u);
            }
        }
        float s = 0.f;
#pragma unroll
        for (int j = 0; j < 4; ++j) s += (v[j][0] + v[j][1]) + (v[j][2] + v[j][3]);
        const float mean = wave_sum(s) * (1.f / DM); float s2 = 0.f;
#pragma unroll
        for (int j = 0; j < 4; ++j) { v[j] = v[j] - mean; s2 += (v[j][0] * v[j][0] + v[j][1] * v[j][1]) + (v[j][2] * v[j][2] + v[j][3] * v[j][3]); }
        const float rstd = 1.0f / sqrtf(wave_sum(s2) * (1.f / DM) + LN_EPS);
#pragma unroll
        for (int j = 0; j < 4; ++j) {
            const f32x4 gg = *((const f32x4*)g + F.lane + 64 * j), bb = *((const f32x4*)bt + F.lane + 64 * j);
            v[j] = v[j] * rstd * gg + bb;
            *((f32x4*)(outf + (size_t)row * DM) + F.lane + 64 * j) = v[j];
            if (outb) *((u32x2*)(outb + (size_t)row * DM) + F.lane + 64 * j) = (u32x2){cvtpk(v[j][0], v[j][1]), cvtpk(v[j][2], v[j][3])};
        }
    }
#undef CB_LOADIDX
#undef CB_LOADDATA
}

DI void phase_lat(Frame& F) {
    F.lane = vlane(); F.tid = F.wid * 64 + F.lane;
    unsigned char* ws = F.ws;
    pg8::Gemm g{(const bf16_t*)(ws + WS_XB), (const bf16_t*)(ws + WS_W_BIN), 1024}; pg8::StaticOrder S; S.init(T, 1024, 1024, F.G, F.bid);
    EpiLat E{(float*)(ws + WS_LAT), 928};
    pg8::gemm_phase<EpiLat, pg8::StaticOrder, false>(F.lds, g, S, E, F.wid);
}

DI void phase_latrows(Frame& F, const Params& P) {
    F.lane = vlane(); F.tid = F.wid * 64 + F.lane;
    unsigned char* ws = F.ws;
    const float* LAT = (const float*)(ws + WS_LAT);
    bf16_t* CKV = (bf16_t*)(ws + WS_CKV); bf16_t* CQ = (bf16_t*)(ws + WS_CQ); bf16_t* MQ = (bf16_t*)(ws + WS_MQ); bf16_t* Kb = (bf16_t*)(ws + WS_K);
    const int gw = F.bid * 8 + F.wid, NGW = F.G * 8;
    for (int row = gw; row < T; row += NGW) {
        const float* lr = LAT + (size_t)row * 1024;
        {
            const f32x4 v = *((const f32x4*)lr + F.lane);
            const float ss = wave_sum((v[0] * v[0] + v[1] * v[1]) + (v[2] * v[2] + v[3] * v[3]));
            const float rs = 1.0f / sqrtf(ss * (1.f / 256.f) + RMS_EPS);
            const f32x4 gg = *((const f32x4*)KP->kv_g + F.lane);
            const f32x4 o = v * rs * gg;
            *((u32x2*)(CKV + (size_t)row * 256) + F.lane) = (u32x2){cvtpk(o[0], o[1]), cvtpk(o[2], o[3])};
        }
        {
            const f32x4 v0 = *((const f32x4*)(lr + 288) + F.lane);
            f32x4 v1 = (f32x4){0.f, 0.f, 0.f, 0.f};
            if (F.lane < 32) v1 = *((const f32x4*)(lr + 288 + 256) + F.lane);
            const float ss = wave_sum((v0[0] * v0[0] + v0[1] * v0[1]) + (v0[2] * v0[2] + v0[3] * v0[3]) + (v1[0] * v1[0] + v1[1] * v1[1]) + (v1[2] * v1[2] + v1[3] * v1[3]));
            const float rs = 1.0f / sqrtf(ss * (1.f / 384.f) + RMS_EPS);
            const f32x4 g0 = *((const f32x4*)KP->b_g_q + F.lane);
            const f32x4 o0 = v0 * rs * g0;
            *((u32x2*)(CQ + (size_t)row * 384) + F.lane) = (u32x2){cvtpk(o0[0], o0[1]), cvtpk(o0[2], o0[3])};
            if (F.lane < 32) {
                const f32x4 g1 = *((const f32x4*)(KP->b_g_q + 256) + F.lane);
                const f32x4 o1 = v1 * rs * g1;
                *((u32x2*)(CQ + (size_t)row * 384 + 256) + F.lane) = (u32x2){cvtpk(o1[0], o1[1]), cvtpk(o1[2], o1[3])};
            }
        }
        {
            const f32x4 v = *((const f32x4*)(lr + 672) + F.lane) * (0.125f * LOG2E);
            *((u32x2*)(MQ + (size_t)row * 256) + F.lane) = (u32x2){cvtpk(v[0], v[1]), cvtpk(v[2], v[3])};
        }
        if (F.lane < 16) {
            const int i = F.lane;
            const float p = (float)KP->pos[row];
            const float inv = exp2f(-(float)i * (13.287712379549449f / 16.0f));
            float sn, cs; sincos_cw(p * inv, sn, cs);
            const float x1 = lr[256 + i], x2 = lr[256 + 16 + i];
            const unsigned short o1 = (unsigned short)(cvtpk(x1 * cs - x2 * sn, 0.f) & 0xffffu), o2 = (unsigned short)(cvtpk(x1 * sn + x2 * cs, 0.f) & 0xffffu);
#pragma unroll
            for (int h = 0; h < NH; ++h) { Kb[(size_t)row * 1152 + h * 96 + 64 + i] = o1; Kb[(size_t)row * 1152 + h * 96 + 80 + i] = o2; }
        }
    }
}
#ifndef UPSEL
#define UPSEL 7
#endif
struct RouteK1 { unsigned char* ws; DI Dst operator()(const pg8::Unit& u) const { return Dst{(bf16_t*)(ws + WS_K), 1152, u.pm * 256, u.pn * 384, 256, 1.0f, true}; } };
struct RouteQ1 { unsigned char* ws; DI Dst operator()(const pg8::Unit& u) const { const int nv = 1152 - u.pn * 256; return Dst{(bf16_t*)(ws + WS_Q), 1152, u.pm * 256, u.pn * 256, nv < 256 ? nv : 256, 0.10206207261596577f * LOG2E, false}; } };
DI void phase_up1(Frame& F) {
    F.lane = vlane(); F.tid = F.wid * 64 + F.lane;
    unsigned char* ws = F.ws;
    const bf16_t* ckv = (const bf16_t*)(ws + WS_CKV); const bf16_t* cq = (const bf16_t*)(ws + WS_CQ);
    const bf16_t* wukv = (const bf16_t*)(ws + WS_W_UKV); const bf16_t* wuq = (const bf16_t*)(ws + WS_W_UQ);
#if (UPSEL & 1)
    {
        pg8::Gemm g{cq, wuq, 384}; pg8::StaticOrder S; S.init(T, 1280, 384, F.G, F.bid);
        EpiBf16R<RouteQ1> E{RouteQ1{ws}};
        pg8::gemm_phase<EpiBf16R<RouteQ1>, pg8::StaticOrder, true>(F.lds, g, S, E, F.wid);
    }
#endif
#if (UPSEL & 2)
    {
        pg8::Gemm g{ckv, wukv, 256}; pg8::StaticOrder S; S.init(T, 768, 256, F.G, F.G - 1 - F.bid);
        EpiBf16R<RouteK1> E{RouteK1{ws}};
        pg8::gemm_phase<EpiBf16R<RouteK1>, pg8::StaticOrder, true>(F.lds, g, S, E, F.wid);
    }
#endif
#if (UPSEL & 4)
    {
        pg8::Gemm g{wukv + (size_t)768 * 256, ckv, 256}; pg8::StaticOrder S; S.init(768, T, 256, F.G, F.G - 1 - F.bid);
        EpiBf16R<RouteVT> E{RouteVT{ws}};
        pg8::gemm_phase<EpiBf16R<RouteVT>, pg8::StaticOrder, true>(F.lds, g, S, E, F.wid);
    }
#endif
}


__global__ void __launch_bounds__(NTHREADS) mega_fwd(Params P) {
    extern __shared__ __attribute__((aligned(16))) unsigned char lds_raw[];
    Frame F;
    F.lds = (LAS unsigned char*)lds_raw; F.ws = KP->ws; F.ctl = (unsigned*)(KP->ws + WS_CTL);
    F.wid = __builtin_amdgcn_readfirstlane((int)threadIdx.x >> 6); F.lane = vlane(); F.tid = F.wid * 64 + F.lane; F.G = gridDim.x; F.bid = blockIdx.x;
    const int lo = KP->ph_lo, hi = KP->ph_hi;
    { volatile LAS unsigned* st0 = (volatile LAS unsigned*)(F.lds + LDS_CTL + 512); if (F.tid < 2) st0[F.tid] = 0u; }
    __syncthreads();
    XcdBarrier bar = xcd_barrier_post(F.ctl + CW_BAR, (volatile LAS unsigned*)(F.lds + LDS_CTL + 512), F.wid);
#ifndef PHMASK
#define PHMASK 0x1ffff
#endif
#define IN(k) (((PHMASK >> (k)) & 1) && lo <= (k) && (k) < hi)
#define SEAM(k) do { if (IN(k) && IN((k) + 1)) { if (KP->use_grid_sync) { if ((k) == 0) cg::this_grid().sync(); else xcd_barrier(bar); } } } while (0)
    unsigned char* ws = KP->ws;
    if (IN(0)) { phase_prologue(F, P);
    }
    SEAM(0);
    if (IN(1)) { phase_proj0(F, P);
        if (KP->use_grid_sync) xcd_barrier(bar); phase_scan_knorm(F); }
    SEAM(1);
    if (IN(2)) { phase_attn0(F, P);
    }
    SEAM(2);
    if (IN(3)) { phase_outproj(F, KP->x, (const bf16_t*)(ws + WS_W_AOUT));
    }
    SEAM(3);
    if (IN(4)) phase_ln_router(F, P, 0);
    SEAM(4);
    if (IN(5)) phase_moe_gu(F, P, 0);
    SEAM(5);
    if (IN(6)) phase_moe_dn(F, P, 0);
    SEAM(6);
    if (IN(7)) phase_combine(F, P, 0, (float*)(ws + WS_X2), (bf16_t*)(ws + WS_XB));
    SEAM(7);
    if (IN(8)) phase_lat(F);
    SEAM(8);
    if (IN(9)) phase_latrows(F, P);
    SEAM(9);
    if (IN(10)) { phase_up1(F);
    }
    SEAM(10);
    if (IN(11)) { phase_attn1(F, P);
    }
    SEAM(11);
    if (IN(12)) phase_outproj(F, (const float*)(ws + WS_X2), (const bf16_t*)(ws + WS_W_BOUT));
    SEAM(12);
    if (IN(13)) phase_ln_router(F, P, 1);
    SEAM(13);
    if (IN(14)) { phase_moe_gu(F, P, 1);
    }
    SEAM(14);
    if (IN(15)) { phase_moe_dn(F, P, 1);
    }
    SEAM(15);
    if (IN(16)) { phase_combine(F, P, 1, KP->out, nullptr);
    }
#undef IN
#undef SEAM
}

constexpr int N_PHASES = 17;
#ifndef MK_N_LAUNCHES
#define MK_N_LAUNCHES 1
#endif

extern "C" void kernel_launch(void* const* d_in, const int* in_sizes, int n_in, void* d_out, int out_size, void* d_ws, size_t ws_size, hipStream_t stream) {
    static int grid = 0;
    if (grid == 0) {
        if (n_in != 22 || ws_size < WS_END) { fprintf(stderr, "kernel_launch: need 22 inputs and %zu bytes of workspace (got %d, %zu)\n", (size_t)WS_END, n_in, ws_size); grid = -1; return; }
        int dev = 0, cus = 0, per_cu = 0;
        hipGetDevice(&dev);
        hipDeviceGetAttribute(&cus, hipDeviceAttributeMultiprocessorCount, dev);
        if (hipFuncSetAttribute((const void*)mega_fwd, hipFuncAttributeMaxDynamicSharedMemorySize, LDS_BYTES) != hipSuccess) fprintf(stderr, "kernel_launch: hipFuncSetAttribute failed\n");
        if (hipOccupancyMaxActiveBlocksPerMultiprocessor(&per_cu, (const void*)mega_fwd, NTHREADS, LDS_BYTES) != hipSuccess || per_cu < 1) { fprintf(stderr, "kernel_launch: occupancy query failed (%d)\n", per_cu); per_cu = 1; }
        (void)hipGetLastError();
        grid = cus * (per_cu > 1 ? 1 : per_cu);
        if (grid <= 0) grid = 256;
        if (grid != 256) fprintf(stderr, "kernel_launch: built for a 256-CU device (one workgroup per CU); got %d\n", grid);
    }
    if (grid < 0) return;
    hipMemsetAsync((char*)d_ws + WS_CTL, 0, CTL_BYTES, stream);
    Params p{};
    p.x = (const float*)d_in[0]; p.mem = (const float*)d_in[1]; p.pos = (const int*)d_in[2];
    p.a_w_in = (const float*)d_in[3]; p.a_b_f = (const float*)d_in[4]; p.a_w_out = (const float*)d_in[5];
    p.b_w_in = (const float*)d_in[6]; p.b_g_q = (const float*)d_in[7]; p.b_w_uq = (const float*)d_in[8]; p.b_w_out = (const float*)d_in[9];
    p.kv_w_dkv = (const float*)d_in[10]; p.kv_g = (const float*)d_in[11]; p.kv_w_ukv = (const float*)d_in[12]; p.mem_w_kv = (const float*)d_in[13];
    p.ln_g = (const float*)d_in[14]; p.ln_b = (const float*)d_in[15]; p.moe_w_r = (const float*)d_in[16]; p.moe_b_r = (const float*)d_in[17];
    p.moe_w_gu = (const float*)d_in[18]; p.moe_b_gu = (const float*)d_in[19]; p.moe_w_dn = (const float*)d_in[20]; p.moe_b_dn = (const float*)d_in[21];
    p.out = (float*)d_out; p.ws = (unsigned char*)d_ws;
    if (MK_N_LAUNCHES == 1) {
        p.ph_lo = 0; p.ph_hi = N_PHASES; p.use_grid_sync = 1;
        void* args[] = {&p};
        hipError_t e = hipLaunchCooperativeKernel((const void*)mega_fwd, dim3(grid), dim3(NTHREADS), args, LDS_BYTES, stream);
        if (e != hipSuccess) fprintf(stderr, "kernel_launch: cooperative launch failed: %s (grid %d)\n", hipGetErrorString(e), grid);
    } else {
        for (int ph = 0; ph < N_PHASES; ++ph) {
            p.ph_lo = ph; p.ph_hi = ph + 1; p.use_grid_sync = 0;
            hipLaunchKernelGGL(mega_fwd, dim3(grid), dim3(NTHREADS), LDS_BYTES, stream, p);
        }
    }
}
```

```cpp
#include <hip/hip_runtime.h>
#include <hip/hip_cooperative_groups.h>
#include <cstdio>
#include <cstdint>
#include <cmath>
namespace cg = cooperative_groups;

#define DI __device__ __forceinline__
#define LAS __attribute__((address_space(3)))
typedef unsigned short bf16_t;
typedef short bf16x8 __attribute__((ext_vector_type(8)));
typedef float f32x4 __attribute__((ext_vector_type(4)));
typedef float f32x2 __attribute__((ext_vector_type(2)));
typedef float f32x16 __attribute__((ext_vector_type(16)));
typedef unsigned u32x4 __attribute__((ext_vector_type(4)));
typedef unsigned u32x2 __attribute__((ext_vector_type(2)));
typedef int i32x4 __attribute__((ext_vector_type(4)));
typedef int i32x8 __attribute__((ext_vector_type(8)));
typedef long i64x4 __attribute__((ext_vector_type(4)));
typedef __bf16 bf16x2_t __attribute__((ext_vector_type(2)));

constexpr int NB = 2, SEQ = 8192, T = NB * SEQ, DM = 1024;
constexpr int NH = 12, NMEM = 256;
constexpr int FOX_IN = 2572;
constexpr int NE = 32;
constexpr float LOG2E = 1.4426950408889634f;
constexpr float ALPHA = 1.4142135623730951f;
constexpr float LN_EPS = 1e-5f, RMS_EPS = 1e-6f;
constexpr int NTHREADS = 512;
constexpr int LDS_BYTES = 131072 + 4096 + 8 * 1280 + 512;
constexpr int LDS_R1X = 131072 + 4096;
constexpr int LDS_CTL = 131072;
constexpr int SLOT_ROWS = 65536 + NE * 256;

constexpr size_t al256(size_t x) { return (x + 255) & ~(size_t)255; }
constexpr size_t WS_CTL = 0, CTL_BYTES = 65536;
constexpr size_t WS_W_AIN = al256(WS_CTL + CTL_BYTES);
constexpr size_t WS_W_AOUT = al256(WS_W_AIN + (size_t)2560 * 1024 * 2);
constexpr size_t WS_W_BIN = al256(WS_W_AOUT + (size_t)1024 * 1024 * 2);
constexpr size_t WS_W_UQ = al256(WS_W_BIN + (size_t)1024 * 1024 * 2);
constexpr size_t WS_W_UKV = al256(WS_W_UQ + (size_t)1280 * 384 * 2);
constexpr size_t WS_W_BOUT = al256(WS_W_UKV + (size_t)1536 * 256 * 2);
constexpr size_t WS_W_MKV = al256(WS_W_BOUT + (size_t)1024 * 1024 * 2);
constexpr size_t WS_W_GU = al256(WS_W_MKV + (size_t)2 * 512 * 1024 * 2);
constexpr size_t WS_W_DN = al256(WS_W_GU + (size_t)2 * 32 * 2048 * 1024 * 2);
constexpr size_t WS_XB = al256(WS_W_DN + (size_t)2 * 32 * 1024 * 1024 * 2);
constexpr size_t WS_MEMB = al256(WS_XB + (size_t)T * 1024 * 2);
constexpr size_t WS_LOGF = al256(WS_MEMB + (size_t)512 * 1024 * 2);
constexpr size_t WS_CUM = al256(WS_LOGF + (size_t)24 * 8192 * 4);
constexpr size_t WS_Q = al256(WS_CUM + (size_t)24 * 8192 * 4);
constexpr size_t WS_K = al256(WS_Q + (size_t)T * 1152 * 2);
constexpr size_t WS_VT = al256(WS_K + (size_t)T * 1152 * 2);
constexpr size_t WS_MQ = al256(WS_VT + (size_t)1536 * 8192 * 2);
constexpr size_t WS_MK = al256(WS_MQ + (size_t)T * 256 * 2);
constexpr size_t WS_MVT = al256(WS_MK + (size_t)2 * 512 * 256 * 2);
constexpr size_t WS_MERGED = al256(WS_MVT + (size_t)2 * 2 * 256 * 256 * 2);
constexpr size_t WS_Y = al256(WS_MERGED + (size_t)T * 1024 * 2);
constexpr size_t WS_X1 = al256(WS_Y + (size_t)T * 1024 * 4);
constexpr size_t WS_X1B = al256(WS_X1 + (size_t)T * 1024 * 4);
constexpr size_t WS_PE = al256(WS_X1B + (size_t)T * 1024 * 2);
constexpr size_t WS_PPOS = al256(WS_PE + (size_t)T * 4 * 4);
constexpr size_t WS_GATE = al256(WS_PPOS + (size_t)T * 4 * 4);
constexpr size_t WS_TOKOF = al256(WS_GATE + (size_t)T * 4 * 4);
constexpr size_t WS_H = al256(WS_TOKOF + (size_t)NE * T * 4);
constexpr size_t WS_YE = al256(WS_H + (size_t)SLOT_ROWS * 1024 * 2);
constexpr size_t WS_LAT = al256(WS_YE + (size_t)SLOT_ROWS * 1024 * 2);
constexpr size_t WS_CKV = al256(WS_LAT + (size_t)T * 1024 * 4);
constexpr size_t WS_CQ = al256(WS_CKV + (size_t)T * 256 * 2);
constexpr size_t WS_X2 = al256(WS_CQ + (size_t)T * 384 * 2);
constexpr size_t WS_KN2 = al256(WS_X2 + (size_t)T * 1024 * 4);
constexpr size_t WS_WRT = al256(WS_KN2 + (size_t)24 * 128 * 4);
constexpr size_t WS_WRH = al256(WS_WRT + (size_t)2 * 32 * 1024 * 4);
constexpr size_t WS_WRL = al256(WS_WRH + (size_t)2 * 32 * 1024 * 2);
constexpr size_t WS_SGU = al256(WS_WRL + (size_t)2 * 32 * 1024 * 2);
constexpr size_t WS_SDN = al256(WS_SGU + (size_t)2 * 32 * 2048 * 4);
constexpr size_t WS_SAS = al256(WS_SDN + (size_t)2 * 32 * 1024 * 4);
constexpr size_t WS_END = al256(WS_SAS + (size_t)NE * T * 4);
constexpr int CW_CNT = 8192;
constexpr int CW_WORK = 256;
constexpr int CW_BAR = 4096;

struct Params {
    const float* x; const float* mem; const int* pos;
    const float *a_w_in, *a_b_f, *a_w_out, *b_w_in, *b_g_q, *b_w_uq, *b_w_out, *kv_w_dkv, *kv_g, *kv_w_ukv, *mem_w_kv, *ln_g, *ln_b;
    const float *moe_w_r, *moe_b_r, *moe_w_gu, *moe_b_gu, *moe_w_dn, *moe_b_dn;
    float* out; unsigned char* ws; int ph_lo, ph_hi; int use_grid_sync, pad;
};

#define KP ((const __attribute__((address_space(4))) Params*)__builtin_amdgcn_kernarg_segment_ptr())
DI unsigned cvtpk(float lo, float hi) { f32x2 v = {lo, hi}; bf16x2_t b = __builtin_convertvector(v, bf16x2_t); return __builtin_bit_cast(unsigned, b); }
DI float bf2f(unsigned short b) { return __uint_as_float(((unsigned)b) << 16); }
DI float wave_sum(float v) {
#pragma unroll
    for (int o = 1; o < 64; o <<= 1) v += __shfl_xor(v, o);
    return v;
}
DI float wave_max(float v) {
#pragma unroll
    for (int o = 1; o < 64; o <<= 1) v = fmaxf(v, __shfl_xor(v, o));
    return v;
}

DI void sincos_cw(float x, float& sn, float& cs) {
    int j = (int)(x * 1.27323954473516f); j = (j + 1) & ~1;
    const float y = (float)j;
    const float r = ((x - y * 0.78515625f) - y * 2.4187564849853515625e-4f) - y * 3.77489497744594108e-8f;
    const float z = r * r;
    const float sp = ((-1.9515295891e-4f * z + 8.3321608736e-3f) * z - 1.6666654611e-1f) * z * r + r;
    const float cp = ((2.443315711809948e-5f * z - 1.388731625493765e-3f) * z + 4.166664568298827e-2f) * z * z - 0.5f * z + 1.0f;
    const int q = (j >> 1) & 3;
    const float s0 = (q & 1) ? cp : sp, c0 = (q & 1) ? sp : cp;
    sn = (q & 2) ? -s0 : s0;
    cs = ((q + 1) & 2) ? -c0 : c0;
}
DI float fadd_s(float a, float b) { float r; asm("v_add_f32_e32 %0, %1, %2" : "=v"(r) : "v"(a), "v"(b)); return r; }
DI int vlane() { int l; asm volatile("v_mbcnt_lo_u32_b32 %0, -1, 0\n\tv_mbcnt_hi_u32_b32 %0, -1, %0" : "=v"(l)); return l; }
#define LDS_WAIT() asm volatile("s_waitcnt lgkmcnt(0)" ::: "memory")
#define VM_WAIT() asm volatile("s_waitcnt vmcnt(0)" ::: "memory")

#ifndef GEMM_TOKPF
#define GEMM_TOKPF 2
#endif
namespace pg8 {
constexpr int BM = 256, BK = 64, HALF = 128, HTB = HALF * BK * 2, STAGE_BYTES = 8 * HTB, NXCD = 8, WGM = 8;
DI int lds_byte(int r, int c) { const int st = (r >> 4) * 2 + (c >> 5), rr = r & 15, cc = c & 31, ob = rr * 64 + cc * 2; return st * 1024 + (ob ^ (((ob >> 9) & 1) << 5)); }
DI void stage_rc(int b, int& R, int& C) { const int st = b / 1024, sb = b % 1024, swz = sb ^ (((sb >> 9) & 1) << 5); R = (st >> 1) * 16 + swz / 64; C = (st & 1) * 32 + (swz % 64) / 2; }
DI int perm32(int rho) { const int n = rho >> 4, i = rho & 15; return 8 * (i >> 2) + 4 * n + (i & 3); }
struct Unit { int pm, pn; };
struct Gemm { const bf16_t* A; const bf16_t* Bt; int K; };
struct StaticOrder {
    int nM, nN, nwg, G, c, K2;
    DI void init(int M, int N, int K, int G_, int c_) { nM = M / BM; nN = N / BM; nwg = nM * nN; G = G_; c = c_; K2 = K * 2; }
    DI bool next(int i, Unit& u) const {
        const long L = (long)i * G + c; if (L >= nwg) return false;
        int wgid = (int)L; { const int q = nwg / NXCD, r = nwg % NXCD, xcd = wgid % NXCD, off = wgid / NXCD; wgid = (xcd < r ? xcd * (q + 1) : r * (q + 1) + (xcd - r) * q) + off; }
        const int nig = WGM * nN, gid = wgid / nig, fm = gid * WGM, gsz = (nM - fm) < WGM ? (nM - fm) : WGM;
        u.pm = fm + ((wgid % nig) % gsz); u.pn = (wgid % nig) / gsz; return true;
    }
    DI unsigned a_off(const Unit& u, int r) const { return (unsigned)(u.pm * BM + r) * (unsigned)K2; }
    DI unsigned a_off_pf(const Unit& u, int r, int) const { return a_off(u, r); }
    DI void prefetch(const Unit&, int, int, int) const {}
    DI void a_ready(const Unit&) const {}
    DI void done(const Unit&) const {}
};

template <class Epi, class Sched, bool ALIGN_EPI, int MODE = 0>
DI void gemm_phase(LAS unsigned char* lds, const Gemm g, const Sched& S, const Epi& E, const int wid) {
    const int lane = vlane(), tid = wid * 64 + lane, wr = wid >> 2, wc = wid & 3, fr = lane & 15, fq = lane >> 4;
    const int K = g.K, nt = K / BK;
    int RA[2]; unsigned cA2[2], voffB[2];
#pragma unroll
    for (int i = 0; i < 2; ++i) { int R, C; stage_rc(tid * 16 + i * 8192, R, C); const int Rb = Epi::PERM ? ((R & ~31) + perm32(R & 31)) : R;
        RA[i] = R; cA2[i] = (unsigned)C * 2u; voffB[i] = (unsigned)(Rb * K + C) * 2u; }
    const size_t kstep = (size_t)(BK * 2);
    const size_t hstep = (size_t)HALF * K * 2;
    const size_t tstep = 2 * hstep;
    const unsigned ldsw = (unsigned)wid * 1024u;
    const int aoff = lds_byte(wr * 64 + fr, fq * 8), boff = lds_byte(wc * 32 + fr, fq * 8);
#define PG8_SA(b, h) (((b) * 2 + (h)) * HTB)
#define PG8_SB(b, h) ((4 + (b) * 2 + (h)) * HTB)
#define PG8_STAGE_B(bufoff, gbase) do { _Pragma("unroll") for (int _i = 0; _i < 2; ++_i) \
        __builtin_amdgcn_global_load_lds((const unsigned*)((const char*)(gbase) + voffB[_i]), (LAS unsigned*)(lds + (bufoff) + ldsw + _i * 8192), 16, 0, 0); } while (0)
#define PG8_STAGE_A(bufoff, kbytes, uo) do { _Pragma("unroll") for (int _i = 0; _i < 2; ++_i) \
        __builtin_amdgcn_global_load_lds((const unsigned*)((const char*)g.A + (kbytes) + (uo)[_i]), (LAS unsigned*)(lds + (bufoff) + ldsw + _i * 8192), 16, 0, 0); } while (0)
#define PG8_STAGE_A2(bufoff, kbytes, h) do { _Pragma("unroll") for (int _i = 0; _i < 2; ++_i) \
        __builtin_amdgcn_global_load_lds((const unsigned*)((const char*)g.A + (kbytes) + (last ? uN[h][_i] : uC[h][_i])), (LAS unsigned*)(lds + (bufoff) + ldsw + _i * 8192), 16, 0, 0); } while (0)
#define PG8_LDA(dst, b, h) do { _Pragma("unroll") for (int m = 0; m < 4; ++m) { dst[m].lo = *(const LAS i32x4*)(lds + PG8_SA(b, h) + aoff + m * 2048); dst[m].hi = *(const LAS i32x4*)(lds + PG8_SA(b, h) + aoff + m * 2048 + 1024); } } while (0)
#define PG8_LDB(dst, b, h) do { _Pragma("unroll") for (int n = 0; n < 2; ++n) { dst[n].lo = *(const LAS i32x4*)(lds + PG8_SB(b, h) + boff + n * 2048); dst[n].hi = *(const LAS i32x4*)(lds + PG8_SB(b, h) + boff + n * 2048 + 1024); } } while (0)
#define PG8_MMA(ai, bj, At, Bt) do { __builtin_amdgcn_s_setprio(1); _Pragma("unroll") for (int m = 0; m < 4; ++m) _Pragma("unroll") for (int n = 0; n < 2; ++n) { \
        if constexpr (MODE == 2) acc[ai][bj][m][n] = __builtin_amdgcn_mfma_scale_f32_16x16x128_f8f6f4(Bt[n], At[m], acc[ai][bj][m][n], 0, 0, 0, 0, 0, 0); \
        else if constexpr (MODE == 3) { const i64x4 b4_ = __builtin_bit_cast(i64x4, Bt[n]), a4_ = __builtin_bit_cast(i64x4, At[m]); _Pragma("unroll") for (int q = 0; q < 4; ++q) acc[ai][bj][m][n] = __builtin_amdgcn_mfma_f32_16x16x32_fp8_fp8(b4_[q], a4_[q], acc[ai][bj][m][n], 0, 0, 0); } \
        else if constexpr (MODE == 1) { acc[ai][bj][m][n] = __builtin_bit_cast(f32x4, __builtin_amdgcn_mfma_i32_16x16x64_i8(Bt[n].lo, At[m].lo, __builtin_bit_cast(i32x4, acc[ai][bj][m][n]), 0, 0, 0)); \
                                        acc[ai][bj][m][n] = __builtin_bit_cast(f32x4, __builtin_amdgcn_mfma_i32_16x16x64_i8(Bt[n].hi, At[m].hi, __builtin_bit_cast(i32x4, acc[ai][bj][m][n]), 0, 0, 0)); } \
        else { const i32x4 bl_ = Bt[n].lo, bh_ = Bt[n].hi, al_ = At[m].lo, ah_ = At[m].hi;     \
               acc[ai][bj][m][n] = __builtin_amdgcn_mfma_f32_16x16x32_bf16(__builtin_bit_cast(bf16x8, bl_), __builtin_bit_cast(bf16x8, al_), acc[ai][bj][m][n], 0, 0, 0); \
               acc[ai][bj][m][n] = __builtin_amdgcn_mfma_f32_16x16x32_bf16(__builtin_bit_cast(bf16x8, bh_), __builtin_bit_cast(bf16x8, ah_), acc[ai][bj][m][n], 0, 0, 0); } } __builtin_amdgcn_s_setprio(0); } while (0)
#define PG8_WAIT_V(n) asm volatile("s_waitcnt vmcnt(" #n ")" ::: "memory")
#define PG8_WAIT_L(n) asm volatile("s_waitcnt lgkmcnt(" #n ")" ::: "memory")
#define PG8_BAR __builtin_amdgcn_s_barrier()
#define PG8_SCHED __builtin_amdgcn_sched_barrier(0)
    Unit cur, nxt; int ui = 0;
    if (!S.next(0, cur)) return;
    f32x4 acc[2][2][4][2];
#pragma unroll
    for (int a = 0; a < 2; ++a)
#pragma unroll
        for (int b = 0; b < 2; ++b)
#pragma unroll
            for (int m = 0; m < 4; ++m)
#pragma unroll
                for (int n = 0; n < 2; ++n) acc[a][b][m][n] = (f32x4){0.f, 0.f, 0.f, 0.f};
    i32x8 At[4], B0[2], B1[2];
    unsigned uC[2][2], uN[2][2];
#pragma unroll
    for (int h = 0; h < 2; ++h)
#pragma unroll
        for (int i = 0; i < 2; ++i) uC[h][i] = S.a_off(cur, h * HALF + RA[i]) + cA2[i];
    const char* cB = (const char*)g.Bt + (size_t)cur.pn * tstep;
    S.a_ready(cur); E.prefetch(lds, cur, 0, wid);
    PG8_STAGE_B(PG8_SB(0, 0), cB); PG8_STAGE_B(PG8_SB(0, 1), cB + hstep); PG8_STAGE_A(PG8_SA(0, 0), 0, uC[0]); PG8_STAGE_A(PG8_SA(0, 1), 0, uC[1]);
    if (wr == 1) PG8_BAR;
    PG8_WAIT_V(2); PG8_BAR;
    PG8_STAGE_B(PG8_SB(1, 0), cB + kstep); PG8_STAGE_A(PG8_SA(1, 0), kstep, uC[0]); PG8_STAGE_B(PG8_SB(1, 1), cB + hstep + kstep);
    PG8_WAIT_V(6); PG8_BAR;
    for (;;) {
        const bool has_next = S.next(ui + 1, nxt);
        const char* nB = has_next ? (const char*)g.Bt + (size_t)nxt.pn * tstep : cB;
#if GEMM_TOKPF == 1
        if (has_next) S.prefetch(nxt, (ui + 1) & 1, wid, lane);
#elif GEMM_TOKPF == 2
        {
            Unit nx2; const bool has2 = S.next(ui + 2, nx2);
            int RAn[2]; unsigned cAn[2];
            { const int tid2 = wid * 64 + vlane();
#pragma unroll
              for (int i = 0; i < 2; ++i) { int R, C; stage_rc(tid2 * 16 + i * 8192, R, C); RAn[i] = R; cAn[i] = (unsigned)C * 2u; } }
#pragma unroll
            for (int h = 0; h < 2; ++h)
#pragma unroll
                for (int i = 0; i < 2; ++i) uN[h][i] = has_next ? ((ui == 0 ? S.a_off(nxt, h * HALF + RAn[i]) : S.a_off_pf(nxt, h * HALF + RAn[i], (ui + 1) & 1)) + cAn[i]) : uC[h][i];
            if (has2) S.prefetch(nx2, ui & 1, wid, lane);
        }
#else
#pragma unroll
        for (int h = 0; h < 2; ++h)
#pragma unroll
            for (int i = 0; i < 2; ++i) uN[h][i] = has_next ? (S.a_off(nxt, h * HALF + RA[i]) + cA2[i]) : uC[h][i];
#endif
#pragma nounroll
        for (int t = 0; t < nt; t += 2) {
            const bool last = (t == nt - 2);
            const size_t ka1 = (size_t)(t + 1) * kstep;
            const size_t ka2 = last ? (size_t)0 : (size_t)(t + 2) * kstep, ka3 = ka2 + kstep;
            const char* b2 = last ? nB : cB + (size_t)(t + 2) * kstep; const char* b3 = b2 + kstep;
#if GEMM_TOKPF == 1
            if (last) {
                if (has_next) S.a_ready(nxt);
#pragma unroll
                for (int h = 0; h < 2; ++h)
#pragma unroll
                    for (int i = 0; i < 2; ++i) uN[h][i] = has_next ? (S.a_off_pf(nxt, h * HALF + RA[i], (ui + 1) & 1) + cA2[i]) : uC[h][i];
            }
#endif
            PG8_LDB(B0, 0, 0); PG8_LDB(B1, 0, 1); PG8_SCHED; PG8_LDA(At, 0, 0); PG8_STAGE_A(PG8_SA(1, 1), ka1, uC[1]);
            PG8_WAIT_V(8); PG8_WAIT_L(0); PG8_BAR; PG8_MMA(0, 0, At, B0); PG8_MMA(0, 1, At, B1); PG8_BAR; PG8_SCHED;
            PG8_LDA(At, 0, 1); PG8_STAGE_B(PG8_SB(0, 0), b2); PG8_STAGE_B(PG8_SB(0, 1), b2 + hstep); PG8_STAGE_A2(PG8_SA(0, 0), ka2, 0);
            PG8_WAIT_V(8); PG8_WAIT_L(0); PG8_BAR; PG8_MMA(1, 0, At, B0); PG8_MMA(1, 1, At, B1); PG8_BAR; PG8_SCHED;
            PG8_LDB(B0, 1, 0); PG8_LDB(B1, 1, 1); PG8_SCHED; PG8_LDA(At, 1, 0); PG8_STAGE_A2(PG8_SA(0, 1), ka2, 1);
            PG8_WAIT_V(8); PG8_WAIT_L(0); PG8_BAR; PG8_MMA(0, 0, At, B0); PG8_MMA(0, 1, At, B1); PG8_BAR; PG8_SCHED;
            PG8_LDA(At, 1, 1); PG8_STAGE_B(PG8_SB(1, 0), b3); PG8_STAGE_B(PG8_SB(1, 1), b3 + hstep); PG8_STAGE_A2(PG8_SA(1, 0), ka3, 0);
            PG8_WAIT_V(8); PG8_WAIT_L(0); PG8_BAR; PG8_MMA(1, 0, At, B0); PG8_MMA(1, 1, At, B1); PG8_BAR; PG8_SCHED;
        }
        if (has_next) E.prefetch(lds, nxt, (ui + 1) & 1, wid);
        if constexpr (ALIGN_EPI) { if (wr == 0) PG8_BAR; }
        E(lds, acc, cur, wr, wc, fr, fq, ui & 1); S.done(cur);
        if (!has_next) break;
#pragma unroll
        for (int a = 0; a < 2; ++a)
#pragma unroll
            for (int b = 0; b < 2; ++b)
#pragma unroll
                for (int m = 0; m < 4; ++m)
#pragma unroll
                    for (int n = 0; n < 2; ++n) acc[a][b][m][n] = (f32x4){0.f, 0.f, 0.f, 0.f};
        cur = nxt; cB = nB; ++ui;
#pragma unroll
        for (int h = 0; h < 2; ++h)
#pragma unroll
            for (int i = 0; i < 2; ++i) uC[h][i] = uN[h][i];
        if constexpr (ALIGN_EPI) { if (wr == 1) PG8_BAR; }
    }
    PG8_WAIT_V(0);
    if constexpr (!ALIGN_EPI) { if (wr == 0) PG8_BAR; }
    PG8_BAR;
#undef PG8_SA
#undef PG8_SB
#undef PG8_STAGE_A
#undef PG8_STAGE_A2
#undef PG8_STAGE_B
#undef PG8_LDA
#undef PG8_LDB
#undef PG8_MMA
#undef PG8_WAIT_V
#undef PG8_WAIT_L
#undef PG8_BAR
#undef PG8_SCHED
}
}

struct Dst { bf16_t* O; int ldo, row0, col0, nvalid; float scale; bool headmap; };
template <class Route> struct EpiBf16R {
    static constexpr bool PERM = true;
    Route R;
    DI void prefetch(LAS unsigned char*, const pg8::Unit&, int, int) const {}
    DI void operator()(LAS unsigned char*, const f32x4 (&acc)[2][2][4][2], const pg8::Unit& u, int wr, int wc, int fr, int fq, int) const {
        const Dst d = R(u);
#pragma unroll
        for (int ai = 0; ai < 2; ++ai)
#pragma unroll
            for (int m = 0; m < 4; ++m) {
                bf16_t* rowp = d.O + (size_t)(d.row0 + ai * 128 + wr * 64 + m * 16 + fr) * d.ldo + d.col0;
#pragma unroll
                for (int bj = 0; bj < 2; ++bj) {
                    const int c = bj * 128 + wc * 32 + 8 * fq;
                    if (c < d.nvalid) {
                        const f32x4 v0 = acc[ai][bj][m][0] * d.scale, v1 = acc[ai][bj][m][1] * d.scale;
                        u32x4 w; w.x = cvtpk(v0[0], v0[1]); w.y = cvtpk(v0[2], v0[3]); w.z = cvtpk(v1[0], v1[1]); w.w = cvtpk(v1[2], v1[3]);
                        const int oc = d.headmap ? ((c >> 6) * 96 + (c & 63)) : c;
                        *(u32x4*)(rowp + oc) = w;
                    }
                }
            }
    }
};
struct EpiResF32 {
    static constexpr bool PERM = false;
    float* Y; const float* X;
    DI void prefetch(LAS unsigned char*, const pg8::Unit&, int, int) const {}
    DI void operator()(LAS unsigned char*, const f32x4 (&acc)[2][2][4][2], const pg8::Unit& u, int wr, int wc, int fr, int fq, int) const {
#pragma unroll
        for (int ai = 0; ai < 2; ++ai)
#pragma unroll
            for (int m = 0; m < 4; ++m) {
                const size_t ro = (size_t)(u.pm * 256 + ai * 128 + wr * 64 + m * 16 + fr) * DM + u.pn * 256 + wc * 32 + 4 * fq;
#pragma unroll
                for (int bj = 0; bj < 2; ++bj)
#pragma unroll
                    for (int n = 0; n < 2; ++n) {
                        const f32x4 xv = *(const f32x4*)(X + ro + bj * 128 + n * 16);
                        *(f32x4*)(Y + ro + bj * 128 + n * 16) = xv * ALPHA + acc[ai][bj][m][n];
                    }
            }
    }
};
struct EpiLat {
    static constexpr bool PERM = false;
    float* O; int ncol;
    DI void prefetch(LAS unsigned char*, const pg8::Unit&, int, int) const {}
    DI void operator()(LAS unsigned char*, const f32x4 (&acc)[2][2][4][2], const pg8::Unit& u, int wr, int wc, int fr, int fq, int) const {
#pragma unroll
        for (int ai = 0; ai < 2; ++ai)
#pragma unroll
            for (int m = 0; m < 4; ++m) {
                const int c0 = u.pn * 256 + wc * 32 + 4 * fq;
                float* rowp = O + (size_t)(u.pm * 256 + ai * 128 + wr * 64 + m * 16 + fr) * 1024;
#pragma unroll
                for (int bj = 0; bj < 2; ++bj)
#pragma unroll
                    for (int n = 0; n < 2; ++n) { const int c = c0 + bj * 128 + n * 16; if (c < ncol) *(f32x4*)(rowp + c) = acc[ai][bj][m][n]; }
            }
    }
};
struct EpiGU {
    static constexpr bool PERM = true;
    unsigned char* H; const float* bias; const float* sw; const float* sas; const LAS int* tstart;
    DI void prefetch(LAS unsigned char* lds, const pg8::Unit& u, int slot, int wid) const {
        if (wid < 1 || wid > 3) return;
        const int e = u.pn >> 3, ct = u.pn & 7, l = vlane();
        const float* src = wid == 1 ? bias + (size_t)e * 2048 + (l >> 5) * 1024 + ct * 128 + (l & 31) * 4
                         : wid == 2 ? sw + (size_t)e * 2048 + ct * 256 + l * 4
                                    : sas + (size_t)e * T + (u.pm - tstart[e]) * 256 + l * 4;
        __builtin_amdgcn_global_load_lds((const unsigned*)src, (LAS unsigned*)(lds + LDS_R1X + slot * 3072 + (wid - 1) * 1024), 16, 0, 0);
    }
    DI void operator()(LAS unsigned char* lds, const f32x4 (&acc)[2][2][4][2], const pg8::Unit& u, int wr, int wc, int fr, int fq, int slot) const {
        const int j = (u.pn & 7) * 128 + wc * 32 + 8 * fq;
        const LAS unsigned char* cb = lds + LDS_R1X + slot * 3072;
        const LAS f32x2* c2 = (const LAS f32x2*)(cb + (wc * 32 + 8 * fq) * 4);
        const LAS float* sa = (const LAS float*)(cb + 2048) + wr * 64 + fr;
        f32x2 bg[4], bu[4], sg_[4], su_[4];
#pragma unroll
        for (int q = 0; q < 4; ++q) { bg[q] = c2[q]; bu[q] = c2[64 + q]; sg_[q] = c2[128 + q]; su_[q] = c2[192 + q]; }
#pragma unroll
        for (int ai = 0; ai < 2; ++ai)
#pragma unroll
            for (int m = 0; m < 4; ++m) {
                const float st = sa[ai * 128 + m * 16];
                const f32x2 st2 = (f32x2){st, st};
                f32x2 h[4];
#pragma unroll
                for (int q = 0; q < 4; ++q) {
                    const f32x4 ag = acc[ai][0][m][q >> 1], au = acc[ai][1][m][q >> 1];
                    const f32x2 cg = (f32x2){(float)__float_as_int(ag[2 * (q & 1)]), (float)__float_as_int(ag[2 * (q & 1) + 1])};
                    const f32x2 cu = (f32x2){(float)__float_as_int(au[2 * (q & 1)]), (float)__float_as_int(au[2 * (q & 1) + 1])};
                    f32x2 g = cg * (st2 * sg_[q]) + bg[q], uu = cu * (st2 * su_[q]) + bu[q];
                    g[0] = fminf(g[0], 7.0f); g[1] = fminf(g[1], 7.0f);
                    uu[0] = fminf(fmaxf(uu[0], -7.0f), 7.0f); uu[1] = fminf(fmaxf(uu[1], -7.0f), 7.0f);
                    const f32x2 t = g * (f32x2){-1.702f * LOG2E, -1.702f * LOG2E};
                    f32x2 d = (f32x2){__builtin_amdgcn_exp2f(t[0]), __builtin_amdgcn_exp2f(t[1])} + (f32x2){1.0f, 1.0f};
                    d[0] = __builtin_amdgcn_rcpf(d[0]); d[1] = __builtin_amdgcn_rcpf(d[1]);
                    h[q] = (uu + (f32x2){1.0f, 1.0f}) * (g * d);
                }
                u32x2 w;
                w.x = (unsigned)__builtin_amdgcn_cvt_pk_fp8_f32(h[1][0], h[1][1], __builtin_amdgcn_cvt_pk_fp8_f32(h[0][0], h[0][1], 0, false), true);
                w.y = (unsigned)__builtin_amdgcn_cvt_pk_fp8_f32(h[3][0], h[3][1], __builtin_amdgcn_cvt_pk_fp8_f32(h[2][0], h[2][1], 0, false), true);
                *(u32x2*)(H + (size_t)(u.pm * 256 + ai * 128 + wr * 64 + m * 16 + fr) * 1024 + j) = w;
            }
    }
};
struct EpiDN {
    static constexpr bool PERM = true;
    bf16_t* Y; const float* bias; const float* sw;
    DI void prefetch(LAS unsigned char* lds, const pg8::Unit& u, int slot, int wid) const {
        if (wid < 1 || wid > 2) return;
        const int e = u.pn >> 2, ct = u.pn & 3, l = vlane();
        const float* src = (wid == 1 ? bias : sw) + (size_t)e * 1024 + ct * 256 + l * 4;
        __builtin_amdgcn_global_load_lds((const unsigned*)src, (LAS unsigned*)(lds + LDS_R1X + slot * 3072 + (wid - 1) * 1024), 16, 0, 0);
    }
    DI void operator()(LAS unsigned char* lds, const f32x4 (&acc)[2][2][4][2], const pg8::Unit& u, int wr, int wc, int fr, int fq, int slot) const {
        const int ct = u.pn & 3;
        const LAS unsigned char* cb = lds + LDS_R1X + slot * 3072;
#pragma unroll
        for (int bj = 0; bj < 2; ++bj) {
            const int cl = bj * 128 + wc * 32 + 8 * fq, c = ct * 256 + cl;
            const f32x4 b0 = *(const LAS f32x4*)(cb + cl * 4), b1 = *(const LAS f32x4*)(cb + cl * 4 + 16), s0 = *(const LAS f32x4*)(cb + 1024 + cl * 4), s1 = *(const LAS f32x4*)(cb + 1024 + cl * 4 + 16);
#pragma unroll
            for (int ai = 0; ai < 2; ++ai)
#pragma unroll
                for (int m = 0; m < 4; ++m) {
                    const f32x4 v0 = acc[ai][bj][m][0] * s0 + b0, v1 = acc[ai][bj][m][1] * s1 + b1;
                    u32x4 w; w.x = cvtpk(v0[0], v0[1]); w.y = cvtpk(v0[2], v0[3]); w.z = cvtpk(v1[0], v1[1]); w.w = cvtpk(v1[2], v1[3]);
                    *(u32x4*)(Y + (size_t)(u.pm * 256 + ai * 128 + wr * 64 + m * 16 + fr) * 1024 + c) = w;
                }
        }
    }
};
struct Frame {
    LAS unsigned char* lds; unsigned* ctl; unsigned char* ws; int tid, lane, wid; int G, bid;
};
struct MoeOrder {
    const LAS int* tstart; int sh; bool gather; const int* tokof; const LAS int* tokbuf; const LAS int* ulist; unsigned pitch;
    static DI void build(Frame& F, const LAS int* tstart, int nNt, LAS int* ulist) {
        __syncthreads();
        const int nwg = tstart[32] * nNt;
        if (F.tid == 0) ulist[0] = 0;
        __syncthreads();
        if (F.tid < 24) {
            const long L = (long)F.tid * F.G + F.bid;
            if (L < nwg) {
                int wgid = (int)L; { const int q = nwg / 8, r = nwg % 8, xcd = wgid % 8, off = wgid / 8; wgid = (xcd < r ? xcd * (q + 1) : r * (q + 1) + (xcd - r) * q) + off; }
                int e = 0;
                for (int k = 1; k < 32; ++k) if (tstart[k] * nNt <= wgid) e = k;
                const int rem = wgid - tstart[e] * nNt, nte = tstart[e + 1] - tstart[e];
                const int ct = rem / nte, rt = rem % nte;
                ulist[4 + 4 * F.tid] = tstart[e] + rt; ulist[5 + 4 * F.tid] = e * nNt + ct; ulist[6 + 4 * F.tid] = e; ulist[7 + 4 * F.tid] = rt;
                __hip_atomic_fetch_add(ulist, 1, __ATOMIC_RELAXED, __HIP_MEMORY_SCOPE_WORKGROUP);
            }
        }
        __syncthreads();
    }
    DI bool next(int i, pg8::Unit& u) const {
        if (i >= ulist[0]) return false;
        u.pm = ulist[4 + 4 * i]; u.pn = ulist[5 + 4 * i]; return true;
    }
    DI unsigned a_off(const pg8::Unit& u, int r) const {
        if (!gather) return (unsigned)(u.pm * 256 + r) * pitch;
        const int e = u.pn >> sh, idx = (u.pm - tstart[e]) * 256 + r;
        const int t = idx < tstart[80 + e] ? tokof[(size_t)e * T + idx] : 0;
        return (unsigned)t * pitch;
    }
    DI void prefetch(const pg8::Unit& u, int slot, int wid, int lane) const {
        if (gather && wid == 0) {
            const int e = u.pn >> sh, rt = u.pm - tstart[e];
            __builtin_amdgcn_global_load_lds((const unsigned*)(tokof + (size_t)e * T + rt * 256 + vlane() * 4), (LAS unsigned*)((LAS unsigned char*)tokbuf + slot * 1024), 16, 0, 0);
        }
    }
    DI unsigned a_off_pf(const pg8::Unit& u, int r, int slot) const {
        if (!gather) return (unsigned)(u.pm * 256 + r) * pitch;
        const int e = u.pn >> sh, idx = (u.pm - tstart[e]) * 256 + r;
        const int t = idx < tstart[80 + e] ? tokbuf[slot * 256 + r] : 0;
        return (unsigned)t * pitch;
    }
    DI void a_ready(const pg8::Unit&) const {}
    DI void done(const pg8::Unit&) const {}
};

DI int crow(int r, int hi) { return (r & 3) + 8 * (r >> 2) + 4 * hi; }
template <int DK, bool FOX, bool ROPEQ>
DI void attn_unit(LAS unsigned char* lds, const bf16_t* Q, int ldq, const bf16_t* Kp, int ldk, const bf16_t* Vt, int ldv,
                  const float* cum, bf16_t* O, int ldo, int q0, int ntiles, bool causal, const int* pos, const int wid, const float* kn2 = nullptr) {
    constexpr int PK = DK * 2 + 16, KBYTES = 64 * PK, VBYTES = 64 * 136, BUF = KBYTES + VBYTES + 256, KCH = DK / 8, NS = DK / 16;
    const int lane = vlane(), tid = wid * 64 + lane, r32 = lane & 31, hi = lane >> 5;
    const int qw0 = q0 + wid * 32, qrow = qw0 + r32;
    bf16x8 qf[NS];
#pragma unroll
    for (int s = 0; s < NS; ++s) qf[s] = *(const bf16x8*)(Q + (size_t)qrow * ldq + 16 * s + 8 * hi);
    if constexpr (ROPEQ) {
        const float p = (float)pos[qrow];
#pragma unroll
        for (int j = 0; j < 8; ++j) {
            const int i = 8 * hi + j;
            const float inv = exp2f(-(float)i * (13.287712379549449f / 16.0f));
            float sn, cs; sincos_cw(p * inv, sn, cs);
            const float x1 = bf2f((unsigned short)qf[4][j]), x2 = bf2f((unsigned short)qf[5][j]);
            const float o1 = x1 * cs - x2 * sn, o2 = x1 * sn + x2 * cs;
            qf[4][j] = (short)(cvtpk(o1, 0.f) & 0xffffu); qf[5][j] = (short)(cvtpk(o2, 0.f) & 0xffffu);
        }
    }
    const float cq = FOX ? cum[qrow] : 0.f;
    int jstart = 0; float prune_c = 0.f;
    if constexpr (FOX) {
        LAS float* red = (LAS float*)(lds + 2 * BUF);
        float ss = 0.f;
#pragma unroll
        for (int s = 0; s < NS; ++s)
#pragma unroll
            for (int j = 0; j < 8; ++j) { const float v = bf2f((unsigned short)qf[s][j]); ss += v * v; }
        ss += __shfl_xor(ss, 32);
        ss = wave_max(ss);
        float kk = 0.f;
        for (int j = tid; j < ntiles; j += NTHREADS) kk = fmaxf(kk, kn2[j]);
        kk = wave_max(kk);
        __syncthreads();
        if (lane == 0) { red[wid] = ss; red[8 + wid] = kk; }
        __syncthreads();
        float qm = red[0], km = red[8];
#pragma unroll
        for (int w = 1; w < 8; ++w) { qm = fmaxf(qm, red[w]); km = fmaxf(km, red[8 + w]); }
        prune_c = 2.0f * sqrtf(qm * km) * 1.01f + 65.0f;
        const float cq0 = cum[q0];
        int cand = ntiles;
        for (int j = tid; j < ntiles; j += NTHREADS) if (cq0 - cum[64 * j + 63] + prune_c >= 0.f) cand = min(cand, j);
#pragma unroll
        for (int o = 1; o < 64; o <<= 1) cand = min(cand, __shfl_xor(cand, o));
        __syncthreads();
        if (lane == 0) ((LAS int*)red)[16 + wid] = cand;
        __syncthreads();
        jstart = ((LAS int*)red)[16];
#pragma unroll
        for (int w = 1; w < 8; ++w) jstart = min(jstart, ((LAS int*)red)[16 + w]);
        jstart = min(jstart, ntiles - 4);
        __syncthreads();
    }
    const float cqw0 = FOX ? __shfl(cq, 0) : 0.f;
    f32x16 o0, o1;
#pragma unroll
    for (int r = 0; r < 16; ++r) { o0[r] = 0.f; o1[r] = 0.f; }
    float mrun = -1e30f, lrun = 0.f;
    const int kr0 = tid / KCH, kc0 = tid % KCH;
    const int kr1 = (tid + 512) / KCH, kc1 = (tid + 512) % KCH;
    const bool k2 = (DK == 96) && (tid < 256);
    const int vd = tid >> 3, vc = tid & 7;
    u32x4 kreg0, kreg1 = (u32x4){0, 0, 0, 0}, vreg; float creg = 0.f;
#define ATT_GLOAD(j) do { \
        kreg0 = *(const u32x4*)(Kp + (size_t)(64 * (j) + kr0) * ldk + kc0 * 8); \
        if (k2) kreg1 = *(const u32x4*)(Kp + (size_t)(64 * (j) + kr1) * ldk + kc1 * 8); \
        vreg = *(const u32x4*)(Vt + (size_t)vd * ldv + 64 * (j) + vc * 8); \
        if (FOX && tid < 64) creg = cum[64 * (j) + tid]; } while (0)
#define ATT_LWRITE(buf) do { LAS unsigned char* bb_ = lds + (buf) * BUF; \
        *(LAS u32x4*)(bb_ + kr0 * PK + kc0 * 16) = kreg0; \
        if (k2) *(LAS u32x4*)(bb_ + kr1 * PK + kc1 * 16) = kreg1; \
        *(LAS u32x2*)(bb_ + KBYTES + vd * 136 + vc * 16) = (u32x2){vreg.x, vreg.y}; \
        *(LAS u32x2*)(bb_ + KBYTES + vd * 136 + vc * 16 + 8) = (u32x2){vreg.z, vreg.w}; \
        if (FOX && tid < 64) *(LAS float*)(bb_ + KBYTES + VBYTES + tid * 4) = creg; } while (0)
    ATT_GLOAD(jstart); ATT_LWRITE(0); __syncthreads();
    for (int j = jstart; j < ntiles; ++j) {
        const int cur = (j - jstart) & 1;
        if (j + 1 < ntiles) ATT_GLOAD(j + 1);
        const LAS unsigned char* kb = lds + cur * BUF; const LAS unsigned char* vb = kb + KBYTES; const LAS unsigned char* cb = vb + VBYTES;
        bool active = !causal || (64 * j <= qw0 + 31);
        if constexpr (FOX) { if (cqw0 - *(const LAS float*)(cb + 63 * 4) + prune_c < 0.f) active = false; }
        if (active) {
            f32x16 sp0, sp1;
#pragma unroll
            for (int r = 0; r < 16; ++r) { sp0[r] = 0.f; sp1[r] = 0.f; }
#pragma unroll
            for (int s = 0; s < NS; ++s) {
                const bf16x8 k0 = *(const LAS bf16x8*)(kb + r32 * PK + 32 * s + 16 * hi);
                const bf16x8 k1 = *(const LAS bf16x8*)(kb + (32 + r32) * PK + 32 * s + 16 * hi);
                sp0 = __builtin_amdgcn_mfma_f32_32x32x16_bf16(k0, qf[s], sp0, 0, 0, 0);
                sp1 = __builtin_amdgcn_mfma_f32_32x32x16_bf16(k1, qf[s], sp1, 0, 0, 0);
            }
            __builtin_amdgcn_sched_barrier(0);
            if constexpr (FOX) {
#pragma unroll
                for (int g = 0; g < 4; ++g) {
                    const f32x4 c0 = *(const LAS f32x4*)(cb + (8 * g + 4 * hi) * 4);
                    const f32x4 c1 = *(const LAS f32x4*)(cb + (32 + 8 * g + 4 * hi) * 4);
#pragma unroll
                    for (int i = 0; i < 4; ++i) { sp0[4 * g + i] += cq - c0[i]; sp1[4 * g + i] += cq - c1[i]; }
                }
            }
            if (causal && (64 * j + 63 > qw0)) {
#pragma unroll
                for (int r = 0; r < 16; ++r) {
                    const int key = 64 * j + crow(r, hi);
                    if (key > qrow) sp0[r] = -1e30f;
                    if (key + 32 > qrow) sp1[r] = -1e30f;
                }
            }
            float mx = fmaxf(sp0[0], sp1[0]);
#pragma unroll
            for (int r = 1; r < 16; ++r) mx = fmaxf(mx, fmaxf(sp0[r], sp1[r]));
            mx = fmaxf(mx, __shfl_xor(mx, 32));
            const float mnew = fmaxf(mrun, mx);
            const float alpha = __builtin_amdgcn_exp2f(mrun - mnew);
            mrun = mnew;
            float ls = 0.f;
#pragma unroll
            for (int r = 0; r < 16; ++r) { sp0[r] = __builtin_amdgcn_exp2f(sp0[r] - mnew); sp1[r] = __builtin_amdgcn_exp2f(sp1[r] - mnew); ls += sp0[r] + sp1[r]; }
            lrun = lrun * alpha + ls;
#pragma unroll
            for (int r = 0; r < 16; ++r) { o0[r] *= alpha; o1[r] *= alpha; }
            __builtin_amdgcn_sched_barrier(0);
#pragma unroll
            for (int ks = 0; ks < 4; ++ks) {
                const int p = ks >> 1, s2 = ks & 1;
                u32x4 pw;
                if (p == 0) { pw.x = cvtpk(sp0[8 * s2 + 0], sp0[8 * s2 + 1]); pw.y = cvtpk(sp0[8 * s2 + 2], sp0[8 * s2 + 3]); pw.z = cvtpk(sp0[8 * s2 + 4], sp0[8 * s2 + 5]); pw.w = cvtpk(sp0[8 * s2 + 6], sp0[8 * s2 + 7]); }
                else        { pw.x = cvtpk(sp1[8 * s2 + 0], sp1[8 * s2 + 1]); pw.y = cvtpk(sp1[8 * s2 + 2], sp1[8 * s2 + 3]); pw.z = cvtpk(sp1[8 * s2 + 4], sp1[8 * s2 + 5]); pw.w = cvtpk(sp1[8 * s2 + 6], sp1[8 * s2 + 7]); }
                const bf16x8 pf = __builtin_bit_cast(bf16x8, pw);
                const int kbase = (32 * p + 16 * s2 + 4 * hi) * 2;
                {
                    const u32x2 lo = *(const LAS u32x2*)(vb + r32 * 136 + kbase), h2 = *(const LAS u32x2*)(vb + r32 * 136 + kbase + 16);
                    const bf16x8 vf = __builtin_bit_cast(bf16x8, (u32x4){lo.x, lo.y, h2.x, h2.y});
                    o0 = __builtin_amdgcn_mfma_f32_32x32x16_bf16(vf, pf, o0, 0, 0, 0);
                }
                {
                    const u32x2 lo = *(const LAS u32x2*)(vb + (32 + r32) * 136 + kbase), h2 = *(const LAS u32x2*)(vb + (32 + r32) * 136 + kbase + 16);
                    const bf16x8 vf = __builtin_bit_cast(bf16x8, (u32x4){lo.x, lo.y, h2.x, h2.y});
                    o1 = __builtin_amdgcn_mfma_f32_32x32x16_bf16(vf, pf, o1, 0, 0, 0);
                }
            }
        }
        if (j + 1 < ntiles) ATT_LWRITE(cur ^ 1);
        __syncthreads();
    }
#undef ATT_GLOAD
#undef ATT_LWRITE
    const float ltot = lrun + __shfl_xor(lrun, 32);
    const float inv = 1.0f / ltot;
#pragma unroll
    for (int g = 0; g < 4; ++g) {
        const int d0 = 8 * g + 4 * hi;
        u32x2 w0, w1;
        w0.x = cvtpk(o0[4 * g] * inv, o0[4 * g + 1] * inv); w0.y = cvtpk(o0[4 * g + 2] * inv, o0[4 * g + 3] * inv);
        w1.x = cvtpk(o1[4 * g] * inv, o1[4 * g + 1] * inv); w1.y = cvtpk(o1[4 * g + 2] * inv, o1[4 * g + 3] * inv);
        *(u32x2*)(O + (size_t)qrow * ldo + d0) = w0;
        *(u32x2*)(O + (size_t)qrow * ldo + 32 + d0) = w1;
    }
}


template <int DK, bool ROPEQ>
DI void attn_unit_pipe(LAS unsigned char* lds, const bf16_t* Q, int ldq, const bf16_t* Kp, int ldk, const bf16_t* Vt, int ldv,
                       bf16_t* O, int ldo, int q0, int ntiles, const int* pos, const int wid) {
    constexpr int PK = DK * 2 + 16, KBYTES = 64 * PK, VBYTES = 64 * 136, KCH = DK / 8, NS = DK / 16, VOFF = 2 * KBYTES;
    constexpr float THR = 6.0f;
    const int lane = vlane(), tid = wid * 64 + lane, r32 = lane & 31, hi = lane >> 5;
    const int qw0 = q0 + wid * 32, qrow = qw0 + r32;
    bf16x8 qf[NS];
#pragma unroll
    for (int s = 0; s < NS; ++s) qf[s] = *(const bf16x8*)(Q + (size_t)qrow * ldq + 16 * s + 8 * hi);
    if constexpr (ROPEQ) {
        const float p = (float)pos[qrow];
#pragma unroll
        for (int j = 0; j < 8; ++j) {
            const int i = 8 * hi + j;
            const float inv = exp2f(-(float)i * (13.287712379549449f / 16.0f));
            float sn, cs; sincos_cw(p * inv, sn, cs);
            const float x1 = bf2f((unsigned short)qf[NS - 2][j]), x2 = bf2f((unsigned short)qf[NS - 1][j]);
            const float o1 = x1 * cs - x2 * sn, o2 = x1 * sn + x2 * cs;
            qf[NS - 2][j] = (short)(cvtpk(o1, 0.f) & 0xffffu); qf[NS - 1][j] = (short)(cvtpk(o2, 0.f) & 0xffffu);
        }
    }
    const int kr0 = tid / KCH, kc0 = tid % KCH;
    const int kr1 = (tid + 512) / KCH, kc1 = (tid + 512) % KCH;
    const bool k2 = (DK == 96) && (tid < 256);
    const int vd = tid >> 3, vc = tid & 7;
    const int kfo = r32 * PK + 16 * hi;
    const int vfo = VOFF + r32 * 136 + 8 * hi;
    u32x4 kA0, kA1 = (u32x4){0, 0, 0, 0}, vA, kB0, kB1 = (u32x4){0, 0, 0, 0}, vB;
#define SBAR() __builtin_amdgcn_sched_barrier(0)
#define AP_LOADK(j, R0, R1) do { R0 = *(const u32x4*)(Kp + (size_t)(64 * (j) + kr0) * ldk + kc0 * 8); \
        if (k2) R1 = *(const u32x4*)(Kp + (size_t)(64 * (j) + kr1) * ldk + kc1 * 8); } while (0)
#define AP_LOADV(j, RV) do { RV = *(const u32x4*)(Vt + (size_t)vd * ldv + 64 * (j) + vc * 8); } while (0)
#define AP_WRITEK(buf, R0, R1) do { LAS unsigned char* bb_ = lds + (buf) * KBYTES; *(LAS u32x4*)(bb_ + kr0 * PK + kc0 * 16) = R0; \
        if (k2) *(LAS u32x4*)(bb_ + kr1 * PK + kc1 * 16) = R1; } while (0)
#define AP_WRITEV(buf, RV) do { LAS unsigned char* bb_ = lds + VOFF + (buf) * VBYTES; \
        *(LAS u32x2*)(bb_ + vd * 136 + vc * 16) = (u32x2){RV.x, RV.y}; *(LAS u32x2*)(bb_ + vd * 136 + vc * 16 + 8) = (u32x2){RV.z, RV.w}; } while (0)
#define AP_KF(dst0, dst1, kbuf, s) do { dst0 = *(const LAS bf16x8*)(lds + (kbuf) * KBYTES + kfo + 32 * (s)); dst1 = *(const LAS bf16x8*)(lds + (kbuf) * KBYTES + kfo + 32 * PK + 32 * (s)); } while (0)
#define AP_VF(dst0, dst1, vbuf, ks) do { const LAS unsigned char* p_ = lds + (vbuf) * VBYTES + vfo + (32 * ((ks) >> 1) + 16 * ((ks) & 1)) * 2; \
        const u32x2 a_ = *(const LAS u32x2*)(p_), b_ = *(const LAS u32x2*)(p_ + 16), c_ = *(const LAS u32x2*)(p_ + 32 * 136), d_ = *(const LAS u32x2*)(p_ + 32 * 136 + 16); \
        dst0 = __builtin_bit_cast(bf16x8, (u32x4){a_.x, a_.y, b_.x, b_.y}); dst1 = __builtin_bit_cast(bf16x8, (u32x4){c_.x, c_.y, d_.x, d_.y}); } while (0)
#define AP_MFMA(a, b, c) __builtin_amdgcn_mfma_f32_32x32x16_bf16(a, b, c, 0, 0, 0)
#define AP_MASK(S0, S1, t) do { _Pragma("unroll") for (int r_ = 0; r_ < 16; ++r_) { const int key_ = 64 * (t) + crow(r_, hi); \
        if (key_ > qrow) S0[r_] = -1e30f; if (key_ + 32 > qrow) S1[r_] = -1e30f; } } while (0)
#define AP_ROWMAX(S0, S1, out) do { float a_ = fmaxf(fmaxf(S0[0], S1[0]), S0[1]), b_ = fmaxf(fmaxf(S1[1], S0[2]), S1[2]); \
        _Pragma("unroll") for (int r_ = 3; r_ < 15; r_ += 2) { a_ = fmaxf(fmaxf(a_, S0[r_]), S1[r_]); b_ = fmaxf(fmaxf(b_, S0[r_ + 1]), S1[r_ + 1]); } \
        a_ = fmaxf(fmaxf(a_, S0[15]), S1[15]); a_ = fmaxf(a_, b_); out = fmaxf(a_, __shfl_xor(a_, 32)); } while (0)
    f32x16 o0, o1, pa0, pa1, sb0, sb1;
#pragma unroll
    for (int r = 0; r < 16; ++r) { o0[r] = 0.f; o1[r] = 0.f; }
    float mref = 0.f, lrun = 0.f;
    bf16x8 pf[4];
    bf16x8 fa0, fa1, fb0, fb1;
    AP_LOADK(0, kA0, kA1); AP_LOADV(0, vA); AP_WRITEK(0, kA0, kA1); AP_WRITEV(0, vA);
    AP_LOADK(1, kA0, kA1); AP_WRITEK(1, kA0, kA1);
    AP_LOADK(2, kA0, kA1); AP_LOADV(1, vA);
    __syncthreads();
#pragma unroll
    for (int r = 0; r < 16; ++r) { pa0[r] = 0.f; pa1[r] = 0.f; }
#pragma unroll
    for (int s = 0; s < NS; ++s) { AP_KF(fa0, fa1, 0, s); pa0 = AP_MFMA(fa0, qf[s], pa0); pa1 = AP_MFMA(fa1, qf[s], pa1); }
    if (ntiles == 4) AP_MASK(pa0, pa1, 0);
    { float mx; AP_ROWMAX(pa0, pa1, mx); mref = mx;
#pragma unroll
      for (int r = 0; r < 16; ++r) { pa0[r] = __builtin_amdgcn_exp2f(pa0[r] - mx); pa1[r] = __builtin_amdgcn_exp2f(pa1[r] - mx); } }
    __syncthreads();
    f32x16 negm;
#pragma unroll
    for (int r = 0; r < 16; ++r) negm[r] = -mref;
    asm volatile("" : "+v"(negm));
#define AP_STEPA(s, X0, X1, Y0, Y1, VALU) do { if ((s) + 1 < NS) AP_KF(Y0, Y1, kb_, (s) + 1); else AP_VF(Y0, Y1, vb_, 0); \
        if ((s) == 0) { sb0 = AP_MFMA(X0, qf[s], negm); sb1 = AP_MFMA(X1, qf[s], negm); } else { sb0 = AP_MFMA(X0, qf[s], sb0); sb1 = AP_MFMA(X1, qf[s], sb1); } VALU; SBAR(); } while (0)
#define AP_PK(i, P, b) pw_[i] = (u32x4){cvtpk(P[b], P[b + 1]), cvtpk(P[b + 2], P[b + 3]), cvtpk(P[b + 4], P[b + 5]), cvtpk(P[b + 6], P[b + 7])}; \
        ls0_ = fadd_s(ls0_, fadd_s(fadd_s(P[b], P[b + 1]), fadd_s(P[b + 2], P[b + 3]))); ls1_ = fadd_s(ls1_, fadd_s(fadd_s(P[b + 4], P[b + 5]), fadd_s(P[b + 6], P[b + 7]))); asm volatile("" : "+v"(pw_[i]), "+v"(ls0_), "+v"(ls1_))
#define AP_EXP4(P, S, b) do { P[b] = __builtin_amdgcn_exp2f(S[b]); P[b + 1] = __builtin_amdgcn_exp2f(S[b + 1]); P[b + 2] = __builtin_amdgcn_exp2f(S[b + 2]); P[b + 3] = __builtin_amdgcn_exp2f(S[b + 3]); asm volatile("" : "+v"(P)); } while (0)
#define AP_STEPB(ks, X0, X1, Y0, Y1, E0, E1) do { if ((ks) + 1 < 4) AP_VF(Y0, Y1, vb_, (ks) + 1); \
        o0 = AP_MFMA(X0, pf[ks], o0); E0; SBAR(); o1 = AP_MFMA(X1, pf[ks], o1); E1; SBAR(); } while (0)
#define AP_ITER(t, MASKED, WK0, WK1, WV, LK0, LK1, LV) do {     \
        const int kb_ = (t) & 1, vb_ = ((t) - 1) & 1; \
        if ((t) + 2 < ntiles) AP_LOADK((t) + 2, LK0, LK1); \
        if ((t) + 1 < ntiles) AP_LOADV((t) + 1, LV); \
        u32x4 pw_[4]; float ls0_ = 0.f, ls1_ = 0.f; \
        AP_KF(fa0, fa1, kb_, 0); SBAR(); \
        AP_STEPA(0, fa0, fa1, fb0, fb1, AP_PK(0, pa0, 0)); \
        AP_STEPA(1, fb0, fb1, fa0, fa1, AP_PK(1, pa0, 8)); \
        AP_STEPA(2, fa0, fa1, fb0, fb1, AP_PK(2, pa1, 0)); \
        AP_STEPA(3, fb0, fb1, fa0, fa1, AP_PK(3, pa1, 8)); \
        if (NS == 6) { AP_STEPA(4, fa0, fa1, fb0, fb1, (void)0); AP_STEPA(5, fb0, fb1, fa0, fa1, (void)0); } \
        lrun += ls0_ + ls1_; \
        pf[0] = __builtin_bit_cast(bf16x8, pw_[0]); pf[1] = __builtin_bit_cast(bf16x8, pw_[1]); pf[2] = __builtin_bit_cast(bf16x8, pw_[2]); pf[3] = __builtin_bit_cast(bf16x8, pw_[3]); \
        if ((t) >= ntiles - 4) AP_MASK(sb0, sb1, t); \
        float mx_; AP_ROWMAX(sb0, sb1, mx_); \
        float resc_ = 1.0f; bool do_resc_ = false; \
        if (__any(mx_ > THR)) { const float dl_ = fmaxf(mx_, 0.f); mref += dl_; \
            _Pragma("unroll") for (int r_ = 0; r_ < 16; ++r_) { sb0[r_] -= dl_; sb1[r_] -= dl_; negm[r_] = -mref; } \
            asm volatile("" : "+v"(negm)); \
            resc_ = __builtin_amdgcn_exp2f(-dl_); lrun *= resc_; do_resc_ = true; } \
        SBAR(); \
        AP_STEPB(0, fa0, fa1, fb0, fb1, AP_EXP4(pa0, sb0, 0), AP_EXP4(pa0, sb0, 4)); \
        AP_STEPB(1, fb0, fb1, fa0, fa1, AP_EXP4(pa0, sb0, 8), AP_EXP4(pa0, sb0, 12)); \
        AP_STEPB(2, fa0, fa1, fb0, fb1, AP_EXP4(pa1, sb1, 0), AP_EXP4(pa1, sb1, 4)); \
        AP_STEPB(3, fb0, fb1, fa0, fa1, AP_EXP4(pa1, sb1, 8), AP_EXP4(pa1, sb1, 12)); \
        if (do_resc_) { asm volatile("" ::: "memory"); _Pragma("unroll") for (int r_ = 0; r_ < 16; ++r_) { o0[r_] *= resc_; o1[r_] *= resc_; } asm volatile("" : "+v"(o0), "+v"(o1)); } \
        if ((t) + 1 < ntiles) AP_WRITEK(((t) + 1) & 1, WK0, WK1); \
        AP_WRITEV((t) & 1, WV); \
        __syncthreads(); } while (0)
    static_assert(NS == 4 || NS == 6, "head dim 64 or 96");
    if (wid >= 4) __builtin_amdgcn_s_setprio(1);
    int t = 1;
    for (; t + 1 < ntiles; t += 2) { AP_ITER(t, 1, kA0, kA1, vA, kB0, kB1, vB); AP_ITER(t + 1, 1, kB0, kB1, vB, kA0, kA1, vA); }
    AP_ITER(t, 1, kA0, kA1, vA, kB0, kB1, vB);
    {
        u32x4 pw_[4]; float ls0_ = 0.f, ls1_ = 0.f;
        AP_PK(0, pa0, 0); AP_PK(1, pa0, 8); AP_PK(2, pa1, 0); AP_PK(3, pa1, 8);
        lrun += ls0_ + ls1_;
        pf[0] = __builtin_bit_cast(bf16x8, pw_[0]); pf[1] = __builtin_bit_cast(bf16x8, pw_[1]); pf[2] = __builtin_bit_cast(bf16x8, pw_[2]); pf[3] = __builtin_bit_cast(bf16x8, pw_[3]);
        const int vb_ = (ntiles - 1) & 1;
#pragma unroll
        for (int ks = 0; ks < 4; ++ks) { AP_VF(fa0, fa1, vb_, ks); o0 = AP_MFMA(fa0, pf[ks], o0); o1 = AP_MFMA(fa1, pf[ks], o1); }
    }
    const float ltot = lrun + __shfl_xor(lrun, 32);
    const float inv = 1.0f / ltot;
#pragma unroll
    for (int g = 0; g < 4; ++g) {
        const int d0 = 8 * g + 4 * hi;
        u32x2 w0, w1;
        w0.x = cvtpk(o0[4 * g] * inv, o0[4 * g + 1] * inv); w0.y = cvtpk(o0[4 * g + 2] * inv, o0[4 * g + 3] * inv);
        w1.x = cvtpk(o1[4 * g] * inv, o1[4 * g + 1] * inv); w1.y = cvtpk(o1[4 * g + 2] * inv, o1[4 * g + 3] * inv);
        *(u32x2*)(O + (size_t)qrow * ldo + d0) = w0;
        *(u32x2*)(O + (size_t)qrow * ldo + 32 + d0) = w1;
    }
    __syncthreads();
#undef SBAR
#undef AP_LOADK
#undef AP_LOADV
#undef AP_WRITEK
#undef AP_WRITEV
#undef AP_KF
#undef AP_VF
#undef AP_MFMA
#undef AP_MASK
#undef AP_ROWMAX
#undef AP_STEPA
#undef AP_PK
#undef AP_EXP4
#undef AP_STEPB
#undef AP_ITER
}

#define XB_TMO      128
#define XB_XCNT(j)  (256  + 64 * (j))
#define XB_XSUB(j)  (1280 + 64 * (j))
#define XB_XGEN(j)  (2304 + 64 * (j))
#define XB_TOP      3328
#define XB_TOPGEN   3392
#define XCD_BAR_WORDS 3456
#define XB_SPIN_CAP (1u << 18)
DI unsigned xb_ld(unsigned* p) { return __hip_atomic_load(p, __ATOMIC_RELAXED, __HIP_MEMORY_SCOPE_AGENT); }
DI unsigned xb_add(unsigned* p, unsigned v) { return __hip_atomic_fetch_add(p, v, __ATOMIC_RELAXED, __HIP_MEMORY_SCOPE_AGENT); }
DI unsigned xb_xcc_id() { return (unsigned)__builtin_amdgcn_s_getreg((3 << 11) | 20) & 0xFu; }
#define XB_SPIN(cond, bar) do { unsigned _sp = 0; while (cond) { __builtin_amdgcn_s_sleep(1); \
    if ((++_sp & 255u) == 0u) { if (xb_ld(&(bar)[XB_TMO])) break; if (_sp > XB_SPIN_CAP) { atomicAdd(&(bar)[XB_TMO], 1u); break; } } } } while (0)
struct XcdBarrier { unsigned* bar; unsigned x; volatile LAS unsigned* st; int wid; };
DI XcdBarrier xcd_barrier_post(unsigned* bar, volatile LAS unsigned* st, int wid) {
    XcdBarrier b; b.bar = bar; b.x = xb_xcc_id(); b.st = st; b.wid = wid;
    if (wid == 0 && vlane() == 0) (void)xb_add(&bar[XB_XCNT(b.x)], 1u);
    return b;
}
DI void xcd_barrier_complete(unsigned* bar, unsigned x, unsigned& nloc, unsigned& nx) {
    const unsigned G = gridDim.x * gridDim.y * gridDim.z;
    unsigned sum, cnt, mine, sp = 0u;
    for (;;) {
        sum = 0u; cnt = 0u; mine = 0u;
#pragma unroll
        for (unsigned j = 0; j < 16; ++j) { const unsigned c = xb_ld(&bar[XB_XCNT(j)]); sum += c; cnt += (c > 0u) ? 1u : 0u; mine = (j == x) ? c : mine; }
        if (sum == G) break;
        __builtin_amdgcn_s_sleep(1);
        if ((++sp & 255u) == 0u) { if (xb_ld(&bar[XB_TMO])) break; if (sp > XB_SPIN_CAP) { atomicAdd(&bar[XB_TMO], 1u); break; } }
    }
    nloc = mine > 0u ? mine : 1u; nx = cnt > 0u ? cnt : 1u;
}
DI void xcd_barrier(const XcdBarrier& b) {
    asm volatile("s_waitcnt vmcnt(0)" ::: "memory");
    __syncthreads();
    if (b.wid == 0 && vlane() == 0) {
        unsigned* bar = b.bar;
        __builtin_amdgcn_s_waitcnt(0);
        unsigned nloc = b.st[0], nx = b.st[1];
        if (nloc == 0u) { xcd_barrier_complete(bar, b.x, nloc, nx); b.st[0] = nloc; b.st[1] = nx; }
        const unsigned old = xb_add(&bar[XB_XSUB(b.x)], 1u);
        const unsigned gen = old / nloc;
        if (old + 1u == (gen + 1u) * nloc) {
            __builtin_amdgcn_fence(__ATOMIC_RELEASE, "agent");
            asm volatile("s_waitcnt vmcnt(0)" ::: "memory");
            const unsigned og = xb_add(&bar[XB_TOP], 1u);
            const unsigned tg = og / nx;
            if (og + 1u == (tg + 1u) * nx) xb_add(&bar[XB_TOPGEN], 1u);
            else XB_SPIN(xb_ld(&bar[XB_TOPGEN]) == tg, bar);
            __builtin_amdgcn_fence(__ATOMIC_ACQUIRE, "agent");
            xb_add(&bar[XB_XGEN(b.x)], 1u);
            asm volatile("s_waitcnt vmcnt(0)" ::: "memory");
        } else {
            XB_SPIN(xb_ld(&bar[XB_XGEN(b.x)]) == gen, bar);
            __builtin_amdgcn_fence(__ATOMIC_ACQUIRE, "agent");
            asm volatile("s_waitcnt vmcnt(0)" ::: "memory");
        }
    }
    __syncthreads();
}

DI int next_unit(Frame& F, int widx) {
    LAS int* s = (LAS int*)(F.lds + LDS_CTL);
    __syncthreads();
    if (F.tid == 0) *s = (int)atomicAdd(F.ctl + CW_WORK + 64 * widx, 1u);
    __syncthreads();
    return *s;
}

DI void transpose_item(const float* W, int ldw, int srccol, int K, bf16_t* WT, int drow, LAS unsigned* scr, int k0, int lane, int nvalid) {
    const int n4 = lane & 15, kq = lane >> 4;
#pragma unroll 8
    for (int i = 0; i < 16; ++i) {
        const int kk = 4 * i + kq;
        f32x4 v = (f32x4){0.f, 0.f, 0.f, 0.f};
        if (4 * n4 < nvalid) v = *(const f32x4*)(W + (size_t)(k0 + kk) * ldw + srccol + 4 * n4);
        scr[kk * 33 + 2 * n4] = cvtpk(v[0], v[1]); scr[kk * 33 + 2 * n4 + 1] = cvtpk(v[2], v[3]);
    }
    LDS_WAIT(); asm volatile("" ::: "memory");
    const int c = lane & 7;
    const LAS unsigned short* s16 = (const LAS unsigned short*)scr;
#pragma unroll
    for (int j = 0; j < 8; ++j) {
        const int n = (lane >> 3) + 8 * j;
        const LAS unsigned short* sp = s16 + (8 * c) * 66 + n;
        u32x4 o;
        o.x = (unsigned)sp[0 * 66] | ((unsigned)sp[1 * 66] << 16); o.y = (unsigned)sp[2 * 66] | ((unsigned)sp[3 * 66] << 16);
        o.z = (unsigned)sp[4 * 66] | ((unsigned)sp[5 * 66] << 16); o.w = (unsigned)sp[6 * 66] | ((unsigned)sp[7 * 66] << 16);
        if (n < nvalid) *(u32x4*)(WT + (size_t)(drow + n) * K + k0 + 8 * c) = o;
    }
    LDS_WAIT(); asm volatile("" ::: "memory");
}
DI unsigned q8x4(float a, float b, float c, float d, float inv) {
    const float M = 12582912.0f;
    const unsigned ua = __float_as_uint(fmaf(a, inv, M)), ub = __float_as_uint(fmaf(b, inv, M)), uc = __float_as_uint(fmaf(c, inv, M)), ud = __float_as_uint(fmaf(d, inv, M));
    return __builtin_amdgcn_perm(ub, ua, 0x0c0c0400u) | __builtin_amdgcn_perm(ud, uc, 0x04000c0cu);
}
template <int QM>
DI void strip_item(const float* W, int ldw, int n0, unsigned char* dst, float* sc, LAS float* red, int tid) {
    const int c4 = tid & 15, kr = tid >> 4;
    const float* src = W + (size_t)(kr * 32) * ldw + n0 + 4 * c4;
    f32x4 v[32];
#pragma unroll
    for (int p = 0; p < 32; ++p) v[p] = *(const f32x4*)(src + (size_t)p * ldw);
    f32x4 m = (f32x4){0.f, 0.f, 0.f, 0.f};
#pragma unroll
    for (int p = 0; p < 32; ++p)
#pragma unroll
        for (int j = 0; j < 4; ++j) m[j] = fmaxf(m[j], fabsf(v[p][j]));
#pragma unroll
    for (int j = 0; j < 4; ++j) { m[j] = fmaxf(m[j], __shfl_xor(m[j], 16)); m[j] = fmaxf(m[j], __shfl_xor(m[j], 32)); }
    __syncthreads();
    if ((tid & 63) < 16) *(LAS f32x4*)(red + (tid >> 6) * 64 + 4 * c4) = m;
    __syncthreads();
#pragma unroll
    for (int w = 0; w < 8; ++w) { const f32x4 o = *(const LAS f32x4*)(red + w * 64 + 4 * c4);
#pragma unroll
        for (int j = 0; j < 4; ++j) m[j] = fmaxf(m[j], o[j]); }
    constexpr float QMAX = QM == 0 ? 127.0f : 448.0f;
    if (kr == 0) *(f32x4*)(sc + 4 * c4) = m * (1.0f / QMAX);
#pragma unroll
    for (int j = 0; j < 4; ++j) {
        const float inv = m[j] > 0.f ? QMAX / m[j] : 0.f;
        unsigned w[8];
#pragma unroll
        for (int q = 0; q < 8; ++q) {
            if constexpr (QM == 0) w[q] = q8x4(v[4 * q][j], v[4 * q + 1][j], v[4 * q + 2][j], v[4 * q + 3][j], inv);
            else w[q] = (unsigned)__builtin_amdgcn_cvt_pk_fp8_f32(v[4 * q + 2][j] * inv, v[4 * q + 3][j] * inv, __builtin_amdgcn_cvt_pk_fp8_f32(v[4 * q][j] * inv, v[4 * q + 1][j] * inv, 0, false), true);
        }
        u32x4* o = (u32x4*)(dst + (size_t)(4 * c4 + j) * 1024 + kr * 32);
        o[0] = (u32x4){w[0], w[1], w[2], w[3]}; o[1] = (u32x4){w[4], w[5], w[6], w[7]};
    }
}
constexpr int CONV_P1 = 2, CONV_A0 = 3, CONV_GU = 3, CONV_DN = 2, CONV_A1 = 6;
constexpr int MOE_S_GU = 32, MOE_S_DN = 16, MOE_STRIPS_PER_LAYER = 32 * (MOE_S_GU + MOE_S_DN);
DI void moe_convert_strip(unsigned char* ws, LAS float* red, int l, int r, int tid) {
    if (r < 32 * MOE_S_GU) {
        const int e = l * 32 + r / MOE_S_GU, nb = r % MOE_S_GU;
        const int jj = (nb & 15) * 64, drow = (jj >> 7) * 256 + (nb >> 4) * 128 + (jj & 127);
        strip_item<0>(KP->moe_w_gu + (size_t)e * 1024 * 2048, 2048, 64 * nb, ws + WS_W_GU + ((size_t)e * 2048 + drow) * 1024, (float*)(ws + WS_SGU) + (size_t)e * 2048 + drow, red, tid);
    } else {
        r -= 32 * MOE_S_GU;
        const int e = l * 32 + r / MOE_S_DN, nb = r % MOE_S_DN;
        strip_item<2>(KP->moe_w_dn + (size_t)e * 1024 * 1024, 1024, 64 * nb, ws + WS_W_DN + ((size_t)e * 1024 + 64 * nb) * 1024, (float*)(ws + WS_SDN) + (size_t)e * 1024 + 64 * nb, red, tid);
    }
}
constexpr int CW_CONVQ = CW_WORK + 64 * 8;
DI bool conv_pull(Frame& F, int l, int n) {
    LAS int* s = (LAS int*)(F.lds + LDS_CTL + 8);
    __syncthreads();
    if (F.tid == 0) *s = (int)atomicAdd(F.ctl + CW_CONVQ + 64 * l, (unsigned)n);
    __syncthreads();
    const int base = *s;
    for (int c = base; c < base + n && c < MOE_STRIPS_PER_LAYER; ++c) moe_convert_strip(F.ws, (LAS float*)F.lds, l, c, F.tid);
    __syncthreads();
    return base + n < MOE_STRIPS_PER_LAYER;
}
struct TrMat { const float* W; int ldw, col0, K, N; bf16_t* WT; int drow0, mode; };

DI void phase_prologue(Frame& F, const Params& P) {
    F.lane = vlane(); F.tid = F.wid * 64 + F.lane;
    LAS unsigned* scr = (LAS unsigned*)(F.lds + F.wid * 8448);
    const int gw = F.bid * 8 + F.wid, NGW = F.G * 8;
    unsigned char* ws = F.ws;
    TrMat mats[11];
    mats[0] = TrMat{KP->a_w_in, FOX_IN, 0, 1024, 1536, (bf16_t*)(ws + WS_W_AIN), 0, 0};
    mats[1] = TrMat{KP->a_w_in, FOX_IN, 2316, 1024, 256, (bf16_t*)(ws + WS_W_AIN), 1536, 0};
    mats[2] = TrMat{KP->a_w_in, FOX_IN, 1536, 1024, 768, (bf16_t*)(ws + WS_W_AIN), 1792, 0};
    mats[3] = TrMat{KP->a_w_out, 1024, 0, 1024, 1024, (bf16_t*)(ws + WS_W_AOUT), 0, 0};
    mats[4] = TrMat{KP->kv_w_dkv, 288, 0, 1024, 288, (bf16_t*)(ws + WS_W_BIN), 0, 0};
    mats[5] = TrMat{KP->b_w_in, 640, 0, 1024, 640, (bf16_t*)(ws + WS_W_BIN), 288, 0};
    mats[6] = TrMat{KP->b_w_uq, 1152, 0, 384, 1152, (bf16_t*)(ws + WS_W_UQ), 0, 0};
    mats[7] = TrMat{KP->kv_w_ukv, 1536, 0, 256, 1536, (bf16_t*)(ws + WS_W_UKV), 0, 1};
    mats[8] = TrMat{KP->b_w_out, 1024, 0, 1024, 1024, (bf16_t*)(ws + WS_W_BOUT), 0, 0};
    mats[9] = TrMat{KP->mem_w_kv, 512, 0, 1024, 512, (bf16_t*)(ws + WS_W_MKV), 0, 0};
    mats[10] = TrMat{KP->mem_w_kv + (size_t)1024 * 512, 512, 0, 1024, 512, (bf16_t*)(ws + WS_W_MKV) + (size_t)512 * 1024, 0, 0};
    int nsmall = 0;
#pragma unroll
    for (int i = 0; i < 11; ++i) nsmall += (mats[i].K / 64) * ((mats[i].N + 63) / 64);
    const int ntot = nsmall;
    for (int it = gw; it < ntot; it += NGW) {
        int r = it;
        if (r < nsmall) {
#pragma unroll
            for (int i = 0; i < 11; ++i) {
                const int nblk = (mats[i].N + 63) / 64, ni = (mats[i].K / 64) * nblk;
                if (r >= 0 && r < ni) {
                    const int kb = r / nblk, nb = r % nblk;
                    const int drow = mats[i].mode == 1 ? ((nb & 1) * 768 + (nb >> 1) * 64) : (mats[i].drow0 + 64 * nb);
                    transpose_item(mats[i].W, mats[i].ldw, mats[i].col0 + 64 * nb, mats[i].K, mats[i].WT, drow, scr, 64 * kb, F.lane, mats[i].N - 64 * nb);
                }
                r -= ni;
            }
            continue;
        }
    }
    __syncthreads();
    LAS float* wf = (LAS float*)F.lds;
    for (int i = F.tid; i < 1024 * 12; i += NTHREADS) { const int k = i / 12, h = i % 12; wf[i] = KP->a_w_in[(size_t)k * FOX_IN + 2304 + h]; }
    __syncthreads();
    float* logf = (float*)(ws + WS_LOGF);
    bf16_t* xb = (bf16_t*)(ws + WS_XB);
    for (int row = gw; row < T; row += NGW) {
        const f32x4* xr = (const f32x4*)(KP->x + (size_t)row * DM) + F.lane;
        f32x4 v[4];
#pragma unroll
        for (int j = 0; j < 4; ++j) v[j] = xr[64 * j];
        u32x2* o8 = (u32x2*)(xb + (size_t)row * DM) + F.lane;
#pragma unroll
        for (int j = 0; j < 4; ++j) o8[64 * j] = (u32x2){cvtpk(v[j][0], v[j][1]), cvtpk(v[j][2], v[j][3])};
        float part[12];
#pragma unroll
        for (int h = 0; h < 12; ++h) part[h] = 0.f;
#pragma unroll
        for (int j = 0; j < 4; ++j)
#pragma unroll
            for (int i = 0; i < 4; ++i) {
                const int k = 4 * F.lane + 256 * j + i;
                const LAS f32x4* wp = (const LAS f32x4*)(wf + k * 12);
                const f32x4 w0 = wp[0], w1 = wp[1], w2 = wp[2];
                const float xv = v[j][i];
                part[0] += xv * w0[0]; part[1] += xv * w0[1]; part[2] += xv * w0[2]; part[3] += xv * w0[3];
                part[4] += xv * w1[0]; part[5] += xv * w1[1]; part[6] += xv * w1[2]; part[7] += xv * w1[3];
                part[8] += xv * w2[0]; part[9] += xv * w2[1]; part[10] += xv * w2[2]; part[11] += xv * w2[3];
            }
        float mine = 0.f;
#pragma unroll
        for (int h = 0; h < 12; ++h) { const float s = wave_sum(part[h]); if (F.lane == h) mine = s; }
        if (F.lane < 12) {
            const float z = mine + KP->a_b_f[F.lane];
            const float ls = fminf(z, 0.f) - log1pf(expf(-fabsf(z)));
            const int b = row / SEQ, s = row % SEQ;
            logf[(size_t)(b * NH + F.lane) * SEQ + s] = ls;
        }
    }
    {
        float* wrt = (float*)(ws + WS_WRT);
        bf16_t* wrh = (bf16_t*)(ws + WS_WRH); bf16_t* wrl = (bf16_t*)(ws + WS_WRL);
        for (int i = F.bid * NTHREADS + F.tid; i < 2 * 1024 * 32; i += F.G * NTHREADS) { const int l = i >> 15, k = (i >> 5) & 1023, e = i & 31; const float w = KP->moe_w_r[i];
            const unsigned hb = cvtpk(w, 0.f) & 0xffffu; const float hf = __uint_as_float(hb << 16);
            wrt[(size_t)(l * 32 + e) * 1024 + k] = w; wrh[(size_t)(l * 32 + e) * 1024 + k] = (bf16_t)hb; wrl[(size_t)(l * 32 + e) * 1024 + k] = (bf16_t)(cvtpk(w - hf, 0.f) & 0xffffu); }
    }
    bf16_t* memb = (bf16_t*)(ws + WS_MEMB);
    for (int row = gw; row < NB * NMEM; row += NGW) {
        const f32x4* xr = (const f32x4*)(KP->mem + (size_t)row * DM) + F.lane;
        u32x2* o8 = (u32x2*)(memb + (size_t)row * DM) + F.lane;
#pragma unroll
        for (int j = 0; j < 4; ++j) { const f32x4 v = xr[64 * j]; o8[64 * j] = (u32x2){cvtpk(v[0], v[1]), cvtpk(v[2], v[3])}; }
    }
}

DI void scan_unit(Frame& F, int bh) {
    const float* src = (const float*)(F.ws + WS_LOGF) + (size_t)bh * SEQ;
    float* dst = (float*)(F.ws + WS_CUM) + (size_t)bh * SEQ;
    LAS float* wtot = (LAS float*)F.lds;
    float v[16];
#pragma unroll
    for (int j = 0; j < 4; ++j) { const f32x4 t = *(const f32x4*)(src + F.tid * 16 + 4 * j); v[4 * j] = t[0]; v[4 * j + 1] = t[1]; v[4 * j + 2] = t[2]; v[4 * j + 3] = t[3]; }
#pragma unroll
    for (int i = 1; i < 16; ++i) v[i] += v[i - 1];
    float tot = v[15];
    float inc = tot;
#pragma unroll
    for (int o = 1; o < 64; o <<= 1) { const float t = __shfl_up(inc, o); if (F.lane >= o) inc += t; }
    __syncthreads();
    if (F.lane == 63) wtot[F.wid] = inc;
    __syncthreads();
    float base = inc - tot;
    for (int w = 0; w < F.wid; ++w) base += wtot[w];
#pragma unroll
    for (int j = 0; j < 4; ++j) {
        f32x4 t; t[0] = (base + v[4 * j]) * LOG2E; t[1] = (base + v[4 * j + 1]) * LOG2E; t[2] = (base + v[4 * j + 2]) * LOG2E; t[3] = (base + v[4 * j + 3]) * LOG2E;
        *(f32x4*)(dst + F.tid * 16 + 4 * j) = t;
    }
    __syncthreads();
}

struct RouteQKM { unsigned char* ws; DI Dst operator()(const pg8::Unit& u) const {
    if (u.pn < 3) return Dst{(bf16_t*)(ws + WS_Q), 768, u.pm * 256, u.pn * 256, 256, 0.125f * LOG2E, false};
    if (u.pn < 6) return Dst{(bf16_t*)(ws + WS_K), 768, u.pm * 256, (u.pn - 3) * 256, 256, 1.0f, false};
    return Dst{(bf16_t*)(ws + WS_MQ), 256, u.pm * 256, 0, 256, 0.125f * LOG2E, false}; } };
struct RouteVT { unsigned char* ws; DI Dst operator()(const pg8::Unit& u) const {
    const int b = u.pn >> 5; return Dst{(bf16_t*)(ws + WS_VT) + (size_t)b * 768 * SEQ, SEQ, u.pm * 256, (u.pn & 31) * 256, 256, 1.0f, false}; } };
struct RoutePlain { bf16_t* O; int ldo; DI Dst operator()(const pg8::Unit& u) const { return Dst{O, ldo, u.pm * 256, u.pn * 256, 256, 1.0f, false}; } };
DI void phase_proj0(Frame& F, const Params& P) {
    F.lane = vlane(); F.tid = F.wid * 64 + F.lane;
    unsigned char* ws = F.ws;
    const bf16_t* xb = (const bf16_t*)(ws + WS_XB);
    const bf16_t* win = (const bf16_t*)(ws + WS_W_AIN);
    const bf16_t* memb = (const bf16_t*)(ws + WS_MEMB);
    {
        pg8::Gemm g{xb, win, 1024}; pg8::StaticOrder S; S.init(T, 1792, 1024, F.G, F.bid);
        EpiBf16R<RouteQKM> E{RouteQKM{ws}};
        pg8::gemm_phase<EpiBf16R<RouteQKM>, pg8::StaticOrder, true>(F.lds, g, S, E, F.wid);
    }
    {
        pg8::Gemm g{win + (size_t)1792 * 1024, xb, 1024}; pg8::StaticOrder S; S.init(768, T, 1024, F.G, (F.bid + 64) % F.G);
        EpiBf16R<RouteVT> E{RouteVT{ws}};
        pg8::gemm_phase<EpiBf16R<RouteVT>, pg8::StaticOrder, true>(F.lds, g, S, E, F.wid);
    }
    for (int l = 0; l < 2; ++l) {
        const bf16_t* wk = (const bf16_t*)(ws + WS_W_MKV) + (size_t)l * 512 * 1024;
        {
            pg8::Gemm g{memb, wk, 1024}; pg8::StaticOrder S; S.init(512, 256, 1024, F.G, (F.bid + F.G - (152 + 4 * l)) % F.G);
            EpiBf16R<RoutePlain> E{RoutePlain{(bf16_t*)(ws + WS_MK) + (size_t)l * 512 * 256, 256}};
            pg8::gemm_phase<EpiBf16R<RoutePlain>, pg8::StaticOrder, true>(F.lds, g, S, E, F.wid);
        }
        for (int b = 0; b < 2; ++b) {
            pg8::Gemm g{wk + (size_t)256 * 1024, memb + (size_t)b * 256 * 1024, 1024}; pg8::StaticOrder S; S.init(256, 256, 1024, F.G, (F.bid + F.G - (154 + 4 * l + b)) % F.G);
            EpiBf16R<RoutePlain> E{RoutePlain{(bf16_t*)(ws + WS_MVT) + (size_t)(l * 2 + b) * 256 * 256, 256}};
            pg8::gemm_phase<EpiBf16R<RoutePlain>, pg8::StaticOrder, true>(F.lds, g, S, E, F.wid);
        }
    }
    if (F.G == 256 && F.bid >= 128) conv_pull(F, 0, CONV_P1);
}


DI void phase_scan_knorm(Frame& F) {
    F.lane = vlane(); F.tid = F.wid * 64 + F.lane;
    unsigned char* ws = F.ws;
    if (F.bid < 24) scan_unit(F, F.bid);
    const bf16_t* K = (const bf16_t*)(ws + WS_K);
    float* kn2 = (float*)(ws + WS_KN2);
    const int gw = F.bid * 8 + F.wid, NGW = F.G * 8;
    for (int it = gw; it < 24 * 128; it += NGW) {
        const int bh = it >> 7, j = it & 127, b = bh / 12, h = bh % 12;
        const u32x4* kr = (const u32x4*)(K + (size_t)(b * SEQ + 64 * j + F.lane) * 768 + h * 64);
        float ss = 0.f;
#pragma unroll
        for (int c = 0; c < 8; ++c) {
            const u32x4 w = kr[c];
            const unsigned ww[4] = {w.x, w.y, w.z, w.w};
#pragma unroll
            for (int i = 0; i < 4; ++i) { const float a = __uint_as_float(ww[i] << 16), bb = __uint_as_float(ww[i] & 0xffff0000u); ss += a * a + bb * bb; }
        }
        ss = wave_max(ss);
        if (F.lane == 0) kn2[it] = ss;
    }
}

DI void mem_attn_unit(Frame& F, int l, int v) {
    unsigned char* ws = F.ws;
    const int qb = v >> 3, bm = v & 7, b = bm >> 2, mh = bm & 3;
    const bf16_t* Q = (const bf16_t*)(ws + WS_MQ) + (size_t)b * SEQ * 256 + mh * 64;
    const bf16_t* K = (const bf16_t*)(ws + WS_MK) + (size_t)l * 512 * 256 + (size_t)b * 256 * 256 + mh * 64;
    const bf16_t* Vt = (const bf16_t*)(ws + WS_MVT) + (size_t)(l * 2 + b) * 256 * 256 + (size_t)mh * 64 * 256;
    bf16_t* O = (bf16_t*)(ws + WS_MERGED) + (size_t)b * SEQ * 1024 + 768 + mh * 64;
    attn_unit<64, false, false>(F.lds, Q, 256, K, 256, Vt, 256, nullptr, O, 1024, qb * 256, 4, false, nullptr, F.wid);
}
DI void phase_attn0(Frame& F, const Params& P) {
    F.lane = vlane(); F.tid = F.wid * 64 + F.lane;
    unsigned char* ws = F.ws;
    constexpr int NU = 768 + 256 + 512;
    for (;;) {
        const int uu = next_unit(F, 0);
        if (uu >= NU) break;
        if (uu % 3 == 2) { conv_pull(F, 0, CONV_A0); continue; }
        const int u = 2 * (uu / 3) + uu % 3;
        if (u < 768) {
            const int qb = 31 - u / 24, bh = u % 24, b = bh / 12, h = bh % 12;
            const bf16_t* Q = (const bf16_t*)(ws + WS_Q) + (size_t)b * SEQ * 768 + h * 64;
            const bf16_t* K = (const bf16_t*)(ws + WS_K) + (size_t)b * SEQ * 768 + h * 64;
            const bf16_t* Vt = (const bf16_t*)(ws + WS_VT) + (size_t)(b * 768 + h * 64) * SEQ;
            const float* cum = (const float*)(ws + WS_CUM) + (size_t)bh * SEQ;
            bf16_t* O = (bf16_t*)(ws + WS_MERGED) + (size_t)b * SEQ * 1024 + h * 64;
            attn_unit<64, true, false>(F.lds, Q, 768, K, 768, Vt, SEQ, cum, O, 1024, qb * 256, 4 * (qb + 1), true, nullptr, F.wid, (const float*)(ws + WS_KN2) + bh * 128);
        } else mem_attn_unit(F, 0, u - 768);
    }
    while (conv_pull(F, 0, 16)) {}
}
DI void phase_attn1(Frame& F, const Params& P) {
    F.lane = vlane(); F.tid = F.wid * 64 + F.lane;
    unsigned char* ws = F.ws;
    constexpr int NCONV = 256, NU = 768 + 256 + NCONV;
    for (;;) {
        const int uu = next_unit(F, 1);
        if (uu >= NU) break;
        if (uu % 5 == 4) { conv_pull(F, 1, CONV_A1); continue; }
        const int u = 4 * (uu / 5) + uu % 5;
        if (u < 768) {
            const int qb = 31 - u / 24, bh = u % 24, b = bh / 12, h = bh % 12;
            const bf16_t* Q = (const bf16_t*)(ws + WS_Q) + (size_t)b * SEQ * 1152 + h * 96;
            const bf16_t* K = (const bf16_t*)(ws + WS_K) + (size_t)b * SEQ * 1152 + h * 96;
            const bf16_t* Vt = (const bf16_t*)(ws + WS_VT) + (size_t)(b * 768 + h * 64) * SEQ;
            bf16_t* O = (bf16_t*)(ws + WS_MERGED) + (size_t)b * SEQ * 1024 + h * 64;
            attn_unit_pipe<96, true>(F.lds, Q, 1152, K, 1152, Vt, SEQ, O, 1024, qb * 256, 4 * (qb + 1), KP->pos + (size_t)b * SEQ, F.wid);
        } else mem_attn_unit(F, 1, u - 768);
    }
    while (conv_pull(F, 1, 16)) {}
}

DI void phase_outproj(Frame& F, const float* X, const bf16_t* Wt) {
    F.lane = vlane(); F.tid = F.wid * 64 + F.lane;
    unsigned char* ws = F.ws;
    pg8::Gemm g{(const bf16_t*)(ws + WS_MERGED), Wt, 1024}; pg8::StaticOrder S; S.init(T, 1024, 1024, F.G, F.bid);
    EpiResF32 E{(float*)(ws + WS_Y), X};
    pg8::gemm_phase<EpiResF32, pg8::StaticOrder, false>(F.lds, g, S, E, F.wid);
}


DI void phase_ln_router(Frame& F, const Params& P, int l) {
    F.lane = vlane(); F.tid = F.wid * 64 + F.lane;
    unsigned char* ws = F.ws;
    LAS unsigned char* wH = F.lds;
    LAS unsigned char* wL = F.lds + 65536;
    LAS int* pairs = (LAS int*)(F.lds + LDS_CTL + 1024);
    LAS int* lcnt = (LAS int*)(F.lds + LDS_CTL + 3072); LAS int* gbase = lcnt + 32;
    LAS float* lg = (LAS float*)(F.lds + LDS_R1X + F.wid * 1280);
    LAS int* rec = (LAS int*)(F.lds + LDS_R1X + F.wid * 1280 + 1024);
    LAS float* stt = (LAS float*)(F.lds + LDS_R1X + 8 * 1280 + F.wid * 64);
    __syncthreads();
    {
        const u32x4* srcH = (const u32x4*)((const bf16_t*)(ws + WS_WRH) + (size_t)l * 32 * 1024);
        const u32x4* srcL = (const u32x4*)((const bf16_t*)(ws + WS_WRL) + (size_t)l * 32 * 1024);
        for (int i = F.tid; i < 32 * 128; i += NTHREADS) { const int e = i >> 7, c = i & 127; const int off = e * 2048 + ((c ^ (e & 7)) << 4);
            *(LAS u32x4*)(wH + off) = srcH[i]; *(LAS u32x4*)(wL + off) = srcL[i]; }
    }
    if (F.tid < 32) lcnt[F.tid] = 0;
    __syncthreads();
    const float* g = KP->ln_g + (size_t)(l * 2 + 0) * DM; const float* bt = KP->ln_b + (size_t)(l * 2 + 0) * DM;
    const float* br = KP->moe_b_r + l * 32;
    const float* Y = (const float*)(ws + WS_Y);
    unsigned char* X1Q = ws + WS_X1B;
    float* SAS = (float*)(ws + WS_SAS);
    int* PE = (int*)(ws + WS_PE); int* PPOS = (int*)(ws + WS_PPOS); float* GATE = (float*)(ws + WS_GATE); int* TOKOF = (int*)(ws + WS_TOKOF);
    unsigned* cnt = F.ctl + CW_CNT + l * 32 * 64;
    const int gw = F.bid * 8 + F.wid, NGW = F.G * 8;
    int it = 0;
    f32x4 vnx[4];
    if (gw < T) {
#pragma unroll
        for (int j = 0; j < 4; ++j) vnx[j] = *((const f32x4*)(Y + (size_t)gw * DM) + F.lane + 64 * j);
    }
    for (int row = gw; row < T; row += NGW, ++it) {
        f32x4 v[4]; float s = 0.f;
#pragma unroll
        for (int j = 0; j < 4; ++j) { v[j] = vnx[j]; s += (v[j][0] + v[j][1]) + (v[j][2] + v[j][3]); }
        if (row + NGW < T) {
#pragma unroll
            for (int j = 0; j < 4; ++j) vnx[j] = *((const f32x4*)(Y + (size_t)(row + NGW) * DM) + F.lane + 64 * j);
        }
        const float mean = wave_sum(s) * (1.f / DM); float s2 = 0.f;
#pragma unroll
        for (int j = 0; j < 4; ++j) { v[j] = v[j] - mean; s2 += (v[j][0] * v[j][0] + v[j][1] * v[j][1]) + (v[j][2] * v[j][2] + v[j][3] * v[j][3]); }
        const float rstd = 1.0f / sqrtf(wave_sum(s2) * (1.f / DM) + LN_EPS);
        float am = 0.f;
#pragma unroll
        for (int j = 0; j < 4; ++j) {
            const f32x4 gg = *((const f32x4*)g + F.lane + 64 * j), bb = *((const f32x4*)bt + F.lane + 64 * j);
            v[j] = v[j] * rstd * gg + bb;
            am = fmaxf(fmaxf(am, fmaxf(fabsf(v[j][0]), fabsf(v[j][1]))), fmaxf(fabsf(v[j][2]), fabsf(v[j][3])));
        }
        am = wave_max(am);
        const float qinv = am > 0.f ? 127.0f / am : 0.f;
#pragma unroll
        for (int j = 0; j < 4; ++j) *((unsigned*)(X1Q + (size_t)row * DM) + F.lane + 64 * j) = q8x4(v[j][0], v[j][1], v[j][2], v[j][3], qinv);
        if (F.lane == 0) { stt[2 * (it & 7)] = mean; stt[2 * (it & 7) + 1] = rstd; pairs[(F.wid * 16 + 8 + (it & 7)) * 4] = (int)__float_as_uint(am * (1.0f / 127.0f)); }
    }
    asm volatile("s_waitcnt lgkmcnt(0)" ::: "memory");
    {
        const int r16 = F.lane & 15, kg = F.lane >> 4;
        const int arow = gw + NGW * (r16 & 7);
        const float mean = stt[2 * (r16 & 7)], rstd = stt[2 * (r16 & 7) + 1];
        const float* yr = Y + (size_t)(arow < T ? arow : gw) * DM + 8 * kg;
        const float* gp = g + 8 * kg; const float* bp = bt + 8 * kg;
        f32x4 acc0 = (f32x4){0.f, 0.f, 0.f, 0.f}, acc1 = (f32x4){0.f, 0.f, 0.f, 0.f};
        const int e0 = r16, e1 = 16 + r16;
        const int b0off = e0 * 2048, b1off = e1 * 2048, sw = r16 & 7;
#pragma unroll 4
        for (int s2 = 0; s2 < 32; ++s2) {
            const f32x4 y0 = *(const f32x4*)(yr + 32 * s2), y1 = *(const f32x4*)(yr + 32 * s2 + 4);
            const f32x4 g0 = *(const f32x4*)(gp + 32 * s2), g1 = *(const f32x4*)(gp + 32 * s2 + 4);
            const f32x4 c0 = *(const f32x4*)(bp + 32 * s2), c1 = *(const f32x4*)(bp + 32 * s2 + 4);
            const f32x4 x0 = (y0 - mean) * rstd * g0 + c0, x1 = (y1 - mean) * rstd * g1 + c1;
            u32x4 ah, al;
            ah.x = cvtpk(x0[0], x0[1]); ah.y = cvtpk(x0[2], x0[3]); ah.z = cvtpk(x1[0], x1[1]); ah.w = cvtpk(x1[2], x1[3]);
            al.x = cvtpk(x0[0] - __uint_as_float(ah.x << 16), x0[1] - __uint_as_float(ah.x & 0xffff0000u)); al.y = cvtpk(x0[2] - __uint_as_float(ah.y << 16), x0[3] - __uint_as_float(ah.y & 0xffff0000u));
            al.z = cvtpk(x1[0] - __uint_as_float(ah.z << 16), x1[1] - __uint_as_float(ah.z & 0xffff0000u)); al.w = cvtpk(x1[2] - __uint_as_float(ah.w << 16), x1[3] - __uint_as_float(ah.w & 0xffff0000u));
            const bf16x8 Ah = __builtin_bit_cast(bf16x8, ah), Al = __builtin_bit_cast(bf16x8, al);
            const int co = (((4 * s2 + kg) ^ sw) << 4);
            const bf16x8 Bh0 = *(const LAS bf16x8*)(wH + b0off + co), Bl0 = *(const LAS bf16x8*)(wL + b0off + co);
            const bf16x8 Bh1 = *(const LAS bf16x8*)(wH + b1off + co), Bl1 = *(const LAS bf16x8*)(wL + b1off + co);
            acc0 = __builtin_amdgcn_mfma_f32_16x16x32_bf16(Ah, Bh0, acc0, 0, 0, 0); acc0 = __builtin_amdgcn_mfma_f32_16x16x32_bf16(Al, Bh0, acc0, 0, 0, 0); acc0 = __builtin_amdgcn_mfma_f32_16x16x32_bf16(Ah, Bl0, acc0, 0, 0, 0);
            acc1 = __builtin_amdgcn_mfma_f32_16x16x32_bf16(Ah, Bh1, acc1, 0, 0, 0); acc1 = __builtin_amdgcn_mfma_f32_16x16x32_bf16(Al, Bh1, acc1, 0, 0, 0); acc1 = __builtin_amdgcn_mfma_f32_16x16x32_bf16(Ah, Bl1, acc1, 0, 0, 0);
        }
        if (kg < 2) {
            const float bb0 = br[e0], bb1 = br[e1];
#pragma unroll
            for (int r = 0; r < 4; ++r) { lg[(4 * kg + r) * 32 + e0] = acc0[r] + bb0; lg[(4 * kg + r) * 32 + e1] = acc1[r] + bb1; }
        }
        asm volatile("s_waitcnt lgkmcnt(0)" ::: "memory");
        const int rr = F.lane >> 3, sub = F.lane & 7;
        f32x4 vv[8];
#pragma unroll
        for (int q = 0; q < 8; ++q) vv[q] = *(const LAS f32x4*)(lg + rr * 32 + 4 * q);
        const f32x4 mine = *(const LAS f32x4*)(lg + rr * 32 + 4 * sub);
        int rk[4] = {0, 0, 0, 0};
#pragma unroll
        for (int q = 0; q < 8; ++q)
#pragma unroll
            for (int i = 0; i < 4; ++i) {
                const float ve = vv[q][i]; const int ee = 4 * q + i;
#pragma unroll
                for (int c = 0; c < 4; ++c) rk[c] += (ve > mine[c] || (ve == mine[c] && ee < 4 * sub + c)) ? 1 : 0;
            }
#pragma unroll
        for (int c = 0; c < 4; ++c) if (rk[c] < 4) { rec[(rr * 4 + rk[c]) * 2] = 4 * sub + c; rec[(rr * 4 + rk[c]) * 2 + 1] = (int)__float_as_uint(mine[c]); }
        asm volatile("s_waitcnt lgkmcnt(0)" ::: "memory");
        const int te0 = rec[(rr * 4 + 0) * 2], te1 = rec[(rr * 4 + 1) * 2], te2 = rec[(rr * 4 + 2) * 2], te3 = rec[(rr * 4 + 3) * 2];
        const float tv0 = __uint_as_float((unsigned)rec[(rr * 4 + 0) * 2 + 1]), tv1 = __uint_as_float((unsigned)rec[(rr * 4 + 1) * 2 + 1]);
        const float tv2 = __uint_as_float((unsigned)rec[(rr * 4 + 2) * 2 + 1]), tv3 = __uint_as_float((unsigned)rec[(rr * 4 + 3) * 2 + 1]);
        const float e1_ = __expf(tv1 - tv0), e2_ = __expf(tv2 - tv0), e3_ = __expf(tv3 - tv0);
        const float rs = 1.0f / (1.0f + e1_ + e2_ + e3_);
        const int row = gw + NGW * rr;
        if (sub < 4 && row < T) {
            const int k = sub;
            const int e = k == 0 ? te0 : k == 1 ? te1 : k == 2 ? te2 : te3;
            const float gt = (k == 0 ? 1.0f : k == 1 ? e1_ : k == 2 ? e2_ : e3_) * rs;
            const int rnk = __hip_atomic_fetch_add(lcnt + e, 1, __ATOMIC_RELAXED, __HIP_MEMORY_SCOPE_WORKGROUP);
            PE[row * 4 + k] = e; GATE[row * 4 + k] = gt; pairs[(F.wid * 16 + rr) * 4 + k] = e | (rnk << 8);
        }
    }
    __syncthreads();
    if (F.tid < 32) { const int c = lcnt[F.tid]; gbase[F.tid] = c ? (int)atomicAdd(cnt + F.tid * 64, (unsigned)c) : 0; }
    __syncthreads();
    it = 0;
    for (int row = gw; row < T; row += NGW, ++it) {
        if (F.lane < 4) {
            const int pr = pairs[(F.wid * 16 + (it & 15)) * 4 + F.lane], e = pr & 255, p = gbase[e] + (pr >> 8);
            PPOS[row * 4 + F.lane] = p; TOKOF[(size_t)e * T + p] = row; SAS[(size_t)e * T + p] = __uint_as_float((unsigned)pairs[(F.wid * 16 + 8 + (it & 7)) * 4]);
        }
    }
}

DI void moe_tables(Frame& F, int l, LAS int* tstart, LAS int* soff) {
    __syncthreads();
    if (F.tid == 0) {
        int ts = 0;
        for (int e = 0; e < 32; ++e) {
            const int c = (int)__hip_atomic_load(F.ctl + CW_CNT + (l * 32 + e) * 64, __ATOMIC_RELAXED, __HIP_MEMORY_SCOPE_AGENT);
            tstart[e] = ts; soff[e] = ts * 256; tstart[80 + e] = c; ts += (c + 255) >> 8;
        }
        tstart[32] = ts; soff[32] = ts * 256;
    }
    __syncthreads();
}
DI void phase_moe_gu(Frame& F, const Params& P, int l) {
    F.lane = vlane(); F.tid = F.wid * 64 + F.lane;
    unsigned char* ws = F.ws;
    LAS int* tstart = (LAS int*)(F.lds + LDS_CTL + 64); LAS int* soff = tstart + 40;
    moe_tables(F, l, tstart, soff);
    pg8::Gemm g{(const bf16_t*)(ws + WS_X1B), (const bf16_t*)(ws + WS_W_GU + (size_t)l * 32 * 2048 * 1024), 512};
    LAS int* ulist = (LAS int*)(F.lds + LDS_CTL + 3328);
    MoeOrder::build(F, tstart, 8, ulist);
    MoeOrder S{tstart, 3, true, (const int*)(ws + WS_TOKOF), (const LAS int*)(F.lds + LDS_CTL + 1024), ulist, 1024u};
    EpiGU E{ws + WS_H, KP->moe_b_gu + (size_t)l * 32 * 2048, (const float*)(ws + WS_SGU) + (size_t)l * 32 * 2048, (const float*)(ws + WS_SAS), tstart};
    pg8::gemm_phase<EpiGU, MoeOrder, true, 1>(F.lds, g, S, E, F.wid);
    if (l == 0) { const int rem = (tstart[32] * 8) % F.G; if (rem && F.bid >= rem) conv_pull(F, 1, CONV_GU); }
}
DI void phase_moe_dn(Frame& F, const Params& P, int l) {
    F.lane = vlane(); F.tid = F.wid * 64 + F.lane;
    unsigned char* ws = F.ws;
    LAS int* tstart = (LAS int*)(F.lds + LDS_CTL + 64); LAS int* soff = tstart + 40;
    moe_tables(F, l, tstart, soff);
    pg8::Gemm g{(const bf16_t*)(ws + WS_H), (const bf16_t*)(ws + WS_W_DN + (size_t)l * 32 * 1024 * 1024), 512};
    LAS int* ulist = (LAS int*)(F.lds + LDS_CTL + 3328);
    MoeOrder::build(F, tstart, 4, ulist);
    MoeOrder S{tstart, 2, false, nullptr, nullptr, ulist, 1024u};
    EpiDN E{(bf16_t*)(ws + WS_YE), KP->moe_b_dn + (size_t)l * 32 * 1024, (const float*)(ws + WS_SDN) + (size_t)l * 32 * 1024};
    pg8::gemm_phase<EpiDN, MoeOrder, true, 3>(F.lds, g, S, E, F.wid);
    if (l == 0) { const int rem = (tstart[32] * 4) % F.G; if (rem && F.bid >= rem) conv_pull(F, 1, CONV_DN); }
}


DI void phase_combine(Frame& F, const Params& P, int l, float* outf, bf16_t* outb) {
    F.lane = vlane(); F.tid = F.wid * 64 + F.lane;
    unsigned char* ws = F.ws;
    LAS int* tstart = (LAS int*)(F.lds + LDS_CTL + 64); LAS int* soff = tstart + 40;
    moe_tables(F, l, tstart, soff);
    const float* g = KP->ln_g + (size_t)(l * 2 + 1) * DM; const float* bt = KP->ln_b + (size_t)(l * 2 + 1) * DM;
    const float* X1 = (const float*)(ws + WS_Y); const bf16_t* YE = (const bf16_t*)(ws + WS_YE);
    const float* g1 = KP->ln_g + (size_t)(l * 2 + 0) * DM; const float* b1 = KP->ln_b + (size_t)(l * 2 + 0) * DM;
    const int* PE = (const int*)(ws + WS_PE); const int* PPOS = (const int*)(ws + WS_PPOS); const float* GATE = (const float*)(ws + WS_GATE);
    const int gw = F.bid * 8 + F.wid, NGW = F.G * 8;
    i32x4 ie, ip; f32x4 ig;
    f32x4 xn[4]; u32x2 yn[4][4]; f32x4 gn;
#define CB_LOADIDX(r) do { ie = *(const i32x4*)(PE + (size_t)(r) * 4); ip = *(const i32x4*)(PPOS + (size_t)(r) * 4); ig = *(const f32x4*)(GATE + (size_t)(r) * 4); } while (0)
#define CB_LOADDATA(r) do { gn = ig; \
        _Pragma("unroll") for (int j = 0; j < 4; ++j) xn[j] = *((const f32x4*)(X1 + (size_t)(r) * DM) + F.lane + 64 * j); \
        _Pragma("unroll") for (int k = 0; k < 4; ++k) { const int slot = soff[ie[k]] + ip[k]; const u32x2* yr = (const u32x2*)(YE + (size_t)slot * 1024) + F.lane; \
            _Pragma("unroll") for (int j = 0; j < 4; ++j) yn[k][j] = yr[64 * j]; } } while (0)
    if (gw < T) { CB_LOADIDX(gw); CB_LOADDATA(gw); if (gw + NGW < T) CB_LOADIDX(gw + NGW); }
    for (int row = gw; row < T; row += NGW) {
        f32x4 v[4]; u32x2 yc[4][4]; f32x4 gc = gn;
        {
            float s0 = 0.f;
#pragma unroll
            for (int j = 0; j < 4; ++j) { v[j] = xn[j]; s0 += (v[j][0] + v[j][1]) + (v[j][2] + v[j][3]); }
            const float mean0 = wave_sum(s0) * (1.f / DM); float q0 = 0.f;
#pragma unroll
            for (int j = 0; j < 4; ++j) { v[j] = v[j] - mean0; q0 += (v[j][0] * v[j][0] + v[j][1] * v[j][1]) + (v[j][2] * v[j][2] + v[j][3] * v[j][3]); }
            const float rstd0 = 1.0f / sqrtf(wave_sum(q0) * (1.f / DM) + LN_EPS);
#pragma unroll
            for (int j = 0; j < 4; ++j) {
                const f32x4 gg = *((const f32x4*)g1 + F.lane + 64 * j), bb = *((const f32x4*)b1 + F.lane + 64 * j);
                v[j] = (v[j] * rstd0 * gg + bb) * ALPHA;
            }
        }
#pragma unroll
        for (int k = 0; k < 4; ++k)
#pragma unroll
            for (int j = 0; j < 4; ++j) yc[k][j] = yn[k][j];
        if (row + NGW < T) { CB_LOADDATA(row + NGW); if (row + 2 * NGW < T) CB_LOADIDX(row + 2 * NGW); }
#pragma unroll
        for (int k = 0; k < 4; ++k) {
            const float gt = gc[k];
#pragma unroll
            for (int j = 0; j < 4; ++j) {
                const u32x2 w = yc[k][j];
                v[j][0] += gt * __uint_as_float(w.x << 16); v[j][1] += gt * __uint_as_float(w.x & 0xffff0000u);
                v[j][2] += gt * __uint_as_float(w.y << 16); v[j][3] += gt * __uint_as_float(w.y & 0xffff0000u);
            }
        }
        float s = 0.f;
#pragma unroll
        for (int j = 0; j < 4; ++j) s += (v[j][0] + v[j][1]) + (v[j][2] + v[j][3]);
        const float mean = wave_sum(s) * (1.f / DM); float s2 = 0.f;
#pragma unroll
        for (int j = 0; j < 4; ++j) { v[j] = v[j] - mean; s2 += (v[j][0] * v[j][0] + v[j][1] * v[j][1]) + (v[j][2] * v[j][2] + v[j][3] * v[j][3]); }
        const float rstd = 1.0f / sqrtf(wave_sum(s2) * (1.f / DM) + LN_EPS);
#pragma unroll
        for (int j = 0; j < 4; ++j) {
            const f32x4 gg = *((const f32x4*)g + F.lane + 64 * j), bb = *((const f32x4*)bt + F.lane + 64 * j);
            v[j] = v[j] * rstd * gg + bb;
            *((f32x4*)(outf + (size_t)row * DM) + F.lane + 64 * j) = v[j];
            if (outb) *((u32x2*)(outb + (size_t)row * DM) + F.lane + 64 * j) = (u32x2){cvtpk(v[j][0], v[j][1]), cvtpk(v[j][2], v[j][3])};
        }
    }
#undef CB_LOADIDX
#undef CB_LOADDATA
}

DI void phase_lat(Frame& F) {
    F.lane = vlane(); F.tid = F.wid * 64 + F.lane;
    unsigned char* ws = F.ws;
    pg8::Gemm g{(const bf16_t*)(ws + WS_XB), (const bf16_t*)(ws + WS_W_BIN), 1024}; pg8::StaticOrder S; S.init(T, 1024, 1024, F.G, F.bid);
    EpiLat E{(float*)(ws + WS_LAT), 928};
    pg8::gemm_phase<EpiLat, pg8::StaticOrder, false>(F.lds, g, S, E, F.wid);
}

DI void phase_latrows(Frame& F, const Params& P) {
    F.lane = vlane(); F.tid = F.wid * 64 + F.lane;
    unsigned char* ws = F.ws;
    const float* LAT = (const float*)(ws + WS_LAT);
    bf16_t* CKV = (bf16_t*)(ws + WS_CKV); bf16_t* CQ = (bf16_t*)(ws + WS_CQ); bf16_t* MQ = (bf16_t*)(ws + WS_MQ); bf16_t* Kb = (bf16_t*)(ws + WS_K);
    const int gw = F.bid * 8 + F.wid, NGW = F.G * 8;
    for (int row = gw; row < T; row += NGW) {
        const float* lr = LAT + (size_t)row * 1024;
        {
            const f32x4 v = *((const f32x4*)lr + F.lane);
            const float ss = wave_sum((v[0] * v[0] + v[1] * v[1]) + (v[2] * v[2] + v[3] * v[3]));
            const float rs = 1.0f / sqrtf(ss * (1.f / 256.f) + RMS_EPS);
            const f32x4 gg = *((const f32x4*)KP->kv_g + F.lane);
            const f32x4 o = v * rs * gg;
            *((u32x2*)(CKV + (size_t)row * 256) + F.lane) = (u32x2){cvtpk(o[0], o[1]), cvtpk(o[2], o[3])};
        }
        {
            const f32x4 v0 = *((const f32x4*)(lr + 288) + F.lane);
            f32x4 v1 = (f32x4){0.f, 0.f, 0.f, 0.f};
            if (F.lane < 32) v1 = *((const f32x4*)(lr + 288 + 256) + F.lane);
            const float ss = wave_sum((v0[0] * v0[0] + v0[1] * v0[1]) + (v0[2] * v0[2] + v0[3] * v0[3]) + (v1[0] * v1[0] + v1[1] * v1[1]) + (v1[2] * v1[2] + v1[3] * v1[3]));
            const float rs = 1.0f / sqrtf(ss * (1.f / 384.f) + RMS_EPS);
            const f32x4 g0 = *((const f32x4*)KP->b_g_q + F.lane);
            const f32x4 o0 = v0 * rs * g0;
            *((u32x2*)(CQ + (size_t)row * 384) + F.lane) = (u32x2){cvtpk(o0[0], o0[1]), cvtpk(o0[2], o0[3])};
            if (F.lane < 32) {
                const f32x4 g1 = *((const f32x4*)(KP->b_g_q + 256) + F.lane);
                const f32x4 o1 = v1 * rs * g1;
                *((u32x2*)(CQ + (size_t)row * 384 + 256) + F.lane) = (u32x2){cvtpk(o1[0], o1[1]), cvtpk(o1[2], o1[3])};
            }
        }
        {
            const f32x4 v = *((const f32x4*)(lr + 672) + F.lane) * (0.125f * LOG2E);
            *((u32x2*)(MQ + (size_t)row * 256) + F.lane) = (u32x2){cvtpk(v[0], v[1]), cvtpk(v[2], v[3])};
        }
        if (F.lane < 16) {
            const int i = F.lane;
            const float p = (float)KP->pos[row];
            const float inv = exp2f(-(float)i * (13.287712379549449f / 16.0f));
            float sn, cs; sincos_cw(p * inv, sn, cs);
            const float x1 = lr[256 + i], x2 = lr[256 + 16 + i];
            const unsigned short o1 = (unsigned short)(cvtpk(x1 * cs - x2 * sn, 0.f) & 0xffffu), o2 = (unsigned short)(cvtpk(x1 * sn + x2 * cs, 0.f) & 0xffffu);
#pragma unroll
            for (int h = 0; h < NH; ++h) { Kb[(size_t)row * 1152 + h * 96 + 64 + i] = o1; Kb[(size_t)row * 1152 + h * 96 + 80 + i] = o2; }
        }
    }
}
#ifndef UPSEL
#define UPSEL 7
#endif
struct RouteK1 { unsigned char* ws; DI Dst operator()(const pg8::Unit& u) const { return Dst{(bf16_t*)(ws + WS_K), 1152, u.pm * 256, u.pn * 384, 256, 1.0f, true}; } };
struct RouteQ1 { unsigned char* ws; DI Dst operator()(const pg8::Unit& u) const { const int nv = 1152 - u.pn * 256; return Dst{(bf16_t*)(ws + WS_Q), 1152, u.pm * 256, u.pn * 256, nv < 256 ? nv : 256, 0.10206207261596577f * LOG2E, false}; } };
DI void phase_up1(Frame& F) {
    F.lane = vlane(); F.tid = F.wid * 64 + F.lane;
    unsigned char* ws = F.ws;
    const bf16_t* ckv = (const bf16_t*)(ws + WS_CKV); const bf16_t* cq = (const bf16_t*)(ws + WS_CQ);
    const bf16_t* wukv = (const bf16_t*)(ws + WS_W_UKV); const bf16_t* wuq = (const bf16_t*)(ws + WS_W_UQ);
#if (UPSEL & 1)
    {
        pg8::Gemm g{cq, wuq, 384}; pg8::StaticOrder S; S.init(T, 1280, 384, F.G, F.bid);
        EpiBf16R<RouteQ1> E{RouteQ1{ws}};
        pg8::gemm_phase<EpiBf16R<RouteQ1>, pg8::StaticOrder, true>(F.lds, g, S, E, F.wid);
    }
#endif
#if (UPSEL & 2)
    {
        pg8::Gemm g{ckv, wukv, 256}; pg8::StaticOrder S; S.init(T, 768, 256, F.G, F.G - 1 - F.bid);
        EpiBf16R<RouteK1> E{RouteK1{ws}};
        pg8::gemm_phase<EpiBf16R<RouteK1>, pg8::StaticOrder, true>(F.lds, g, S, E, F.wid);
    }
#endif
#if (UPSEL & 4)
    {
        pg8::Gemm g{wukv + (size_t)768 * 256, ckv, 256}; pg8::StaticOrder S; S.init(768, T, 256, F.G, F.G - 1 - F.bid);
        EpiBf16R<RouteVT> E{RouteVT{ws}};
        pg8::gemm_phase<EpiBf16R<RouteVT>, pg8::StaticOrder, true>(F.lds, g, S, E, F.wid);
    }
#endif
}


__global__ void __launch_bounds__(NTHREADS) mega_fwd(Params P) {
    extern __shared__ __attribute__((aligned(16))) unsigned char lds_raw[];
    Frame F;
    F.lds = (LAS unsigned char*)lds_raw; F.ws = KP->ws; F.ctl = (unsigned*)(KP->ws + WS_CTL);
    F.wid = __builtin_amdgcn_readfirstlane((int)threadIdx.x >> 6); F.lane = vlane(); F.tid = F.wid * 64 + F.lane; F.G = gridDim.x; F.bid = blockIdx.x;
    const int lo = KP->ph_lo, hi = KP->ph_hi;
    { volatile LAS unsigned* st0 = (volatile LAS unsigned*)(F.lds + LDS_CTL + 512); if (F.tid < 2) st0[F.tid] = 0u; }
    __syncthreads();
    XcdBarrier bar = xcd_barrier_post(F.ctl + CW_BAR, (volatile LAS unsigned*)(F.lds + LDS_CTL + 512), F.wid);
#ifndef PHMASK
#define PHMASK 0x1ffff
#endif
#define IN(k) (((PHMASK >> (k)) & 1) && lo <= (k) && (k) < hi)
#define SEAM(k) do { if (IN(k) && IN((k) + 1)) { if (KP->use_grid_sync) { if ((k) == 0) cg::this_grid().sync(); else xcd_barrier(bar); } } } while (0)
    unsigned char* ws = KP->ws;
    if (IN(0)) { phase_prologue(F, P);
    }
    SEAM(0);
    if (IN(1)) { phase_proj0(F, P);
        if (KP->use_grid_sync) xcd_barrier(bar); phase_scan_knorm(F); }
    SEAM(1);
    if (IN(2)) { phase_attn0(F, P);
    }
    SEAM(2);
    if (IN(3)) { phase_outproj(F, KP->x, (const bf16_t*)(ws + WS_W_AOUT));
    }
    SEAM(3);
    if (IN(4)) phase_ln_router(F, P, 0);
    SEAM(4);
    if (IN(5)) phase_moe_gu(F, P, 0);
    SEAM(5);
    if (IN(6)) phase_moe_dn(F, P, 0);
    SEAM(6);
    if (IN(7)) phase_combine(F, P, 0, (float*)(ws + WS_X2), (bf16_t*)(ws + WS_XB));
    SEAM(7);
    if (IN(8)) phase_lat(F);
    SEAM(8);
    if (IN(9)) phase_latrows(F, P);
    SEAM(9);
    if (IN(10)) { phase_up1(F);
    }
    SEAM(10);
    if (IN(11)) { phase_attn1(F, P);
    }
    SEAM(11);
    if (IN(12)) phase_outproj(F, (const float*)(ws + WS_X2), (const bf16_t*)(ws + WS_W_BOUT));
    SEAM(12);
    if (IN(13)) phase_ln_router(F, P, 1);
    SEAM(13);
    if (IN(14)) { phase_moe_gu(F, P, 1);
    }
    SEAM(14);
    if (IN(15)) { phase_moe_dn(F, P, 1);
    }
    SEAM(15);
    if (IN(16)) { phase_combine(F, P, 1, KP->out, nullptr);
    }
#undef IN
#undef SEAM
}

constexpr int N_PHASES = 17;
#ifndef MK_N_LAUNCHES
#define MK_N_LAUNCHES 1
#endif

extern "C" void kernel_launch(void* const* d_in, const int* in_sizes, int n_in, void* d_out, int out_size, void* d_ws, size_t ws_size, hipStream_t stream) {
    static int grid = 0;
    if (grid == 0) {
        if (n_in != 22 || ws_size < WS_END) { fprintf(stderr, "kernel_launch: need 22 inputs and %zu bytes of workspace (got %d, %zu)\n", (size_t)WS_END, n_in, ws_size); grid = -1; return; }
        int dev = 0, cus = 0, per_cu = 0;
        hipGetDevice(&dev);
        hipDeviceGetAttribute(&cus, hipDeviceAttributeMultiprocessorCount, dev);
        if (hipFuncSetAttribute((const void*)mega_fwd, hipFuncAttributeMaxDynamicSharedMemorySize, LDS_BYTES) != hipSuccess) fprintf(stderr, "kernel_launch: hipFuncSetAttribute failed\n");
        if (hipOccupancyMaxActiveBlocksPerMultiprocessor(&per_cu, (const void*)mega_fwd, NTHREADS, LDS_BYTES) != hipSuccess || per_cu < 1) { fprintf(stderr, "kernel_launch: occupancy query failed (%d)\n", per_cu); per_cu = 1; }
        (void)hipGetLastError();
        grid = cus * (per_cu > 1 ? 1 : per_cu);
        if (grid <= 0) grid = 256;
        if (grid != 256) fprintf(stderr, "kernel_launch: built for a 256-CU device (one workgroup per CU); got %d\n", grid);
    }
    if (grid < 0) return;
    hipMemsetAsync((char*)d_ws + WS_CTL, 0, CTL_BYTES, stream);
    Params p{};
    p.x = (const float*)d_in[0]; p.mem = (const float*)d_in[1]; p.pos = (const int*)d_in[2];
    p.a_w_in = (const float*)d_in[3]; p.a_b_f = (const float*)d_in[4]; p.a_w_out = (const float*)d_in[5];
    p.b_w_in = (const float*)d_in[6]; p.b_g_q = (const float*)d_in[7]; p.b_w_uq = (const float*)d_in[8]; p.b_w_out = (const float*)d_in[9];
    p.kv_w_dkv = (const float*)d_in[10]; p.kv_g = (const float*)d_in[11]; p.kv_w_ukv = (const float*)d_in[12]; p.mem_w_kv = (const float*)d_in[13];
    p.ln_g = (const float*)d_in[14]; p.ln_b = (const float*)d_in[15]; p.moe_w_r = (const float*)d_in[16]; p.moe_b_r = (const float*)d_in[17];
    p.moe_w_gu = (const float*)d_in[18]; p.moe_b_gu = (const float*)d_in[19]; p.moe_w_dn = (const float*)d_in[20]; p.moe_b_dn = (const float*)d_in[21];
    p.out = (float*)d_out; p.ws = (unsigned char*)d_ws;
    if (MK_N_LAUNCHES == 1) {
        p.ph_lo = 0; p.ph_hi = N_PHASES; p.use_grid_sync = 1;
        void* args[] = {&p};
        hipError_t e = hipLaunchCooperativeKernel((const void*)mega_fwd, dim3(grid), dim3(NTHREADS), args, LDS_BYTES, stream);
        if (e != hipSuccess) fprintf(stderr, "kernel_launch: cooperative launch failed: %s (grid %d)\n", hipGetErrorString(e), grid);
    } else {
        for (int ph = 0; ph < N_PHASES; ++ph) {
            p.ph_lo = ph; p.ph_hi = ph + 1; p.use_grid_sync = 0;
            hipLaunchKernelGGL(mega_fwd, dim3(grid), dim3(NTHREADS), LDS_BYTES, stream, p);
        }
    }
}
```

```cpp
#include <hip/hip_runtime.h>
#include <hip/hip_cooperative_groups.h>
#include <cstdio>
#include <cstdint>
#include <cmath>
namespace cg = cooperative_groups;

#define DI __device__ __forceinline__
#define LAS __attribute__((address_space(3)))
typedef unsigned short bf16_t;
typedef short bf16x8 __attribute__((ext_vector_type(8)));
typedef float f32x4 __attribute__((ext_vector_type(4)));
typedef float f32x2 __attribute__((ext_vector_type(2)));
typedef float f32x16 __attribute__((ext_vector_type(16)));
typedef unsigned u32x4 __attribute__((ext_vector_type(4)));
typedef unsigned u32x2 __attribute__((ext_vector_type(2)));
typedef int i32x4 __attribute__((ext_vector_type(4)));
typedef int i32x8 __attribute__((ext_vector_type(8)));
typedef long i64x4 __attribute__((ext_vector_type(4)));
typedef __bf16 bf16x2_t __attribute__((ext_vector_type(2)));

constexpr int NB = 2, SEQ = 8192, T = NB * SEQ, DM = 1024;
constexpr int NH = 12, NMEM = 256;
constexpr int FOX_IN = 2572;
constexpr int NE = 32;
constexpr float LOG2E = 1.4426950408889634f;
constexpr float ALPHA = 1.4142135623730951f;
constexpr float LN_EPS = 1e-5f, RMS_EPS = 1e-6f;
constexpr int NTHREADS = 512;
constexpr int LDS_BYTES = 131072 + 4096 + 8 * 1280 + 512;
constexpr int LDS_R1X = 131072 + 4096;
constexpr int LDS_CTL = 131072;
constexpr int SLOT_ROWS = 65536 + NE * 256;

constexpr size_t al256(size_t x) { return (x + 255) & ~(size_t)255; }
constexpr size_t WS_CTL = 0, CTL_BYTES = 65536;
constexpr size_t WS_W_AIN = al256(WS_CTL + CTL_BYTES);
constexpr size_t WS_W_AOUT = al256(WS_W_AIN + (size_t)2560 * 1024 * 2);
constexpr size_t WS_W_BIN = al256(WS_W_AOUT + (size_t)1024 * 1024 * 2);
constexpr size_t WS_W_UQ = al256(WS_W_BIN + (size_t)1024 * 1024 * 2);
constexpr size_t WS_W_UKV = al256(WS_W_UQ + (size_t)1280 * 384 * 2);
constexpr size_t WS_W_BOUT = al256(WS_W_UKV + (size_t)1536 * 256 * 2);
constexpr size_t WS_W_MKV = al256(WS_W_BOUT + (size_t)1024 * 1024 * 2);
constexpr size_t WS_W_GU = al256(WS_W_MKV + (size_t)2 * 512 * 1024 * 2);
constexpr size_t WS_W_DN = al256(WS_W_GU + (size_t)2 * 32 * 2048 * 1024 * 2);
constexpr size_t WS_XB = al256(WS_W_DN + (size_t)2 * 32 * 1024 * 1024 * 2);
constexpr size_t WS_MEMB = al256(WS_XB + (size_t)T * 1024 * 2);
constexpr size_t WS_LOGF = al256(WS_MEMB + (size_t)512 * 1024 * 2);
constexpr size_t WS_CUM = al256(WS_LOGF + (size_t)24 * 8192 * 4);
constexpr size_t WS_Q = al256(WS_CUM + (size_t)24 * 8192 * 4);
constexpr size_t WS_K = al256(WS_Q + (size_t)T * 1152 * 2);
constexpr size_t WS_VT = al256(WS_K + (size_t)T * 1152 * 2);
constexpr size_t WS_MQ = al256(WS_VT + (size_t)1536 * 8192 * 2);
constexpr size_t WS_MK = al256(WS_MQ + (size_t)T * 256 * 2);
constexpr size_t WS_MVT = al256(WS_MK + (size_t)2 * 512 * 256 * 2);
constexpr size_t WS_MERGED = al256(WS_MVT + (size_t)2 * 2 * 256 * 256 * 2);
constexpr size_t WS_Y = al256(WS_MERGED + (size_t)T * 1024 * 2);
constexpr size_t WS_X1 = al256(WS_Y + (size_t)T * 1024 * 4);
constexpr size_t WS_X1B = al256(WS_X1 + (size_t)T * 1024 * 4);
constexpr size_t WS_PE = al256(WS_X1B + (size_t)T * 1024 * 2);
constexpr size_t WS_PPOS = al256(WS_PE + (size_t)T * 4 * 4);
constexpr size_t WS_GATE = al256(WS_PPOS + (size_t)T * 4 * 4);
constexpr size_t WS_TOKOF = al256(WS_GATE + (size_t)T * 4 * 4);
constexpr size_t WS_H = al256(WS_TOKOF + (size_t)NE * T * 4);
constexpr size_t WS_YE = al256(WS_H + (size_t)SLOT_ROWS * 1024 * 2);
constexpr size_t WS_LAT = al256(WS_YE + (size_t)SLOT_ROWS * 1024 * 2);
constexpr size_t WS_CKV = al256(WS_LAT + (size_t)T * 1024 * 4);
constexpr size_t WS_CQ = al256(WS_CKV + (size_t)T * 256 * 2);
constexpr size_t WS_X2 = al256(WS_CQ + (size_t)T * 384 * 2);
constexpr size_t WS_KN2 = al256(WS_X2 + (size_t)T * 1024 * 4);
constexpr size_t WS_WRT = al256(WS_KN2 + (size_t)24 * 128 * 4);
constexpr size_t WS_WRH = al256(WS_WRT + (size_t)2 * 32 * 1024 * 4);
constexpr size_t WS_WRL = al256(WS_WRH + (size_t)2 * 32 * 1024 * 2);
constexpr size_t WS_SGU = al256(WS_WRL + (size_t)2 * 32 * 1024 * 2);
constexpr size_t WS_SDN = al256(WS_SGU + (size_t)2 * 32 * 2048 * 4);
constexpr size_t WS_SAS = al256(WS_SDN + (size_t)2 * 32 * 1024 * 4);
constexpr size_t WS_END = al256(WS_SAS + (size_t)NE * T * 4);
constexpr int CW_CNT = 8192;
constexpr int CW_WORK = 256;
constexpr int CW_BAR = 4096;

struct Params {
    const float* x; const float* mem; const int* pos;
    const float *a_w_in, *a_b_f, *a_w_out, *b_w_in, *b_g_q, *b_w_uq, *b_w_out, *kv_w_dkv, *kv_g, *kv_w_ukv, *mem_w_kv, *ln_g, *ln_b;
    const float *moe_w_r, *moe_b_r, *moe_w_gu, *moe_b_gu, *moe_w_dn, *moe_b_dn;
    float* out; unsigned char* ws; int ph_lo, ph_hi; int use_grid_sync, pad;
};

#define KP ((const __attribute__((address_space(4))) Params*)__builtin_amdgcn_kernarg_segment_ptr())
DI unsigned cvtpk(float lo, float hi) { f32x2 v = {lo, hi}; bf16x2_t b = __builtin_convertvector(v, bf16x2_t); return __builtin_bit_cast(unsigned, b); }
DI float bf2f(unsigned short b) { return __uint_as_float(((unsigned)b) << 16); }
DI float wave_sum(float v) {
#pragma unroll
    for (int o = 1; o < 64; o <<= 1) v += __shfl_xor(v, o);
    return v;
}
DI float wave_max(float v) {
#pragma unroll
    for (int o = 1; o < 64; o <<= 1) v = fmaxf(v, __shfl_xor(v, o));
    return v;
}

DI void sincos_cw(float x, float& sn, float& cs) {
    int j = (int)(x * 1.27323954473516f); j = (j + 1) & ~1;
    const float y = (float)j;
    const float r = ((x - y * 0.78515625f) - y * 2.4187564849853515625e-4f) - y * 3.77489497744594108e-8f;
    const float z = r * r;
    const float sp = ((-1.9515295891e-4f * z + 8.3321608736e-3f) * z - 1.6666654611e-1f) * z * r + r;
    const float cp = ((2.443315711809948e-5f * z - 1.388731625493765e-3f) * z + 4.166664568298827e-2f) * z * z - 0.5f * z + 1.0f;
    const int q = (j >> 1) & 3;
    const float s0 = (q & 1) ? cp : sp, c0 = (q & 1) ? sp : cp;
    sn = (q & 2) ? -s0 : s0;
    cs = ((q + 1) & 2) ? -c0 : c0;
}
DI float fadd_s(float a, float b) { float r; asm("v_add_f32_e32 %0, %1, %2" : "=v"(r) : "v"(a), "v"(b)); return r; }
DI int vlane() { int l; asm volatile("v_mbcnt_lo_u32_b32 %0, -1, 0\n\tv_mbcnt_hi_u32_b32 %0, -1, %0" : "=v"(l)); return l; }
#define LDS_WAIT() asm volatile("s_waitcnt lgkmcnt(0)" ::: "memory")
#define VM_WAIT() asm volatile("s_waitcnt vmcnt(0)" ::: "memory")

#ifndef GEMM_TOKPF
#define GEMM_TOKPF 2
#endif
namespace pg8 {
constexpr int BM = 256, BK = 64, HALF = 128, HTB = HALF * BK * 2, STAGE_BYTES = 8 * HTB, NXCD = 8, WGM = 8;
DI int lds_byte(int r, int c) { const int st = (r >> 4) * 2 + (c >> 5), rr = r & 15, cc = c & 31, ob = rr * 64 + cc * 2; return st * 1024 + (ob ^ (((ob >> 9) & 1) << 5)); }
DI void stage_rc(int b, int& R, int& C) { const int st = b / 1024, sb = b % 1024, swz = sb ^ (((sb >> 9) & 1) << 5); R = (st >> 1) * 16 + swz / 64; C = (st & 1) * 32 + (swz % 64) / 2; }
DI int perm32(int rho) { const int n = rho >> 4, i = rho & 15; return 8 * (i >> 2) + 4 * n + (i & 3); }
struct Unit { int pm, pn; };
struct Gemm { const bf16_t* A; const bf16_t* Bt; int K; };
struct StaticOrder {
    int nM, nN, nwg, G, c, K2;
    DI void init(int M, int N, int K, int G_, int c_) { nM = M / BM; nN = N / BM; nwg = nM * nN; G = G_; c = c_; K2 = K * 2; }
    DI bool next(int i, Unit& u) const {
        const long L = (long)i * G + c; if (L >= nwg) return false;
        int wgid = (int)L; { const int q = nwg / NXCD, r = nwg % NXCD, xcd = wgid % NXCD, off = wgid / NXCD; wgid = (xcd < r ? xcd * (q + 1) : r * (q + 1) + (xcd - r) * q) + off; }
        const int nig = WGM * nN, gid = wgid / nig, fm = gid * WGM, gsz = (nM - fm) < WGM ? (nM - fm) : WGM;
        u.pm = fm + ((wgid % nig) % gsz); u.pn = (wgid % nig) / gsz; return true;
    }
    DI unsigned a_off(const Unit& u, int r) const { return (unsigned)(u.pm * BM + r) * (unsigned)K2; }
    DI unsigned a_off_pf(const Unit& u, int r, int) const { return a_off(u, r); }
    DI void prefetch(const Unit&, int, int, int) const {}
    DI void a_ready(const Unit&) const {}
    DI void done(const Unit&) const {}
};

template <class Epi, class Sched, bool ALIGN_EPI, int MODE = 0>
DI void gemm_phase(LAS unsigned char* lds, const Gemm g, const Sched& S, const Epi& E, const int wid) {
    const int lane = vlane(), tid = wid * 64 + lane, wr = wid >> 2, wc = wid & 3, fr = lane & 15, fq = lane >> 4;
    const int K = g.K, nt = K / BK;
    int RA[2]; unsigned cA2[2], voffB[2];
#pragma unroll
    for (int i = 0; i < 2; ++i) { int R, C; stage_rc(tid * 16 + i * 8192, R, C); const int Rb = Epi::PERM ? ((R & ~31) + perm32(R & 31)) : R;
        RA[i] = R; cA2[i] = (unsigned)C * 2u; voffB[i] = (unsigned)(Rb * K + C) * 2u; }
    const size_t kstep = (size_t)(BK * 2);
    const size_t hstep = (size_t)HALF * K * 2;
    const size_t tstep = 2 * hstep;
    const unsigned ldsw = (unsigned)wid * 1024u;
    const int aoff = lds_byte(wr * 64 + fr, fq * 8), boff = lds_byte(wc * 32 + fr, fq * 8);
#define PG8_SA(b, h) (((b) * 2 + (h)) * HTB)
#define PG8_SB(b, h) ((4 + (b) * 2 + (h)) * HTB)
#define PG8_STAGE_B(bufoff, gbase) do { _Pragma("unroll") for (int _i = 0; _i < 2; ++_i) \
        __builtin_amdgcn_global_load_lds((const unsigned*)((const char*)(gbase) + voffB[_i]), (LAS unsigned*)(lds + (bufoff) + ldsw + _i * 8192), 16, 0, 0); } while (0)
#define PG8_STAGE_A(bufoff, kbytes, uo) do { _Pragma("unroll") for (int _i = 0; _i < 2; ++_i) \
        __builtin_amdgcn_global_load_lds((const unsigned*)((const char*)g.A + (kbytes) + (uo)[_i]), (LAS unsigned*)(lds + (bufoff) + ldsw + _i * 8192), 16, 0, 0); } while (0)
#define PG8_STAGE_A2(bufoff, kbytes, h) do { _Pragma("unroll") for (int _i = 0; _i < 2; ++_i) \
        __builtin_amdgcn_global_load_lds((const unsigned*)((const char*)g.A + (kbytes) + (last ? uN[h][_i] : uC[h][_i])), (LAS unsigned*)(lds + (bufoff) + ldsw + _i * 8192), 16, 0, 0); } while (0)
#define PG8_LDA(dst, b, h) do { _Pragma("unroll") for (int m = 0; m < (MODE == 2 ? 2 : 4); ++m) { dst[m].lo = *(const LAS i32x4*)(lds + PG8_SA(b, h) + aoff + m * 2048); dst[m].hi = *(const LAS i32x4*)(lds + PG8_SA(b, h) + aoff + m * 2048 + 1024); } } while (0)
#define PG8_LDB(dst, b, h) do { _Pragma("unroll") for (int n = 0; n < 2; ++n) { dst[n].lo = *(const LAS i32x4*)(lds + PG8_SB(b, h) + boff + n * 2048); dst[n].hi = *(const LAS i32x4*)(lds + PG8_SB(b, h) + boff + n * 2048 + 1024); } } while (0)
#define PG8_MMA(ai, bj, At, Bt) do { __builtin_amdgcn_s_setprio(1); _Pragma("unroll") for (int m = 0; m < 4; ++m) _Pragma("unroll") for (int n = 0; n < 2; ++n) { \
        if constexpr (MODE == 2) acc[ai][bj][m][n] = __builtin_amdgcn_mfma_scale_f32_16x16x128_f8f6f4(Bt[n], At[m], acc[ai][bj][m][n], 0, 0, 0, 0, 0, 0); \
        else if constexpr (MODE == 3) { const i64x4 b4_ = __builtin_bit_cast(i64x4, Bt[n]), a4_ = __builtin_bit_cast(i64x4, At[m]); _Pragma("unroll") for (int q = 0; q < 4; ++q) acc[ai][bj][m][n] = __builtin_amdgcn_mfma_f32_16x16x32_fp8_fp8(b4_[q], a4_[q], acc[ai][bj][m][n], 0, 0, 0); } \
        else if constexpr (MODE == 1) { acc[ai][bj][m][n] = __builtin_bit_cast(f32x4, __builtin_amdgcn_mfma_i32_16x16x64_i8(Bt[n].lo, At[m].lo, __builtin_bit_cast(i32x4, acc[ai][bj][m][n]), 0, 0, 0)); \
                                        acc[ai][bj][m][n] = __builtin_bit_cast(f32x4, __builtin_amdgcn_mfma_i32_16x16x64_i8(Bt[n].hi, At[m].hi, __builtin_bit_cast(i32x4, acc[ai][bj][m][n]), 0, 0, 0)); } \
        else { const i32x4 bl_ = Bt[n].lo, bh_ = Bt[n].hi, al_ = At[m].lo, ah_ = At[m].hi;     \
               acc[ai][bj][m][n] = __builtin_amdgcn_mfma_f32_16x16x32_bf16(__builtin_bit_cast(bf16x8, bl_), __builtin_bit_cast(bf16x8, al_), acc[ai][bj][m][n], 0, 0, 0); \
               acc[ai][bj][m][n] = __builtin_amdgcn_mfma_f32_16x16x32_bf16(__builtin_bit_cast(bf16x8, bh_), __builtin_bit_cast(bf16x8, ah_), acc[ai][bj][m][n], 0, 0, 0); } } __builtin_amdgcn_s_setprio(0); } while (0)
#define PG8_MFMA8(Bv, Av, C) C = __builtin_amdgcn_mfma_scale_f32_16x16x128_f8f6f4(Bv, Av, C, 0, 0, 0, 0, 0, 0)
#define PG8_MMAX(ai, b, h) do { if constexpr (MODE == 2) { __builtin_amdgcn_s_setprio(1); \
        _Pragma("unroll") for (int m = 0; m < 2; ++m) _Pragma("unroll") for (int n = 0; n < 2; ++n) { PG8_MFMA8(B0[n], At[m], acc[ai][0][m][n]); PG8_MFMA8(B1[n], At[m], acc[ai][1][m][n]); } \
        __builtin_amdgcn_sched_barrier(0); \
        _Pragma("unroll") for (int m = 0; m < 2; ++m) { At[m].lo = *(const LAS i32x4*)(lds + PG8_SA(b, h) + aoff + (m + 2) * 2048); At[m].hi = *(const LAS i32x4*)(lds + PG8_SA(b, h) + aoff + (m + 2) * 2048 + 1024); } \
        asm volatile("s_waitcnt lgkmcnt(0)" ::: "memory"); __builtin_amdgcn_sched_barrier(0); \
        _Pragma("unroll") for (int m = 0; m < 2; ++m) _Pragma("unroll") for (int n = 0; n < 2; ++n) { PG8_MFMA8(B0[n], At[m], acc[ai][0][m + 2][n]); PG8_MFMA8(B1[n], At[m], acc[ai][1][m + 2][n]); } \
        __builtin_amdgcn_s_setprio(0); } else { PG8_MMA(ai, 0, At, B0); PG8_MMA(ai, 1, At, B1); } } while (0)
#define PG8_WAIT_V(n) asm volatile("s_waitcnt vmcnt(" #n ")" ::: "memory")
#define PG8_WAIT_L(n) asm volatile("s_waitcnt lgkmcnt(" #n ")" ::: "memory")
#define PG8_BAR __builtin_amdgcn_s_barrier()
#define PG8_SCHED __builtin_amdgcn_sched_barrier(0)
    Unit cur, nxt; int ui = 0;
    if (!S.next(0, cur)) return;
    f32x4 acc[2][2][4][2];
#pragma unroll
    for (int a = 0; a < 2; ++a)
#pragma unroll
        for (int b = 0; b < 2; ++b)
#pragma unroll
            for (int m = 0; m < 4; ++m)
#pragma unroll
                for (int n = 0; n < 2; ++n) acc[a][b][m][n] = (f32x4){0.f, 0.f, 0.f, 0.f};
    i32x8 At[4], B0[2], B1[2];
    unsigned uC[2][2], uN[2][2];
#pragma unroll
    for (int h = 0; h < 2; ++h)
#pragma unroll
        for (int i = 0; i < 2; ++i) uC[h][i] = S.a_off(cur, h * HALF + RA[i]) + cA2[i];
    const char* cB = (const char*)g.Bt + (size_t)cur.pn * tstep;
    S.a_ready(cur); E.prefetch(lds, cur, 0, wid);
    PG8_STAGE_B(PG8_SB(0, 0), cB); PG8_STAGE_B(PG8_SB(0, 1), cB + hstep); PG8_STAGE_A(PG8_SA(0, 0), 0, uC[0]); PG8_STAGE_A(PG8_SA(0, 1), 0, uC[1]);
    if (wr == 1) PG8_BAR;
    PG8_WAIT_V(2); PG8_BAR;
    PG8_STAGE_B(PG8_SB(1, 0), cB + kstep); PG8_STAGE_A(PG8_SA(1, 0), kstep, uC[0]); PG8_STAGE_B(PG8_SB(1, 1), cB + hstep + kstep);
    PG8_WAIT_V(6); PG8_BAR;
    for (;;) {
        const bool has_next = S.next(ui + 1, nxt);
        const char* nB = has_next ? (const char*)g.Bt + (size_t)nxt.pn * tstep : cB;
#if GEMM_TOKPF == 1
        if (has_next) S.prefetch(nxt, (ui + 1) & 1, wid, lane);
#elif GEMM_TOKPF == 2
        {
            Unit nx2; const bool has2 = S.next(ui + 2, nx2);
            int RAn[2]; unsigned cAn[2];
            { const int tid2 = wid * 64 + vlane();
#pragma unroll
              for (int i = 0; i < 2; ++i) { int R, C; stage_rc(tid2 * 16 + i * 8192, R, C); RAn[i] = R; cAn[i] = (unsigned)C * 2u; } }
#pragma unroll
            for (int h = 0; h < 2; ++h)
#pragma unroll
                for (int i = 0; i < 2; ++i) uN[h][i] = has_next ? ((ui == 0 ? S.a_off(nxt, h * HALF + RAn[i]) : S.a_off_pf(nxt, h * HALF + RAn[i], (ui + 1) & 1)) + cAn[i]) : uC[h][i];
            if (has2) S.prefetch(nx2, ui & 1, wid, lane);
        }
#else
#pragma unroll
        for (int h = 0; h < 2; ++h)
#pragma unroll
            for (int i = 0; i < 2; ++i) uN[h][i] = has_next ? (S.a_off(nxt, h * HALF + RA[i]) + cA2[i]) : uC[h][i];
#endif
#pragma nounroll
        for (int t = 0; t < nt; t += 2) {
            const bool last = (t == nt - 2);
            const size_t ka1 = (size_t)(t + 1) * kstep;
            const size_t ka2 = last ? (size_t)0 : (size_t)(t + 2) * kstep, ka3 = ka2 + kstep;
            const char* b2 = last ? nB : cB + (size_t)(t + 2) * kstep; const char* b3 = b2 + kstep;
#if GEMM_TOKPF == 1
            if (last) {
                if (has_next) S.a_ready(nxt);
#pragma unroll
                for (int h = 0; h < 2; ++h)
#pragma unroll
                    for (int i = 0; i < 2; ++i) uN[h][i] = has_next ? (S.a_off_pf(nxt, h * HALF + RA[i], (ui + 1) & 1) + cA2[i]) : uC[h][i];
            }
#endif
            PG8_LDB(B0, 0, 0); PG8_LDB(B1, 0, 1); PG8_SCHED; PG8_LDA(At, 0, 0); PG8_STAGE_A(PG8_SA(1, 1), ka1, uC[1]);
            PG8_WAIT_V(8); PG8_WAIT_L(0); PG8_BAR; PG8_MMAX(0, 0, 0); PG8_BAR; PG8_SCHED;
            PG8_LDA(At, 0, 1); PG8_STAGE_B(PG8_SB(0, 0), b2); PG8_STAGE_B(PG8_SB(0, 1), b2 + hstep); PG8_STAGE_A2(PG8_SA(0, 0), ka2, 0);
            PG8_WAIT_V(8); PG8_WAIT_L(0); PG8_BAR; PG8_MMAX(1, 0, 1); PG8_BAR; PG8_SCHED;
            PG8_LDB(B0, 1, 0); PG8_LDB(B1, 1, 1); PG8_SCHED; PG8_LDA(At, 1, 0); PG8_STAGE_A2(PG8_SA(0, 1), ka2, 1);
            PG8_WAIT_V(8); PG8_WAIT_L(0); PG8_BAR; PG8_MMAX(0, 1, 0); PG8_BAR; PG8_SCHED;
            PG8_LDA(At, 1, 1); PG8_STAGE_B(PG8_SB(1, 0), b3); PG8_STAGE_B(PG8_SB(1, 1), b3 + hstep); PG8_STAGE_A2(PG8_SA(1, 0), ka3, 0);
            PG8_WAIT_V(8); PG8_WAIT_L(0); PG8_BAR; PG8_MMAX(1, 1, 1); PG8_BAR; PG8_SCHED;
        }
        if (has_next) E.prefetch(lds, nxt, (ui + 1) & 1, wid);
        if constexpr (ALIGN_EPI) { if (wr == 0) PG8_BAR; }
        E(lds, acc, cur, wr, wc, fr, fq, ui & 1); S.done(cur);
        if (!has_next) break;
#pragma unroll
        for (int a = 0; a < 2; ++a)
#pragma unroll
            for (int b = 0; b < 2; ++b)
#pragma unroll
                for (int m = 0; m < 4; ++m)
#pragma unroll
                    for (int n = 0; n < 2; ++n) acc[a][b][m][n] = (f32x4){0.f, 0.f, 0.f, 0.f};
        cur = nxt; cB = nB; ++ui;
#pragma unroll
        for (int h = 0; h < 2; ++h)
#pragma unroll
            for (int i = 0; i < 2; ++i) uC[h][i] = uN[h][i];
        if constexpr (ALIGN_EPI) { if (wr == 1) PG8_BAR; }
    }
    PG8_WAIT_V(0);
    if constexpr (!ALIGN_EPI) { if (wr == 0) PG8_BAR; }
    PG8_BAR;
#undef PG8_SA
#undef PG8_SB
#undef PG8_STAGE_A
#undef PG8_STAGE_A2
#undef PG8_STAGE_B
#undef PG8_LDA
#undef PG8_LDB
#undef PG8_MMA
#undef PG8_MMAX
#undef PG8_MFMA8
#undef PG8_WAIT_V
#undef PG8_WAIT_L
#undef PG8_BAR
#undef PG8_SCHED
}
}

struct Dst { bf16_t* O; int ldo, row0, col0, nvalid; float scale; bool headmap; };
template <class Route> struct EpiBf16R {
    static constexpr bool PERM = true;
    Route R;
    DI void prefetch(LAS unsigned char*, const pg8::Unit&, int, int) const {}
    DI void operator()(LAS unsigned char*, const f32x4 (&acc)[2][2][4][2], const pg8::Unit& u, int wr, int wc, int fr, int fq, int) const {
        const Dst d = R(u);
#pragma unroll
        for (int ai = 0; ai < 2; ++ai)
#pragma unroll
            for (int m = 0; m < 4; ++m) {
                bf16_t* rowp = d.O + (size_t)(d.row0 + ai * 128 + wr * 64 + m * 16 + fr) * d.ldo + d.col0;
#pragma unroll
                for (int bj = 0; bj < 2; ++bj) {
                    const int c = bj * 128 + wc * 32 + 8 * fq;
                    if (c < d.nvalid) {
                        const f32x4 v0 = acc[ai][bj][m][0] * d.scale, v1 = acc[ai][bj][m][1] * d.scale;
                        u32x4 w; w.x = cvtpk(v0[0], v0[1]); w.y = cvtpk(v0[2], v0[3]); w.z = cvtpk(v1[0], v1[1]); w.w = cvtpk(v1[2], v1[3]);
                        const int oc = d.headmap ? ((c >> 6) * 96 + (c & 63)) : c;
                        *(u32x4*)(rowp + oc) = w;
                    }
                }
            }
    }
};
struct EpiResF32 {
    static constexpr bool PERM = false;
    float* Y; const float* X;
    DI void prefetch(LAS unsigned char*, const pg8::Unit&, int, int) const {}
    DI void operator()(LAS unsigned char*, const f32x4 (&acc)[2][2][4][2], const pg8::Unit& u, int wr, int wc, int fr, int fq, int) const {
#pragma unroll
        for (int ai = 0; ai < 2; ++ai)
#pragma unroll
            for (int m = 0; m < 4; ++m) {
                const size_t ro = (size_t)(u.pm * 256 + ai * 128 + wr * 64 + m * 16 + fr) * DM + u.pn * 256 + wc * 32 + 4 * fq;
#pragma unroll
                for (int bj = 0; bj < 2; ++bj)
#pragma unroll
                    for (int n = 0; n < 2; ++n) {
                        const f32x4 xv = *(const f32x4*)(X + ro + bj * 128 + n * 16);
                        *(f32x4*)(Y + ro + bj * 128 + n * 16) = xv * ALPHA + acc[ai][bj][m][n];
                    }
            }
    }
};
struct EpiLat {
    static constexpr bool PERM = false;
    float* O; int ncol;
    DI void prefetch(LAS unsigned char*, const pg8::Unit&, int, int) const {}
    DI void operator()(LAS unsigned char*, const f32x4 (&acc)[2][2][4][2], const pg8::Unit& u, int wr, int wc, int fr, int fq, int) const {
#pragma unroll
        for (int ai = 0; ai < 2; ++ai)
#pragma unroll
            for (int m = 0; m < 4; ++m) {
                const int c0 = u.pn * 256 + wc * 32 + 4 * fq;
                float* rowp = O + (size_t)(u.pm * 256 + ai * 128 + wr * 64 + m * 16 + fr) * 1024;
#pragma unroll
                for (int bj = 0; bj < 2; ++bj)
#pragma unroll
                    for (int n = 0; n < 2; ++n) { const int c = c0 + bj * 128 + n * 16; if (c < ncol) *(f32x4*)(rowp + c) = acc[ai][bj][m][n]; }
            }
    }
};
struct EpiGU {
    static constexpr bool PERM = true;
    unsigned char* H; const float* bias; const float* sw; const float* sas; const LAS int* tstart;
    DI void prefetch(LAS unsigned char* lds, const pg8::Unit& u, int slot, int wid) const {
        if (wid < 1 || wid > 3) return;
        const int e = u.pn >> 3, ct = u.pn & 7, l = vlane();
        const float* src = wid == 1 ? bias + (size_t)e * 2048 + (l >> 5) * 1024 + ct * 128 + (l & 31) * 4
                         : wid == 2 ? sw + (size_t)e * 2048 + ct * 256 + l * 4
                                    : sas + (size_t)e * T + (u.pm - tstart[e]) * 256 + l * 4;
        __builtin_amdgcn_global_load_lds((const unsigned*)src, (LAS unsigned*)(lds + LDS_R1X + slot * 3072 + (wid - 1) * 1024), 16, 0, 0);
    }
    DI void operator()(LAS unsigned char* lds, const f32x4 (&acc)[2][2][4][2], const pg8::Unit& u, int wr, int wc, int fr, int fq, int slot) const {
        const int j = (u.pn & 7) * 128 + wc * 32 + 8 * fq;
        const LAS unsigned char* cb = lds + LDS_R1X + slot * 3072;
        const LAS f32x2* c2 = (const LAS f32x2*)(cb + (wc * 32 + 8 * fq) * 4);
        const LAS float* sa = (const LAS float*)(cb + 2048) + wr * 64 + fr;
        f32x2 bg[4], bu[4], sg_[4], su_[4];
#pragma unroll
        for (int q = 0; q < 4; ++q) { bg[q] = c2[q]; bu[q] = c2[64 + q]; sg_[q] = c2[128 + q]; su_[q] = c2[192 + q]; }
#pragma unroll
        for (int ai = 0; ai < 2; ++ai)
#pragma unroll
            for (int m = 0; m < 4; ++m) {
                const float st = sa[ai * 128 + m * 16];
                const f32x2 st2 = (f32x2){st, st};
                f32x2 h[4];
#pragma unroll
                for (int q = 0; q < 4; ++q) {
                    const f32x4 ag = acc[ai][0][m][q >> 1], au = acc[ai][1][m][q >> 1];
                    const f32x2 cg = (f32x2){(float)__float_as_int(ag[2 * (q & 1)]), (float)__float_as_int(ag[2 * (q & 1) + 1])};
                    const f32x2 cu = (f32x2){(float)__float_as_int(au[2 * (q & 1)]), (float)__float_as_int(au[2 * (q & 1) + 1])};
                    f32x2 g = cg * (st2 * sg_[q]) + bg[q], uu = cu * (st2 * su_[q]) + bu[q];
                    g[0] = fminf(g[0], 7.0f); g[1] = fminf(g[1], 7.0f);
                    uu[0] = fminf(fmaxf(uu[0], -7.0f), 7.0f); uu[1] = fminf(fmaxf(uu[1], -7.0f), 7.0f);
                    const f32x2 t = g * (f32x2){-1.702f * LOG2E, -1.702f * LOG2E};
                    f32x2 d = (f32x2){__builtin_amdgcn_exp2f(t[0]), __builtin_amdgcn_exp2f(t[1])} + (f32x2){1.0f, 1.0f};
                    d[0] = __builtin_amdgcn_rcpf(d[0]); d[1] = __builtin_amdgcn_rcpf(d[1]);
                    h[q] = (uu + (f32x2){1.0f, 1.0f}) * (g * d);
                }
                u32x2 w;
                w.x = (unsigned)__builtin_amdgcn_cvt_pk_fp8_f32(h[1][0], h[1][1], __builtin_amdgcn_cvt_pk_fp8_f32(h[0][0], h[0][1], 0, false), true);
                w.y = (unsigned)__builtin_amdgcn_cvt_pk_fp8_f32(h[3][0], h[3][1], __builtin_amdgcn_cvt_pk_fp8_f32(h[2][0], h[2][1], 0, false), true);
                *(u32x2*)(H + (size_t)(u.pm * 256 + ai * 128 + wr * 64 + m * 16 + fr) * 1024 + j) = w;
            }
    }
};
struct EpiDN {
    static constexpr bool PERM = true;
    bf16_t* Y; const float* bias; const float* sw;
    DI void prefetch(LAS unsigned char* lds, const pg8::Unit& u, int slot, int wid) const {
        if (wid < 1 || wid > 2) return;
        const int e = u.pn >> 2, ct = u.pn & 3, l = vlane();
        const float* src = (wid == 1 ? bias : sw) + (size_t)e * 1024 + ct * 256 + l * 4;
        __builtin_amdgcn_global_load_lds((const unsigned*)src, (LAS unsigned*)(lds + LDS_R1X + slot * 3072 + (wid - 1) * 1024), 16, 0, 0);
    }
    DI void operator()(LAS unsigned char* lds, const f32x4 (&acc)[2][2][4][2], const pg8::Unit& u, int wr, int wc, int fr, int fq, int slot) const {
        const int ct = u.pn & 3;
        const LAS unsigned char* cb = lds + LDS_R1X + slot * 3072;
#pragma unroll
        for (int bj = 0; bj < 2; ++bj) {
            const int cl = bj * 128 + wc * 32 + 8 * fq, c = ct * 256 + cl;
            const f32x4 b0 = *(const LAS f32x4*)(cb + cl * 4), b1 = *(const LAS f32x4*)(cb + cl * 4 + 16), s0 = *(const LAS f32x4*)(cb + 1024 + cl * 4), s1 = *(const LAS f32x4*)(cb + 1024 + cl * 4 + 16);
#pragma unroll
            for (int ai = 0; ai < 2; ++ai)
#pragma unroll
                for (int m = 0; m < 4; ++m) {
                    const f32x4 v0 = acc[ai][bj][m][0] * s0 + b0, v1 = acc[ai][bj][m][1] * s1 + b1;
                    u32x4 w; w.x = cvtpk(v0[0], v0[1]); w.y = cvtpk(v0[2], v0[3]); w.z = cvtpk(v1[0], v1[1]); w.w = cvtpk(v1[2], v1[3]);
                    *(u32x4*)(Y + (size_t)(u.pm * 256 + ai * 128 + wr * 64 + m * 16 + fr) * 1024 + c) = w;
                }
        }
    }
};
struct Frame {
    LAS unsigned char* lds; unsigned* ctl; unsigned char* ws; int tid, lane, wid; int G, bid;
};
struct MoeOrder {
    const LAS int* tstart; int sh; bool gather; const int* tokof; const LAS int* tokbuf; const LAS int* ulist; unsigned pitch;
    static DI void build(Frame& F, const LAS int* tstart, int nNt, LAS int* ulist) {
        __syncthreads();
        const int nwg = tstart[32] * nNt;
        if (F.tid == 0) ulist[0] = 0;
        __syncthreads();
        if (F.tid < 24) {
            const long L = (long)F.tid * F.G + F.bid;
            if (L < nwg) {
                int wgid = (int)L; { const int q = nwg / 8, r = nwg % 8, xcd = wgid % 8, off = wgid / 8; wgid = (xcd < r ? xcd * (q + 1) : r * (q + 1) + (xcd - r) * q) + off; }
                int e = 0;
                for (int k = 1; k < 32; ++k) if (tstart[k] * nNt <= wgid) e = k;
                const int rem = wgid - tstart[e] * nNt, nte = tstart[e + 1] - tstart[e];
                const int ct = rem / nte, rt = rem % nte;
                ulist[4 + 4 * F.tid] = tstart[e] + rt; ulist[5 + 4 * F.tid] = e * nNt + ct; ulist[6 + 4 * F.tid] = e; ulist[7 + 4 * F.tid] = rt;
                __hip_atomic_fetch_add(ulist, 1, __ATOMIC_RELAXED, __HIP_MEMORY_SCOPE_WORKGROUP);
            }
        }
        __syncthreads();
    }
    DI bool next(int i, pg8::Unit& u) const {
        if (i >= ulist[0]) return false;
        u.pm = ulist[4 + 4 * i]; u.pn = ulist[5 + 4 * i]; return true;
    }
    DI unsigned a_off(const pg8::Unit& u, int r) const {
        if (!gather) return (unsigned)(u.pm * 256 + r) * pitch;
        const int e = u.pn >> sh, idx = (u.pm - tstart[e]) * 256 + r;
        const int t = idx < tstart[80 + e] ? tokof[(size_t)e * T + idx] : 0;
        return (unsigned)t * pitch;
    }
    DI void prefetch(const pg8::Unit& u, int slot, int wid, int lane) const {
        if (gather && wid == 0) {
            const int e = u.pn >> sh, rt = u.pm - tstart[e];
            __builtin_amdgcn_global_load_lds((const unsigned*)(tokof + (size_t)e * T + rt * 256 + vlane() * 4), (LAS unsigned*)((LAS unsigned char*)tokbuf + slot * 1024), 16, 0, 0);
        }
    }
    DI unsigned a_off_pf(const pg8::Unit& u, int r, int slot) const {
        if (!gather) return (unsigned)(u.pm * 256 + r) * pitch;
        const int e = u.pn >> sh, idx = (u.pm - tstart[e]) * 256 + r;
        const int t = idx < tstart[80 + e] ? tokbuf[slot * 256 + r] : 0;
        return (unsigned)t * pitch;
    }
    DI void a_ready(const pg8::Unit&) const {}
    DI void done(const pg8::Unit&) const {}
};

struct MoeOrderDN {
    const LAS int* ulist;
    DI bool next(int i, pg8::Unit& u) const { if (i >= ulist[0]) return false; u.pm = __builtin_amdgcn_readfirstlane(ulist[4 + 4 * i]); u.pn = __builtin_amdgcn_readfirstlane(ulist[5 + 4 * i]); return true; }
    DI unsigned a_off(const pg8::Unit& u, int r) const { return (unsigned)(u.pm * 256 + r) * 1024u; }
    DI unsigned a_off_pf(const pg8::Unit& u, int r, int) const { return a_off(u, r); }
    DI void prefetch(const pg8::Unit&, int, int, int) const {}
    DI void a_ready(const pg8::Unit&) const {}
    DI void done(const pg8::Unit&) const {}
};

DI int crow(int r, int hi) { return (r & 3) + 8 * (r >> 2) + 4 * hi; }
template <int DK, bool FOX, bool ROPEQ>
DI void attn_unit(LAS unsigned char* lds, const bf16_t* Q, int ldq, const bf16_t* Kp, int ldk, const bf16_t* Vt, int ldv,
                  const float* cum, bf16_t* O, int ldo, int q0, int ntiles, bool causal, const int* pos, const int wid, const float* kn2 = nullptr) {
    constexpr int PK = DK * 2 + 16, KBYTES = 64 * PK, VBYTES = 64 * 136, BUF = KBYTES + VBYTES + 256, KCH = DK / 8, NS = DK / 16;
    const int lane = vlane(), tid = wid * 64 + lane, r32 = lane & 31, hi = lane >> 5;
    const int qw0 = q0 + wid * 32, qrow = qw0 + r32;
    bf16x8 qf[NS];
#pragma unroll
    for (int s = 0; s < NS; ++s) qf[s] = *(const bf16x8*)(Q + (size_t)qrow * ldq + 16 * s + 8 * hi);
    if constexpr (ROPEQ) {
        const float p = (float)pos[qrow];
#pragma unroll
        for (int j = 0; j < 8; ++j) {
            const int i = 8 * hi + j;
            const float inv = exp2f(-(float)i * (13.287712379549449f / 16.0f));
            float sn, cs; sincos_cw(p * inv, sn, cs);
            const float x1 = bf2f((unsigned short)qf[4][j]), x2 = bf2f((unsigned short)qf[5][j]);
            const float o1 = x1 * cs - x2 * sn, o2 = x1 * sn + x2 * cs;
            qf[4][j] = (short)(cvtpk(o1, 0.f) & 0xffffu); qf[5][j] = (short)(cvtpk(o2, 0.f) & 0xffffu);
        }
    }
    const float cq = FOX ? cum[qrow] : 0.f;
    int jstart = 0; float prune_c = 0.f;
    if constexpr (FOX) {
        LAS float* red = (LAS float*)(lds + 2 * BUF);
        float ss = 0.f;
#pragma unroll
        for (int s = 0; s < NS; ++s)
#pragma unroll
            for (int j = 0; j < 8; ++j) { const float v = bf2f((unsigned short)qf[s][j]); ss += v * v; }
        ss += __shfl_xor(ss, 32);
        ss = wave_max(ss);
        float kk = 0.f;
        for (int j = tid; j < ntiles; j += NTHREADS) kk = fmaxf(kk, kn2[j]);
        kk = wave_max(kk);
        __syncthreads();
        if (lane == 0) { red[wid] = ss; red[8 + wid] = kk; }
        __syncthreads();
        float qm = red[0], km = red[8];
#pragma unroll
        for (int w = 1; w < 8; ++w) { qm = fmaxf(qm, red[w]); km = fmaxf(km, red[8 + w]); }
        prune_c = 2.0f * sqrtf(qm * km) * 1.01f + 65.0f;
        const float cq0 = cum[q0];
        int cand = ntiles;
        for (int j = tid; j < ntiles; j += NTHREADS) if (cq0 - cum[64 * j + 63] + prune_c >= 0.f) cand = min(cand, j);
#pragma unroll
        for (int o = 1; o < 64; o <<= 1) cand = min(cand, __shfl_xor(cand, o));
        __syncthreads();
        if (lane == 0) ((LAS int*)red)[16 + wid] = cand;
        __syncthreads();
        jstart = ((LAS int*)red)[16];
#pragma unroll
        for (int w = 1; w < 8; ++w) jstart = min(jstart, ((LAS int*)red)[16 + w]);
        jstart = min(jstart, ntiles - 4);
        __syncthreads();
    }
    const float cqw0 = FOX ? __shfl(cq, 0) : 0.f;
    f32x16 o0, o1;
#pragma unroll
    for (int r = 0; r < 16; ++r) { o0[r] = 0.f; o1[r] = 0.f; }
    float mrun = -1e30f, lrun = 0.f;
    const int kr0 = tid / KCH, kc0 = tid % KCH;
    const int kr1 = (tid + 512) / KCH, kc1 = (tid + 512) % KCH;
    const bool k2 = (DK == 96) && (tid < 256);
    const int vd = tid >> 3, vc = tid & 7;
    u32x4 kreg0, kreg1 = (u32x4){0, 0, 0, 0}, vreg; float creg = 0.f;
#define ATT_GLOAD(j) do { \
        kreg0 = *(const u32x4*)(Kp + (size_t)(64 * (j) + kr0) * ldk + kc0 * 8); \
        if (k2) kreg1 = *(const u32x4*)(Kp + (size_t)(64 * (j) + kr1) * ldk + kc1 * 8); \
        vreg = *(const u32x4*)(Vt + (size_t)vd * ldv + 64 * (j) + vc * 8); \
        if (FOX && tid < 64) creg = cum[64 * (j) + tid]; } while (0)
#define ATT_LWRITE(buf) do { LAS unsigned char* bb_ = lds + (buf) * BUF; \
        *(LAS u32x4*)(bb_ + kr0 * PK + kc0 * 16) = kreg0; \
        if (k2) *(LAS u32x4*)(bb_ + kr1 * PK + kc1 * 16) = kreg1; \
        *(LAS u32x2*)(bb_ + KBYTES + vd * 136 + vc * 16) = (u32x2){vreg.x, vreg.y}; \
        *(LAS u32x2*)(bb_ + KBYTES + vd * 136 + vc * 16 + 8) = (u32x2){vreg.z, vreg.w}; \
        if (FOX && tid < 64) *(LAS float*)(bb_ + KBYTES + VBYTES + tid * 4) = creg; } while (0)
    ATT_GLOAD(jstart); ATT_LWRITE(0); __syncthreads();
    for (int j = jstart; j < ntiles; ++j) {
        const int cur = (j - jstart) & 1;
        if (j + 1 < ntiles) ATT_GLOAD(j + 1);
        const LAS unsigned char* kb = lds + cur * BUF; const LAS unsigned char* vb = kb + KBYTES; const LAS unsigned char* cb = vb + VBYTES;
        bool active = !causal || (64 * j <= qw0 + 31);
        if constexpr (FOX) { if (cqw0 - *(const LAS float*)(cb + 63 * 4) + prune_c < 0.f) active = false; }
        if (active) {
            f32x16 sp0, sp1;
#pragma unroll
            for (int r = 0; r < 16; ++r) { sp0[r] = 0.f; sp1[r] = 0.f; }
#pragma unroll
            for (int s = 0; s < NS; ++s) {
                const bf16x8 k0 = *(const LAS bf16x8*)(kb + r32 * PK + 32 * s + 16 * hi);
                const bf16x8 k1 = *(const LAS bf16x8*)(kb + (32 + r32) * PK + 32 * s + 16 * hi);
                sp0 = __builtin_amdgcn_mfma_f32_32x32x16_bf16(k0, qf[s], sp0, 0, 0, 0);
                sp1 = __builtin_amdgcn_mfma_f32_32x32x16_bf16(k1, qf[s], sp1, 0, 0, 0);
            }
            __builtin_amdgcn_sched_barrier(0);
            if constexpr (FOX) {
#pragma unroll
                for (int g = 0; g < 4; ++g) {
                    const f32x4 c0 = *(const LAS f32x4*)(cb + (8 * g + 4 * hi) * 4);
                    const f32x4 c1 = *(const LAS f32x4*)(cb + (32 + 8 * g + 4 * hi) * 4);
#pragma unroll
                    for (int i = 0; i < 4; ++i) { sp0[4 * g + i] += cq - c0[i]; sp1[4 * g + i] += cq - c1[i]; }
                }
            }
            if (causal && (64 * j + 63 > qw0)) {
#pragma unroll
                for (int r = 0; r < 16; ++r) {
                    const int key = 64 * j + crow(r, hi);
                    if (key > qrow) sp0[r] = -1e30f;
                    if (key + 32 > qrow) sp1[r] = -1e30f;
                }
            }
            float mx = fmaxf(sp0[0], sp1[0]);
#pragma unroll
            for (int r = 1; r < 16; ++r) mx = fmaxf(mx, fmaxf(sp0[r], sp1[r]));
            mx = fmaxf(mx, __shfl_xor(mx, 32));
            const float mnew = fmaxf(mrun, mx);
            const float alpha = __builtin_amdgcn_exp2f(mrun - mnew);
            mrun = mnew;
            float ls = 0.f;
#pragma unroll
            for (int r = 0; r < 16; ++r) { sp0[r] = __builtin_amdgcn_exp2f(sp0[r] - mnew); sp1[r] = __builtin_amdgcn_exp2f(sp1[r] - mnew); ls += sp0[r] + sp1[r]; }
            lrun = lrun * alpha + ls;
#pragma unroll
            for (int r = 0; r < 16; ++r) { o0[r] *= alpha; o1[r] *= alpha; }
            __builtin_amdgcn_sched_barrier(0);
#pragma unroll
            for (int ks = 0; ks < 4; ++ks) {
                const int p = ks >> 1, s2 = ks & 1;
                u32x4 pw;
                if (p == 0) { pw.x = cvtpk(sp0[8 * s2 + 0], sp0[8 * s2 + 1]); pw.y = cvtpk(sp0[8 * s2 + 2], sp0[8 * s2 + 3]); pw.z = cvtpk(sp0[8 * s2 + 4], sp0[8 * s2 + 5]); pw.w = cvtpk(sp0[8 * s2 + 6], sp0[8 * s2 + 7]); }
                else        { pw.x = cvtpk(sp1[8 * s2 + 0], sp1[8 * s2 + 1]); pw.y = cvtpk(sp1[8 * s2 + 2], sp1[8 * s2 + 3]); pw.z = cvtpk(sp1[8 * s2 + 4], sp1[8 * s2 + 5]); pw.w = cvtpk(sp1[8 * s2 + 6], sp1[8 * s2 + 7]); }
                const bf16x8 pf = __builtin_bit_cast(bf16x8, pw);
                const int kbase = (32 * p + 16 * s2 + 4 * hi) * 2;
                {
                    const u32x2 lo = *(const LAS u32x2*)(vb + r32 * 136 + kbase), h2 = *(const LAS u32x2*)(vb + r32 * 136 + kbase + 16);
                    const bf16x8 vf = __builtin_bit_cast(bf16x8, (u32x4){lo.x, lo.y, h2.x, h2.y});
                    o0 = __builtin_amdgcn_mfma_f32_32x32x16_bf16(vf, pf, o0, 0, 0, 0);
                }
                {
                    const u32x2 lo = *(const LAS u32x2*)(vb + (32 + r32) * 136 + kbase), h2 = *(const LAS u32x2*)(vb + (32 + r32) * 136 + kbase + 16);
                    const bf16x8 vf = __builtin_bit_cast(bf16x8, (u32x4){lo.x, lo.y, h2.x, h2.y});
                    o1 = __builtin_amdgcn_mfma_f32_32x32x16_bf16(vf, pf, o1, 0, 0, 0);
                }
            }
        }
        if (j + 1 < ntiles) ATT_LWRITE(cur ^ 1);
        __syncthreads();
    }
#undef ATT_GLOAD
#undef ATT_LWRITE
    const float ltot = lrun + __shfl_xor(lrun, 32);
    const float inv = 1.0f / ltot;
#pragma unroll
    for (int g = 0; g < 4; ++g) {
        const int d0 = 8 * g + 4 * hi;
        u32x2 w0, w1;
        w0.x = cvtpk(o0[4 * g] * inv, o0[4 * g + 1] * inv); w0.y = cvtpk(o0[4 * g + 2] * inv, o0[4 * g + 3] * inv);
        w1.x = cvtpk(o1[4 * g] * inv, o1[4 * g + 1] * inv); w1.y = cvtpk(o1[4 * g + 2] * inv, o1[4 * g + 3] * inv);
        *(u32x2*)(O + (size_t)qrow * ldo + d0) = w0;
        *(u32x2*)(O + (size_t)qrow * ldo + 32 + d0) = w1;
    }
}


template <int DK, bool ROPEQ>
DI void attn_unit_pipe(LAS unsigned char* lds, const bf16_t* Q, int ldq, const bf16_t* Kp, int ldk, const bf16_t* Vt, int ldv,
                       bf16_t* O, int ldo, int q0, int ntiles, const int* pos, const int wid) {
    constexpr int PK = DK * 2 + 16, KBYTES = 64 * PK, VBYTES = 64 * 136, KCH = DK / 8, NS = DK / 16, VOFF = 2 * KBYTES;
    constexpr float THR = 6.0f;
    const int lane = vlane(), tid = wid * 64 + lane, r32 = lane & 31, hi = lane >> 5;
    const int qw0 = q0 + wid * 32, qrow = qw0 + r32;
    bf16x8 qf[NS];
#pragma unroll
    for (int s = 0; s < NS; ++s) qf[s] = *(const bf16x8*)(Q + (size_t)qrow * ldq + 16 * s + 8 * hi);
    if constexpr (ROPEQ) {
        const float p = (float)pos[qrow];
#pragma unroll
        for (int j = 0; j < 8; ++j) {
            const int i = 8 * hi + j;
            const float inv = exp2f(-(float)i * (13.287712379549449f / 16.0f));
            float sn, cs; sincos_cw(p * inv, sn, cs);
            const float x1 = bf2f((unsigned short)qf[NS - 2][j]), x2 = bf2f((unsigned short)qf[NS - 1][j]);
            const float o1 = x1 * cs - x2 * sn, o2 = x1 * sn + x2 * cs;
            qf[NS - 2][j] = (short)(cvtpk(o1, 0.f) & 0xffffu); qf[NS - 1][j] = (short)(cvtpk(o2, 0.f) & 0xffffu);
        }
    }
    const int kr0 = tid / KCH, kc0 = tid % KCH;
    const int kr1 = (tid + 512) / KCH, kc1 = (tid + 512) % KCH;
    const bool k2 = (DK == 96) && (tid < 256);
    const int vd = tid >> 3, vc = tid & 7;
    const int kfo = r32 * PK + 16 * hi;
    const int vfo = VOFF + r32 * 136 + 8 * hi;
    u32x4 kA0, kA1 = (u32x4){0, 0, 0, 0}, vA, kB0, kB1 = (u32x4){0, 0, 0, 0}, vB;
#define SBAR() __builtin_amdgcn_sched_barrier(0)
#define AP_LOADK(j, R0, R1) do { R0 = *(const u32x4*)(Kp + (size_t)(64 * (j) + kr0) * ldk + kc0 * 8); \
        if (k2) R1 = *(const u32x4*)(Kp + (size_t)(64 * (j) + kr1) * ldk + kc1 * 8); } while (0)
#define AP_LOADV(j, RV) do { RV = *(const u32x4*)(Vt + (size_t)vd * ldv + 64 * (j) + vc * 8); } while (0)
#define AP_WRITEK(buf, R0, R1) do { LAS unsigned char* bb_ = lds + (buf) * KBYTES; *(LAS u32x4*)(bb_ + kr0 * PK + kc0 * 16) = R0; \
        if (k2) *(LAS u32x4*)(bb_ + kr1 * PK + kc1 * 16) = R1; } while (0)
#define AP_WRITEV(buf, RV) do { LAS unsigned char* bb_ = lds + VOFF + (buf) * VBYTES; \
        *(LAS u32x2*)(bb_ + vd * 136 + vc * 16) = (u32x2){RV.x, RV.y}; *(LAS u32x2*)(bb_ + vd * 136 + vc * 16 + 8) = (u32x2){RV.z, RV.w}; } while (0)
#define AP_KF(dst0, dst1, kbuf, s) do { dst0 = *(const LAS bf16x8*)(lds + (kbuf) * KBYTES + kfo + 32 * (s)); dst1 = *(const LAS bf16x8*)(lds + (kbuf) * KBYTES + kfo + 32 * PK + 32 * (s)); } while (0)
#define AP_VF(dst0, dst1, vbuf, ks) do { const LAS unsigned char* p_ = lds + (vbuf) * VBYTES + vfo + (32 * ((ks) >> 1) + 16 * ((ks) & 1)) * 2; \
        const u32x2 a_ = *(const LAS u32x2*)(p_), b_ = *(const LAS u32x2*)(p_ + 16), c_ = *(const LAS u32x2*)(p_ + 32 * 136), d_ = *(const LAS u32x2*)(p_ + 32 * 136 + 16); \
        dst0 = __builtin_bit_cast(bf16x8, (u32x4){a_.x, a_.y, b_.x, b_.y}); dst1 = __builtin_bit_cast(bf16x8, (u32x4){c_.x, c_.y, d_.x, d_.y}); } while (0)
#define AP_MFMA(a, b, c) __builtin_amdgcn_mfma_f32_32x32x16_bf16(a, b, c, 0, 0, 0)
#define AP_MASK(S0, S1, t) do { _Pragma("unroll") for (int r_ = 0; r_ < 16; ++r_) { const int key_ = 64 * (t) + crow(r_, hi); \
        if (key_ > qrow) S0[r_] = -1e30f; if (key_ + 32 > qrow) S1[r_] = -1e30f; } } while (0)
#define AP_ROWMAX(S0, S1, out) do { float a_ = fmaxf(fmaxf(S0[0], S1[0]), S0[1]), b_ = fmaxf(fmaxf(S1[1], S0[2]), S1[2]); \
        _Pragma("unroll") for (int r_ = 3; r_ < 15; r_ += 2) { a_ = fmaxf(fmaxf(a_, S0[r_]), S1[r_]); b_ = fmaxf(fmaxf(b_, S0[r_ + 1]), S1[r_ + 1]); } \
        a_ = fmaxf(fmaxf(a_, S0[15]), S1[15]); a_ = fmaxf(a_, b_); out = fmaxf(a_, __shfl_xor(a_, 32)); } while (0)
    f32x16 o0, o1, pa0, pa1, sb0, sb1;
#pragma unroll
    for (int r = 0; r < 16; ++r) { o0[r] = 0.f; o1[r] = 0.f; }
    float mref = 0.f, lrun = 0.f;
    bf16x8 pf[4];
    bf16x8 fa0, fa1, fb0, fb1;
    AP_LOADK(0, kA0, kA1); AP_LOADV(0, vA); AP_WRITEK(0, kA0, kA1); AP_WRITEV(0, vA);
    AP_LOADK(1, kA0, kA1); AP_WRITEK(1, kA0, kA1);
    AP_LOADK(2, kA0, kA1); AP_LOADV(1, vA);
    __syncthreads();
#pragma unroll
    for (int r = 0; r < 16; ++r) { pa0[r] = 0.f; pa1[r] = 0.f; }
#pragma unroll
    for (int s = 0; s < NS; ++s) { AP_KF(fa0, fa1, 0, s); pa0 = AP_MFMA(fa0, qf[s], pa0); pa1 = AP_MFMA(fa1, qf[s], pa1); }
    if (ntiles == 4) AP_MASK(pa0, pa1, 0);
    { float mx; AP_ROWMAX(pa0, pa1, mx); mref = mx;
#pragma unroll
      for (int r = 0; r < 16; ++r) { pa0[r] = __builtin_amdgcn_exp2f(pa0[r] - mx); pa1[r] = __builtin_amdgcn_exp2f(pa1[r] - mx); } }
    __syncthreads();
    f32x16 negm;
#pragma unroll
    for (int r = 0; r < 16; ++r) negm[r] = -mref;
    asm volatile("" : "+v"(negm));
#define AP_STEPA(s, X0, X1, Y0, Y1, VALU) do { if ((s) + 1 < NS) AP_KF(Y0, Y1, kb_, (s) + 1); else AP_VF(Y0, Y1, vb_, 0); \
        if ((s) == 0) { sb0 = AP_MFMA(X0, qf[s], negm); sb1 = AP_MFMA(X1, qf[s], negm); } else { sb0 = AP_MFMA(X0, qf[s], sb0); sb1 = AP_MFMA(X1, qf[s], sb1); } VALU; SBAR(); } while (0)
#define AP_PK(i, P, b) pw_[i] = (u32x4){cvtpk(P[b], P[b + 1]), cvtpk(P[b + 2], P[b + 3]), cvtpk(P[b + 4], P[b + 5]), cvtpk(P[b + 6], P[b + 7])}; \
        ls0_ = fadd_s(ls0_, fadd_s(fadd_s(P[b], P[b + 1]), fadd_s(P[b + 2], P[b + 3]))); ls1_ = fadd_s(ls1_, fadd_s(fadd_s(P[b + 4], P[b + 5]), fadd_s(P[b + 6], P[b + 7]))); asm volatile("" : "+v"(pw_[i]), "+v"(ls0_), "+v"(ls1_))
#define AP_EXP4(P, S, b) do { P[b] = __builtin_amdgcn_exp2f(S[b]); P[b + 1] = __builtin_amdgcn_exp2f(S[b + 1]); P[b + 2] = __builtin_amdgcn_exp2f(S[b + 2]); P[b + 3] = __builtin_amdgcn_exp2f(S[b + 3]); asm volatile("" : "+v"(P)); } while (0)
#define AP_STEPB(ks, X0, X1, Y0, Y1, E0, E1) do { if ((ks) + 1 < 4) AP_VF(Y0, Y1, vb_, (ks) + 1); \
        o0 = AP_MFMA(X0, pf[ks], o0); E0; SBAR(); o1 = AP_MFMA(X1, pf[ks], o1); E1; SBAR(); } while (0)
#define AP_ITER(t, MASKED, WK0, WK1, WV, LK0, LK1, LV) do {     \
        const int kb_ = (t) & 1, vb_ = ((t) - 1) & 1; \
        if ((t) + 2 < ntiles) AP_LOADK((t) + 2, LK0, LK1); \
        if ((t) + 1 < ntiles) AP_LOADV((t) + 1, LV); \
        u32x4 pw_[4]; float ls0_ = 0.f, ls1_ = 0.f; \
        AP_KF(fa0, fa1, kb_, 0); SBAR(); \
        AP_STEPA(0, fa0, fa1, fb0, fb1, AP_PK(0, pa0, 0)); \
        AP_STEPA(1, fb0, fb1, fa0, fa1, AP_PK(1, pa0, 8)); \
        AP_STEPA(2, fa0, fa1, fb0, fb1, AP_PK(2, pa1, 0)); \
        AP_STEPA(3, fb0, fb1, fa0, fa1, AP_PK(3, pa1, 8)); \
        if (NS == 6) { AP_STEPA(4, fa0, fa1, fb0, fb1, (void)0); AP_STEPA(5, fb0, fb1, fa0, fa1, (void)0); } \
        lrun += ls0_ + ls1_; \
        pf[0] = __builtin_bit_cast(bf16x8, pw_[0]); pf[1] = __builtin_bit_cast(bf16x8, pw_[1]); pf[2] = __builtin_bit_cast(bf16x8, pw_[2]); pf[3] = __builtin_bit_cast(bf16x8, pw_[3]); \
        if ((t) >= ntiles - 4) AP_MASK(sb0, sb1, t); \
        float mx_; AP_ROWMAX(sb0, sb1, mx_); \
        float resc_ = 1.0f; bool do_resc_ = false; \
        if (__any(mx_ > THR)) { const float dl_ = fmaxf(mx_, 0.f); mref += dl_; \
            _Pragma("unroll") for (int r_ = 0; r_ < 16; ++r_) { sb0[r_] -= dl_; sb1[r_] -= dl_; negm[r_] = -mref; } \
            asm volatile("" : "+v"(negm)); \
            resc_ = __builtin_amdgcn_exp2f(-dl_); lrun *= resc_; do_resc_ = true; } \
        SBAR(); \
        AP_STEPB(0, fa0, fa1, fb0, fb1, AP_EXP4(pa0, sb0, 0), AP_EXP4(pa0, sb0, 4)); \
        AP_STEPB(1, fb0, fb1, fa0, fa1, AP_EXP4(pa0, sb0, 8), AP_EXP4(pa0, sb0, 12)); \
        AP_STEPB(2, fa0, fa1, fb0, fb1, AP_EXP4(pa1, sb1, 0), AP_EXP4(pa1, sb1, 4)); \
        AP_STEPB(3, fb0, fb1, fa0, fa1, AP_EXP4(pa1, sb1, 8), AP_EXP4(pa1, sb1, 12)); \
        if (do_resc_) { asm volatile("" ::: "memory"); _Pragma("unroll") for (int r_ = 0; r_ < 16; ++r_) { o0[r_] *= resc_; o1[r_] *= resc_; } asm volatile("" : "+v"(o0), "+v"(o1)); } \
        if ((t) + 1 < ntiles) AP_WRITEK(((t) + 1) & 1, WK0, WK1); \
        AP_WRITEV((t) & 1, WV); \
        __syncthreads(); } while (0)
    static_assert(NS == 4 || NS == 6, "head dim 64 or 96");
    if (wid >= 4) __builtin_amdgcn_s_setprio(1);
    int t = 1;
    for (; t + 1 < ntiles; t += 2) { AP_ITER(t, 1, kA0, kA1, vA, kB0, kB1, vB); AP_ITER(t + 1, 1, kB0, kB1, vB, kA0, kA1, vA); }
    AP_ITER(t, 1, kA0, kA1, vA, kB0, kB1, vB);
    {
        u32x4 pw_[4]; float ls0_ = 0.f, ls1_ = 0.f;
        AP_PK(0, pa0, 0); AP_PK(1, pa0, 8); AP_PK(2, pa1, 0); AP_PK(3, pa1, 8);
        lrun += ls0_ + ls1_;
        pf[0] = __builtin_bit_cast(bf16x8, pw_[0]); pf[1] = __builtin_bit_cast(bf16x8, pw_[1]); pf[2] = __builtin_bit_cast(bf16x8, pw_[2]); pf[3] = __builtin_bit_cast(bf16x8, pw_[3]);
        const int vb_ = (ntiles - 1) & 1;
#pragma unroll
        for (int ks = 0; ks < 4; ++ks) { AP_VF(fa0, fa1, vb_, ks); o0 = AP_MFMA(fa0, pf[ks], o0); o1 = AP_MFMA(fa1, pf[ks], o1); }
    }
    const float ltot = lrun + __shfl_xor(lrun, 32);
    const float inv = 1.0f / ltot;
#pragma unroll
    for (int g = 0; g < 4; ++g) {
        const int d0 = 8 * g + 4 * hi;
        u32x2 w0, w1;
        w0.x = cvtpk(o0[4 * g] * inv, o0[4 * g + 1] * inv); w0.y = cvtpk(o0[4 * g + 2] * inv, o0[4 * g + 3] * inv);
        w1.x = cvtpk(o1[4 * g] * inv, o1[4 * g + 1] * inv); w1.y = cvtpk(o1[4 * g + 2] * inv, o1[4 * g + 3] * inv);
        *(u32x2*)(O + (size_t)qrow * ldo + d0) = w0;
        *(u32x2*)(O + (size_t)qrow * ldo + 32 + d0) = w1;
    }
    __syncthreads();
#undef SBAR
#undef AP_LOADK
#undef AP_LOADV
#undef AP_WRITEK
#undef AP_WRITEV
#undef AP_KF
#undef AP_VF
#undef AP_MFMA
#undef AP_MASK
#undef AP_ROWMAX
#undef AP_STEPA
#undef AP_PK
#undef AP_EXP4
#undef AP_STEPB
#undef AP_ITER
}

#define XB_TMO      128
#define XB_XCNT(j)  (256  + 64 * (j))
#define XB_XSUB(j)  (1280 + 64 * (j))
#define XB_XGEN(j)  (2304 + 64 * (j))
#define XB_TOP      3328
#define XB_TOPGEN   3392
#define XCD_BAR_WORDS 3456
#define XB_SPIN_CAP (1u << 18)
DI unsigned xb_ld(unsigned* p) { return __hip_atomic_load(p, __ATOMIC_RELAXED, __HIP_MEMORY_SCOPE_AGENT); }
DI unsigned xb_add(unsigned* p, unsigned v) { return __hip_atomic_fetch_add(p, v, __ATOMIC_RELAXED, __HIP_MEMORY_SCOPE_AGENT); }
DI unsigned xb_xcc_id() { return (unsigned)__builtin_amdgcn_s_getreg((3 << 11) | 20) & 0xFu; }
#define XB_SPIN(cond, bar) do { unsigned _sp = 0; while (cond) { __builtin_amdgcn_s_sleep(1); \
    if ((++_sp & 255u) == 0u) { if (xb_ld(&(bar)[XB_TMO])) break; if (_sp > XB_SPIN_CAP) { atomicAdd(&(bar)[XB_TMO], 1u); break; } } } } while (0)
struct XcdBarrier { unsigned* bar; unsigned x; volatile LAS unsigned* st; int wid; };
DI XcdBarrier xcd_barrier_post(unsigned* bar, volatile LAS unsigned* st, int wid) {
    XcdBarrier b; b.bar = bar; b.x = xb_xcc_id(); b.st = st; b.wid = wid;
    if (wid == 0 && vlane() == 0) (void)xb_add(&bar[XB_XCNT(b.x)], 1u);
    return b;
}
DI void xcd_barrier_complete(unsigned* bar, unsigned x, unsigned& nloc, unsigned& nx) {
    const unsigned G = gridDim.x * gridDim.y * gridDim.z;
    unsigned sum, cnt, mine, sp = 0u;
    for (;;) {
        sum = 0u; cnt = 0u; mine = 0u;
#pragma unroll
        for (unsigned j = 0; j < 16; ++j) { const unsigned c = xb_ld(&bar[XB_XCNT(j)]); sum += c; cnt += (c > 0u) ? 1u : 0u; mine = (j == x) ? c : mine; }
        if (sum == G) break;
        __builtin_amdgcn_s_sleep(1);
        if ((++sp & 255u) == 0u) { if (xb_ld(&bar[XB_TMO])) break; if (sp > XB_SPIN_CAP) { atomicAdd(&bar[XB_TMO], 1u); break; } }
    }
    nloc = mine > 0u ? mine : 1u; nx = cnt > 0u ? cnt : 1u;
}
DI void xcd_barrier(const XcdBarrier& b) {
    asm volatile("s_waitcnt vmcnt(0)" ::: "memory");
    __syncthreads();
    if (b.wid == 0 && vlane() == 0) {
        unsigned* bar = b.bar;
        __builtin_amdgcn_s_waitcnt(0);
        unsigned nloc = b.st[0], nx = b.st[1];
        if (nloc == 0u) { xcd_barrier_complete(bar, b.x, nloc, nx); b.st[0] = nloc; b.st[1] = nx; }
        const unsigned old = xb_add(&bar[XB_XSUB(b.x)], 1u);
        const unsigned gen = old / nloc;
        if (old + 1u == (gen + 1u) * nloc) {
            __builtin_amdgcn_fence(__ATOMIC_RELEASE, "agent");
            asm volatile("s_waitcnt vmcnt(0)" ::: "memory");
            const unsigned og = xb_add(&bar[XB_TOP], 1u);
            const unsigned tg = og / nx;
            if (og + 1u == (tg + 1u) * nx) xb_add(&bar[XB_TOPGEN], 1u);
            else XB_SPIN(xb_ld(&bar[XB_TOPGEN]) == tg, bar);
            __builtin_amdgcn_fence(__ATOMIC_ACQUIRE, "agent");
            xb_add(&bar[XB_XGEN(b.x)], 1u);
            asm volatile("s_waitcnt vmcnt(0)" ::: "memory");
        } else {
            XB_SPIN(xb_ld(&bar[XB_XGEN(b.x)]) == gen, bar);
            __builtin_amdgcn_fence(__ATOMIC_ACQUIRE, "agent");
            asm volatile("s_waitcnt vmcnt(0)" ::: "memory");
        }
    }
    __syncthreads();
}

DI int next_unit(Frame& F, int widx) {
    LAS int* s = (LAS int*)(F.lds + LDS_CTL);
    __syncthreads();
    if (F.tid == 0) *s = (int)atomicAdd(F.ctl + CW_WORK + 64 * widx, 1u);
    __syncthreads();
    return *s;
}

DI void transpose_item(const float* W, int ldw, int srccol, int K, bf16_t* WT, int drow, LAS unsigned* scr, int k0, int lane, int nvalid) {
    const int n4 = lane & 15, kq = lane >> 4;
#pragma unroll 8
    for (int i = 0; i < 16; ++i) {
        const int kk = 4 * i + kq;
        f32x4 v = (f32x4){0.f, 0.f, 0.f, 0.f};
        if (4 * n4 < nvalid) v = *(const f32x4*)(W + (size_t)(k0 + kk) * ldw + srccol + 4 * n4);
        scr[kk * 33 + 2 * n4] = cvtpk(v[0], v[1]); scr[kk * 33 + 2 * n4 + 1] = cvtpk(v[2], v[3]);
    }
    LDS_WAIT(); asm volatile("" ::: "memory");
    const int c = lane & 7;
    const LAS unsigned short* s16 = (const LAS unsigned short*)scr;
#pragma unroll
    for (int j = 0; j < 8; ++j) {
        const int n = (lane >> 3) + 8 * j;
        const LAS unsigned short* sp = s16 + (8 * c) * 66 + n;
        u32x4 o;
        o.x = (unsigned)sp[0 * 66] | ((unsigned)sp[1 * 66] << 16); o.y = (unsigned)sp[2 * 66] | ((unsigned)sp[3 * 66] << 16);
        o.z = (unsigned)sp[4 * 66] | ((unsigned)sp[5 * 66] << 16); o.w = (unsigned)sp[6 * 66] | ((unsigned)sp[7 * 66] << 16);
        if (n < nvalid) *(u32x4*)(WT + (size_t)(drow + n) * K + k0 + 8 * c) = o;
    }
    LDS_WAIT(); asm volatile("" ::: "memory");
}
DI unsigned q8x4(float a, float b, float c, float d, float inv) {
    const float M = 12582912.0f;
    const unsigned ua = __float_as_uint(fmaf(a, inv, M)), ub = __float_as_uint(fmaf(b, inv, M)), uc = __float_as_uint(fmaf(c, inv, M)), ud = __float_as_uint(fmaf(d, inv, M));
    return __builtin_amdgcn_perm(ub, ua, 0x0c0c0400u) | __builtin_amdgcn_perm(ud, uc, 0x04000c0cu);
}
template <int QM>
DI void strip_item(const float* W, int ldw, int n0, unsigned char* dst, float* sc, LAS float* red, int tid) {
    const int c4 = tid & 15, kr = tid >> 4;
    const float* src = W + (size_t)(kr * 32) * ldw + n0 + 4 * c4;
    f32x4 v[32];
#pragma unroll
    for (int p = 0; p < 32; ++p) v[p] = *(const f32x4*)(src + (size_t)p * ldw);
    f32x4 m = (f32x4){0.f, 0.f, 0.f, 0.f};
#pragma unroll
    for (int p = 0; p < 32; ++p)
#pragma unroll
        for (int j = 0; j < 4; ++j) m[j] = fmaxf(m[j], fabsf(v[p][j]));
#pragma unroll
    for (int j = 0; j < 4; ++j) { m[j] = fmaxf(m[j], __shfl_xor(m[j], 16)); m[j] = fmaxf(m[j], __shfl_xor(m[j], 32)); }
    __syncthreads();
    if ((tid & 63) < 16) *(LAS f32x4*)(red + (tid >> 6) * 64 + 4 * c4) = m;
    __syncthreads();
#pragma unroll
    for (int w = 0; w < 8; ++w) { const f32x4 o = *(const LAS f32x4*)(red + w * 64 + 4 * c4);
#pragma unroll
        for (int j = 0; j < 4; ++j) m[j] = fmaxf(m[j], o[j]); }
    constexpr float QMAX = QM == 0 ? 127.0f : 448.0f;
    if (kr == 0) *(f32x4*)(sc + 4 * c4) = m * (1.0f / QMAX);
#pragma unroll
    for (int j = 0; j < 4; ++j) {
        const float inv = m[j] > 0.f ? QMAX / m[j] : 0.f;
        unsigned w[8];
#pragma unroll
        for (int q = 0; q < 8; ++q) {
            if constexpr (QM == 0) w[q] = q8x4(v[4 * q][j], v[4 * q + 1][j], v[4 * q + 2][j], v[4 * q + 3][j], inv);
            else w[q] = (unsigned)__builtin_amdgcn_cvt_pk_fp8_f32(v[4 * q + 2][j] * inv, v[4 * q + 3][j] * inv, __builtin_amdgcn_cvt_pk_fp8_f32(v[4 * q][j] * inv, v[4 * q + 1][j] * inv, 0, false), true);
        }
        u32x4* o = (u32x4*)(dst + (size_t)(4 * c4 + j) * 1024 + kr * 32);
        o[0] = (u32x4){w[0], w[1], w[2], w[3]}; o[1] = (u32x4){w[4], w[5], w[6], w[7]};
    }
}
constexpr int CONV_P1 = 2, CONV_A0 = 3, CONV_GU = 3, CONV_DN = 2, CONV_A1 = 6;
constexpr int MOE_S_GU = 32, MOE_S_DN = 16, MOE_STRIPS_PER_LAYER = 32 * (MOE_S_GU + MOE_S_DN);
DI void moe_convert_strip(unsigned char* ws, LAS float* red, int l, int r, int tid) {
    if (r < 32 * MOE_S_GU) {
        const int e = l * 32 + r / MOE_S_GU, nb = r % MOE_S_GU;
        const int jj = (nb & 15) * 64, drow = (jj >> 7) * 256 + (nb >> 4) * 128 + (jj & 127);
        strip_item<0>(KP->moe_w_gu + (size_t)e * 1024 * 2048, 2048, 64 * nb, ws + WS_W_GU + ((size_t)e * 2048 + drow) * 1024, (float*)(ws + WS_SGU) + (size_t)e * 2048 + drow, red, tid);
    } else {
        r -= 32 * MOE_S_GU;
        const int e = l * 32 + r / MOE_S_DN, nb = r % MOE_S_DN;
        strip_item<2>(KP->moe_w_dn + (size_t)e * 1024 * 1024, 1024, 64 * nb, ws + WS_W_DN + ((size_t)e * 1024 + 64 * nb) * 1024, (float*)(ws + WS_SDN) + (size_t)e * 1024 + 64 * nb, red, tid);
    }
}
constexpr int CW_CONVQ = CW_WORK + 64 * 8;
DI bool conv_pull(Frame& F, int l, int n) {
    LAS int* s = (LAS int*)(F.lds + LDS_CTL + 8);
    __syncthreads();
    if (F.tid == 0) *s = (int)atomicAdd(F.ctl + CW_CONVQ + 64 * l, (unsigned)n);
    __syncthreads();
    const int base = *s;
    for (int c = base; c < base + n && c < MOE_STRIPS_PER_LAYER; ++c) moe_convert_strip(F.ws, (LAS float*)F.lds, l, c, F.tid);
    __syncthreads();
    return base + n < MOE_STRIPS_PER_LAYER;
}
struct TrMat { const float* W; int ldw, col0, K, N; bf16_t* WT; int drow0, mode; };

DI void phase_prologue(Frame& F, const Params& P) {
    F.lane = vlane(); F.tid = F.wid * 64 + F.lane;
    LAS unsigned* scr = (LAS unsigned*)(F.lds + F.wid * 8448);
    const int gw = F.bid * 8 + F.wid, NGW = F.G * 8;
    unsigned char* ws = F.ws;
    TrMat mats[11];
    mats[0] = TrMat{KP->a_w_in, FOX_IN, 0, 1024, 1536, (bf16_t*)(ws + WS_W_AIN), 0, 0};
    mats[1] = TrMat{KP->a_w_in, FOX_IN, 2316, 1024, 256, (bf16_t*)(ws + WS_W_AIN), 1536, 0};
    mats[2] = TrMat{KP->a_w_in, FOX_IN, 1536, 1024, 768, (bf16_t*)(ws + WS_W_AIN), 1792, 0};
    mats[3] = TrMat{KP->a_w_out, 1024, 0, 1024, 1024, (bf16_t*)(ws + WS_W_AOUT), 0, 0};
    mats[4] = TrMat{KP->kv_w_dkv, 288, 0, 1024, 288, (bf16_t*)(ws + WS_W_BIN), 0, 0};
    mats[5] = TrMat{KP->b_w_in, 640, 0, 1024, 640, (bf16_t*)(ws + WS_W_BIN), 288, 0};
    mats[6] = TrMat{KP->b_w_uq, 1152, 0, 384, 1152, (bf16_t*)(ws + WS_W_UQ), 0, 0};
    mats[7] = TrMat{KP->kv_w_ukv, 1536, 0, 256, 1536, (bf16_t*)(ws + WS_W_UKV), 0, 1};
    mats[8] = TrMat{KP->b_w_out, 1024, 0, 1024, 1024, (bf16_t*)(ws + WS_W_BOUT), 0, 0};
    mats[9] = TrMat{KP->mem_w_kv, 512, 0, 1024, 512, (bf16_t*)(ws + WS_W_MKV), 0, 0};
    mats[10] = TrMat{KP->mem_w_kv + (size_t)1024 * 512, 512, 0, 1024, 512, (bf16_t*)(ws + WS_W_MKV) + (size_t)512 * 1024, 0, 0};
    int nsmall = 0;
#pragma unroll
    for (int i = 0; i < 11; ++i) nsmall += (mats[i].K / 64) * ((mats[i].N + 63) / 64);
    const int ntot = nsmall;
    for (int it = gw; it < ntot; it += NGW) {
        int r = it;
        if (r < nsmall) {
#pragma unroll
            for (int i = 0; i < 11; ++i) {
                const int nblk = (mats[i].N + 63) / 64, ni = (mats[i].K / 64) * nblk;
                if (r >= 0 && r < ni) {
                    const int kb = r / nblk, nb = r % nblk;
                    const int drow = mats[i].mode == 1 ? ((nb & 1) * 768 + (nb >> 1) * 64) : (mats[i].drow0 + 64 * nb);
                    transpose_item(mats[i].W, mats[i].ldw, mats[i].col0 + 64 * nb, mats[i].K, mats[i].WT, drow, scr, 64 * kb, F.lane, mats[i].N - 64 * nb);
                }
                r -= ni;
            }
            continue;
        }
    }
    __syncthreads();
    LAS float* wf = (LAS float*)F.lds;
    for (int i = F.tid; i < 1024 * 12; i += NTHREADS) { const int k = i / 12, h = i % 12; wf[i] = KP->a_w_in[(size_t)k * FOX_IN + 2304 + h]; }
    __syncthreads();
    float* logf = (float*)(ws + WS_LOGF);
    bf16_t* xb = (bf16_t*)(ws + WS_XB);
    for (int row = gw; row < T; row += NGW) {
        const f32x4* xr = (const f32x4*)(KP->x + (size_t)row * DM) + F.lane;
        f32x4 v[4];
#pragma unroll
        for (int j = 0; j < 4; ++j) v[j] = xr[64 * j];
        u32x2* o8 = (u32x2*)(xb + (size_t)row * DM) + F.lane;
#pragma unroll
        for (int j = 0; j < 4; ++j) o8[64 * j] = (u32x2){cvtpk(v[j][0], v[j][1]), cvtpk(v[j][2], v[j][3])};
        float part[12];
#pragma unroll
        for (int h = 0; h < 12; ++h) part[h] = 0.f;
#pragma unroll
        for (int j = 0; j < 4; ++j)
#pragma unroll
            for (int i = 0; i < 4; ++i) {
                const int k = 4 * F.lane + 256 * j + i;
                const LAS f32x4* wp = (const LAS f32x4*)(wf + k * 12);
                const f32x4 w0 = wp[0], w1 = wp[1], w2 = wp[2];
                const float xv = v[j][i];
                part[0] += xv * w0[0]; part[1] += xv * w0[1]; part[2] += xv * w0[2]; part[3] += xv * w0[3];
                part[4] += xv * w1[0]; part[5] += xv * w1[1]; part[6] += xv * w1[2]; part[7] += xv * w1[3];
                part[8] += xv * w2[0]; part[9] += xv * w2[1]; part[10] += xv * w2[2]; part[11] += xv * w2[3];
            }
        float mine = 0.f;
#pragma unroll
        for (int h = 0; h < 12; ++h) { const float s = wave_sum(part[h]); if (F.lane == h) mine = s; }
        if (F.lane < 12) {
            const float z = mine + KP->a_b_f[F.lane];
            const float ls = fminf(z, 0.f) - log1pf(expf(-fabsf(z)));
            const int b = row / SEQ, s = row % SEQ;
            logf[(size_t)(b * NH + F.lane) * SEQ + s] = ls;
        }
    }
    {
        float* wrt = (float*)(ws + WS_WRT);
        bf16_t* wrh = (bf16_t*)(ws + WS_WRH); bf16_t* wrl = (bf16_t*)(ws + WS_WRL);
        for (int i = F.bid * NTHREADS + F.tid; i < 2 * 1024 * 32; i += F.G * NTHREADS) { const int l = i >> 15, k = (i >> 5) & 1023, e = i & 31; const float w = KP->moe_w_r[i];
            const unsigned hb = cvtpk(w, 0.f) & 0xffffu; const float hf = __uint_as_float(hb << 16);
            wrt[(size_t)(l * 32 + e) * 1024 + k] = w; wrh[(size_t)(l * 32 + e) * 1024 + k] = (bf16_t)hb; wrl[(size_t)(l * 32 + e) * 1024 + k] = (bf16_t)(cvtpk(w - hf, 0.f) & 0xffffu); }
    }
    bf16_t* memb = (bf16_t*)(ws + WS_MEMB);
    for (int row = gw; row < NB * NMEM; row += NGW) {
        const f32x4* xr = (const f32x4*)(KP->mem + (size_t)row * DM) + F.lane;
        u32x2* o8 = (u32x2*)(memb + (size_t)row * DM) + F.lane;
#pragma unroll
        for (int j = 0; j < 4; ++j) { const f32x4 v = xr[64 * j]; o8[64 * j] = (u32x2){cvtpk(v[0], v[1]), cvtpk(v[2], v[3])}; }
    }
}

DI void scan_unit(Frame& F, int bh) {
    const float* src = (const float*)(F.ws + WS_LOGF) + (size_t)bh * SEQ;
    float* dst = (float*)(F.ws + WS_CUM) + (size_t)bh * SEQ;
    LAS float* wtot = (LAS float*)F.lds;
    float v[16];
#pragma unroll
    for (int j = 0; j < 4; ++j) { const f32x4 t = *(const f32x4*)(src + F.tid * 16 + 4 * j); v[4 * j] = t[0]; v[4 * j + 1] = t[1]; v[4 * j + 2] = t[2]; v[4 * j + 3] = t[3]; }
#pragma unroll
    for (int i = 1; i < 16; ++i) v[i] += v[i - 1];
    float tot = v[15];
    float inc = tot;
#pragma unroll
    for (int o = 1; o < 64; o <<= 1) { const float t = __shfl_up(inc, o); if (F.lane >= o) inc += t; }
    __syncthreads();
    if (F.lane == 63) wtot[F.wid] = inc;
    __syncthreads();
    float base = inc - tot;
    for (int w = 0; w < F.wid; ++w) base += wtot[w];
#pragma unroll
    for (int j = 0; j < 4; ++j) {
        f32x4 t; t[0] = (base + v[4 * j]) * LOG2E; t[1] = (base + v[4 * j + 1]) * LOG2E; t[2] = (base + v[4 * j + 2]) * LOG2E; t[3] = (base + v[4 * j + 3]) * LOG2E;
        *(f32x4*)(dst + F.tid * 16 + 4 * j) = t;
    }
    __syncthreads();
}

struct RouteQKM { unsigned char* ws; DI Dst operator()(const pg8::Unit& u) const {
    if (u.pn < 3) return Dst{(bf16_t*)(ws + WS_Q), 768, u.pm * 256, u.pn * 256, 256, 0.125f * LOG2E, false};
    if (u.pn < 6) return Dst{(bf16_t*)(ws + WS_K), 768, u.pm * 256, (u.pn - 3) * 256, 256, 1.0f, false};
    return Dst{(bf16_t*)(ws + WS_MQ), 256, u.pm * 256, 0, 256, 0.125f * LOG2E, false}; } };
struct RouteVT { unsigned char* ws; DI Dst operator()(const pg8::Unit& u) const {
    const int b = u.pn >> 5; return Dst{(bf16_t*)(ws + WS_VT) + (size_t)b * 768 * SEQ, SEQ, u.pm * 256, (u.pn & 31) * 256, 256, 1.0f, false}; } };
struct RoutePlain { bf16_t* O; int ldo; DI Dst operator()(const pg8::Unit& u) const { return Dst{O, ldo, u.pm * 256, u.pn * 256, 256, 1.0f, false}; } };
DI void phase_proj0(Frame& F, const Params& P) {
    F.lane = vlane(); F.tid = F.wid * 64 + F.lane;
    unsigned char* ws = F.ws;
    const bf16_t* xb = (const bf16_t*)(ws + WS_XB);
    const bf16_t* win = (const bf16_t*)(ws + WS_W_AIN);
    const bf16_t* memb = (const bf16_t*)(ws + WS_MEMB);
    {
        pg8::Gemm g{xb, win, 1024}; pg8::StaticOrder S; S.init(T, 1792, 1024, F.G, F.bid);
        EpiBf16R<RouteQKM> E{RouteQKM{ws}};
        pg8::gemm_phase<EpiBf16R<RouteQKM>, pg8::StaticOrder, true>(F.lds, g, S, E, F.wid);
    }
    {
        pg8::Gemm g{win + (size_t)1792 * 1024, xb, 1024}; pg8::StaticOrder S; S.init(768, T, 1024, F.G, (F.bid + 64) % F.G);
        EpiBf16R<RouteVT> E{RouteVT{ws}};
        pg8::gemm_phase<EpiBf16R<RouteVT>, pg8::StaticOrder, true>(F.lds, g, S, E, F.wid);
    }
    for (int l = 0; l < 2; ++l) {
        const bf16_t* wk = (const bf16_t*)(ws + WS_W_MKV) + (size_t)l * 512 * 1024;
        {
            pg8::Gemm g{memb, wk, 1024}; pg8::StaticOrder S; S.init(512, 256, 1024, F.G, (F.bid + F.G - (152 + 4 * l)) % F.G);
            EpiBf16R<RoutePlain> E{RoutePlain{(bf16_t*)(ws + WS_MK) + (size_t)l * 512 * 256, 256}};
            pg8::gemm_phase<EpiBf16R<RoutePlain>, pg8::StaticOrder, true>(F.lds, g, S, E, F.wid);
        }
        for (int b = 0; b < 2; ++b) {
            pg8::Gemm g{wk + (size_t)256 * 1024, memb + (size_t)b * 256 * 1024, 1024}; pg8::StaticOrder S; S.init(256, 256, 1024, F.G, (F.bid + F.G - (154 + 4 * l + b)) % F.G);
            EpiBf16R<RoutePlain> E{RoutePlain{(bf16_t*)(ws + WS_MVT) + (size_t)(l * 2 + b) * 256 * 256, 256}};
            pg8::gemm_phase<EpiBf16R<RoutePlain>, pg8::StaticOrder, true>(F.lds, g, S, E, F.wid);
        }
    }
    if (F.G == 256 && F.bid >= 128) conv_pull(F, 0, CONV_P1);
}


DI void phase_scan_knorm(Frame& F) {
    F.lane = vlane(); F.tid = F.wid * 64 + F.lane;
    unsigned char* ws = F.ws;
    if (F.bid < 24) scan_unit(F, F.bid);
    const bf16_t* K = (const bf16_t*)(ws + WS_K);
    float* kn2 = (float*)(ws + WS_KN2);
    const int gw = F.bid * 8 + F.wid, NGW = F.G * 8;
    for (int it = gw; it < 24 * 128; it += NGW) {
        const int bh = it >> 7, j = it & 127, b = bh / 12, h = bh % 12;
        const u32x4* kr = (const u32x4*)(K + (size_t)(b * SEQ + 64 * j + F.lane) * 768 + h * 64);
        float ss = 0.f;
#pragma unroll
        for (int c = 0; c < 8; ++c) {
            const u32x4 w = kr[c];
            const unsigned ww[4] = {w.x, w.y, w.z, w.w};
#pragma unroll
            for (int i = 0; i < 4; ++i) { const float a = __uint_as_float(ww[i] << 16), bb = __uint_as_float(ww[i] & 0xffff0000u); ss += a * a + bb * bb; }
        }
        ss = wave_max(ss);
        if (F.lane == 0) kn2[it] = ss;
    }
}

DI void mem_attn_unit(Frame& F, int l, int v) {
    unsigned char* ws = F.ws;
    const int qb = v >> 3, bm = v & 7, b = bm >> 2, mh = bm & 3;
    const bf16_t* Q = (const bf16_t*)(ws + WS_MQ) + (size_t)b * SEQ * 256 + mh * 64;
    const bf16_t* K = (const bf16_t*)(ws + WS_MK) + (size_t)l * 512 * 256 + (size_t)b * 256 * 256 + mh * 64;
    const bf16_t* Vt = (const bf16_t*)(ws + WS_MVT) + (size_t)(l * 2 + b) * 256 * 256 + (size_t)mh * 64 * 256;
    bf16_t* O = (bf16_t*)(ws + WS_MERGED) + (size_t)b * SEQ * 1024 + 768 + mh * 64;
    attn_unit<64, false, false>(F.lds, Q, 256, K, 256, Vt, 256, nullptr, O, 1024, qb * 256, 4, false, nullptr, F.wid);
}
DI void phase_attn0(Frame& F, const Params& P) {
    F.lane = vlane(); F.tid = F.wid * 64 + F.lane;
    unsigned char* ws = F.ws;
    constexpr int NU = 768 + 256 + 512;
    for (;;) {
        const int uu = next_unit(F, 0);
        if (uu >= NU) break;
        if (uu % 3 == 2) { conv_pull(F, 0, CONV_A0); continue; }
        const int u = 2 * (uu / 3) + uu % 3;
        if (u < 768) {
            const int qb = 31 - u / 24, bh = u % 24, b = bh / 12, h = bh % 12;
            const bf16_t* Q = (const bf16_t*)(ws + WS_Q) + (size_t)b * SEQ * 768 + h * 64;
            const bf16_t* K = (const bf16_t*)(ws + WS_K) + (size_t)b * SEQ * 768 + h * 64;
            const bf16_t* Vt = (const bf16_t*)(ws + WS_VT) + (size_t)(b * 768 + h * 64) * SEQ;
            const float* cum = (const float*)(ws + WS_CUM) + (size_t)bh * SEQ;
            bf16_t* O = (bf16_t*)(ws + WS_MERGED) + (size_t)b * SEQ * 1024 + h * 64;
            attn_unit<64, true, false>(F.lds, Q, 768, K, 768, Vt, SEQ, cum, O, 1024, qb * 256, 4 * (qb + 1), true, nullptr, F.wid, (const float*)(ws + WS_KN2) + bh * 128);
        } else mem_attn_unit(F, 0, u - 768);
    }
    while (conv_pull(F, 0, 16)) {}
}
DI void phase_attn1(Frame& F, const Params& P) {
    F.lane = vlane(); F.tid = F.wid * 64 + F.lane;
    unsigned char* ws = F.ws;
    constexpr int NCONV = 256, NU = 768 + 256 + NCONV;
    for (;;) {
        const int uu = next_unit(F, 1);
        if (uu >= NU) break;
        if (uu % 5 == 4) { conv_pull(F, 1, CONV_A1); continue; }
        const int u = 4 * (uu / 5) + uu % 5;
        if (u < 768) {
            const int qb = 31 - u / 24, bh = u % 24, b = bh / 12, h = bh % 12;
            const bf16_t* Q = (const bf16_t*)(ws + WS_Q) + (size_t)b * SEQ * 1152 + h * 96;
            const bf16_t* K = (const bf16_t*)(ws + WS_K) + (size_t)b * SEQ * 1152 + h * 96;
            const bf16_t* Vt = (const bf16_t*)(ws + WS_VT) + (size_t)(b * 768 + h * 64) * SEQ;
            bf16_t* O = (bf16_t*)(ws + WS_MERGED) + (size_t)b * SEQ * 1024 + h * 64;
            attn_unit_pipe<96, true>(F.lds, Q, 1152, K, 1152, Vt, SEQ, O, 1024, qb * 256, 4 * (qb + 1), KP->pos + (size_t)b * SEQ, F.wid);
        } else mem_attn_unit(F, 1, u - 768);
    }
    while (conv_pull(F, 1, 16)) {}
}

DI void phase_outproj(Frame& F, const float* X, const bf16_t* Wt) {
    F.lane = vlane(); F.tid = F.wid * 64 + F.lane;
    unsigned char* ws = F.ws;
    pg8::Gemm g{(const bf16_t*)(ws + WS_MERGED), Wt, 1024}; pg8::StaticOrder S; S.init(T, 1024, 1024, F.G, F.bid);
    EpiResF32 E{(float*)(ws + WS_Y), X};
    pg8::gemm_phase<EpiResF32, pg8::StaticOrder, false>(F.lds, g, S, E, F.wid);
}


DI void phase_ln_router(Frame& F, const Params& P, int l) {
    F.lane = vlane(); F.tid = F.wid * 64 + F.lane;
    unsigned char* ws = F.ws;
    LAS unsigned char* wH = F.lds;
    LAS unsigned char* wL = F.lds + 65536;
    LAS int* pairs = (LAS int*)(F.lds + LDS_CTL + 1024);
    LAS int* lcnt = (LAS int*)(F.lds + LDS_CTL + 3072); LAS int* gbase = lcnt + 32;
    LAS float* lg = (LAS float*)(F.lds + LDS_R1X + F.wid * 1280);
    LAS int* rec = (LAS int*)(F.lds + LDS_R1X + F.wid * 1280 + 1024);
    LAS float* stt = (LAS float*)(F.lds + LDS_R1X + 8 * 1280 + F.wid * 64);
    __syncthreads();
    {
        const u32x4* srcH = (const u32x4*)((const bf16_t*)(ws + WS_WRH) + (size_t)l * 32 * 1024);
        const u32x4* srcL = (const u32x4*)((const bf16_t*)(ws + WS_WRL) + (size_t)l * 32 * 1024);
        for (int i = F.tid; i < 32 * 128; i += NTHREADS) { const int e = i >> 7, c = i & 127; const int off = e * 2048 + ((c ^ (e & 7)) << 4);
            *(LAS u32x4*)(wH + off) = srcH[i]; *(LAS u32x4*)(wL + off) = srcL[i]; }
    }
    if (F.tid < 32) lcnt[F.tid] = 0;
    __syncthreads();
    const float* g = KP->ln_g + (size_t)(l * 2 + 0) * DM; const float* bt = KP->ln_b + (size_t)(l * 2 + 0) * DM;
    const float* br = KP->moe_b_r + l * 32;
    const float* Y = (const float*)(ws + WS_Y);
    unsigned char* X1Q = ws + WS_X1B;
    float* SAS = (float*)(ws + WS_SAS);
    int* PE = (int*)(ws + WS_PE); int* PPOS = (int*)(ws + WS_PPOS); float* GATE = (float*)(ws + WS_GATE); int* TOKOF = (int*)(ws + WS_TOKOF);
    unsigned* cnt = F.ctl + CW_CNT + l * 32 * 64;
    const int gw = F.bid * 8 + F.wid, NGW = F.G * 8;
    int it = 0;
    f32x4 vnx[4];
    if (gw < T) {
#pragma unroll
        for (int j = 0; j < 4; ++j) vnx[j] = *((const f32x4*)(Y + (size_t)gw * DM) + F.lane + 64 * j);
    }
    for (int row = gw; row < T; row += NGW, ++it) {
        f32x4 v[4]; float s = 0.f;
#pragma unroll
        for (int j = 0; j < 4; ++j) { v[j] = vnx[j]; s += (v[j][0] + v[j][1]) + (v[j][2] + v[j][3]); }
        if (row + NGW < T) {
#pragma unroll
            for (int j = 0; j < 4; ++j) vnx[j] = *((const f32x4*)(Y + (size_t)(row + NGW) * DM) + F.lane + 64 * j);
        }
        const float mean = wave_sum(s) * (1.f / DM); float s2 = 0.f;
#pragma unroll
        for (int j = 0; j < 4; ++j) { v[j] = v[j] - mean; s2 += (v[j][0] * v[j][0] + v[j][1] * v[j][1]) + (v[j][2] * v[j][2] + v[j][3] * v[j][3]); }
        const float rstd = 1.0f / sqrtf(wave_sum(s2) * (1.f / DM) + LN_EPS);
        float am = 0.f;
#pragma unroll
        for (int j = 0; j < 4; ++j) {
            const f32x4 gg = *((const f32x4*)g + F.lane + 64 * j), bb = *((const f32x4*)bt + F.lane + 64 * j);
            v[j] = v[j] * rstd * gg + bb;
            am = fmaxf(fmaxf(am, fmaxf(fabsf(v[j][0]), fabsf(v[j][1]))), fmaxf(fabsf(v[j][2]), fabsf(v[j][3])));
        }
        am = wave_max(am);
        const float qinv = am > 0.f ? 127.0f / am : 0.f;
#pragma unroll
        for (int j = 0; j < 4; ++j) *((unsigned*)(X1Q + (size_t)row * DM) + F.lane + 64 * j) = q8x4(v[j][0], v[j][1], v[j][2], v[j][3], qinv);
        if (F.lane == 0) { stt[2 * (it & 7)] = mean; stt[2 * (it & 7) + 1] = rstd; pairs[(F.wid * 16 + 8 + (it & 7)) * 4] = (int)__float_as_uint(am * (1.0f / 127.0f)); }
    }
    asm volatile("s_waitcnt lgkmcnt(0)" ::: "memory");
    {
        const int r16 = F.lane & 15, kg = F.lane >> 4;
        const int arow = gw + NGW * (r16 & 7);
        const float mean = stt[2 * (r16 & 7)], rstd = stt[2 * (r16 & 7) + 1];
        const float* yr = Y + (size_t)(arow < T ? arow : gw) * DM + 8 * kg;
        const float* gp = g + 8 * kg; const float* bp = bt + 8 * kg;
        f32x4 acc0 = (f32x4){0.f, 0.f, 0.f, 0.f}, acc1 = (f32x4){0.f, 0.f, 0.f, 0.f};
        const int e0 = r16, e1 = 16 + r16;
        const int b0off = e0 * 2048, b1off = e1 * 2048, sw = r16 & 7;
#pragma unroll 4
        for (int s2 = 0; s2 < 32; ++s2) {
            const f32x4 y0 = *(const f32x4*)(yr + 32 * s2), y1 = *(const f32x4*)(yr + 32 * s2 + 4);
            const f32x4 g0 = *(const f32x4*)(gp + 32 * s2), g1 = *(const f32x4*)(gp + 32 * s2 + 4);
            const f32x4 c0 = *(const f32x4*)(bp + 32 * s2), c1 = *(const f32x4*)(bp + 32 * s2 + 4);
            const f32x4 x0 = (y0 - mean) * rstd * g0 + c0, x1 = (y1 - mean) * rstd * g1 + c1;
            u32x4 ah, al;
            ah.x = cvtpk(x0[0], x0[1]); ah.y = cvtpk(x0[2], x0[3]); ah.z = cvtpk(x1[0], x1[1]); ah.w = cvtpk(x1[2], x1[3]);
            al.x = cvtpk(x0[0] - __uint_as_float(ah.x << 16), x0[1] - __uint_as_float(ah.x & 0xffff0000u)); al.y = cvtpk(x0[2] - __uint_as_float(ah.y << 16), x0[3] - __uint_as_float(ah.y & 0xffff0000u));
            al.z = cvtpk(x1[0] - __uint_as_float(ah.z << 16), x1[1] - __uint_as_float(ah.z & 0xffff0000u)); al.w = cvtpk(x1[2] - __uint_as_float(ah.w << 16), x1[3] - __uint_as_float(ah.w & 0xffff0000u));
            const bf16x8 Ah = __builtin_bit_cast(bf16x8, ah), Al = __builtin_bit_cast(bf16x8, al);
            const int co = (((4 * s2 + kg) ^ sw) << 4);
            const bf16x8 Bh0 = *(const LAS bf16x8*)(wH + b0off + co), Bl0 = *(const LAS bf16x8*)(wL + b0off + co);
            const bf16x8 Bh1 = *(const LAS bf16x8*)(wH + b1off + co), Bl1 = *(const LAS bf16x8*)(wL + b1off + co);
            acc0 = __builtin_amdgcn_mfma_f32_16x16x32_bf16(Ah, Bh0, acc0, 0, 0, 0); acc0 = __builtin_amdgcn_mfma_f32_16x16x32_bf16(Al, Bh0, acc0, 0, 0, 0); acc0 = __builtin_amdgcn_mfma_f32_16x16x32_bf16(Ah, Bl0, acc0, 0, 0, 0);
            acc1 = __builtin_amdgcn_mfma_f32_16x16x32_bf16(Ah, Bh1, acc1, 0, 0, 0); acc1 = __builtin_amdgcn_mfma_f32_16x16x32_bf16(Al, Bh1, acc1, 0, 0, 0); acc1 = __builtin_amdgcn_mfma_f32_16x16x32_bf16(Ah, Bl1, acc1, 0, 0, 0);
        }
        if (kg < 2) {
            const float bb0 = br[e0], bb1 = br[e1];
#pragma unroll
            for (int r = 0; r < 4; ++r) { lg[(4 * kg + r) * 32 + e0] = acc0[r] + bb0; lg[(4 * kg + r) * 32 + e1] = acc1[r] + bb1; }
        }
        asm volatile("s_waitcnt lgkmcnt(0)" ::: "memory");
        const int rr = F.lane >> 3, sub = F.lane & 7;
        f32x4 vv[8];
#pragma unroll
        for (int q = 0; q < 8; ++q) vv[q] = *(const LAS f32x4*)(lg + rr * 32 + 4 * q);
        const f32x4 mine = *(const LAS f32x4*)(lg + rr * 32 + 4 * sub);
        int rk[4] = {0, 0, 0, 0};
#pragma unroll
        for (int q = 0; q < 8; ++q)
#pragma unroll
            for (int i = 0; i < 4; ++i) {
                const float ve = vv[q][i]; const int ee = 4 * q + i;
#pragma unroll
                for (int c = 0; c < 4; ++c) rk[c] += (ve > mine[c] || (ve == mine[c] && ee < 4 * sub + c)) ? 1 : 0;
            }
#pragma unroll
        for (int c = 0; c < 4; ++c) if (rk[c] < 4) { rec[(rr * 4 + rk[c]) * 2] = 4 * sub + c; rec[(rr * 4 + rk[c]) * 2 + 1] = (int)__float_as_uint(mine[c]); }
        asm volatile("s_waitcnt lgkmcnt(0)" ::: "memory");
        const int te0 = rec[(rr * 4 + 0) * 2], te1 = rec[(rr * 4 + 1) * 2], te2 = rec[(rr * 4 + 2) * 2], te3 = rec[(rr * 4 + 3) * 2];
        const float tv0 = __uint_as_float((unsigned)rec[(rr * 4 + 0) * 2 + 1]), tv1 = __uint_as_float((unsigned)rec[(rr * 4 + 1) * 2 + 1]);
        const float tv2 = __uint_as_float((unsigned)rec[(rr * 4 + 2) * 2 + 1]), tv3 = __uint_as_float((unsigned)rec[(rr * 4 + 3) * 2 + 1]);
        const float e1_ = __expf(tv1 - tv0), e2_ = __expf(tv2 - tv0), e3_ = __expf(tv3 - tv0);
        const float rs = 1.0f / (1.0f + e1_ + e2_ + e3_);
        const int row = gw + NGW * rr;
        if (sub < 4 && row < T) {
            const int k = sub;
            const int e = k == 0 ? te0 : k == 1 ? te1 : k == 2 ? te2 : te3;
            const float gt = (k == 0 ? 1.0f : k == 1 ? e1_ : k == 2 ? e2_ : e3_) * rs;
            const int rnk = __hip_atomic_fetch_add(lcnt + e, 1, __ATOMIC_RELAXED, __HIP_MEMORY_SCOPE_WORKGROUP);
            PE[row * 4 + k] = e; GATE[row * 4 + k] = gt; pairs[(F.wid * 16 + rr) * 4 + k] = e | (rnk << 8);
        }
    }
    __syncthreads();
    if (F.tid < 32) { const int c = lcnt[F.tid]; gbase[F.tid] = c ? (int)atomicAdd(cnt + F.tid * 64, (unsigned)c) : 0; }
    __syncthreads();
    it = 0;
    for (int row = gw; row < T; row += NGW, ++it) {
        if (F.lane < 4) {
            const int pr = pairs[(F.wid * 16 + (it & 15)) * 4 + F.lane], e = pr & 255, p = gbase[e] + (pr >> 8);
            PPOS[row * 4 + F.lane] = p; TOKOF[(size_t)e * T + p] = row; SAS[(size_t)e * T + p] = __uint_as_float((unsigned)pairs[(F.wid * 16 + 8 + (it & 7)) * 4]);
        }
    }
}

DI void moe_tables(Frame& F, int l, LAS int* tstart, LAS int* soff) {
    __syncthreads();
    if (F.tid == 0) {
        int ts = 0;
        for (int e = 0; e < 32; ++e) {
            const int c = (int)__hip_atomic_load(F.ctl + CW_CNT + (l * 32 + e) * 64, __ATOMIC_RELAXED, __HIP_MEMORY_SCOPE_AGENT);
            tstart[e] = ts; soff[e] = ts * 256; tstart[80 + e] = c; ts += (c + 255) >> 8;
        }
        tstart[32] = ts; soff[32] = ts * 256;
    }
    __syncthreads();
}
DI void phase_moe_gu(Frame& F, const Params& P, int l) {
    F.lane = vlane(); F.tid = F.wid * 64 + F.lane;
    unsigned char* ws = F.ws;
    LAS int* tstart = (LAS int*)(F.lds + LDS_CTL + 64); LAS int* soff = tstart + 40;
    moe_tables(F, l, tstart, soff);
    pg8::Gemm g{(const bf16_t*)(ws + WS_X1B), (const bf16_t*)(ws + WS_W_GU + (size_t)l * 32 * 2048 * 1024), 512};
    LAS int* ulist = (LAS int*)(F.lds + LDS_CTL + 3328);
    MoeOrder::build(F, tstart, 8, ulist);
    MoeOrder S{tstart, 3, true, (const int*)(ws + WS_TOKOF), (const LAS int*)(F.lds + LDS_CTL + 1024), ulist, 1024u};
    EpiGU E{ws + WS_H, KP->moe_b_gu + (size_t)l * 32 * 2048, (const float*)(ws + WS_SGU) + (size_t)l * 32 * 2048, (const float*)(ws + WS_SAS), tstart};
    pg8::gemm_phase<EpiGU, MoeOrder, true, 1>(F.lds, g, S, E, F.wid);
    if (l == 0) { const int rem = (tstart[32] * 8) % F.G; if (rem && F.bid >= rem) conv_pull(F, 1, CONV_GU); }
}
DI void phase_moe_dn(Frame& F, const Params& P, int l) {
    F.lane = vlane(); F.tid = F.wid * 64 + F.lane;
    unsigned char* ws = F.ws;
    LAS int* tstart = (LAS int*)(F.lds + LDS_CTL + 64); LAS int* soff = tstart + 40;
    moe_tables(F, l, tstart, soff);
    pg8::Gemm g{(const bf16_t*)(ws + WS_H), (const bf16_t*)(ws + WS_W_DN + (size_t)l * 32 * 1024 * 1024), 512};
    LAS int* ulist = (LAS int*)(F.lds + LDS_CTL + 3328);
    MoeOrder::build(F, tstart, 4, ulist);
    MoeOrderDN S{ulist};
    EpiDN E{(bf16_t*)(ws + WS_YE), KP->moe_b_dn + (size_t)l * 32 * 1024, (const float*)(ws + WS_SDN) + (size_t)l * 32 * 1024};
    pg8::gemm_phase<EpiDN, MoeOrderDN, true, 2>(F.lds, g, S, E, F.wid);
    F.lane = vlane(); F.tid = F.wid * 64 + F.lane;
    if (l == 0) { const int rem = (tstart[32] * 4) % F.G; if (rem && F.bid >= rem) conv_pull(F, 1, CONV_DN); }
}


DI void phase_combine(Frame& F, const Params& P, int l, float* outf, bf16_t* outb) {
    F.lane = vlane(); F.tid = F.wid * 64 + F.lane;
    unsigned char* ws = F.ws;
    LAS int* tstart = (LAS int*)(F.lds + LDS_CTL + 64); LAS int* soff = tstart + 40;
    moe_tables(F, l, tstart, soff);
    const float* g = KP->ln_g + (size_t)(l * 2 + 1) * DM; const float* bt = KP->ln_b + (size_t)(l * 2 + 1) * DM;
    const float* X1 = (const float*)(ws + WS_Y); const bf16_t* YE = (const bf16_t*)(ws + WS_YE);
    const float* g1 = KP->ln_g + (size_t)(l * 2 + 0) * DM; const float* b1 = KP->ln_b + (size_t)(l * 2 + 0) * DM;
    const int* PE = (const int*)(ws + WS_PE); const int* PPOS = (const int*)(ws + WS_PPOS); const float* GATE = (const float*)(ws + WS_GATE);
    const int gw = F.bid * 8 + F.wid, NGW = F.G * 8;
    i32x4 ie, ip; f32x4 ig;
    f32x4 xn[4]; u32x2 yn[4][4]; f32x4 gn;
#define CB_LOADIDX(r) do { ie = *(const i32x4*)(PE + (size_t)(r) * 4); ip = *(const i32x4*)(PPOS + (size_t)(r) * 4); ig = *(const f32x4*)(GATE + (size_t)(r) * 4); } while (0)
#define CB_LOADDATA(r) do { gn = ig; \
        _Pragma("unroll") for (int j = 0; j < 4; ++j) xn[j] = *((const f32x4*)(X1 + (size_t)(r) * DM) + F.lane + 64 * j); \
        _Pragma("unroll") for (int k = 0; k < 4; ++k) { const int slot = soff[ie[k]] + ip[k]; const u32x2* yr = (const u32x2*)(YE + (size_t)slot * 1024) + F.lane; \
            _Pragma("unroll") for (int j = 0; j < 4; ++j) yn[k][j] = yr[64 * j]; } } while (0)
    if (gw < T) { CB_LOADIDX(gw); CB_LOADDATA(gw); if (gw + NGW < T) CB_LOADIDX(gw + NGW); }
    for (int row = gw; row < T; row += NGW) {
        f32x4 v[4]; u32x2 yc[4][4]; f32x4 gc = gn;
        {
            float s0 = 0.f;
#pragma unroll
            for (int j = 0; j < 4; ++j) { v[j] = xn[j]; s0 += (v[j][0] + v[j][1]) + (v[j][2] + v[j][3]); }
            const float mean0 = wave_sum(s0) * (1.f / DM); float q0 = 0.f;
#pragma unroll
            for (int j = 0; j < 4; ++j) { v[j] = v[j] - mean0; q0 += (v[j][0] * v[j][0] + v[j][1] * v[j][1]) + (v[j][2] * v[j][2] + v[j][3] * v[j][3]); }
            const float rstd0 = 1.0f / sqrtf(wave_sum(q0) * (1.f / DM) + LN_EPS);
#pragma unroll
            for (int j = 0; j < 4; ++j) {
                const f32x4 gg = *((const f32x4*)g1 + F.lane + 64 * j), bb = *((const f32x4*)b1 + F.lane + 64 * j);
                v[j] = (v[j] * rstd0 * gg + bb) * ALPHA;
            }
        }
#pragma unroll
        for (int k = 0; k < 4; ++k)
#pragma unroll
            for (int j = 0; j < 4; ++j) yc[k][j] = yn[k][j];
        if (row + NGW < T) { CB_LOADDATA(row + NGW); if (row + 2 * NGW < T) CB_LOADIDX(row + 2 * NGW); }
#pragma unroll
        for (int k = 0; k < 4; ++k) {
            const float gt = gc[k];
#pragma unroll
            for (int j = 0; j < 4; ++j) {
                const u32x2 w = yc[k][j];
                v[j][0] += gt * __uint_as_float(w.x << 16); v[j][1] += gt * __uint_as_float(w.x & 0xffff0000u);
                v[j][2] += gt * __uint_as_float(w.y << 16); v[j][3] += gt * __uint_as_float(w.y & 0xffff0000u);
            }
        }
        float s = 0.f;
#pragma unroll
        for (int j = 0; j < 4; ++j) s += (v[j][0] + v[j][1]) + (v[j][2] + v[j][3]);
        const float mean = wave_sum(s) * (1.f / DM); float s2 = 0.f;
#pragma unroll
        for (int j = 0; j < 4; ++j) { v[j] = v[j] - mean; s2 += (v[j][0] * v[j][0] + v[j][1] * v[j][1]) + (v[j][2] * v[j][2] + v[j][3] * v[j][3]); }
        const float rstd = 1.0f / sqrtf(wave_sum(s2) * (1.f / DM) + LN_EPS);
#pragma unroll
        for (int j = 0; j < 4; ++j) {
            const f32x4 gg = *((const f32x4*)g + F.lane + 64 * j), bb = *((const f32x4*)bt + F.lane + 64 * j);
            v[j] = v[j] * rstd * gg + bb;
            *((f32x4*)(outf + (size_t)row * DM) + F.lane + 64 * j) = v[j];
            if (outb) *((u32x2*)(outb + (size_t)row * DM) + F.lane + 64 * j) = (u32x2){cvtpk(v[j][0], v[j][1]), cvtpk(v[j][2], v[j][3])};
        }
    }
#undef CB_LOADIDX
#undef CB_LOADDATA
}

DI void phase_lat(Frame& F) {
    F.lane = vlane(); F.tid = F.wid * 64 + F.lane;
    unsigned char* ws = F.ws;
    pg8::Gemm g{(const bf16_t*)(ws + WS_XB), (const bf16_t*)(ws + WS_W_BIN), 1024}; pg8::StaticOrder S; S.init(T, 1024, 1024, F.G, F.bid);
    EpiLat E{(float*)(ws + WS_LAT), 928};
    pg8::gemm_phase<EpiLat, pg8::StaticOrder, false>(F.lds, g, S, E, F.wid);
}

DI void phase_latrows(Frame& F, const Params& P) {
    F.lane = vlane(); F.tid = F.wid * 64 + F.lane;
    unsigned char* ws = F.ws;
    const float* LAT = (const float*)(ws + WS_LAT);
    bf16_t* CKV = (bf16_t*)(ws + WS_CKV); bf16_t* CQ = (bf16_t*)(ws + WS_CQ); bf16_t* MQ = (bf16_t*)(ws + WS_MQ); bf16_t* Kb = (bf16_t*)(ws + WS_K);
    const int gw = F.bid * 8 + F.wid, NGW = F.G * 8;
    for (int row = gw; row < T; row += NGW) {
        const float* lr = LAT + (size_t)row * 1024;
        {
            const f32x4 v = *((const f32x4*)lr + F.lane);
            const float ss = wave_sum((v[0] * v[0] + v[1] * v[1]) + (v[2] * v[2] + v[3] * v[3]));
            const float rs = 1.0f / sqrtf(ss * (1.f / 256.f) + RMS_EPS);
            const f32x4 gg = *((const f32x4*)KP->kv_g + F.lane);
            const f32x4 o = v * rs * gg;
            *((u32x2*)(CKV + (size_t)row * 256) + F.lane) = (u32x2){cvtpk(o[0], o[1]), cvtpk(o[2], o[3])};
        }
        {
            const f32x4 v0 = *((const f32x4*)(lr + 288) + F.lane);
            f32x4 v1 = (f32x4){0.f, 0.f, 0.f, 0.f};
            if (F.lane < 32) v1 = *((const f32x4*)(lr + 288 + 256) + F.lane);
            const float ss = wave_sum((v0[0] * v0[0] + v0[1] * v0[1]) + (v0[2] * v0[2] + v0[3] * v0[3]) + (v1[0] * v1[0] + v1[1] * v1[1]) + (v1[2] * v1[2] + v1[3] * v1[3]));
            const float rs = 1.0f / sqrtf(ss * (1.f / 384.f) + RMS_EPS);
            const f32x4 g0 = *((const f32x4*)KP->b_g_q + F.lane);
            const f32x4 o0 = v0 * rs * g0;
            *((u32x2*)(CQ + (size_t)row * 384) + F.lane) = (u32x2){cvtpk(o0[0], o0[1]), cvtpk(o0[2], o0[3])};
            if (F.lane < 32) {
                const f32x4 g1 = *((const f32x4*)(KP->b_g_q + 256) + F.lane);
                const f32x4 o1 = v1 * rs * g1;
                *((u32x2*)(CQ + (size_t)row * 384 + 256) + F.lane) = (u32x2){cvtpk(o1[0], o1[1]), cvtpk(o1[2], o1[3])};
            }
        }
        {
            const f32x4 v = *((const f32x4*)(lr + 672) + F.lane) * (0.125f * LOG2E);
            *((u32x2*)(MQ + (size_t)row * 256) + F.lane) = (u32x2){cvtpk(v[0], v[1]), cvtpk(v[2], v[3])};
        }
        if (F.lane < 16) {
            const int i = F.lane;
            const float p = (float)KP->pos[row];
            const float inv = exp2f(-(float)i * (13.287712379549449f / 16.0f));
            float sn, cs; sincos_cw(p * inv, sn, cs);
            const float x1 = lr[256 + i], x2 = lr[256 + 16 + i];
            const unsigned short o1 = (unsigned short)(cvtpk(x1 * cs - x2 * sn, 0.f) & 0xffffu), o2 = (unsigned short)(cvtpk(x1 * sn + x2 * cs, 0.f) & 0xffffu);
#pragma unroll
            for (int h = 0; h < NH; ++h) { Kb[(size_t)row * 1152 + h * 96 + 64 + i] = o1; Kb[(size_t)row * 1152 + h * 96 + 80 + i] = o2; }
        }
    }
}
#ifndef UPSEL
#define UPSEL 7
#endif
struct RouteK1 { unsigned char* ws; DI Dst operator()(const pg8::Unit& u) const { return Dst{(bf16_t*)(ws + WS_K), 1152, u.pm * 256, u.pn * 384, 256, 1.0f, true}; } };
struct RouteQ1 { unsigned char* ws; DI Dst operator()(const pg8::Unit& u) const { const int nv = 1152 - u.pn * 256; return Dst{(bf16_t*)(ws + WS_Q), 1152, u.pm * 256, u.pn * 256, nv < 256 ? nv : 256, 0.10206207261596577f * LOG2E, false}; } };
DI void phase_up1(Frame& F) {
    F.lane = vlane(); F.tid = F.wid * 64 + F.lane;
    unsigned char* ws = F.ws;
    const bf16_t* ckv = (const bf16_t*)(ws + WS_CKV); const bf16_t* cq = (const bf16_t*)(ws + WS_CQ);
    const bf16_t* wukv = (const bf16_t*)(ws + WS_W_UKV); const bf16_t* wuq = (const bf16_t*)(ws + WS_W_UQ);
#if (UPSEL & 1)
    {
        pg8::Gemm g{cq, wuq, 384}; pg8::StaticOrder S; S.init(T, 1280, 384, F.G, F.bid);
        EpiBf16R<RouteQ1> E{RouteQ1{ws}};
        pg8::gemm_phase<EpiBf16R<RouteQ1>, pg8::StaticOrder, true>(F.lds, g, S, E, F.wid);
    }
#endif
#if (UPSEL & 2)
    {
        pg8::Gemm g{ckv, wukv, 256}; pg8::StaticOrder S; S.init(T, 768, 256, F.G, F.G - 1 - F.bid);
        EpiBf16R<RouteK1> E{RouteK1{ws}};
        pg8::gemm_phase<EpiBf16R<RouteK1>, pg8::StaticOrder, true>(F.lds, g, S, E, F.wid);
    }
#endif
#if (UPSEL & 4)
    {
        pg8::Gemm g{wukv + (size_t)768 * 256, ckv, 256}; pg8::StaticOrder S; S.init(768, T, 256, F.G, F.G - 1 - F.bid);
        EpiBf16R<RouteVT> E{RouteVT{ws}};
        pg8::gemm_phase<EpiBf16R<RouteVT>, pg8::StaticOrder, true>(F.lds, g, S, E, F.wid);
    }
#endif
}


__global__ void __launch_bounds__(NTHREADS) mega_fwd(Params P) {
    extern __shared__ __attribute__((aligned(16))) unsigned char lds_raw[];
    Frame F;
    F.lds = (LAS unsigned char*)lds_raw; F.ws = KP->ws; F.ctl = (unsigned*)(KP->ws + WS_CTL);
    F.wid = __builtin_amdgcn_readfirstlane((int)threadIdx.x >> 6); F.lane = vlane(); F.tid = F.wid * 64 + F.lane; F.G = gridDim.x; F.bid = blockIdx.x;
    const int lo = KP->ph_lo, hi = KP->ph_hi;
    { volatile LAS unsigned* st0 = (volatile LAS unsigned*)(F.lds + LDS_CTL + 512); if (F.tid < 2) st0[F.tid] = 0u; }
    __syncthreads();
    XcdBarrier bar = xcd_barrier_post(F.ctl + CW_BAR, (volatile LAS unsigned*)(F.lds + LDS_CTL + 512), F.wid);
#ifndef PHMASK
#define PHMASK 0x1ffff
#endif
#define IN(k) (((PHMASK >> (k)) & 1) && lo <= (k) && (k) < hi)
#define SEAM(k) do { if (IN(k) && IN((k) + 1)) { if (KP->use_grid_sync) { if ((k) == 0) cg::this_grid().sync(); else xcd_barrier(bar); } } } while (0)
    unsigned char* ws = KP->ws;
    if (IN(0)) { phase_prologue(F, P);
    }
    SEAM(0);
    if (IN(1)) { phase_proj0(F, P);
        if (KP->use_grid_sync) xcd_barrier(bar); phase_scan_knorm(F); }
    SEAM(1);
    if (IN(2)) { phase_attn0(F, P);
    }
    SEAM(2);
    if (IN(3)) { phase_outproj(F, KP->x, (const bf16_t*)(ws + WS_W_AOUT));
    }
    SEAM(3);
    if (IN(4)) phase_ln_router(F, P, 0);
    SEAM(4);
    if (IN(5)) phase_moe_gu(F, P, 0);
    SEAM(5);
    if (IN(6)) phase_moe_dn(F, P, 0);
    SEAM(6);
    if (IN(7)) phase_combine(F, P, 0, (float*)(ws + WS_X2), (bf16_t*)(ws + WS_XB));
    SEAM(7);
    if (IN(8)) phase_lat(F);
    SEAM(8);
    if (IN(9)) phase_latrows(F, P);
    SEAM(9);
    if (IN(10)) { phase_up1(F);
    }
    SEAM(10);
    if (IN(11)) { phase_attn1(F, P);
    }
    SEAM(11);
    if (IN(12)) phase_outproj(F, (const float*)(ws + WS_X2), (const bf16_t*)(ws + WS_W_BOUT));
    SEAM(12);
    if (IN(13)) phase_ln_router(F, P, 1);
    SEAM(13);
    if (IN(14)) { phase_moe_gu(F, P, 1);
    }
    SEAM(14);
    if (IN(15)) { phase_moe_dn(F, P, 1);
    }
    SEAM(15);
    if (IN(16)) { phase_combine(F, P, 1, KP->out, nullptr);
    }
#undef IN
#undef SEAM
}

constexpr int N_PHASES = 17;
#ifndef MK_N_LAUNCHES
#define MK_N_LAUNCHES 1
#endif

extern "C" void kernel_launch(void* const* d_in, const int* in_sizes, int n_in, void* d_out, int out_size, void* d_ws, size_t ws_size, hipStream_t stream) {
    static int grid = 0;
    if (grid == 0) {
        if (n_in != 22 || ws_size < WS_END) { fprintf(stderr, "kernel_launch: need 22 inputs and %zu bytes of workspace (got %d, %zu)\n", (size_t)WS_END, n_in, ws_size); grid = -1; return; }
        int dev = 0, cus = 0, per_cu = 0;
        hipGetDevice(&dev);
        hipDeviceGetAttribute(&cus, hipDeviceAttributeMultiprocessorCount, dev);
        if (hipFuncSetAttribute((const void*)mega_fwd, hipFuncAttributeMaxDynamicSharedMemorySize, LDS_BYTES) != hipSuccess) fprintf(stderr, "kernel_launch: hipFuncSetAttribute failed\n");
        if (hipOccupancyMaxActiveBlocksPerMultiprocessor(&per_cu, (const void*)mega_fwd, NTHREADS, LDS_BYTES) != hipSuccess || per_cu < 1) { fprintf(stderr, "kernel_launch: occupancy query failed (%d)\n", per_cu); per_cu = 1; }
        (void)hipGetLastError();
        grid = cus * (per_cu > 1 ? 1 : per_cu);
        if (grid <= 0) grid = 256;
        if (grid != 256) fprintf(stderr, "kernel_launch: built for a 256-CU device (one workgroup per CU); got %d\n", grid);
    }
    if (grid < 0) return;
    hipMemsetAsync((char*)d_ws + WS_CTL, 0, CTL_BYTES, stream);
    Params p{};
    p.x = (const float*)d_in[0]; p.mem = (const float*)d_in[1]; p.pos = (const int*)d_in[2];
    p.a_w_in = (const float*)d_in[3]; p.a_b_f = (const float*)d_in[4]; p.a_w_out = (const float*)d_in[5];
    p.b_w_in = (const float*)d_in[6]; p.b_g_q = (const float*)d_in[7]; p.b_w_uq = (const float*)d_in[8]; p.b_w_out = (const float*)d_in[9];
    p.kv_w_dkv = (const float*)d_in[10]; p.kv_g = (const float*)d_in[11]; p.kv_w_ukv = (const float*)d_in[12]; p.mem_w_kv = (const float*)d_in[13];
    p.ln_g = (const float*)d_in[14]; p.ln_b = (const float*)d_in[15]; p.moe_w_r = (const float*)d_in[16]; p.moe_b_r = (const float*)d_in[17];
    p.moe_w_gu = (const float*)d_in[18]; p.moe_b_gu = (const float*)d_in[19]; p.moe_w_dn = (const float*)d_in[20]; p.moe_b_dn = (const float*)d_in[21];
    p.out = (float*)d_out; p.ws = (unsigned char*)d_ws;
    if (MK_N_LAUNCHES == 1) {
        p.ph_lo = 0; p.ph_hi = N_PHASES; p.use_grid_sync = 1;
        void* args[] = {&p};
        hipError_t e = hipLaunchCooperativeKernel((const void*)mega_fwd, dim3(grid), dim3(NTHREADS), args, LDS_BYTES, stream);
        if (e != hipSuccess) fprintf(stderr, "kernel_launch: cooperative launch failed: %s (grid %d)\n", hipGetErrorString(e), grid);
    } else {
        for (int ph = 0; ph < N_PHASES; ++ph) {
            p.ph_lo = ph; p.ph_hi = ph + 1; p.use_grid_sync = 0;
            hipLaunchKernelGGL(mega_fwd, dim3(grid), dim3(NTHREADS), LDS_BYTES, stream, p);
        }
    }
}
```

```cpp
#include <hip/hip_runtime.h>
#include <hip/hip_cooperative_groups.h>
#include <cstdio>
#include <cstdint>
#include <cmath>
namespace cg = cooperative_groups;

#define DI __device__ __forceinline__
#define LAS __attribute__((address_space(3)))
typedef unsigned short bf16_t;
typedef short bf16x8 __attribute__((ext_vector_type(8)));
typedef float f32x4 __attribute__((ext_vector_type(4)));
typedef float f32x2 __attribute__((ext_vector_type(2)));
typedef float f32x16 __attribute__((ext_vector_type(16)));
typedef unsigned u32x4 __attribute__((ext_vector_type(4)));
typedef unsigned u32x2 __attribute__((ext_vector_type(2)));
typedef int i32x4 __attribute__((ext_vector_type(4)));
typedef int i32x8 __attribute__((ext_vector_type(8)));
typedef long i64x4 __attribute__((ext_vector_type(4)));
typedef __bf16 bf16x2_t __attribute__((ext_vector_type(2)));

constexpr int NB = 2, SEQ = 8192, T = NB * SEQ, DM = 1024;
constexpr int NH = 12, NMEM = 256;
constexpr int FOX_IN = 2572;
constexpr int NE = 32;
constexpr float LOG2E = 1.4426950408889634f;
constexpr float ALPHA = 1.4142135623730951f;
constexpr float LN_EPS = 1e-5f, RMS_EPS = 1e-6f;
constexpr int NTHREADS = 512;
constexpr int LDS_BYTES = 131072 + 4096 + 8 * 1280 + 512;
constexpr int LDS_R1X = 131072 + 4096;
constexpr int LDS_CTL = 131072;
constexpr int SLOT_ROWS = 65536 + NE * 256;

constexpr size_t al256(size_t x) { return (x + 255) & ~(size_t)255; }
constexpr size_t WS_CTL = 0, CTL_BYTES = 65536;
constexpr size_t WS_W_AIN = al256(WS_CTL + CTL_BYTES);
constexpr size_t WS_W_AOUT = al256(WS_W_AIN + (size_t)2560 * 1024 * 2);
constexpr size_t WS_W_BIN = al256(WS_W_AOUT + (size_t)1024 * 1024 * 2);
constexpr size_t WS_W_UQ = al256(WS_W_BIN + (size_t)1024 * 1024 * 2);
constexpr size_t WS_W_UKV = al256(WS_W_UQ + (size_t)1280 * 384 * 2);
constexpr size_t WS_W_BOUT = al256(WS_W_UKV + (size_t)1536 * 256 * 2);
constexpr size_t WS_W_MKV = al256(WS_W_BOUT + (size_t)1024 * 1024 * 2);
constexpr size_t WS_W_GU = al256(WS_W_MKV + (size_t)2 * 512 * 1024 * 2);
constexpr size_t WS_W_DN = al256(WS_W_GU + (size_t)2 * 32 * 2048 * 1024 * 2);
constexpr size_t WS_XB = al256(WS_W_DN + (size_t)2 * 32 * 1024 * 1024 * 2);
constexpr size_t WS_MEMB = al256(WS_XB + (size_t)T * 1024 * 2);
constexpr size_t WS_LOGF = al256(WS_MEMB + (size_t)512 * 1024 * 2);
constexpr size_t WS_CUM = al256(WS_LOGF + (size_t)24 * 8192 * 4);
constexpr size_t WS_Q = al256(WS_CUM + (size_t)24 * 8192 * 4);
constexpr size_t WS_K = al256(WS_Q + (size_t)T * 1152 * 2);
constexpr size_t WS_VT = al256(WS_K + (size_t)T * 1152 * 2);
constexpr size_t WS_MQ = al256(WS_VT + (size_t)1536 * 8192 * 2);
constexpr size_t WS_MK = al256(WS_MQ + (size_t)T * 256 * 2);
constexpr size_t WS_MVT = al256(WS_MK + (size_t)2 * 512 * 256 * 2);
constexpr size_t WS_MERGED = al256(WS_MVT + (size_t)2 * 2 * 256 * 256 * 2);
constexpr size_t WS_Y = al256(WS_MERGED + (size_t)T * 1024 * 2);
constexpr size_t WS_X1 = al256(WS_Y + (size_t)T * 1024 * 4);
constexpr size_t WS_X1B = al256(WS_X1 + (size_t)T * 1024 * 4);
constexpr size_t WS_PE = al256(WS_X1B + (size_t)T * 1024 * 2);
constexpr size_t WS_PPOS = al256(WS_PE + (size_t)T * 4 * 4);
constexpr size_t WS_GATE = al256(WS_PPOS + (size_t)T * 4 * 4);
constexpr size_t WS_TOKOF = al256(WS_GATE + (size_t)T * 4 * 4);
constexpr size_t WS_H = al256(WS_TOKOF + (size_t)NE * T * 4);
constexpr size_t WS_YE = al256(WS_H + (size_t)SLOT_ROWS * 1024 * 2);
constexpr size_t WS_LAT = al256(WS_YE + (size_t)SLOT_ROWS * 1024 * 2);
constexpr size_t WS_CKV = al256(WS_LAT + (size_t)T * 1024 * 4);
constexpr size_t WS_CQ = al256(WS_CKV + (size_t)T * 256 * 2);
constexpr size_t WS_X2 = al256(WS_CQ + (size_t)T * 384 * 2);
constexpr size_t WS_KN2 = al256(WS_X2 + (size_t)T * 1024 * 4);
constexpr size_t WS_WRT = al256(WS_KN2 + (size_t)24 * 128 * 4);
constexpr size_t WS_WRH = al256(WS_WRT + (size_t)2 * 32 * 1024 * 4);
constexpr size_t WS_WRL = al256(WS_WRH + (size_t)2 * 32 * 1024 * 2);
constexpr size_t WS_SGU = al256(WS_WRL + (size_t)2 * 32 * 1024 * 2);
constexpr size_t WS_SDN = al256(WS_SGU + (size_t)2 * 32 * 2048 * 4);
constexpr size_t WS_SAS = al256(WS_SDN + (size_t)2 * 32 * 1024 * 4);
constexpr size_t WS_END = al256(WS_SAS + (size_t)NE * T * 4);
constexpr int CW_CNT = 8192;
constexpr int CW_WORK = 256;
constexpr int CW_BAR = 4096;

struct Params {
    const float* x; const float* mem; const int* pos;
    const float *a_w_in, *a_b_f, *a_w_out, *b_w_in, *b_g_q, *b_w_uq, *b_w_out, *kv_w_dkv, *kv_g, *kv_w_ukv, *mem_w_kv, *ln_g, *ln_b;
    const float *moe_w_r, *moe_b_r, *moe_w_gu, *moe_b_gu, *moe_w_dn, *moe_b_dn;
    float* out; unsigned char* ws; int ph_lo, ph_hi; int use_grid_sync, pad;
};

#define KP ((const __attribute__((address_space(4))) Params*)__builtin_amdgcn_kernarg_segment_ptr())
DI unsigned cvtpk(float lo, float hi) { f32x2 v = {lo, hi}; bf16x2_t b = __builtin_convertvector(v, bf16x2_t); return __builtin_bit_cast(unsigned, b); }
DI float bf2f(unsigned short b) { return __uint_as_float(((unsigned)b) << 16); }
DI float wave_sum(float v) {
#pragma unroll
    for (int o = 1; o < 64; o <<= 1) v += __shfl_xor(v, o);
    return v;
}
DI float wave_max(float v) {
#pragma unroll
    for (int o = 1; o < 64; o <<= 1) v = fmaxf(v, __shfl_xor(v, o));
    return v;
}

DI void sincos_cw(float x, float& sn, float& cs) {
    int j = (int)(x * 1.27323954473516f); j = (j + 1) & ~1;
    const float y = (float)j;
    const float r = ((x - y * 0.78515625f) - y * 2.4187564849853515625e-4f) - y * 3.77489497744594108e-8f;
    const float z = r * r;
    const float sp = ((-1.9515295891e-4f * z + 8.3321608736e-3f) * z - 1.6666654611e-1f) * z * r + r;
    const float cp = ((2.443315711809948e-5f * z - 1.388731625493765e-3f) * z + 4.166664568298827e-2f) * z * z - 0.5f * z + 1.0f;
    const int q = (j >> 1) & 3;
    const float s0 = (q & 1) ? cp : sp, c0 = (q & 1) ? sp : cp;
    sn = (q & 2) ? -s0 : s0;
    cs = ((q + 1) & 2) ? -c0 : c0;
}
DI float fadd_s(float a, float b) { float r; asm("v_add_f32_e32 %0, %1, %2" : "=v"(r) : "v"(a), "v"(b)); return r; }
DI int vlane() { int l; asm volatile("v_mbcnt_lo_u32_b32 %0, -1, 0\n\tv_mbcnt_hi_u32_b32 %0, -1, %0" : "=v"(l)); return l; }
#define LDS_WAIT() asm volatile("s_waitcnt lgkmcnt(0)" ::: "memory")
#define VM_WAIT() asm volatile("s_waitcnt vmcnt(0)" ::: "memory")

#ifndef GEMM_TOKPF
#define GEMM_TOKPF 2
#endif
namespace pg8 {
constexpr int BM = 256, BK = 64, HALF = 128, HTB = HALF * BK * 2, STAGE_BYTES = 8 * HTB, NXCD = 8, WGM = 8;
DI int lds_byte(int r, int c) { const int st = (r >> 4) * 2 + (c >> 5), rr = r & 15, cc = c & 31, ob = rr * 64 + cc * 2; return st * 1024 + (ob ^ (((ob >> 9) & 1) << 5)); }
DI void stage_rc(int b, int& R, int& C) { const int st = b / 1024, sb = b % 1024, swz = sb ^ (((sb >> 9) & 1) << 5); R = (st >> 1) * 16 + swz / 64; C = (st & 1) * 32 + (swz % 64) / 2; }
DI int perm32(int rho) { const int n = rho >> 4, i = rho & 15; return 8 * (i >> 2) + 4 * n + (i & 3); }
struct Unit { int pm, pn; };
struct Gemm { const bf16_t* A; const bf16_t* Bt; int K; };
struct StaticOrder {
    int nM, nN, nwg, G, c, K2;
    DI void init(int M, int N, int K, int G_, int c_) { nM = M / BM; nN = N / BM; nwg = nM * nN; G = G_; c = c_; K2 = K * 2; }
    DI bool next(int i, Unit& u) const {
        const long L = (long)i * G + c; if (L >= nwg) return false;
        int wgid = (int)L; { const int q = nwg / NXCD, r = nwg % NXCD, xcd = wgid % NXCD, off = wgid / NXCD; wgid = (xcd < r ? xcd * (q + 1) : r * (q + 1) + (xcd - r) * q) + off; }
        const int nig = WGM * nN, gid = wgid / nig, fm = gid * WGM, gsz = (nM - fm) < WGM ? (nM - fm) : WGM;
        u.pm = fm + ((wgid % nig) % gsz); u.pn = (wgid % nig) / gsz; return true;
    }
    DI unsigned a_off(const Unit& u, int r) const { return (unsigned)(u.pm * BM + r) * (unsigned)K2; }
    DI unsigned a_off_pf(const Unit& u, int r, int) const { return a_off(u, r); }
    DI void prefetch(const Unit&, int, int, int) const {}
    DI void a_ready(const Unit&) const {}
    DI void done(const Unit&) const {}
};

template <class Epi, class Sched, bool ALIGN_EPI, int MODE = 0>
DI void gemm_phase(LAS unsigned char* lds, const Gemm g, const Sched& S, const Epi& E, const int wid) {
    const int lane = vlane(), tid = wid * 64 + lane, wr = wid >> 2, wc = wid & 3, fr = lane & 15, fq = lane >> 4;
    const int K = g.K, nt = K / BK;
    int RA[2]; unsigned cA2[2], voffB[2];
#pragma unroll
    for (int i = 0; i < 2; ++i) { int R, C; stage_rc(tid * 16 + i * 8192, R, C); const int Rb = Epi::PERM ? ((R & ~31) + perm32(R & 31)) : R;
        RA[i] = R; cA2[i] = (unsigned)C * 2u; voffB[i] = (unsigned)(Rb * K + C) * 2u; }
    const size_t kstep = (size_t)(BK * 2);
    const size_t hstep = (size_t)HALF * K * 2;
    const size_t tstep = 2 * hstep;
    const unsigned ldsw = (unsigned)wid * 1024u;
    const int aoff = lds_byte(wr * 64 + fr, fq * 8), boff = lds_byte(wc * 32 + fr, fq * 8);
#define PG8_SA(b, h) (((b) * 2 + (h)) * HTB)
#define PG8_SB(b, h) ((4 + (b) * 2 + (h)) * HTB)
#define PG8_STAGE_B(bufoff, gbase) do { _Pragma("unroll") for (int _i = 0; _i < 2; ++_i) \
        __builtin_amdgcn_global_load_lds((const unsigned*)((const char*)(gbase) + voffB[_i]), (LAS unsigned*)(lds + (bufoff) + ldsw + _i * 8192), 16, 0, 0); } while (0)
#define PG8_STAGE_A(bufoff, kbytes, uo) do { _Pragma("unroll") for (int _i = 0; _i < 2; ++_i) \
        __builtin_amdgcn_global_load_lds((const unsigned*)((const char*)g.A + (kbytes) + (uo)[_i]), (LAS unsigned*)(lds + (bufoff) + ldsw + _i * 8192), 16, 0, 0); } while (0)
#define PG8_STAGE_A2(bufoff, kbytes, h) do { _Pragma("unroll") for (int _i = 0; _i < 2; ++_i) \
        __builtin_amdgcn_global_load_lds((const unsigned*)((const char*)g.A + (kbytes) + (last ? uN[h][_i] : uC[h][_i])), (LAS unsigned*)(lds + (bufoff) + ldsw + _i * 8192), 16, 0, 0); } while (0)
#define PG8_LDA(dst, b, h) do { _Pragma("unroll") for (int m = 0; m < (MODE == 2 ? 2 : 4); ++m) { dst[m].lo = *(const LAS i32x4*)(lds + PG8_SA(b, h) + aoff + m * 2048); dst[m].hi = *(const LAS i32x4*)(lds + PG8_SA(b, h) + aoff + m * 2048 + 1024); } } while (0)
#define PG8_LDB(dst, b, h) do { _Pragma("unroll") for (int n = 0; n < 2; ++n) { dst[n].lo = *(const LAS i32x4*)(lds + PG8_SB(b, h) + boff + n * 2048); dst[n].hi = *(const LAS i32x4*)(lds + PG8_SB(b, h) + boff + n * 2048 + 1024); } } while (0)
#define PG8_MMA(ai, bj, At, Bt) do { __builtin_amdgcn_s_setprio(1); _Pragma("unroll") for (int m = 0; m < 4; ++m) _Pragma("unroll") for (int n = 0; n < 2; ++n) { \
        if constexpr (MODE == 2) acc[ai][bj][m][n] = __builtin_amdgcn_mfma_scale_f32_16x16x128_f8f6f4(Bt[n], At[m], acc[ai][bj][m][n], 0, 0, 0, 0, 0, 0); \
        else if constexpr (MODE == 3) { const i64x4 b4_ = __builtin_bit_cast(i64x4, Bt[n]), a4_ = __builtin_bit_cast(i64x4, At[m]); _Pragma("unroll") for (int q = 0; q < 4; ++q) acc[ai][bj][m][n] = __builtin_amdgcn_mfma_f32_16x16x32_fp8_fp8(b4_[q], a4_[q], acc[ai][bj][m][n], 0, 0, 0); } \
        else if constexpr (MODE == 1) { acc[ai][bj][m][n] = __builtin_bit_cast(f32x4, __builtin_amdgcn_mfma_i32_16x16x64_i8(Bt[n].lo, At[m].lo, __builtin_bit_cast(i32x4, acc[ai][bj][m][n]), 0, 0, 0)); \
                                        acc[ai][bj][m][n] = __builtin_bit_cast(f32x4, __builtin_amdgcn_mfma_i32_16x16x64_i8(Bt[n].hi, At[m].hi, __builtin_bit_cast(i32x4, acc[ai][bj][m][n]), 0, 0, 0)); } \
        else { const i32x4 bl_ = Bt[n].lo, bh_ = Bt[n].hi, al_ = At[m].lo, ah_ = At[m].hi;     \
               acc[ai][bj][m][n] = __builtin_amdgcn_mfma_f32_16x16x32_bf16(__builtin_bit_cast(bf16x8, bl_), __builtin_bit_cast(bf16x8, al_), acc[ai][bj][m][n], 0, 0, 0); \
               acc[ai][bj][m][n] = __builtin_amdgcn_mfma_f32_16x16x32_bf16(__builtin_bit_cast(bf16x8, bh_), __builtin_bit_cast(bf16x8, ah_), acc[ai][bj][m][n], 0, 0, 0); } } __builtin_amdgcn_s_setprio(0); } while (0)
#define PG8_MFMA8(Bv, Av, C) C = __builtin_amdgcn_mfma_scale_f32_16x16x128_f8f6f4(Bv, Av, C, 0, 0, 0, 0, 0, 0)
#define PG8_MMAX(ai, b, h) do { if constexpr (MODE == 2) { __builtin_amdgcn_s_setprio(1); \
        _Pragma("unroll") for (int m = 0; m < 2; ++m) _Pragma("unroll") for (int n = 0; n < 2; ++n) { PG8_MFMA8(B0[n], At[m], acc[ai][0][m][n]); PG8_MFMA8(B1[n], At[m], acc[ai][1][m][n]); } \
        __builtin_amdgcn_sched_barrier(0); \
        _Pragma("unroll") for (int m = 0; m < 2; ++m) { At[m].lo = *(const LAS i32x4*)(lds + PG8_SA(b, h) + aoff + (m + 2) * 2048); At[m].hi = *(const LAS i32x4*)(lds + PG8_SA(b, h) + aoff + (m + 2) * 2048 + 1024); } \
        asm volatile("s_waitcnt lgkmcnt(0)" ::: "memory"); __builtin_amdgcn_sched_barrier(0); \
        _Pragma("unroll") for (int m = 0; m < 2; ++m) _Pragma("unroll") for (int n = 0; n < 2; ++n) { PG8_MFMA8(B0[n], At[m], acc[ai][0][m + 2][n]); PG8_MFMA8(B1[n], At[m], acc[ai][1][m + 2][n]); } \
        __builtin_amdgcn_s_setprio(0); } else { PG8_MMA(ai, 0, At, B0); PG8_MMA(ai, 1, At, B1); } } while (0)
#define PG8_WAIT_V(n) asm volatile("s_waitcnt vmcnt(" #n ")" ::: "memory")
#define PG8_WAIT_L(n) asm volatile("s_waitcnt lgkmcnt(" #n ")" ::: "memory")
#define PG8_BAR __builtin_amdgcn_s_barrier()
#define PG8_SCHED __builtin_amdgcn_sched_barrier(0)
    Unit cur, nxt; int ui = 0;
    if (!S.next(0, cur)) return;
    f32x4 acc[2][2][4][2];
#pragma unroll
    for (int a = 0; a < 2; ++a)
#pragma unroll
        for (int b = 0; b < 2; ++b)
#pragma unroll
            for (int m = 0; m < 4; ++m)
#pragma unroll
                for (int n = 0; n < 2; ++n) acc[a][b][m][n] = (f32x4){0.f, 0.f, 0.f, 0.f};
    i32x8 At[4], B0[2], B1[2];
    unsigned uC[2][2], uN[2][2];
#pragma unroll
    for (int h = 0; h < 2; ++h)
#pragma unroll
        for (int i = 0; i < 2; ++i) uC[h][i] = S.a_off(cur, h * HALF + RA[i]) + cA2[i];
    const char* cB = (const char*)g.Bt + (size_t)cur.pn * tstep;
    S.a_ready(cur); E.prefetch(lds, cur, 0, wid);
    PG8_STAGE_B(PG8_SB(0, 0), cB); PG8_STAGE_B(PG8_SB(0, 1), cB + hstep); PG8_STAGE_A(PG8_SA(0, 0), 0, uC[0]); PG8_STAGE_A(PG8_SA(0, 1), 0, uC[1]);
    if (wr == 1) PG8_BAR;
    PG8_WAIT_V(2); PG8_BAR;
    PG8_STAGE_B(PG8_SB(1, 0), cB + kstep); PG8_STAGE_A(PG8_SA(1, 0), kstep, uC[0]); PG8_STAGE_B(PG8_SB(1, 1), cB + hstep + kstep);
    PG8_WAIT_V(6); PG8_BAR;
    for (;;) {
        const bool has_next = S.next(ui + 1, nxt);
        const char* nB = has_next ? (const char*)g.Bt + (size_t)nxt.pn * tstep : cB;
#if GEMM_TOKPF == 1
        if (has_next) S.prefetch(nxt, (ui + 1) & 1, wid, lane);
#elif GEMM_TOKPF == 2
        {
            Unit nx2; const bool has2 = S.next(ui + 2, nx2);
            int RAn[2]; unsigned cAn[2];
            { const int tid2 = wid * 64 + vlane();
#pragma unroll
              for (int i = 0; i < 2; ++i) { int R, C; stage_rc(tid2 * 16 + i * 8192, R, C); RAn[i] = R; cAn[i] = (unsigned)C * 2u; } }
#pragma unroll
            for (int h = 0; h < 2; ++h)
#pragma unroll
                for (int i = 0; i < 2; ++i) uN[h][i] = has_next ? ((ui == 0 ? S.a_off(nxt, h * HALF + RAn[i]) : S.a_off_pf(nxt, h * HALF + RAn[i], (ui + 1) & 1)) + cAn[i]) : uC[h][i];
            if (has2) S.prefetch(nx2, ui & 1, wid, lane);
        }
#else
#pragma unroll
        for (int h = 0; h < 2; ++h)
#pragma unroll
            for (int i = 0; i < 2; ++i) uN[h][i] = has_next ? (S.a_off(nxt, h * HALF + RA[i]) + cA2[i]) : uC[h][i];
#endif
#pragma nounroll
        for (int t = 0; t < nt; t += 2) {
            const bool last = (t == nt - 2);
            const size_t ka1 = (size_t)(t + 1) * kstep;
            const size_t ka2 = last ? (size_t)0 : (size_t)(t + 2) * kstep, ka3 = ka2 + kstep;
            const char* b2 = last ? nB : cB + (size_t)(t + 2) * kstep; const char* b3 = b2 + kstep;
#if GEMM_TOKPF == 1
            if (last) {
                if (has_next) S.a_ready(nxt);
#pragma unroll
                for (int h = 0; h < 2; ++h)
#pragma unroll
                    for (int i = 0; i < 2; ++i) uN[h][i] = has_next ? (S.a_off_pf(nxt, h * HALF + RA[i], (ui + 1) & 1) + cA2[i]) : uC[h][i];
            }
#endif
            PG8_LDB(B0, 0, 0); PG8_LDB(B1, 0, 1); PG8_SCHED; PG8_LDA(At, 0, 0); PG8_STAGE_A(PG8_SA(1, 1), ka1, uC[1]);
            PG8_WAIT_V(8); PG8_WAIT_L(0); PG8_BAR; PG8_MMAX(0, 0, 0); PG8_BAR; PG8_SCHED;
            PG8_LDA(At, 0, 1); PG8_STAGE_B(PG8_SB(0, 0), b2); PG8_STAGE_B(PG8_SB(0, 1), b2 + hstep); PG8_STAGE_A2(PG8_SA(0, 0), ka2, 0);
            PG8_WAIT_V(8); PG8_WAIT_L(0); PG8_BAR; PG8_MMAX(1, 0, 1); PG8_BAR; PG8_SCHED;
            PG8_LDB(B0, 1, 0); PG8_LDB(B1, 1, 1); PG8_SCHED; PG8_LDA(At, 1, 0); PG8_STAGE_A2(PG8_SA(0, 1), ka2, 1);
            PG8_WAIT_V(8); PG8_WAIT_L(0); PG8_BAR; PG8_MMAX(0, 1, 0); PG8_BAR; PG8_SCHED;
            PG8_LDA(At, 1, 1); PG8_STAGE_B(PG8_SB(1, 0), b3); PG8_STAGE_B(PG8_SB(1, 1), b3 + hstep); PG8_STAGE_A2(PG8_SA(1, 0), ka3, 0);
            PG8_WAIT_V(8); PG8_WAIT_L(0); PG8_BAR; PG8_MMAX(1, 1, 1); PG8_BAR; PG8_SCHED;
        }
        if (has_next) E.prefetch(lds, nxt, (ui + 1) & 1, wid);
        if constexpr (ALIGN_EPI) { if (wr == 0) PG8_BAR; }
        E(lds, acc, cur, wr, wc, fr, fq, ui & 1); S.done(cur);
        if (!has_next) break;
#pragma unroll
        for (int a = 0; a < 2; ++a)
#pragma unroll
            for (int b = 0; b < 2; ++b)
#pragma unroll
                for (int m = 0; m < 4; ++m)
#pragma unroll
                    for (int n = 0; n < 2; ++n) acc[a][b][m][n] = (f32x4){0.f, 0.f, 0.f, 0.f};
        cur = nxt; cB = nB; ++ui;
#pragma unroll
        for (int h = 0; h < 2; ++h)
#pragma unroll
            for (int i = 0; i < 2; ++i) uC[h][i] = uN[h][i];
        if constexpr (ALIGN_EPI) { if (wr == 1) PG8_BAR; }
    }
    PG8_WAIT_V(0);
    if constexpr (!ALIGN_EPI) { if (wr == 0) PG8_BAR; }
    PG8_BAR;
#undef PG8_SA
#undef PG8_SB
#undef PG8_STAGE_A
#undef PG8_STAGE_A2
#undef PG8_STAGE_B
#undef PG8_LDA
#undef PG8_LDB
#undef PG8_MMA
#undef PG8_MMAX
#undef PG8_MFMA8
#undef PG8_WAIT_V
#undef PG8_WAIT_L
#undef PG8_BAR
#undef PG8_SCHED
}
}

struct Dst { bf16_t* O; int ldo, row0, col0, nvalid; float scale; bool headmap; };
template <class Route> struct EpiBf16R {
    static constexpr bool PERM = true;
    Route R;
    DI void prefetch(LAS unsigned char*, const pg8::Unit&, int, int) const {}
    DI void operator()(LAS unsigned char*, const f32x4 (&acc)[2][2][4][2], const pg8::Unit& u, int wr, int wc, int fr, int fq, int) const {
        const Dst d = R(u);
#pragma unroll
        for (int ai = 0; ai < 2; ++ai)
#pragma unroll
            for (int m = 0; m < 4; ++m) {
                bf16_t* rowp = d.O + (size_t)(d.row0 + ai * 128 + wr * 64 + m * 16 + fr) * d.ldo + d.col0;
#pragma unroll
                for (int bj = 0; bj < 2; ++bj) {
                    const int c = bj * 128 + wc * 32 + 8 * fq;
                    if (c < d.nvalid) {
                        const f32x4 v0 = acc[ai][bj][m][0] * d.scale, v1 = acc[ai][bj][m][1] * d.scale;
                        u32x4 w; w.x = cvtpk(v0[0], v0[1]); w.y = cvtpk(v0[2], v0[3]); w.z = cvtpk(v1[0], v1[1]); w.w = cvtpk(v1[2], v1[3]);
                        const int oc = d.headmap ? ((c >> 6) * 96 + (c & 63)) : c;
                        *(u32x4*)(rowp + oc) = w;
                    }
                }
            }
    }
};
DI f32x4 bf4(u32x2 w) { return (f32x4){__uint_as_float(w.x << 16), __uint_as_float(w.x & 0xffff0000u), __uint_as_float(w.y << 16), __uint_as_float(w.y & 0xffff0000u)}; }
struct EpiResB16 {
    static constexpr bool PERM = true;
    bf16_t* Y; const bf16_t* X;
    DI void prefetch(LAS unsigned char*, const pg8::Unit&, int, int) const {}
    DI void operator()(LAS unsigned char*, const f32x4 (&acc)[2][2][4][2], const pg8::Unit& u, int wr, int wc, int fr, int fq, int) const {
#pragma unroll
        for (int ai = 0; ai < 2; ++ai)
#pragma unroll
            for (int m = 0; m < 4; ++m) {
                const size_t ro = (size_t)(u.pm * 256 + ai * 128 + wr * 64 + m * 16 + fr) * DM + u.pn * 256 + wc * 32 + 8 * fq;
#pragma unroll
                for (int bj = 0; bj < 2; ++bj) {
                    const u32x4 xw = *(const u32x4*)(X + ro + bj * 128);
                    const f32x4 v0 = bf4((u32x2){xw.x, xw.y}) * ALPHA + acc[ai][bj][m][0], v1 = bf4((u32x2){xw.z, xw.w}) * ALPHA + acc[ai][bj][m][1];
                    u32x4 w; w.x = cvtpk(v0[0], v0[1]); w.y = cvtpk(v0[2], v0[3]); w.z = cvtpk(v1[0], v1[1]); w.w = cvtpk(v1[2], v1[3]);
                    *(u32x4*)(Y + ro + bj * 128) = w;
                }
            }
    }
};
struct EpiLat {
    static constexpr bool PERM = false;
    float* O; int ncol;
    DI void prefetch(LAS unsigned char*, const pg8::Unit&, int, int) const {}
    DI void operator()(LAS unsigned char*, const f32x4 (&acc)[2][2][4][2], const pg8::Unit& u, int wr, int wc, int fr, int fq, int) const {
#pragma unroll
        for (int ai = 0; ai < 2; ++ai)
#pragma unroll
            for (int m = 0; m < 4; ++m) {
                const int c0 = u.pn * 256 + wc * 32 + 4 * fq;
                float* rowp = O + (size_t)(u.pm * 256 + ai * 128 + wr * 64 + m * 16 + fr) * 1024;
#pragma unroll
                for (int bj = 0; bj < 2; ++bj)
#pragma unroll
                    for (int n = 0; n < 2; ++n) { const int c = c0 + bj * 128 + n * 16; if (c < ncol) *(f32x4*)(rowp + c) = acc[ai][bj][m][n]; }
            }
    }
};
struct EpiGU {
    static constexpr bool PERM = true;
    unsigned char* H; const float* bias; const float* sw; const float* sas; const LAS int* tstart;
    DI void prefetch(LAS unsigned char* lds, const pg8::Unit& u, int slot, int wid) const {
        if (wid < 1 || wid > 3) return;
        const int e = u.pn >> 3, ct = u.pn & 7, l = vlane();
        const float* src = wid == 1 ? bias + (size_t)e * 2048 + (l >> 5) * 1024 + ct * 128 + (l & 31) * 4
                         : wid == 2 ? sw + (size_t)e * 2048 + ct * 256 + l * 4
                                    : sas + (size_t)e * T + (u.pm - tstart[e]) * 256 + l * 4;
        __builtin_amdgcn_global_load_lds((const unsigned*)src, (LAS unsigned*)(lds + LDS_R1X + slot * 3072 + (wid - 1) * 1024), 16, 0, 0);
    }
    DI void operator()(LAS unsigned char* lds, const f32x4 (&acc)[2][2][4][2], const pg8::Unit& u, int wr, int wc, int fr, int fq, int slot) const {
        const int j = (u.pn & 7) * 128 + wc * 32 + 8 * fq;
        const LAS unsigned char* cb = lds + LDS_R1X + slot * 3072;
        const LAS f32x2* c2 = (const LAS f32x2*)(cb + (wc * 32 + 8 * fq) * 4);
        const LAS float* sa = (const LAS float*)(cb + 2048) + wr * 64 + fr;
        f32x2 bg[4], bu[4], sg_[4], su_[4];
#pragma unroll
        for (int q = 0; q < 4; ++q) { bg[q] = c2[q]; bu[q] = c2[64 + q]; sg_[q] = c2[128 + q]; su_[q] = c2[192 + q]; }
#pragma unroll
        for (int ai = 0; ai < 2; ++ai)
#pragma unroll
            for (int m = 0; m < 4; ++m) {
                const float st = sa[ai * 128 + m * 16];
                const f32x2 st2 = (f32x2){st, st};
                f32x2 h[4];
#pragma unroll
                for (int q = 0; q < 4; ++q) {
                    const f32x4 ag = acc[ai][0][m][q >> 1], au = acc[ai][1][m][q >> 1];
                    const f32x2 cg = (f32x2){(float)__float_as_int(ag[2 * (q & 1)]), (float)__float_as_int(ag[2 * (q & 1) + 1])};
                    const f32x2 cu = (f32x2){(float)__float_as_int(au[2 * (q & 1)]), (float)__float_as_int(au[2 * (q & 1) + 1])};
                    f32x2 g = cg * (st2 * sg_[q]) + bg[q], uu = cu * (st2 * su_[q]) + bu[q];
                    g[0] = fminf(g[0], 7.0f); g[1] = fminf(g[1], 7.0f);
                    uu[0] = fminf(fmaxf(uu[0], -7.0f), 7.0f); uu[1] = fminf(fmaxf(uu[1], -7.0f), 7.0f);
                    const f32x2 t = g * (f32x2){-1.702f * LOG2E, -1.702f * LOG2E};
                    f32x2 d = (f32x2){__builtin_amdgcn_exp2f(t[0]), __builtin_amdgcn_exp2f(t[1])} + (f32x2){1.0f, 1.0f};
                    d[0] = __builtin_amdgcn_rcpf(d[0]); d[1] = __builtin_amdgcn_rcpf(d[1]);
                    h[q] = (uu + (f32x2){1.0f, 1.0f}) * (g * d);
                }
                u32x2 w;
                w.x = (unsigned)__builtin_amdgcn_cvt_pk_fp8_f32(h[1][0], h[1][1], __builtin_amdgcn_cvt_pk_fp8_f32(h[0][0], h[0][1], 0, false), true);
                w.y = (unsigned)__builtin_amdgcn_cvt_pk_fp8_f32(h[3][0], h[3][1], __builtin_amdgcn_cvt_pk_fp8_f32(h[2][0], h[2][1], 0, false), true);
                *(u32x2*)(H + (size_t)(u.pm * 256 + ai * 128 + wr * 64 + m * 16 + fr) * 1024 + j) = w;
            }
    }
};
struct EpiDN {
    static constexpr bool PERM = true;
    bf16_t* Y; const float* bias; const float* sw;
    DI void prefetch(LAS unsigned char* lds, const pg8::Unit& u, int slot, int wid) const {
        if (wid < 1 || wid > 2) return;
        const int e = u.pn >> 2, ct = u.pn & 3, l = vlane();
        const float* src = (wid == 1 ? bias : sw) + (size_t)e * 1024 + ct * 256 + l * 4;
        __builtin_amdgcn_global_load_lds((const unsigned*)src, (LAS unsigned*)(lds + LDS_R1X + slot * 3072 + (wid - 1) * 1024), 16, 0, 0);
    }
    DI void operator()(LAS unsigned char* lds, const f32x4 (&acc)[2][2][4][2], const pg8::Unit& u, int wr, int wc, int fr, int fq, int slot) const {
        const int ct = u.pn & 3;
        const LAS unsigned char* cb = lds + LDS_R1X + slot * 3072;
#pragma unroll
        for (int bj = 0; bj < 2; ++bj) {
            const int cl = bj * 128 + wc * 32 + 8 * fq, c = ct * 256 + cl;
            const f32x4 b0 = *(const LAS f32x4*)(cb + cl * 4), b1 = *(const LAS f32x4*)(cb + cl * 4 + 16), s0 = *(const LAS f32x4*)(cb + 1024 + cl * 4), s1 = *(const LAS f32x4*)(cb + 1024 + cl * 4 + 16);
#pragma unroll
            for (int ai = 0; ai < 2; ++ai)
#pragma unroll
                for (int m = 0; m < 4; ++m) {
                    const f32x4 v0 = acc[ai][bj][m][0] * s0 + b0, v1 = acc[ai][bj][m][1] * s1 + b1;
                    u32x4 w; w.x = cvtpk(v0[0], v0[1]); w.y = cvtpk(v0[2], v0[3]); w.z = cvtpk(v1[0], v1[1]); w.w = cvtpk(v1[2], v1[3]);
                    *(u32x4*)(Y + (size_t)(u.pm * 256 + ai * 128 + wr * 64 + m * 16 + fr) * 1024 + c) = w;
                }
        }
    }
};
struct Frame {
    LAS unsigned char* lds; unsigned* ctl; unsigned char* ws; int tid, lane, wid; int G, bid;
};
struct MoeOrder {
    const LAS int* tstart; int sh; bool gather; const int* tokof; const LAS int* tokbuf; const LAS int* ulist; unsigned pitch;
    static DI void build(Frame& F, const LAS int* tstart, int nNt, LAS int* ulist) {
        __syncthreads();
        const int nwg = tstart[32] * nNt;
        if (F.tid == 0) ulist[0] = 0;
        __syncthreads();
        if (F.tid < 24) {
            const long L = (long)F.tid * F.G + F.bid;
            if (L < nwg) {
                int wgid = (int)L; { const int q = nwg / 8, r = nwg % 8, xcd = wgid % 8, off = wgid / 8; wgid = (xcd < r ? xcd * (q + 1) : r * (q + 1) + (xcd - r) * q) + off; }
                int e = 0;
                for (int k = 1; k < 32; ++k) if (tstart[k] * nNt <= wgid) e = k;
                const int rem = wgid - tstart[e] * nNt, nte = tstart[e + 1] - tstart[e];
                const int ct = rem / nte, rt = rem % nte;
                ulist[4 + 4 * F.tid] = tstart[e] + rt; ulist[5 + 4 * F.tid] = e * nNt + ct; ulist[6 + 4 * F.tid] = e; ulist[7 + 4 * F.tid] = rt;
                __hip_atomic_fetch_add(ulist, 1, __ATOMIC_RELAXED, __HIP_MEMORY_SCOPE_WORKGROUP);
            }
        }
        __syncthreads();
    }
    DI bool next(int i, pg8::Unit& u) const {
        if (i >= ulist[0]) return false;
        u.pm = ulist[4 + 4 * i]; u.pn = ulist[5 + 4 * i]; return true;
    }
    DI unsigned a_off(const pg8::Unit& u, int r) const {
        if (!gather) return (unsigned)(u.pm * 256 + r) * pitch;
        const int e = u.pn >> sh, idx = (u.pm - tstart[e]) * 256 + r;
        const int t = idx < tstart[80 + e] ? tokof[(size_t)e * T + idx] : 0;
        return (unsigned)t * pitch;
    }
    DI void prefetch(const pg8::Unit& u, int slot, int wid, int lane) const {
        if (gather && wid == 0) {
            const int e = u.pn >> sh, rt = u.pm - tstart[e];
            __builtin_amdgcn_global_load_lds((const unsigned*)(tokof + (size_t)e * T + rt * 256 + vlane() * 4), (LAS unsigned*)((LAS unsigned char*)tokbuf + slot * 1024), 16, 0, 0);
        }
    }
    DI unsigned a_off_pf(const pg8::Unit& u, int r, int slot) const {
        if (!gather) return (unsigned)(u.pm * 256 + r) * pitch;
        const int e = u.pn >> sh, idx = (u.pm - tstart[e]) * 256 + r;
        const int t = idx < tstart[80 + e] ? tokbuf[slot * 256 + r] : 0;
        return (unsigned)t * pitch;
    }
    DI void a_ready(const pg8::Unit&) const {}
    DI void done(const pg8::Unit&) const {}
};

struct MoeOrderDN {
    const LAS int* ulist;
    DI bool next(int i, pg8::Unit& u) const { if (i >= ulist[0]) return false; u.pm = __builtin_amdgcn_readfirstlane(ulist[4 + 4 * i]); u.pn = __builtin_amdgcn_readfirstlane(ulist[5 + 4 * i]); return true; }
    DI unsigned a_off(const pg8::Unit& u, int r) const { return (unsigned)(u.pm * 256 + r) * 1024u; }
    DI unsigned a_off_pf(const pg8::Unit& u, int r, int) const { return a_off(u, r); }
    DI void prefetch(const pg8::Unit&, int, int, int) const {}
    DI void a_ready(const pg8::Unit&) const {}
    DI void done(const pg8::Unit&) const {}
};

DI int crow(int r, int hi) { return (r & 3) + 8 * (r >> 2) + 4 * hi; }
template <int DK, bool FOX, bool ROPEQ>
DI void attn_unit(LAS unsigned char* lds, const bf16_t* Q, int ldq, const bf16_t* Kp, int ldk, const bf16_t* Vt, int ldv,
                  const float* cum, bf16_t* O, int ldo, int q0, int ntiles, bool causal, const int* pos, const int wid, const float* kn2 = nullptr) {
    constexpr int PK = DK * 2 + 16, KBYTES = 64 * PK, VBYTES = 64 * 136, BUF = KBYTES + VBYTES + 256, KCH = DK / 8, NS = DK / 16;
    const int lane = vlane(), tid = wid * 64 + lane, r32 = lane & 31, hi = lane >> 5;
    const int qw0 = q0 + wid * 32, qrow = qw0 + r32;
    bf16x8 qf[NS];
#pragma unroll
    for (int s = 0; s < NS; ++s) qf[s] = *(const bf16x8*)(Q + (size_t)qrow * ldq + 16 * s + 8 * hi);
    if constexpr (ROPEQ) {
        const float p = (float)pos[qrow];
#pragma unroll
        for (int j = 0; j < 8; ++j) {
            const int i = 8 * hi + j;
            const float inv = exp2f(-(float)i * (13.287712379549449f / 16.0f));
            float sn, cs; sincos_cw(p * inv, sn, cs);
            const float x1 = bf2f((unsigned short)qf[4][j]), x2 = bf2f((unsigned short)qf[5][j]);
            const float o1 = x1 * cs - x2 * sn, o2 = x1 * sn + x2 * cs;
            qf[4][j] = (short)(cvtpk(o1, 0.f) & 0xffffu); qf[5][j] = (short)(cvtpk(o2, 0.f) & 0xffffu);
        }
    }
    const float cq = FOX ? cum[qrow] : 0.f;
    int jstart = 0; float prune_c = 0.f;
    if constexpr (FOX) {
        LAS float* red = (LAS float*)(lds + 2 * BUF);
        float ss = 0.f;
#pragma unroll
        for (int s = 0; s < NS; ++s)
#pragma unroll
            for (int j = 0; j < 8; ++j) { const float v = bf2f((unsigned short)qf[s][j]); ss += v * v; }
        ss += __shfl_xor(ss, 32);
        ss = wave_max(ss);
        float kk = 0.f;
        for (int j = tid; j < ntiles; j += NTHREADS) kk = fmaxf(kk, kn2[j]);
        kk = wave_max(kk);
        __syncthreads();
        if (lane == 0) { red[wid] = ss; red[8 + wid] = kk; }
        __syncthreads();
        float qm = red[0], km = red[8];
#pragma unroll
        for (int w = 1; w < 8; ++w) { qm = fmaxf(qm, red[w]); km = fmaxf(km, red[8 + w]); }
        prune_c = 2.0f * sqrtf(qm * km) * 1.01f + 65.0f;
        const float cq0 = cum[q0];
        int cand = ntiles;
        for (int j = tid; j < ntiles; j += NTHREADS) if (cq0 - cum[64 * j + 63] + prune_c >= 0.f) cand = min(cand, j);
#pragma unroll
        for (int o = 1; o < 64; o <<= 1) cand = min(cand, __shfl_xor(cand, o));
        __syncthreads();
        if (lane == 0) ((LAS int*)red)[16 + wid] = cand;
        __syncthreads();
        jstart = ((LAS int*)red)[16];
#pragma unroll
        for (int w = 1; w < 8; ++w) jstart = min(jstart, ((LAS int*)red)[16 + w]);
        jstart = min(jstart, ntiles - 4);
        __syncthreads();
    }
    const float cqw0 = FOX ? __shfl(cq, 0) : 0.f;
    f32x16 o0, o1;
#pragma unroll
    for (int r = 0; r < 16; ++r) { o0[r] = 0.f; o1[r] = 0.f; }
    float mrun = -1e30f, lrun = 0.f;
    const int kr0 = tid / KCH, kc0 = tid % KCH;
    const int kr1 = (tid + 512) / KCH, kc1 = (tid + 512) % KCH;
    const bool k2 = (DK == 96) && (tid < 256);
    const int vd = tid >> 3, vc = tid & 7;
    u32x4 kreg0, kreg1 = (u32x4){0, 0, 0, 0}, vreg; float creg = 0.f;
#define ATT_GLOAD(j) do { \
        kreg0 = *(const u32x4*)(Kp + (size_t)(64 * (j) + kr0) * ldk + kc0 * 8); \
        if (k2) kreg1 = *(const u32x4*)(Kp + (size_t)(64 * (j) + kr1) * ldk + kc1 * 8); \
        vreg = *(const u32x4*)(Vt + (size_t)vd * ldv + 64 * (j) + vc * 8); \
        if (FOX && tid < 64) creg = cum[64 * (j) + tid]; } while (0)
#define ATT_LWRITE(buf) do { LAS unsigned char* bb_ = lds + (buf) * BUF; \
        *(LAS u32x4*)(bb_ + kr0 * PK + kc0 * 16) = kreg0; \
        if (k2) *(LAS u32x4*)(bb_ + kr1 * PK + kc1 * 16) = kreg1; \
        *(LAS u32x2*)(bb_ + KBYTES + vd * 136 + vc * 16) = (u32x2){vreg.x, vreg.y}; \
        *(LAS u32x2*)(bb_ + KBYTES + vd * 136 + vc * 16 + 8) = (u32x2){vreg.z, vreg.w}; \
        if (FOX && tid < 64) *(LAS float*)(bb_ + KBYTES + VBYTES + tid * 4) = creg; } while (0)
    ATT_GLOAD(jstart); ATT_LWRITE(0); __syncthreads();
    for (int j = jstart; j < ntiles; ++j) {
        const int cur = (j - jstart) & 1;
        if (j + 1 < ntiles) ATT_GLOAD(j + 1);
        const LAS unsigned char* kb = lds + cur * BUF; const LAS unsigned char* vb = kb + KBYTES; const LAS unsigned char* cb = vb + VBYTES;
        bool active = !causal || (64 * j <= qw0 + 31);
        if constexpr (FOX) { if (cqw0 - *(const LAS float*)(cb + 63 * 4) + prune_c < 0.f) active = false; }
        if (active) {
            f32x16 sp0, sp1;
#pragma unroll
            for (int r = 0; r < 16; ++r) { sp0[r] = 0.f; sp1[r] = 0.f; }
#pragma unroll
            for (int s = 0; s < NS; ++s) {
                const bf16x8 k0 = *(const LAS bf16x8*)(kb + r32 * PK + 32 * s + 16 * hi);
                const bf16x8 k1 = *(const LAS bf16x8*)(kb + (32 + r32) * PK + 32 * s + 16 * hi);
                sp0 = __builtin_amdgcn_mfma_f32_32x32x16_bf16(k0, qf[s], sp0, 0, 0, 0);
                sp1 = __builtin_amdgcn_mfma_f32_32x32x16_bf16(k1, qf[s], sp1, 0, 0, 0);
            }
            __builtin_amdgcn_sched_barrier(0);
            if constexpr (FOX) {
#pragma unroll
                for (int g = 0; g < 4; ++g) {
                    const f32x4 c0 = *(const LAS f32x4*)(cb + (8 * g + 4 * hi) * 4);
                    const f32x4 c1 = *(const LAS f32x4*)(cb + (32 + 8 * g + 4 * hi) * 4);
#pragma unroll
                    for (int i = 0; i < 4; ++i) { sp0[4 * g + i] += cq - c0[i]; sp1[4 * g + i] += cq - c1[i]; }
                }
            }
            if (causal && (64 * j + 63 > qw0)) {
#pragma unroll
                for (int r = 0; r < 16; ++r) {
                    const int key = 64 * j + crow(r, hi);
                    if (key > qrow) sp0[r] = -1e30f;
                    if (key + 32 > qrow) sp1[r] = -1e30f;
                }
            }
            float mx = fmaxf(sp0[0], sp1[0]);
#pragma unroll
            for (int r = 1; r < 16; ++r) mx = fmaxf(mx, fmaxf(sp0[r], sp1[r]));
            mx = fmaxf(mx, __shfl_xor(mx, 32));
            const float mnew = fmaxf(mrun, mx);
            const float alpha = __builtin_amdgcn_exp2f(mrun - mnew);
            mrun = mnew;
            float ls = 0.f;
#pragma unroll
            for (int r = 0; r < 16; ++r) { sp0[r] = __builtin_amdgcn_exp2f(sp0[r] - mnew); sp1[r] = __builtin_amdgcn_exp2f(sp1[r] - mnew); ls += sp0[r] + sp1[r]; }
            lrun = lrun * alpha + ls;
#pragma unroll
            for (int r = 0; r < 16; ++r) { o0[r] *= alpha; o1[r] *= alpha; }
            __builtin_amdgcn_sched_barrier(0);
#pragma unroll
            for (int ks = 0; ks < 4; ++ks) {
                const int p = ks >> 1, s2 = ks & 1;
                u32x4 pw;
                if (p == 0) { pw.x = cvtpk(sp0[8 * s2 + 0], sp0[8 * s2 + 1]); pw.y = cvtpk(sp0[8 * s2 + 2], sp0[8 * s2 + 3]); pw.z = cvtpk(sp0[8 * s2 + 4], sp0[8 * s2 + 5]); pw.w = cvtpk(sp0[8 * s2 + 6], sp0[8 * s2 + 7]); }
                else        { pw.x = cvtpk(sp1[8 * s2 + 0], sp1[8 * s2 + 1]); pw.y = cvtpk(sp1[8 * s2 + 2], sp1[8 * s2 + 3]); pw.z = cvtpk(sp1[8 * s2 + 4], sp1[8 * s2 + 5]); pw.w = cvtpk(sp1[8 * s2 + 6], sp1[8 * s2 + 7]); }
                const bf16x8 pf = __builtin_bit_cast(bf16x8, pw);
                const int kbase = (32 * p + 16 * s2 + 4 * hi) * 2;
                {
                    const u32x2 lo = *(const LAS u32x2*)(vb + r32 * 136 + kbase), h2 = *(const LAS u32x2*)(vb + r32 * 136 + kbase + 16);
                    const bf16x8 vf = __builtin_bit_cast(bf16x8, (u32x4){lo.x, lo.y, h2.x, h2.y});
                    o0 = __builtin_amdgcn_mfma_f32_32x32x16_bf16(vf, pf, o0, 0, 0, 0);
                }
                {
                    const u32x2 lo = *(const LAS u32x2*)(vb + (32 + r32) * 136 + kbase), h2 = *(const LAS u32x2*)(vb + (32 + r32) * 136 + kbase + 16);
                    const bf16x8 vf = __builtin_bit_cast(bf16x8, (u32x4){lo.x, lo.y, h2.x, h2.y});
                    o1 = __builtin_amdgcn_mfma_f32_32x32x16_bf16(vf, pf, o1, 0, 0, 0);
                }
            }
        }
        if (j + 1 < ntiles) ATT_LWRITE(cur ^ 1);
        __syncthreads();
    }
#undef ATT_GLOAD
#undef ATT_LWRITE
    const float ltot = lrun + __shfl_xor(lrun, 32);
    const float inv = 1.0f / ltot;
#pragma unroll
    for (int g = 0; g < 4; ++g) {
        const int d0 = 8 * g + 4 * hi;
        u32x2 w0, w1;
        w0.x = cvtpk(o0[4 * g] * inv, o0[4 * g + 1] * inv); w0.y = cvtpk(o0[4 * g + 2] * inv, o0[4 * g + 3] * inv);
        w1.x = cvtpk(o1[4 * g] * inv, o1[4 * g + 1] * inv); w1.y = cvtpk(o1[4 * g + 2] * inv, o1[4 * g + 3] * inv);
        *(u32x2*)(O + (size_t)qrow * ldo + d0) = w0;
        *(u32x2*)(O + (size_t)qrow * ldo + 32 + d0) = w1;
    }
}


template <int DK, bool ROPEQ>
DI void attn_unit_pipe(LAS unsigned char* lds, const bf16_t* Q, int ldq, const bf16_t* Kp, int ldk, const bf16_t* Vt, int ldv,
                       bf16_t* O, int ldo, int q0, int ntiles, const int* pos, const int wid) {
    constexpr int PK = DK * 2 + 16, KBYTES = 64 * PK, VBYTES = 64 * 136, KCH = DK / 8, NS = DK / 16, VOFF = 2 * KBYTES;
    constexpr float THR = 6.0f;
    const int lane = vlane(), tid = wid * 64 + lane, r32 = lane & 31, hi = lane >> 5;
    const int qw0 = q0 + wid * 32, qrow = qw0 + r32;
    bf16x8 qf[NS];
#pragma unroll
    for (int s = 0; s < NS; ++s) qf[s] = *(const bf16x8*)(Q + (size_t)qrow * ldq + 16 * s + 8 * hi);
    if constexpr (ROPEQ) {
        const float p = (float)pos[qrow];
#pragma unroll
        for (int j = 0; j < 8; ++j) {
            const int i = 8 * hi + j;
            const float inv = exp2f(-(float)i * (13.287712379549449f / 16.0f));
            float sn, cs; sincos_cw(p * inv, sn, cs);
            const float x1 = bf2f((unsigned short)qf[NS - 2][j]), x2 = bf2f((unsigned short)qf[NS - 1][j]);
            const float o1 = x1 * cs - x2 * sn, o2 = x1 * sn + x2 * cs;
            qf[NS - 2][j] = (short)(cvtpk(o1, 0.f) & 0xffffu); qf[NS - 1][j] = (short)(cvtpk(o2, 0.f) & 0xffffu);
        }
    }
    const int kr0 = tid / KCH, kc0 = tid % KCH;
    const int kr1 = (tid + 512) / KCH, kc1 = (tid + 512) % KCH;
    const bool k2 = (DK == 96) && (tid < 256);
    const int vd = tid >> 3, vc = tid & 7;
    const int kfo = r32 * PK + 16 * hi;
    const int vfo = VOFF + r32 * 136 + 8 * hi;
    u32x4 kA0, kA1 = (u32x4){0, 0, 0, 0}, vA, kB0, kB1 = (u32x4){0, 0, 0, 0}, vB;
#define SBAR() __builtin_amdgcn_sched_barrier(0)
#define AP_LOADK(j, R0, R1) do { R0 = *(const u32x4*)(Kp + (size_t)(64 * (j) + kr0) * ldk + kc0 * 8); \
        if (k2) R1 = *(const u32x4*)(Kp + (size_t)(64 * (j) + kr1) * ldk + kc1 * 8); } while (0)
#define AP_LOADV(j, RV) do { RV = *(const u32x4*)(Vt + (size_t)vd * ldv + 64 * (j) + vc * 8); } while (0)
#define AP_WRITEK(buf, R0, R1) do { LAS unsigned char* bb_ = lds + (buf) * KBYTES; *(LAS u32x4*)(bb_ + kr0 * PK + kc0 * 16) = R0; \
        if (k2) *(LAS u32x4*)(bb_ + kr1 * PK + kc1 * 16) = R1; } while (0)
#define AP_WRITEV(buf, RV) do { LAS unsigned char* bb_ = lds + VOFF + (buf) * VBYTES; \
        *(LAS u32x2*)(bb_ + vd * 136 + vc * 16) = (u32x2){RV.x, RV.y}; *(LAS u32x2*)(bb_ + vd * 136 + vc * 16 + 8) = (u32x2){RV.z, RV.w}; } while (0)
#define AP_KF(dst0, dst1, kbuf, s) do { dst0 = *(const LAS bf16x8*)(lds + (kbuf) * KBYTES + kfo + 32 * (s)); dst1 = *(const LAS bf16x8*)(lds + (kbuf) * KBYTES + kfo + 32 * PK + 32 * (s)); } while (0)
#define AP_VF(dst0, dst1, vbuf, ks) do { const LAS unsigned char* p_ = lds + (vbuf) * VBYTES + vfo + (32 * ((ks) >> 1) + 16 * ((ks) & 1)) * 2; \
        const u32x2 a_ = *(const LAS u32x2*)(p_), b_ = *(const LAS u32x2*)(p_ + 16), c_ = *(const LAS u32x2*)(p_ + 32 * 136), d_ = *(const LAS u32x2*)(p_ + 32 * 136 + 16); \
        dst0 = __builtin_bit_cast(bf16x8, (u32x4){a_.x, a_.y, b_.x, b_.y}); dst1 = __builtin_bit_cast(bf16x8, (u32x4){c_.x, c_.y, d_.x, d_.y}); } while (0)
#define AP_MFMA(a, b, c) __builtin_amdgcn_mfma_f32_32x32x16_bf16(a, b, c, 0, 0, 0)
#define AP_MASK(S0, S1, t) do { _Pragma("unroll") for (int r_ = 0; r_ < 16; ++r_) { const int key_ = 64 * (t) + crow(r_, hi); \
        if (key_ > qrow) S0[r_] = -1e30f; if (key_ + 32 > qrow) S1[r_] = -1e30f; } } while (0)
#define AP_ROWMAX(S0, S1, out) do { float a_ = fmaxf(fmaxf(S0[0], S1[0]), S0[1]), b_ = fmaxf(fmaxf(S1[1], S0[2]), S1[2]); \
        _Pragma("unroll") for (int r_ = 3; r_ < 15; r_ += 2) { a_ = fmaxf(fmaxf(a_, S0[r_]), S1[r_]); b_ = fmaxf(fmaxf(b_, S0[r_ + 1]), S1[r_ + 1]); } \
        a_ = fmaxf(fmaxf(a_, S0[15]), S1[15]); a_ = fmaxf(a_, b_); out = fmaxf(a_, __shfl_xor(a_, 32)); } while (0)
    f32x16 o0, o1, pa0, pa1, sb0, sb1;
#pragma unroll
    for (int r = 0; r < 16; ++r) { o0[r] = 0.f; o1[r] = 0.f; }
    float mref = 0.f, lrun = 0.f;
    bf16x8 pf[4];
    bf16x8 fa0, fa1, fb0, fb1;
    AP_LOADK(0, kA0, kA1); AP_LOADV(0, vA); AP_WRITEK(0, kA0, kA1); AP_WRITEV(0, vA);
    AP_LOADK(1, kA0, kA1); AP_WRITEK(1, kA0, kA1);
    AP_LOADK(2, kA0, kA1); AP_LOADV(1, vA);
    __syncthreads();
#pragma unroll
    for (int r = 0; r < 16; ++r) { pa0[r] = 0.f; pa1[r] = 0.f; }
#pragma unroll
    for (int s = 0; s < NS; ++s) { AP_KF(fa0, fa1, 0, s); pa0 = AP_MFMA(fa0, qf[s], pa0); pa1 = AP_MFMA(fa1, qf[s], pa1); }
    if (ntiles == 4) AP_MASK(pa0, pa1, 0);
    { float mx; AP_ROWMAX(pa0, pa1, mx); mref = mx;
#pragma unroll
      for (int r = 0; r < 16; ++r) { pa0[r] = __builtin_amdgcn_exp2f(pa0[r] - mx); pa1[r] = __builtin_amdgcn_exp2f(pa1[r] - mx); } }
    __syncthreads();
    f32x16 negm;
#pragma unroll
    for (int r = 0; r < 16; ++r) negm[r] = -mref;
    asm volatile("" : "+v"(negm));
#define AP_STEPA(s, X0, X1, Y0, Y1, VALU) do { if ((s) + 1 < NS) AP_KF(Y0, Y1, kb_, (s) + 1); else AP_VF(Y0, Y1, vb_, 0); \
        if ((s) == 0) { sb0 = AP_MFMA(X0, qf[s], negm); sb1 = AP_MFMA(X1, qf[s], negm); } else { sb0 = AP_MFMA(X0, qf[s], sb0); sb1 = AP_MFMA(X1, qf[s], sb1); } VALU; SBAR(); } while (0)
#define AP_PK(i, P, b) pw_[i] = (u32x4){cvtpk(P[b], P[b + 1]), cvtpk(P[b + 2], P[b + 3]), cvtpk(P[b + 4], P[b + 5]), cvtpk(P[b + 6], P[b + 7])}; \
        ls0_ = fadd_s(ls0_, fadd_s(fadd_s(P[b], P[b + 1]), fadd_s(P[b + 2], P[b + 3]))); ls1_ = fadd_s(ls1_, fadd_s(fadd_s(P[b + 4], P[b + 5]), fadd_s(P[b + 6], P[b + 7]))); asm volatile("" : "+v"(pw_[i]), "+v"(ls0_), "+v"(ls1_))
#define AP_EXP4(P, S, b) do { P[b] = __builtin_amdgcn_exp2f(S[b]); P[b + 1] = __builtin_amdgcn_exp2f(S[b + 1]); P[b + 2] = __builtin_amdgcn_exp2f(S[b + 2]); P[b + 3] = __builtin_amdgcn_exp2f(S[b + 3]); asm volatile("" : "+v"(P)); } while (0)
#define AP_STEPB(ks, X0, X1, Y0, Y1, E0, E1) do { if ((ks) + 1 < 4) AP_VF(Y0, Y1, vb_, (ks) + 1); \
        o0 = AP_MFMA(X0, pf[ks], o0); E0; SBAR(); o1 = AP_MFMA(X1, pf[ks], o1); E1; SBAR(); } while (0)
#define AP_ITER(t, MASKED, WK0, WK1, WV, LK0, LK1, LV) do {     \
        const int kb_ = (t) & 1, vb_ = ((t) - 1) & 1; \
        if ((t) + 2 < ntiles) AP_LOADK((t) + 2, LK0, LK1); \
        if ((t) + 1 < ntiles) AP_LOADV((t) + 1, LV); \
        u32x4 pw_[4]; float ls0_ = 0.f, ls1_ = 0.f; \
        AP_KF(fa0, fa1, kb_, 0); SBAR(); \
        AP_STEPA(0, fa0, fa1, fb0, fb1, AP_PK(0, pa0, 0)); \
        AP_STEPA(1, fb0, fb1, fa0, fa1, AP_PK(1, pa0, 8)); \
        AP_STEPA(2, fa0, fa1, fb0, fb1, AP_PK(2, pa1, 0)); \
        AP_STEPA(3, fb0, fb1, fa0, fa1, AP_PK(3, pa1, 8)); \
        if (NS == 6) { AP_STEPA(4, fa0, fa1, fb0, fb1, (void)0); AP_STEPA(5, fb0, fb1, fa0, fa1, (void)0); } \
        lrun += ls0_ + ls1_; \
        pf[0] = __builtin_bit_cast(bf16x8, pw_[0]); pf[1] = __builtin_bit_cast(bf16x8, pw_[1]); pf[2] = __builtin_bit_cast(bf16x8, pw_[2]); pf[3] = __builtin_bit_cast(bf16x8, pw_[3]); \
        if ((t) >= ntiles - 4) AP_MASK(sb0, sb1, t); \
        float mx_; AP_ROWMAX(sb0, sb1, mx_); \
        float resc_ = 1.0f; bool do_resc_ = false; \
        if (__any(mx_ > THR)) { const float dl_ = fmaxf(mx_, 0.f); mref += dl_; \
            _Pragma("unroll") for (int r_ = 0; r_ < 16; ++r_) { sb0[r_] -= dl_; sb1[r_] -= dl_; negm[r_] = -mref; } \
            asm volatile("" : "+v"(negm)); \
            resc_ = __builtin_amdgcn_exp2f(-dl_); lrun *= resc_; do_resc_ = true; } \
        SBAR(); \
        AP_STEPB(0, fa0, fa1, fb0, fb1, AP_EXP4(pa0, sb0, 0), AP_EXP4(pa0, sb0, 4)); \
        AP_STEPB(1, fb0, fb1, fa0, fa1, AP_EXP4(pa0, sb0, 8), AP_EXP4(pa0, sb0, 12)); \
        AP_STEPB(2, fa0, fa1, fb0, fb1, AP_EXP4(pa1, sb1, 0), AP_EXP4(pa1, sb1, 4)); \
        AP_STEPB(3, fb0, fb1, fa0, fa1, AP_EXP4(pa1, sb1, 8), AP_EXP4(pa1, sb1, 12)); \
        if (do_resc_) { asm volatile("" ::: "memory"); _Pragma("unroll") for (int r_ = 0; r_ < 16; ++r_) { o0[r_] *= resc_; o1[r_] *= resc_; } asm volatile("" : "+v"(o0), "+v"(o1)); } \
        if ((t) + 1 < ntiles) AP_WRITEK(((t) + 1) & 1, WK0, WK1); \
        AP_WRITEV((t) & 1, WV); \
        __syncthreads(); } while (0)
    static_assert(NS == 4 || NS == 6, "head dim 64 or 96");
    if (wid >= 4) __builtin_amdgcn_s_setprio(1);
    int t = 1;
    for (; t + 1 < ntiles; t += 2) { AP_ITER(t, 1, kA0, kA1, vA, kB0, kB1, vB); AP_ITER(t + 1, 1, kB0, kB1, vB, kA0, kA1, vA); }
    AP_ITER(t, 1, kA0, kA1, vA, kB0, kB1, vB);
    {
        u32x4 pw_[4]; float ls0_ = 0.f, ls1_ = 0.f;
        AP_PK(0, pa0, 0); AP_PK(1, pa0, 8); AP_PK(2, pa1, 0); AP_PK(3, pa1, 8);
        lrun += ls0_ + ls1_;
        pf[0] = __builtin_bit_cast(bf16x8, pw_[0]); pf[1] = __builtin_bit_cast(bf16x8, pw_[1]); pf[2] = __builtin_bit_cast(bf16x8, pw_[2]); pf[3] = __builtin_bit_cast(bf16x8, pw_[3]);
        const int vb_ = (ntiles - 1) & 1;
#pragma unroll
        for (int ks = 0; ks < 4; ++ks) { AP_VF(fa0, fa1, vb_, ks); o0 = AP_MFMA(fa0, pf[ks], o0); o1 = AP_MFMA(fa1, pf[ks], o1); }
    }
    const float ltot = lrun + __shfl_xor(lrun, 32);
    const float inv = 1.0f / ltot;
#pragma unroll
    for (int g = 0; g < 4; ++g) {
        const int d0 = 8 * g + 4 * hi;
        u32x2 w0, w1;
        w0.x = cvtpk(o0[4 * g] * inv, o0[4 * g + 1] * inv); w0.y = cvtpk(o0[4 * g + 2] * inv, o0[4 * g + 3] * inv);
        w1.x = cvtpk(o1[4 * g] * inv, o1[4 * g + 1] * inv); w1.y = cvtpk(o1[4 * g + 2] * inv, o1[4 * g + 3] * inv);
        *(u32x2*)(O + (size_t)qrow * ldo + d0) = w0;
        *(u32x2*)(O + (size_t)qrow * ldo + 32 + d0) = w1;
    }
    __syncthreads();
#undef SBAR
#undef AP_LOADK
#undef AP_LOADV
#undef AP_WRITEK
#undef AP_WRITEV
#undef AP_KF
#undef AP_VF
#undef AP_MFMA
#undef AP_MASK
#undef AP_ROWMAX
#undef AP_STEPA
#undef AP_PK
#undef AP_EXP4
#undef AP_STEPB
#undef AP_ITER
}

#define XB_TMO      128
#define XB_XCNT(j)  (256  + 64 * (j))
#define XB_XSUB(j)  (1280 + 64 * (j))
#define XB_XGEN(j)  (2304 + 64 * (j))
#define XB_TOP      3328
#define XB_TOPGEN   3392
#define XCD_BAR_WORDS 3456
#define XB_SPIN_CAP (1u << 18)
DI unsigned xb_ld(unsigned* p) { return __hip_atomic_load(p, __ATOMIC_RELAXED, __HIP_MEMORY_SCOPE_AGENT); }
DI unsigned xb_add(unsigned* p, unsigned v) { return __hip_atomic_fetch_add(p, v, __ATOMIC_RELAXED, __HIP_MEMORY_SCOPE_AGENT); }
DI unsigned xb_xcc_id() { return (unsigned)__builtin_amdgcn_s_getreg((3 << 11) | 20) & 0xFu; }
#define XB_SPIN(cond, bar) do { unsigned _sp = 0; while (cond) { __builtin_amdgcn_s_sleep(1); \
    if ((++_sp & 255u) == 0u) { if (xb_ld(&(bar)[XB_TMO])) break; if (_sp > XB_SPIN_CAP) { atomicAdd(&(bar)[XB_TMO], 1u); break; } } } } while (0)
struct XcdBarrier { unsigned* bar; unsigned x; volatile LAS unsigned* st; int wid; };
DI XcdBarrier xcd_barrier_post(unsigned* bar, volatile LAS unsigned* st, int wid) {
    XcdBarrier b; b.bar = bar; b.x = xb_xcc_id(); b.st = st; b.wid = wid;
    if (wid == 0 && vlane() == 0) (void)xb_add(&bar[XB_XCNT(b.x)], 1u);
    return b;
}
DI void xcd_barrier_complete(unsigned* bar, unsigned x, unsigned& nloc, unsigned& nx) {
    const unsigned G = gridDim.x * gridDim.y * gridDim.z;
    unsigned sum, cnt, mine, sp = 0u;
    for (;;) {
        sum = 0u; cnt = 0u; mine = 0u;
#pragma unroll
        for (unsigned j = 0; j < 16; ++j) { const unsigned c = xb_ld(&bar[XB_XCNT(j)]); sum += c; cnt += (c > 0u) ? 1u : 0u; mine = (j == x) ? c : mine; }
        if (sum == G) break;
        __builtin_amdgcn_s_sleep(1);
        if ((++sp & 255u) == 0u) { if (xb_ld(&bar[XB_TMO])) break; if (sp > XB_SPIN_CAP) { atomicAdd(&bar[XB_TMO], 1u); break; } }
    }
    nloc = mine > 0u ? mine : 1u; nx = cnt > 0u ? cnt : 1u;
}
DI void xcd_barrier(const XcdBarrier& b) {
    asm volatile("s_waitcnt vmcnt(0)" ::: "memory");
    __syncthreads();
    if (b.wid == 0 && vlane() == 0) {
        unsigned* bar = b.bar;
        __builtin_amdgcn_s_waitcnt(0);
        unsigned nloc = b.st[0], nx = b.st[1];
        if (nloc == 0u) { xcd_barrier_complete(bar, b.x, nloc, nx); b.st[0] = nloc; b.st[1] = nx; }
        const unsigned old = xb_add(&bar[XB_XSUB(b.x)], 1u);
        const unsigned gen = old / nloc;
        if (old + 1u == (gen + 1u) * nloc) {
            __builtin_amdgcn_fence(__ATOMIC_RELEASE, "agent");
            asm volatile("s_waitcnt vmcnt(0)" ::: "memory");
            const unsigned og = xb_add(&bar[XB_TOP], 1u);
            const unsigned tg = og / nx;
            if (og + 1u == (tg + 1u) * nx) xb_add(&bar[XB_TOPGEN], 1u);
            else XB_SPIN(xb_ld(&bar[XB_TOPGEN]) == tg, bar);
            __builtin_amdgcn_fence(__ATOMIC_ACQUIRE, "agent");
            xb_add(&bar[XB_XGEN(b.x)], 1u);
            asm volatile("s_waitcnt vmcnt(0)" ::: "memory");
        } else {
            XB_SPIN(xb_ld(&bar[XB_XGEN(b.x)]) == gen, bar);
            __builtin_amdgcn_fence(__ATOMIC_ACQUIRE, "agent");
            asm volatile("s_waitcnt vmcnt(0)" ::: "memory");
        }
    }
    __syncthreads();
}

DI int next_unit(Frame& F, int widx) {
    LAS int* s = (LAS int*)(F.lds + LDS_CTL);
    __syncthreads();
    if (F.tid == 0) *s = (int)atomicAdd(F.ctl + CW_WORK + 64 * widx, 1u);
    __syncthreads();
    return *s;
}

DI void transpose_item(const float* W, int ldw, int srccol, int K, bf16_t* WT, int drow, LAS unsigned* scr, int k0, int lane, int nvalid) {
    const int n4 = lane & 15, kq = lane >> 4;
#pragma unroll 8
    for (int i = 0; i < 16; ++i) {
        const int kk = 4 * i + kq;
        f32x4 v = (f32x4){0.f, 0.f, 0.f, 0.f};
        if (4 * n4 < nvalid) v = *(const f32x4*)(W + (size_t)(k0 + kk) * ldw + srccol + 4 * n4);
        scr[kk * 33 + 2 * n4] = cvtpk(v[0], v[1]); scr[kk * 33 + 2 * n4 + 1] = cvtpk(v[2], v[3]);
    }
    LDS_WAIT(); asm volatile("" ::: "memory");
    const int c = lane & 7;
    const LAS unsigned short* s16 = (const LAS unsigned short*)scr;
#pragma unroll
    for (int j = 0; j < 8; ++j) {
        const int n = (lane >> 3) + 8 * j;
        const LAS unsigned short* sp = s16 + (8 * c) * 66 + n;
        u32x4 o;
        o.x = (unsigned)sp[0 * 66] | ((unsigned)sp[1 * 66] << 16); o.y = (unsigned)sp[2 * 66] | ((unsigned)sp[3 * 66] << 16);
        o.z = (unsigned)sp[4 * 66] | ((unsigned)sp[5 * 66] << 16); o.w = (unsigned)sp[6 * 66] | ((unsigned)sp[7 * 66] << 16);
        if (n < nvalid) *(u32x4*)(WT + (size_t)(drow + n) * K + k0 + 8 * c) = o;
    }
    LDS_WAIT(); asm volatile("" ::: "memory");
}
DI unsigned q8x4(float a, float b, float c, float d, float inv) {
    const float M = 12582912.0f;
    const unsigned ua = __float_as_uint(fmaf(a, inv, M)), ub = __float_as_uint(fmaf(b, inv, M)), uc = __float_as_uint(fmaf(c, inv, M)), ud = __float_as_uint(fmaf(d, inv, M));
    return __builtin_amdgcn_perm(ub, ua, 0x0c0c0400u) | __builtin_amdgcn_perm(ud, uc, 0x04000c0cu);
}
template <int QM>
DI void strip_item(const float* W, int ldw, int n0, unsigned char* dst, float* sc, LAS float* red, int tid) {
    const int c4 = tid & 15, kr = tid >> 4;
    const float* src = W + (size_t)(kr * 32) * ldw + n0 + 4 * c4;
    f32x4 v[32];
#pragma unroll
    for (int p = 0; p < 32; ++p) v[p] = *(const f32x4*)(src + (size_t)p * ldw);
    f32x4 m = (f32x4){0.f, 0.f, 0.f, 0.f};
#pragma unroll
    for (int p = 0; p < 32; ++p)
#pragma unroll
        for (int j = 0; j < 4; ++j) m[j] = fmaxf(m[j], fabsf(v[p][j]));
#pragma unroll
    for (int j = 0; j < 4; ++j) { m[j] = fmaxf(m[j], __shfl_xor(m[j], 16)); m[j] = fmaxf(m[j], __shfl_xor(m[j], 32)); }
    __syncthreads();
    if ((tid & 63) < 16) *(LAS f32x4*)(red + (tid >> 6) * 64 + 4 * c4) = m;
    __syncthreads();
#pragma unroll
    for (int w = 0; w < 8; ++w) { const f32x4 o = *(const LAS f32x4*)(red + w * 64 + 4 * c4);
#pragma unroll
        for (int j = 0; j < 4; ++j) m[j] = fmaxf(m[j], o[j]); }
    constexpr float QMAX = QM == 0 ? 127.0f : 448.0f;
    if (kr == 0) *(f32x4*)(sc + 4 * c4) = m * (1.0f / QMAX);
#pragma unroll
    for (int j = 0; j < 4; ++j) {
        const float inv = m[j] > 0.f ? QMAX / m[j] : 0.f;
        unsigned w[8];
#pragma unroll
        for (int q = 0; q < 8; ++q) {
            if constexpr (QM == 0) w[q] = q8x4(v[4 * q][j], v[4 * q + 1][j], v[4 * q + 2][j], v[4 * q + 3][j], inv);
            else w[q] = (unsigned)__builtin_amdgcn_cvt_pk_fp8_f32(v[4 * q + 2][j] * inv, v[4 * q + 3][j] * inv, __builtin_amdgcn_cvt_pk_fp8_f32(v[4 * q][j] * inv, v[4 * q + 1][j] * inv, 0, false), true);
        }
        u32x4* o = (u32x4*)(dst + (size_t)(4 * c4 + j) * 1024 + kr * 32);
        o[0] = (u32x4){w[0], w[1], w[2], w[3]}; o[1] = (u32x4){w[4], w[5], w[6], w[7]};
    }
}
constexpr int CONV_P1 = 2, CONV_A0 = 3, CONV_GU = 3, CONV_DN = 2, CONV_A1 = 6;
constexpr int MOE_S_GU = 32, MOE_S_DN = 16, MOE_STRIPS_PER_LAYER = 32 * (MOE_S_GU + MOE_S_DN);
DI void moe_convert_strip(unsigned char* ws, LAS float* red, int l, int r, int tid) {
    if (r < 32 * MOE_S_GU) {
        const int e = l * 32 + r / MOE_S_GU, nb = r % MOE_S_GU;
        const int jj = (nb & 15) * 64, drow = (jj >> 7) * 256 + (nb >> 4) * 128 + (jj & 127);
        strip_item<0>(KP->moe_w_gu + (size_t)e * 1024 * 2048, 2048, 64 * nb, ws + WS_W_GU + ((size_t)e * 2048 + drow) * 1024, (float*)(ws + WS_SGU) + (size_t)e * 2048 + drow, red, tid);
    } else {
        r -= 32 * MOE_S_GU;
        const int e = l * 32 + r / MOE_S_DN, nb = r % MOE_S_DN;
        strip_item<2>(KP->moe_w_dn + (size_t)e * 1024 * 1024, 1024, 64 * nb, ws + WS_W_DN + ((size_t)e * 1024 + 64 * nb) * 1024, (float*)(ws + WS_SDN) + (size_t)e * 1024 + 64 * nb, red, tid);
    }
}
constexpr int CW_CONVQ = CW_WORK + 64 * 8;
DI bool conv_pull(Frame& F, int l, int n) {
    LAS int* s = (LAS int*)(F.lds + LDS_CTL + 8);
    __syncthreads();
    if (F.tid == 0) *s = (int)atomicAdd(F.ctl + CW_CONVQ + 64 * l, (unsigned)n);
    __syncthreads();
    const int base = *s;
    for (int c = base; c < base + n && c < MOE_STRIPS_PER_LAYER; ++c) moe_convert_strip(F.ws, (LAS float*)F.lds, l, c, F.tid);
    __syncthreads();
    return base + n < MOE_STRIPS_PER_LAYER;
}
struct TrMat { const float* W; int ldw, col0, K, N; bf16_t* WT; int drow0, mode; };

DI void phase_prologue(Frame& F, const Params& P) {
    F.lane = vlane(); F.tid = F.wid * 64 + F.lane;
    LAS unsigned* scr = (LAS unsigned*)(F.lds + F.wid * 8448);
    const int gw = F.bid * 8 + F.wid, NGW = F.G * 8;
    unsigned char* ws = F.ws;
    TrMat mats[11];
    mats[0] = TrMat{KP->a_w_in, FOX_IN, 0, 1024, 1536, (bf16_t*)(ws + WS_W_AIN), 0, 0};
    mats[1] = TrMat{KP->a_w_in, FOX_IN, 2316, 1024, 256, (bf16_t*)(ws + WS_W_AIN), 1536, 0};
    mats[2] = TrMat{KP->a_w_in, FOX_IN, 1536, 1024, 768, (bf16_t*)(ws + WS_W_AIN), 1792, 0};
    mats[3] = TrMat{KP->a_w_out, 1024, 0, 1024, 1024, (bf16_t*)(ws + WS_W_AOUT), 0, 0};
    mats[4] = TrMat{KP->kv_w_dkv, 288, 0, 1024, 288, (bf16_t*)(ws + WS_W_BIN), 0, 0};
    mats[5] = TrMat{KP->b_w_in, 640, 0, 1024, 640, (bf16_t*)(ws + WS_W_BIN), 288, 0};
    mats[6] = TrMat{KP->b_w_uq, 1152, 0, 384, 1152, (bf16_t*)(ws + WS_W_UQ), 0, 0};
    mats[7] = TrMat{KP->kv_w_ukv, 1536, 0, 256, 1536, (bf16_t*)(ws + WS_W_UKV), 0, 1};
    mats[8] = TrMat{KP->b_w_out, 1024, 0, 1024, 1024, (bf16_t*)(ws + WS_W_BOUT), 0, 0};
    mats[9] = TrMat{KP->mem_w_kv, 512, 0, 1024, 512, (bf16_t*)(ws + WS_W_MKV), 0, 0};
    mats[10] = TrMat{KP->mem_w_kv + (size_t)1024 * 512, 512, 0, 1024, 512, (bf16_t*)(ws + WS_W_MKV) + (size_t)512 * 1024, 0, 0};
    int nsmall = 0;
#pragma unroll
    for (int i = 0; i < 11; ++i) nsmall += (mats[i].K / 64) * ((mats[i].N + 63) / 64);
    const int ntot = nsmall;
    for (int it = gw; it < ntot; it += NGW) {
        int r = it;
        if (r < nsmall) {
#pragma unroll
            for (int i = 0; i < 11; ++i) {
                const int nblk = (mats[i].N + 63) / 64, ni = (mats[i].K / 64) * nblk;
                if (r >= 0 && r < ni) {
                    const int kb = r / nblk, nb = r % nblk;
                    const int drow = mats[i].mode == 1 ? ((nb & 1) * 768 + (nb >> 1) * 64) : (mats[i].drow0 + 64 * nb);
                    transpose_item(mats[i].W, mats[i].ldw, mats[i].col0 + 64 * nb, mats[i].K, mats[i].WT, drow, scr, 64 * kb, F.lane, mats[i].N - 64 * nb);
                }
                r -= ni;
            }
            continue;
        }
    }
    __syncthreads();
    LAS float* wf = (LAS float*)F.lds;
    for (int i = F.tid; i < 1024 * 12; i += NTHREADS) { const int k = i / 12, h = i % 12; wf[i] = KP->a_w_in[(size_t)k * FOX_IN + 2304 + h]; }
    __syncthreads();
    float* logf = (float*)(ws + WS_LOGF);
    bf16_t* xb = (bf16_t*)(ws + WS_XB);
    for (int row = gw; row < T; row += NGW) {
        const f32x4* xr = (const f32x4*)(KP->x + (size_t)row * DM) + F.lane;
        f32x4 v[4];
#pragma unroll
        for (int j = 0; j < 4; ++j) v[j] = xr[64 * j];
        u32x2* o8 = (u32x2*)(xb + (size_t)row * DM) + F.lane;
#pragma unroll
        for (int j = 0; j < 4; ++j) o8[64 * j] = (u32x2){cvtpk(v[j][0], v[j][1]), cvtpk(v[j][2], v[j][3])};
        float part[12];
#pragma unroll
        for (int h = 0; h < 12; ++h) part[h] = 0.f;
#pragma unroll
        for (int j = 0; j < 4; ++j)
#pragma unroll
            for (int i = 0; i < 4; ++i) {
                const int k = 4 * F.lane + 256 * j + i;
                const LAS f32x4* wp = (const LAS f32x4*)(wf + k * 12);
                const f32x4 w0 = wp[0], w1 = wp[1], w2 = wp[2];
                const float xv = v[j][i];
                part[0] += xv * w0[0]; part[1] += xv * w0[1]; part[2] += xv * w0[2]; part[3] += xv * w0[3];
                part[4] += xv * w1[0]; part[5] += xv * w1[1]; part[6] += xv * w1[2]; part[7] += xv * w1[3];
                part[8] += xv * w2[0]; part[9] += xv * w2[1]; part[10] += xv * w2[2]; part[11] += xv * w2[3];
            }
        float mine = 0.f;
#pragma unroll
        for (int h = 0; h < 12; ++h) { const float s = wave_sum(part[h]); if (F.lane == h) mine = s; }
        if (F.lane < 12) {
            const float z = mine + KP->a_b_f[F.lane];
            const float ls = fminf(z, 0.f) - log1pf(expf(-fabsf(z)));
            const int b = row / SEQ, s = row % SEQ;
            logf[(size_t)(b * NH + F.lane) * SEQ + s] = ls;
        }
    }
    {
        float* wrt = (float*)(ws + WS_WRT);
        bf16_t* wrh = (bf16_t*)(ws + WS_WRH); bf16_t* wrl = (bf16_t*)(ws + WS_WRL);
        for (int i = F.bid * NTHREADS + F.tid; i < 2 * 1024 * 32; i += F.G * NTHREADS) { const int l = i >> 15, k = (i >> 5) & 1023, e = i & 31; const float w = KP->moe_w_r[i];
            const unsigned hb = cvtpk(w, 0.f) & 0xffffu; const float hf = __uint_as_float(hb << 16);
            wrt[(size_t)(l * 32 + e) * 1024 + k] = w; wrh[(size_t)(l * 32 + e) * 1024 + k] = (bf16_t)hb; wrl[(size_t)(l * 32 + e) * 1024 + k] = (bf16_t)(cvtpk(w - hf, 0.f) & 0xffffu); }
    }
    bf16_t* memb = (bf16_t*)(ws + WS_MEMB);
    for (int row = gw; row < NB * NMEM; row += NGW) {
        const f32x4* xr = (const f32x4*)(KP->mem + (size_t)row * DM) + F.lane;
        u32x2* o8 = (u32x2*)(memb + (size_t)row * DM) + F.lane;
#pragma unroll
        for (int j = 0; j < 4; ++j) { const f32x4 v = xr[64 * j]; o8[64 * j] = (u32x2){cvtpk(v[0], v[1]), cvtpk(v[2], v[3])}; }
    }
}

DI void scan_unit(Frame& F, int bh) {
    const float* src = (const float*)(F.ws + WS_LOGF) + (size_t)bh * SEQ;
    float* dst = (float*)(F.ws + WS_CUM) + (size_t)bh * SEQ;
    LAS float* wtot = (LAS float*)F.lds;
    float v[16];
#pragma unroll
    for (int j = 0; j < 4; ++j) { const f32x4 t = *(const f32x4*)(src + F.tid * 16 + 4 * j); v[4 * j] = t[0]; v[4 * j + 1] = t[1]; v[4 * j + 2] = t[2]; v[4 * j + 3] = t[3]; }
#pragma unroll
    for (int i = 1; i < 16; ++i) v[i] += v[i - 1];
    float tot = v[15];
    float inc = tot;
#pragma unroll
    for (int o = 1; o < 64; o <<= 1) { const float t = __shfl_up(inc, o); if (F.lane >= o) inc += t; }
    __syncthreads();
    if (F.lane == 63) wtot[F.wid] = inc;
    __syncthreads();
    float base = inc - tot;
    for (int w = 0; w < F.wid; ++w) base += wtot[w];
#pragma unroll
    for (int j = 0; j < 4; ++j) {
        f32x4 t; t[0] = (base + v[4 * j]) * LOG2E; t[1] = (base + v[4 * j + 1]) * LOG2E; t[2] = (base + v[4 * j + 2]) * LOG2E; t[3] = (base + v[4 * j + 3]) * LOG2E;
        *(f32x4*)(dst + F.tid * 16 + 4 * j) = t;
    }
    __syncthreads();
}

struct RouteQKM { unsigned char* ws; DI Dst operator()(const pg8::Unit& u) const {
    if (u.pn < 3) return Dst{(bf16_t*)(ws + WS_Q), 768, u.pm * 256, u.pn * 256, 256, 0.125f * LOG2E, false};
    if (u.pn < 6) return Dst{(bf16_t*)(ws + WS_K), 768, u.pm * 256, (u.pn - 3) * 256, 256, 1.0f, false};
    return Dst{(bf16_t*)(ws + WS_MQ), 256, u.pm * 256, 0, 256, 0.125f * LOG2E, false}; } };
struct RouteVT { unsigned char* ws; DI Dst operator()(const pg8::Unit& u) const {
    const int b = u.pn >> 5; return Dst{(bf16_t*)(ws + WS_VT) + (size_t)b * 768 * SEQ, SEQ, u.pm * 256, (u.pn & 31) * 256, 256, 1.0f, false}; } };
struct RoutePlain { bf16_t* O; int ldo; DI Dst operator()(const pg8::Unit& u) const { return Dst{O, ldo, u.pm * 256, u.pn * 256, 256, 1.0f, false}; } };
DI void phase_proj0(Frame& F, const Params& P) {
    F.lane = vlane(); F.tid = F.wid * 64 + F.lane;
    unsigned char* ws = F.ws;
    const bf16_t* xb = (const bf16_t*)(ws + WS_XB);
    const bf16_t* win = (const bf16_t*)(ws + WS_W_AIN);
    const bf16_t* memb = (const bf16_t*)(ws + WS_MEMB);
    {
        pg8::Gemm g{xb, win, 1024}; pg8::StaticOrder S; S.init(T, 1792, 1024, F.G, F.bid);
        EpiBf16R<RouteQKM> E{RouteQKM{ws}};
        pg8::gemm_phase<EpiBf16R<RouteQKM>, pg8::StaticOrder, true>(F.lds, g, S, E, F.wid);
    }
    {
        pg8::Gemm g{win + (size_t)1792 * 1024, xb, 1024}; pg8::StaticOrder S; S.init(768, T, 1024, F.G, (F.bid + 64) % F.G);
        EpiBf16R<RouteVT> E{RouteVT{ws}};
        pg8::gemm_phase<EpiBf16R<RouteVT>, pg8::StaticOrder, true>(F.lds, g, S, E, F.wid);
    }
    for (int l = 0; l < 2; ++l) {
        const bf16_t* wk = (const bf16_t*)(ws + WS_W_MKV) + (size_t)l * 512 * 1024;
        {
            pg8::Gemm g{memb, wk, 1024}; pg8::StaticOrder S; S.init(512, 256, 1024, F.G, (F.bid + F.G - (152 + 4 * l)) % F.G);
            EpiBf16R<RoutePlain> E{RoutePlain{(bf16_t*)(ws + WS_MK) + (size_t)l * 512 * 256, 256}};
            pg8::gemm_phase<EpiBf16R<RoutePlain>, pg8::StaticOrder, true>(F.lds, g, S, E, F.wid);
        }
        for (int b = 0; b < 2; ++b) {
            pg8::Gemm g{wk + (size_t)256 * 1024, memb + (size_t)b * 256 * 1024, 1024}; pg8::StaticOrder S; S.init(256, 256, 1024, F.G, (F.bid + F.G - (154 + 4 * l + b)) % F.G);
            EpiBf16R<RoutePlain> E{RoutePlain{(bf16_t*)(ws + WS_MVT) + (size_t)(l * 2 + b) * 256 * 256, 256}};
            pg8::gemm_phase<EpiBf16R<RoutePlain>, pg8::StaticOrder, true>(F.lds, g, S, E, F.wid);
        }
    }
    if (F.G == 256 && F.bid >= 128) conv_pull(F, 0, CONV_P1);
}


DI void phase_scan_knorm(Frame& F) {
    F.lane = vlane(); F.tid = F.wid * 64 + F.lane;
    unsigned char* ws = F.ws;
    if (F.bid < 24) scan_unit(F, F.bid);
    const bf16_t* K = (const bf16_t*)(ws + WS_K);
    float* kn2 = (float*)(ws + WS_KN2);
    const int gw = F.bid * 8 + F.wid, NGW = F.G * 8;
    for (int it = gw; it < 24 * 128; it += NGW) {
        const int bh = it >> 7, j = it & 127, b = bh / 12, h = bh % 12;
        const u32x4* kr = (const u32x4*)(K + (size_t)(b * SEQ + 64 * j + F.lane) * 768 + h * 64);
        float ss = 0.f;
#pragma unroll
        for (int c = 0; c < 8; ++c) {
            const u32x4 w = kr[c];
            const unsigned ww[4] = {w.x, w.y, w.z, w.w};
#pragma unroll
            for (int i = 0; i < 4; ++i) { const float a = __uint_as_float(ww[i] << 16), bb = __uint_as_float(ww[i] & 0xffff0000u); ss += a * a + bb * bb; }
        }
        ss = wave_max(ss);
        if (F.lane == 0) kn2[it] = ss;
    }
}

DI void mem_attn_unit(Frame& F, int l, int v) {
    unsigned char* ws = F.ws;
    const int qb = v >> 3, bm = v & 7, b = bm >> 2, mh = bm & 3;
    const bf16_t* Q = (const bf16_t*)(ws + WS_MQ) + (size_t)b * SEQ * 256 + mh * 64;
    const bf16_t* K = (const bf16_t*)(ws + WS_MK) + (size_t)l * 512 * 256 + (size_t)b * 256 * 256 + mh * 64;
    const bf16_t* Vt = (const bf16_t*)(ws + WS_MVT) + (size_t)(l * 2 + b) * 256 * 256 + (size_t)mh * 64 * 256;
    bf16_t* O = (bf16_t*)(ws + WS_MERGED) + (size_t)b * SEQ * 1024 + 768 + mh * 64;
    attn_unit<64, false, false>(F.lds, Q, 256, K, 256, Vt, 256, nullptr, O, 1024, qb * 256, 4, false, nullptr, F.wid);
}
DI void phase_attn0(Frame& F, const Params& P) {
    F.lane = vlane(); F.tid = F.wid * 64 + F.lane;
    unsigned char* ws = F.ws;
    constexpr int NU = 768 + 256 + 512;
    for (;;) {
        const int uu = next_unit(F, 0);
        if (uu >= NU) break;
        if (uu % 3 == 2) { conv_pull(F, 0, CONV_A0); continue; }
        const int u = 2 * (uu / 3) + uu % 3;
        if (u < 768) {
            const int qb = 31 - u / 24, bh = u % 24, b = bh / 12, h = bh % 12;
            const bf16_t* Q = (const bf16_t*)(ws + WS_Q) + (size_t)b * SEQ * 768 + h * 64;
            const bf16_t* K = (const bf16_t*)(ws + WS_K) + (size_t)b * SEQ * 768 + h * 64;
            const bf16_t* Vt = (const bf16_t*)(ws + WS_VT) + (size_t)(b * 768 + h * 64) * SEQ;
            const float* cum = (const float*)(ws + WS_CUM) + (size_t)bh * SEQ;
            bf16_t* O = (bf16_t*)(ws + WS_MERGED) + (size_t)b * SEQ * 1024 + h * 64;
            attn_unit<64, true, false>(F.lds, Q, 768, K, 768, Vt, SEQ, cum, O, 1024, qb * 256, 4 * (qb + 1), true, nullptr, F.wid, (const float*)(ws + WS_KN2) + bh * 128);
        } else mem_attn_unit(F, 0, u - 768);
    }
    while (conv_pull(F, 0, 16)) {}
}
DI void phase_attn1(Frame& F, const Params& P) {
    F.lane = vlane(); F.tid = F.wid * 64 + F.lane;
    unsigned char* ws = F.ws;
    constexpr int NCONV = 256, NU = 768 + 256 + NCONV;
    for (;;) {
        const int uu = next_unit(F, 1);
        if (uu >= NU) break;
        if (uu % 5 == 4) { conv_pull(F, 1, CONV_A1); continue; }
        const int u = 4 * (uu / 5) + uu % 5;
        if (u < 768) {
            const int qb = 31 - u / 24, bh = u % 24, b = bh / 12, h = bh % 12;
            const bf16_t* Q = (const bf16_t*)(ws + WS_Q) + (size_t)b * SEQ * 1152 + h * 96;
            const bf16_t* K = (const bf16_t*)(ws + WS_K) + (size_t)b * SEQ * 1152 + h * 96;
            const bf16_t* Vt = (const bf16_t*)(ws + WS_VT) + (size_t)(b * 768 + h * 64) * SEQ;
            bf16_t* O = (bf16_t*)(ws + WS_MERGED) + (size_t)b * SEQ * 1024 + h * 64;
            attn_unit_pipe<96, true>(F.lds, Q, 1152, K, 1152, Vt, SEQ, O, 1024, qb * 256, 4 * (qb + 1), KP->pos + (size_t)b * SEQ, F.wid);
        } else mem_attn_unit(F, 1, u - 768);
    }
    while (conv_pull(F, 1, 16)) {}
}

DI void phase_outproj(Frame& F, const bf16_t* Wt) {
    F.lane = vlane(); F.tid = F.wid * 64 + F.lane;
    unsigned char* ws = F.ws;
    pg8::Gemm g{(const bf16_t*)(ws + WS_MERGED), Wt, 1024}; pg8::StaticOrder S; S.init(T, 1024, 1024, F.G, F.bid);
    EpiResB16 E{(bf16_t*)(ws + WS_Y), (const bf16_t*)(ws + WS_XB)};
    pg8::gemm_phase<EpiResB16, pg8::StaticOrder, false>(F.lds, g, S, E, F.wid);
}


DI void phase_ln_router(Frame& F, const Params& P, int l) {
    F.lane = vlane(); F.tid = F.wid * 64 + F.lane;
    unsigned char* ws = F.ws;
    LAS unsigned char* wH = F.lds;
    LAS unsigned char* wL = F.lds + 65536;
    LAS int* pairs = (LAS int*)(F.lds + LDS_CTL + 1024);
    LAS int* lcnt = (LAS int*)(F.lds + LDS_CTL + 3072); LAS int* gbase = lcnt + 32;
    LAS float* lg = (LAS float*)(F.lds + LDS_R1X + F.wid * 1280);
    LAS int* rec = (LAS int*)(F.lds + LDS_R1X + F.wid * 1280 + 1024);
    LAS float* stt = (LAS float*)(F.lds + LDS_R1X + 8 * 1280 + F.wid * 64);
    __syncthreads();
    {
        const u32x4* srcH = (const u32x4*)((const bf16_t*)(ws + WS_WRH) + (size_t)l * 32 * 1024);
        const u32x4* srcL = (const u32x4*)((const bf16_t*)(ws + WS_WRL) + (size_t)l * 32 * 1024);
        for (int i = F.tid; i < 32 * 128; i += NTHREADS) { const int e = i >> 7, c = i & 127; const int off = e * 2048 + ((c ^ (e & 7)) << 4);
            *(LAS u32x4*)(wH + off) = srcH[i]; *(LAS u32x4*)(wL + off) = srcL[i]; }
    }
    if (F.tid < 32) lcnt[F.tid] = 0;
    __syncthreads();
    const float* g = KP->ln_g + (size_t)(l * 2 + 0) * DM; const float* bt = KP->ln_b + (size_t)(l * 2 + 0) * DM;
    const float* br = KP->moe_b_r + l * 32;
    const bf16_t* Y = (const bf16_t*)(ws + WS_Y);
    unsigned char* X1Q = ws + WS_X1B;
    float* SAS = (float*)(ws + WS_SAS);
    int* PE = (int*)(ws + WS_PE); int* PPOS = (int*)(ws + WS_PPOS); float* GATE = (float*)(ws + WS_GATE); int* TOKOF = (int*)(ws + WS_TOKOF);
    unsigned* cnt = F.ctl + CW_CNT + l * 32 * 64;
    const int gw = F.bid * 8 + F.wid, NGW = F.G * 8;
    int it = 0;
    u32x2 vnx[4];
    if (gw < T) {
#pragma unroll
        for (int j = 0; j < 4; ++j) vnx[j] = *((const u32x2*)(Y + (size_t)gw * DM) + F.lane + 64 * j);
    }
    for (int row = gw; row < T; row += NGW, ++it) {
        f32x4 v[4]; float s = 0.f;
#pragma unroll
        for (int j = 0; j < 4; ++j) { v[j] = bf4(vnx[j]); s += (v[j][0] + v[j][1]) + (v[j][2] + v[j][3]); }
        if (row + NGW < T) {
#pragma unroll
            for (int j = 0; j < 4; ++j) vnx[j] = *((const u32x2*)(Y + (size_t)(row + NGW) * DM) + F.lane + 64 * j);
        }
        const float mean = wave_sum(s) * (1.f / DM); float s2 = 0.f;
#pragma unroll
        for (int j = 0; j < 4; ++j) { v[j] = v[j] - mean; s2 += (v[j][0] * v[j][0] + v[j][1] * v[j][1]) + (v[j][2] * v[j][2] + v[j][3] * v[j][3]); }
        const float rstd = 1.0f / sqrtf(wave_sum(s2) * (1.f / DM) + LN_EPS);
        float am = 0.f;
#pragma unroll
        for (int j = 0; j < 4; ++j) {
            const f32x4 gg = *((const f32x4*)g + F.lane + 64 * j), bb = *((const f32x4*)bt + F.lane + 64 * j);
            v[j] = v[j] * rstd * gg + bb;
            am = fmaxf(fmaxf(am, fmaxf(fabsf(v[j][0]), fabsf(v[j][1]))), fmaxf(fabsf(v[j][2]), fabsf(v[j][3])));
        }
        am = wave_max(am);
        const float qinv = am > 0.f ? 127.0f / am : 0.f;
#pragma unroll
        for (int j = 0; j < 4; ++j) *((unsigned*)(X1Q + (size_t)row * DM) + F.lane + 64 * j) = q8x4(v[j][0], v[j][1], v[j][2], v[j][3], qinv);
        if (F.lane == 0) { stt[2 * (it & 7)] = mean; stt[2 * (it & 7) + 1] = rstd; pairs[(F.wid * 16 + 8 + (it & 7)) * 4] = (int)__float_as_uint(am * (1.0f / 127.0f)); }
    }
    asm volatile("s_waitcnt lgkmcnt(0)" ::: "memory");
    {
        const int r16 = F.lane & 15, kg = F.lane >> 4;
        const int arow = gw + NGW * (r16 & 7);
        const float mean = stt[2 * (r16 & 7)], rstd = stt[2 * (r16 & 7) + 1];
        const bf16_t* yr = Y + (size_t)(arow < T ? arow : gw) * DM + 8 * kg;
        const float* gp = g + 8 * kg; const float* bp = bt + 8 * kg;
        f32x4 acc0 = (f32x4){0.f, 0.f, 0.f, 0.f}, acc1 = (f32x4){0.f, 0.f, 0.f, 0.f};
        const int e0 = r16, e1 = 16 + r16;
        const int b0off = e0 * 2048, b1off = e1 * 2048, sw = r16 & 7;
#pragma unroll 4
        for (int s2 = 0; s2 < 32; ++s2) {
            const u32x4 yw = *(const u32x4*)(yr + 32 * s2); const f32x4 y0 = bf4((u32x2){yw.x, yw.y}), y1 = bf4((u32x2){yw.z, yw.w});
            const f32x4 g0 = *(const f32x4*)(gp + 32 * s2), g1 = *(const f32x4*)(gp + 32 * s2 + 4);
            const f32x4 c0 = *(const f32x4*)(bp + 32 * s2), c1 = *(const f32x4*)(bp + 32 * s2 + 4);
            const f32x4 x0 = (y0 - mean) * rstd * g0 + c0, x1 = (y1 - mean) * rstd * g1 + c1;
            u32x4 ah, al;
            ah.x = cvtpk(x0[0], x0[1]); ah.y = cvtpk(x0[2], x0[3]); ah.z = cvtpk(x1[0], x1[1]); ah.w = cvtpk(x1[2], x1[3]);
            al.x = cvtpk(x0[0] - __uint_as_float(ah.x << 16), x0[1] - __uint_as_float(ah.x & 0xffff0000u)); al.y = cvtpk(x0[2] - __uint_as_float(ah.y << 16), x0[3] - __uint_as_float(ah.y & 0xffff0000u));
            al.z = cvtpk(x1[0] - __uint_as_float(ah.z << 16), x1[1] - __uint_as_float(ah.z & 0xffff0000u)); al.w = cvtpk(x1[2] - __uint_as_float(ah.w << 16), x1[3] - __uint_as_float(ah.w & 0xffff0000u));
            const bf16x8 Ah = __builtin_bit_cast(bf16x8, ah), Al = __builtin_bit_cast(bf16x8, al);
            const int co = (((4 * s2 + kg) ^ sw) << 4);
            const bf16x8 Bh0 = *(const LAS bf16x8*)(wH + b0off + co), Bl0 = *(const LAS bf16x8*)(wL + b0off + co);
            const bf16x8 Bh1 = *(const LAS bf16x8*)(wH + b1off + co), Bl1 = *(const LAS bf16x8*)(wL + b1off + co);
            acc0 = __builtin_amdgcn_mfma_f32_16x16x32_bf16(Ah, Bh0, acc0, 0, 0, 0); acc0 = __builtin_amdgcn_mfma_f32_16x16x32_bf16(Al, Bh0, acc0, 0, 0, 0); acc0 = __builtin_amdgcn_mfma_f32_16x16x32_bf16(Ah, Bl0, acc0, 0, 0, 0);
            acc1 = __builtin_amdgcn_mfma_f32_16x16x32_bf16(Ah, Bh1, acc1, 0, 0, 0); acc1 = __builtin_amdgcn_mfma_f32_16x16x32_bf16(Al, Bh1, acc1, 0, 0, 0); acc1 = __builtin_amdgcn_mfma_f32_16x16x32_bf16(Ah, Bl1, acc1, 0, 0, 0);
        }
        if (kg < 2) {
            const float bb0 = br[e0], bb1 = br[e1];
#pragma unroll
            for (int r = 0; r < 4; ++r) { lg[(4 * kg + r) * 32 + e0] = acc0[r] + bb0; lg[(4 * kg + r) * 32 + e1] = acc1[r] + bb1; }
        }
        asm volatile("s_waitcnt lgkmcnt(0)" ::: "memory");
        const int rr = F.lane >> 3, sub = F.lane & 7;
        f32x4 vv[8];
#pragma unroll
        for (int q = 0; q < 8; ++q) vv[q] = *(const LAS f32x4*)(lg + rr * 32 + 4 * q);
        const f32x4 mine = *(const LAS f32x4*)(lg + rr * 32 + 4 * sub);
        int rk[4] = {0, 0, 0, 0};
#pragma unroll
        for (int q = 0; q < 8; ++q)
#pragma unroll
            for (int i = 0; i < 4; ++i) {
                const float ve = vv[q][i]; const int ee = 4 * q + i;
#pragma unroll
                for (int c = 0; c < 4; ++c) rk[c] += (ve > mine[c] || (ve == mine[c] && ee < 4 * sub + c)) ? 1 : 0;
            }
#pragma unroll
        for (int c = 0; c < 4; ++c) if (rk[c] < 4) { rec[(rr * 4 + rk[c]) * 2] = 4 * sub + c; rec[(rr * 4 + rk[c]) * 2 + 1] = (int)__float_as_uint(mine[c]); }
        asm volatile("s_waitcnt lgkmcnt(0)" ::: "memory");
        const int te0 = rec[(rr * 4 + 0) * 2], te1 = rec[(rr * 4 + 1) * 2], te2 = rec[(rr * 4 + 2) * 2], te3 = rec[(rr * 4 + 3) * 2];
        const float tv0 = __uint_as_float((unsigned)rec[(rr * 4 + 0) * 2 + 1]), tv1 = __uint_as_float((unsigned)rec[(rr * 4 + 1) * 2 + 1]);
        const float tv2 = __uint_as_float((unsigned)rec[(rr * 4 + 2) * 2 + 1]), tv3 = __uint_as_float((unsigned)rec[(rr * 4 + 3) * 2 + 1]);
        const float e1_ = __expf(tv1 - tv0), e2_ = __expf(tv2 - tv0), e3_ = __expf(tv3 - tv0);
        const float rs = 1.0f / (1.0f + e1_ + e2_ + e3_);
        const int row = gw + NGW * rr;
        if (sub < 4 && row < T) {
            const int k = sub;
            const int e = k == 0 ? te0 : k == 1 ? te1 : k == 2 ? te2 : te3;
            const float gt = (k == 0 ? 1.0f : k == 1 ? e1_ : k == 2 ? e2_ : e3_) * rs;
            const int rnk = __hip_atomic_fetch_add(lcnt + e, 1, __ATOMIC_RELAXED, __HIP_MEMORY_SCOPE_WORKGROUP);
            PE[row * 4 + k] = e; GATE[row * 4 + k] = gt; pairs[(F.wid * 16 + rr) * 4 + k] = e | (rnk << 8);
        }
    }
    __syncthreads();
    if (F.tid < 32) { const int c = lcnt[F.tid]; gbase[F.tid] = c ? (int)atomicAdd(cnt + F.tid * 64, (unsigned)c) : 0; }
    __syncthreads();
    it = 0;
    for (int row = gw; row < T; row += NGW, ++it) {
        if (F.lane < 4) {
            const int pr = pairs[(F.wid * 16 + (it & 15)) * 4 + F.lane], e = pr & 255, p = gbase[e] + (pr >> 8);
            PPOS[row * 4 + F.lane] = p; TOKOF[(size_t)e * T + p] = row; SAS[(size_t)e * T + p] = __uint_as_float((unsigned)pairs[(F.wid * 16 + 8 + (it & 7)) * 4]);
        }
    }
}

DI void moe_tables(Frame& F, int l, LAS int* tstart, LAS int* soff) {
    __syncthreads();
    if (F.tid == 0) {
        int ts = 0;
        for (int e = 0; e < 32; ++e) {
            const int c = (int)__hip_atomic_load(F.ctl + CW_CNT + (l * 32 + e) * 64, __ATOMIC_RELAXED, __HIP_MEMORY_SCOPE_AGENT);
            tstart[e] = ts; soff[e] = ts * 256; tstart[80 + e] = c; ts += (c + 255) >> 8;
        }
        tstart[32] = ts; soff[32] = ts * 256;
    }
    __syncthreads();
}
DI void phase_moe_gu(Frame& F, const Params& P, int l) {
    F.lane = vlane(); F.tid = F.wid * 64 + F.lane;
    unsigned char* ws = F.ws;
    LAS int* tstart = (LAS int*)(F.lds + LDS_CTL + 64); LAS int* soff = tstart + 40;
    moe_tables(F, l, tstart, soff);
    pg8::Gemm g{(const bf16_t*)(ws + WS_X1B), (const bf16_t*)(ws + WS_W_GU + (size_t)l * 32 * 2048 * 1024), 512};
    LAS int* ulist = (LAS int*)(F.lds + LDS_CTL + 3328);
    MoeOrder::build(F, tstart, 8, ulist);
    MoeOrder S{tstart, 3, true, (const int*)(ws + WS_TOKOF), (const LAS int*)(F.lds + LDS_CTL + 1024), ulist, 1024u};
    EpiGU E{ws + WS_H, KP->moe_b_gu + (size_t)l * 32 * 2048, (const float*)(ws + WS_SGU) + (size_t)l * 32 * 2048, (const float*)(ws + WS_SAS), tstart};
    pg8::gemm_phase<EpiGU, MoeOrder, true, 1>(F.lds, g, S, E, F.wid);
    if (l == 0) { const int rem = (tstart[32] * 8) % F.G; if (rem && F.bid >= rem) conv_pull(F, 1, CONV_GU); }
}
DI void phase_moe_dn(Frame& F, const Params& P, int l) {
    F.lane = vlane(); F.tid = F.wid * 64 + F.lane;
    unsigned char* ws = F.ws;
    LAS int* tstart = (LAS int*)(F.lds + LDS_CTL + 64); LAS int* soff = tstart + 40;
    moe_tables(F, l, tstart, soff);
    pg8::Gemm g{(const bf16_t*)(ws + WS_H), (const bf16_t*)(ws + WS_W_DN + (size_t)l * 32 * 1024 * 1024), 512};
    LAS int* ulist = (LAS int*)(F.lds + LDS_CTL + 3328);
    MoeOrder::build(F, tstart, 4, ulist);
    MoeOrderDN S{ulist};
    EpiDN E{(bf16_t*)(ws + WS_YE), KP->moe_b_dn + (size_t)l * 32 * 1024, (const float*)(ws + WS_SDN) + (size_t)l * 32 * 1024};
    pg8::gemm_phase<EpiDN, MoeOrderDN, true, 2>(F.lds, g, S, E, F.wid);
    F.lane = vlane(); F.tid = F.wid * 64 + F.lane;
    if (l == 0) { const int rem = (tstart[32] * 4) % F.G; if (rem && F.bid >= rem) conv_pull(F, 1, CONV_DN); }
}


DI void phase_combine(Frame& F, const Params& P, int l, float* outf, bf16_t* outb) {
    F.lane = vlane(); F.tid = F.wid * 64 + F.lane;
    unsigned char* ws = F.ws;
    LAS int* tstart = (LAS int*)(F.lds + LDS_CTL + 64); LAS int* soff = tstart + 40;
    moe_tables(F, l, tstart, soff);
    const float* g = KP->ln_g + (size_t)(l * 2 + 1) * DM; const float* bt = KP->ln_b + (size_t)(l * 2 + 1) * DM;
    const bf16_t* X1 = (const bf16_t*)(ws + WS_Y); const bf16_t* YE = (const bf16_t*)(ws + WS_YE);
    const float* g1 = KP->ln_g + (size_t)(l * 2 + 0) * DM; const float* b1 = KP->ln_b + (size_t)(l * 2 + 0) * DM;
    const int* PE = (const int*)(ws + WS_PE); const int* PPOS = (const int*)(ws + WS_PPOS); const float* GATE = (const float*)(ws + WS_GATE);
    const int gw = F.bid * 8 + F.wid, NGW = F.G * 8;
    i32x4 ie, ip; f32x4 ig;
    u32x2 xn[4]; u32x2 yn[4][4]; f32x4 gn;
#define CB_LOADIDX(r) do { ie = *(const i32x4*)(PE + (size_t)(r) * 4); ip = *(const i32x4*)(PPOS + (size_t)(r) * 4); ig = *(const f32x4*)(GATE + (size_t)(r) * 4); } while (0)
#define CB_LOADDATA(r) do { gn = ig; \
        _Pragma("unroll") for (int j = 0; j < 4; ++j) xn[j] = *((const u32x2*)(X1 + (size_t)(r) * DM) + F.lane + 64 * j); \
        _Pragma("unroll") for (int k = 0; k < 4; ++k) { const int slot = soff[ie[k]] + ip[k]; const u32x2* yr = (const u32x2*)(YE + (size_t)slot * 1024) + F.lane; \
            _Pragma("unroll") for (int j = 0; j < 4; ++j) yn[k][j] = yr[64 * j]; } } while (0)
    if (gw < T) { CB_LOADIDX(gw); CB_LOADDATA(gw); if (gw + NGW < T) CB_LOADIDX(gw + NGW); }
    for (int row = gw; row < T; row += NGW) {
        f32x4 v[4]; u32x2 yc[4][4]; f32x4 gc = gn;
        {
            float s0 = 0.f;
#pragma unroll
            for (int j = 0; j < 4; ++j) { v[j] = bf4(xn[j]); s0 += (v[j][0] + v[j][1]) + (v[j][2] + v[j][3]); }
            const float mean0 = wave_sum(s0) * (1.f / DM); float q0 = 0.f;
#pragma unroll
            for (int j = 0; j < 4; ++j) { v[j] = v[j] - mean0; q0 += (v[j][0] * v[j][0] + v[j][1] * v[j][1]) + (v[j][2] * v[j][2] + v[j][3] * v[j][3]); }
            const float rstd0 = 1.0f / sqrtf(wave_sum(q0) * (1.f / DM) + LN_EPS);
#pragma unroll
            for (int j = 0; j < 4; ++j) {
                const f32x4 gg = *((const f32x4*)g1 + F.lane + 64 * j), bb = *((const f32x4*)b1 + F.lane + 64 * j);
                v[j] = (v[j] * rstd0 * gg + bb) * ALPHA;
            }
        }
#pragma unroll
        for (int k = 0; k < 4; ++k)
#pragma unroll
            for (int j = 0; j < 4; ++j) yc[k][j] = yn[k][j];
        if (row + NGW < T) { CB_LOADDATA(row + NGW); if (row + 2 * NGW < T) CB_LOADIDX(row + 2 * NGW); }
#pragma unroll
        for (int k = 0; k < 4; ++k) {
            const float gt = gc[k];
#pragma unroll
            for (int j = 0; j < 4; ++j) {
                const u32x2 w = yc[k][j];
                v[j][0] += gt * __uint_as_float(w.x << 16); v[j][1] += gt * __uint_as_float(w.x & 0xffff0000u);
                v[j][2] += gt * __uint_as_float(w.y << 16); v[j][3] += gt * __uint_as_float(w.y & 0xffff0000u);
            }
        }
        float s = 0.f;
#pragma unroll
        for (int j = 0; j < 4; ++j) s += (v[j][0] + v[j][1]) + (v[j][2] + v[j][3]);
        const float mean = wave_sum(s) * (1.f / DM); float s2 = 0.f;
#pragma unroll
        for (int j = 0; j < 4; ++j) { v[j] = v[j] - mean; s2 += (v[j][0] * v[j][0] + v[j][1] * v[j][1]) + (v[j][2] * v[j][2] + v[j][3] * v[j][3]); }
        const float rstd = 1.0f / sqrtf(wave_sum(s2) * (1.f / DM) + LN_EPS);
#pragma unroll
        for (int j = 0; j < 4; ++j) {
            const f32x4 gg = *((const f32x4*)g + F.lane + 64 * j), bb = *((const f32x4*)bt + F.lane + 64 * j);
            v[j] = v[j] * rstd * gg + bb;
            if (outf) *((f32x4*)(outf + (size_t)row * DM) + F.lane + 64 * j) = v[j];
            if (outb) *((u32x2*)(outb + (size_t)row * DM) + F.lane + 64 * j) = (u32x2){cvtpk(v[j][0], v[j][1]), cvtpk(v[j][2], v[j][3])};
        }
    }
#undef CB_LOADIDX
#undef CB_LOADDATA
}

DI void phase_lat(Frame& F) {
    F.lane = vlane(); F.tid = F.wid * 64 + F.lane;
    unsigned char* ws = F.ws;
    pg8::Gemm g{(const bf16_t*)(ws + WS_XB), (const bf16_t*)(ws + WS_W_BIN), 1024}; pg8::StaticOrder S; S.init(T, 1024, 1024, F.G, F.bid);
    EpiLat E{(float*)(ws + WS_LAT), 928};
    pg8::gemm_phase<EpiLat, pg8::StaticOrder, false>(F.lds, g, S, E, F.wid);
}

DI void phase_latrows(Frame& F, const Params& P) {
    F.lane = vlane(); F.tid = F.wid * 64 + F.lane;
    unsigned char* ws = F.ws;
    const float* LAT = (const float*)(ws + WS_LAT);
    bf16_t* CKV = (bf16_t*)(ws + WS_CKV); bf16_t* CQ = (bf16_t*)(ws + WS_CQ); bf16_t* MQ = (bf16_t*)(ws + WS_MQ); bf16_t* Kb = (bf16_t*)(ws + WS_K);
    const int gw = F.bid * 8 + F.wid, NGW = F.G * 8;
    for (int row = gw; row < T; row += NGW) {
        const float* lr = LAT + (size_t)row * 1024;
        {
            const f32x4 v = *((const f32x4*)lr + F.lane);
            const float ss = wave_sum((v[0] * v[0] + v[1] * v[1]) + (v[2] * v[2] + v[3] * v[3]));
            const float rs = 1.0f / sqrtf(ss * (1.f / 256.f) + RMS_EPS);
            const f32x4 gg = *((const f32x4*)KP->kv_g + F.lane);
            const f32x4 o = v * rs * gg;
            *((u32x2*)(CKV + (size_t)row * 256) + F.lane) = (u32x2){cvtpk(o[0], o[1]), cvtpk(o[2], o[3])};
        }
        {
            const f32x4 v0 = *((const f32x4*)(lr + 288) + F.lane);
            f32x4 v1 = (f32x4){0.f, 0.f, 0.f, 0.f};
            if (F.lane < 32) v1 = *((const f32x4*)(lr + 288 + 256) + F.lane);
            const float ss = wave_sum((v0[0] * v0[0] + v0[1] * v0[1]) + (v0[2] * v0[2] + v0[3] * v0[3]) + (v1[0] * v1[0] + v1[1] * v1[1]) + (v1[2] * v1[2] + v1[3] * v1[3]));
            const float rs = 1.0f / sqrtf(ss * (1.f / 384.f) + RMS_EPS);
            const f32x4 g0 = *((const f32x4*)KP->b_g_q + F.lane);
            const f32x4 o0 = v0 * rs * g0;
            *((u32x2*)(CQ + (size_t)row * 384) + F.lane) = (u32x2){cvtpk(o0[0], o0[1]), cvtpk(o0[2], o0[3])};
            if (F.lane < 32) {
                const f32x4 g1 = *((const f32x4*)(KP->b_g_q + 256) + F.lane);
                const f32x4 o1 = v1 * rs * g1;
                *((u32x2*)(CQ + (size_t)row * 384 + 256) + F.lane) = (u32x2){cvtpk(o1[0], o1[1]), cvtpk(o1[2], o1[3])};
            }
        }
        {
            const f32x4 v = *((const f32x4*)(lr + 672) + F.lane) * (0.125f * LOG2E);
            *((u32x2*)(MQ + (size_t)row * 256) + F.lane) = (u32x2){cvtpk(v[0], v[1]), cvtpk(v[2], v[3])};
        }
        if (F.lane < 16) {
            const int i = F.lane;
            const float p = (float)KP->pos[row];
            const float inv = exp2f(-(float)i * (13.287712379549449f / 16.0f));
            float sn, cs; sincos_cw(p * inv, sn, cs);
            const float x1 = lr[256 + i], x2 = lr[256 + 16 + i];
            const unsigned short o1 = (unsigned short)(cvtpk(x1 * cs - x2 * sn, 0.f) & 0xffffu), o2 = (unsigned short)(cvtpk(x1 * sn + x2 * cs, 0.f) & 0xffffu);
#pragma unroll
            for (int h = 0; h < NH; ++h) { Kb[(size_t)row * 1152 + h * 96 + 64 + i] = o1; Kb[(size_t)row * 1152 + h * 96 + 80 + i] = o2; }
        }
    }
}
#ifndef UPSEL
#define UPSEL 7
#endif
struct RouteK1 { unsigned char* ws; DI Dst operator()(const pg8::Unit& u) const { return Dst{(bf16_t*)(ws + WS_K), 1152, u.pm * 256, u.pn * 384, 256, 1.0f, true}; } };
struct RouteQ1 { unsigned char* ws; DI Dst operator()(const pg8::Unit& u) const { const int nv = 1152 - u.pn * 256; return Dst{(bf16_t*)(ws + WS_Q), 1152, u.pm * 256, u.pn * 256, nv < 256 ? nv : 256, 0.10206207261596577f * LOG2E, false}; } };
DI void phase_up1(Frame& F) {
    F.lane = vlane(); F.tid = F.wid * 64 + F.lane;
    unsigned char* ws = F.ws;
    const bf16_t* ckv = (const bf16_t*)(ws + WS_CKV); const bf16_t* cq = (const bf16_t*)(ws + WS_CQ);
    const bf16_t* wukv = (const bf16_t*)(ws + WS_W_UKV); const bf16_t* wuq = (const bf16_t*)(ws + WS_W_UQ);
#if (UPSEL & 1)
    {
        pg8::Gemm g{cq, wuq, 384}; pg8::StaticOrder S; S.init(T, 1280, 384, F.G, F.bid);
        EpiBf16R<RouteQ1> E{RouteQ1{ws}};
        pg8::gemm_phase<EpiBf16R<RouteQ1>, pg8::StaticOrder, true>(F.lds, g, S, E, F.wid);
    }
#endif
#if (UPSEL & 2)
    {
        pg8::Gemm g{ckv, wukv, 256}; pg8::StaticOrder S; S.init(T, 768, 256, F.G, F.G - 1 - F.bid);
        EpiBf16R<RouteK1> E{RouteK1{ws}};
        pg8::gemm_phase<EpiBf16R<RouteK1>, pg8::StaticOrder, true>(F.lds, g, S, E, F.wid);
    }
#endif
#if (UPSEL & 4)
    {
        pg8::Gemm g{wukv + (size_t)768 * 256, ckv, 256}; pg8::StaticOrder S; S.init(768, T, 256, F.G, F.G - 1 - F.bid);
        EpiBf16R<RouteVT> E{RouteVT{ws}};
        pg8::gemm_phase<EpiBf16R<RouteVT>, pg8::StaticOrder, true>(F.lds, g, S, E, F.wid);
    }
#endif
}


__global__ void __launch_bounds__(NTHREADS) mega_fwd(Params P) {
    extern __shared__ __attribute__((aligned(16))) unsigned char lds_raw[];
    Frame F;
    F.lds = (LAS unsigned char*)lds_raw; F.ws = KP->ws; F.ctl = (unsigned*)(KP->ws + WS_CTL);
    F.wid = __builtin_amdgcn_readfirstlane((int)threadIdx.x >> 6); F.lane = vlane(); F.tid = F.wid * 64 + F.lane; F.G = gridDim.x; F.bid = blockIdx.x;
    const int lo = KP->ph_lo, hi = KP->ph_hi;
    { volatile LAS unsigned* st0 = (volatile LAS unsigned*)(F.lds + LDS_CTL + 512); if (F.tid < 2) st0[F.tid] = 0u; }
    __syncthreads();
    XcdBarrier bar = xcd_barrier_post(F.ctl + CW_BAR, (volatile LAS unsigned*)(F.lds + LDS_CTL + 512), F.wid);
#ifndef PHMASK
#define PHMASK 0x1ffff
#endif
#define IN(k) (((PHMASK >> (k)) & 1) && lo <= (k) && (k) < hi)
#define SEAM(k) do { if (IN(k) && IN((k) + 1)) { if (KP->use_grid_sync) { if ((k) == 0) cg::this_grid().sync(); else xcd_barrier(bar); } } } while (0)
    unsigned char* ws = KP->ws;
    if (IN(0)) { phase_prologue(F, P);
    }
    SEAM(0);
    if (IN(1)) { phase_proj0(F, P);
        if (KP->use_grid_sync) xcd_barrier(bar); phase_scan_knorm(F); }
    SEAM(1);
    if (IN(2)) { phase_attn0(F, P);
    }
    SEAM(2);
    if (IN(3)) { phase_outproj(F, (const bf16_t*)(ws + WS_W_AOUT));
    }
    SEAM(3);
    if (IN(4)) phase_ln_router(F, P, 0);
    SEAM(4);
    if (IN(5)) phase_moe_gu(F, P, 0);
    SEAM(5);
    if (IN(6)) phase_moe_dn(F, P, 0);
    SEAM(6);
    if (IN(7)) phase_combine(F, P, 0, nullptr, (bf16_t*)(ws + WS_XB));
    SEAM(7);
    if (IN(8)) phase_lat(F);
    SEAM(8);
    if (IN(9)) phase_latrows(F, P);
    SEAM(9);
    if (IN(10)) { phase_up1(F);
    }
    SEAM(10);
    if (IN(11)) { phase_attn1(F, P);
    }
    SEAM(11);
    if (IN(12)) phase_outproj(F, (const bf16_t*)(ws + WS_W_BOUT));
    SEAM(12);
    if (IN(13)) phase_ln_router(F, P, 1);
    SEAM(13);
    if (IN(14)) { phase_moe_gu(F, P, 1);
    }
    SEAM(14);
    if (IN(15)) { phase_moe_dn(F, P, 1);
    }
    SEAM(15);
    if (IN(16)) { phase_combine(F, P, 1, KP->out, nullptr);
    }
#undef IN
#undef SEAM
}

constexpr int N_PHASES = 17;
#ifndef MK_N_LAUNCHES
#define MK_N_LAUNCHES 1
#endif

extern "C" void kernel_launch(void* const* d_in, const int* in_sizes, int n_in, void* d_out, int out_size, void* d_ws, size_t ws_size, hipStream_t stream) {
    static int grid = 0;
    if (grid == 0) {
        if (n_in != 22 || ws_size < WS_END) { fprintf(stderr, "kernel_launch: need 22 inputs and %zu bytes of workspace (got %d, %zu)\n", (size_t)WS_END, n_in, ws_size); grid = -1; return; }
        int dev = 0, cus = 0, per_cu = 0;
        hipGetDevice(&dev);
        hipDeviceGetAttribute(&cus, hipDeviceAttributeMultiprocessorCount, dev);
        if (hipFuncSetAttribute((const void*)mega_fwd, hipFuncAttributeMaxDynamicSharedMemorySize, LDS_BYTES) != hipSuccess) fprintf(stderr, "kernel_launch: hipFuncSetAttribute failed\n");
        if (hipOccupancyMaxActiveBlocksPerMultiprocessor(&per_cu, (const void*)mega_fwd, NTHREADS, LDS_BYTES) != hipSuccess || per_cu < 1) { fprintf(stderr, "kernel_launch: occupancy query failed (%d)\n", per_cu); per_cu = 1; }
        (void)hipGetLastError();
        grid = cus * (per_cu > 1 ? 1 : per_cu);
        if (grid <= 0) grid = 256;
        if (grid != 256) fprintf(stderr, "kernel_launch: built for a 256-CU device (one workgroup per CU); got %d\n", grid);
    }
    if (grid < 0) return;
    hipMemsetAsync((char*)d_ws + WS_CTL, 0, CTL_BYTES, stream);
    Params p{};
    p.x = (const float*)d_in[0]; p.mem = (const float*)d_in[1]; p.pos = (const int*)d_in[2];
    p.a_w_in = (const float*)d_in[3]; p.a_b_f = (const float*)d_in[4]; p.a_w_out = (const float*)d_in[5];
    p.b_w_in = (const float*)d_in[6]; p.b_g_q = (const float*)d_in[7]; p.b_w_uq = (const float*)d_in[8]; p.b_w_out = (const float*)d_in[9];
    p.kv_w_dkv = (const float*)d_in[10]; p.kv_g = (const float*)d_in[11]; p.kv_w_ukv = (const float*)d_in[12]; p.mem_w_kv = (const float*)d_in[13];
    p.ln_g = (const float*)d_in[14]; p.ln_b = (const float*)d_in[15]; p.moe_w_r = (const float*)d_in[16]; p.moe_b_r = (const float*)d_in[17];
    p.moe_w_gu = (const float*)d_in[18]; p.moe_b_gu = (const float*)d_in[19]; p.moe_w_dn = (const float*)d_in[20]; p.moe_b_dn = (const float*)d_in[21];
    p.out = (float*)d_out; p.ws = (unsigned char*)d_ws;
    if (MK_N_LAUNCHES == 1) {
        p.ph_lo = 0; p.ph_hi = N_PHASES; p.use_grid_sync = 1;
        void* args[] = {&p};
        hipError_t e = hipLaunchCooperativeKernel((const void*)mega_fwd, dim3(grid), dim3(NTHREADS), args, LDS_BYTES, stream);
        if (e != hipSuccess) fprintf(stderr, "kernel_launch: cooperative launch failed: %s (grid %d)\n", hipGetErrorString(e), grid);
    } else {
        for (int ph = 0; ph < N_PHASES; ++ph) {
            p.ph_lo = ph; p.ph_hi = ph + 1; p.use_grid_sync = 0;
            hipLaunchKernelGGL(mega_fwd, dim3(grid), dim3(NTHREADS), LDS_BYTES, stream, p);
        }
    }
}
```

```cpp
#include <hip/hip_runtime.h>
#include <hip/hip_cooperative_groups.h>
#include <cstdio>
#include <cstdint>
#include <cmath>
namespace cg = cooperative_groups;

#define DI __device__ __forceinline__
#define LAS __attribute__((address_space(3)))
typedef unsigned short bf16_t;
typedef short bf16x8 __attribute__((ext_vector_type(8)));
typedef float f32x4 __attribute__((ext_vector_type(4)));
typedef float f32x2 __attribute__((ext_vector_type(2)));
typedef float f32x16 __attribute__((ext_vector_type(16)));
typedef unsigned u32x4 __attribute__((ext_vector_type(4)));
typedef unsigned u32x2 __attribute__((ext_vector_type(2)));
typedef int i32x4 __attribute__((ext_vector_type(4)));
typedef int i32x8 __attribute__((ext_vector_type(8)));
typedef long i64x4 __attribute__((ext_vector_type(4)));
typedef __bf16 bf16x2_t __attribute__((ext_vector_type(2)));

constexpr int NB = 2, SEQ = 8192, T = NB * SEQ, DM = 1024;
constexpr int NH = 12, NMEM = 256;
constexpr int FOX_IN = 2572;
constexpr int NE = 32;
constexpr float LOG2E = 1.4426950408889634f;
constexpr float ALPHA = 1.4142135623730951f;
constexpr float LN_EPS = 1e-5f, RMS_EPS = 1e-6f;
constexpr int NTHREADS = 512;
constexpr int LDS_BYTES = 131072 + 4096 + 8 * 1280 + 512;
constexpr int LDS_R1X = 131072 + 4096;
constexpr int LDS_CTL = 131072;
constexpr int SLOT_ROWS = 65536 + NE * 256;

constexpr size_t al256(size_t x) { return (x + 255) & ~(size_t)255; }
constexpr size_t WS_CTL = 0, CTL_BYTES = 65536;
constexpr size_t WS_W_AIN = al256(WS_CTL + CTL_BYTES);
constexpr size_t WS_W_AOUT = al256(WS_W_AIN + (size_t)2560 * 1024 * 2);
constexpr size_t WS_W_BIN = al256(WS_W_AOUT + (size_t)1024 * 1024 * 2);
constexpr size_t WS_W_UQ = al256(WS_W_BIN + (size_t)1024 * 1024 * 2);
constexpr size_t WS_W_UKV = al256(WS_W_UQ + (size_t)1280 * 384 * 2);
constexpr size_t WS_W_BOUT = al256(WS_W_UKV + (size_t)1536 * 256 * 2);
constexpr size_t WS_W_MKV = al256(WS_W_BOUT + (size_t)1024 * 1024 * 2);
constexpr size_t WS_W_GU = al256(WS_W_MKV + (size_t)2 * 512 * 1024 * 2);
constexpr size_t WS_W_DN = al256(WS_W_GU + (size_t)2 * 32 * 2048 * 1024 * 2);
constexpr size_t WS_XB = al256(WS_W_DN + (size_t)2 * 32 * 1024 * 1024 * 2);
constexpr size_t WS_MEMB = al256(WS_XB + (size_t)T * 1024 * 2);
constexpr size_t WS_LOGF = al256(WS_MEMB + (size_t)512 * 1024 * 2);
constexpr size_t WS_CUM = al256(WS_LOGF + (size_t)24 * 8192 * 4);
constexpr size_t WS_Q = al256(WS_CUM + (size_t)24 * 8192 * 4);
constexpr size_t WS_K = al256(WS_Q + (size_t)T * 1152 * 2);
constexpr size_t WS_VT = al256(WS_K + (size_t)T * 1152 * 2);
constexpr size_t WS_MQ = al256(WS_VT + (size_t)1536 * 8192 * 2);
constexpr size_t WS_MK = al256(WS_MQ + (size_t)T * 256 * 2);
constexpr size_t WS_MVT = al256(WS_MK + (size_t)2 * 512 * 256 * 2);
constexpr size_t WS_MERGED = al256(WS_MVT + (size_t)2 * 2 * 256 * 256 * 2);
constexpr size_t WS_Y = al256(WS_MERGED + (size_t)T * 1024 * 2);
constexpr size_t WS_X1 = al256(WS_Y + (size_t)T * 1024 * 4);
constexpr size_t WS_X1B = al256(WS_X1 + (size_t)T * 1024 * 4);
constexpr size_t WS_PE = al256(WS_X1B + (size_t)T * 1024 * 2);
constexpr size_t WS_PPOS = al256(WS_PE + (size_t)T * 4 * 4);
constexpr size_t WS_GATE = al256(WS_PPOS + (size_t)T * 4 * 4);
constexpr size_t WS_TOKOF = al256(WS_GATE + (size_t)T * 4 * 4);
constexpr size_t WS_H = al256(WS_TOKOF + (size_t)NE * T * 4);
constexpr size_t WS_YE = al256(WS_H + (size_t)SLOT_ROWS * 1024 * 2);
constexpr size_t WS_LAT = al256(WS_YE + (size_t)SLOT_ROWS * 1024 * 2);
constexpr size_t WS_CKV = al256(WS_LAT + (size_t)T * 1024 * 4);
constexpr size_t WS_CQ = al256(WS_CKV + (size_t)T * 256 * 2);
constexpr size_t WS_X2 = al256(WS_CQ + (size_t)T * 384 * 2);
constexpr size_t WS_KN2 = al256(WS_X2 + (size_t)T * 1024 * 4);
constexpr size_t WS_WRT = al256(WS_KN2 + (size_t)24 * 128 * 4);
constexpr size_t WS_WRH = al256(WS_WRT + (size_t)2 * 32 * 1024 * 4);
constexpr size_t WS_WRL = al256(WS_WRH + (size_t)2 * 32 * 1024 * 2);
constexpr size_t WS_SGU = al256(WS_WRL + (size_t)2 * 32 * 1024 * 2);
constexpr size_t WS_SDN = al256(WS_SGU + (size_t)2 * 32 * 2048 * 4);
constexpr size_t WS_SAS = al256(WS_SDN + (size_t)2 * 32 * 1024 * 4);
constexpr size_t WS_END = al256(WS_SAS + (size_t)NE * T * 4);
constexpr int CW_CNT = 8192;
constexpr int CW_WORK = 256;
constexpr int CW_BAR = 4096;

struct Params {
    const float* x; const float* mem; const int* pos;
    const float *a_w_in, *a_b_f, *a_w_out, *b_w_in, *b_g_q, *b_w_uq, *b_w_out, *kv_w_dkv, *kv_g, *kv_w_ukv, *mem_w_kv, *ln_g, *ln_b;
    const float *moe_w_r, *moe_b_r, *moe_w_gu, *moe_b_gu, *moe_w_dn, *moe_b_dn;
    float* out; unsigned char* ws; int ph_lo, ph_hi; int use_grid_sync, pad;
};

#define KP ((const __attribute__((address_space(4))) Params*)__builtin_amdgcn_kernarg_segment_ptr())
DI unsigned cvtpk(float lo, float hi) { f32x2 v = {lo, hi}; bf16x2_t b = __builtin_convertvector(v, bf16x2_t); return __builtin_bit_cast(unsigned, b); }
DI float bf2f(unsigned short b) { return __uint_as_float(((unsigned)b) << 16); }
DI float wave_sum(float v) {
#pragma unroll
    for (int o = 1; o < 64; o <<= 1) v += __shfl_xor(v, o);
    return v;
}
DI float wave_max(float v) {
#pragma unroll
    for (int o = 1; o < 64; o <<= 1) v = fmaxf(v, __shfl_xor(v, o));
    return v;
}

DI void sincos_cw(float x, float& sn, float& cs) {
    int j = (int)(x * 1.27323954473516f); j = (j + 1) & ~1;
    const float y = (float)j;
    const float r = ((x - y * 0.78515625f) - y * 2.4187564849853515625e-4f) - y * 3.77489497744594108e-8f;
    const float z = r * r;
    const float sp = ((-1.9515295891e-4f * z + 8.3321608736e-3f) * z - 1.6666654611e-1f) * z * r + r;
    const float cp = ((2.443315711809948e-5f * z - 1.388731625493765e-3f) * z + 4.166664568298827e-2f) * z * z - 0.5f * z + 1.0f;
    const int q = (j >> 1) & 3;
    const float s0 = (q & 1) ? cp : sp, c0 = (q & 1) ? sp : cp;
    sn = (q & 2) ? -s0 : s0;
    cs = ((q + 1) & 2) ? -c0 : c0;
}
DI float fadd_s(float a, float b) { float r; asm("v_add_f32_e32 %0, %1, %2" : "=v"(r) : "v"(a), "v"(b)); return r; }
DI int vlane() { int l; asm volatile("v_mbcnt_lo_u32_b32 %0, -1, 0\n\tv_mbcnt_hi_u32_b32 %0, -1, %0" : "=v"(l)); return l; }
#define LDS_WAIT() asm volatile("s_waitcnt lgkmcnt(0)" ::: "memory")
#define VM_WAIT() asm volatile("s_waitcnt vmcnt(0)" ::: "memory")

#ifndef GEMM_TOKPF
#define GEMM_TOKPF 2
#endif
namespace pg8 {
constexpr int BM = 256, BK = 64, HALF = 128, HTB = HALF * BK * 2, STAGE_BYTES = 8 * HTB, NXCD = 8, WGM = 8;
DI int lds_byte(int r, int c) { const int st = (r >> 4) * 2 + (c >> 5), rr = r & 15, cc = c & 31, ob = rr * 64 + cc * 2; return st * 1024 + (ob ^ (((ob >> 9) & 1) << 5)); }
DI void stage_rc(int b, int& R, int& C) { const int st = b / 1024, sb = b % 1024, swz = sb ^ (((sb >> 9) & 1) << 5); R = (st >> 1) * 16 + swz / 64; C = (st & 1) * 32 + (swz % 64) / 2; }
DI int perm32(int rho) { const int n = rho >> 4, i = rho & 15; return 8 * (i >> 2) + 4 * n + (i & 3); }
struct Unit { int pm, pn; };
struct Gemm { const bf16_t* A; const bf16_t* Bt; int K; };
struct StaticOrder {
    int nM, nN, nwg, G, c, K2;
    DI void init(int M, int N, int K, int G_, int c_) { nM = M / BM; nN = N / BM; nwg = nM * nN; G = G_; c = c_; K2 = K * 2; }
    DI bool next(int i, Unit& u) const {
        const long L = (long)i * G + c; if (L >= nwg) return false;
        int wgid = (int)L; { const int q = nwg / NXCD, r = nwg % NXCD, xcd = wgid % NXCD, off = wgid / NXCD; wgid = (xcd < r ? xcd * (q + 1) : r * (q + 1) + (xcd - r) * q) + off; }
        const int nig = WGM * nN, gid = wgid / nig, fm = gid * WGM, gsz = (nM - fm) < WGM ? (nM - fm) : WGM;
        u.pm = fm + ((wgid % nig) % gsz); u.pn = (wgid % nig) / gsz; return true;
    }
    DI unsigned a_off(const Unit& u, int r) const { return (unsigned)(u.pm * BM + r) * (unsigned)K2; }
    DI unsigned a_off_pf(const Unit& u, int r, int) const { return a_off(u, r); }
    DI void prefetch(const Unit&, int, int, int) const {}
    DI void a_ready(const Unit&) const {}
    DI void done(const Unit&) const {}
};

template <class Epi, class Sched, bool ALIGN_EPI, int MODE = 0>
DI void gemm_phase(LAS unsigned char* lds, const Gemm g, const Sched& S, const Epi& E, const int wid) {
    const int lane = vlane(), tid = wid * 64 + lane, wr = wid >> 2, wc = wid & 3, fr = lane & 15, fq = lane >> 4;
    const int K = g.K, nt = K / BK;
    int RA[2]; unsigned cA2[2], voffB[2];
#pragma unroll
    for (int i = 0; i < 2; ++i) { int R, C; stage_rc(tid * 16 + i * 8192, R, C); const int Rb = Epi::PERM ? ((R & ~31) + perm32(R & 31)) : R;
        RA[i] = R; cA2[i] = (unsigned)C * 2u; voffB[i] = (unsigned)(Rb * K + C) * 2u; }
    const size_t kstep = (size_t)(BK * 2);
    const size_t hstep = (size_t)HALF * K * 2;
    const size_t tstep = 2 * hstep;
    const unsigned ldsw = (unsigned)wid * 1024u;
    const int aoff = lds_byte(wr * 64 + fr, fq * 8), boff = lds_byte(wc * 32 + fr, fq * 8);
#define PG8_SA(b, h) (((b) * 2 + (h)) * HTB)
#define PG8_SB(b, h) ((4 + (b) * 2 + (h)) * HTB)
#define PG8_STAGE_B(bufoff, gbase) do { _Pragma("unroll") for (int _i = 0; _i < 2; ++_i) \
        __builtin_amdgcn_global_load_lds((const unsigned*)((const char*)(gbase) + voffB[_i]), (LAS unsigned*)(lds + (bufoff) + ldsw + _i * 8192), 16, 0, 0); } while (0)
#define PG8_STAGE_A(bufoff, kbytes, uo) do { _Pragma("unroll") for (int _i = 0; _i < 2; ++_i) \
        __builtin_amdgcn_global_load_lds((const unsigned*)((const char*)g.A + (kbytes) + (uo)[_i]), (LAS unsigned*)(lds + (bufoff) + ldsw + _i * 8192), 16, 0, 0); } while (0)
#define PG8_STAGE_A2(bufoff, kbytes, h) do { _Pragma("unroll") for (int _i = 0; _i < 2; ++_i) \
        __builtin_amdgcn_global_load_lds((const unsigned*)((const char*)g.A + (kbytes) + (last ? uN[h][_i] : uC[h][_i])), (LAS unsigned*)(lds + (bufoff) + ldsw + _i * 8192), 16, 0, 0); } while (0)
#define PG8_LDA(dst, b, h) do { _Pragma("unroll") for (int m = 0; m < (MODE == 2 ? 2 : 4); ++m) { dst[m].lo = *(const LAS i32x4*)(lds + PG8_SA(b, h) + aoff + m * 2048); dst[m].hi = *(const LAS i32x4*)(lds + PG8_SA(b, h) + aoff + m * 2048 + 1024); } } while (0)
#define PG8_LDB(dst, b, h) do { _Pragma("unroll") for (int n = 0; n < 2; ++n) { dst[n].lo = *(const LAS i32x4*)(lds + PG8_SB(b, h) + boff + n * 2048); dst[n].hi = *(const LAS i32x4*)(lds + PG8_SB(b, h) + boff + n * 2048 + 1024); } } while (0)
#define PG8_MMA(ai, bj, At, Bt) do { __builtin_amdgcn_s_setprio(1); _Pragma("unroll") for (int m = 0; m < 4; ++m) _Pragma("unroll") for (int n = 0; n < 2; ++n) { \
        if constexpr (MODE == 2) acc[ai][bj][m][n] = __builtin_amdgcn_mfma_scale_f32_16x16x128_f8f6f4(Bt[n], At[m], acc[ai][bj][m][n], 0, 0, 0, 0, 0, 0); \
        else if constexpr (MODE == 3) { const i64x4 b4_ = __builtin_bit_cast(i64x4, Bt[n]), a4_ = __builtin_bit_cast(i64x4, At[m]); _Pragma("unroll") for (int q = 0; q < 4; ++q) acc[ai][bj][m][n] = __builtin_amdgcn_mfma_f32_16x16x32_fp8_fp8(b4_[q], a4_[q], acc[ai][bj][m][n], 0, 0, 0); } \
        else if constexpr (MODE == 1) { acc[ai][bj][m][n] = __builtin_bit_cast(f32x4, __builtin_amdgcn_mfma_i32_16x16x64_i8(Bt[n].lo, At[m].lo, __builtin_bit_cast(i32x4, acc[ai][bj][m][n]), 0, 0, 0)); \
                                        acc[ai][bj][m][n] = __builtin_bit_cast(f32x4, __builtin_amdgcn_mfma_i32_16x16x64_i8(Bt[n].hi, At[m].hi, __builtin_bit_cast(i32x4, acc[ai][bj][m][n]), 0, 0, 0)); } \
        else { const i32x4 bl_ = Bt[n].lo, bh_ = Bt[n].hi, al_ = At[m].lo, ah_ = At[m].hi;     \
               acc[ai][bj][m][n] = __builtin_amdgcn_mfma_f32_16x16x32_bf16(__builtin_bit_cast(bf16x8, bl_), __builtin_bit_cast(bf16x8, al_), acc[ai][bj][m][n], 0, 0, 0); \
               acc[ai][bj][m][n] = __builtin_amdgcn_mfma_f32_16x16x32_bf16(__builtin_bit_cast(bf16x8, bh_), __builtin_bit_cast(bf16x8, ah_), acc[ai][bj][m][n], 0, 0, 0); } } __builtin_amdgcn_s_setprio(0); } while (0)
#define PG8_MFMA8(Bv, Av, C) C = __builtin_amdgcn_mfma_scale_f32_16x16x128_f8f6f4(Bv, Av, C, 0, 0, 0, 0, 0, 0)
#define PG8_MMAX(ai, b, h) do { if constexpr (MODE == 2) { __builtin_amdgcn_s_setprio(1); \
        _Pragma("unroll") for (int m = 0; m < 2; ++m) _Pragma("unroll") for (int n = 0; n < 2; ++n) { PG8_MFMA8(B0[n], At[m], acc[ai][0][m][n]); PG8_MFMA8(B1[n], At[m], acc[ai][1][m][n]); } \
        __builtin_amdgcn_sched_barrier(0); \
        _Pragma("unroll") for (int m = 0; m < 2; ++m) { At[m].lo = *(const LAS i32x4*)(lds + PG8_SA(b, h) + aoff + (m + 2) * 2048); At[m].hi = *(const LAS i32x4*)(lds + PG8_SA(b, h) + aoff + (m + 2) * 2048 + 1024); } \
        asm volatile("s_waitcnt lgkmcnt(0)" ::: "memory"); __builtin_amdgcn_sched_barrier(0); \
        _Pragma("unroll") for (int m = 0; m < 2; ++m) _Pragma("unroll") for (int n = 0; n < 2; ++n) { PG8_MFMA8(B0[n], At[m], acc[ai][0][m + 2][n]); PG8_MFMA8(B1[n], At[m], acc[ai][1][m + 2][n]); } \
        __builtin_amdgcn_s_setprio(0); } else { PG8_MMA(ai, 0, At, B0); PG8_MMA(ai, 1, At, B1); } } while (0)
#define PG8_WAIT_V(n) asm volatile("s_waitcnt vmcnt(" #n ")" ::: "memory")
#define PG8_WAIT_L(n) asm volatile("s_waitcnt lgkmcnt(" #n ")" ::: "memory")
#define PG8_BAR __builtin_amdgcn_s_barrier()
#define PG8_SCHED __builtin_amdgcn_sched_barrier(0)
    Unit cur, nxt; int ui = 0;
    if (!S.next(0, cur)) return;
    f32x4 acc[2][2][4][2];
#pragma unroll
    for (int a = 0; a < 2; ++a)
#pragma unroll
        for (int b = 0; b < 2; ++b)
#pragma unroll
            for (int m = 0; m < 4; ++m)
#pragma unroll
                for (int n = 0; n < 2; ++n) acc[a][b][m][n] = (f32x4){0.f, 0.f, 0.f, 0.f};
    i32x8 At[4], B0[2], B1[2];
    unsigned uC[2][2], uN[2][2];
#pragma unroll
    for (int h = 0; h < 2; ++h)
#pragma unroll
        for (int i = 0; i < 2; ++i) uC[h][i] = S.a_off(cur, h * HALF + RA[i]) + cA2[i];
    const char* cB = (const char*)g.Bt + (size_t)cur.pn * tstep;
    S.a_ready(cur); E.prefetch(lds, cur, 0, wid);
    PG8_STAGE_B(PG8_SB(0, 0), cB); PG8_STAGE_B(PG8_SB(0, 1), cB + hstep); PG8_STAGE_A(PG8_SA(0, 0), 0, uC[0]); PG8_STAGE_A(PG8_SA(0, 1), 0, uC[1]);
    if (wr == 1) PG8_BAR;
    PG8_WAIT_V(2); PG8_BAR;
    PG8_STAGE_B(PG8_SB(1, 0), cB + kstep); PG8_STAGE_A(PG8_SA(1, 0), kstep, uC[0]); PG8_STAGE_B(PG8_SB(1, 1), cB + hstep + kstep);
    PG8_WAIT_V(6); PG8_BAR;
    for (;;) {
        const bool has_next = S.next(ui + 1, nxt);
        const char* nB = has_next ? (const char*)g.Bt + (size_t)nxt.pn * tstep : cB;
#if GEMM_TOKPF == 1
        if (has_next) S.prefetch(nxt, (ui + 1) & 1, wid, lane);
#elif GEMM_TOKPF == 2
        {
            Unit nx2; const bool has2 = S.next(ui + 2, nx2);
            int RAn[2]; unsigned cAn[2];
            { const int tid2 = wid * 64 + vlane();
#pragma unroll
              for (int i = 0; i < 2; ++i) { int R, C; stage_rc(tid2 * 16 + i * 8192, R, C); RAn[i] = R; cAn[i] = (unsigned)C * 2u; } }
#pragma unroll
            for (int h = 0; h < 2; ++h)
#pragma unroll
                for (int i = 0; i < 2; ++i) uN[h][i] = has_next ? ((ui == 0 ? S.a_off(nxt, h * HALF + RAn[i]) : S.a_off_pf(nxt, h * HALF + RAn[i], (ui + 1) & 1)) + cAn[i]) : uC[h][i];
            if (has2) S.prefetch(nx2, ui & 1, wid, lane);
        }
#else
#pragma unroll
        for (int h = 0; h < 2; ++h)
#pragma unroll
            for (int i = 0; i < 2; ++i) uN[h][i] = has_next ? (S.a_off(nxt, h * HALF + RA[i]) + cA2[i]) : uC[h][i];
#endif
#pragma nounroll
        for (int t = 0; t < nt; t += 2) {
            const bool last = (t == nt - 2);
            const size_t ka1 = (size_t)(t + 1) * kstep;
            const size_t ka2 = last ? (size_t)0 : (size_t)(t + 2) * kstep, ka3 = ka2 + kstep;
            const char* b2 = last ? nB : cB + (size_t)(t + 2) * kstep; const char* b3 = b2 + kstep;
#if GEMM_TOKPF == 1
            if (last) {
                if (has_next) S.a_ready(nxt);
#pragma unroll
                for (int h = 0; h < 2; ++h)
#pragma unroll
                    for (int i = 0; i < 2; ++i) uN[h][i] = has_next ? (S.a_off_pf(nxt, h * HALF + RA[i], (ui + 1) & 1) + cA2[i]) : uC[h][i];
            }
#endif
            PG8_LDB(B0, 0, 0); PG8_LDB(B1, 0, 1); PG8_SCHED; PG8_LDA(At, 0, 0); if constexpr (MODE != 2) PG8_STAGE_A(PG8_SA(1, 1), ka1, uC[1]);
            PG8_WAIT_V(8); PG8_WAIT_L(0); PG8_BAR; if constexpr (MODE == 2) PG8_STAGE_A(PG8_SA(1, 1), ka1, uC[1]); PG8_MMAX(0, 0, 0); PG8_BAR; PG8_SCHED;
            PG8_LDA(At, 0, 1); PG8_STAGE_B(PG8_SB(0, 0), b2); PG8_STAGE_B(PG8_SB(0, 1), b2 + hstep); if constexpr (MODE != 2) PG8_STAGE_A2(PG8_SA(0, 0), ka2, 0);
            PG8_WAIT_V(8); PG8_WAIT_L(0); PG8_BAR; if constexpr (MODE == 2) PG8_STAGE_A2(PG8_SA(0, 0), ka2, 0); PG8_MMAX(1, 0, 1); PG8_BAR; PG8_SCHED;
            PG8_LDB(B0, 1, 0); PG8_LDB(B1, 1, 1); PG8_SCHED; PG8_LDA(At, 1, 0); if constexpr (MODE != 2) PG8_STAGE_A2(PG8_SA(0, 1), ka2, 1);
            PG8_WAIT_V(8); PG8_WAIT_L(0); PG8_BAR; if constexpr (MODE == 2) PG8_STAGE_A2(PG8_SA(0, 1), ka2, 1); PG8_MMAX(0, 1, 0); PG8_BAR; PG8_SCHED;
            PG8_LDA(At, 1, 1); PG8_STAGE_B(PG8_SB(1, 0), b3); PG8_STAGE_B(PG8_SB(1, 1), b3 + hstep); if constexpr (MODE != 2) PG8_STAGE_A2(PG8_SA(1, 0), ka3, 0);
            PG8_WAIT_V(8); PG8_WAIT_L(0); PG8_BAR; if constexpr (MODE == 2) PG8_STAGE_A2(PG8_SA(1, 0), ka3, 0); PG8_MMAX(1, 1, 1); PG8_BAR; PG8_SCHED;
        }
        if (has_next) E.prefetch(lds, nxt, (ui + 1) & 1, wid);
        if constexpr (ALIGN_EPI) { if (wr == 0) PG8_BAR; }
        E(lds, acc, cur, wr, wc, fr, fq, ui & 1); S.done(cur);
        if (!has_next) break;
#pragma unroll
        for (int a = 0; a < 2; ++a)
#pragma unroll
            for (int b = 0; b < 2; ++b)
#pragma unroll
                for (int m = 0; m < 4; ++m)
#pragma unroll
                    for (int n = 0; n < 2; ++n) acc[a][b][m][n] = (f32x4){0.f, 0.f, 0.f, 0.f};
        cur = nxt; cB = nB; ++ui;
#pragma unroll
        for (int h = 0; h < 2; ++h)
#pragma unroll
            for (int i = 0; i < 2; ++i) uC[h][i] = uN[h][i];
        if constexpr (ALIGN_EPI) { if (wr == 1) PG8_BAR; }
    }
    PG8_WAIT_V(0);
    if constexpr (!ALIGN_EPI) { if (wr == 0) PG8_BAR; }
    PG8_BAR;
#undef PG8_SA
#undef PG8_SB
#undef PG8_STAGE_A
#undef PG8_STAGE_A2
#undef PG8_STAGE_B
#undef PG8_LDA
#undef PG8_LDB
#undef PG8_MMA
#undef PG8_MMAX
#undef PG8_MFMA8
#undef PG8_WAIT_V
#undef PG8_WAIT_L
#undef PG8_BAR
#undef PG8_SCHED
}
}

struct Dst { bf16_t* O; int ldo, row0, col0, nvalid; float scale; bool headmap; };
template <class Route> struct EpiBf16R {
    static constexpr bool PERM = true;
    Route R;
    DI void prefetch(LAS unsigned char*, const pg8::Unit&, int, int) const {}
    DI void operator()(LAS unsigned char*, const f32x4 (&acc)[2][2][4][2], const pg8::Unit& u, int wr, int wc, int fr, int fq, int) const {
        const Dst d = R(u);
#pragma unroll
        for (int ai = 0; ai < 2; ++ai)
#pragma unroll
            for (int m = 0; m < 4; ++m) {
                bf16_t* rowp = d.O + (size_t)(d.row0 + ai * 128 + wr * 64 + m * 16 + fr) * d.ldo + d.col0;
#pragma unroll
                for (int bj = 0; bj < 2; ++bj) {
                    const int c = bj * 128 + wc * 32 + 8 * fq;
                    if (c < d.nvalid) {
                        const f32x4 v0 = acc[ai][bj][m][0] * d.scale, v1 = acc[ai][bj][m][1] * d.scale;
                        u32x4 w; w.x = cvtpk(v0[0], v0[1]); w.y = cvtpk(v0[2], v0[3]); w.z = cvtpk(v1[0], v1[1]); w.w = cvtpk(v1[2], v1[3]);
                        const int oc = d.headmap ? ((c >> 6) * 96 + (c & 63)) : c;
                        *(u32x4*)(rowp + oc) = w;
                    }
                }
            }
    }
};
DI f32x4 bf4(u32x2 w) { return (f32x4){__uint_as_float(w.x << 16), __uint_as_float(w.x & 0xffff0000u), __uint_as_float(w.y << 16), __uint_as_float(w.y & 0xffff0000u)}; }
struct EpiResB16 {
    static constexpr bool PERM = true;
    bf16_t* Y; const bf16_t* X;
    DI void prefetch(LAS unsigned char*, const pg8::Unit&, int, int) const {}
    DI void operator()(LAS unsigned char*, const f32x4 (&acc)[2][2][4][2], const pg8::Unit& u, int wr, int wc, int fr, int fq, int) const {
#pragma unroll
        for (int ai = 0; ai < 2; ++ai)
#pragma unroll
            for (int m = 0; m < 4; ++m) {
                const size_t ro = (size_t)(u.pm * 256 + ai * 128 + wr * 64 + m * 16 + fr) * DM + u.pn * 256 + wc * 32 + 8 * fq;
#pragma unroll
                for (int bj = 0; bj < 2; ++bj) {
                    const u32x4 xw = *(const u32x4*)(X + ro + bj * 128);
                    const f32x4 v0 = bf4((u32x2){xw.x, xw.y}) * ALPHA + acc[ai][bj][m][0], v1 = bf4((u32x2){xw.z, xw.w}) * ALPHA + acc[ai][bj][m][1];
                    u32x4 w; w.x = cvtpk(v0[0], v0[1]); w.y = cvtpk(v0[2], v0[3]); w.z = cvtpk(v1[0], v1[1]); w.w = cvtpk(v1[2], v1[3]);
                    *(u32x4*)(Y + ro + bj * 128) = w;
                }
            }
    }
};
struct EpiLat {
    static constexpr bool PERM = false;
    float* O; int ncol;
    DI void prefetch(LAS unsigned char*, const pg8::Unit&, int, int) const {}
    DI void operator()(LAS unsigned char*, const f32x4 (&acc)[2][2][4][2], const pg8::Unit& u, int wr, int wc, int fr, int fq, int) const {
#pragma unroll
        for (int ai = 0; ai < 2; ++ai)
#pragma unroll
            for (int m = 0; m < 4; ++m) {
                const int c0 = u.pn * 256 + wc * 32 + 4 * fq;
                float* rowp = O + (size_t)(u.pm * 256 + ai * 128 + wr * 64 + m * 16 + fr) * 1024;
#pragma unroll
                for (int bj = 0; bj < 2; ++bj)
#pragma unroll
                    for (int n = 0; n < 2; ++n) { const int c = c0 + bj * 128 + n * 16; if (c < ncol) *(f32x4*)(rowp + c) = acc[ai][bj][m][n]; }
            }
    }
};
struct EpiGU {
    static constexpr bool PERM = true;
    unsigned char* H; const float* bias; const float* sw; const float* sas; const LAS int* tstart;
    DI void prefetch(LAS unsigned char* lds, const pg8::Unit& u, int slot, int wid) const {
        if (wid < 1 || wid > 3) return;
        const int e = u.pn >> 3, ct = u.pn & 7, l = vlane();
        const float* src = wid == 1 ? bias + (size_t)e * 2048 + (l >> 5) * 1024 + ct * 128 + (l & 31) * 4
                         : wid == 2 ? sw + (size_t)e * 2048 + ct * 256 + l * 4
                                    : sas + (size_t)e * T + (u.pm - tstart[e]) * 256 + l * 4;
        __builtin_amdgcn_global_load_lds((const unsigned*)src, (LAS unsigned*)(lds + LDS_R1X + slot * 3072 + (wid - 1) * 1024), 16, 0, 0);
    }
    DI void operator()(LAS unsigned char* lds, const f32x4 (&acc)[2][2][4][2], const pg8::Unit& u, int wr, int wc, int fr, int fq, int slot) const {
        const int j = (u.pn & 7) * 128 + wc * 32 + 8 * fq;
        const LAS unsigned char* cb = lds + LDS_R1X + slot * 3072;
        const LAS f32x2* c2 = (const LAS f32x2*)(cb + (wc * 32 + 8 * fq) * 4);
        const LAS float* sa = (const LAS float*)(cb + 2048) + wr * 64 + fr;
        f32x2 bg[4], bu[4], sg_[4], su_[4];
#pragma unroll
        for (int q = 0; q < 4; ++q) { bg[q] = c2[q]; bu[q] = c2[64 + q]; sg_[q] = c2[128 + q]; su_[q] = c2[192 + q]; }
#pragma unroll
        for (int ai = 0; ai < 2; ++ai)
#pragma unroll
            for (int m = 0; m < 4; ++m) {
                const float st = sa[ai * 128 + m * 16];
                const f32x2 st2 = (f32x2){st, st};
                f32x2 h[4];
#pragma unroll
                for (int q = 0; q < 4; ++q) {
                    const f32x4 ag = acc[ai][0][m][q >> 1], au = acc[ai][1][m][q >> 1];
                    const f32x2 cg = (f32x2){(float)__float_as_int(ag[2 * (q & 1)]), (float)__float_as_int(ag[2 * (q & 1) + 1])};
                    const f32x2 cu = (f32x2){(float)__float_as_int(au[2 * (q & 1)]), (float)__float_as_int(au[2 * (q & 1) + 1])};
                    f32x2 g = cg * (st2 * sg_[q]) + bg[q], uu = cu * (st2 * su_[q]) + bu[q];
                    g[0] = fminf(g[0], 7.0f); g[1] = fminf(g[1], 7.0f);
                    uu[0] = fminf(fmaxf(uu[0], -7.0f), 7.0f); uu[1] = fminf(fmaxf(uu[1], -7.0f), 7.0f);
                    const f32x2 t = g * (f32x2){-1.702f * LOG2E, -1.702f * LOG2E};
                    f32x2 d = (f32x2){__builtin_amdgcn_exp2f(t[0]), __builtin_amdgcn_exp2f(t[1])} + (f32x2){1.0f, 1.0f};
                    d[0] = __builtin_amdgcn_rcpf(d[0]); d[1] = __builtin_amdgcn_rcpf(d[1]);
                    h[q] = (uu + (f32x2){1.0f, 1.0f}) * (g * d);
                }
                u32x2 w;
                w.x = (unsigned)__builtin_amdgcn_cvt_pk_fp8_f32(h[1][0], h[1][1], __builtin_amdgcn_cvt_pk_fp8_f32(h[0][0], h[0][1], 0, false), true);
                w.y = (unsigned)__builtin_amdgcn_cvt_pk_fp8_f32(h[3][0], h[3][1], __builtin_amdgcn_cvt_pk_fp8_f32(h[2][0], h[2][1], 0, false), true);
                *(u32x2*)(H + (size_t)(u.pm * 256 + ai * 128 + wr * 64 + m * 16 + fr) * 1024 + j) = w;
            }
    }
};
struct EpiDN {
    static constexpr bool PERM = true;
    bf16_t* Y; const float* bias; const float* sw;
    DI void prefetch(LAS unsigned char* lds, const pg8::Unit& u, int slot, int wid) const {
        if (wid < 1 || wid > 2) return;
        const int e = u.pn >> 2, ct = u.pn & 3, l = vlane();
        const float* src = (wid == 1 ? bias : sw) + (size_t)e * 1024 + ct * 256 + l * 4;
        __builtin_amdgcn_global_load_lds((const unsigned*)src, (LAS unsigned*)(lds + LDS_R1X + slot * 3072 + (wid - 1) * 1024), 16, 0, 0);
    }
    DI void operator()(LAS unsigned char* lds, const f32x4 (&acc)[2][2][4][2], const pg8::Unit& u, int wr, int wc, int fr, int fq, int slot) const {
        const int ct = u.pn & 3;
        const LAS unsigned char* cb = lds + LDS_R1X + slot * 3072;
#pragma unroll
        for (int bj = 0; bj < 2; ++bj) {
            const int cl = bj * 128 + wc * 32 + 8 * fq, c = ct * 256 + cl;
            const f32x4 b0 = *(const LAS f32x4*)(cb + cl * 4), b1 = *(const LAS f32x4*)(cb + cl * 4 + 16), s0 = *(const LAS f32x4*)(cb + 1024 + cl * 4), s1 = *(const LAS f32x4*)(cb + 1024 + cl * 4 + 16);
#pragma unroll
            for (int ai = 0; ai < 2; ++ai)
#pragma unroll
                for (int m = 0; m < 4; ++m) {
                    const f32x4 v0 = acc[ai][bj][m][0] * s0 + b0, v1 = acc[ai][bj][m][1] * s1 + b1;
                    u32x4 w; w.x = cvtpk(v0[0], v0[1]); w.y = cvtpk(v0[2], v0[3]); w.z = cvtpk(v1[0], v1[1]); w.w = cvtpk(v1[2], v1[3]);
                    *(u32x4*)(Y + (size_t)(u.pm * 256 + ai * 128 + wr * 64 + m * 16 + fr) * 1024 + c) = w;
                }
        }
    }
};
struct Frame {
    LAS unsigned char* lds; unsigned* ctl; unsigned char* ws; int tid, lane, wid; int G, bid;
};
struct MoeOrder {
    const LAS int* tstart; int sh; bool gather; const int* tokof; const LAS int* tokbuf; const LAS int* ulist; unsigned pitch;
    static DI void build(Frame& F, const LAS int* tstart, int nNt, LAS int* ulist) {
        __syncthreads();
        const int nwg = tstart[32] * nNt;
        if (F.tid == 0) ulist[0] = 0;
        __syncthreads();
        if (F.tid < 24) {
            const long L = (long)F.tid * F.G + F.bid;
            if (L < nwg) {
                int wgid = (int)L; { const int q = nwg / 8, r = nwg % 8, xcd = wgid % 8, off = wgid / 8; wgid = (xcd < r ? xcd * (q + 1) : r * (q + 1) + (xcd - r) * q) + off; }
                int e = 0;
                for (int k = 1; k < 32; ++k) if (tstart[k] * nNt <= wgid) e = k;
                const int rem = wgid - tstart[e] * nNt, nte = tstart[e + 1] - tstart[e];
                const int ct = rem / nte, rt = rem % nte;
                ulist[4 + 4 * F.tid] = tstart[e] + rt; ulist[5 + 4 * F.tid] = e * nNt + ct; ulist[6 + 4 * F.tid] = e; ulist[7 + 4 * F.tid] = rt;
                __hip_atomic_fetch_add(ulist, 1, __ATOMIC_RELAXED, __HIP_MEMORY_SCOPE_WORKGROUP);
            }
        }
        __syncthreads();
    }
    DI bool next(int i, pg8::Unit& u) const {
        if (i >= ulist[0]) return false;
        u.pm = ulist[4 + 4 * i]; u.pn = ulist[5 + 4 * i]; return true;
    }
    DI unsigned a_off(const pg8::Unit& u, int r) const {
        if (!gather) return (unsigned)(u.pm * 256 + r) * pitch;
        const int e = u.pn >> sh, idx = (u.pm - tstart[e]) * 256 + r;
        const int t = idx < tstart[80 + e] ? tokof[(size_t)e * T + idx] : 0;
        return (unsigned)t * pitch;
    }
    DI void prefetch(const pg8::Unit& u, int slot, int wid, int lane) const {
        if (gather && wid == 0) {
            const int e = u.pn >> sh, rt = u.pm - tstart[e];
            __builtin_amdgcn_global_load_lds((const unsigned*)(tokof + (size_t)e * T + rt * 256 + vlane() * 4), (LAS unsigned*)((LAS unsigned char*)tokbuf + slot * 1024), 16, 0, 0);
        }
    }
    DI unsigned a_off_pf(const pg8::Unit& u, int r, int slot) const {
        if (!gather) return (unsigned)(u.pm * 256 + r) * pitch;
        const int e = u.pn >> sh, idx = (u.pm - tstart[e]) * 256 + r;
        const int t = idx < tstart[80 + e] ? tokbuf[slot * 256 + r] : 0;
        return (unsigned)t * pitch;
    }
    DI void a_ready(const pg8::Unit&) const {}
    DI void done(const pg8::Unit&) const {}
};

struct MoeOrderDN {
    const LAS int* ulist;
    DI bool next(int i, pg8::Unit& u) const { if (i >= ulist[0]) return false; u.pm = __builtin_amdgcn_readfirstlane(ulist[4 + 4 * i]); u.pn = __builtin_amdgcn_readfirstlane(ulist[5 + 4 * i]); return true; }
    DI unsigned a_off(const pg8::Unit& u, int r) const { return (unsigned)(u.pm * 256 + r) * 1024u; }
    DI unsigned a_off_pf(const pg8::Unit& u, int r, int) const { return a_off(u, r); }
    DI void prefetch(const pg8::Unit&, int, int, int) const {}
    DI void a_ready(const pg8::Unit&) const {}
    DI void done(const pg8::Unit&) const {}
};

DI int crow(int r, int hi) { return (r & 3) + 8 * (r >> 2) + 4 * hi; }
template <int DK, bool FOX, bool ROPEQ>
DI void attn_unit(LAS unsigned char* lds, const bf16_t* Q, int ldq, const bf16_t* Kp, int ldk, const bf16_t* Vt, int ldv,
                  const float* cum, bf16_t* O, int ldo, int q0, int ntiles, bool causal, const int* pos, const int wid, const float* kn2 = nullptr) {
    constexpr int PK = DK * 2 + 16, KBYTES = 64 * PK, VBYTES = 64 * 136, BUF = KBYTES + VBYTES + 256, KCH = DK / 8, NS = DK / 16;
    const int lane = vlane(), tid = wid * 64 + lane, r32 = lane & 31, hi = lane >> 5;
    const int qw0 = q0 + wid * 32, qrow = qw0 + r32;
    bf16x8 qf[NS];
#pragma unroll
    for (int s = 0; s < NS; ++s) qf[s] = *(const bf16x8*)(Q + (size_t)qrow * ldq + 16 * s + 8 * hi);
    if constexpr (ROPEQ) {
        const float p = (float)pos[qrow];
#pragma unroll
        for (int j = 0; j < 8; ++j) {
            const int i = 8 * hi + j;
            const float inv = exp2f(-(float)i * (13.287712379549449f / 16.0f));
            float sn, cs; sincos_cw(p * inv, sn, cs);
            const float x1 = bf2f((unsigned short)qf[4][j]), x2 = bf2f((unsigned short)qf[5][j]);
            const float o1 = x1 * cs - x2 * sn, o2 = x1 * sn + x2 * cs;
            qf[4][j] = (short)(cvtpk(o1, 0.f) & 0xffffu); qf[5][j] = (short)(cvtpk(o2, 0.f) & 0xffffu);
        }
    }
    const float cq = FOX ? cum[qrow] : 0.f;
    int jstart = 0; float prune_c = 0.f;
    if constexpr (FOX) {
        LAS float* red = (LAS float*)(lds + 2 * BUF);
        float ss = 0.f;
#pragma unroll
        for (int s = 0; s < NS; ++s)
#pragma unroll
            for (int j = 0; j < 8; ++j) { const float v = bf2f((unsigned short)qf[s][j]); ss += v * v; }
        ss += __shfl_xor(ss, 32);
        ss = wave_max(ss);
        float kk = 0.f;
        for (int j = tid; j < ntiles; j += NTHREADS) kk = fmaxf(kk, kn2[j]);
        kk = wave_max(kk);
        __syncthreads();
        if (lane == 0) { red[wid] = ss; red[8 + wid] = kk; }
        __syncthreads();
        float qm = red[0], km = red[8];
#pragma unroll
        for (int w = 1; w < 8; ++w) { qm = fmaxf(qm, red[w]); km = fmaxf(km, red[8 + w]); }
        prune_c = 2.0f * sqrtf(qm * km) * 1.01f + 65.0f;
        const float cq0 = cum[q0];
        int cand = ntiles;
        for (int j = tid; j < ntiles; j += NTHREADS) if (cq0 - cum[64 * j + 63] + prune_c >= 0.f) cand = min(cand, j);
#pragma unroll
        for (int o = 1; o < 64; o <<= 1) cand = min(cand, __shfl_xor(cand, o));
        __syncthreads();
        if (lane == 0) ((LAS int*)red)[16 + wid] = cand;
        __syncthreads();
        jstart = ((LAS int*)red)[16];
#pragma unroll
        for (int w = 1; w < 8; ++w) jstart = min(jstart, ((LAS int*)red)[16 + w]);
        jstart = min(jstart, ntiles - 4);
        __syncthreads();
    }
    const float cqw0 = FOX ? __shfl(cq, 0) : 0.f;
    f32x16 o0, o1;
#pragma unroll
    for (int r = 0; r < 16; ++r) { o0[r] = 0.f; o1[r] = 0.f; }
    float mrun = -1e30f, lrun = 0.f;
    const int kr0 = tid / KCH, kc0 = tid % KCH;
    const int kr1 = (tid + 512) / KCH, kc1 = (tid + 512) % KCH;
    const bool k2 = (DK == 96) && (tid < 256);
    const int vd = tid >> 3, vc = tid & 7;
    u32x4 kreg0, kreg1 = (u32x4){0, 0, 0, 0}, vreg; float creg = 0.f;
#define ATT_GLOAD(j) do { \
        kreg0 = *(const u32x4*)(Kp + (size_t)(64 * (j) + kr0) * ldk + kc0 * 8); \
        if (k2) kreg1 = *(const u32x4*)(Kp + (size_t)(64 * (j) + kr1) * ldk + kc1 * 8); \
        vreg = *(const u32x4*)(Vt + (size_t)vd * ldv + 64 * (j) + vc * 8); \
        if (FOX && tid < 64) creg = cum[64 * (j) + tid]; } while (0)
#define ATT_LWRITE(buf) do { LAS unsigned char* bb_ = lds + (buf) * BUF; \
        *(LAS u32x4*)(bb_ + kr0 * PK + kc0 * 16) = kreg0; \
        if (k2) *(LAS u32x4*)(bb_ + kr1 * PK + kc1 * 16) = kreg1; \
        *(LAS u32x2*)(bb_ + KBYTES + vd * 136 + vc * 16) = (u32x2){vreg.x, vreg.y}; \
        *(LAS u32x2*)(bb_ + KBYTES + vd * 136 + vc * 16 + 8) = (u32x2){vreg.z, vreg.w}; \
        if (FOX && tid < 64) *(LAS float*)(bb_ + KBYTES + VBYTES + tid * 4) = creg; } while (0)
    ATT_GLOAD(jstart); ATT_LWRITE(0); __syncthreads();
    for (int j = jstart; j < ntiles; ++j) {
        const int cur = (j - jstart) & 1;
        if (j + 1 < ntiles) ATT_GLOAD(j + 1);
        const LAS unsigned char* kb = lds + cur * BUF; const LAS unsigned char* vb = kb + KBYTES; const LAS unsigned char* cb = vb + VBYTES;
        bool active = !causal || (64 * j <= qw0 + 31);
        if constexpr (FOX) { if (cqw0 - *(const LAS float*)(cb + 63 * 4) + prune_c < 0.f) active = false; }
        if (active) {
            f32x16 sp0, sp1;
#pragma unroll
            for (int r = 0; r < 16; ++r) { sp0[r] = 0.f; sp1[r] = 0.f; }
#pragma unroll
            for (int s = 0; s < NS; ++s) {
                const bf16x8 k0 = *(const LAS bf16x8*)(kb + r32 * PK + 32 * s + 16 * hi);
                const bf16x8 k1 = *(const LAS bf16x8*)(kb + (32 + r32) * PK + 32 * s + 16 * hi);
                sp0 = __builtin_amdgcn_mfma_f32_32x32x16_bf16(k0, qf[s], sp0, 0, 0, 0);
                sp1 = __builtin_amdgcn_mfma_f32_32x32x16_bf16(k1, qf[s], sp1, 0, 0, 0);
            }
            __builtin_amdgcn_sched_barrier(0);
            if constexpr (FOX) {
#pragma unroll
                for (int g = 0; g < 4; ++g) {
                    const f32x4 c0 = *(const LAS f32x4*)(cb + (8 * g + 4 * hi) * 4);
                    const f32x4 c1 = *(const LAS f32x4*)(cb + (32 + 8 * g + 4 * hi) * 4);
#pragma unroll
                    for (int i = 0; i < 4; ++i) { sp0[4 * g + i] += cq - c0[i]; sp1[4 * g + i] += cq - c1[i]; }
                }
            }
            if (causal && (64 * j + 63 > qw0)) {
#pragma unroll
                for (int r = 0; r < 16; ++r) {
                    const int key = 64 * j + crow(r, hi);
                    if (key > qrow) sp0[r] = -1e30f;
                    if (key + 32 > qrow) sp1[r] = -1e30f;
                }
            }
            float mx = fmaxf(sp0[0], sp1[0]);
#pragma unroll
            for (int r = 1; r < 16; ++r) mx = fmaxf(mx, fmaxf(sp0[r], sp1[r]));
            mx = fmaxf(mx, __shfl_xor(mx, 32));
            const float mnew = fmaxf(mrun, mx);
            const float alpha = __builtin_amdgcn_exp2f(mrun - mnew);
            mrun = mnew;
            float ls = 0.f;
#pragma unroll
            for (int r = 0; r < 16; ++r) { sp0[r] = __builtin_amdgcn_exp2f(sp0[r] - mnew); sp1[r] = __builtin_amdgcn_exp2f(sp1[r] - mnew); ls += sp0[r] + sp1[r]; }
            lrun = lrun * alpha + ls;
#pragma unroll
            for (int r = 0; r < 16; ++r) { o0[r] *= alpha; o1[r] *= alpha; }
            __builtin_amdgcn_sched_barrier(0);
#pragma unroll
            for (int ks = 0; ks < 4; ++ks) {
                const int p = ks >> 1, s2 = ks & 1;
                u32x4 pw;
                if (p == 0) { pw.x = cvtpk(sp0[8 * s2 + 0], sp0[8 * s2 + 1]); pw.y = cvtpk(sp0[8 * s2 + 2], sp0[8 * s2 + 3]); pw.z = cvtpk(sp0[8 * s2 + 4], sp0[8 * s2 + 5]); pw.w = cvtpk(sp0[8 * s2 + 6], sp0[8 * s2 + 7]); }
                else        { pw.x = cvtpk(sp1[8 * s2 + 0], sp1[8 * s2 + 1]); pw.y = cvtpk(sp1[8 * s2 + 2], sp1[8 * s2 + 3]); pw.z = cvtpk(sp1[8 * s2 + 4], sp1[8 * s2 + 5]); pw.w = cvtpk(sp1[8 * s2 + 6], sp1[8 * s2 + 7]); }
                const bf16x8 pf = __builtin_bit_cast(bf16x8, pw);
                const int kbase = (32 * p + 16 * s2 + 4 * hi) * 2;
                {
                    const u32x2 lo = *(const LAS u32x2*)(vb + r32 * 136 + kbase), h2 = *(const LAS u32x2*)(vb + r32 * 136 + kbase + 16);
                    const bf16x8 vf = __builtin_bit_cast(bf16x8, (u32x4){lo.x, lo.y, h2.x, h2.y});
                    o0 = __builtin_amdgcn_mfma_f32_32x32x16_bf16(vf, pf, o0, 0, 0, 0);
                }
                {
                    const u32x2 lo = *(const LAS u32x2*)(vb + (32 + r32) * 136 + kbase), h2 = *(const LAS u32x2*)(vb + (32 + r32) * 136 + kbase + 16);
                    const bf16x8 vf = __builtin_bit_cast(bf16x8, (u32x4){lo.x, lo.y, h2.x, h2.y});
                    o1 = __builtin_amdgcn_mfma_f32_32x32x16_bf16(vf, pf, o1, 0, 0, 0);
                }
            }
        }
        if (j + 1 < ntiles) ATT_LWRITE(cur ^ 1);
        __syncthreads();
    }
#undef ATT_GLOAD
#undef ATT_LWRITE
    const float ltot = lrun + __shfl_xor(lrun, 32);
    const float inv = 1.0f / ltot;
#pragma unroll
    for (int g = 0; g < 4; ++g) {
        const int d0 = 8 * g + 4 * hi;
        u32x2 w0, w1;
        w0.x = cvtpk(o0[4 * g] * inv, o0[4 * g + 1] * inv); w0.y = cvtpk(o0[4 * g + 2] * inv, o0[4 * g + 3] * inv);
        w1.x = cvtpk(o1[4 * g] * inv, o1[4 * g + 1] * inv); w1.y = cvtpk(o1[4 * g + 2] * inv, o1[4 * g + 3] * inv);
        *(u32x2*)(O + (size_t)qrow * ldo + d0) = w0;
        *(u32x2*)(O + (size_t)qrow * ldo + 32 + d0) = w1;
    }
}


template <int DK, bool ROPEQ>
DI void attn_unit_pipe(LAS unsigned char* lds, const bf16_t* Q, int ldq, const bf16_t* Kp, int ldk, const bf16_t* Vt, int ldv,
                       bf16_t* O, int ldo, int q0, int ntiles, const int* pos, const int wid) {
    constexpr int PK = DK * 2 + 16, KBYTES = 64 * PK, VBYTES = 64 * 136, KCH = DK / 8, NS = DK / 16, VOFF = 2 * KBYTES;
    constexpr float THR = 6.0f;
    const int lane = vlane(), tid = wid * 64 + lane, r32 = lane & 31, hi = lane >> 5;
    const int qw0 = q0 + wid * 32, qrow = qw0 + r32;
    bf16x8 qf[NS];
#pragma unroll
    for (int s = 0; s < NS; ++s) qf[s] = *(const bf16x8*)(Q + (size_t)qrow * ldq + 16 * s + 8 * hi);
    if constexpr (ROPEQ) {
        const float p = (float)pos[qrow];
#pragma unroll
        for (int j = 0; j < 8; ++j) {
            const int i = 8 * hi + j;
            const float inv = exp2f(-(float)i * (13.287712379549449f / 16.0f));
            float sn, cs; sincos_cw(p * inv, sn, cs);
            const float x1 = bf2f((unsigned short)qf[NS - 2][j]), x2 = bf2f((unsigned short)qf[NS - 1][j]);
            const float o1 = x1 * cs - x2 * sn, o2 = x1 * sn + x2 * cs;
            qf[NS - 2][j] = (short)(cvtpk(o1, 0.f) & 0xffffu); qf[NS - 1][j] = (short)(cvtpk(o2, 0.f) & 0xffffu);
        }
    }
    const int kr0 = tid / KCH, kc0 = tid % KCH;
    const int kr1 = (tid + 512) / KCH, kc1 = (tid + 512) % KCH;
    const bool k2 = (DK == 96) && (tid < 256);
    const int vd = tid >> 3, vc = tid & 7;
    const int kfo = r32 * PK + 16 * hi;
    const int vfo = VOFF + r32 * 136 + 8 * hi;
    u32x4 kA0, kA1 = (u32x4){0, 0, 0, 0}, vA, kB0, kB1 = (u32x4){0, 0, 0, 0}, vB;
#define SBAR() __builtin_amdgcn_sched_barrier(0)
#define AP_LOADK(j, R0, R1) do { R0 = *(const u32x4*)(Kp + (size_t)(64 * (j) + kr0) * ldk + kc0 * 8); \
        if (k2) R1 = *(const u32x4*)(Kp + (size_t)(64 * (j) + kr1) * ldk + kc1 * 8); } while (0)
#define AP_LOADV(j, RV) do { RV = *(const u32x4*)(Vt + (size_t)vd * ldv + 64 * (j) + vc * 8); } while (0)
#define AP_WRITEK(buf, R0, R1) do { LAS unsigned char* bb_ = lds + (buf) * KBYTES; *(LAS u32x4*)(bb_ + kr0 * PK + kc0 * 16) = R0; \
        if (k2) *(LAS u32x4*)(bb_ + kr1 * PK + kc1 * 16) = R1; } while (0)
#define AP_WRITEV(buf, RV) do { LAS unsigned char* bb_ = lds + VOFF + (buf) * VBYTES; \
        *(LAS u32x2*)(bb_ + vd * 136 + vc * 16) = (u32x2){RV.x, RV.y}; *(LAS u32x2*)(bb_ + vd * 136 + vc * 16 + 8) = (u32x2){RV.z, RV.w}; } while (0)
#define AP_KF(dst0, dst1, kbuf, s) do { dst0 = *(const LAS bf16x8*)(lds + (kbuf) * KBYTES + kfo + 32 * (s)); dst1 = *(const LAS bf16x8*)(lds + (kbuf) * KBYTES + kfo + 32 * PK + 32 * (s)); } while (0)
#define AP_VF(dst0, dst1, vbuf, ks) do { const LAS unsigned char* p_ = lds + (vbuf) * VBYTES + vfo + (32 * ((ks) >> 1) + 16 * ((ks) & 1)) * 2; \
        const u32x2 a_ = *(const LAS u32x2*)(p_), b_ = *(const LAS u32x2*)(p_ + 16), c_ = *(const LAS u32x2*)(p_ + 32 * 136), d_ = *(const LAS u32x2*)(p_ + 32 * 136 + 16); \
        dst0 = __builtin_bit_cast(bf16x8, (u32x4){a_.x, a_.y, b_.x, b_.y}); dst1 = __builtin_bit_cast(bf16x8, (u32x4){c_.x, c_.y, d_.x, d_.y}); } while (0)
#define AP_MFMA(a, b, c) __builtin_amdgcn_mfma_f32_32x32x16_bf16(a, b, c, 0, 0, 0)
#define AP_MASK(S0, S1, t) do { _Pragma("unroll") for (int r_ = 0; r_ < 16; ++r_) { const int key_ = 64 * (t) + crow(r_, hi); \
        if (key_ > qrow) S0[r_] = -1e30f; if (key_ + 32 > qrow) S1[r_] = -1e30f; } } while (0)
#define AP_ROWMAX(S0, S1, out) do { float a_ = fmaxf(fmaxf(S0[0], S1[0]), S0[1]), b_ = fmaxf(fmaxf(S1[1], S0[2]), S1[2]); \
        _Pragma("unroll") for (int r_ = 3; r_ < 15; r_ += 2) { a_ = fmaxf(fmaxf(a_, S0[r_]), S1[r_]); b_ = fmaxf(fmaxf(b_, S0[r_ + 1]), S1[r_ + 1]); } \
        a_ = fmaxf(fmaxf(a_, S0[15]), S1[15]); a_ = fmaxf(a_, b_); out = fmaxf(a_, __shfl_xor(a_, 32)); } while (0)
    f32x16 o0, o1, pa0, pa1, sb0, sb1;
#pragma unroll
    for (int r = 0; r < 16; ++r) { o0[r] = 0.f; o1[r] = 0.f; }
    float mref = 0.f, lrun = 0.f;
    bf16x8 pf[4];
    bf16x8 fa0, fa1, fb0, fb1;
    AP_LOADK(0, kA0, kA1); AP_LOADV(0, vA); AP_WRITEK(0, kA0, kA1); AP_WRITEV(0, vA);
    AP_LOADK(1, kA0, kA1); AP_WRITEK(1, kA0, kA1);
    AP_LOADK(2, kA0, kA1); AP_LOADV(1, vA);
    __syncthreads();
#pragma unroll
    for (int r = 0; r < 16; ++r) { pa0[r] = 0.f; pa1[r] = 0.f; }
#pragma unroll
    for (int s = 0; s < NS; ++s) { AP_KF(fa0, fa1, 0, s); pa0 = AP_MFMA(fa0, qf[s], pa0); pa1 = AP_MFMA(fa1, qf[s], pa1); }
    if (ntiles == 4) AP_MASK(pa0, pa1, 0);
    { float mx; AP_ROWMAX(pa0, pa1, mx); mref = mx;
#pragma unroll
      for (int r = 0; r < 16; ++r) { pa0[r] = __builtin_amdgcn_exp2f(pa0[r] - mx); pa1[r] = __builtin_amdgcn_exp2f(pa1[r] - mx); } }
    __syncthreads();
    f32x16 negm;
#pragma unroll
    for (int r = 0; r < 16; ++r) negm[r] = -mref;
    asm volatile("" : "+v"(negm));
#define AP_STEPA(s, X0, X1, Y0, Y1, VALU) do { if ((s) + 1 < NS) AP_KF(Y0, Y1, kb_, (s) + 1); else AP_VF(Y0, Y1, vb_, 0); \
        if ((s) == 0) { sb0 = AP_MFMA(X0, qf[s], negm); sb1 = AP_MFMA(X1, qf[s], negm); } else { sb0 = AP_MFMA(X0, qf[s], sb0); sb1 = AP_MFMA(X1, qf[s], sb1); } VALU; SBAR(); } while (0)
#define AP_PK(i, P, b) pw_[i] = (u32x4){cvtpk(P[b], P[b + 1]), cvtpk(P[b + 2], P[b + 3]), cvtpk(P[b + 4], P[b + 5]), cvtpk(P[b + 6], P[b + 7])}; \
        ls0_ = fadd_s(ls0_, fadd_s(fadd_s(P[b], P[b + 1]), fadd_s(P[b + 2], P[b + 3]))); ls1_ = fadd_s(ls1_, fadd_s(fadd_s(P[b + 4], P[b + 5]), fadd_s(P[b + 6], P[b + 7]))); asm volatile("" : "+v"(pw_[i]), "+v"(ls0_), "+v"(ls1_))
#define AP_EXP4(P, S, b) do { P[b] = __builtin_amdgcn_exp2f(S[b]); P[b + 1] = __builtin_amdgcn_exp2f(S[b + 1]); P[b + 2] = __builtin_amdgcn_exp2f(S[b + 2]); P[b + 3] = __builtin_amdgcn_exp2f(S[b + 3]); asm volatile("" : "+v"(P)); } while (0)
#define AP_STEPB(ks, X0, X1, Y0, Y1, E0, E1) do { if ((ks) + 1 < 4) AP_VF(Y0, Y1, vb_, (ks) + 1); \
        o0 = AP_MFMA(X0, pf[ks], o0); E0; SBAR(); o1 = AP_MFMA(X1, pf[ks], o1); E1; SBAR(); } while (0)
#define AP_ITER(t, MASKED, WK0, WK1, WV, LK0, LK1, LV) do {     \
        const int kb_ = (t) & 1, vb_ = ((t) - 1) & 1; \
        if ((t) + 2 < ntiles) AP_LOADK((t) + 2, LK0, LK1); \
        if ((t) + 1 < ntiles) AP_LOADV((t) + 1, LV); \
        u32x4 pw_[4]; float ls0_ = 0.f, ls1_ = 0.f; \
        AP_KF(fa0, fa1, kb_, 0); SBAR(); \
        AP_STEPA(0, fa0, fa1, fb0, fb1, AP_PK(0, pa0, 0)); \
        AP_STEPA(1, fb0, fb1, fa0, fa1, AP_PK(1, pa0, 8)); \
        AP_STEPA(2, fa0, fa1, fb0, fb1, AP_PK(2, pa1, 0)); \
        AP_STEPA(3, fb0, fb1, fa0, fa1, AP_PK(3, pa1, 8)); \
        if (NS == 6) { AP_STEPA(4, fa0, fa1, fb0, fb1, (void)0); AP_STEPA(5, fb0, fb1, fa0, fa1, (void)0); } \
        lrun += ls0_ + ls1_; \
        pf[0] = __builtin_bit_cast(bf16x8, pw_[0]); pf[1] = __builtin_bit_cast(bf16x8, pw_[1]); pf[2] = __builtin_bit_cast(bf16x8, pw_[2]); pf[3] = __builtin_bit_cast(bf16x8, pw_[3]); \
        if ((t) >= ntiles - 4) AP_MASK(sb0, sb1, t); \
        float mx_; AP_ROWMAX(sb0, sb1, mx_); \
        float resc_ = 1.0f; bool do_resc_ = false; \
        if (__any(mx_ > THR)) { const float dl_ = fmaxf(mx_, 0.f); mref += dl_; \
            _Pragma("unroll") for (int r_ = 0; r_ < 16; ++r_) { sb0[r_] -= dl_; sb1[r_] -= dl_; negm[r_] = -mref; } \
            asm volatile("" : "+v"(negm)); \
            resc_ = __builtin_amdgcn_exp2f(-dl_); lrun *= resc_; do_resc_ = true; } \
        SBAR(); \
        AP_STEPB(0, fa0, fa1, fb0, fb1, AP_EXP4(pa0, sb0, 0), AP_EXP4(pa0, sb0, 4)); \
        AP_STEPB(1, fb0, fb1, fa0, fa1, AP_EXP4(pa0, sb0, 8), AP_EXP4(pa0, sb0, 12)); \
        AP_STEPB(2, fa0, fa1, fb0, fb1, AP_EXP4(pa1, sb1, 0), AP_EXP4(pa1, sb1, 4)); \
        AP_STEPB(3, fb0, fb1, fa0, fa1, AP_EXP4(pa1, sb1, 8), AP_EXP4(pa1, sb1, 12)); \
        if (do_resc_) { asm volatile("" ::: "memory"); _Pragma("unroll") for (int r_ = 0; r_ < 16; ++r_) { o0[r_] *= resc_; o1[r_] *= resc_; } asm volatile("" : "+v"(o0), "+v"(o1)); } \
        if ((t) + 1 < ntiles) AP_WRITEK(((t) + 1) & 1, WK0, WK1); \
        AP_WRITEV((t) & 1, WV); \
        __syncthreads(); } while (0)
    static_assert(NS == 4 || NS == 6, "head dim 64 or 96");
    if (wid >= 4) __builtin_amdgcn_s_setprio(1);
    int t = 1;
    for (; t + 1 < ntiles; t += 2) { AP_ITER(t, 1, kA0, kA1, vA, kB0, kB1, vB); AP_ITER(t + 1, 1, kB0, kB1, vB, kA0, kA1, vA); }
    AP_ITER(t, 1, kA0, kA1, vA, kB0, kB1, vB);
    {
        u32x4 pw_[4]; float ls0_ = 0.f, ls1_ = 0.f;
        AP_PK(0, pa0, 0); AP_PK(1, pa0, 8); AP_PK(2, pa1, 0); AP_PK(3, pa1, 8);
        lrun += ls0_ + ls1_;
        pf[0] = __builtin_bit_cast(bf16x8, pw_[0]); pf[1] = __builtin_bit_cast(bf16x8, pw_[1]); pf[2] = __builtin_bit_cast(bf16x8, pw_[2]); pf[3] = __builtin_bit_cast(bf16x8, pw_[3]);
        const int vb_ = (ntiles - 1) & 1;
#pragma unroll
        for (int ks = 0; ks < 4; ++ks) { AP_VF(fa0, fa1, vb_, ks); o0 = AP_MFMA(fa0, pf[ks], o0); o1 = AP_MFMA(fa1, pf[ks], o1); }
    }
    const float ltot = lrun + __shfl_xor(lrun, 32);
    const float inv = 1.0f / ltot;
#pragma unroll
    for (int g = 0; g < 4; ++g) {
        const int d0 = 8 * g + 4 * hi;
        u32x2 w0, w1;
        w0.x = cvtpk(o0[4 * g] * inv, o0[4 * g + 1] * inv); w0.y = cvtpk(o0[4 * g + 2] * inv, o0[4 * g + 3] * inv);
        w1.x = cvtpk(o1[4 * g] * inv, o1[4 * g + 1] * inv); w1.y = cvtpk(o1[4 * g + 2] * inv, o1[4 * g + 3] * inv);
        *(u32x2*)(O + (size_t)qrow * ldo + d0) = w0;
        *(u32x2*)(O + (size_t)qrow * ldo + 32 + d0) = w1;
    }
    __syncthreads();
#undef SBAR
#undef AP_LOADK
#undef AP_LOADV
#undef AP_WRITEK
#undef AP_WRITEV
#undef AP_KF
#undef AP_VF
#undef AP_MFMA
#undef AP_MASK
#undef AP_ROWMAX
#undef AP_STEPA
#undef AP_PK
#undef AP_EXP4
#undef AP_STEPB
#undef AP_ITER
}

#define XB_TMO      128
#define XB_XCNT(j)  (256  + 64 * (j))
#define XB_XSUB(j)  (1280 + 64 * (j))
#define XB_XGEN(j)  (2304 + 64 * (j))
#define XB_TOP      3328
#define XB_TOPGEN   3392
#define XCD_BAR_WORDS 3456
#define XB_SPIN_CAP (1u << 18)
DI unsigned xb_ld(unsigned* p) { return __hip_atomic_load(p, __ATOMIC_RELAXED, __HIP_MEMORY_SCOPE_AGENT); }
DI unsigned xb_add(unsigned* p, unsigned v) { return __hip_atomic_fetch_add(p, v, __ATOMIC_RELAXED, __HIP_MEMORY_SCOPE_AGENT); }
DI unsigned xb_xcc_id() { return (unsigned)__builtin_amdgcn_s_getreg((3 << 11) | 20) & 0xFu; }
#define XB_SPIN(cond, bar) do { unsigned _sp = 0; while (cond) { __builtin_amdgcn_s_sleep(1); \
    if ((++_sp & 255u) == 0u) { if (xb_ld(&(bar)[XB_TMO])) break; if (_sp > XB_SPIN_CAP) { atomicAdd(&(bar)[XB_TMO], 1u); break; } } } } while (0)
struct XcdBarrier { unsigned* bar; unsigned x; volatile LAS unsigned* st; int wid; };
DI XcdBarrier xcd_barrier_post(unsigned* bar, volatile LAS unsigned* st, int wid) {
    XcdBarrier b; b.bar = bar; b.x = xb_xcc_id(); b.st = st; b.wid = wid;
    if (wid == 0 && vlane() == 0) (void)xb_add(&bar[XB_XCNT(b.x)], 1u);
    return b;
}
DI void xcd_barrier_complete(unsigned* bar, unsigned x, unsigned& nloc, unsigned& nx) {
    const unsigned G = gridDim.x * gridDim.y * gridDim.z;
    unsigned sum, cnt, mine, sp = 0u;
    for (;;) {
        sum = 0u; cnt = 0u; mine = 0u;
#pragma unroll
        for (unsigned j = 0; j < 16; ++j) { const unsigned c = xb_ld(&bar[XB_XCNT(j)]); sum += c; cnt += (c > 0u) ? 1u : 0u; mine = (j == x) ? c : mine; }
        if (sum == G) break;
        __builtin_amdgcn_s_sleep(1);
        if ((++sp & 255u) == 0u) { if (xb_ld(&bar[XB_TMO])) break; if (sp > XB_SPIN_CAP) { atomicAdd(&bar[XB_TMO], 1u); break; } }
    }
    nloc = mine > 0u ? mine : 1u; nx = cnt > 0u ? cnt : 1u;
}
DI void xcd_barrier(const XcdBarrier& b) {
    asm volatile("s_waitcnt vmcnt(0)" ::: "memory");
    __syncthreads();
    if (b.wid == 0 && vlane() == 0) {
        unsigned* bar = b.bar;
        __builtin_amdgcn_s_waitcnt(0);
        unsigned nloc = b.st[0], nx = b.st[1];
        if (nloc == 0u) { xcd_barrier_complete(bar, b.x, nloc, nx); b.st[0] = nloc; b.st[1] = nx; }
        const unsigned old = xb_add(&bar[XB_XSUB(b.x)], 1u);
        const unsigned gen = old / nloc;
        if (old + 1u == (gen + 1u) * nloc) {
            __builtin_amdgcn_fence(__ATOMIC_RELEASE, "agent");
            asm volatile("s_waitcnt vmcnt(0)" ::: "memory");
            const unsigned og = xb_add(&bar[XB_TOP], 1u);
            const unsigned tg = og / nx;
            if (og + 1u == (tg + 1u) * nx) xb_add(&bar[XB_TOPGEN], 1u);
            else XB_SPIN(xb_ld(&bar[XB_TOPGEN]) == tg, bar);
            __builtin_amdgcn_fence(__ATOMIC_ACQUIRE, "agent");
            xb_add(&bar[XB_XGEN(b.x)], 1u);
            asm volatile("s_waitcnt vmcnt(0)" ::: "memory");
        } else {
            XB_SPIN(xb_ld(&bar[XB_XGEN(b.x)]) == gen, bar);
            __builtin_amdgcn_fence(__ATOMIC_ACQUIRE, "agent");
            asm volatile("s_waitcnt vmcnt(0)" ::: "memory");
        }
    }
    __syncthreads();
}

DI int next_unit(Frame& F, int widx) {
    LAS int* s = (LAS int*)(F.lds + LDS_CTL);
    __syncthreads();
    if (F.tid == 0) *s = (int)atomicAdd(F.ctl + CW_WORK + 64 * widx, 1u);
    __syncthreads();
    return *s;
}

DI void transpose_item(const float* W, int ldw, int srccol, int K, bf16_t* WT, int drow, LAS unsigned* scr, int k0, int lane, int nvalid) {
    const int n4 = lane & 15, kq = lane >> 4;
#pragma unroll 8
    for (int i = 0; i < 16; ++i) {
        const int kk = 4 * i + kq;
        f32x4 v = (f32x4){0.f, 0.f, 0.f, 0.f};
        if (4 * n4 < nvalid) v = *(const f32x4*)(W + (size_t)(k0 + kk) * ldw + srccol + 4 * n4);
        scr[kk * 33 + 2 * n4] = cvtpk(v[0], v[1]); scr[kk * 33 + 2 * n4 + 1] = cvtpk(v[2], v[3]);
    }
    LDS_WAIT(); asm volatile("" ::: "memory");
    const int c = lane & 7;
    const LAS unsigned short* s16 = (const LAS unsigned short*)scr;
#pragma unroll
    for (int j = 0; j < 8; ++j) {
        const int n = (lane >> 3) + 8 * j;
        const LAS unsigned short* sp = s16 + (8 * c) * 66 + n;
        u32x4 o;
        o.x = (unsigned)sp[0 * 66] | ((unsigned)sp[1 * 66] << 16); o.y = (unsigned)sp[2 * 66] | ((unsigned)sp[3 * 66] << 16);
        o.z = (unsigned)sp[4 * 66] | ((unsigned)sp[5 * 66] << 16); o.w = (unsigned)sp[6 * 66] | ((unsigned)sp[7 * 66] << 16);
        if (n < nvalid) *(u32x4*)(WT + (size_t)(drow + n) * K + k0 + 8 * c) = o;
    }
    LDS_WAIT(); asm volatile("" ::: "memory");
}
DI unsigned q8x4(float a, float b, float c, float d, float inv) {
    const float M = 12582912.0f;
    const unsigned ua = __float_as_uint(fmaf(a, inv, M)), ub = __float_as_uint(fmaf(b, inv, M)), uc = __float_as_uint(fmaf(c, inv, M)), ud = __float_as_uint(fmaf(d, inv, M));
    return __builtin_amdgcn_perm(ub, ua, 0x0c0c0400u) | __builtin_amdgcn_perm(ud, uc, 0x04000c0cu);
}
template <int QM>
DI void strip_item(const float* W, int ldw, int n0, unsigned char* dst, float* sc, LAS float* red, int tid) {
    const int c4 = tid & 15, kr = tid >> 4;
    const float* src = W + (size_t)(kr * 32) * ldw + n0 + 4 * c4;
    f32x4 v[32];
#pragma unroll
    for (int p = 0; p < 32; ++p) v[p] = *(const f32x4*)(src + (size_t)p * ldw);
    f32x4 m = (f32x4){0.f, 0.f, 0.f, 0.f};
#pragma unroll
    for (int p = 0; p < 32; ++p)
#pragma unroll
        for (int j = 0; j < 4; ++j) m[j] = fmaxf(m[j], fabsf(v[p][j]));
#pragma unroll
    for (int j = 0; j < 4; ++j) { m[j] = fmaxf(m[j], __shfl_xor(m[j], 16)); m[j] = fmaxf(m[j], __shfl_xor(m[j], 32)); }
    __syncthreads();
    if ((tid & 63) < 16) *(LAS f32x4*)(red + (tid >> 6) * 64 + 4 * c4) = m;
    __syncthreads();
#pragma unroll
    for (int w = 0; w < 8; ++w) { const f32x4 o = *(const LAS f32x4*)(red + w * 64 + 4 * c4);
#pragma unroll
        for (int j = 0; j < 4; ++j) m[j] = fmaxf(m[j], o[j]); }
    constexpr float QMAX = QM == 0 ? 127.0f : 448.0f;
    if (kr == 0) *(f32x4*)(sc + 4 * c4) = m * (1.0f / QMAX);
#pragma unroll
    for (int j = 0; j < 4; ++j) {
        const float inv = m[j] > 0.f ? QMAX / m[j] : 0.f;
        unsigned w[8];
#pragma unroll
        for (int q = 0; q < 8; ++q) {
            if constexpr (QM == 0) w[q] = q8x4(v[4 * q][j], v[4 * q + 1][j], v[4 * q + 2][j], v[4 * q + 3][j], inv);
            else w[q] = (unsigned)__builtin_amdgcn_cvt_pk_fp8_f32(v[4 * q + 2][j] * inv, v[4 * q + 3][j] * inv, __builtin_amdgcn_cvt_pk_fp8_f32(v[4 * q][j] * inv, v[4 * q + 1][j] * inv, 0, false), true);
        }
        u32x4* o = (u32x4*)(dst + (size_t)(4 * c4 + j) * 1024 + kr * 32);
        o[0] = (u32x4){w[0], w[1], w[2], w[3]}; o[1] = (u32x4){w[4], w[5], w[6], w[7]};
    }
}
constexpr int CONV_P1 = 2, CONV_A0 = 3, CONV_GU = 3, CONV_DN = 2, CONV_A1 = 6;
constexpr int MOE_S_GU = 32, MOE_S_DN = 16, MOE_STRIPS_PER_LAYER = 32 * (MOE_S_GU + MOE_S_DN);
DI void moe_convert_strip(unsigned char* ws, LAS float* red, int l, int r, int tid) {
    if (r < 32 * MOE_S_GU) {
        const int e = l * 32 + r / MOE_S_GU, nb = r % MOE_S_GU;
        const int jj = (nb & 15) * 64, drow = (jj >> 7) * 256 + (nb >> 4) * 128 + (jj & 127);
        strip_item<0>(KP->moe_w_gu + (size_t)e * 1024 * 2048, 2048, 64 * nb, ws + WS_W_GU + ((size_t)e * 2048 + drow) * 1024, (float*)(ws + WS_SGU) + (size_t)e * 2048 + drow, red, tid);
    } else {
        r -= 32 * MOE_S_GU;
        const int e = l * 32 + r / MOE_S_DN, nb = r % MOE_S_DN;
        strip_item<2>(KP->moe_w_dn + (size_t)e * 1024 * 1024, 1024, 64 * nb, ws + WS_W_DN + ((size_t)e * 1024 + 64 * nb) * 1024, (float*)(ws + WS_SDN) + (size_t)e * 1024 + 64 * nb, red, tid);
    }
}
constexpr int CW_CONVQ = CW_WORK + 64 * 8;
DI bool conv_pull(Frame& F, int l, int n) {
    LAS int* s = (LAS int*)(F.lds + LDS_CTL + 8);
    __syncthreads();
    if (F.tid == 0) *s = (int)atomicAdd(F.ctl + CW_CONVQ + 64 * l, (unsigned)n);
    __syncthreads();
    const int base = *s;
    for (int c = base; c < base + n && c < MOE_STRIPS_PER_LAYER; ++c) moe_convert_strip(F.ws, (LAS float*)F.lds, l, c, F.tid);
    __syncthreads();
    return base + n < MOE_STRIPS_PER_LAYER;
}
struct TrMat { const float* W; int ldw, col0, K, N; bf16_t* WT; int drow0, mode; };

DI void phase_prologue(Frame& F, const Params& P) {
    F.lane = vlane(); F.tid = F.wid * 64 + F.lane;
    LAS unsigned* scr = (LAS unsigned*)(F.lds + F.wid * 8448);
    const int gw = F.bid * 8 + F.wid, NGW = F.G * 8;
    unsigned char* ws = F.ws;
    TrMat mats[11];
    mats[0] = TrMat{KP->a_w_in, FOX_IN, 0, 1024, 1536, (bf16_t*)(ws + WS_W_AIN), 0, 0};
    mats[1] = TrMat{KP->a_w_in, FOX_IN, 2316, 1024, 256, (bf16_t*)(ws + WS_W_AIN), 1536, 0};
    mats[2] = TrMat{KP->a_w_in, FOX_IN, 1536, 1024, 768, (bf16_t*)(ws + WS_W_AIN), 1792, 0};
    mats[3] = TrMat{KP->a_w_out, 1024, 0, 1024, 1024, (bf16_t*)(ws + WS_W_AOUT), 0, 0};
    mats[4] = TrMat{KP->kv_w_dkv, 288, 0, 1024, 288, (bf16_t*)(ws + WS_W_BIN), 0, 0};
    mats[5] = TrMat{KP->b_w_in, 640, 0, 1024, 640, (bf16_t*)(ws + WS_W_BIN), 288, 0};
    mats[6] = TrMat{KP->b_w_uq, 1152, 0, 384, 1152, (bf16_t*)(ws + WS_W_UQ), 0, 0};
    mats[7] = TrMat{KP->kv_w_ukv, 1536, 0, 256, 1536, (bf16_t*)(ws + WS_W_UKV), 0, 1};
    mats[8] = TrMat{KP->b_w_out, 1024, 0, 1024, 1024, (bf16_t*)(ws + WS_W_BOUT), 0, 0};
    mats[9] = TrMat{KP->mem_w_kv, 512, 0, 1024, 512, (bf16_t*)(ws + WS_W_MKV), 0, 0};
    mats[10] = TrMat{KP->mem_w_kv + (size_t)1024 * 512, 512, 0, 1024, 512, (bf16_t*)(ws + WS_W_MKV) + (size_t)512 * 1024, 0, 0};
    int nsmall = 0;
#pragma unroll
    for (int i = 0; i < 11; ++i) nsmall += (mats[i].K / 64) * ((mats[i].N + 63) / 64);
    const int ntot = nsmall;
    for (int it = gw; it < ntot; it += NGW) {
        int r = it;
        if (r < nsmall) {
#pragma unroll
            for (int i = 0; i < 11; ++i) {
                const int nblk = (mats[i].N + 63) / 64, ni = (mats[i].K / 64) * nblk;
                if (r >= 0 && r < ni) {
                    const int kb = r / nblk, nb = r % nblk;
                    const int drow = mats[i].mode == 1 ? ((nb & 1) * 768 + (nb >> 1) * 64) : (mats[i].drow0 + 64 * nb);
                    transpose_item(mats[i].W, mats[i].ldw, mats[i].col0 + 64 * nb, mats[i].K, mats[i].WT, drow, scr, 64 * kb, F.lane, mats[i].N - 64 * nb);
                }
                r -= ni;
            }
            continue;
        }
    }
    __syncthreads();
    LAS float* wf = (LAS float*)F.lds;
    for (int i = F.tid; i < 1024 * 12; i += NTHREADS) { const int k = i / 12, h = i % 12; wf[i] = KP->a_w_in[(size_t)k * FOX_IN + 2304 + h]; }
    __syncthreads();
    float* logf = (float*)(ws + WS_LOGF);
    bf16_t* xb = (bf16_t*)(ws + WS_XB);
    for (int row = gw; row < T; row += NGW) {
        const f32x4* xr = (const f32x4*)(KP->x + (size_t)row * DM) + F.lane;
        f32x4 v[4];
#pragma unroll
        for (int j = 0; j < 4; ++j) v[j] = xr[64 * j];
        u32x2* o8 = (u32x2*)(xb + (size_t)row * DM) + F.lane;
#pragma unroll
        for (int j = 0; j < 4; ++j) o8[64 * j] = (u32x2){cvtpk(v[j][0], v[j][1]), cvtpk(v[j][2], v[j][3])};
        float part[12];
#pragma unroll
        for (int h = 0; h < 12; ++h) part[h] = 0.f;
#pragma unroll
        for (int j = 0; j < 4; ++j)
#pragma unroll
            for (int i = 0; i < 4; ++i) {
                const int k = 4 * F.lane + 256 * j + i;
                const LAS f32x4* wp = (const LAS f32x4*)(wf + k * 12);
                const f32x4 w0 = wp[0], w1 = wp[1], w2 = wp[2];
                const float xv = v[j][i];
                part[0] += xv * w0[0]; part[1] += xv * w0[1]; part[2] += xv * w0[2]; part[3] += xv * w0[3];
                part[4] += xv * w1[0]; part[5] += xv * w1[1]; part[6] += xv * w1[2]; part[7] += xv * w1[3];
                part[8] += xv * w2[0]; part[9] += xv * w2[1]; part[10] += xv * w2[2]; part[11] += xv * w2[3];
            }
        float mine = 0.f;
#pragma unroll
        for (int h = 0; h < 12; ++h) { const float s = wave_sum(part[h]); if (F.lane == h) mine = s; }
        if (F.lane < 12) {
            const float z = mine + KP->a_b_f[F.lane];
            const float ls = fminf(z, 0.f) - log1pf(expf(-fabsf(z)));
            const int b = row / SEQ, s = row % SEQ;
            logf[(size_t)(b * NH + F.lane) * SEQ + s] = ls;
        }
    }
    {
        float* wrt = (float*)(ws + WS_WRT);
        bf16_t* wrh = (bf16_t*)(ws + WS_WRH); bf16_t* wrl = (bf16_t*)(ws + WS_WRL);
        for (int i = F.bid * NTHREADS + F.tid; i < 2 * 1024 * 32; i += F.G * NTHREADS) { const int l = i >> 15, k = (i >> 5) & 1023, e = i & 31; const float w = KP->moe_w_r[i];
            const unsigned hb = cvtpk(w, 0.f) & 0xffffu; const float hf = __uint_as_float(hb << 16);
            wrt[(size_t)(l * 32 + e) * 1024 + k] = w; wrh[(size_t)(l * 32 + e) * 1024 + k] = (bf16_t)hb; wrl[(size_t)(l * 32 + e) * 1024 + k] = (bf16_t)(cvtpk(w - hf, 0.f) & 0xffffu); }
    }
    bf16_t* memb = (bf16_t*)(ws + WS_MEMB);
    for (int row = gw; row < NB * NMEM; row += NGW) {
        const f32x4* xr = (const f32x4*)(KP->mem + (size_t)row * DM) + F.lane;
        u32x2* o8 = (u32x2*)(memb + (size_t)row * DM) + F.lane;
#pragma unroll
        for (int j = 0; j < 4; ++j) { const f32x4 v = xr[64 * j]; o8[64 * j] = (u32x2){cvtpk(v[0], v[1]), cvtpk(v[2], v[3])}; }
    }
}

DI void scan_unit(Frame& F, int bh) {
    const float* src = (const float*)(F.ws + WS_LOGF) + (size_t)bh * SEQ;
    float* dst = (float*)(F.ws + WS_CUM) + (size_t)bh * SEQ;
    LAS float* wtot = (LAS float*)F.lds;
    float v[16];
#pragma unroll
    for (int j = 0; j < 4; ++j) { const f32x4 t = *(const f32x4*)(src + F.tid * 16 + 4 * j); v[4 * j] = t[0]; v[4 * j + 1] = t[1]; v[4 * j + 2] = t[2]; v[4 * j + 3] = t[3]; }
#pragma unroll
    for (int i = 1; i < 16; ++i) v[i] += v[i - 1];
    float tot = v[15];
    float inc = tot;
#pragma unroll
    for (int o = 1; o < 64; o <<= 1) { const float t = __shfl_up(inc, o); if (F.lane >= o) inc += t; }
    __syncthreads();
    if (F.lane == 63) wtot[F.wid] = inc;
    __syncthreads();
    float base = inc - tot;
    for (int w = 0; w < F.wid; ++w) base += wtot[w];
#pragma unroll
    for (int j = 0; j < 4; ++j) {
        f32x4 t; t[0] = (base + v[4 * j]) * LOG2E; t[1] = (base + v[4 * j + 1]) * LOG2E; t[2] = (base + v[4 * j + 2]) * LOG2E; t[3] = (base + v[4 * j + 3]) * LOG2E;
        *(f32x4*)(dst + F.tid * 16 + 4 * j) = t;
    }
    __syncthreads();
}

struct RouteQKM { unsigned char* ws; DI Dst operator()(const pg8::Unit& u) const {
    if (u.pn < 3) return Dst{(bf16_t*)(ws + WS_Q), 768, u.pm * 256, u.pn * 256, 256, 0.125f * LOG2E, false};
    if (u.pn < 6) return Dst{(bf16_t*)(ws + WS_K), 768, u.pm * 256, (u.pn - 3) * 256, 256, 1.0f, false};
    return Dst{(bf16_t*)(ws + WS_MQ), 256, u.pm * 256, 0, 256, 0.125f * LOG2E, false}; } };
struct RouteVT { unsigned char* ws; DI Dst operator()(const pg8::Unit& u) const {
    const int b = u.pn >> 5; return Dst{(bf16_t*)(ws + WS_VT) + (size_t)b * 768 * SEQ, SEQ, u.pm * 256, (u.pn & 31) * 256, 256, 1.0f, false}; } };
struct RoutePlain { bf16_t* O; int ldo; DI Dst operator()(const pg8::Unit& u) const { return Dst{O, ldo, u.pm * 256, u.pn * 256, 256, 1.0f, false}; } };
DI void phase_proj0(Frame& F, const Params& P) {
    F.lane = vlane(); F.tid = F.wid * 64 + F.lane;
    unsigned char* ws = F.ws;
    const bf16_t* xb = (const bf16_t*)(ws + WS_XB);
    const bf16_t* win = (const bf16_t*)(ws + WS_W_AIN);
    const bf16_t* memb = (const bf16_t*)(ws + WS_MEMB);
    {
        pg8::Gemm g{xb, win, 1024}; pg8::StaticOrder S; S.init(T, 1792, 1024, F.G, F.bid);
        EpiBf16R<RouteQKM> E{RouteQKM{ws}};
        pg8::gemm_phase<EpiBf16R<RouteQKM>, pg8::StaticOrder, true>(F.lds, g, S, E, F.wid);
    }
    {
        pg8::Gemm g{win + (size_t)1792 * 1024, xb, 1024}; pg8::StaticOrder S; S.init(768, T, 1024, F.G, (F.bid + 64) % F.G);
        EpiBf16R<RouteVT> E{RouteVT{ws}};
        pg8::gemm_phase<EpiBf16R<RouteVT>, pg8::StaticOrder, true>(F.lds, g, S, E, F.wid);
    }
    for (int l = 0; l < 2; ++l) {
        const bf16_t* wk = (const bf16_t*)(ws + WS_W_MKV) + (size_t)l * 512 * 1024;
        {
            pg8::Gemm g{memb, wk, 1024}; pg8::StaticOrder S; S.init(512, 256, 1024, F.G, (F.bid + F.G - (152 + 4 * l)) % F.G);
            EpiBf16R<RoutePlain> E{RoutePlain{(bf16_t*)(ws + WS_MK) + (size_t)l * 512 * 256, 256}};
            pg8::gemm_phase<EpiBf16R<RoutePlain>, pg8::StaticOrder, true>(F.lds, g, S, E, F.wid);
        }
        for (int b = 0; b < 2; ++b) {
            pg8::Gemm g{wk + (size_t)256 * 1024, memb + (size_t)b * 256 * 1024, 1024}; pg8::StaticOrder S; S.init(256, 256, 1024, F.G, (F.bid + F.G - (154 + 4 * l + b)) % F.G);
            EpiBf16R<RoutePlain> E{RoutePlain{(bf16_t*)(ws + WS_MVT) + (size_t)(l * 2 + b) * 256 * 256, 256}};
            pg8::gemm_phase<EpiBf16R<RoutePlain>, pg8::StaticOrder, true>(F.lds, g, S, E, F.wid);
        }
    }
    if (F.G == 256 && F.bid >= 128) conv_pull(F, 0, CONV_P1);
}


DI void phase_scan_knorm(Frame& F) {
    F.lane = vlane(); F.tid = F.wid * 64 + F.lane;
    unsigned char* ws = F.ws;
    if (F.bid < 24) scan_unit(F, F.bid);
    const bf16_t* K = (const bf16_t*)(ws + WS_K);
    float* kn2 = (float*)(ws + WS_KN2);
    const int gw = F.bid * 8 + F.wid, NGW = F.G * 8;
    for (int it = gw; it < 24 * 128; it += NGW) {
        const int bh = it >> 7, j = it & 127, b = bh / 12, h = bh % 12;
        const u32x4* kr = (const u32x4*)(K + (size_t)(b * SEQ + 64 * j + F.lane) * 768 + h * 64);
        float ss = 0.f;
#pragma unroll
        for (int c = 0; c < 8; ++c) {
            const u32x4 w = kr[c];
            const unsigned ww[4] = {w.x, w.y, w.z, w.w};
#pragma unroll
            for (int i = 0; i < 4; ++i) { const float a = __uint_as_float(ww[i] << 16), bb = __uint_as_float(ww[i] & 0xffff0000u); ss += a * a + bb * bb; }
        }
        ss = wave_max(ss);
        if (F.lane == 0) kn2[it] = ss;
    }
}

DI void mem_attn_unit(Frame& F, int l, int v) {
    unsigned char* ws = F.ws;
    const int qb = v >> 3, bm = v & 7, b = bm >> 2, mh = bm & 3;
    const bf16_t* Q = (const bf16_t*)(ws + WS_MQ) + (size_t)b * SEQ * 256 + mh * 64;
    const bf16_t* K = (const bf16_t*)(ws + WS_MK) + (size_t)l * 512 * 256 + (size_t)b * 256 * 256 + mh * 64;
    const bf16_t* Vt = (const bf16_t*)(ws + WS_MVT) + (size_t)(l * 2 + b) * 256 * 256 + (size_t)mh * 64 * 256;
    bf16_t* O = (bf16_t*)(ws + WS_MERGED) + (size_t)b * SEQ * 1024 + 768 + mh * 64;
    attn_unit<64, false, false>(F.lds, Q, 256, K, 256, Vt, 256, nullptr, O, 1024, qb * 256, 4, false, nullptr, F.wid);
}
DI void phase_attn0(Frame& F, const Params& P) {
    F.lane = vlane(); F.tid = F.wid * 64 + F.lane;
    unsigned char* ws = F.ws;
    constexpr int NU = 768 + 256 + 512;
    for (;;) {
        const int uu = next_unit(F, 0);
        if (uu >= NU) break;
        if (uu % 3 == 2) { conv_pull(F, 0, CONV_A0); continue; }
        const int u = 2 * (uu / 3) + uu % 3;
        if (u < 768) {
            const int qb = 31 - u / 24, bh = u % 24, b = bh / 12, h = bh % 12;
            const bf16_t* Q = (const bf16_t*)(ws + WS_Q) + (size_t)b * SEQ * 768 + h * 64;
            const bf16_t* K = (const bf16_t*)(ws + WS_K) + (size_t)b * SEQ * 768 + h * 64;
            const bf16_t* Vt = (const bf16_t*)(ws + WS_VT) + (size_t)(b * 768 + h * 64) * SEQ;
            const float* cum = (const float*)(ws + WS_CUM) + (size_t)bh * SEQ;
            bf16_t* O = (bf16_t*)(ws + WS_MERGED) + (size_t)b * SEQ * 1024 + h * 64;
            attn_unit<64, true, false>(F.lds, Q, 768, K, 768, Vt, SEQ, cum, O, 1024, qb * 256, 4 * (qb + 1), true, nullptr, F.wid, (const float*)(ws + WS_KN2) + bh * 128);
        } else mem_attn_unit(F, 0, u - 768);
    }
    while (conv_pull(F, 0, 16)) {}
}
DI void phase_attn1(Frame& F, const Params& P) {
    F.lane = vlane(); F.tid = F.wid * 64 + F.lane;
    unsigned char* ws = F.ws;
    constexpr int NCONV = 256, NU = 768 + 256 + NCONV;
    for (;;) {
        const int uu = next_unit(F, 1);
        if (uu >= NU) break;
        if (uu % 5 == 4) { conv_pull(F, 1, CONV_A1); continue; }
        const int u = 4 * (uu / 5) + uu % 5;
        if (u < 768) {
            const int qb = 31 - u / 24, bh = u % 24, b = bh / 12, h = bh % 12;
            const bf16_t* Q = (const bf16_t*)(ws + WS_Q) + (size_t)b * SEQ * 1152 + h * 96;
            const bf16_t* K = (const bf16_t*)(ws + WS_K) + (size_t)b * SEQ * 1152 + h * 96;
            const bf16_t* Vt = (const bf16_t*)(ws + WS_VT) + (size_t)(b * 768 + h * 64) * SEQ;
            bf16_t* O = (bf16_t*)(ws + WS_MERGED) + (size_t)b * SEQ * 1024 + h * 64;
            attn_unit_pipe<96, true>(F.lds, Q, 1152, K, 1152, Vt, SEQ, O, 1024, qb * 256, 4 * (qb + 1), KP->pos + (size_t)b * SEQ, F.wid);
        } else mem_attn_unit(F, 1, u - 768);
    }
    while (conv_pull(F, 1, 16)) {}
}

DI void phase_outproj(Frame& F, const bf16_t* Wt) {
    F.lane = vlane(); F.tid = F.wid * 64 + F.lane;
    unsigned char* ws = F.ws;
    pg8::Gemm g{(const bf16_t*)(ws + WS_MERGED), Wt, 1024}; pg8::StaticOrder S; S.init(T, 1024, 1024, F.G, F.bid);
    EpiResB16 E{(bf16_t*)(ws + WS_Y), (const bf16_t*)(ws + WS_XB)};
    pg8::gemm_phase<EpiResB16, pg8::StaticOrder, false>(F.lds, g, S, E, F.wid);
}


DI void phase_ln_router(Frame& F, const Params& P, int l) {
    F.lane = vlane(); F.tid = F.wid * 64 + F.lane;
    unsigned char* ws = F.ws;
    LAS unsigned char* wH = F.lds;
    LAS unsigned char* wL = F.lds + 65536;
    LAS int* pairs = (LAS int*)(F.lds + LDS_CTL + 1024);
    LAS int* lcnt = (LAS int*)(F.lds + LDS_CTL + 3072); LAS int* gbase = lcnt + 32;
    LAS float* lg = (LAS float*)(F.lds + LDS_R1X + F.wid * 1280);
    LAS int* rec = (LAS int*)(F.lds + LDS_R1X + F.wid * 1280 + 1024);
    LAS float* stt = (LAS float*)(F.lds + LDS_R1X + 8 * 1280 + F.wid * 64);
    __syncthreads();
    {
        const u32x4* srcH = (const u32x4*)((const bf16_t*)(ws + WS_WRH) + (size_t)l * 32 * 1024);
        const u32x4* srcL = (const u32x4*)((const bf16_t*)(ws + WS_WRL) + (size_t)l * 32 * 1024);
        for (int i = F.tid; i < 32 * 128; i += NTHREADS) { const int e = i >> 7, c = i & 127; const int off = e * 2048 + ((c ^ (e & 7)) << 4);
            *(LAS u32x4*)(wH + off) = srcH[i]; *(LAS u32x4*)(wL + off) = srcL[i]; }
    }
    if (F.tid < 32) lcnt[F.tid] = 0;
    __syncthreads();
    const float* g = KP->ln_g + (size_t)(l * 2 + 0) * DM; const float* bt = KP->ln_b + (size_t)(l * 2 + 0) * DM;
    const float* br = KP->moe_b_r + l * 32;
    const bf16_t* Y = (const bf16_t*)(ws + WS_Y);
    unsigned char* X1Q = ws + WS_X1B;
    float* SAS = (float*)(ws + WS_SAS);
    int* PE = (int*)(ws + WS_PE); int* PPOS = (int*)(ws + WS_PPOS); float* GATE = (float*)(ws + WS_GATE); int* TOKOF = (int*)(ws + WS_TOKOF);
    unsigned* cnt = F.ctl + CW_CNT + l * 32 * 64;
    const int gw = F.bid * 8 + F.wid, NGW = F.G * 8;
    int it = 0;
    u32x2 vnx[4];
    if (gw < T) {
#pragma unroll
        for (int j = 0; j < 4; ++j) vnx[j] = *((const u32x2*)(Y + (size_t)gw * DM) + F.lane + 64 * j);
    }
    for (int row = gw; row < T; row += NGW, ++it) {
        f32x4 v[4]; float s = 0.f;
#pragma unroll
        for (int j = 0; j < 4; ++j) { v[j] = bf4(vnx[j]); s += (v[j][0] + v[j][1]) + (v[j][2] + v[j][3]); }
        if (row + NGW < T) {
#pragma unroll
            for (int j = 0; j < 4; ++j) vnx[j] = *((const u32x2*)(Y + (size_t)(row + NGW) * DM) + F.lane + 64 * j);
        }
        const float mean = wave_sum(s) * (1.f / DM); float s2 = 0.f;
#pragma unroll
        for (int j = 0; j < 4; ++j) { v[j] = v[j] - mean; s2 += (v[j][0] * v[j][0] + v[j][1] * v[j][1]) + (v[j][2] * v[j][2] + v[j][3] * v[j][3]); }
        const float rstd = 1.0f / sqrtf(wave_sum(s2) * (1.f / DM) + LN_EPS);
        float am = 0.f;
#pragma unroll
        for (int j = 0; j < 4; ++j) {
            const f32x4 gg = *((const f32x4*)g + F.lane + 64 * j), bb = *((const f32x4*)bt + F.lane + 64 * j);
            v[j] = v[j] * rstd * gg + bb;
            am = fmaxf(fmaxf(am, fmaxf(fabsf(v[j][0]), fabsf(v[j][1]))), fmaxf(fabsf(v[j][2]), fabsf(v[j][3])));
        }
        am = wave_max(am);
        const float qinv = am > 0.f ? 127.0f / am : 0.f;
#pragma unroll
        for (int j = 0; j < 4; ++j) *((unsigned*)(X1Q + (size_t)row * DM) + F.lane + 64 * j) = q8x4(v[j][0], v[j][1], v[j][2], v[j][3], qinv);
        if (F.lane == 0) { stt[2 * (it & 7)] = mean; stt[2 * (it & 7) + 1] = rstd; pairs[(F.wid * 16 + 8 + (it & 7)) * 4] = (int)__float_as_uint(am * (1.0f / 127.0f)); }
    }
    asm volatile("s_waitcnt lgkmcnt(0)" ::: "memory");
    {
        const int r16 = F.lane & 15, kg = F.lane >> 4;
        const int arow = gw + NGW * (r16 & 7);
        const float mean = stt[2 * (r16 & 7)], rstd = stt[2 * (r16 & 7) + 1];
        const bf16_t* yr = Y + (size_t)(arow < T ? arow : gw) * DM + 8 * kg;
        const float* gp = g + 8 * kg; const float* bp = bt + 8 * kg;
        f32x4 acc0 = (f32x4){0.f, 0.f, 0.f, 0.f}, acc1 = (f32x4){0.f, 0.f, 0.f, 0.f};
        const int e0 = r16, e1 = 16 + r16;
        const int b0off = e0 * 2048, b1off = e1 * 2048, sw = r16 & 7;
#pragma unroll 4
        for (int s2 = 0; s2 < 32; ++s2) {
            const u32x4 yw = *(const u32x4*)(yr + 32 * s2); const f32x4 y0 = bf4((u32x2){yw.x, yw.y}), y1 = bf4((u32x2){yw.z, yw.w});
            const f32x4 g0 = *(const f32x4*)(gp + 32 * s2), g1 = *(const f32x4*)(gp + 32 * s2 + 4);
            const f32x4 c0 = *(const f32x4*)(bp + 32 * s2), c1 = *(const f32x4*)(bp + 32 * s2 + 4);
            const f32x4 x0 = (y0 - mean) * rstd * g0 + c0, x1 = (y1 - mean) * rstd * g1 + c1;
            u32x4 ah, al;
            ah.x = cvtpk(x0[0], x0[1]); ah.y = cvtpk(x0[2], x0[3]); ah.z = cvtpk(x1[0], x1[1]); ah.w = cvtpk(x1[2], x1[3]);
            al.x = cvtpk(x0[0] - __uint_as_float(ah.x << 16), x0[1] - __uint_as_float(ah.x & 0xffff0000u)); al.y = cvtpk(x0[2] - __uint_as_float(ah.y << 16), x0[3] - __uint_as_float(ah.y & 0xffff0000u));
            al.z = cvtpk(x1[0] - __uint_as_float(ah.z << 16), x1[1] - __uint_as_float(ah.z & 0xffff0000u)); al.w = cvtpk(x1[2] - __uint_as_float(ah.w << 16), x1[3] - __uint_as_float(ah.w & 0xffff0000u));
            const bf16x8 Ah = __builtin_bit_cast(bf16x8, ah), Al = __builtin_bit_cast(bf16x8, al);
            const int co = (((4 * s2 + kg) ^ sw) << 4);
            const bf16x8 Bh0 = *(const LAS bf16x8*)(wH + b0off + co), Bl0 = *(const LAS bf16x8*)(wL + b0off + co);
            const bf16x8 Bh1 = *(const LAS bf16x8*)(wH + b1off + co), Bl1 = *(const LAS bf16x8*)(wL + b1off + co);
            acc0 = __builtin_amdgcn_mfma_f32_16x16x32_bf16(Ah, Bh0, acc0, 0, 0, 0); acc0 = __builtin_amdgcn_mfma_f32_16x16x32_bf16(Al, Bh0, acc0, 0, 0, 0); acc0 = __builtin_amdgcn_mfma_f32_16x16x32_bf16(Ah, Bl0, acc0, 0, 0, 0);
            acc1 = __builtin_amdgcn_mfma_f32_16x16x32_bf16(Ah, Bh1, acc1, 0, 0, 0); acc1 = __builtin_amdgcn_mfma_f32_16x16x32_bf16(Al, Bh1, acc1, 0, 0, 0); acc1 = __builtin_amdgcn_mfma_f32_16x16x32_bf16(Ah, Bl1, acc1, 0, 0, 0);
        }
        if (kg < 2) {
            const float bb0 = br[e0], bb1 = br[e1];
#pragma unroll
            for (int r = 0; r < 4; ++r) { lg[(4 * kg + r) * 32 + e0] = acc0[r] + bb0; lg[(4 * kg + r) * 32 + e1] = acc1[r] + bb1; }
        }
        asm volatile("s_waitcnt lgkmcnt(0)" ::: "memory");
        const int rr = F.lane >> 3, sub = F.lane & 7;
        f32x4 vv[8];
#pragma unroll
        for (int q = 0; q < 8; ++q) vv[q] = *(const LAS f32x4*)(lg + rr * 32 + 4 * q);
        const f32x4 mine = *(const LAS f32x4*)(lg + rr * 32 + 4 * sub);
        int rk[4] = {0, 0, 0, 0};
#pragma unroll
        for (int q = 0; q < 8; ++q)
#pragma unroll
            for (int i = 0; i < 4; ++i) {
                const float ve = vv[q][i]; const int ee = 4 * q + i;
#pragma unroll
                for (int c = 0; c < 4; ++c) rk[c] += (ve > mine[c] || (ve == mine[c] && ee < 4 * sub + c)) ? 1 : 0;
            }
#pragma unroll
        for (int c = 0; c < 4; ++c) if (rk[c] < 4) { rec[(rr * 4 + rk[c]) * 2] = 4 * sub + c; rec[(rr * 4 + rk[c]) * 2 + 1] = (int)__float_as_uint(mine[c]); }
        asm volatile("s_waitcnt lgkmcnt(0)" ::: "memory");
        const int te0 = rec[(rr * 4 + 0) * 2], te1 = rec[(rr * 4 + 1) * 2], te2 = rec[(rr * 4 + 2) * 2], te3 = rec[(rr * 4 + 3) * 2];
        const float tv0 = __uint_as_float((unsigned)rec[(rr * 4 + 0) * 2 + 1]), tv1 = __uint_as_float((unsigned)rec[(rr * 4 + 1) * 2 + 1]);
        const float tv2 = __uint_as_float((unsigned)rec[(rr * 4 + 2) * 2 + 1]), tv3 = __uint_as_float((unsigned)rec[(rr * 4 + 3) * 2 + 1]);
        const float e1_ = __expf(tv1 - tv0), e2_ = __expf(tv2 - tv0), e3_ = __expf(tv3 - tv0);
        const float rs = 1.0f / (1.0f + e1_ + e2_ + e3_);
        const int row = gw + NGW * rr;
        if (sub < 4 && row < T) {
            const int k = sub;
            const int e = k == 0 ? te0 : k == 1 ? te1 : k == 2 ? te2 : te3;
            const float gt = (k == 0 ? 1.0f : k == 1 ? e1_ : k == 2 ? e2_ : e3_) * rs;
            const int rnk = __hip_atomic_fetch_add(lcnt + e, 1, __ATOMIC_RELAXED, __HIP_MEMORY_SCOPE_WORKGROUP);
            PE[row * 4 + k] = e; GATE[row * 4 + k] = gt; pairs[(F.wid * 16 + rr) * 4 + k] = e | (rnk << 8);
        }
    }
    __syncthreads();
    if (F.tid < 32) { const int c = lcnt[F.tid]; gbase[F.tid] = c ? (int)atomicAdd(cnt + F.tid * 64, (unsigned)c) : 0; }
    __syncthreads();
    it = 0;
    for (int row = gw; row < T; row += NGW, ++it) {
        if (F.lane < 4) {
            const int pr = pairs[(F.wid * 16 + (it & 15)) * 4 + F.lane], e = pr & 255, p = gbase[e] + (pr >> 8);
            PPOS[row * 4 + F.lane] = p; TOKOF[(size_t)e * T + p] = row; SAS[(size_t)e * T + p] = __uint_as_float((unsigned)pairs[(F.wid * 16 + 8 + (it & 7)) * 4]);
        }
    }
}

DI void moe_tables(Frame& F, int l, LAS int* tstart, LAS int* soff) {
    __syncthreads();
    if (F.tid == 0) {
        int ts = 0;
        for (int e = 0; e < 32; ++e) {
            const int c = (int)__hip_atomic_load(F.ctl + CW_CNT + (l * 32 + e) * 64, __ATOMIC_RELAXED, __HIP_MEMORY_SCOPE_AGENT);
            tstart[e] = ts; soff[e] = ts * 256; tstart[80 + e] = c; ts += (c + 255) >> 8;
        }
        tstart[32] = ts; soff[32] = ts * 256;
    }
    __syncthreads();
}
DI void phase_moe_gu(Frame& F, const Params& P, int l) {
    F.lane = vlane(); F.tid = F.wid * 64 + F.lane;
    unsigned char* ws = F.ws;
    LAS int* tstart = (LAS int*)(F.lds + LDS_CTL + 64); LAS int* soff = tstart + 40;
    moe_tables(F, l, tstart, soff);
    pg8::Gemm g{(const bf16_t*)(ws + WS_X1B), (const bf16_t*)(ws + WS_W_GU + (size_t)l * 32 * 2048 * 1024), 512};
    LAS int* ulist = (LAS int*)(F.lds + LDS_CTL + 3328);
    MoeOrder::build(F, tstart, 8, ulist);
    MoeOrder S{tstart, 3, true, (const int*)(ws + WS_TOKOF), (const LAS int*)(F.lds + LDS_CTL + 1024), ulist, 1024u};
    EpiGU E{ws + WS_H, KP->moe_b_gu + (size_t)l * 32 * 2048, (const float*)(ws + WS_SGU) + (size_t)l * 32 * 2048, (const float*)(ws + WS_SAS), tstart};
    pg8::gemm_phase<EpiGU, MoeOrder, true, 1>(F.lds, g, S, E, F.wid);
    if (l == 0) { const int rem = (tstart[32] * 8) % F.G; if (rem && F.bid >= rem) conv_pull(F, 1, CONV_GU); }
}
DI void phase_moe_dn(Frame& F, const Params& P, int l) {
    F.lane = vlane(); F.tid = F.wid * 64 + F.lane;
    unsigned char* ws = F.ws;
    LAS int* tstart = (LAS int*)(F.lds + LDS_CTL + 64); LAS int* soff = tstart + 40;
    moe_tables(F, l, tstart, soff);
    pg8::Gemm g{(const bf16_t*)(ws + WS_H), (const bf16_t*)(ws + WS_W_DN + (size_t)l * 32 * 1024 * 1024), 512};
    LAS int* ulist = (LAS int*)(F.lds + LDS_CTL + 3328);
    MoeOrder::build(F, tstart, 4, ulist);
    MoeOrderDN S{ulist};
    EpiDN E{(bf16_t*)(ws + WS_YE), KP->moe_b_dn + (size_t)l * 32 * 1024, (const float*)(ws + WS_SDN) + (size_t)l * 32 * 1024};
    pg8::gemm_phase<EpiDN, MoeOrderDN, true, 2>(F.lds, g, S, E, F.wid);
    F.lane = vlane(); F.tid = F.wid * 64 + F.lane;
    if (l == 0) { const int rem = (tstart[32] * 4) % F.G; if (rem && F.bid >= rem) conv_pull(F, 1, CONV_DN); }
}


DI void phase_combine(Frame& F, const Params& P, int l, float* outf, bf16_t* outb) {
    F.lane = vlane(); F.tid = F.wid * 64 + F.lane;
    unsigned char* ws = F.ws;
    LAS int* tstart = (LAS int*)(F.lds + LDS_CTL + 64); LAS int* soff = tstart + 40;
    moe_tables(F, l, tstart, soff);
    const float* g = KP->ln_g + (size_t)(l * 2 + 1) * DM; const float* bt = KP->ln_b + (size_t)(l * 2 + 1) * DM;
    const bf16_t* X1 = (const bf16_t*)(ws + WS_Y); const bf16_t* YE = (const bf16_t*)(ws + WS_YE);
    const float* g1 = KP->ln_g + (size_t)(l * 2 + 0) * DM; const float* b1 = KP->ln_b + (size_t)(l * 2 + 0) * DM;
    const int* PE = (const int*)(ws + WS_PE); const int* PPOS = (const int*)(ws + WS_PPOS); const float* GATE = (const float*)(ws + WS_GATE);
    const int gw = F.bid * 8 + F.wid, NGW = F.G * 8;
    i32x4 ie, ip; f32x4 ig;
    u32x2 xn[4]; u32x2 yn[4][4]; f32x4 gn;
#define CB_LOADIDX(r) do { ie = *(const i32x4*)(PE + (size_t)(r) * 4); ip = *(const i32x4*)(PPOS + (size_t)(r) * 4); ig = *(const f32x4*)(GATE + (size_t)(r) * 4); } while (0)
#define CB_LOADDATA(r) do { gn = ig; \
        _Pragma("unroll") for (int j = 0; j < 4; ++j) xn[j] = *((const u32x2*)(X1 + (size_t)(r) * DM) + F.lane + 64 * j); \
        _Pragma("unroll") for (int k = 0; k < 4; ++k) { const int slot = soff[ie[k]] + ip[k]; const u32x2* yr = (const u32x2*)(YE + (size_t)slot * 1024) + F.lane; \
            _Pragma("unroll") for (int j = 0; j < 4; ++j) yn[k][j] = yr[64 * j]; } } while (0)
    if (gw < T) { CB_LOADIDX(gw); CB_LOADDATA(gw); if (gw + NGW < T) CB_LOADIDX(gw + NGW); }
    for (int row = gw; row < T; row += NGW) {
        f32x4 v[4]; u32x2 yc[4][4]; f32x4 gc = gn;
        {
            float s0 = 0.f;
#pragma unroll
            for (int j = 0; j < 4; ++j) { v[j] = bf4(xn[j]); s0 += (v[j][0] + v[j][1]) + (v[j][2] + v[j][3]); }
            const float mean0 = wave_sum(s0) * (1.f / DM); float q0 = 0.f;
#pragma unroll
            for (int j = 0; j < 4; ++j) { v[j] = v[j] - mean0; q0 += (v[j][0] * v[j][0] + v[j][1] * v[j][1]) + (v[j][2] * v[j][2] + v[j][3] * v[j][3]); }
            const float rstd0 = 1.0f / sqrtf(wave_sum(q0) * (1.f / DM) + LN_EPS);
#pragma unroll
            for (int j = 0; j < 4; ++j) {
                const f32x4 gg = *((const f32x4*)g1 + F.lane + 64 * j), bb = *((const f32x4*)b1 + F.lane + 64 * j);
                v[j] = (v[j] * rstd0 * gg + bb) * ALPHA;
            }
        }
#pragma unroll
        for (int k = 0; k < 4; ++k)
#pragma unroll
            for (int j = 0; j < 4; ++j) yc[k][j] = yn[k][j];
        if (row + NGW < T) { CB_LOADDATA(row + NGW); if (row + 2 * NGW < T) CB_LOADIDX(row + 2 * NGW); }
#pragma unroll
        for (int k = 0; k < 4; ++k) {
            const float gt = gc[k];
#pragma unroll
            for (int j = 0; j < 4; ++j) {
                const u32x2 w = yc[k][j];
                v[j][0] += gt * __uint_as_float(w.x << 16); v[j][1] += gt * __uint_as_float(w.x & 0xffff0000u);
                v[j][2] += gt * __uint_as_float(w.y << 16); v[j][3] += gt * __uint_as_float(w.y & 0xffff0000u);
            }
        }
        float s = 0.f;
#pragma unroll
        for (int j = 0; j < 4; ++j) s += (v[j][0] + v[j][1]) + (v[j][2] + v[j][3]);
        const float mean = wave_sum(s) * (1.f / DM); float s2 = 0.f;
#pragma unroll
        for (int j = 0; j < 4; ++j) { v[j] = v[j] - mean; s2 += (v[j][0] * v[j][0] + v[j][1] * v[j][1]) + (v[j][2] * v[j][2] + v[j][3] * v[j][3]); }
        const float rstd = 1.0f / sqrtf(wave_sum(s2) * (1.f / DM) + LN_EPS);
#pragma unroll
        for (int j = 0; j < 4; ++j) {
            const f32x4 gg = *((const f32x4*)g + F.lane + 64 * j), bb = *((const f32x4*)bt + F.lane + 64 * j);
            v[j] = v[j] * rstd * gg + bb;
            if (outf) *((f32x4*)(outf + (size_t)row * DM) + F.lane + 64 * j) = v[j];
            if (outb) *((u32x2*)(outb + (size_t)row * DM) + F.lane + 64 * j) = (u32x2){cvtpk(v[j][0], v[j][1]), cvtpk(v[j][2], v[j][3])};
        }
    }
#undef CB_LOADIDX
#undef CB_LOADDATA
}

DI void phase_lat(Frame& F) {
    F.lane = vlane(); F.tid = F.wid * 64 + F.lane;
    unsigned char* ws = F.ws;
    pg8::Gemm g{(const bf16_t*)(ws + WS_XB), (const bf16_t*)(ws + WS_W_BIN), 1024}; pg8::StaticOrder S; S.init(T, 1024, 1024, F.G, F.bid);
    EpiLat E{(float*)(ws + WS_LAT), 928};
    pg8::gemm_phase<EpiLat, pg8::StaticOrder, false>(F.lds, g, S, E, F.wid);
}

DI void phase_latrows(Frame& F, const Params& P) {
    F.lane = vlane(); F.tid = F.wid * 64 + F.lane;
    unsigned char* ws = F.ws;
    const float* LAT = (const float*)(ws + WS_LAT);
    bf16_t* CKV = (bf16_t*)(ws + WS_CKV); bf16_t* CQ = (bf16_t*)(ws + WS_CQ); bf16_t* MQ = (bf16_t*)(ws + WS_MQ); bf16_t* Kb = (bf16_t*)(ws + WS_K);
    const int gw = F.bid * 8 + F.wid, NGW = F.G * 8;
    for (int row = gw; row < T; row += NGW) {
        const float* lr = LAT + (size_t)row * 1024;
        {
            const f32x4 v = *((const f32x4*)lr + F.lane);
            const float ss = wave_sum((v[0] * v[0] + v[1] * v[1]) + (v[2] * v[2] + v[3] * v[3]));
            const float rs = 1.0f / sqrtf(ss * (1.f / 256.f) + RMS_EPS);
            const f32x4 gg = *((const f32x4*)KP->kv_g + F.lane);
            const f32x4 o = v * rs * gg;
            *((u32x2*)(CKV + (size_t)row * 256) + F.lane) = (u32x2){cvtpk(o[0], o[1]), cvtpk(o[2], o[3])};
        }
        {
            const f32x4 v0 = *((const f32x4*)(lr + 288) + F.lane);
            f32x4 v1 = (f32x4){0.f, 0.f, 0.f, 0.f};
            if (F.lane < 32) v1 = *((const f32x4*)(lr + 288 + 256) + F.lane);
            const float ss = wave_sum((v0[0] * v0[0] + v0[1] * v0[1]) + (v0[2] * v0[2] + v0[3] * v0[3]) + (v1[0] * v1[0] + v1[1] * v1[1]) + (v1[2] * v1[2] + v1[3] * v1[3]));
            const float rs = 1.0f / sqrtf(ss * (1.f / 384.f) + RMS_EPS);
            const f32x4 g0 = *((const f32x4*)KP->b_g_q + F.lane);
            const f32x4 o0 = v0 * rs * g0;
            *((u32x2*)(CQ + (size_t)row * 384) + F.lane) = (u32x2){cvtpk(o0[0], o0[1]), cvtpk(o0[2], o0[3])};
            if (F.lane < 32) {
                const f32x4 g1 = *((const f32x4*)(KP->b_g_q + 256) + F.lane);
                const f32x4 o1 = v1 * rs * g1;
                *((u32x2*)(CQ + (size_t)row * 384 + 256) + F.lane) = (u32x2){cvtpk(o1[0], o1[1]), cvtpk(o1[2], o1[3])};
            }
        }
        {
            const f32x4 v = *((const f32x4*)(lr + 672) + F.lane) * (0.125f * LOG2E);
            *((u32x2*)(MQ + (size_t)row * 256) + F.lane) = (u32x2){cvtpk(v[0], v[1]), cvtpk(v[2], v[3])};
        }
        if (F.lane < 16) {
            const int i = F.lane;
            const float p = (float)KP->pos[row];
            const float inv = exp2f(-(float)i * (13.287712379549449f / 16.0f));
            float sn, cs; sincos_cw(p * inv, sn, cs);
            const float x1 = lr[256 + i], x2 = lr[256 + 16 + i];
            const unsigned short o1 = (unsigned short)(cvtpk(x1 * cs - x2 * sn, 0.f) & 0xffffu), o2 = (unsigned short)(cvtpk(x1 * sn + x2 * cs, 0.f) & 0xffffu);
#pragma unroll
            for (int h = 0; h < NH; ++h) { Kb[(size_t)row * 1152 + h * 96 + 64 + i] = o1; Kb[(size_t)row * 1152 + h * 96 + 80 + i] = o2; }
        }
    }
}
#ifndef UPSEL
#define UPSEL 7
#endif
struct RouteK1 { unsigned char* ws; DI Dst operator()(const pg8::Unit& u) const { return Dst{(bf16_t*)(ws + WS_K), 1152, u.pm * 256, u.pn * 384, 256, 1.0f, true}; } };
struct RouteQ1 { unsigned char* ws; DI Dst operator()(const pg8::Unit& u) const { const int nv = 1152 - u.pn * 256; return Dst{(bf16_t*)(ws + WS_Q), 1152, u.pm * 256, u.pn * 256, nv < 256 ? nv : 256, 0.10206207261596577f * LOG2E, false}; } };
DI void phase_up1(Frame& F) {
    F.lane = vlane(); F.tid = F.wid * 64 + F.lane;
    unsigned char* ws = F.ws;
    const bf16_t* ckv = (const bf16_t*)(ws + WS_CKV); const bf16_t* cq = (const bf16_t*)(ws + WS_CQ);
    const bf16_t* wukv = (const bf16_t*)(ws + WS_W_UKV); const bf16_t* wuq = (const bf16_t*)(ws + WS_W_UQ);
#if (UPSEL & 1)
    {
        pg8::Gemm g{cq, wuq, 384}; pg8::StaticOrder S; S.init(T, 1280, 384, F.G, F.bid);
        EpiBf16R<RouteQ1> E{RouteQ1{ws}};
        pg8::gemm_phase<EpiBf16R<RouteQ1>, pg8::StaticOrder, true>(F.lds, g, S, E, F.wid);
    }
#endif
#if (UPSEL & 2)
    {
        pg8::Gemm g{ckv, wukv, 256}; pg8::StaticOrder S; S.init(T, 768, 256, F.G, F.G - 1 - F.bid);
        EpiBf16R<RouteK1> E{RouteK1{ws}};
        pg8::gemm_phase<EpiBf16R<RouteK1>, pg8::StaticOrder, true>(F.lds, g, S, E, F.wid);
    }
#endif
#if (UPSEL & 4)
    {
        pg8::Gemm g{wukv + (size_t)768 * 256, ckv, 256}; pg8::StaticOrder S; S.init(768, T, 256, F.G, F.G - 1 - F.bid);
        EpiBf16R<RouteVT> E{RouteVT{ws}};
        pg8::gemm_phase<EpiBf16R<RouteVT>, pg8::StaticOrder, true>(F.lds, g, S, E, F.wid);
    }
#endif
}


__global__ void __launch_bounds__(NTHREADS) mega_fwd(Params P) {
    extern __shared__ __attribute__((aligned(16))) unsigned char lds_raw[];
    Frame F;
    F.lds = (LAS unsigned char*)lds_raw; F.ws = KP->ws; F.ctl = (unsigned*)(KP->ws + WS_CTL);
    F.wid = __builtin_amdgcn_readfirstlane((int)threadIdx.x >> 6); F.lane = vlane(); F.tid = F.wid * 64 + F.lane; F.G = gridDim.x; F.bid = blockIdx.x;
    const int lo = KP->ph_lo, hi = KP->ph_hi;
    { volatile LAS unsigned* st0 = (volatile LAS unsigned*)(F.lds + LDS_CTL + 512); if (F.tid < 2) st0[F.tid] = 0u; }
    __syncthreads();
    XcdBarrier bar = xcd_barrier_post(F.ctl + CW_BAR, (volatile LAS unsigned*)(F.lds + LDS_CTL + 512), F.wid);
#ifndef PHMASK
#define PHMASK 0x1ffff
#endif
#define IN(k) (((PHMASK >> (k)) & 1) && lo <= (k) && (k) < hi)
#define SEAM(k) do { if (IN(k) && IN((k) + 1)) { if (KP->use_grid_sync) { if ((k) == 0) cg::this_grid().sync(); else xcd_barrier(bar); } } } while (0)
    unsigned char* ws = KP->ws;
    if (IN(0)) { phase_prologue(F, P);
    }
    SEAM(0);
    if (IN(1)) { phase_proj0(F, P);
        if (KP->use_grid_sync) xcd_barrier(bar); phase_scan_knorm(F); }
    SEAM(1);
    if (IN(2)) { phase_attn0(F, P);
    }
    SEAM(2);
    if (IN(3)) { phase_outproj(F, (const bf16_t*)(ws + WS_W_AOUT));
    }
    SEAM(3);
    if (IN(4)) phase_ln_router(F, P, 0);
    SEAM(4);
    if (IN(5)) phase_moe_gu(F, P, 0);
    SEAM(5);
    if (IN(6)) phase_moe_dn(F, P, 0);
    SEAM(6);
    if (IN(7)) phase_combine(F, P, 0, nullptr, (bf16_t*)(ws + WS_XB));
    SEAM(7);
    if (IN(8)) phase_lat(F);
    SEAM(8);
    if (IN(9)) phase_latrows(F, P);
    SEAM(9);
    if (IN(10)) { phase_up1(F);
    }
    SEAM(10);
    if (IN(11)) { phase_attn1(F, P);
    }
    SEAM(11);
    if (IN(12)) phase_outproj(F, (const bf16_t*)(ws + WS_W_BOUT));
    SEAM(12);
    if (IN(13)) phase_ln_router(F, P, 1);
    SEAM(13);
    if (IN(14)) { phase_moe_gu(F, P, 1);
    }
    SEAM(14);
    if (IN(15)) { phase_moe_dn(F, P, 1);
    }
    SEAM(15);
    if (IN(16)) { phase_combine(F, P, 1, KP->out, nullptr);
    }
#undef IN
#undef SEAM
}

constexpr int N_PHASES = 17;
#ifndef MK_N_LAUNCHES
#define MK_N_LAUNCHES 1
#endif

extern "C" void kernel_launch(void* const* d_in, const int* in_sizes, int n_in, void* d_out, int out_size, void* d_ws, size_t ws_size, hipStream_t stream) {
    static int grid = 0;
    if (grid == 0) {
        if (n_in != 22 || ws_size < WS_END) { fprintf(stderr, "kernel_launch: need 22 inputs and %zu bytes of workspace (got %d, %zu)\n", (size_t)WS_END, n_in, ws_size); grid = -1; return; }
        int dev = 0, cus = 0, per_cu = 0;
        hipGetDevice(&dev);
        hipDeviceGetAttribute(&cus, hipDeviceAttributeMultiprocessorCount, dev);
        if (hipFuncSetAttribute((const void*)mega_fwd, hipFuncAttributeMaxDynamicSharedMemorySize, LDS_BYTES) != hipSuccess) fprintf(stderr, "kernel_launch: hipFuncSetAttribute failed\n");
        if (hipOccupancyMaxActiveBlocksPerMultiprocessor(&per_cu, (const void*)mega_fwd, NTHREADS, LDS_BYTES) != hipSuccess || per_cu < 1) { fprintf(stderr, "kernel_launch: occupancy query failed (%d)\n", per_cu); per_cu = 1; }
        (void)hipGetLastError();
        grid = cus * (per_cu > 1 ? 1 : per_cu);
        if (grid <= 0) grid = 256;
        if (grid != 256) fprintf(stderr, "kernel_launch: built for a 256-CU device (one workgroup per CU); got %d\n", grid);
    }
    if (grid < 0) return;
    hipMemsetAsync((char*)d_ws + WS_CTL, 0, CTL_BYTES, stream);
    Params p{};
    p.x = (const float*)d_in[0]; p.mem = (const float*)d_in[1]; p.pos = (const int*)d_in[2];
    p.a_w_in = (const float*)d_in[3]; p.a_b_f = (const float*)d_in[4]; p.a_w_out = (const float*)d_in[5];
    p.b_w_in = (const float*)d_in[6]; p.b_g_q = (const float*)d_in[7]; p.b_w_uq = (const float*)d_in[8]; p.b_w_out = (const float*)d_in[9];
    p.kv_w_dkv = (const float*)d_in[10]; p.kv_g = (const float*)d_in[11]; p.kv_w_ukv = (const float*)d_in[12]; p.mem_w_kv = (const float*)d_in[13];
    p.ln_g = (const float*)d_in[14]; p.ln_b = (const float*)d_in[15]; p.moe_w_r = (const float*)d_in[16]; p.moe_b_r = (const float*)d_in[17];
    p.moe_w_gu = (const float*)d_in[18]; p.moe_b_gu = (const float*)d_in[19]; p.moe_w_dn = (const float*)d_in[20]; p.moe_b_dn = (const float*)d_in[21];
    p.out = (float*)d_out; p.ws = (unsigned char*)d_ws;
    if (MK_N_LAUNCHES == 1) {
        p.ph_lo = 0; p.ph_hi = N_PHASES; p.use_grid_sync = 1;
        void* args[] = {&p};
        hipError_t e = hipLaunchCooperativeKernel((const void*)mega_fwd, dim3(grid), dim3(NTHREADS), args, LDS_BYTES, stream);
        if (e != hipSuccess) fprintf(stderr, "kernel_launch: cooperative launch failed: %s (grid %d)\n", hipGetErrorString(e), grid);
    } else {
        for (int ph = 0; ph < N_PHASES; ++ph) {
            p.ph_lo = ph; p.ph_hi = ph + 1; p.use_grid_sync = 0;
            hipLaunchKernelGGL(mega_fwd, dim3(grid), dim3(NTHREADS), LDS_BYTES, stream, p);
        }
    }
}
```
